# Optimizing an MI355X kernel written in HIP

```python
import jax
import jax.numpy as jnp
from jax import lax
import numpy as np

D_MODEL = 2048
BATCH = 4
SEQ = 4096
DEPTH = 2

EPS = 1e-6
NEG_INF = -1e30
CONV_CH = D_MODEL // 2
CONV_GROUPS = 8
CONV_WIDTH = 31
ATT_HEADS = 8
HEAD_DIM = 128
ATT_W = ATT_HEADS * HEAD_DIM
ATT_BRANCHES = ((128, 1), (512, 4), (2048, 16))
ATT_BLK = 64
ALIBI_MAX = 8.0
LRU_WIDTH = (4 * D_MODEL // 3) // 128 * 128
LRU_BLOCKS = 16
LRU_BW = LRU_WIDTH // LRU_BLOCKS
LRU_CONV = 4
LRU_C = 8.0
N_GROUPS = 4
EXPERTS_PER_GROUP = 8
N_EXPERTS = N_GROUPS * EXPERTS_PER_GROUP
TOP_K = 2
EXPERT_FF = D_MODEL // 2
MOE_BLK = 256

kernel_name = "hybrid_conv_dilattn_rglru_hmoe_encoder"


def rms_norm(x, g):
    xf = x.astype(jnp.float32)
    y = xf * lax.rsqrt(jnp.mean(xf * xf, axis=-1, keepdims=True) + EPS)
    return (y * g.astype(jnp.float32)).astype(x.dtype)


def group_layer_norm(x, g, b, groups):
    shp = x.shape
    xf = x.astype(jnp.float32).reshape(*shp[:-1], groups, shp[-1] // groups)
    mu = jnp.mean(xf, axis=-1, keepdims=True)
    var = jnp.mean(jnp.square(xf - mu), axis=-1, keepdims=True)
    y = ((xf - mu) * lax.rsqrt(var + EPS)).reshape(shp)
    return (y * g.astype(jnp.float32) + b.astype(jnp.float32)).astype(x.dtype)


def depthwise_conv(x, w, b, pad_left, pad_right):
    y = lax.conv_general_dilated(
        x, w[:, None, :].astype(x.dtype), window_strides=(1,),
        padding=[(pad_left, pad_right)], dimension_numbers=("NWC", "WIO", "NWC"),
        feature_group_count=x.shape[-1])
    return y + b


def ada_modulation(c, w, b):
    mod = jax.nn.silu(c) @ w + b
    shift, scale, gate = jnp.split(mod, 3, axis=-1)
    return shift[:, None, :], scale[:, None, :], gate[:, None, :]


def modulated_residual(x, c, norm_g, ada_w, ada_b, fn):
    shift, scale, gate = ada_modulation(c, ada_w, ada_b)
    h = rms_norm(x, norm_g) * (1.0 + scale) + shift
    return x + gate * fn(h)


def dilated_window_attention(q, k, v, dilation, radius, slopes):
    bsz, seq, heads, dh = q.shape
    sub = seq // dilation
    nblk = -(-sub // ATT_BLK)
    padded = nblk * ATT_BLK

    def by_residue(t):
        t = t.reshape(bsz, sub, dilation, heads, dh).transpose(0, 2, 1, 3, 4)
        return jnp.pad(t, ((0, 0), (0, 0), (0, padded - sub), (0, 0), (0, 0)))

    def neighbour_blocks(t):
        tp = jnp.pad(t, ((0, 0), (0, 0), (ATT_BLK, ATT_BLK), (0, 0), (0, 0)))
        tp = tp.reshape(bsz, dilation, nblk + 2, ATT_BLK, heads, dh)
        return jnp.concatenate([tp[:, :, :-2], tp[:, :, 1:-1], tp[:, :, 2:]], axis=3)

    qb = by_residue(q).reshape(bsz, dilation, nblk, ATT_BLK, heads, dh)
    kb = neighbour_blocks(by_residue(k))
    vb = neighbour_blocks(by_residue(v))

    m_idx = jnp.arange(padded).reshape(nblk, ATT_BLK, 1)
    n_idx = ((jnp.arange(nblk) - 1) * ATT_BLK)[:, None, None] + jnp.arange(3 * ATT_BLK)[None, None, :]
    rel = jnp.abs(m_idx - n_idx)
    valid = (rel <= radius) & (n_idx >= 0) & (n_idx < sub)
    alibi = slopes[None, :, None, None] * (rel * dilation).astype(jnp.float32)[:, None]

    s = jnp.einsum("brnihe,brnjhe->brnhij", qb, kb).astype(jnp.float32) * (dh ** -0.5) - alibi
    s = jnp.where(valid[:, None], s, NEG_INF)
    mx = jnp.max(s, axis=-1, keepdims=True)
    e = jnp.exp(s - mx)
    den = jnp.sum(e, axis=-1, keepdims=True)
    o = jnp.einsum("brnhij,brnjhe->brnihe", (e / den).astype(v.dtype), vb)
    lse = (mx + jnp.log(den))[..., 0].transpose(0, 1, 2, 4, 3)

    def to_sequence(t):
        t = t.reshape(bsz, dilation, padded, *t.shape[4:])[:, :, :sub]
        t = jnp.swapaxes(t, 1, 2)
        return t.reshape(bsz, seq, *t.shape[3:])

    return to_sequence(o), to_sequence(lse)


def conv_attention_mixer(h, w_in, conv_w, conv_b, conv_norm_g, conv_norm_b, w_out):
    bsz, seq, _ = h.shape
    split_at = [CONV_CH, 2 * CONV_CH, 2 * CONV_CH + ATT_W, 2 * CONV_CH + 2 * ATT_W]
    glu_v, glu_g, q, k, v = jnp.split(h @ w_in, split_at, axis=-1)
    a = glu_v * jax.nn.sigmoid(glu_g)
    a = depthwise_conv(a, conv_w, conv_b, CONV_WIDTH // 2, CONV_WIDTH // 2)
    a = jax.nn.silu(group_layer_norm(a, conv_norm_g, conv_norm_b, CONV_GROUPS))
    q, k, v = (t.reshape(bsz, seq, ATT_HEADS, HEAD_DIM) for t in (q, k, v))
    slopes = 2.0 ** (-ALIBI_MAX * jnp.arange(1, ATT_HEADS + 1, dtype=jnp.float32) / ATT_HEADS)
    outs, lses = [], []
    for window, dilation in ATT_BRANCHES:
        o_br, lse_br = dilated_window_attention(q, k, v, dilation, window // (2 * dilation), slopes)
        outs.append(o_br)
        lses.append(lse_br)
    wts = jax.nn.softmax(jnp.stack(lses), axis=0)[..., None]
    o = jnp.sum(wts * jnp.stack(outs).astype(jnp.float32), axis=0).astype(h.dtype)
    return jnp.concatenate([a, o.reshape(bsz, seq, ATT_W)], axis=-1) @ w_out


def block_diagonal(x, w, b):
    xb = x.reshape(*x.shape[:-1], LRU_BLOCKS, LRU_BW)
    return jnp.einsum("bsnc,ncd->bsnd", xb, w).reshape(x.shape) + b


def linear_recurrence_combine(left, right):
    a_l, b_l = left
    a_r, b_r = right
    return a_l * a_r, a_r * b_l + b_r


def rglru(x, w_a, b_a, w_x, b_x, lam, reverse):
    r = jax.nn.sigmoid(block_diagonal(x, w_a, b_a).astype(jnp.float32))
    i = jax.nn.sigmoid(block_diagonal(x, w_x, b_x).astype(jnp.float32))
    log_a = -LRU_C * r * jax.nn.softplus(-lam.astype(jnp.float32))
    a = jnp.exp(log_a)
    u = jnp.sqrt(-jnp.expm1(2.0 * log_a)) * (i * x.astype(jnp.float32))
    _, hs = lax.associative_scan(linear_recurrence_combine, (a, u), axis=1, reverse=reverse)
    return hs.astype(x.dtype)


def rglru_mixer(h, w_in, conv_w, conv_b, w_a, b_a, w_x, b_x, lam, w_out):
    gate, xr = jnp.split(h @ w_in, 2, axis=-1)
    xr = depthwise_conv(xr, conv_w, conv_b, LRU_CONV // 2, LRU_CONV - 1 - LRU_CONV // 2)
    y = (rglru(xr, w_a[0], b_a[0], w_x[0], b_x[0], lam[0], reverse=False)
         + rglru(xr, w_a[1], b_a[1], w_x[1], b_x[1], lam[1], reverse=True))
    return (jax.nn.gelu(gate) * y) @ w_out


def hierarchical_moe(h, w_group, w_expert, w_gate_up, w_down):
    bsz, seq, d = h.shape
    xt = h.reshape(-1, d)
    n_tok = xt.shape[0]
    g_logits = (xt @ w_group).astype(jnp.float32)
    g_sel = jnp.argmax(g_logits, axis=-1)
    g_prob = jnp.take_along_axis(jax.nn.softmax(g_logits, axis=-1), g_sel[:, None], axis=-1)
    e_logits = (xt @ w_expert).astype(jnp.float32).reshape(n_tok, N_GROUPS, EXPERTS_PER_GROUP)
    e_logits = jnp.take_along_axis(e_logits, g_sel[:, None, None], axis=1)[:, 0]
    top_v, top_i = lax.top_k(e_logits, TOP_K)
    gate = (g_prob * jax.nn.softmax(top_v, axis=-1)).reshape(-1)
    eid = (g_sel[:, None] * EXPERTS_PER_GROUP + top_i).reshape(-1)
    tok = jnp.repeat(jnp.arange(n_tok, dtype=jnp.int32), TOP_K)
    n_asg = n_tok * TOP_K
    order = jnp.argsort(eid)
    eid_s, tok_s, gate_s = eid[order], tok[order], gate[order]
    counts = jnp.bincount(eid, length=N_EXPERTS)
    start = jnp.cumsum(counts) - counts
    pcounts = (counts + MOE_BLK - 1) // MOE_BLK * MOE_BLK
    pend = jnp.cumsum(pcounts)
    dest = (pend - pcounts)[eid_s] + jnp.arange(n_asg) - start[eid_s]
    rows = n_asg + N_EXPERTS * MOE_BLK
    buf_tok = jnp.full((rows,), n_tok, jnp.int32).at[dest].set(tok_s)
    buf_gate = jnp.zeros((rows,), h.dtype).at[dest].set(gate_s.astype(h.dtype))
    n_blk = rows // MOE_BLK
    blk_expert = jnp.minimum(
        jnp.searchsorted(pend, jnp.arange(n_blk) * MOE_BLK, side="right"), N_EXPERTS - 1)
    xpad = jnp.concatenate([xt, jnp.zeros((1, d), xt.dtype)], axis=0)
    xb = xpad[buf_tok].reshape(n_blk, MOE_BLK, d)

    def expert_block(args):
        xblk, e = args
        g, u = jnp.split(xblk @ w_gate_up[e], 2, axis=-1)
        return (jax.nn.silu(g) * u) @ w_down[e]

    yb = lax.map(expert_block, (xb, blk_expert)).reshape(rows, d)
    y = jnp.zeros((n_tok + 1, d), yb.dtype).at[buf_tok].add(yb * buf_gate[:, None])
    return y[:n_tok].reshape(bsz, seq, d)


def setup_inputs(seed: int = 0) -> dict:
    key = jax.random.key(seed)
    keys = iter(jax.random.split(key, 64))
    d = D_MODEL

    def normal(shape, scale):
        return jax.random.normal(next(keys), shape, jnp.float32) * scale

    def gain(n):
        return 1.0 + normal((n,), 0.05)

    def small(shape):
        return normal(shape, 0.01)

    def lru_lambda():
        a0 = jax.random.uniform(next(keys), (2, LRU_WIDTH), jnp.float32, 0.9, 0.999)
        s = a0 ** (1.0 / LRU_C)
        return jnp.log(s) - jnp.log1p(-s)

    ada_scale = 0.5 * d ** -0.5
    inp = {}
    inp["x"] = normal((BATCH, SEQ, d), 1.0)
    inp["c"] = normal((BATCH, d), 1.0)
    inp["norm0_mix"] = gain(d)
    inp["ada0_mix_w"] = normal((d, 3 * d), ada_scale)
    inp["ada0_mix_b"] = small((3 * d,))
    inp["w_in0"] = normal((d, 2 * CONV_CH + 3 * ATT_W), d ** -0.5)
    inp["conv_w"] = normal((CONV_WIDTH, CONV_CH), CONV_WIDTH ** -0.5)
    inp["conv_b"] = small((CONV_CH,))
    inp["conv_norm_g"] = gain(CONV_CH)
    inp["conv_norm_b"] = small((CONV_CH,))
    inp["w_out0"] = normal((CONV_CH + ATT_W, d), (CONV_CH + ATT_W) ** -0.5)
    inp["norm0_ffn"] = gain(d)
    inp["ada0_ffn_w"] = normal((d, 3 * d), ada_scale)
    inp["ada0_ffn_b"] = small((3 * d,))
    inp["moe0_w_group"] = normal((d, N_GROUPS), d ** -0.5)
    inp["moe0_w_expert"] = normal((d, N_EXPERTS), d ** -0.5)
    inp["moe0_w_gate_up"] = normal((N_EXPERTS, d, 2 * EXPERT_FF), d ** -0.5)
    inp["moe0_w_down"] = normal((N_EXPERTS, EXPERT_FF, d), EXPERT_FF ** -0.5)
    inp["norm1_mix"] = gain(d)
    inp["ada1_mix_w"] = normal((d, 3 * d), ada_scale)
    inp["ada1_mix_b"] = small((3 * d,))
    inp["w_in1"] = normal((d, 2 * LRU_WIDTH), d ** -0.5)
    inp["lru_conv_w"] = normal((LRU_CONV, LRU_WIDTH), LRU_CONV ** -0.5)
    inp["lru_conv_b"] = small((LRU_WIDTH,))
    inp["lru_w_a"] = normal((2, LRU_BLOCKS, LRU_BW, LRU_BW), LRU_BW ** -0.5)
    inp["lru_b_a"] = small((2, LRU_WIDTH))
    inp["lru_w_x"] = normal((2, LRU_BLOCKS, LRU_BW, LRU_BW), LRU_BW ** -0.5)
    inp["lru_b_x"] = small((2, LRU_WIDTH))
    inp["lru_lambda"] = lru_lambda()
    inp["w_out1"] = normal((LRU_WIDTH, d), LRU_WIDTH ** -0.5)
    inp["norm1_ffn"] = gain(d)
    inp["ada1_ffn_w"] = normal((d, 3 * d), ada_scale)
    inp["ada1_ffn_b"] = small((3 * d,))
    inp["moe1_w_group"] = normal((d, N_GROUPS), d ** -0.5)
    inp["moe1_w_expert"] = normal((d, N_EXPERTS), d ** -0.5)
    inp["moe1_w_gate_up"] = normal((N_EXPERTS, d, 2 * EXPERT_FF), d ** -0.5)
    inp["moe1_w_down"] = normal((N_EXPERTS, EXPERT_FF, d), EXPERT_FF ** -0.5)
    inp["norm_final"] = gain(d)
    return inp


def reference(x, c,
              norm0_mix, ada0_mix_w, ada0_mix_b, w_in0, conv_w, conv_b, conv_norm_g, conv_norm_b, w_out0,
              norm0_ffn, ada0_ffn_w, ada0_ffn_b, moe0_w_group, moe0_w_expert, moe0_w_gate_up, moe0_w_down,
              norm1_mix, ada1_mix_w, ada1_mix_b, w_in1, lru_conv_w, lru_conv_b, lru_w_a, lru_b_a,
              lru_w_x, lru_b_x, lru_lambda, w_out1,
              norm1_ffn, ada1_ffn_w, ada1_ffn_b, moe1_w_group, moe1_w_expert, moe1_w_gate_up, moe1_w_down,
              norm_final):
    mixer_fns = (
        lambda h: conv_attention_mixer(h, w_in0, conv_w, conv_b, conv_norm_g, conv_norm_b, w_out0),
        lambda h: rglru_mixer(h, w_in1, lru_conv_w, lru_conv_b, lru_w_a, lru_b_a, lru_w_x, lru_b_x,
                              lru_lambda, w_out1),
    )
    mix_mod = ((norm0_mix, ada0_mix_w, ada0_mix_b), (norm1_mix, ada1_mix_w, ada1_mix_b))
    ffn_mod = ((norm0_ffn, ada0_ffn_w, ada0_ffn_b), (norm1_ffn, ada1_ffn_w, ada1_ffn_b))
    moe_params = ((moe0_w_group, moe0_w_expert, moe0_w_gate_up, moe0_w_down),
                  (moe1_w_group, moe1_w_expert, moe1_w_gate_up, moe1_w_down))
    for layer in range(DEPTH):
        x = modulated_residual(x, c, *mix_mod[layer], mixer_fns[layer])
        x = modulated_residual(x, c, *ffn_mod[layer], lambda h: hierarchical_moe(h, *moe_params[layer]))
    return rms_norm(x, norm_final)
```

```cpp
#include <hip/hip_runtime.h>
#include <stdint.h>

typedef unsigned short bf16_t;
typedef float f32x4 __attribute__((ext_vector_type(4)));

#define DI __device__ __forceinline__

constexpr int T_TOK = 16384, DM = 2048, SEQ = 4096, NBATCH = 4;
constexpr int N_IN0 = 5120, N_IN1 = 5376, LRU_W = 2688, LRU_BW = 168;
constexpr int NEXP = 32, EFF = 1024, ECAP = 16384, ROWS_PAD = 40960;

DI float bf2f(bf16_t b) { return __uint_as_float(((unsigned)b) << 16); }
DI bf16_t f2bf(float f) { unsigned u = __float_as_uint(f); u += 0x7FFFu + ((u >> 16) & 1u); return (bf16_t)(u >> 16); }
DI float sigmoidf_(float x) { return __builtin_amdgcn_rcpf(1.0f + __expf(-x)); }
DI float siluf_(float x) { return x * __builtin_amdgcn_rcpf(1.0f + __expf(-x)); }
DI float gelu_tanh(float x) { const float u = 0.7978845608028654f * (x + 0.044715f * x * x * x); return x * __builtin_amdgcn_rcpf(1.0f + __expf(-2.0f * u)); }
DI float wave_sum(float v) { for (int o = 32; o > 0; o >>= 1) v += __shfl_xor(v, o); return v; }
DI float wave_max(float v) { for (int o = 32; o > 0; o >>= 1) v = fmaxf(v, __shfl_xor(v, o)); return v; }

struct Params {
    const float *x, *c;
    const float *norm0_mix, *ada0_mix_w, *ada0_mix_b, *w_in0, *conv_w, *conv_b, *conv_norm_g, *conv_norm_b, *w_out0;
    const float *norm0_ffn, *ada0_ffn_w, *ada0_ffn_b, *moe0_w_group, *moe0_w_expert, *moe0_w_gate_up, *moe0_w_down;
    const float *norm1_mix, *ada1_mix_w, *ada1_mix_b, *w_in1, *lru_conv_w, *lru_conv_b, *lru_w_a, *lru_b_a, *lru_w_x, *lru_b_x, *lru_lambda, *w_out1;
    const float *norm1_ffn, *ada1_ffn_w, *ada1_ffn_b, *moe1_w_group, *moe1_w_expert, *moe1_w_gate_up, *moe1_w_down;
    const float *norm_final;
    float* out;
    unsigned* bar; int* cnt;
    float* mod;
    float* wrt;
    float* rbias;
    bf16_t *w_in0t, *w_out0t, *w_gut0, *w_dt0, *w_in1t, *w_out1t, *w_gut1, *w_dt1, *w_lru;
    bf16_t *H, *G, *AO, *HF, *ACT, *YB, *XC, *KVH;
    float* XA;
    int* tokl; float* gatel; int* asg;
};

struct GUnit { int rowbase; int nvalid; int e; const int* gather; };
struct GArgs { const bf16_t* A; const bf16_t* Bt; size_t bt_estride; long long lda, K, moe_layer; const float* xin; long long lgate; };
typedef unsigned u32x4_ __attribute__((ext_vector_type(4)));
typedef __bf16 bf2v_ __attribute__((ext_vector_type(2)));
typedef float f32x2_ __attribute__((ext_vector_type(2)));
DI unsigned pk2e(float a, float b) { f32x2_ v = {a, b}; bf2v_ r = __builtin_convertvector(v, bf2v_); return __builtin_bit_cast(unsigned, r); }
DI u32x4_ pack8(f32x4 a, f32x4 b) { return (u32x4_){pk2e(a[0], a[1]), pk2e(a[2], a[3]), pk2e(b[0], b[1]), pk2e(b[2], b[3])}; }
struct EpiIn0 { static constexpr bool GATHER = false; const float* xin; int lgate; DI void operator()(const Params& p, const GUnit& u, int r, int col0, f32x4 lo0, f32x4 lo1, f32x4 hi0, f32x4 hi1) const {
    const int row = u.rowbase + r;
    if (col0 < 3072) { bf16_t* o = p.G + (size_t)row * N_IN0 + col0; *(u32x4_*)o = pack8(lo0, lo1); *(u32x4_*)(o + 128) = pack8(hi0, hi1); }
    else { const int b = row / SEQ, t = row % SEQ, i0 = (col0 - 3072) >> 7, i1 = i0 + 1;
        bf16_t* o0 = p.KVH + ((size_t)((b * 8 + (i0 & 7)) * 2 + (i0 >> 3)) * SEQ + t) * 128 + (col0 & 127);
        bf16_t* o1 = p.KVH + ((size_t)((b * 8 + (i1 & 7)) * 2 + (i1 >> 3)) * SEQ + t) * 128 + (col0 & 127);
        *(u32x4_*)o0 = pack8(lo0, lo1); *(u32x4_*)o1 = pack8(hi0, hi1); } } };
struct EpiOut { static constexpr bool GATHER = false; const float* xin; int lgate; DI void operator()(const Params& p, const GUnit& u, int r, int col0, f32x4 lo0, f32x4 lo1, f32x4 hi0, f32x4 hi1) const {
    const int row = u.rowbase + r, b = row / SEQ; const float* gt = p.mod + (lgate * 4 + b) * 6144 + 4096 + col0; const float* xi = xin + (size_t)row * DM + col0; float* o = p.XA + (size_t)row * DM + col0;
    *(f32x4*)o = *(const f32x4*)xi + *(const f32x4*)gt * lo0; *(f32x4*)(o + 4) = *(const f32x4*)(xi + 4) + *(const f32x4*)(gt + 4) * lo1;
    *(f32x4*)(o + 128) = *(const f32x4*)(xi + 128) + *(const f32x4*)(gt + 128) * hi0; *(f32x4*)(o + 132) = *(const f32x4*)(xi + 132) + *(const f32x4*)(gt + 132) * hi1; } };
DI unsigned pk4_fp8e(float a, float b, float c, float d, float sc) { a = fminf(fmaxf(a * sc, -448.f), 448.f); b = fminf(fmaxf(b * sc, -448.f), 448.f); c = fminf(fmaxf(c * sc, -448.f), 448.f); d = fminf(fmaxf(d * sc, -448.f), 448.f);
    unsigned w = 0u; w = __builtin_amdgcn_cvt_pk_fp8_f32(a, b, w, false); w = __builtin_amdgcn_cvt_pk_fp8_f32(c, d, w, true); return w; }
struct EpiGU { static constexpr bool GATHER = true; const float* xin; int lgate; DI void operator()(const Params& p, const GUnit& u, int r, int col0, f32x4 lo0, f32x4 lo1, f32x4 hi0, f32x4 hi1) const {
    f32x4 a0, a1;
#pragma unroll
    for (int j = 0; j < 4; ++j) { a0[j] = siluf_(lo0[j]) * hi0[j]; a1[j] = siluf_(lo1[j]) * hi1[j]; }
    *(uint2*)((unsigned char*)p.ACT + (size_t)(u.rowbase + r) * EFF + (col0 >> 8) * 128 + (col0 & 127)) = make_uint2(pk4_fp8e(a0[0], a0[1], a0[2], a0[3], 8.f), pk4_fp8e(a1[0], a1[1], a1[2], a1[3], 8.f)); } };
struct EpiDown { static constexpr bool GATHER = false; const float* xin; int lgate; DI void operator()(const Params& p, const GUnit& u, int r, int col0, f32x4 lo0, f32x4 lo1, f32x4 hi0, f32x4 hi1) const {
    const float g = p.gatel[(u.gather - p.tokl) + r]; bf16_t* o = p.YB + (size_t)(u.rowbase + r) * DM + col0;
    *(u32x4_*)o = pack8(lo0 * g, lo1 * g); *(u32x4_*)(o + 128) = pack8(hi0 * g, hi1 * g); } };
struct EpiIn1 { static constexpr bool GATHER = false; const float* xin; int lgate; DI void operator()(const Params& p, const GUnit& u, int r, int col0, f32x4 lo0, f32x4 lo1, f32x4 hi0, f32x4 hi1) const {
    bf16_t* o = p.G + (size_t)(u.rowbase + r) * N_IN1 + col0;
    if (col0 < LRU_W) {
#pragma unroll
        for (int j = 0; j < 4; ++j) { lo0[j] = gelu_tanh(lo0[j]); lo1[j] = gelu_tanh(lo1[j]); } }
    if (col0 + 128 < LRU_W) {
#pragma unroll
        for (int j = 0; j < 4; ++j) { hi0[j] = gelu_tanh(hi0[j]); hi1[j] = gelu_tanh(hi1[j]); } }
    *(u32x4_*)o = pack8(lo0, lo1); *(u32x4_*)(o + 128) = pack8(hi0, hi1); } };

#define LAS __attribute__((address_space(3)))
typedef short bf16x8 __attribute__((ext_vector_type(8)));
DI int opaque_tid() { int t = threadIdx.x; asm volatile("" : "+v"(t)); return t; }
namespace gm {
constexpr int BM = 256, BK = 64, HALF = 128, HTB = HALF * BK * 2, STAGE_BYTES = 8 * HTB, NXCD = 8, WGM = 4;
constexpr int TAB_OFF = STAGE_BYTES;
DI int lds_byte(int r, int c) { const int st = (r >> 4) * 2 + (c >> 5), rr = r & 15, cc = c & 31, ob = rr * 64 + cc * 2; return st * 1024 + (ob ^ (((ob >> 9) & 1) << 5)); }
DI int perm32(int rho) { const int n = rho >> 4, i = rho & 15; return 8 * (i >> 2) + 4 * n + (i & 3); }
DI void stage_rc(int b, int& R, int& C) { const int st = b / 1024, sb = b % 1024, swz = sb ^ (((sb >> 9) & 1) << 5); R = (st >> 1) * 16 + swz / 64; C = (st & 1) * 32 + (swz % 64) / 2; }
struct Unit { int arow, nvalid, orow, pn, e, goff; };
struct DenseSched {
    static constexpr bool GATHER = false, HALF_SKIP = false;
    int nM, nN, nwg, G, c;
    DI void init(int M, int N) { nM = M / BM; nN = N / BM; nwg = nM * nN; G = gridDim.x; c = blockIdx.x; }
    DI bool next(int i, Unit& u) const {
        const long L = (long)i * G + c; if (L >= nwg) return false;
        int wgid = (int)L; { const int q = nwg / NXCD, r = nwg % NXCD, xcd = wgid % NXCD, off = wgid / NXCD; wgid = (xcd < r ? xcd * (q + 1) : r * (q + 1) + (xcd - r) * q) + off; }
        const int nig = WGM * nN, gid = wgid / nig, fm = gid * WGM, gsz = (nM - fm) < WGM ? (nM - fm) : WGM;
        const int pm = fm + ((wgid % nig) % gsz); u.pn = (wgid % nig) / gsz; u.arow = pm * BM; u.orow = pm * BM; u.nvalid = BM; u.e = 0; u.goff = 0; return true;
    }
};
template <bool GATH> struct MoeSched {
    static constexpr bool GATHER = GATH, HALF_SKIP = true;
    const LAS int* tab; int G, c;
    DI void init(const LAS int* t) { tab = t; G = gridDim.x; c = blockIdx.x; }
    DI bool next(int i, Unit& u) const {
        const int L = i * G + c, mtile = L >> 3; const int total = __builtin_amdgcn_readfirstlane(tab[32]);
        if (mtile >= total) return false;
        int e = 0; for (int j = 1; j < 32; ++j) { if (__builtin_amdgcn_readfirstlane(tab[j]) <= mtile) e = j; }
        const int mt = mtile - __builtin_amdgcn_readfirstlane(tab[e]); const int cn = __builtin_amdgcn_readfirstlane(tab[64 + e]);
        u.e = e; u.pn = L & 7; u.orow = mtile * BM; u.arow = mtile * BM; u.nvalid = (cn - mt * BM) < BM ? (cn - mt * BM) : BM; u.goff = e * ECAP + mt * BM; return true;
    }
};
DI void moe_tables(LAS int* tab, const int* cnt) {
    if (threadIdx.x == 0) { int run = 0; for (int e = 0; e < 32; ++e) { const int cn = cnt[e]; tab[e] = run; tab[64 + e] = cn; run += (cn + 255) >> 8; } tab[32] = run; }
    __syncthreads();
}

typedef int i32x8 __attribute__((ext_vector_type(8)));
typedef int i32x4 __attribute__((ext_vector_type(4)));
DI void mfma8(f32x4& acc, const i32x8& w8, const i32x8& x8, int ws, int as) {
    asm volatile("v_mfma_scale_f32_16x16x128_f8f6f4 %0, %1, %2, %0, %3, %4 op_sel_hi:[0,0,0]" : "+v"(acc) : "v"(w8), "v"(x8), "v"(ws), "v"(as)); }
template <class Epi, class Sched, bool FP8 = false>
DI void gemm_phase(LAS unsigned char* lds, const Params& p, const bf16_t* A, const bf16_t* Bt, size_t bt_estride, int K, const Sched& S, const Epi& E, int wscale = 0x7f7f7f7f, int ascale = 0x7f7f7f7f) {
    const int tid = opaque_tid(), wid = __builtin_amdgcn_readfirstlane(tid >> 6), lane = tid & 63, wr = wid >> 2, wc = wid & 3, fr = lane & 15, fq = lane >> 4;
    const int nt = K / BK;
    unsigned voffA[2], voffB[2];
#pragma unroll
    for (int i = 0; i < 2; ++i) { int R, C; stage_rc(tid * 16 + i * 8192, R, C); voffA[i] = (unsigned)(R * K + C) * 2u; voffB[i] = (unsigned)(((R & ~31) + perm32(R & 31)) * K + C) * 2u; }
    const size_t kstep = (size_t)(BK * 2), hstep = (size_t)HALF * K * 2, tstep = 2 * hstep;
    const unsigned ldsw = (unsigned)wid * 1024u;
    const int aoff = lds_byte(wr * 64 + fr, fq * 8), boff = lds_byte(wc * 32 + fr, fq * 8);
#define G_SA(b, h) (((b) * 2 + (h)) * HTB)
#define G_SB(b, h) ((4 + (b) * 2 + (h)) * HTB)
#define G_STAGE(bufoff, gbase, voff) do { _Pragma("unroll") for (int _i = 0; _i < 2; ++_i) \
        __builtin_amdgcn_global_load_lds((const unsigned*)((const char*)(gbase) + (voff)[_i]), (LAS unsigned*)(lds + (bufoff) + ldsw + _i * 8192), 16, 0, 0); } while (0)
#define G_STAGE_A(bufoff, ubase, gv, h, koff) do { if constexpr (Sched::GATHER) { G_STAGE(bufoff, (const char*)A + (koff), gv[h]); } else { G_STAGE(bufoff, (ubase) + (h) * hstep + (koff), voffA); } } while (0)
#define G_LD16(off_) (*(const LAS i32x4*)(lds + (off_)))
#define G_LD16B(off_) (*(const LAS bf16x8*)(lds + (off_)))
#define G_LDA(dst, b, h) do { _Pragma("unroll") for (int m = 0; m < 4; ++m) { if constexpr (FP8) dst##8[m] = __builtin_shufflevector(G_LD16(G_SA(b, h) + aoff + m * 2048), G_LD16(G_SA(b, h) + aoff + m * 2048 + 1024), 0, 1, 2, 3, 4, 5, 6, 7); \
        else { dst[m][0] = G_LD16B(G_SA(b, h) + aoff + m * 2048); dst[m][1] = G_LD16B(G_SA(b, h) + aoff + m * 2048 + 1024); } } } while (0)
#define G_LDB(dst, b, h) do { _Pragma("unroll") for (int n = 0; n < 2; ++n) { if constexpr (FP8) dst##8[n] = __builtin_shufflevector(G_LD16(G_SB(b, h) + boff + n * 2048), G_LD16(G_SB(b, h) + boff + n * 2048 + 1024), 0, 1, 2, 3, 4, 5, 6, 7); \
        else { dst[n][0] = G_LD16B(G_SB(b, h) + boff + n * 2048); dst[n][1] = G_LD16B(G_SB(b, h) + boff + n * 2048 + 1024); } } } while (0)
#define G_MMA(ai, bj, At, Bt_) do { __builtin_amdgcn_s_setprio(1); _Pragma("unroll") for (int m = 0; m < 4; ++m) _Pragma("unroll") for (int n = 0; n < 2; ++n) { \
        if constexpr (FP8) mfma8(acc[ai][bj][m][n], Bt_##8[n], At##8[m], wscale, ascale); \
        else { _Pragma("unroll") for (int k = 0; k < 2; ++k) acc[ai][bj][m][n] = __builtin_amdgcn_mfma_f32_16x16x32_bf16(Bt_[n][k], At[m][k], acc[ai][bj][m][n], 0, 0, 0); } } \
        __builtin_amdgcn_s_setprio(0); } while (0)
#define G_WAIT_V(n) asm volatile("s_waitcnt vmcnt(" #n ")" ::: "memory")
#define G_WAIT_L(n) asm volatile("s_waitcnt lgkmcnt(" #n ")" ::: "memory")
#define G_BAR __builtin_amdgcn_s_barrier()
#define G_SCHED __builtin_amdgcn_sched_barrier(0)
    Unit cur, nxt; int ui = 0;
    if (!S.next(0, cur)) return;
    f32x4 acc[2][2][4][2];
#pragma unroll
    for (int a = 0; a < 2; ++a)
#pragma unroll
        for (int b = 0; b < 2; ++b)
#pragma unroll
            for (int m = 0; m < 4; ++m)
#pragma unroll
                for (int n = 0; n < 2; ++n) acc[a][b][m][n] = (f32x4){0.f, 0.f, 0.f, 0.f};
    bf16x8 At[4][2], B0[2][2], B1[2][2]; i32x8 At8[4], B08[2], B18[2];
    unsigned gcur[2][2] = {{0u, 0u}, {0u, 0u}}, gnxt[2][2] = {{0u, 0u}, {0u, 0u}};
    auto gather_offs = [&](const Unit& u, unsigned (&g)[2][2]) {
        if constexpr (Sched::GATHER) {
#pragma unroll
            for (int h = 0; h < 2; ++h)
#pragma unroll
                for (int i = 0; i < 2; ++i) { int tz = tid; asm volatile("" : "+v"(tz)); int R, C; stage_rc(tz * 16 + i * 8192, R, C); const int r = h * HALF + R; const int tk = p.tokl[u.goff + (r < u.nvalid ? r : 0)]; const int tok = r < u.nvalid ? tk : 0; g[h][i] = (unsigned)(tok * K + C) * 2u; }
        }
    };
    const char* cA = (const char*)A + (size_t)(cur.arow / BM) * tstep; const char* cB = (const char*)Bt + ((size_t)cur.e * bt_estride) * 2 + (size_t)cur.pn * tstep;
    gather_offs(cur, gcur);
    G_STAGE(G_SB(0, 0), cB, voffB); G_STAGE_A(G_SA(0, 0), cA, gcur, 0, 0); G_STAGE(G_SB(0, 1), cB + hstep, voffB); G_STAGE_A(G_SA(0, 1), cA, gcur, 1, 0);
    if (wr == 1) G_BAR;
    G_WAIT_V(4); G_BAR;
    G_STAGE(G_SB(1, 0), cB + kstep, voffB); G_STAGE_A(G_SA(1, 0), cA, gcur, 0, kstep); G_STAGE(G_SB(1, 1), cB + hstep + kstep, voffB);
    G_WAIT_V(6); G_BAR;
    for (;;) {
        const bool has_next = S.next(ui + 1, nxt);
        const char* nA = has_next ? (const char*)A + (size_t)(nxt.arow / BM) * tstep : cA;
        const char* nB = has_next ? (const char*)Bt + ((size_t)nxt.e * bt_estride) * 2 + (size_t)nxt.pn * tstep : cB;
        if constexpr (Sched::GATHER) { if (has_next) gather_offs(nxt, gnxt); else {
#pragma unroll
            for (int h = 0; h < 2; ++h) { gnxt[h][0] = gcur[h][0]; gnxt[h][1] = gcur[h][1]; } } }
        for (int t = 0; t < nt; t += 2) {
            const bool last = (t == nt - 2);
            const size_t k1 = (size_t)(t + 1) * kstep;
            const char* a2 = last ? nA : cA; const char* b2 = last ? nB : cB + (size_t)(t + 2) * kstep;
            const size_t k2 = last ? 0 : (size_t)(t + 2) * kstep; const size_t k3 = k2 + kstep;
            const char* b3 = b2 + kstep;
            unsigned g2[2][2];
#pragma unroll
            for (int h = 0; h < 2; ++h) { g2[h][0] = last ? gnxt[h][0] : gcur[h][0]; g2[h][1] = last ? gnxt[h][1] : gcur[h][1]; }
            G_LDB(B0, 0, 0); G_SCHED; G_LDA(At, 0, 0); G_STAGE_A(G_SA(1, 1), cA, gcur, 1, k1);
            G_WAIT_L(8); G_BAR; G_WAIT_L(0); G_MMA(0, 0, At, B0); G_BAR; G_SCHED;
            G_LDB(B1, 0, 1); G_STAGE(G_SB(0, 0), b2, voffB);
            G_BAR; G_WAIT_L(0); G_MMA(0, 1, At, B1); G_BAR;
            G_LDA(At, 0, 1); G_STAGE_A(G_SA(0, 0), a2, g2, 0, k2);
            G_BAR; G_WAIT_L(0); if (!Sched::HALF_SKIP || cur.nvalid > HALF) G_MMA(1, 0, At, B0); G_BAR; G_SCHED;
            G_STAGE(G_SB(0, 1), b2 + hstep, voffB);
            G_WAIT_V(6); G_BAR; if (!Sched::HALF_SKIP || cur.nvalid > HALF) G_MMA(1, 1, At, B1); G_BAR;
            G_LDB(B0, 1, 0); G_SCHED; G_LDA(At, 1, 0); G_STAGE_A(G_SA(0, 1), a2, g2, 1, k2);
            G_WAIT_L(8); G_BAR; G_WAIT_L(0); G_MMA(0, 0, At, B0); G_BAR; G_SCHED;
            G_LDB(B1, 1, 1); G_STAGE(G_SB(1, 0), b3, voffB);
            G_BAR; G_WAIT_L(0); G_MMA(0, 1, At, B1); G_BAR;
            G_LDA(At, 1, 1); G_STAGE_A(G_SA(1, 0), a2, g2, 0, k3);
            G_BAR; G_WAIT_L(0); if (!Sched::HALF_SKIP || cur.nvalid > HALF) G_MMA(1, 0, At, B0); G_BAR; G_SCHED;
            G_STAGE(G_SB(1, 1), b3 + hstep, voffB);
            G_WAIT_V(6); G_BAR; if (!Sched::HALF_SKIP || cur.nvalid > HALF) G_MMA(1, 1, At, B1); G_BAR;
        }
        if constexpr (FP8) asm volatile("s_nop 15\n\ts_nop 15" ::: "memory");
        { GUnit gu; gu.rowbase = cur.orow; gu.nvalid = cur.nvalid; gu.e = cur.e; gu.gather = p.tokl + cur.goff;
#pragma unroll
          for (int ai = 0; ai < 2; ++ai)
#pragma unroll
            for (int m = 0; m < 4; ++m) { const int r = ai * HALF + wr * 64 + m * 16 + fr;
              if (r < cur.nvalid) E(p, gu, r, cur.pn * BM + wc * 32 + fq * 8, acc[ai][0][m][0], acc[ai][0][m][1], acc[ai][1][m][0], acc[ai][1][m][1]); } }
        if (!has_next) break;
#pragma unroll
        for (int a = 0; a < 2; ++a)
#pragma unroll
            for (int b = 0; b < 2; ++b)
#pragma unroll
                for (int m = 0; m < 4; ++m)
#pragma unroll
                    for (int n = 0; n < 2; ++n) acc[a][b][m][n] = (f32x4){0.f, 0.f, 0.f, 0.f};
        cur = nxt; cA = nA; cB = nB; ++ui;
#pragma unroll
        for (int h = 0; h < 2; ++h) { gcur[h][0] = gnxt[h][0]; gcur[h][1] = gnxt[h][1]; }
    }
    G_WAIT_V(0);
    if (wr == 0) G_BAR;
    G_BAR;
}
}

extern __shared__ __attribute__((aligned(16))) unsigned char dyn_smem[];
constexpr int LDS_BYTES = gm::STAGE_BYTES + 1024;

typedef __bf16 bf2v __attribute__((ext_vector_type(2)));
typedef float f32x2 __attribute__((ext_vector_type(2)));
typedef float f32x16 __attribute__((ext_vector_type(16)));
typedef short s16x4 __attribute__((ext_vector_type(4)));
typedef unsigned u32x4 __attribute__((ext_vector_type(4)));
DI unsigned pk2(float a, float b) { f32x2 v = {a, b}; bf2v r = __builtin_convertvector(v, bf2v); return __builtin_bit_cast(unsigned, r); }
DI float bflo(unsigned u) { return __uint_as_float(u << 16); }
DI float bfhi(unsigned u) { return __uint_as_float(u & 0xffff0000u); }

DI unsigned pk4_fp8(float a, float b, float c, float d, float sc) {
    a = __builtin_amdgcn_fmed3f(a * sc, -448.f, 448.f); b = __builtin_amdgcn_fmed3f(b * sc, -448.f, 448.f); c = __builtin_amdgcn_fmed3f(c * sc, -448.f, 448.f); d = __builtin_amdgcn_fmed3f(d * sc, -448.f, 448.f);
    unsigned w = 0u; w = __builtin_amdgcn_cvt_pk_fp8_f32(a, b, w, false); w = __builtin_amdgcn_cvt_pk_fp8_f32(c, d, w, true); return w; }
constexpr bool D8_IN0 = true, D8_OUT0 = false, D8_IN1 = false;
constexpr float W8_SCALE = 256.f, A8_SCALE = 8.f;
constexpr int W8_E8M0 = 0x77777777, A8_E8M0 = 0x7c7c7c7c;
namespace ph {
DI void mods(const Params& p, LAS unsigned char* lds) {
    const int tid = opaque_tid(), wave = tid >> 6, lane = tid & 63, l8 = tid & 7, rg = tid >> 3;
    LAS float* fl = (LAS float*)lds; LAS float* red = fl + 4 * DM;
    for (int i = tid; i < 4 * DM; i += 512) fl[i] = siluf_(p.c[i]);
    __syncthreads();
    for (int u = blockIdx.x; u < 768; u += gridDim.x) {
        const int l = u / 192, c32 = u % 192;
        const float* w = l == 0 ? p.ada0_mix_w : l == 1 ? p.ada0_ffn_w : l == 2 ? p.ada1_mix_w : p.ada1_ffn_w;
        const float* bs = l == 0 ? p.ada0_mix_b : l == 1 ? p.ada0_ffn_b : l == 2 ? p.ada1_mix_b : p.ada1_ffn_b;
        f32x4 acc[4] = {{0.f, 0.f, 0.f, 0.f}, {0.f, 0.f, 0.f, 0.f}, {0.f, 0.f, 0.f, 0.f}, {0.f, 0.f, 0.f, 0.f}};
        const float* wp = w + (size_t)rg * 6144 + c32 * 32 + l8 * 4;
#pragma unroll 8
        for (int i = 0; i < 32; ++i) { const f32x4 wv = *(const f32x4*)(wp + (size_t)(64 * i) * 6144); const int k = rg + 64 * i;
#pragma unroll
            for (int b = 0; b < 4; ++b) acc[b] += fl[b * DM + k] * wv; }
#pragma unroll
        for (int b = 0; b < 4; ++b)
#pragma unroll
            for (int j = 0; j < 4; ++j) { float v = acc[b][j]; v += __shfl_xor(v, 8); v += __shfl_xor(v, 16); v += __shfl_xor(v, 32); acc[b][j] = v; }
        if (lane < 8) {
#pragma unroll
            for (int b = 0; b < 4; ++b) *(LAS f32x4*)(red + (wave * 4 + b) * 32 + lane * 4) = acc[b]; }
        __syncthreads();
        if (tid < 128) { const int b = tid >> 5, col = tid & 31; float sum = 0.f;
#pragma unroll
            for (int w8 = 0; w8 < 8; ++w8) sum += red[(w8 * 4 + b) * 32 + col];
            p.mod[(l * 4 + b) * 6144 + c32 * 32 + col] = sum + bs[c32 * 32 + col]; }
        __syncthreads();
    }
}
constexpr int NT_UNITS = (640 + 256 + 672 + 336 + 2 * (8192 + 4096)) / 2;
struct UD { const float* sp; bf16_t* dst; int K, N, mode, e, kt, ntile; };
DI UD tdecode(const Params& p, int u, int lane) {
    const float* srcs[8] = {p.w_in0, p.w_out0, p.w_in1, p.w_out1, p.moe0_w_gate_up, p.moe0_w_down, p.moe1_w_gate_up, p.moe1_w_down};
    bf16_t* dsts[8] = {p.w_in0t, p.w_out0t, p.w_in1t, p.w_out1t, p.w_gut0, p.w_dt0, p.w_gut1, p.w_dt1};
    constexpr int Ks[8] = {DM, DM, DM, LRU_W, DM, EFF, DM, EFF}, Ns[8] = {N_IN0, DM, N_IN1, DM, 2048, DM, 2048, DM}, nus[8] = {320, 128, 336, 168, 4096, 2048, 4096, 2048};
    constexpr int modes[8] = {D8_IN0 ? 2 : 0, D8_OUT0 ? 2 : 0, D8_IN1 ? 2 : 0, 0, 3, 2, 3, 2};
    int v = u, mi = 0;
#pragma unroll
    for (int m = 0; m < 8; ++m) { if (mi == m && v >= nus[m]) { v -= nus[m]; mi = m + 1; } }
    UD d; const float* src = srcs[0]; d.dst = dsts[0]; d.K = Ks[0]; d.N = Ns[0]; d.mode = modes[0];
#pragma unroll
    for (int m = 1; m < 8; ++m) if (mi == m) { src = srcs[m]; d.dst = dsts[m]; d.K = Ks[m]; d.N = Ns[m]; d.mode = modes[m]; }
    const int ntl = d.N / 256, ktl = d.K / 128; d.e = v / (ktl * ntl); const int rem = v % (ktl * ntl); d.kt = rem / ntl; d.ntile = rem % ntl;
    d.sp = src + (size_t)d.e * d.K * d.N + (size_t)(d.kt * 128) * d.N + d.ntile * 256 + lane * 4;
    return d;
}
DI void transposer(const Params& p, LAS unsigned char* lds, int first, int count, int stride) {
    const int tid = opaque_tid(), wave = tid >> 6, lane = tid & 63;
    LAS float* fl = (LAS float*)lds;
    if (count <= 0) return;
    if (tdecode(p, first, lane).mode & 2) {
        LAS unsigned* td = (LAS unsigned*)lds;
        const int nl = lane & 15, ks = lane >> 4;
        auto src_of = [&](const UD& d, int g, int j) -> const float* { const int kq = 4 * (g >> 2) + ks, nq = 16 * (g & 3) + nl; return d.sp - lane * 4 + (size_t)(4 * kq + j) * d.N + 4 * nq; };
        f32x4 va[4][4], vb[4][4];
        auto load_unit = [&](int u, f32x4 (&v)[4][4]) { const UD dd = tdecode(p, u, lane);
#pragma unroll
            for (int i = 0; i < 4; ++i)
#pragma unroll
                for (int j = 0; j < 4; ++j) v[i][j] = *(const f32x4*)src_of(dd, wave * 4 + i, j); };
        auto process = [&](int jn, f32x4 (&v)[4][4]) { const int u = first + jn * stride;
            const UD d = tdecode(p, u, lane); const int K = d.K, N = d.N, mode = d.mode, e = d.e, kt = d.kt, ntile = d.ntile;
            LAS unsigned* tile = td + (jn & 1) * (256 * 33);
#pragma unroll
            for (int i = 0; i < 4; ++i) { const int g = wave * 4 + i, kq = 4 * (g >> 2) + ks, nq = 16 * (g & 3) + nl;
#pragma unroll
                for (int en = 0; en < 4; ++en) tile[(4 * nq + en) * 33 + kq] = pk4_fp8(v[i][0][en], v[i][1][en], v[i][2][en], v[i][3][en], W8_SCALE); }
            __syncthreads();
            if (jn + 2 < count) load_unit(u + 2 * stride, v);
            { const int n = tid >> 1, kh = tid & 1; const int ng = ntile * 256 + n; const int jg = ng & 1023; const int np = (mode & 1) ? (256 * (jg >> 7) + (ng < 1024 ? 0 : 128) + (jg & 127)) : ng;
              unsigned char* dp = (unsigned char*)d.dst + (size_t)e * N * K + (size_t)np * K + kt * 128 + kh * 64;
#pragma unroll
              for (int jj = 0; jj < 4; ++jj) { const LAS unsigned* tp = tile + n * 33 + kh * 16 + jj * 4; *(uint4*)(dp + jj * 16) = make_uint4(tp[0], tp[1], tp[2], tp[3]); } } };
        load_unit(first, va); if (count > 1) load_unit(first + stride, vb);
        for (int jn = 0; jn < count; jn += 2) { process(jn, va); if (jn + 1 < count) process(jn + 1, vb); }
        __syncthreads();
        return;
    }
    f32x4 vv[16];
    { const UD d0 = tdecode(p, first, lane);
#pragma unroll
        for (int i = 0; i < 16; ++i) vv[i] = *(const f32x4*)(d0.sp + (size_t)(i * 8 + wave) * d0.N); }
    for (int j = 0; j < count; ++j) { const int u = first + j * stride;
        const UD d = tdecode(p, u, lane); const int K = d.K, N = d.N, mode = d.mode, e = d.e, kt = d.kt, ntile = d.ntile; bf16_t* dst = d.dst;
#pragma unroll
        for (int i = 0; i < 16; ++i) { LAS float* tp = fl + (i * 8 + wave) * 257 + lane * 4; tp[0] = vv[i][0]; tp[1] = vv[i][1]; tp[2] = vv[i][2]; tp[3] = vv[i][3]; }
        __syncthreads();
        if (j + 1 < count) { const UD dn = tdecode(p, u + stride, lane);
#pragma unroll
            for (int i = 0; i < 16; ++i) vv[i] = *(const f32x4*)(dn.sp + (size_t)(i * 8 + wave) * dn.N); }
        { const int n = tid >> 1, kh = tid & 1; const int ng = ntile * 256 + n; const int jg = ng & 1023; const int np = (mode & 1) ? (256 * (jg >> 7) + (ng < 1024 ? 0 : 128) + (jg & 127)) : ng;
          bf16_t* dp = dst + (size_t)e * N * K + (size_t)np * K + kt * 128 + kh * 64;
#pragma unroll
          for (int jj = 0; jj < 8; ++jj) { unsigned w4[4];
#pragma unroll
              for (int q = 0; q < 4; ++q) { const int k = kh * 64 + jj * 8 + q * 2; w4[q] = pk2(fl[k * 257 + n], fl[(k + 1) * 257 + n]); }
              *(uint4*)(dp + jj * 8) = make_uint4(w4[0], w4[1], w4[2], w4[3]); } }
        __syncthreads();
    }
}
DI void lru_weights(const Params& p) {
    const int tid = opaque_tid();
    for (size_t i = (size_t)blockIdx.x * 512 + tid; i < (size_t)2 * 2 * 16 * 4 * 48 * 192; i += (size_t)gridDim.x * 512) {
        const int k = i % 192, j = (i / 192) % 48, qt = (i / (192 * 48)) % 4, n = (i / (192 * 48 * 4)) % 16, which = (i / (192 * 48 * 4 * 16)) % 2, dir = i / (192 * 48 * 4 * 16 * 2);
        const float* w = which == 0 ? p.lru_w_a : p.lru_w_x; float v = 0.f;
        if (j < 42 && k < 168) v = w[(((size_t)dir * 16 + n) * 168 + k) * 168 + qt * 42 + j];
        p.w_lru[i] = f2bf(v);
    }
}
DI void fold_router(const Params& p) {
    const int tid = opaque_tid(), wave = tid >> 6, lane = tid & 63;
    for (size_t i = (size_t)blockIdx.x * 512 + tid; i < (size_t)2 * 4 * 48 * DM; i += (size_t)gridDim.x * 512) {
        const int k = i % DM, n = (i / DM) % 48, b = (i / (DM * 48)) % 4, l = i / (DM * 48 * 4);
        const float* g = l == 0 ? p.norm0_ffn : p.norm1_ffn; const float* md = p.mod + ((l == 0 ? 1 : 3) * 4 + b) * 6144;
        const float* we = l == 0 ? p.moe0_w_expert : p.moe1_w_expert; const float* wg = l == 0 ? p.moe0_w_group : p.moe1_w_group;
        const float w = n < 32 ? we[k * 32 + n] : n < 36 ? wg[k * 4 + (n - 32)] : 0.f;
        p.wrt[i] = g[k] * (1.f + md[2048 + k]) * w;
    }
    for (int task = blockIdx.x * 8 + wave; task < 2 * 4 * 48; task += gridDim.x * 8) {
        const int n = task % 48, b = (task / 48) % 4, l = task / (48 * 4);
        const float* md = p.mod + ((l == 0 ? 1 : 3) * 4 + b) * 6144;
        const float* we = l == 0 ? p.moe0_w_expert : p.moe1_w_expert; const float* wg = l == 0 ? p.moe0_w_group : p.moe1_w_group;
        float part = 0.f;
        for (int k = lane; k < DM; k += 64) { const float w = n < 32 ? we[k * 32 + n] : n < 36 ? wg[k * 4 + (n - 32)] : 0.f; part += md[k] * w; }
        part = wave_sum(part); if (lane == 0) p.rbias[task] = part;
    }
}
template <int MODE, bool OUT8 = false> DI void norm_rows(const Params& p, const float* xin, const float* gain, int lmod, int lgate, const LAS int* tab) {
    const int tid = opaque_tid(), wave = tid >> 6, lane = tid & 63;
    for (int row = blockIdx.x * 8 + wave; row < T_TOK; row += gridDim.x * 8) {
        const int b = row / SEQ;
        f32x4 v[8];
#pragma unroll
        for (int i = 0; i < 8; ++i) v[i] = *(const f32x4*)(xin + (size_t)row * DM + i * 256 + lane * 4);
        if constexpr (MODE >= 1) {
            const int a0 = p.asg[row * 2], a1 = p.asg[row * 2 + 1];
            const size_t r0 = (size_t)tab[a0 >> 14] * 256 + (a0 & 16383), r1 = (size_t)tab[a1 >> 14] * 256 + (a1 & 16383);
            const float* gt = p.mod + (lgate * 4 + b) * 6144 + 4096;
#pragma unroll
            for (int i = 0; i < 8; ++i) { const int col = i * 256 + lane * 4; const f32x4 g4 = *(const f32x4*)(gt + col);
                const uint2 y0 = *(const uint2*)(p.YB + r0 * DM + col), y1 = *(const uint2*)(p.YB + r1 * DM + col);
                v[i][0] += g4[0] * (bflo(y0.x) + bflo(y1.x)); v[i][1] += g4[1] * (bfhi(y0.x) + bfhi(y1.x));
                v[i][2] += g4[2] * (bflo(y0.y) + bflo(y1.y)); v[i][3] += g4[3] * (bfhi(y0.y) + bfhi(y1.y)); }
            if constexpr (MODE == 1) {
#pragma unroll
                for (int i = 0; i < 8; ++i) *(f32x4*)(p.XA + (size_t)row * DM + i * 256 + lane * 4) = v[i]; }
        }
        float ss = 0.f;
#pragma unroll
        for (int i = 0; i < 8; ++i) ss += v[i][0] * v[i][0] + v[i][1] * v[i][1] + v[i][2] * v[i][2] + v[i][3] * v[i][3];
        ss = wave_sum(ss); const float rstd = rsqrtf(ss * (1.0f / DM) + 1e-6f);
        if constexpr (MODE == 2) {
#pragma unroll
            for (int i = 0; i < 8; ++i) { const int col = i * 256 + lane * 4; const f32x4 g4 = *(const f32x4*)(gain + col); *(f32x4*)(p.out + (size_t)row * DM + col) = v[i] * rstd * g4; }
        } else { const float* md = p.mod + (lmod * 4 + b) * 6144;
#pragma unroll
            for (int i = 0; i < 8; ++i) { const int col = i * 256 + lane * 4; const f32x4 g4 = *(const f32x4*)(gain + col), sc = *(const f32x4*)(md + 2048 + col), sh = *(const f32x4*)(md + col);
                const f32x4 h = v[i] * rstd * g4 * (1.f + sc) + sh;
                if constexpr (OUT8) *(unsigned*)((unsigned char*)p.H + (size_t)row * DM + col) = pk4_fp8(h[0], h[1], h[2], h[3], A8_SCALE);
                else *(uint2*)(p.H + (size_t)row * DM + col) = make_uint2(pk2(h[0], h[1]), pk2(h[2], h[3])); } }
    }
}
template <bool DRY = false, bool NORM = false> DI void router(const Params& p, int l, LAS unsigned char* lds, const float* gain = nullptr, int lmod = 0) {
    const int tid = opaque_tid(), wave = __builtin_amdgcn_readfirstlane(tid >> 6), lane = tid & 63;
    LAS float* lg = (LAS float*)lds + (wave & 3) * (16 * 48);
    LAS float* part = (LAS float*)lds + 4 * 16 * 48 + (wave & 3) * (64 * 13);
    LAS float* rsl = (LAS float*)lds + 4 * 16 * 48 + 4 * 64 * 13 + (wave & 3) * 16;
    for (int tg = blockIdx.x; tg < T_TOK / 64; tg += gridDim.x) {
        const int tile = tg * 4 + (wave & 3), kh = wave >> 2;
        const int row0 = tile * 16, b = row0 / SEQ, r = lane & 15, q = lane >> 4;
        const float* xa = p.XA + (size_t)(row0 + r) * DM + 4 * q + kh * (DM / 2);
        const float* wt = p.wrt + (((size_t)l * 4 + b) * 48 + r) * DM + 4 * q + kh * (DM / 2);
        f32x4 acc[3] = {{0.f, 0.f, 0.f, 0.f}, {0.f, 0.f, 0.f, 0.f}, {0.f, 0.f, 0.f, 0.f}}; float ss = 0.f;
#pragma unroll 2
        for (int s = 0; s < DM / 32; ++s) {
            const f32x4 a4 = *(const f32x4*)(xa + 16 * s);
            ss += a4[0] * a4[0] + a4[1] * a4[1] + a4[2] * a4[2] + a4[3] * a4[3];
#pragma unroll
            for (int n = 0; n < 3; ++n) { const f32x4 b4 = *(const f32x4*)(wt + (size_t)n * 16 * DM + 16 * s);
#pragma unroll
                for (int j = 0; j < 4; ++j) acc[n] = __builtin_amdgcn_mfma_f32_16x16x4f32(a4[j], b4[j], acc[n], 0, 0, 0); }
        }
        if (kh == 1) {
#pragma unroll
            for (int n = 0; n < 3; ++n)
#pragma unroll
                for (int j = 0; j < 4; ++j) part[(n * 4 + j) * 64 + lane] = acc[n][j];
            part[12 * 64 + lane] = ss; }
        __syncthreads();
        if (kh == 0) {
#pragma unroll
            for (int n = 0; n < 3; ++n)
#pragma unroll
                for (int j = 0; j < 4; ++j) acc[n][j] += part[(n * 4 + j) * 64 + lane];
            ss += part[12 * 64 + lane];
        ss += __shfl_xor(ss, 16); ss += __shfl_xor(ss, 32);
        const float rstd = rsqrtf(ss * (1.0f / DM) + 1e-6f);
        if (NORM && q == 0) rsl[r] = rstd;
#pragma unroll
        for (int j = 0; j < 4; ++j) { const float rs = __shfl(rstd, 4 * q + j);
#pragma unroll
            for (int n = 0; n < 3; ++n) lg[(4 * q + j) * 48 + n * 16 + r] = acc[n][j] * rs + p.rbias[(l * 4 + b) * 48 + n * 16 + r]; }
        __builtin_amdgcn_wave_barrier();
        if (!DRY && lane < 16) {
            const LAS float* L = lg + lane * 48; const int tok = row0 + lane;
            int gs = 0; float gm = L[32];
#pragma unroll
            for (int g = 1; g < 4; ++g) if (L[32 + g] > gm) { gm = L[32 + g]; gs = g; }
            float gden = 0.f;
#pragma unroll
            for (int g = 0; g < 4; ++g) gden += __expf(L[32 + g] - gm);
            const float gprob = 1.0f / gden;
            int i0 = 0; float v0 = L[gs * 8];
            for (int j = 1; j < 8; ++j) { const float x = L[gs * 8 + j]; if (x > v0) { v0 = x; i0 = j; } }
            int i1 = -1; float v1 = -3.4e38f;
            for (int j = 0; j < 8; ++j) { const float x = L[gs * 8 + j]; if (j != i0 && x > v1) { v1 = x; i1 = j; } }
            const float e1 = __expf(v1 - v0), g0 = gprob / (1.f + e1), g1 = gprob * e1 / (1.f + e1);
            const int ea = gs * 8 + i0, eb = gs * 8 + i1;
            const int sa = atomicAdd(&p.cnt[l * 32 + ea], 1), sb = atomicAdd(&p.cnt[l * 32 + eb], 1);
            p.tokl[ea * ECAP + sa] = tok; p.gatel[ea * ECAP + sa] = g0; p.tokl[eb * ECAP + sb] = tok; p.gatel[eb * ECAP + sb] = g1;
            p.asg[tok * 2] = (ea << 14) | sa; p.asg[tok * 2 + 1] = (eb << 14) | sb;
        }
        }
        __syncthreads();
        if constexpr (NORM) {
            const float* md = p.mod + (lmod * 4 + b) * 6144;
            f32x4 g4[8], sc[8], sh[8];
#pragma unroll
            for (int i = 0; i < 8; ++i) { const int col = i * 256 + lane * 4; g4[i] = *(const f32x4*)(gain + col); sc[i] = 1.f + *(const f32x4*)(md + 2048 + col); sh[i] = *(const f32x4*)(md + col); g4[i] *= sc[i]; }
#pragma unroll 2
            for (int j = 0; j < 8; ++j) { const int row = row0 + kh * 8 + j; const float rs = rsl[kh * 8 + j];
#pragma unroll
                for (int i = 0; i < 8; ++i) { const int col = i * 256 + lane * 4; const f32x4 v = *(const f32x4*)(p.XA + (size_t)row * DM + col);
                    const f32x4 h = v * rs * g4[i] + sh[i];
                    *(unsigned*)((unsigned char*)p.H + (size_t)row * DM + col) = pk4_fp8(h[0], h[1], h[2], h[3], A8_SCALE); } }
            __syncthreads();
        }
    }
}
DI void conv_gln(const Params& p, LAS unsigned char* lds) {
    const int tid = opaque_tid(), wave = tid >> 6, lane = tid & 63;
    LAS float* at = (LAS float*)lds;
    u32x4 rv[3], rg[3];
    auto load_raw = [&](int u) { const int g = u & 7, t0 = ((u >> 3) & 63) * 64, b = u >> 9;
#pragma unroll
        for (int i = 0; i < 3; ++i) { const int idx = tid + 512 * i, rr = idx >> 4, c8 = idx & 15, t = t0 - 15 + rr; rv[i] = (u32x4){0u, 0u, 0u, 0u}; rg[i] = (u32x4){0u, 0u, 0u, 0u};
            if (idx < 94 * 16 && t >= 0 && t < SEQ) { const bf16_t* row = p.G + (size_t)(b * SEQ + t) * N_IN0 + g * 128 + c8 * 8; rv[i] = *(const u32x4*)row; rg[i] = *(const u32x4*)(row + 1024); } } };
    int gcur = -1; f32x2 wk[31], bias = {0.f, 0.f}, gam = {0.f, 0.f}, bet = {0.f, 0.f};
    if ((int)blockIdx.x < 2048) load_raw(blockIdx.x);
    for (int u = blockIdx.x; u < 2048; u += gridDim.x) {
        const int g = u & 7, t0 = ((u >> 3) & 63) * 64, b = u >> 9;
        const int ch = g * 128 + 2 * lane;
        if (g != gcur) { gcur = g;
#pragma unroll
            for (int k = 0; k < 31; ++k) wk[k] = *(const f32x2*)(p.conv_w + k * 1024 + ch);
            bias = *(const f32x2*)(p.conv_b + ch); gam = *(const f32x2*)(p.conv_norm_g + ch); bet = *(const f32x2*)(p.conv_norm_b + ch); }
#pragma unroll
        for (int i = 0; i < 3; ++i) { const int idx = tid + 512 * i, rr = idx >> 4, c8 = idx & 15;
            if (idx < 94 * 16) { const u32x4 v = rv[i], gg = rg[i];
                const f32x4 lo = {bflo(v[0]) * sigmoidf_(bflo(gg[0])), bfhi(v[0]) * sigmoidf_(bfhi(gg[0])), bflo(v[1]) * sigmoidf_(bflo(gg[1])), bfhi(v[1]) * sigmoidf_(bfhi(gg[1]))};
                const f32x4 hi = {bflo(v[2]) * sigmoidf_(bflo(gg[2])), bfhi(v[2]) * sigmoidf_(bfhi(gg[2])), bflo(v[3]) * sigmoidf_(bflo(gg[3])), bfhi(v[3]) * sigmoidf_(bfhi(gg[3]))};
                *(LAS f32x4*)(at + rr * 132 + c8 * 8) = lo; *(LAS f32x4*)(at + rr * 132 + c8 * 8 + 4) = hi; } }
        __syncthreads();
        if (u + (int)gridDim.x < 2048) load_raw(u + gridDim.x);
        f32x2 acc[8];
#pragma unroll
        for (int j = 0; j < 8; ++j) acc[j] = bias;
#pragma unroll
        for (int rr = 0; rr < 38; ++rr) { const f32x2 a2 = *(const LAS f32x2*)(at + (wave * 8 + rr) * 132 + 2 * lane);
#pragma unroll
            for (int j = 0; j < 8; ++j) { const int k = rr - j; if (k >= 0 && k < 31) acc[j] += wk[k] * a2; } }
#pragma unroll
        for (int j = 0; j < 8; ++j) { const float mu = wave_sum(acc[j][0] + acc[j][1]) * (1.f / 128.f); const float d0 = acc[j][0] - mu, d1 = acc[j][1] - mu;
            const float var = wave_sum(d0 * d0 + d1 * d1) * (1.f / 128.f); const float rs = rsqrtf(var + 1e-6f);
            const float y0 = d0 * rs * gam[0] + bet[0], y1 = d1 * rs * gam[1] + bet[1];
            if constexpr (D8_OUT0) *(unsigned short*)((unsigned char*)p.AO + (size_t)(b * SEQ + t0 + wave * 8 + j) * DM + ch) = (unsigned short)(pk4_fp8(siluf_(y0), siluf_(y1), 0.f, 0.f, A8_SCALE) & 0xffffu);
            else *(unsigned*)(p.AO + (size_t)(b * SEQ + t0 + wave * 8 + j) * DM + ch) = pk2(siluf_(y0), siluf_(y1)); }
        __syncthreads();
    }
}
DI unsigned off_b(unsigned row, unsigned ch) { return 256u * row + 16u * (ch ^ (((row & 3u) << 2) | ((row >> 2) & 3u))); }
DI void tr_read4(unsigned a0, unsigned a1, s16x4& r00, s16x4& r01, s16x4& r10, s16x4& r11) {
    asm volatile("ds_read_b64_tr_b16 %0, %4\n\tds_read_b64_tr_b16 %1, %5\n\tds_read_b64_tr_b16 %2, %4 offset:4096\n\tds_read_b64_tr_b16 %3, %5 offset:4096\n\ts_waitcnt lgkmcnt(0)"
                 : "=&v"(r00), "=&v"(r01), "=&v"(r10), "=&v"(r11) : "v"(a0), "v"(a1) : "memory");
}
template <int PASS> DI void attn_wave(const Params& p, LAS unsigned char* vimg, unsigned vb0, unsigned vb1, int lane_, int b, int h, int qbase  ) {
    int lane = lane_; asm volatile("" : "+v"(lane));
    const int c = lane & 31, hh = lane >> 5, srow = lane >> 4, sch = lane & 15;
    constexpr int QS = PASS == 0 ? 16 : 1, NT = PASS == 0 ? 13 : 5;
    const int tq = qbase + QS * c;
    const bf16_t* gb = p.G + (size_t)(b * SEQ) * N_IN0; const bf16_t* kb = p.KVH + (size_t)((b * 8 + h) * 2) * SEQ * 128;
    float* st_o = (float*)p.YB + ((size_t)(b * 8 + h) * SEQ + tq) * 128;
    float* st_ml = (float*)p.YB + (size_t)NBATCH * 8 * SEQ * 128 + ((size_t)(b * 8 + h) * SEQ + tq) * 2;
    bf16x8 qf[8];
#pragma unroll
    for (int ks = 0; ks < 8; ++ks) qf[ks] = *(const bf16x8*)(gb + (size_t)tq * N_IN0 + 2048 + h * 128 + 16 * ks + 8 * hh);
    const float sc2 = 0.08838834764831845f * 1.4426950408889634f, sl2 = exp2f(-(float)(h + 1)) * 1.4426950408889634f;
    f32x16 o[4]; float m_run, l_run;
    if constexpr (PASS == 0) {
#pragma unroll
        for (int i = 0; i < 4; ++i)
#pragma unroll
            for (int j = 0; j < 16; ++j) o[i][j] = 0.f;
        m_run = -30000.f; l_run = 0.f;
    } else {
#pragma unroll
        for (int c4 = 0; c4 < 4; ++c4)
#pragma unroll
            for (int g4 = 0; g4 < 4; ++g4) { const f32x4 v = *(const f32x4*)(st_o + 32 * c4 + 8 * g4 + 4 * hh); o[c4][4 * g4] = v[0]; o[c4][4 * g4 + 1] = v[1]; o[c4][4 * g4 + 2] = v[2]; o[c4][4 * g4 + 3] = v[3]; }
        const f32x2 ml = *(const f32x2*)st_ml; m_run = ml[0]; l_run = hh == 0 ? ml[1] : 0.f;
    }
    auto tile_geom = [&](int tile, int& d, int& sb) { if constexpr (PASS == 0) { if (tile < 5) { d = 16; sb = qbase - 1024 + 512 * tile; } else { d = 4; sb = qbase - 256 + 128 * (tile - 5); } } else { d = 1; sb = qbase - 64 + 32 * tile; } };
    auto load_k = [&](int tile, bf16x8 (&kf)[8]) { int d, sb; tile_geom(tile, d, sb); int sp = sb + d * c; sp = sp < 0 ? 0 : (sp >= SEQ ? SEQ - 1 : sp);
        const bf16_t* src = kb + (unsigned)(sp * 128 + 8 * hh);
#pragma unroll
        for (int ks = 0; ks < 8; ++ks) kf[ks] = *(const bf16x8*)(src + 16 * ks); };
    auto load_v = [&](int tile, u32x4 (&vv)[8]) { int d, sb; tile_geom(tile, d, sb);
#pragma unroll
        for (int i = 0; i < 8; ++i) { int sp = sb + d * (srow + 4 * i); sp = sp < 0 ? 0 : (sp >= SEQ ? SEQ - 1 : sp); vv[i] = *(const u32x4*)(kb + (unsigned)(SEQ * 128 + sp * 128 + sch * 8)); } };
    bf16x8 kf[8]; u32x4 vv[8];
    load_k(0, kf); load_v(0, vv);
    for (int tile = 0; tile < NT; ++tile) {
        int d, sb; tile_geom(tile, d, sb);
        const int tn = tile < NT - 1 ? tile + 1 : NT - 1;
#pragma unroll
        for (int i = 0; i < 8; ++i) *(LAS u32x4*)(vimg + off_b(srow + 4 * i, sch)) = vv[i];
        load_v(tn, vv);
        f32x16 sacc;
#pragma unroll
        for (int j = 0; j < 16; ++j) sacc[j] = 0.f;
#pragma unroll
        for (int ks = 0; ks < 8; ++ks) sacc = __builtin_amdgcn_mfma_f32_32x32x16_bf16(kf[ks], qf[ks], sacc, 0, 0, 0);
        load_k(tn, kf);
        const float df = (float)d, basef = (float)(sb - tq) + df * (float)(4 * hh);
        const float lo = fmaxf(-64.f * df, -(float)tq), hi = fminf(64.f * df, (float)(SEQ - 1 - tq));
        const float mid = 0.5f * (lo + hi), half = 0.5f * (hi - lo);
        float tmax = -1e30f;
#pragma unroll
        for (int i = 0; i < 16; ++i) { const float deltaf = basef + df * (float)((i & 3) + 8 * (i >> 2));
            const bool valid = __builtin_fabsf(deltaf - mid) <= half;
            const float sv = valid ? sacc[i] * sc2 - sl2 * __builtin_fabsf(deltaf) : -1e30f; sacc[i] = sv; tmax = fmaxf(tmax, sv); }
        tmax = fmaxf(tmax, __shfl_xor(tmax, 32));
        const float m_new = tmax > m_run + 8.0f ? tmax : m_run;
        if (__any(m_new != m_run)) { const float alpha = __builtin_amdgcn_exp2f(m_run - m_new);
            l_run *= alpha;
#pragma unroll
            for (int i = 0; i < 4; ++i) o[i] *= alpha; }
        m_run = m_new;
        float psum = 0.f;
#pragma unroll
        for (int i = 0; i < 16; ++i) { const float pi = __builtin_amdgcn_exp2f(sacc[i] - m_new); psum += pi; sacc[i] = pi; }
        l_run += psum;
        bf16x8 pf[2];
#pragma unroll
        for (int s = 0; s < 2; ++s) { const unsigned w0 = pk2(sacc[8 * s], sacc[8 * s + 1]), w1 = pk2(sacc[8 * s + 2], sacc[8 * s + 3]), w2 = pk2(sacc[8 * s + 4], sacc[8 * s + 5]), w3 = pk2(sacc[8 * s + 6], sacc[8 * s + 7]);
            pf[s] = __builtin_bit_cast(bf16x8, (u32x4){w0, w1, w2, w3}); }
#pragma unroll
        for (int c4 = 0; c4 < 4; ++c4) {
            s16x4 r00, r01, r10, r11; tr_read4(vb0 ^ (unsigned)(c4 << 6), vb1 ^ (unsigned)(c4 << 6), r00, r01, r10, r11);
            const bf16x8 v0 = __builtin_shufflevector(r00, r01, 0, 1, 2, 3, 4, 5, 6, 7), v1 = __builtin_shufflevector(r10, r11, 0, 1, 2, 3, 4, 5, 6, 7);
            o[c4] = __builtin_amdgcn_mfma_f32_32x32x16_bf16(v0, pf[0], o[c4], 0, 0, 0);
            o[c4] = __builtin_amdgcn_mfma_f32_32x32x16_bf16(v1, pf[1], o[c4], 0, 0, 0); }
    }
    const float ltot = l_run + __shfl_xor(l_run, 32);
    if constexpr (PASS == 0) {
#pragma unroll
        for (int c4 = 0; c4 < 4; ++c4)
#pragma unroll
            for (int g4 = 0; g4 < 4; ++g4) *(f32x4*)(st_o + 32 * c4 + 8 * g4 + 4 * hh) = (f32x4){o[c4][4 * g4], o[c4][4 * g4 + 1], o[c4][4 * g4 + 2], o[c4][4 * g4 + 3]};
        if (hh == 0) *(f32x2*)st_ml = (f32x2){m_run, ltot};
    } else {
        const float inv = 1.0f / ltot;
        bf16_t* orow = p.AO + (size_t)(b * SEQ + tq) * DM + 1024 + h * 128;
#pragma unroll
        for (int c4 = 0; c4 < 4; ++c4)
#pragma unroll
            for (int g4 = 0; g4 < 4; ++g4) { const int dh = 32 * c4 + 8 * g4 + 4 * hh;
                if constexpr (D8_OUT0) *(unsigned*)((unsigned char*)p.AO + (size_t)(b * SEQ + tq) * DM + 1024 + h * 128 + dh) = pk4_fp8(o[c4][4 * g4] * inv, o[c4][4 * g4 + 1] * inv, o[c4][4 * g4 + 2] * inv, o[c4][4 * g4 + 3] * inv, A8_SCALE);
                else *(uint2*)(orow + dh) = make_uint2(pk2(o[c4][4 * g4] * inv, o[c4][4 * g4 + 1] * inv), pk2(o[c4][4 * g4 + 2] * inv, o[c4][4 * g4 + 3] * inv)); }
    }
}
DI void attention(const Params& p, LAS unsigned char* lds) {
    const int tid = opaque_tid(), wave = __builtin_amdgcn_readfirstlane(tid >> 6), lane = tid & 63, hh = lane >> 5;
    LAS unsigned char* vimg = lds + wave * 8192;
    const unsigned vbase = (unsigned)(uintptr_t)vimg;
    const int q4 = (lane & 15) >> 2, pp = lane & 3, blk = (lane >> 4) & 1;
    const unsigned vb0 = vbase + 256u * (4 * hh + q4) + 16u * ((2 * blk + (pp >> 1)) ^ (hh & 3)) + 8u * (pp & 1) + ((unsigned)q4 << 6);
    const unsigned vb1 = vbase + 256u * (8 + 4 * hh + q4) + 16u * ((2 * blk + (pp >> 1)) ^ ((2 + hh) & 3)) + 8u * (pp & 1) + ((unsigned)q4 << 6);
    for (int u = blockIdx.x; u < 256; u += gridDim.x) {
        const int bh = (u & 7) * 4 + ((u >> 3) >> 3), span = (u >> 3) & 7, h = bh & 7, b = bh >> 3;
#pragma unroll 1
        for (int j = 0; j < 2; ++j) attn_wave<0>(p, vimg, vb0, vb1, lane, b, h, span * 512 + wave * 2 + j);
        asm volatile("s_waitcnt vmcnt(0)" ::: "memory");
        __syncthreads();
#pragma unroll 1
        for (int j = 0; j < 2; ++j) attn_wave<1>(p, vimg, vb0, vb1, lane, b, h, span * 512 + (wave * 2 + j) * 32);
        __syncthreads();
    }
}
DI float om_exp2x(float la, float a) {
    const float x = 2.f * la;
    const float pl = x * (1.f + x * (0.5f + x * (0.16666667f + x * (0.041666668f + x * 0.008333334f))));
    return x > -0.25f ? -pl : 1.f - a * a;
}
DI void lru_conv(const Params& p) {
    const int tid = opaque_tid();
    if (tid < 336) {
        const int ch = tid * 8;
        float cw[4][8], cb[8];
#pragma unroll
        for (int j = 0; j < 4; ++j) { const f32x4 w0 = *(const f32x4*)(p.lru_conv_w + j * LRU_W + ch), w1 = *(const f32x4*)(p.lru_conv_w + j * LRU_W + ch + 4);
            cw[j][0] = w0[0]; cw[j][1] = w0[1]; cw[j][2] = w0[2]; cw[j][3] = w0[3]; cw[j][4] = w1[0]; cw[j][5] = w1[1]; cw[j][6] = w1[2]; cw[j][7] = w1[3]; }
        { const f32x4 b0 = *(const f32x4*)(p.lru_conv_b + ch), b1 = *(const f32x4*)(p.lru_conv_b + ch + 4); cb[0] = b0[0]; cb[1] = b0[1]; cb[2] = b0[2]; cb[3] = b0[3]; cb[4] = b1[0]; cb[5] = b1[1]; cb[6] = b1[2]; cb[7] = b1[3]; }
        for (int run = blockIdx.x; run < T_TOK / 32; run += gridDim.x) {
            const int tok0 = run * 32, t0 = tok0 % SEQ;
            const bf16_t* src = p.G + (size_t)tok0 * N_IN1 + LRU_W + ch;
            u32x4 rows[35];
#pragma unroll
            for (int i = 0; i < 35; ++i) { const int t = t0 - 2 + i; rows[i] = (t >= 0 && t < SEQ) ? *(const u32x4*)(src + (ptrdiff_t)(i - 2) * N_IN1) : (u32x4){0u, 0u, 0u, 0u}; }
#pragma unroll
            for (int i = 0; i < 32; ++i) { float xc[8];
#pragma unroll
                for (int e = 0; e < 8; ++e) xc[e] = cb[e];
#pragma unroll
                for (int j = 0; j < 4; ++j) { const u32x4 xv = rows[i + j];
                    xc[0] += cw[j][0] * bflo(xv[0]); xc[1] += cw[j][1] * bfhi(xv[0]); xc[2] += cw[j][2] * bflo(xv[1]); xc[3] += cw[j][3] * bfhi(xv[1]);
                    xc[4] += cw[j][4] * bflo(xv[2]); xc[5] += cw[j][5] * bfhi(xv[2]); xc[6] += cw[j][6] * bflo(xv[3]); xc[7] += cw[j][7] * bfhi(xv[3]); }
                *(u32x4*)(p.XC + (size_t)(tok0 + i) * LRU_W + ch) = (u32x4){pk2(xc[0], xc[1]), pk2(xc[2], xc[3]), pk2(xc[4], xc[5]), pk2(xc[6], xc[7])}; }
        }
    }
}
DI void lru(const Params& p, LAS unsigned char* lds) {
    const int tid = opaque_tid(), wave = __builtin_amdgcn_readfirstlane(tid >> 6), lane = tid & 63, col = lane & 15, g = lane >> 4;
    LAS unsigned char* wl = lds;
    LAS unsigned char* xs = lds + 36864;
    LAS float* sums = (LAS float*)(lds + 36864 + 86016);
    LAS float* cst = sums + 1536;
    for (int u = blockIdx.x; u < 256; u += gridDim.x) {
        const int b = u >> 6, n = (u >> 2) & 15, qt = u & 3, chq = n * LRU_BW + qt * 42;
        const char* xcb = (const char*)(p.XC + (size_t)(b * SEQ) * LRU_W + n * LRU_BW);
        const bf16_t* gb = p.G + (size_t)(b * SEQ) * N_IN1;
        unsigned poff[6];
#pragma unroll
        for (int i = 0; i < 6; ++i) { const int idx = tid + 512 * i; poff[i] = (unsigned)((idx / 21) * LRU_W + (idx % 21) * 8) * 2u; }
        auto dma_chunk = [&](int chunk, int bsel) { const char* src = xcb + (size_t)chunk * 128 * LRU_W * 2; LAS unsigned char* dst = xs + bsel * 43008 + wave * 1024;
#pragma unroll
            for (int i = 0; i < 5; ++i) __builtin_amdgcn_global_load_lds((const unsigned*)(src + poff[i]), (LAS unsigned*)(dst + i * 8192), 16, 0, 0);
            if (wave < 2) __builtin_amdgcn_global_load_lds((const unsigned*)(src + poff[5]), (LAS unsigned*)(dst + 5 * 8192), 16, 0, 0); };
        for (int dir = 0; dir < 2; ++dir) {
            __syncthreads();
            for (int i = tid; i < 2 * 48 * 24; i += 512) { const int which = i / (48 * 24), r = (i / 24) % 48, ck = i % 24; const int nt = r >> 4, cl = r & 15, ks = ck >> 2, gg = ck & 3;
                *(LAS u32x4*)(wl + ((which * 3 + nt) * 6 + ks) * 1024 + (gg * 16 + cl) * 16) = *(const u32x4*)(p.w_lru + ((((size_t)(dir * 2 + which) * 16 + n) * 4 + qt) * 48 + r) * 192 + ck * 8); }
            if (tid < 48) { const bool valid = tid < 42; const int ch = dir * LRU_W + chq + tid;
                cst[tid] = valid ? p.lru_b_a[ch] : 0.f; cst[48 + tid] = valid ? p.lru_b_x[ch] : 0.f;
                const float lam = valid ? p.lru_lambda[ch] : 0.f; const float sp = (-lam > 20.f) ? -lam : log1pf(__expf(-lam)); cst[96 + tid] = -8.0f * sp; }
            dma_chunk(dir == 0 ? 0 : 31, 0);
            asm volatile("s_waitcnt vmcnt(0)" ::: "memory");
            __syncthreads();
            float cba[3], cbx[3], cex[3];
#pragma unroll
            for (int nt = 0; nt < 3; ++nt) { cba[nt] = cst[nt * 16 + col]; cbx[nt] = cst[48 + nt * 16 + col]; cex[nt] = cst[96 + nt * 16 + col]; }
            float carry[3] = {0.f, 0.f, 0.f};
            for (int step = 0; step < 32; ++step) {
                const int c = dir == 0 ? step : 31 - step, c0 = c * 128, par = step & 1;
                const bool has_next = step < 31;
                if (has_next) dma_chunk(dir == 0 ? c + 1 : c - 1, par ^ 1);
                LAS unsigned char* xb = xs + par * 43008;
                uint2 hfv[3] = {make_uint2(0u, 0u), make_uint2(0u, 0u), make_uint2(0u, 0u)}; unsigned short gtv[3][4];
                const uint2* hfp = (const uint2*)p.HF + ((size_t)((u * 32 + c) * 8 + wave) * 3) * 64 + lane;
                if (dir == 1) {
#pragma unroll
                    for (int nt = 0; nt < 3; ++nt) { hfv[nt] = hfp[nt * 64];
#pragma unroll
                        for (int r = 0; r < 4; ++r) gtv[nt][r] = (nt * 16 + col < 42) ? gb[(size_t)(c0 + wave * 16 + 4 * g + r) * N_IN1 + chq + nt * 16 + col] : (unsigned short)0; } }
                bf16x8 af[6];
#pragma unroll
                for (int ks = 0; ks < 6; ++ks) { const int ch0 = 32 * ks + 8 * g; const bool kval = ch0 < LRU_BW; const int chl0 = kval ? ch0 : 160;
                    const u32x4 xv = *(const LAS u32x4*)(xb + (wave * 16 + col) * 336 + chl0 * 2);
                    af[ks] = __builtin_bit_cast(bf16x8, kval ? xv : (u32x4){0u, 0u, 0u, 0u}); }
                f32x4 acc[2][3];
#pragma unroll
                for (int w2 = 0; w2 < 2; ++w2)
#pragma unroll
                    for (int nt = 0; nt < 3; ++nt) { acc[w2][nt] = (f32x4){0.f, 0.f, 0.f, 0.f};
#pragma unroll
                        for (int ks = 0; ks < 6; ++ks) { const bf16x8 bfr = *(const LAS bf16x8*)(wl + ((w2 * 3 + nt) * 6 + ks) * 1024 + lane * 16);
                            acc[w2][nt] = __builtin_amdgcn_mfma_f32_16x16x32_bf16(af[ks], bfr, acc[w2][nt], 0, 0, 0); } }
                float hl[3][4], Pl[3][4];
#pragma unroll
                for (int nt = 0; nt < 3; ++nt) { const int chl = nt * 16 + col;
                    float av[4], uv[4];
#pragma unroll
                    for (int r = 0; r < 4; ++r) { const float za = acc[0][nt][r] + cba[nt], zx = acc[1][nt][r] + cbx[nt];
                        const float rg = sigmoidf_(za), ig = sigmoidf_(zx); const float la = cex[nt] * rg; const float a = __expf(la);
                        const float xcv = bf2f(*(const LAS bf16_t*)(xb + (wave * 16 + 4 * g + r) * 336 + (qt * 42 + chl) * 2));
                        av[r] = a; uv[r] = __builtin_amdgcn_sqrtf(om_exp2x(la, a)) * ig * xcv; }
                    float h[4], P[4], A, H;
                    if (dir == 0) { h[0] = uv[0]; P[0] = av[0];
#pragma unroll
                        for (int r = 1; r < 4; ++r) { h[r] = av[r] * h[r - 1] + uv[r]; P[r] = av[r] * P[r - 1]; }
                        A = P[3]; H = h[3];
                        { const float A1 = __shfl_up(A, 16), H1 = __shfl_up(H, 16); if (g >= 1) { H = A * H1 + H; A = A * A1; } }
                        { const float A2 = __shfl_up(A, 32), H2 = __shfl_up(H, 32); if (g >= 2) { H = A * H2 + H; A = A * A2; } }
                        float Ae = __shfl_up(A, 16), He = __shfl_up(H, 16); if (g == 0) { Ae = 1.f; He = 0.f; }
                        const float At = __shfl(A, 48 + col), Ht = __shfl(H, 48 + col);
#pragma unroll
                        for (int r = 0; r < 4; ++r) { hl[nt][r] = h[r] + P[r] * He; Pl[nt][r] = P[r] * Ae; }
                        if (g == 3) *(LAS f32x2*)(sums + ((par * 8 + wave) * 48 + chl) * 2) = (f32x2){At, Ht};
                    } else { h[3] = uv[3]; P[3] = av[3];
#pragma unroll
                        for (int r = 2; r >= 0; --r) { h[r] = av[r] * h[r + 1] + uv[r]; P[r] = av[r] * P[r + 1]; }
                        A = P[0]; H = h[0];
                        { const float A1 = __shfl_down(A, 16), H1 = __shfl_down(H, 16); if (g <= 2) { H = A * H1 + H; A = A * A1; } }
                        { const float A2 = __shfl_down(A, 32), H2 = __shfl_down(H, 32); if (g <= 1) { H = A * H2 + H; A = A * A2; } }
                        float Ae = __shfl_down(A, 16), He = __shfl_down(H, 16); if (g == 3) { Ae = 1.f; He = 0.f; }
                        const float At = __shfl(A, col), Ht = __shfl(H, col);
#pragma unroll
                        for (int r = 0; r < 4; ++r) { hl[nt][r] = h[r] + P[r] * He; Pl[nt][r] = P[r] * Ae; }
                        if (g == 0) *(LAS f32x2*)(sums + ((par * 8 + wave) * 48 + chl) * 2) = (f32x2){At, Ht};
                    }
                }
                asm volatile("s_waitcnt vmcnt(0)" ::: "memory");
                __syncthreads();
#pragma unroll
                for (int nt = 0; nt < 3; ++nt) { const int chl = nt * 16 + col; float C = carry[nt], Cw = 0.f;
#pragma unroll
                    for (int k = 0; k < 8; ++k) { const int w2 = dir == 0 ? k : 7 - k; const f32x2 sv = *(const LAS f32x2*)(sums + ((par * 8 + w2) * 48 + chl) * 2);
                        if (w2 == wave) Cw = C; C = sv[0] * C + sv[1]; }
                    carry[nt] = C;
                    float hv[4];
#pragma unroll
                    for (int r = 0; r < 4; ++r) hv[r] = hl[nt][r] + Pl[nt][r] * Cw;
                    if (dir == 0) ((uint2*)p.HF)[((size_t)((u * 32 + c) * 8 + wave) * 3 + nt) * 64 + lane] = make_uint2(pk2(hv[0], hv[1]), pk2(hv[2], hv[3]));
                    else if (chl < 42) { const float ff[4] = {bflo(hfv[nt].x), bfhi(hfv[nt].x), bflo(hfv[nt].y), bfhi(hfv[nt].y)};
#pragma unroll
                        for (int r = 0; r < 4; ++r) p.AO[(size_t)(b * SEQ + c0 + wave * 16 + 4 * g + r) * LRU_W + chq + chl] = f2bf(bf2f(gtv[nt][r]) * (ff[r] + hv[r])); }
                }
            }
        }
    }
}
}

#define XB_TMO      128
#define XB_XCNT(j)  (256  + 64 * (j))
#define XB_XSUB(j)  (1280 + 64 * (j))
#define XB_XGEN(j)  (2304 + 64 * (j))
#define XB_TOP      3328
#define XB_TOPGEN   3392
#define XCD_BAR_WORDS 3456
#define XB_SPIN_CAP (1u << 18)

__device__ __forceinline__ unsigned xb_ld(unsigned* p)              { return __hip_atomic_load(p, __ATOMIC_RELAXED, __HIP_MEMORY_SCOPE_AGENT); }
__device__ __forceinline__ unsigned xb_add(unsigned* p, unsigned v) { return __hip_atomic_fetch_add(p, v, __ATOMIC_RELAXED, __HIP_MEMORY_SCOPE_AGENT); }
__device__ __forceinline__ unsigned xb_xcc_id() { return (unsigned)__builtin_amdgcn_s_getreg((3 << 11) | 20) & 0xFu; }
#define XB_SPIN(cond, bar) do { unsigned _sp = 0; while (cond) { __builtin_amdgcn_s_sleep(1); \
    if ((++_sp & 255u) == 0u) { if (xb_ld(&(bar)[XB_TMO])) break; if (_sp > XB_SPIN_CAP) { atomicAdd(&(bar)[XB_TMO], 1u); break; } } } } while (0)

struct XcdBarrier {
    unsigned* bar; unsigned x;
    volatile LAS unsigned* st;
};

__device__ __forceinline__ XcdBarrier xcd_barrier_post(unsigned* bar, volatile LAS unsigned* st) {
    XcdBarrier b; b.bar = bar; b.x = xb_xcc_id(); b.st = st;
    if (threadIdx.x == 0) (void)xb_add(&bar[XB_XCNT(b.x)], 1u);
    return b;
}
__device__ __forceinline__ void xcd_barrier_complete(unsigned* bar, unsigned x, unsigned& nloc, unsigned& nx) {
    const unsigned G = gridDim.x * gridDim.y * gridDim.z;
    unsigned sum, cnt, mine, sp = 0u;
    for (;;) {
        sum = 0u; cnt = 0u; mine = 0u;
#pragma unroll
        for (unsigned j = 0; j < 16; ++j) { const unsigned c = xb_ld(&bar[XB_XCNT(j)]); sum += c; cnt += (c > 0u) ? 1u : 0u; mine = (j == x) ? c : mine; }
        if (sum == G) break;
        __builtin_amdgcn_s_sleep(1);
        if ((++sp & 255u) == 0u) { if (xb_ld(&bar[XB_TMO])) break; if (sp > XB_SPIN_CAP) { atomicAdd(&bar[XB_TMO], 1u); break; } }
    }
    nloc = mine > 0u ? mine : 1u; nx = cnt > 0u ? cnt : 1u;
}

__device__ __forceinline__ void xcd_barrier(const XcdBarrier& b) {
    asm volatile("s_waitcnt vmcnt(0)" ::: "memory");
    __syncthreads();
    if (threadIdx.x == 0) {
        unsigned* bar = b.bar;
        __builtin_amdgcn_s_waitcnt(0);
        unsigned nloc = b.st[0], nx = b.st[1];
        if (nloc == 0u) { xcd_barrier_complete(bar, b.x, nloc, nx); b.st[0] = nloc; b.st[1] = nx; }
        const unsigned old = xb_add(&bar[XB_XSUB(b.x)], 1u);
        const unsigned gen = old / nloc;
        if (old + 1u == (gen + 1u) * nloc) {
            __builtin_amdgcn_fence(__ATOMIC_RELEASE, "agent");
            asm volatile("s_waitcnt vmcnt(0)" ::: "memory");
            const unsigned og = xb_add(&bar[XB_TOP], 1u);
            const unsigned tg = og / nx;
            if (og + 1u == (tg + 1u) * nx) xb_add(&bar[XB_TOPGEN], 1u);
            else XB_SPIN(xb_ld(&bar[XB_TOPGEN]) == tg, bar);
            __builtin_amdgcn_fence(__ATOMIC_ACQUIRE, "agent");
            xb_add(&bar[XB_XGEN(b.x)], 1u);
            asm volatile("s_waitcnt vmcnt(0)" ::: "memory");
        } else {
            XB_SPIN(xb_ld(&bar[XB_XGEN(b.x)]) == gen, bar);
            __builtin_amdgcn_fence(__ATOMIC_ACQUIRE, "agent");
            asm volatile("s_waitcnt vmcnt(0)" ::: "memory");
        }
    }
    __syncthreads();
}


constexpr int PROBE = 0;
constexpr int LDS_XB_OFF = gm::STAGE_BYTES + 1024;
constexpr int LDS_TOTAL = LDS_XB_OFF + 16;
__global__ void __launch_bounds__(512, 2) mega(Params p) {
    LAS unsigned char* lds = (LAS unsigned char*)dyn_smem;
    LAS int* tab = (LAS int*)(lds + gm::TAB_OFF);
    volatile LAS unsigned* xbw = (volatile LAS unsigned*)(lds + LDS_XB_OFF);
    if (threadIdx.x == 0) { xbw[0] = 0u; xbw[1] = 0u; xbw[2] = 0u; xbw[3] = 0u; }
    __syncthreads();
    XcdBarrier bar = xcd_barrier_post(p.bar, xbw);
    ph::mods(p, lds);
    if constexpr (PROBE == 14) { ph::mods(p, lds); ph::mods(p, lds); }
    xcd_barrier(bar);
    { const int c = blockIdx.x, G = gridDim.x;
      ph::transposer(p, lds, c, c < 320 ? (320 - c + G - 1) / G : 0, G); __syncthreads();
      ph::transposer(p, lds, 320 + c, c < 632 ? (632 - c + G - 1) / G : 0, G); __syncthreads(); }
    ph::lru_weights(p);
    ph::fold_router(p);
    ph::norm_rows<0, D8_IN0>(p, p.x, p.norm0_mix, 0, 0, nullptr);
    xcd_barrier(bar);
    { const int c = blockIdx.x, G = gridDim.x; const int tcount = c < 6144 ? (6144 - c + G - 1) / G : 0; const bool t_first = ((c >> 3) & 1) != 0;
      if (t_first) { ph::transposer(p, lds, 952 + c, tcount, G); __syncthreads(); }
      { gm::DenseSched S; S.init(T_TOK, N_IN0); EpiIn0 e; e.xin = nullptr; e.lgate = 0; if constexpr (D8_IN0) gm::gemm_phase<EpiIn0, gm::DenseSched, true>(lds, p, p.H, p.w_in0t, 0, DM / 2, S, e, W8_E8M0, A8_E8M0); else gm::gemm_phase(lds, p, p.H, p.w_in0t, 0, DM, S, e); }
      if (!t_first) { __syncthreads(); ph::transposer(p, lds, 952 + c, tcount, G); }
      if constexpr (PROBE == 21) { __syncthreads(); ph::transposer(p, lds, 952 + c, tcount, G); }
      if constexpr (PROBE == 24) { __syncthreads(); if (t_first) ph::transposer(p, lds, 952 + c, tcount, G); }
      if constexpr (PROBE == 23) { __syncthreads(); if (t_first) { ph::transposer(p, lds, 952 + c, tcount, G); __syncthreads(); }
        { gm::DenseSched S; S.init(T_TOK, N_IN0); EpiIn0 e; e.xin = nullptr; e.lgate = 0; gm::gemm_phase<EpiIn0, gm::DenseSched, true>(lds, p, p.H, p.w_in0t, 0, DM / 2, S, e, W8_E8M0, A8_E8M0); }
        if (!t_first) { __syncthreads(); ph::transposer(p, lds, 952 + c, tcount, G); } }
      if constexpr (PROBE == 20) { __syncthreads(); gm::DenseSched S; S.init(T_TOK, N_IN0); EpiIn0 e; e.xin = nullptr; e.lgate = 0; gm::gemm_phase<EpiIn0, gm::DenseSched, true>(lds, p, p.H, p.w_in0t, 0, DM / 2, S, e, W8_E8M0, A8_E8M0); } }
    xcd_barrier(bar);
    ph::attention(p, lds);
    if constexpr (PROBE == 4) ph::attention(p, lds);
    __syncthreads();
    ph::conv_gln(p, lds);
    if constexpr (PROBE == 5) ph::conv_gln(p, lds);
    xcd_barrier(bar);
    { gm::DenseSched S; S.init(T_TOK, DM); EpiOut e; e.xin = p.x; e.lgate = 0; if constexpr (D8_OUT0) gm::gemm_phase<EpiOut, gm::DenseSched, true>(lds, p, p.AO, p.w_out0t, 0, DM / 2, S, e, W8_E8M0, A8_E8M0); else gm::gemm_phase(lds, p, p.AO, p.w_out0t, 0, DM, S, e); }
    xcd_barrier(bar);
    ph::router<false, true>(p, 0, lds, p.norm0_ffn, 1);
    if constexpr (PROBE == 12) { ph::router<true>(p, 0, lds); ph::router<true>(p, 0, lds); }
    xcd_barrier(bar);
    if constexpr (PROBE == 11) { xcd_barrier(bar); xcd_barrier(bar); xcd_barrier(bar); xcd_barrier(bar); xcd_barrier(bar); xcd_barrier(bar); xcd_barrier(bar); xcd_barrier(bar); xcd_barrier(bar); xcd_barrier(bar); }
    gm::moe_tables(tab, p.cnt);
    { gm::MoeSched<true> S; S.init(tab); EpiGU e; e.xin = nullptr; e.lgate = 0; gm::gemm_phase<EpiGU, gm::MoeSched<true>, true>(lds, p, p.H, p.w_gut0, (size_t)2048 * (DM / 2), DM / 2, S, e, W8_E8M0, A8_E8M0); if constexpr (PROBE == 3) gm::gemm_phase<EpiGU, gm::MoeSched<true>, true>(lds, p, p.H, p.w_gut0, (size_t)2048 * (DM / 2), DM / 2, S, e, W8_E8M0, A8_E8M0); }
    xcd_barrier(bar);
    { gm::MoeSched<false> S; S.init(tab); EpiDown e; e.xin = nullptr; e.lgate = 0; gm::gemm_phase<EpiDown, gm::MoeSched<false>, true>(lds, p, p.ACT, p.w_dt0, (size_t)DM * (EFF / 2), EFF / 2, S, e, W8_E8M0, A8_E8M0); if constexpr (PROBE == 8) gm::gemm_phase<EpiDown, gm::MoeSched<false>, true>(lds, p, p.ACT, p.w_dt0, (size_t)DM * (EFF / 2), EFF / 2, S, e, W8_E8M0, A8_E8M0); }
    xcd_barrier(bar);
    ph::norm_rows<1, D8_IN1>(p, p.XA, p.norm1_mix, 2, 1, tab);
    xcd_barrier(bar);
    { const int c = blockIdx.x, G = gridDim.x; int tfirst, tcount, tstride;
      if (G == 256) { tstride = 1; if (c < 64) { tcount = 18; tfirst = 18 * c; } else { tcount = 26; tfirst = 1152 + 26 * (c - 64); } }
      else { tstride = G; tfirst = c; tcount = c < 6144 ? (6144 - c + G - 1) / G : 0; }
      const bool t_first = ((c >> 3) & 1) != 0;
      if (t_first) { ph::transposer(p, lds, 7096 + tfirst, tcount, tstride); __syncthreads(); }
      { gm::DenseSched S; S.init(T_TOK, N_IN1); EpiIn1 e; e.xin = nullptr; e.lgate = 0; gm::gemm_phase(lds, p, p.H, p.w_in1t, 0, DM, S, e); }
      if (!t_first) { __syncthreads(); ph::transposer(p, lds, 7096 + tfirst, tcount, tstride); } }
    xcd_barrier(bar);
    ph::lru_conv(p);
    if constexpr (PROBE == 9) { ph::lru_conv(p); ph::lru_conv(p); }
    xcd_barrier(bar);
    ph::lru(p, lds);
    if constexpr (PROBE == 6) ph::lru(p, lds);
    xcd_barrier(bar);
    { gm::DenseSched S; S.init(T_TOK, DM); EpiOut e; e.xin = p.XA; e.lgate = 2; gm::gemm_phase(lds, p, p.AO, p.w_out1t, 0, LRU_W, S, e); }
    xcd_barrier(bar);
    ph::router<false, true>(p, 1, lds, p.norm1_ffn, 3);
    xcd_barrier(bar);
    gm::moe_tables(tab, p.cnt + 32);
    { gm::MoeSched<true> S; S.init(tab); EpiGU e; e.xin = nullptr; e.lgate = 0; gm::gemm_phase<EpiGU, gm::MoeSched<true>, true>(lds, p, p.H, p.w_gut1, (size_t)2048 * (DM / 2), DM / 2, S, e, W8_E8M0, A8_E8M0); }
    xcd_barrier(bar);
    { gm::MoeSched<false> S; S.init(tab); EpiDown e; e.xin = nullptr; e.lgate = 0; gm::gemm_phase<EpiDown, gm::MoeSched<false>, true>(lds, p, p.ACT, p.w_dt1, (size_t)DM * (EFF / 2), EFF / 2, S, e, W8_E8M0, A8_E8M0); }
    xcd_barrier(bar);
    ph::norm_rows<2>(p, p.XA, p.norm_final, 0, 3, tab);
    if constexpr (PROBE == 15) { ph::norm_rows<2>(p, p.XA, p.norm_final, 0, 3, tab); ph::norm_rows<2>(p, p.XA, p.norm_final, 0, 3, tab); }
}

static inline size_t al256(size_t x) { return (x + 255) & ~(size_t)255; }

extern "C" void kernel_launch(void* const* d_in, const int* in_sizes, int n_in, void* d_out, int out_size, void* d_ws, size_t ws_size, hipStream_t stream) {
    Params p{};
    const float** ip = (const float**)&p.x;
    for (int i = 0; i < 38; ++i) ip[i] = (const float*)d_in[i];
    p.out = (float*)d_out;
    char* w = (char*)d_ws; size_t off = 0;
    auto take = [&](size_t bytes) { char* r = w + off; off += al256(bytes); return r; };
    p.bar = (unsigned*)take(16384); p.cnt = (int*)take(256);
    const size_t zero_bytes = off;
    p.mod = (float*)take(4 * 4 * 6144 * 4); p.wrt = (float*)take((size_t)2 * 4 * 48 * 2048 * 4); p.rbias = (float*)take(2 * 4 * 48 * 4);
    p.w_in0t = (bf16_t*)take((size_t)N_IN0 * DM * 2); p.w_out0t = (bf16_t*)take((size_t)DM * DM * 2);
    p.w_gut0 = (bf16_t*)take((size_t)NEXP * 2048 * DM); p.w_dt0 = (bf16_t*)take((size_t)NEXP * DM * EFF);
    p.w_in1t = (bf16_t*)take((size_t)N_IN1 * DM * 2); p.w_out1t = (bf16_t*)take((size_t)DM * LRU_W * 2);
    p.w_gut1 = (bf16_t*)take((size_t)NEXP * 2048 * DM); p.w_dt1 = (bf16_t*)take((size_t)NEXP * DM * EFF);
    p.w_lru = (bf16_t*)take((size_t)2 * 2 * 16 * 2 * 96 * 192 * 2);
    p.H = (bf16_t*)take((size_t)T_TOK * DM * 2); p.G = (bf16_t*)take((size_t)T_TOK * N_IN1 * 2); p.AO = (bf16_t*)take((size_t)T_TOK * LRU_W * 2); p.HF = (bf16_t*)take((size_t)256 * 32 * 8 * 3 * 64 * 8);
    p.XA = (float*)take((size_t)T_TOK * DM * 4); p.ACT = (bf16_t*)take((size_t)ROWS_PAD * EFF * 2); p.YB = (bf16_t*)take((size_t)ROWS_PAD * DM * 2);
    p.XC = (bf16_t*)take((size_t)T_TOK * LRU_W * 2); p.KVH = (bf16_t*)take((size_t)NBATCH * 8 * 2 * SEQ * 128 * 2);
    p.tokl = (int*)take((size_t)NEXP * ECAP * 4); p.gatel = (float*)take((size_t)NEXP * ECAP * 4); p.asg = (int*)take((size_t)T_TOK * 2 * 4);
    if (off > ws_size) return;
    (void)hipMemsetAsync(d_ws, 0, zero_bytes, stream);
    static int grid = 0;
    if (!grid) { int dev = 0, cus = 0, per_cu = 0; (void)hipGetDevice(&dev); (void)hipDeviceGetAttribute(&cus, hipDeviceAttributeMultiprocessorCount, dev);
        (void)hipFuncSetAttribute((const void*)mega, hipFuncAttributeMaxDynamicSharedMemorySize, LDS_TOTAL);
        (void)hipOccupancyMaxActiveBlocksPerMultiprocessor(&per_cu, mega, 512, LDS_TOTAL);
        grid = cus * (per_cu < 1 ? per_cu : 1); }
    if (grid > 0) mega<<<grid, 512, LDS_TOTAL, stream>>>(p);
}
```

```cpp
#include <hip/hip_runtime.h>
#include <stdint.h>

typedef unsigned short bf16_t;
typedef float f32x4 __attribute__((ext_vector_type(4)));

#define DI __device__ __forceinline__

constexpr int T_TOK = 16384, DM = 2048, SEQ = 4096, NBATCH = 4;
constexpr int N_IN0 = 5120, N_IN1 = 5376, LRU_W = 2688, LRU_BW = 168;
constexpr int NEXP = 32, EFF = 1024, ECAP = 16384, ROWS_PAD = 40960;

DI float bf2f(bf16_t b) { return __uint_as_float(((unsigned)b) << 16); }
DI bf16_t f2bf(float f) { unsigned u = __float_as_uint(f); u += 0x7FFFu + ((u >> 16) & 1u); return (bf16_t)(u >> 16); }
DI float sigmoidf_(float x) { return __builtin_amdgcn_rcpf(1.0f + __expf(-x)); }
DI float siluf_(float x) { return x * __builtin_amdgcn_rcpf(1.0f + __expf(-x)); }
DI float gelu_tanh(float x) { const float u = 0.7978845608028654f * (x + 0.044715f * x * x * x); return x * __builtin_amdgcn_rcpf(1.0f + __expf(-2.0f * u)); }
DI float wave_sum(float v) { for (int o = 32; o > 0; o >>= 1) v += __shfl_xor(v, o); return v; }
DI float wave_max(float v) { for (int o = 32; o > 0; o >>= 1) v = fmaxf(v, __shfl_xor(v, o)); return v; }

struct Params {
    const float *x, *c;
    const float *norm0_mix, *ada0_mix_w, *ada0_mix_b, *w_in0, *conv_w, *conv_b, *conv_norm_g, *conv_norm_b, *w_out0;
    const float *norm0_ffn, *ada0_ffn_w, *ada0_ffn_b, *moe0_w_group, *moe0_w_expert, *moe0_w_gate_up, *moe0_w_down;
    const float *norm1_mix, *ada1_mix_w, *ada1_mix_b, *w_in1, *lru_conv_w, *lru_conv_b, *lru_w_a, *lru_b_a, *lru_w_x, *lru_b_x, *lru_lambda, *w_out1;
    const float *norm1_ffn, *ada1_ffn_w, *ada1_ffn_b, *moe1_w_group, *moe1_w_expert, *moe1_w_gate_up, *moe1_w_down;
    const float *norm_final;
    float* out;
    unsigned* bar; int* cnt;
    float* mod;
    float* wrt;
    float* rbias;
    bf16_t *w_in0t, *w_out0t, *w_gut0, *w_dt0, *w_in1t, *w_out1t, *w_gut1, *w_dt1, *w_lru;
    bf16_t *H, *G, *AO, *HF, *ACT, *YB, *XC, *KVH;
    float* XA;
    int* tokl; float* gatel; int* asg;
};

constexpr bool YB8_E = true;
struct GUnit { int rowbase; int nvalid; int e; const int* gather; };
struct GArgs { const bf16_t* A; const bf16_t* Bt; size_t bt_estride; long long lda, K, moe_layer; const float* xin; long long lgate; };
typedef unsigned u32x4_ __attribute__((ext_vector_type(4)));
typedef __bf16 bf2v_ __attribute__((ext_vector_type(2)));
typedef float f32x2_ __attribute__((ext_vector_type(2)));
DI unsigned pk2e(float a, float b) { f32x2_ v = {a, b}; bf2v_ r = __builtin_convertvector(v, bf2v_); return __builtin_bit_cast(unsigned, r); }
DI u32x4_ pack8(f32x4 a, f32x4 b) { return (u32x4_){pk2e(a[0], a[1]), pk2e(a[2], a[3]), pk2e(b[0], b[1]), pk2e(b[2], b[3])}; }
struct EpiIn0 { static constexpr bool GATHER = false; const float* xin; int lgate; DI void operator()(const Params& p, const GUnit& u, int r, int col0, f32x4 lo0, f32x4 lo1, f32x4 hi0, f32x4 hi1) const {
    const int row = u.rowbase + r;
    if (col0 < 3072) { bf16_t* o = p.G + (size_t)row * N_IN0 + col0; *(u32x4_*)o = pack8(lo0, lo1); *(u32x4_*)(o + 128) = pack8(hi0, hi1); }
    else { const int b = row / SEQ, t = row % SEQ, i0 = (col0 - 3072) >> 7, i1 = i0 + 1;
        bf16_t* o0 = p.KVH + ((size_t)((b * 8 + (i0 & 7)) * 2 + (i0 >> 3)) * SEQ + t) * 128 + (col0 & 127);
        bf16_t* o1 = p.KVH + ((size_t)((b * 8 + (i1 & 7)) * 2 + (i1 >> 3)) * SEQ + t) * 128 + (col0 & 127);
        *(u32x4_*)o0 = pack8(lo0, lo1); *(u32x4_*)o1 = pack8(hi0, hi1); } } };
struct EpiOut { static constexpr bool GATHER = false; const float* xin; int lgate; DI void operator()(const Params& p, const GUnit& u, int r, int col0, f32x4 lo0, f32x4 lo1, f32x4 hi0, f32x4 hi1) const {
    const int row = u.rowbase + r, b = row / SEQ; const float* gt = p.mod + (lgate * 4 + b) * 6144 + 4096 + col0; const float* xi = xin + (size_t)row * DM + col0; float* o = p.XA + (size_t)row * DM + col0;
    *(f32x4*)o = *(const f32x4*)xi + *(const f32x4*)gt * lo0; *(f32x4*)(o + 4) = *(const f32x4*)(xi + 4) + *(const f32x4*)(gt + 4) * lo1;
    *(f32x4*)(o + 128) = *(const f32x4*)(xi + 128) + *(const f32x4*)(gt + 128) * hi0; *(f32x4*)(o + 132) = *(const f32x4*)(xi + 132) + *(const f32x4*)(gt + 132) * hi1; } };
DI unsigned pk4_fp8e(float a, float b, float c, float d, float sc) { a = fminf(fmaxf(a * sc, -448.f), 448.f); b = fminf(fmaxf(b * sc, -448.f), 448.f); c = fminf(fmaxf(c * sc, -448.f), 448.f); d = fminf(fmaxf(d * sc, -448.f), 448.f);
    unsigned w = 0u; w = __builtin_amdgcn_cvt_pk_fp8_f32(a, b, w, false); w = __builtin_amdgcn_cvt_pk_fp8_f32(c, d, w, true); return w; }
struct EpiGU { static constexpr bool GATHER = true; const float* xin; int lgate; DI void operator()(const Params& p, const GUnit& u, int r, int col0, f32x4 lo0, f32x4 lo1, f32x4 hi0, f32x4 hi1) const {
    f32x4 a0, a1;
#pragma unroll
    for (int j = 0; j < 4; ++j) { a0[j] = siluf_(lo0[j]) * hi0[j]; a1[j] = siluf_(lo1[j]) * hi1[j]; }
    *(uint2*)((unsigned char*)p.ACT + (size_t)(u.rowbase + r) * EFF + (col0 >> 8) * 128 + (col0 & 127)) = make_uint2(pk4_fp8e(a0[0], a0[1], a0[2], a0[3], 8.f), pk4_fp8e(a1[0], a1[1], a1[2], a1[3], 8.f)); } };
struct EpiDown { static constexpr bool GATHER = false; const float* xin; int lgate; DI void operator()(const Params& p, const GUnit& u, int r, int col0, f32x4 lo0, f32x4 lo1, f32x4 hi0, f32x4 hi1) const {
    const float g = p.gatel[(u.gather - p.tokl) + r];
    if constexpr (YB8_E) { const float gs = g * 64.f; unsigned char* o = (unsigned char*)p.YB + (size_t)(u.rowbase + r) * DM + col0;
        *(uint2*)o = make_uint2(pk4_fp8e(lo0[0], lo0[1], lo0[2], lo0[3], gs), pk4_fp8e(lo1[0], lo1[1], lo1[2], lo1[3], gs)); *(uint2*)(o + 128) = make_uint2(pk4_fp8e(hi0[0], hi0[1], hi0[2], hi0[3], gs), pk4_fp8e(hi1[0], hi1[1], hi1[2], hi1[3], gs)); }
    else { bf16_t* o = p.YB + (size_t)(u.rowbase + r) * DM + col0; *(u32x4_*)o = pack8(lo0 * g, lo1 * g); *(u32x4_*)(o + 128) = pack8(hi0 * g, hi1 * g); } } };
struct EpiIn1 { static constexpr bool GATHER = false; const float* xin; int lgate; DI void operator()(const Params& p, const GUnit& u, int r, int col0, f32x4 lo0, f32x4 lo1, f32x4 hi0, f32x4 hi1) const {
    bf16_t* o = p.G + (size_t)(u.rowbase + r) * N_IN1 + col0;
    if (col0 < LRU_W) {
#pragma unroll
        for (int j = 0; j < 4; ++j) { lo0[j] = gelu_tanh(lo0[j]); lo1[j] = gelu_tanh(lo1[j]); } }
    if (col0 + 128 < LRU_W) {
#pragma unroll
        for (int j = 0; j < 4; ++j) { hi0[j] = gelu_tanh(hi0[j]); hi1[j] = gelu_tanh(hi1[j]); } }
    *(u32x4_*)o = pack8(lo0, lo1); *(u32x4_*)(o + 128) = pack8(hi0, hi1); } };

#define LAS __attribute__((address_space(3)))
typedef short bf16x8 __attribute__((ext_vector_type(8)));
DI int opaque_tid() { int t = threadIdx.x; asm volatile("" : "+v"(t)); return t; }
namespace gm {
constexpr int BM = 256, BK = 64, HALF = 128, HTB = HALF * BK * 2, STAGE_BYTES = 8 * HTB, NXCD = 8, WGM = 4;
constexpr int TAB_OFF = STAGE_BYTES;
DI int lds_byte(int r, int c) { const int st = (r >> 4) * 2 + (c >> 5), rr = r & 15, cc = c & 31, ob = rr * 64 + cc * 2; return st * 1024 + (ob ^ (((ob >> 9) & 1) << 5)); }
DI int perm32(int rho) { const int n = rho >> 4, i = rho & 15; return 8 * (i >> 2) + 4 * n + (i & 3); }
DI void stage_rc(int b, int& R, int& C) { const int st = b / 1024, sb = b % 1024, swz = sb ^ (((sb >> 9) & 1) << 5); R = (st >> 1) * 16 + swz / 64; C = (st & 1) * 32 + (swz % 64) / 2; }
struct Unit { int arow, nvalid, orow, pn, e, goff; };
struct DenseSched {
    static constexpr bool GATHER = false, HALF_SKIP = false;
    int nM, nN, nwg, G, c;
    DI void init(int M, int N) { nM = M / BM; nN = N / BM; nwg = nM * nN; G = gridDim.x; c = blockIdx.x; }
    DI bool next(int i, Unit& u) const {
        const long L = (long)i * G + c; if (L >= nwg) return false;
        int wgid = (int)L; { const int q = nwg / NXCD, r = nwg % NXCD, xcd = wgid % NXCD, off = wgid / NXCD; wgid = (xcd < r ? xcd * (q + 1) : r * (q + 1) + (xcd - r) * q) + off; }
        const int nig = WGM * nN, gid = wgid / nig, fm = gid * WGM, gsz = (nM - fm) < WGM ? (nM - fm) : WGM;
        const int pm = fm + ((wgid % nig) % gsz); u.pn = (wgid % nig) / gsz; u.arow = pm * BM; u.orow = pm * BM; u.nvalid = BM; u.e = 0; u.goff = 0; return true;
    }
};
template <bool GATH> struct MoeSched {
    static constexpr bool GATHER = GATH, HALF_SKIP = true;
    const LAS int* tab; int G, c;
    DI void init(const LAS int* t) { tab = t; G = gridDim.x; c = blockIdx.x; }
    DI bool next(int i, Unit& u) const {
        const int L = i * G + c, mtile = L >> 3; const int total = __builtin_amdgcn_readfirstlane(tab[32]);
        if (mtile >= total) return false;
        int e = 0; for (int j = 1; j < 32; ++j) { if (__builtin_amdgcn_readfirstlane(tab[j]) <= mtile) e = j; }
        const int mt = mtile - __builtin_amdgcn_readfirstlane(tab[e]); const int cn = __builtin_amdgcn_readfirstlane(tab[64 + e]);
        u.e = e; u.pn = L & 7; u.orow = mtile * BM; u.arow = mtile * BM; u.nvalid = (cn - mt * BM) < BM ? (cn - mt * BM) : BM; u.goff = e * ECAP + mt * BM; return true;
    }
};
DI void moe_tables(LAS int* tab, const int* cnt) {
    if (threadIdx.x == 0) { int run = 0; for (int e = 0; e < 32; ++e) { const int cn = cnt[e]; tab[e] = run; tab[64 + e] = cn; run += (cn + 255) >> 8; } tab[32] = run; }
    __syncthreads();
}

typedef int i32x8 __attribute__((ext_vector_type(8)));
typedef int i32x4 __attribute__((ext_vector_type(4)));
DI void mfma8(f32x4& acc, const i32x8& w8, const i32x8& x8, int ws, int as) {
    asm volatile("v_mfma_scale_f32_16x16x128_f8f6f4 %0, %1, %2, %0, %3, %4 op_sel_hi:[0,0,0]" : "+v"(acc) : "v"(w8), "v"(x8), "v"(ws), "v"(as)); }
template <class Epi, class Sched, bool FP8 = false>
DI void gemm_phase(LAS unsigned char* lds, const Params& p, const bf16_t* A, const bf16_t* Bt, size_t bt_estride, int K, const Sched& S, const Epi& E, int wscale = 0x7f7f7f7f, int ascale = 0x7f7f7f7f) {
    const int tid = opaque_tid(), wid = __builtin_amdgcn_readfirstlane(tid >> 6), lane = tid & 63, wr = wid >> 2, wc = wid & 3, fr = lane & 15, fq = lane >> 4;
    const int nt = K / BK;
    unsigned voffA[2], voffB[2];
#pragma unroll
    for (int i = 0; i < 2; ++i) { int R, C; stage_rc(tid * 16 + i * 8192, R, C); voffA[i] = (unsigned)(R * K + C) * 2u; voffB[i] = (unsigned)(((R & ~31) + perm32(R & 31)) * K + C) * 2u; }
    const size_t kstep = (size_t)(BK * 2), hstep = (size_t)HALF * K * 2, tstep = 2 * hstep;
    const unsigned ldsw = (unsigned)wid * 1024u;
    const int aoff = lds_byte(wr * 64 + fr, fq * 8), boff = lds_byte(wc * 32 + fr, fq * 8);
#define G_SA(b, h) (((b) * 2 + (h)) * HTB)
#define G_SB(b, h) ((4 + (b) * 2 + (h)) * HTB)
#define G_STAGE(bufoff, gbase, voff) do { _Pragma("unroll") for (int _i = 0; _i < 2; ++_i) \
        __builtin_amdgcn_global_load_lds((const unsigned*)((const char*)(gbase) + (voff)[_i]), (LAS unsigned*)(lds + (bufoff) + ldsw + _i * 8192), 16, 0, 0); } while (0)
#define G_STAGE_A(bufoff, ubase, gv, h, koff) do { if constexpr (Sched::GATHER) { G_STAGE(bufoff, (const char*)A + (koff), gv[h]); } else { G_STAGE(bufoff, (ubase) + (h) * hstep + (koff), voffA); } } while (0)
#define G_LD16(off_) (*(const LAS i32x4*)(lds + (off_)))
#define G_LD16B(off_) (*(const LAS bf16x8*)(lds + (off_)))
#define G_LDA(dst, b, h) do { _Pragma("unroll") for (int m = 0; m < 4; ++m) { if constexpr (FP8) dst##8[m] = __builtin_shufflevector(G_LD16(G_SA(b, h) + aoff + m * 2048), G_LD16(G_SA(b, h) + aoff + m * 2048 + 1024), 0, 1, 2, 3, 4, 5, 6, 7); \
        else { dst[m][0] = G_LD16B(G_SA(b, h) + aoff + m * 2048); dst[m][1] = G_LD16B(G_SA(b, h) + aoff + m * 2048 + 1024); } } } while (0)
#define G_LDB(dst, b, h) do { _Pragma("unroll") for (int n = 0; n < 2; ++n) { if constexpr (FP8) dst##8[n] = __builtin_shufflevector(G_LD16(G_SB(b, h) + boff + n * 2048), G_LD16(G_SB(b, h) + boff + n * 2048 + 1024), 0, 1, 2, 3, 4, 5, 6, 7); \
        else { dst[n][0] = G_LD16B(G_SB(b, h) + boff + n * 2048); dst[n][1] = G_LD16B(G_SB(b, h) + boff + n * 2048 + 1024); } } } while (0)
#define G_MMA(ai, bj, At, Bt_) do { __builtin_amdgcn_s_setprio(1); _Pragma("unroll") for (int m = 0; m < 4; ++m) _Pragma("unroll") for (int n = 0; n < 2; ++n) { \
        if constexpr (FP8) mfma8(acc[ai][bj][m][n], Bt_##8[n], At##8[m], wscale, ascale); \
        else { _Pragma("unroll") for (int k = 0; k < 2; ++k) acc[ai][bj][m][n] = __builtin_amdgcn_mfma_f32_16x16x32_bf16(Bt_[n][k], At[m][k], acc[ai][bj][m][n], 0, 0, 0); } } \
        __builtin_amdgcn_s_setprio(0); } while (0)
#define G_WAIT_V(n) asm volatile("s_waitcnt vmcnt(" #n ")" ::: "memory")
#define G_WAIT_L(n) asm volatile("s_waitcnt lgkmcnt(" #n ")" ::: "memory")
#define G_BAR __builtin_amdgcn_s_barrier()
#define G_SCHED __builtin_amdgcn_sched_barrier(0)
    Unit cur, nxt; int ui = 0;
    if (!S.next(0, cur)) return;
    f32x4 acc[2][2][4][2];
#pragma unroll
    for (int a = 0; a < 2; ++a)
#pragma unroll
        for (int b = 0; b < 2; ++b)
#pragma unroll
            for (int m = 0; m < 4; ++m)
#pragma unroll
                for (int n = 0; n < 2; ++n) acc[a][b][m][n] = (f32x4){0.f, 0.f, 0.f, 0.f};
    bf16x8 At[4][2], B0[2][2], B1[2][2]; i32x8 At8[4], B08[2], B18[2];
    unsigned gcur[2][2] = {{0u, 0u}, {0u, 0u}}, gnxt[2][2] = {{0u, 0u}, {0u, 0u}};
    auto gather_offs = [&](const Unit& u, unsigned (&g)[2][2]) {
        if constexpr (Sched::GATHER) {
#pragma unroll
            for (int h = 0; h < 2; ++h)
#pragma unroll
                for (int i = 0; i < 2; ++i) { int tz = tid; asm volatile("" : "+v"(tz)); int R, C; stage_rc(tz * 16 + i * 8192, R, C); const int r = h * HALF + R; const int tk = p.tokl[u.goff + (r < u.nvalid ? r : 0)]; const int tok = r < u.nvalid ? tk : 0; g[h][i] = (unsigned)(tok * K + C) * 2u; }
        }
    };
    const char* cA = (const char*)A + (size_t)(cur.arow / BM) * tstep; const char* cB = (const char*)Bt + ((size_t)cur.e * bt_estride) * 2 + (size_t)cur.pn * tstep;
    gather_offs(cur, gcur);
    G_STAGE(G_SB(0, 0), cB, voffB); G_STAGE_A(G_SA(0, 0), cA, gcur, 0, 0); G_STAGE(G_SB(0, 1), cB + hstep, voffB); G_STAGE_A(G_SA(0, 1), cA, gcur, 1, 0);
    if (wr == 1) G_BAR;
    G_WAIT_V(4); G_BAR;
    G_STAGE(G_SB(1, 0), cB + kstep, voffB); G_STAGE_A(G_SA(1, 0), cA, gcur, 0, kstep); G_STAGE(G_SB(1, 1), cB + hstep + kstep, voffB);
    G_WAIT_V(6); G_BAR;
    for (;;) {
        const bool has_next = S.next(ui + 1, nxt);
        const char* nA = has_next ? (const char*)A + (size_t)(nxt.arow / BM) * tstep : cA;
        const char* nB = has_next ? (const char*)Bt + ((size_t)nxt.e * bt_estride) * 2 + (size_t)nxt.pn * tstep : cB;
        if constexpr (Sched::GATHER) { if (has_next) gather_offs(nxt, gnxt); else {
#pragma unroll
            for (int h = 0; h < 2; ++h) { gnxt[h][0] = gcur[h][0]; gnxt[h][1] = gcur[h][1]; } } }
        for (int t = 0; t < nt; t += 2) {
            const bool last = (t == nt - 2);
            const size_t k1 = (size_t)(t + 1) * kstep;
            const char* a2 = last ? nA : cA; const char* b2 = last ? nB : cB + (size_t)(t + 2) * kstep;
            const size_t k2 = last ? 0 : (size_t)(t + 2) * kstep; const size_t k3 = k2 + kstep;
            const char* b3 = b2 + kstep;
            unsigned g2[2][2];
#pragma unroll
            for (int h = 0; h < 2; ++h) { g2[h][0] = last ? gnxt[h][0] : gcur[h][0]; g2[h][1] = last ? gnxt[h][1] : gcur[h][1]; }
            G_LDB(B0, 0, 0); G_SCHED; G_LDA(At, 0, 0); G_STAGE_A(G_SA(1, 1), cA, gcur, 1, k1);
            G_WAIT_L(8); G_BAR; G_WAIT_L(0); G_MMA(0, 0, At, B0); G_BAR; G_SCHED;
            G_LDB(B1, 0, 1); G_STAGE(G_SB(0, 0), b2, voffB);
            G_BAR; G_WAIT_L(0); G_MMA(0, 1, At, B1); G_BAR;
            G_LDA(At, 0, 1); G_STAGE_A(G_SA(0, 0), a2, g2, 0, k2);
            G_BAR; G_WAIT_L(0); if (!Sched::HALF_SKIP || cur.nvalid > HALF) G_MMA(1, 0, At, B0); G_BAR; G_SCHED;
            G_STAGE(G_SB(0, 1), b2 + hstep, voffB);
            G_WAIT_V(6); G_BAR; if (!Sched::HALF_SKIP || cur.nvalid > HALF) G_MMA(1, 1, At, B1); G_BAR;
            G_LDB(B0, 1, 0); G_SCHED; G_LDA(At, 1, 0); G_STAGE_A(G_SA(0, 1), a2, g2, 1, k2);
            G_WAIT_L(8); G_BAR; G_WAIT_L(0); G_MMA(0, 0, At, B0); G_BAR; G_SCHED;
            G_LDB(B1, 1, 1); G_STAGE(G_SB(1, 0), b3, voffB);
            G_BAR; G_WAIT_L(0); G_MMA(0, 1, At, B1); G_BAR;
            G_LDA(At, 1, 1); G_STAGE_A(G_SA(1, 0), a2, g2, 0, k3);
            G_BAR; G_WAIT_L(0); if (!Sched::HALF_SKIP || cur.nvalid > HALF) G_MMA(1, 0, At, B0); G_BAR; G_SCHED;
            G_STAGE(G_SB(1, 1), b3 + hstep, voffB);
            G_WAIT_V(6); G_BAR; if (!Sched::HALF_SKIP || cur.nvalid > HALF) G_MMA(1, 1, At, B1); G_BAR;
        }
        if constexpr (FP8) asm volatile("s_nop 15\n\ts_nop 15" ::: "memory");
        { GUnit gu; gu.rowbase = cur.orow; gu.nvalid = cur.nvalid; gu.e = cur.e; gu.gather = p.tokl + cur.goff;
#pragma unroll
          for (int ai = 0; ai < 2; ++ai)
#pragma unroll
            for (int m = 0; m < 4; ++m) { const int r = ai * HALF + wr * 64 + m * 16 + fr;
              if (r < cur.nvalid) E(p, gu, r, cur.pn * BM + wc * 32 + fq * 8, acc[ai][0][m][0], acc[ai][0][m][1], acc[ai][1][m][0], acc[ai][1][m][1]); } }
        if (!has_next) break;
#pragma unroll
        for (int a = 0; a < 2; ++a)
#pragma unroll
            for (int b = 0; b < 2; ++b)
#pragma unroll
                for (int m = 0; m < 4; ++m)
#pragma unroll
                    for (int n = 0; n < 2; ++n) acc[a][b][m][n] = (f32x4){0.f, 0.f, 0.f, 0.f};
        cur = nxt; cA = nA; cB = nB; ++ui;
#pragma unroll
        for (int h = 0; h < 2; ++h) { gcur[h][0] = gnxt[h][0]; gcur[h][1] = gnxt[h][1]; }
    }
    G_WAIT_V(0);
    if (wr == 0) G_BAR;
    G_BAR;
}
}

extern __shared__ __attribute__((aligned(16))) unsigned char dyn_smem[];
constexpr int LDS_BYTES = gm::STAGE_BYTES + 1024;

typedef __bf16 bf2v __attribute__((ext_vector_type(2)));
typedef float f32x2 __attribute__((ext_vector_type(2)));
typedef float f32x16 __attribute__((ext_vector_type(16)));
typedef short s16x4 __attribute__((ext_vector_type(4)));
typedef unsigned u32x4 __attribute__((ext_vector_type(4)));
DI unsigned pk2(float a, float b) { f32x2 v = {a, b}; bf2v r = __builtin_convertvector(v, bf2v); return __builtin_bit_cast(unsigned, r); }
DI float bflo(unsigned u) { return __uint_as_float(u << 16); }
DI float bfhi(unsigned u) { return __uint_as_float(u & 0xffff0000u); }

DI unsigned pk4_fp8(float a, float b, float c, float d, float sc) {
    a = __builtin_amdgcn_fmed3f(a * sc, -448.f, 448.f); b = __builtin_amdgcn_fmed3f(b * sc, -448.f, 448.f); c = __builtin_amdgcn_fmed3f(c * sc, -448.f, 448.f); d = __builtin_amdgcn_fmed3f(d * sc, -448.f, 448.f);
    unsigned w = 0u; w = __builtin_amdgcn_cvt_pk_fp8_f32(a, b, w, false); w = __builtin_amdgcn_cvt_pk_fp8_f32(c, d, w, true); return w; }
constexpr bool D8_IN0 = true, D8_OUT0 = false, D8_IN1 = false;
constexpr bool YB8 = true;
constexpr float Y8_SCALE = 64.f;
constexpr float W8_SCALE = 256.f, A8_SCALE = 8.f;
constexpr int W8_E8M0 = 0x77777777, A8_E8M0 = 0x7c7c7c7c;
namespace ph {
DI void mods(const Params& p, LAS unsigned char* lds) {
    const int tid = opaque_tid(), wave = tid >> 6, lane = tid & 63, l8 = tid & 7, rg = tid >> 3;
    LAS float* fl = (LAS float*)lds; LAS float* red = fl + 4 * DM;
    for (int i = tid; i < 4 * DM; i += 512) fl[i] = siluf_(p.c[i]);
    __syncthreads();
    for (int u = blockIdx.x; u < 768; u += gridDim.x) {
        const int l = u / 192, c32 = u % 192;
        const float* w = l == 0 ? p.ada0_mix_w : l == 1 ? p.ada0_ffn_w : l == 2 ? p.ada1_mix_w : p.ada1_ffn_w;
        const float* bs = l == 0 ? p.ada0_mix_b : l == 1 ? p.ada0_ffn_b : l == 2 ? p.ada1_mix_b : p.ada1_ffn_b;
        f32x4 acc[4] = {{0.f, 0.f, 0.f, 0.f}, {0.f, 0.f, 0.f, 0.f}, {0.f, 0.f, 0.f, 0.f}, {0.f, 0.f, 0.f, 0.f}};
        const float* wp = w + (size_t)rg * 6144 + c32 * 32 + l8 * 4;
#pragma unroll 8
        for (int i = 0; i < 32; ++i) { const f32x4 wv = *(const f32x4*)(wp + (size_t)(64 * i) * 6144); const int k = rg + 64 * i;
#pragma unroll
            for (int b = 0; b < 4; ++b) acc[b] += fl[b * DM + k] * wv; }
#pragma unroll
        for (int b = 0; b < 4; ++b)
#pragma unroll
            for (int j = 0; j < 4; ++j) { float v = acc[b][j]; v += __shfl_xor(v, 8); v += __shfl_xor(v, 16); v += __shfl_xor(v, 32); acc[b][j] = v; }
        if (lane < 8) {
#pragma unroll
            for (int b = 0; b < 4; ++b) *(LAS f32x4*)(red + (wave * 4 + b) * 32 + lane * 4) = acc[b]; }
        __syncthreads();
        if (tid < 128) { const int b = tid >> 5, col = tid & 31; float sum = 0.f;
#pragma unroll
            for (int w8 = 0; w8 < 8; ++w8) sum += red[(w8 * 4 + b) * 32 + col];
            p.mod[(l * 4 + b) * 6144 + c32 * 32 + col] = sum + bs[c32 * 32 + col]; }
        __syncthreads();
    }
}
constexpr int NT_UNITS = (640 + 256 + 672 + 336 + 2 * (8192 + 4096)) / 2;
struct UD { const float* sp; bf16_t* dst; int K, N, mode, e, kt, ntile; };
DI UD tdecode(const Params& p, int u, int lane) {
    const float* srcs[8] = {p.w_in0, p.w_out0, p.w_in1, p.w_out1, p.moe0_w_gate_up, p.moe0_w_down, p.moe1_w_gate_up, p.moe1_w_down};
    bf16_t* dsts[8] = {p.w_in0t, p.w_out0t, p.w_in1t, p.w_out1t, p.w_gut0, p.w_dt0, p.w_gut1, p.w_dt1};
    constexpr int Ks[8] = {DM, DM, DM, LRU_W, DM, EFF, DM, EFF}, Ns[8] = {N_IN0, DM, N_IN1, DM, 2048, DM, 2048, DM}, nus[8] = {320, 128, 336, 168, 4096, 2048, 4096, 2048};
    constexpr int modes[8] = {D8_IN0 ? 2 : 0, D8_OUT0 ? 2 : 0, D8_IN1 ? 2 : 0, 0, 3, 2, 3, 2};
    int v = u, mi = 0;
#pragma unroll
    for (int m = 0; m < 8; ++m) { if (mi == m && v >= nus[m]) { v -= nus[m]; mi = m + 1; } }
    UD d; const float* src = srcs[0]; d.dst = dsts[0]; d.K = Ks[0]; d.N = Ns[0]; d.mode = modes[0];
#pragma unroll
    for (int m = 1; m < 8; ++m) if (mi == m) { src = srcs[m]; d.dst = dsts[m]; d.K = Ks[m]; d.N = Ns[m]; d.mode = modes[m]; }
    const int ntl = d.N / 256, ktl = d.K / 128; d.e = v / (ktl * ntl); const int rem = v % (ktl * ntl); d.kt = rem / ntl; d.ntile = rem % ntl;
    d.sp = src + (size_t)d.e * d.K * d.N + (size_t)(d.kt * 128) * d.N + d.ntile * 256 + lane * 4;
    return d;
}
DI void transposer(const Params& p, LAS unsigned char* lds, int first, int count, int stride) {
    const int tid = opaque_tid(), wave = tid >> 6, lane = tid & 63;
    LAS float* fl = (LAS float*)lds;
    if (count <= 0) return;
    if (tdecode(p, first, lane).mode & 2) {
        LAS unsigned* td = (LAS unsigned*)lds;
        const int nl = lane & 15, ks = lane >> 4;
        auto src_of = [&](const UD& d, int g, int j) -> const float* { const int kq = 4 * (g >> 2) + ks, nq = 16 * (g & 3) + nl; return d.sp - lane * 4 + (size_t)(4 * kq + j) * d.N + 4 * nq; };
        f32x4 va[4][4], vb[4][4];
        auto load_unit = [&](int u, f32x4 (&v)[4][4]) { const UD dd = tdecode(p, u, lane);
#pragma unroll
            for (int i = 0; i < 4; ++i)
#pragma unroll
                for (int j = 0; j < 4; ++j) v[i][j] = *(const f32x4*)src_of(dd, wave * 4 + i, j); };
        auto process = [&](int jn, f32x4 (&v)[4][4]) { const int u = first + jn * stride;
            const UD d = tdecode(p, u, lane); const int K = d.K, N = d.N, mode = d.mode, e = d.e, kt = d.kt, ntile = d.ntile;
            LAS unsigned* tile = td + (jn & 1) * (256 * 33);
#pragma unroll
            for (int i = 0; i < 4; ++i) { const int g = wave * 4 + i, kq = 4 * (g >> 2) + ks, nq = 16 * (g & 3) + nl;
#pragma unroll
                for (int en = 0; en < 4; ++en) tile[(4 * nq + en) * 33 + kq] = pk4_fp8(v[i][0][en], v[i][1][en], v[i][2][en], v[i][3][en], W8_SCALE); }
            __syncthreads();
            if (jn + 2 < count) load_unit(u + 2 * stride, v);
            { const int n = tid >> 1, kh = tid & 1; const int ng = ntile * 256 + n; const int jg = ng & 1023; const int np = (mode & 1) ? (256 * (jg >> 7) + (ng < 1024 ? 0 : 128) + (jg & 127)) : ng;
              unsigned char* dp = (unsigned char*)d.dst + (size_t)e * N * K + (size_t)np * K + kt * 128 + kh * 64;
#pragma unroll
              for (int jj = 0; jj < 4; ++jj) { const LAS unsigned* tp = tile + n * 33 + kh * 16 + jj * 4; *(uint4*)(dp + jj * 16) = make_uint4(tp[0], tp[1], tp[2], tp[3]); } } };
        load_unit(first, va); if (count > 1) load_unit(first + stride, vb);
        for (int jn = 0; jn < count; jn += 2) { process(jn, va); if (jn + 1 < count) process(jn + 1, vb); }
        __syncthreads();
        return;
    }
    f32x4 vv[16];
    { const UD d0 = tdecode(p, first, lane);
#pragma unroll
        for (int i = 0; i < 16; ++i) vv[i] = *(const f32x4*)(d0.sp + (size_t)(i * 8 + wave) * d0.N); }
    for (int j = 0; j < count; ++j) { const int u = first + j * stride;
        const UD d = tdecode(p, u, lane); const int K = d.K, N = d.N, mode = d.mode, e = d.e, kt = d.kt, ntile = d.ntile; bf16_t* dst = d.dst;
#pragma unroll
        for (int i = 0; i < 16; ++i) { LAS float* tp = fl + (i * 8 + wave) * 257 + lane * 4; tp[0] = vv[i][0]; tp[1] = vv[i][1]; tp[2] = vv[i][2]; tp[3] = vv[i][3]; }
        __syncthreads();
        if (j + 1 < count) { const UD dn = tdecode(p, u + stride, lane);
#pragma unroll
            for (int i = 0; i < 16; ++i) vv[i] = *(const f32x4*)(dn.sp + (size_t)(i * 8 + wave) * dn.N); }
        { const int n = tid >> 1, kh = tid & 1; const int ng = ntile * 256 + n; const int jg = ng & 1023; const int np = (mode & 1) ? (256 * (jg >> 7) + (ng < 1024 ? 0 : 128) + (jg & 127)) : ng;
          bf16_t* dp = dst + (size_t)e * N * K + (size_t)np * K + kt * 128 + kh * 64;
#pragma unroll
          for (int jj = 0; jj < 8; ++jj) { unsigned w4[4];
#pragma unroll
              for (int q = 0; q < 4; ++q) { const int k = kh * 64 + jj * 8 + q * 2; w4[q] = pk2(fl[k * 257 + n], fl[(k + 1) * 257 + n]); }
              *(uint4*)(dp + jj * 8) = make_uint4(w4[0], w4[1], w4[2], w4[3]); } }
        __syncthreads();
    }
}
DI void lru_weights(const Params& p) {
    const int tid = opaque_tid();
    for (size_t i = (size_t)blockIdx.x * 512 + tid; i < (size_t)2 * 2 * 16 * 4 * 48 * 192; i += (size_t)gridDim.x * 512) {
        const int k = i % 192, j = (i / 192) % 48, qt = (i / (192 * 48)) % 4, n = (i / (192 * 48 * 4)) % 16, which = (i / (192 * 48 * 4 * 16)) % 2, dir = i / (192 * 48 * 4 * 16 * 2);
        const float* w = which == 0 ? p.lru_w_a : p.lru_w_x; float v = 0.f;
        if (j < 42 && k < 168) v = w[(((size_t)dir * 16 + n) * 168 + k) * 168 + qt * 42 + j];
        p.w_lru[i] = f2bf(v);
    }
}
DI void fold_router(const Params& p) {
    const int tid = opaque_tid(), wave = tid >> 6, lane = tid & 63;
    for (size_t i = (size_t)blockIdx.x * 512 + tid; i < (size_t)2 * 4 * 48 * DM; i += (size_t)gridDim.x * 512) {
        const int k = i % DM, n = (i / DM) % 48, b = (i / (DM * 48)) % 4, l = i / (DM * 48 * 4);
        const float* g = l == 0 ? p.norm0_ffn : p.norm1_ffn; const float* md = p.mod + ((l == 0 ? 1 : 3) * 4 + b) * 6144;
        const float* we = l == 0 ? p.moe0_w_expert : p.moe1_w_expert; const float* wg = l == 0 ? p.moe0_w_group : p.moe1_w_group;
        const float w = n < 32 ? we[k * 32 + n] : n < 36 ? wg[k * 4 + (n - 32)] : 0.f;
        p.wrt[i] = g[k] * (1.f + md[2048 + k]) * w;
    }
    for (int task = blockIdx.x * 8 + wave; task < 2 * 4 * 48; task += gridDim.x * 8) {
        const int n = task % 48, b = (task / 48) % 4, l = task / (48 * 4);
        const float* md = p.mod + ((l == 0 ? 1 : 3) * 4 + b) * 6144;
        const float* we = l == 0 ? p.moe0_w_expert : p.moe1_w_expert; const float* wg = l == 0 ? p.moe0_w_group : p.moe1_w_group;
        float part = 0.f;
        for (int k = lane; k < DM; k += 64) { const float w = n < 32 ? we[k * 32 + n] : n < 36 ? wg[k * 4 + (n - 32)] : 0.f; part += md[k] * w; }
        part = wave_sum(part); if (lane == 0) p.rbias[task] = part;
    }
}
template <int MODE, bool OUT8 = false> DI void norm_rows(const Params& p, const float* xin, const float* gain, int lmod, int lgate, const LAS int* tab) {
    const int tid = opaque_tid(), wave = tid >> 6, lane = tid & 63;
    for (int row = blockIdx.x * 8 + wave; row < T_TOK; row += gridDim.x * 8) {
        const int b = row / SEQ;
        f32x4 v[8];
#pragma unroll
        for (int i = 0; i < 8; ++i) v[i] = *(const f32x4*)(xin + (size_t)row * DM + i * 256 + lane * 4);
        if constexpr (MODE >= 1) {
            const int a0 = p.asg[row * 2], a1 = p.asg[row * 2 + 1];
            const size_t r0 = (size_t)tab[a0 >> 14] * 256 + (a0 & 16383), r1 = (size_t)tab[a1 >> 14] * 256 + (a1 & 16383);
            const float* gt = p.mod + (lgate * 4 + b) * 6144 + 4096;
#pragma unroll
            for (int i = 0; i < 8; ++i) { const int col = i * 256 + lane * 4; const f32x4 g4 = *(const f32x4*)(gt + col);
                if constexpr (YB8) { const unsigned y0 = *(const unsigned*)((const unsigned char*)p.YB + r0 * DM + col), y1 = *(const unsigned*)((const unsigned char*)p.YB + r1 * DM + col);
                    const f32x2 a0 = __builtin_amdgcn_cvt_pk_f32_fp8(y0, false), a1 = __builtin_amdgcn_cvt_pk_f32_fp8(y0, true), b0 = __builtin_amdgcn_cvt_pk_f32_fp8(y1, false), b1 = __builtin_amdgcn_cvt_pk_f32_fp8(y1, true);
                    const f32x4 gq = g4 * (1.f / Y8_SCALE);
                    v[i][0] += gq[0] * (a0[0] + b0[0]); v[i][1] += gq[1] * (a0[1] + b0[1]); v[i][2] += gq[2] * (a1[0] + b1[0]); v[i][3] += gq[3] * (a1[1] + b1[1]); }
                else { const uint2 y0 = *(const uint2*)(p.YB + r0 * DM + col), y1 = *(const uint2*)(p.YB + r1 * DM + col);
                v[i][0] += g4[0] * (bflo(y0.x) + bflo(y1.x)); v[i][1] += g4[1] * (bfhi(y0.x) + bfhi(y1.x));
                v[i][2] += g4[2] * (bflo(y0.y) + bflo(y1.y)); v[i][3] += g4[3] * (bfhi(y0.y) + bfhi(y1.y)); } }
            if constexpr (MODE == 1) {
#pragma unroll
                for (int i = 0; i < 8; ++i) *(f32x4*)(p.XA + (size_t)row * DM + i * 256 + lane * 4) = v[i]; }
        }
        float ss = 0.f;
#pragma unroll
        for (int i = 0; i < 8; ++i) ss += v[i][0] * v[i][0] + v[i][1] * v[i][1] + v[i][2] * v[i][2] + v[i][3] * v[i][3];
        ss = wave_sum(ss); const float rstd = rsqrtf(ss * (1.0f / DM) + 1e-6f);
        if constexpr (MODE == 2) {
#pragma unroll
            for (int i = 0; i < 8; ++i) { const int col = i * 256 + lane * 4; const f32x4 g4 = *(const f32x4*)(gain + col); *(f32x4*)(p.out + (size_t)row * DM + col) = v[i] * rstd * g4; }
        } else { const float* md = p.mod + (lmod * 4 + b) * 6144;
#pragma unroll
            for (int i = 0; i < 8; ++i) { const int col = i * 256 + lane * 4; const f32x4 g4 = *(const f32x4*)(gain + col), sc = *(const f32x4*)(md + 2048 + col), sh = *(const f32x4*)(md + col);
                const f32x4 h = v[i] * rstd * g4 * (1.f + sc) + sh;
                if constexpr (OUT8) *(unsigned*)((unsigned char*)p.H + (size_t)row * DM + col) = pk4_fp8(h[0], h[1], h[2], h[3], A8_SCALE);
                else *(uint2*)(p.H + (size_t)row * DM + col) = make_uint2(pk2(h[0], h[1]), pk2(h[2], h[3])); } }
    }
}
template <bool DRY = false, bool NORM = false> DI void router(const Params& p, int l, LAS unsigned char* lds, const float* gain = nullptr, int lmod = 0) {
    const int tid = opaque_tid(), wave = __builtin_amdgcn_readfirstlane(tid >> 6), lane = tid & 63;
    LAS float* lg = (LAS float*)lds + (wave & 3) * (16 * 48);
    LAS float* part = (LAS float*)lds + 4 * 16 * 48 + (wave & 3) * (64 * 13);
    LAS float* rsl = (LAS float*)lds + 4 * 16 * 48 + 4 * 64 * 13 + (wave & 3) * 16;
    for (int tg = blockIdx.x; tg < T_TOK / 64; tg += gridDim.x) {
        const int tile = tg * 4 + (wave & 3), kh = wave >> 2;
        const int row0 = tile * 16, b = row0 / SEQ, r = lane & 15, q = lane >> 4;
        const float* xa = p.XA + (size_t)(row0 + r) * DM + 4 * q + kh * (DM / 2);
        const float* wt = p.wrt + (((size_t)l * 4 + b) * 48 + r) * DM + 4 * q + kh * (DM / 2);
        f32x4 acc[3] = {{0.f, 0.f, 0.f, 0.f}, {0.f, 0.f, 0.f, 0.f}, {0.f, 0.f, 0.f, 0.f}}; float ss = 0.f;
#pragma unroll 2
        for (int s = 0; s < DM / 32; ++s) {
            const f32x4 a4 = *(const f32x4*)(xa + 16 * s);
            ss += a4[0] * a4[0] + a4[1] * a4[1] + a4[2] * a4[2] + a4[3] * a4[3];
#pragma unroll
            for (int n = 0; n < 3; ++n) { const f32x4 b4 = *(const f32x4*)(wt + (size_t)n * 16 * DM + 16 * s);
#pragma unroll
                for (int j = 0; j < 4; ++j) acc[n] = __builtin_amdgcn_mfma_f32_16x16x4f32(a4[j], b4[j], acc[n], 0, 0, 0); }
        }
        if (kh == 1) {
#pragma unroll
            for (int n = 0; n < 3; ++n)
#pragma unroll
                for (int j = 0; j < 4; ++j) part[(n * 4 + j) * 64 + lane] = acc[n][j];
            part[12 * 64 + lane] = ss; }
        __syncthreads();
        if (kh == 0) {
#pragma unroll
            for (int n = 0; n < 3; ++n)
#pragma unroll
                for (int j = 0; j < 4; ++j) acc[n][j] += part[(n * 4 + j) * 64 + lane];
            ss += part[12 * 64 + lane];
        ss += __shfl_xor(ss, 16); ss += __shfl_xor(ss, 32);
        const float rstd = rsqrtf(ss * (1.0f / DM) + 1e-6f);
        if (NORM && q == 0) rsl[r] = rstd;
#pragma unroll
        for (int j = 0; j < 4; ++j) { const float rs = __shfl(rstd, 4 * q + j);
#pragma unroll
            for (int n = 0; n < 3; ++n) lg[(4 * q + j) * 48 + n * 16 + r] = acc[n][j] * rs + p.rbias[(l * 4 + b) * 48 + n * 16 + r]; }
        __builtin_amdgcn_wave_barrier();
        if (!DRY && lane < 16) {
            const LAS float* L = lg + lane * 48; const int tok = row0 + lane;
            int gs = 0; float gm = L[32];
#pragma unroll
            for (int g = 1; g < 4; ++g) if (L[32 + g] > gm) { gm = L[32 + g]; gs = g; }
            float gden = 0.f;
#pragma unroll
            for (int g = 0; g < 4; ++g) gden += __expf(L[32 + g] - gm);
            const float gprob = 1.0f / gden;
            int i0 = 0; float v0 = L[gs * 8];
            for (int j = 1; j < 8; ++j) { const float x = L[gs * 8 + j]; if (x > v0) { v0 = x; i0 = j; } }
            int i1 = -1; float v1 = -3.4e38f;
            for (int j = 0; j < 8; ++j) { const float x = L[gs * 8 + j]; if (j != i0 && x > v1) { v1 = x; i1 = j; } }
            const float e1 = __expf(v1 - v0), g0 = gprob / (1.f + e1), g1 = gprob * e1 / (1.f + e1);
            const int ea = gs * 8 + i0, eb = gs * 8 + i1;
            const int sa = atomicAdd(&p.cnt[l * 32 + ea], 1), sb = atomicAdd(&p.cnt[l * 32 + eb], 1);
            p.tokl[ea * ECAP + sa] = tok; p.gatel[ea * ECAP + sa] = g0; p.tokl[eb * ECAP + sb] = tok; p.gatel[eb * ECAP + sb] = g1;
            p.asg[tok * 2] = (ea << 14) | sa; p.asg[tok * 2 + 1] = (eb << 14) | sb;
        }
        }
        __syncthreads();
        if constexpr (NORM) {
            const float* md = p.mod + (lmod * 4 + b) * 6144;
            f32x4 g4[8], sc[8], sh[8];
#pragma unroll
            for (int i = 0; i < 8; ++i) { const int col = i * 256 + lane * 4; g4[i] = *(const f32x4*)(gain + col); sc[i] = 1.f + *(const f32x4*)(md + 2048 + col); sh[i] = *(const f32x4*)(md + col); g4[i] *= sc[i]; }
#pragma unroll 2
            for (int j = 0; j < 8; ++j) { const int row = row0 + kh * 8 + j; const float rs = rsl[kh * 8 + j];
#pragma unroll
                for (int i = 0; i < 8; ++i) { const int col = i * 256 + lane * 4; const f32x4 v = *(const f32x4*)(p.XA + (size_t)row * DM + col);
                    const f32x4 h = v * rs * g4[i] + sh[i];
                    *(unsigned*)((unsigned char*)p.H + (size_t)row * DM + col) = pk4_fp8(h[0], h[1], h[2], h[3], A8_SCALE); } }
            __syncthreads();
        }
    }
}
DI void conv_gln(const Params& p, LAS unsigned char* lds) {
    const int tid = opaque_tid(), wave = tid >> 6, lane = tid & 63;
    LAS float* at = (LAS float*)lds;
    u32x4 rv[3], rg[3];
    auto load_raw = [&](int u) { const int g = u & 7, t0 = ((u >> 3) & 63) * 64, b = u >> 9;
#pragma unroll
        for (int i = 0; i < 3; ++i) { const int idx = tid + 512 * i, rr = idx >> 4, c8 = idx & 15, t = t0 - 15 + rr; rv[i] = (u32x4){0u, 0u, 0u, 0u}; rg[i] = (u32x4){0u, 0u, 0u, 0u};
            if (idx < 94 * 16 && t >= 0 && t < SEQ) { const bf16_t* row = p.G + (size_t)(b * SEQ + t) * N_IN0 + g * 128 + c8 * 8; rv[i] = *(const u32x4*)row; rg[i] = *(const u32x4*)(row + 1024); } } };
    int gcur = -1; f32x2 wk[31], bias = {0.f, 0.f}, gam = {0.f, 0.f}, bet = {0.f, 0.f};
    if ((int)blockIdx.x < 2048) load_raw(blockIdx.x);
    for (int u = blockIdx.x; u < 2048; u += gridDim.x) {
        const int g = u & 7, t0 = ((u >> 3) & 63) * 64, b = u >> 9;
        const int ch = g * 128 + 2 * lane;
        if (g != gcur) { gcur = g;
#pragma unroll
            for (int k = 0; k < 31; ++k) wk[k] = *(const f32x2*)(p.conv_w + k * 1024 + ch);
            bias = *(const f32x2*)(p.conv_b + ch); gam = *(const f32x2*)(p.conv_norm_g + ch); bet = *(const f32x2*)(p.conv_norm_b + ch); }
#pragma unroll
        for (int i = 0; i < 3; ++i) { const int idx = tid + 512 * i, rr = idx >> 4, c8 = idx & 15;
            if (idx < 94 * 16) { const u32x4 v = rv[i], gg = rg[i];
                const f32x4 lo = {bflo(v[0]) * sigmoidf_(bflo(gg[0])), bfhi(v[0]) * sigmoidf_(bfhi(gg[0])), bflo(v[1]) * sigmoidf_(bflo(gg[1])), bfhi(v[1]) * sigmoidf_(bfhi(gg[1]))};
                const f32x4 hi = {bflo(v[2]) * sigmoidf_(bflo(gg[2])), bfhi(v[2]) * sigmoidf_(bfhi(gg[2])), bflo(v[3]) * sigmoidf_(bflo(gg[3])), bfhi(v[3]) * sigmoidf_(bfhi(gg[3]))};
                *(LAS f32x4*)(at + rr * 132 + c8 * 8) = lo; *(LAS f32x4*)(at + rr * 132 + c8 * 8 + 4) = hi; } }
        __syncthreads();
        if (u + (int)gridDim.x < 2048) load_raw(u + gridDim.x);
        f32x2 acc[8];
#pragma unroll
        for (int j = 0; j < 8; ++j) acc[j] = bias;
#pragma unroll
        for (int rr = 0; rr < 38; ++rr) { const f32x2 a2 = *(const LAS f32x2*)(at + (wave * 8 + rr) * 132 + 2 * lane);
#pragma unroll
            for (int j = 0; j < 8; ++j) { const int k = rr - j; if (k >= 0 && k < 31) acc[j] += wk[k] * a2; } }
#pragma unroll
        for (int j = 0; j < 8; ++j) { const float mu = wave_sum(acc[j][0] + acc[j][1]) * (1.f / 128.f); const float d0 = acc[j][0] - mu, d1 = acc[j][1] - mu;
            const float var = wave_sum(d0 * d0 + d1 * d1) * (1.f / 128.f); const float rs = rsqrtf(var + 1e-6f);
            const float y0 = d0 * rs * gam[0] + bet[0], y1 = d1 * rs * gam[1] + bet[1];
            if constexpr (D8_OUT0) *(unsigned short*)((unsigned char*)p.AO + (size_t)(b * SEQ + t0 + wave * 8 + j) * DM + ch) = (unsigned short)(pk4_fp8(siluf_(y0), siluf_(y1), 0.f, 0.f, A8_SCALE) & 0xffffu);
            else *(unsigned*)(p.AO + (size_t)(b * SEQ + t0 + wave * 8 + j) * DM + ch) = pk2(siluf_(y0), siluf_(y1)); }
        __syncthreads();
    }
}
DI unsigned off_b(unsigned row, unsigned ch) { return 256u * row + 16u * (ch ^ (((row & 3u) << 2) | ((row >> 2) & 3u))); }
DI void tr_read4(unsigned a0, unsigned a1, s16x4& r00, s16x4& r01, s16x4& r10, s16x4& r11) {
    asm volatile("ds_read_b64_tr_b16 %0, %4\n\tds_read_b64_tr_b16 %1, %5\n\tds_read_b64_tr_b16 %2, %4 offset:4096\n\tds_read_b64_tr_b16 %3, %5 offset:4096\n\ts_waitcnt lgkmcnt(0)"
                 : "=&v"(r00), "=&v"(r01), "=&v"(r10), "=&v"(r11) : "v"(a0), "v"(a1) : "memory");
}
template <int PASS> DI void attn_wave(const Params& p, LAS unsigned char* vimg, unsigned vb0, unsigned vb1, int lane_, int b, int h, int qbase  ) {
    int lane = lane_; asm volatile("" : "+v"(lane));
    const int c = lane & 31, hh = lane >> 5, srow = lane >> 4, sch = lane & 15;
    constexpr int QS = PASS == 0 ? 16 : 1, NT = PASS == 0 ? 13 : 5;
    const int tq = qbase + QS * c;
    const bf16_t* gb = p.G + (size_t)(b * SEQ) * N_IN0; const bf16_t* kb = p.KVH + (size_t)((b * 8 + h) * 2) * SEQ * 128;
    float* st_o = (float*)p.YB + ((size_t)(b * 8 + h) * SEQ + tq) * 128;
    float* st_ml = (float*)p.YB + (size_t)NBATCH * 8 * SEQ * 128 + ((size_t)(b * 8 + h) * SEQ + tq) * 2;
    bf16x8 qf[8];
#pragma unroll
    for (int ks = 0; ks < 8; ++ks) qf[ks] = *(const bf16x8*)(gb + (size_t)tq * N_IN0 + 2048 + h * 128 + 16 * ks + 8 * hh);
    const float sc2 = 0.08838834764831845f * 1.4426950408889634f, sl2 = exp2f(-(float)(h + 1)) * 1.4426950408889634f;
    f32x16 o[4]; float m_run, l_run;
    if constexpr (PASS == 0) {
#pragma unroll
        for (int i = 0; i < 4; ++i)
#pragma unroll
            for (int j = 0; j < 16; ++j) o[i][j] = 0.f;
        m_run = -30000.f; l_run = 0.f;
    } else {
#pragma unroll
        for (int c4 = 0; c4 < 4; ++c4)
#pragma unroll
            for (int g4 = 0; g4 < 4; ++g4) { const f32x4 v = *(const f32x4*)(st_o + 32 * c4 + 8 * g4 + 4 * hh); o[c4][4 * g4] = v[0]; o[c4][4 * g4 + 1] = v[1]; o[c4][4 * g4 + 2] = v[2]; o[c4][4 * g4 + 3] = v[3]; }
        const f32x2 ml = *(const f32x2*)st_ml; m_run = ml[0]; l_run = hh == 0 ? ml[1] : 0.f;
    }
    auto tile_geom = [&](int tile, int& d, int& sb) { if constexpr (PASS == 0) { if (tile < 5) { d = 16; sb = qbase - 1024 + 512 * tile; } else { d = 4; sb = qbase - 256 + 128 * (tile - 5); } } else { d = 1; sb = qbase - 64 + 32 * tile; } };
    auto load_k = [&](int tile, bf16x8 (&kf)[8]) { int d, sb; tile_geom(tile, d, sb); int sp = sb + d * c; sp = sp < 0 ? 0 : (sp >= SEQ ? SEQ - 1 : sp);
        const bf16_t* src = kb + (unsigned)(sp * 128 + 8 * hh);
#pragma unroll
        for (int ks = 0; ks < 8; ++ks) kf[ks] = *(const bf16x8*)(src + 16 * ks); };
    auto load_v = [&](int tile, u32x4 (&vv)[8]) { int d, sb; tile_geom(tile, d, sb);
#pragma unroll
        for (int i = 0; i < 8; ++i) { int sp = sb + d * (srow + 4 * i); sp = sp < 0 ? 0 : (sp >= SEQ ? SEQ - 1 : sp); vv[i] = *(const u32x4*)(kb + (unsigned)(SEQ * 128 + sp * 128 + sch * 8)); } };
    bf16x8 kf[8]; u32x4 vv[8];
    load_k(0, kf); load_v(0, vv);
    for (int tile = 0; tile < NT; ++tile) {
        int d, sb; tile_geom(tile, d, sb);
        const int tn = tile < NT - 1 ? tile + 1 : NT - 1;
#pragma unroll
        for (int i = 0; i < 8; ++i) *(LAS u32x4*)(vimg + off_b(srow + 4 * i, sch)) = vv[i];
        load_v(tn, vv);
        f32x16 sacc;
#pragma unroll
        for (int j = 0; j < 16; ++j) sacc[j] = 0.f;
#pragma unroll
        for (int ks = 0; ks < 8; ++ks) sacc = __builtin_amdgcn_mfma_f32_32x32x16_bf16(kf[ks], qf[ks], sacc, 0, 0, 0);
        load_k(tn, kf);
        const float df = (float)d, basef = (float)(sb - tq) + df * (float)(4 * hh);
        const float lo = fmaxf(-64.f * df, -(float)tq), hi = fminf(64.f * df, (float)(SEQ - 1 - tq));
        const float mid = 0.5f * (lo + hi), half = 0.5f * (hi - lo);
        float tmax = -1e30f;
#pragma unroll
        for (int i = 0; i < 16; ++i) { const float deltaf = basef + df * (float)((i & 3) + 8 * (i >> 2));
            const bool valid = __builtin_fabsf(deltaf - mid) <= half;
            const float sv = valid ? sacc[i] * sc2 - sl2 * __builtin_fabsf(deltaf) : -1e30f; sacc[i] = sv; tmax = fmaxf(tmax, sv); }
        tmax = fmaxf(tmax, __shfl_xor(tmax, 32));
        const float m_new = tmax > m_run + 8.0f ? tmax : m_run;
        if (__any(m_new != m_run)) { const float alpha = __builtin_amdgcn_exp2f(m_run - m_new);
            l_run *= alpha;
#pragma unroll
            for (int i = 0; i < 4; ++i) o[i] *= alpha; }
        m_run = m_new;
        float psum = 0.f;
#pragma unroll
        for (int i = 0; i < 16; ++i) { const float pi = __builtin_amdgcn_exp2f(sacc[i] - m_new); psum += pi; sacc[i] = pi; }
        l_run += psum;
        bf16x8 pf[2];
#pragma unroll
        for (int s = 0; s < 2; ++s) { const unsigned w0 = pk2(sacc[8 * s], sacc[8 * s + 1]), w1 = pk2(sacc[8 * s + 2], sacc[8 * s + 3]), w2 = pk2(sacc[8 * s + 4], sacc[8 * s + 5]), w3 = pk2(sacc[8 * s + 6], sacc[8 * s + 7]);
            pf[s] = __builtin_bit_cast(bf16x8, (u32x4){w0, w1, w2, w3}); }
#pragma unroll
        for (int c4 = 0; c4 < 4; ++c4) {
            s16x4 r00, r01, r10, r11; tr_read4(vb0 ^ (unsigned)(c4 << 6), vb1 ^ (unsigned)(c4 << 6), r00, r01, r10, r11);
            const bf16x8 v0 = __builtin_shufflevector(r00, r01, 0, 1, 2, 3, 4, 5, 6, 7), v1 = __builtin_shufflevector(r10, r11, 0, 1, 2, 3, 4, 5, 6, 7);
            o[c4] = __builtin_amdgcn_mfma_f32_32x32x16_bf16(v0, pf[0], o[c4], 0, 0, 0);
            o[c4] = __builtin_amdgcn_mfma_f32_32x32x16_bf16(v1, pf[1], o[c4], 0, 0, 0); }
    }
    const float ltot = l_run + __shfl_xor(l_run, 32);
    if constexpr (PASS == 0) {
#pragma unroll
        for (int c4 = 0; c4 < 4; ++c4)
#pragma unroll
            for (int g4 = 0; g4 < 4; ++g4) *(f32x4*)(st_o + 32 * c4 + 8 * g4 + 4 * hh) = (f32x4){o[c4][4 * g4], o[c4][4 * g4 + 1], o[c4][4 * g4 + 2], o[c4][4 * g4 + 3]};
        if (hh == 0) *(f32x2*)st_ml = (f32x2){m_run, ltot};
    } else {
        const float inv = 1.0f / ltot;
        bf16_t* orow = p.AO + (size_t)(b * SEQ + tq) * DM + 1024 + h * 128;
#pragma unroll
        for (int c4 = 0; c4 < 4; ++c4)
#pragma unroll
            for (int g4 = 0; g4 < 4; ++g4) { const int dh = 32 * c4 + 8 * g4 + 4 * hh;
                if constexpr (D8_OUT0) *(unsigned*)((unsigned char*)p.AO + (size_t)(b * SEQ + tq) * DM + 1024 + h * 128 + dh) = pk4_fp8(o[c4][4 * g4] * inv, o[c4][4 * g4 + 1] * inv, o[c4][4 * g4 + 2] * inv, o[c4][4 * g4 + 3] * inv, A8_SCALE);
                else *(uint2*)(orow + dh) = make_uint2(pk2(o[c4][4 * g4] * inv, o[c4][4 * g4 + 1] * inv), pk2(o[c4][4 * g4 + 2] * inv, o[c4][4 * g4 + 3] * inv)); }
    }
}
DI void attention(const Params& p, LAS unsigned char* lds) {
    const int tid = opaque_tid(), wave = __builtin_amdgcn_readfirstlane(tid >> 6), lane = tid & 63, hh = lane >> 5;
    LAS unsigned char* vimg = lds + wave * 8192;
    const unsigned vbase = (unsigned)(uintptr_t)vimg;
    const int q4 = (lane & 15) >> 2, pp = lane & 3, blk = (lane >> 4) & 1;
    const unsigned vb0 = vbase + 256u * (4 * hh + q4) + 16u * ((2 * blk + (pp >> 1)) ^ (hh & 3)) + 8u * (pp & 1) + ((unsigned)q4 << 6);
    const unsigned vb1 = vbase + 256u * (8 + 4 * hh + q4) + 16u * ((2 * blk + (pp >> 1)) ^ ((2 + hh) & 3)) + 8u * (pp & 1) + ((unsigned)q4 << 6);
    for (int u = blockIdx.x; u < 256; u += gridDim.x) {
        const int bh = (u & 7) * 4 + ((u >> 3) >> 3), span = (u >> 3) & 7, h = bh & 7, b = bh >> 3;
#pragma unroll 1
        for (int j = 0; j < 2; ++j) attn_wave<0>(p, vimg, vb0, vb1, lane, b, h, span * 512 + wave * 2 + j);
        asm volatile("s_waitcnt vmcnt(0)" ::: "memory");
        __syncthreads();
#pragma unroll 1
        for (int j = 0; j < 2; ++j) attn_wave<1>(p, vimg, vb0, vb1, lane, b, h, span * 512 + (wave * 2 + j) * 32);
        __syncthreads();
    }
}
DI float om_exp2x(float la, float a) {
    const float x = 2.f * la;
    const float pl = x * (1.f + x * (0.5f + x * (0.16666667f + x * (0.041666668f + x * 0.008333334f))));
    return x > -0.25f ? -pl : 1.f - a * a;
}
DI void lru_conv(const Params& p) {
    const int tid = opaque_tid();
    if (tid < 336) {
        const int ch = tid * 8;
        float cw[4][8], cb[8];
#pragma unroll
        for (int j = 0; j < 4; ++j) { const f32x4 w0 = *(const f32x4*)(p.lru_conv_w + j * LRU_W + ch), w1 = *(const f32x4*)(p.lru_conv_w + j * LRU_W + ch + 4);
            cw[j][0] = w0[0]; cw[j][1] = w0[1]; cw[j][2] = w0[2]; cw[j][3] = w0[3]; cw[j][4] = w1[0]; cw[j][5] = w1[1]; cw[j][6] = w1[2]; cw[j][7] = w1[3]; }
        { const f32x4 b0 = *(const f32x4*)(p.lru_conv_b + ch), b1 = *(const f32x4*)(p.lru_conv_b + ch + 4); cb[0] = b0[0]; cb[1] = b0[1]; cb[2] = b0[2]; cb[3] = b0[3]; cb[4] = b1[0]; cb[5] = b1[1]; cb[6] = b1[2]; cb[7] = b1[3]; }
        for (int run = blockIdx.x; run < T_TOK / 32; run += gridDim.x) {
            const int tok0 = run * 32, t0 = tok0 % SEQ;
            const bf16_t* src = p.G + (size_t)tok0 * N_IN1 + LRU_W + ch;
            u32x4 rows[35];
#pragma unroll
            for (int i = 0; i < 35; ++i) { const int t = t0 - 2 + i; rows[i] = (t >= 0 && t < SEQ) ? *(const u32x4*)(src + (ptrdiff_t)(i - 2) * N_IN1) : (u32x4){0u, 0u, 0u, 0u}; }
#pragma unroll
            for (int i = 0; i < 32; ++i) { float xc[8];
#pragma unroll
                for (int e = 0; e < 8; ++e) xc[e] = cb[e];
#pragma unroll
                for (int j = 0; j < 4; ++j) { const u32x4 xv = rows[i + j];
                    xc[0] += cw[j][0] * bflo(xv[0]); xc[1] += cw[j][1] * bfhi(xv[0]); xc[2] += cw[j][2] * bflo(xv[1]); xc[3] += cw[j][3] * bfhi(xv[1]);
                    xc[4] += cw[j][4] * bflo(xv[2]); xc[5] += cw[j][5] * bfhi(xv[2]); xc[6] += cw[j][6] * bflo(xv[3]); xc[7] += cw[j][7] * bfhi(xv[3]); }
                *(u32x4*)(p.XC + (size_t)(tok0 + i) * LRU_W + ch) = (u32x4){pk2(xc[0], xc[1]), pk2(xc[2], xc[3]), pk2(xc[4], xc[5]), pk2(xc[6], xc[7])}; }
        }
    }
}
DI void lru(const Params& p, LAS unsigned char* lds) {
    const int tid = opaque_tid(), wave = __builtin_amdgcn_readfirstlane(tid >> 6), lane = tid & 63, col = lane & 15, g = lane >> 4;
    LAS unsigned char* wl = lds;
    LAS unsigned char* xs = lds + 36864;
    LAS float* sums = (LAS float*)(lds + 36864 + 86016);
    LAS float* cst = sums + 1536;
    for (int u = blockIdx.x; u < 256; u += gridDim.x) {
        const int b = u >> 6, n = (u >> 2) & 15, qt = u & 3, chq = n * LRU_BW + qt * 42;
        const char* xcb = (const char*)(p.XC + (size_t)(b * SEQ) * LRU_W + n * LRU_BW);
        const bf16_t* gb = p.G + (size_t)(b * SEQ) * N_IN1;
        unsigned poff[6];
#pragma unroll
        for (int i = 0; i < 6; ++i) { const int idx = tid + 512 * i; poff[i] = (unsigned)((idx / 21) * LRU_W + (idx % 21) * 8) * 2u; }
        auto dma_chunk = [&](int chunk, int bsel) { const char* src = xcb + (size_t)chunk * 128 * LRU_W * 2; LAS unsigned char* dst = xs + bsel * 43008 + wave * 1024;
#pragma unroll
            for (int i = 0; i < 5; ++i) __builtin_amdgcn_global_load_lds((const unsigned*)(src + poff[i]), (LAS unsigned*)(dst + i * 8192), 16, 0, 0);
            if (wave < 2) __builtin_amdgcn_global_load_lds((const unsigned*)(src + poff[5]), (LAS unsigned*)(dst + 5 * 8192), 16, 0, 0); };
        for (int dir = 0; dir < 2; ++dir) {
            __syncthreads();
            for (int i = tid; i < 2 * 48 * 24; i += 512) { const int which = i / (48 * 24), r = (i / 24) % 48, ck = i % 24; const int nt = r >> 4, cl = r & 15, ks = ck >> 2, gg = ck & 3;
                *(LAS u32x4*)(wl + ((which * 3 + nt) * 6 + ks) * 1024 + (gg * 16 + cl) * 16) = *(const u32x4*)(p.w_lru + ((((size_t)(dir * 2 + which) * 16 + n) * 4 + qt) * 48 + r) * 192 + ck * 8); }
            if (tid < 48) { const bool valid = tid < 42; const int ch = dir * LRU_W + chq + tid;
                cst[tid] = valid ? p.lru_b_a[ch] : 0.f; cst[48 + tid] = valid ? p.lru_b_x[ch] : 0.f;
                const float lam = valid ? p.lru_lambda[ch] : 0.f; const float sp = (-lam > 20.f) ? -lam : log1pf(__expf(-lam)); cst[96 + tid] = -8.0f * sp; }
            dma_chunk(dir == 0 ? 0 : 31, 0);
            asm volatile("s_waitcnt vmcnt(0)" ::: "memory");
            __syncthreads();
            float cba[3], cbx[3], cex[3];
#pragma unroll
            for (int nt = 0; nt < 3; ++nt) { cba[nt] = cst[nt * 16 + col]; cbx[nt] = cst[48 + nt * 16 + col]; cex[nt] = cst[96 + nt * 16 + col]; }
            float carry[3] = {0.f, 0.f, 0.f};
            for (int step = 0; step < 32; ++step) {
                const int c = dir == 0 ? step : 31 - step, c0 = c * 128, par = step & 1;
                const bool has_next = step < 31;
                if (has_next) dma_chunk(dir == 0 ? c + 1 : c - 1, par ^ 1);
                LAS unsigned char* xb = xs + par * 43008;
                uint2 hfv[3] = {make_uint2(0u, 0u), make_uint2(0u, 0u), make_uint2(0u, 0u)}; unsigned short gtv[3][4];
                const uint2* hfp = (const uint2*)p.HF + ((size_t)((u * 32 + c) * 8 + wave) * 3) * 64 + lane;
                if (dir == 1) {
#pragma unroll
                    for (int nt = 0; nt < 3; ++nt) { hfv[nt] = hfp[nt * 64];
#pragma unroll
                        for (int r = 0; r < 4; ++r) gtv[nt][r] = (nt * 16 + col < 42) ? gb[(size_t)(c0 + wave * 16 + 4 * g + r) * N_IN1 + chq + nt * 16 + col] : (unsigned short)0; } }
                bf16x8 af[6];
#pragma unroll
                for (int ks = 0; ks < 6; ++ks) { const int ch0 = 32 * ks + 8 * g; const bool kval = ch0 < LRU_BW; const int chl0 = kval ? ch0 : 160;
                    const u32x4 xv = *(const LAS u32x4*)(xb + (wave * 16 + col) * 336 + chl0 * 2);
                    af[ks] = __builtin_bit_cast(bf16x8, kval ? xv : (u32x4){0u, 0u, 0u, 0u}); }
                f32x4 acc[2][3];
#pragma unroll
                for (int w2 = 0; w2 < 2; ++w2)
#pragma unroll
                    for (int nt = 0; nt < 3; ++nt) { acc[w2][nt] = (f32x4){0.f, 0.f, 0.f, 0.f};
#pragma unroll
                        for (int ks = 0; ks < 6; ++ks) { const bf16x8 bfr = *(const LAS bf16x8*)(wl + ((w2 * 3 + nt) * 6 + ks) * 1024 + lane * 16);
                            acc[w2][nt] = __builtin_amdgcn_mfma_f32_16x16x32_bf16(af[ks], bfr, acc[w2][nt], 0, 0, 0); } }
                float hl[3][4], Pl[3][4];
#pragma unroll
                for (int nt = 0; nt < 3; ++nt) { const int chl = nt * 16 + col;
                    float av[4], uv[4];
#pragma unroll
                    for (int r = 0; r < 4; ++r) { const float za = acc[0][nt][r] + cba[nt], zx = acc[1][nt][r] + cbx[nt];
                        const float rg = sigmoidf_(za), ig = sigmoidf_(zx); const float la = cex[nt] * rg; const float a = __expf(la);
                        const float xcv = bf2f(*(const LAS bf16_t*)(xb + (wave * 16 + 4 * g + r) * 336 + (qt * 42 + chl) * 2));
                        av[r] = a; uv[r] = __builtin_amdgcn_sqrtf(om_exp2x(la, a)) * ig * xcv; }
                    float h[4], P[4], A, H;
                    if (dir == 0) { h[0] = uv[0]; P[0] = av[0];
#pragma unroll
                        for (int r = 1; r < 4; ++r) { h[r] = av[r] * h[r - 1] + uv[r]; P[r] = av[r] * P[r - 1]; }
                        A = P[3]; H = h[3];
                        { const float A1 = __shfl_up(A, 16), H1 = __shfl_up(H, 16); if (g >= 1) { H = A * H1 + H; A = A * A1; } }
                        { const float A2 = __shfl_up(A, 32), H2 = __shfl_up(H, 32); if (g >= 2) { H = A * H2 + H; A = A * A2; } }
                        float Ae = __shfl_up(A, 16), He = __shfl_up(H, 16); if (g == 0) { Ae = 1.f; He = 0.f; }
                        const float At = __shfl(A, 48 + col), Ht = __shfl(H, 48 + col);
#pragma unroll
                        for (int r = 0; r < 4; ++r) { hl[nt][r] = h[r] + P[r] * He; Pl[nt][r] = P[r] * Ae; }
                        if (g == 3) *(LAS f32x2*)(sums + ((par * 8 + wave) * 48 + chl) * 2) = (f32x2){At, Ht};
                    } else { h[3] = uv[3]; P[3] = av[3];
#pragma unroll
                        for (int r = 2; r >= 0; --r) { h[r] = av[r] * h[r + 1] + uv[r]; P[r] = av[r] * P[r + 1]; }
                        A = P[0]; H = h[0];
                        { const float A1 = __shfl_down(A, 16), H1 = __shfl_down(H, 16); if (g <= 2) { H = A * H1 + H; A = A * A1; } }
                        { const float A2 = __shfl_down(A, 32), H2 = __shfl_down(H, 32); if (g <= 1) { H = A * H2 + H; A = A * A2; } }
                        float Ae = __shfl_down(A, 16), He = __shfl_down(H, 16); if (g == 3) { Ae = 1.f; He = 0.f; }
                        const float At = __shfl(A, col), Ht = __shfl(H, col);
#pragma unroll
                        for (int r = 0; r < 4; ++r) { hl[nt][r] = h[r] + P[r] * He; Pl[nt][r] = P[r] * Ae; }
                        if (g == 0) *(LAS f32x2*)(sums + ((par * 8 + wave) * 48 + chl) * 2) = (f32x2){At, Ht};
                    }
                }
                asm volatile("s_waitcnt vmcnt(0)" ::: "memory");
                __syncthreads();
#pragma unroll
                for (int nt = 0; nt < 3; ++nt) { const int chl = nt * 16 + col; float C = carry[nt], Cw = 0.f;
#pragma unroll
                    for (int k = 0; k < 8; ++k) { const int w2 = dir == 0 ? k : 7 - k; const f32x2 sv = *(const LAS f32x2*)(sums + ((par * 8 + w2) * 48 + chl) * 2);
                        if (w2 == wave) Cw = C; C = sv[0] * C + sv[1]; }
                    carry[nt] = C;
                    float hv[4];
#pragma unroll
                    for (int r = 0; r < 4; ++r) hv[r] = hl[nt][r] + Pl[nt][r] * Cw;
                    if (dir == 0) ((uint2*)p.HF)[((size_t)((u * 32 + c) * 8 + wave) * 3 + nt) * 64 + lane] = make_uint2(pk2(hv[0], hv[1]), pk2(hv[2], hv[3]));
                    else if (chl < 42) { const float ff[4] = {bflo(hfv[nt].x), bfhi(hfv[nt].x), bflo(hfv[nt].y), bfhi(hfv[nt].y)};
#pragma unroll
                        for (int r = 0; r < 4; ++r) p.AO[(size_t)(b * SEQ + c0 + wave * 16 + 4 * g + r) * LRU_W + chq + chl] = f2bf(bf2f(gtv[nt][r]) * (ff[r] + hv[r])); }
                }
            }
        }
    }
}
}

#define XB_TMO      128
#define XB_XCNT(j)  (256  + 64 * (j))
#define XB_XSUB(j)  (1280 + 64 * (j))
#define XB_XGEN(j)  (2304 + 64 * (j))
#define XB_TOP      3328
#define XB_TOPGEN   3392
#define XCD_BAR_WORDS 3456
#define XB_SPIN_CAP (1u << 18)

__device__ __forceinline__ unsigned xb_ld(unsigned* p)              { return __hip_atomic_load(p, __ATOMIC_RELAXED, __HIP_MEMORY_SCOPE_AGENT); }
__device__ __forceinline__ unsigned xb_add(unsigned* p, unsigned v) { return __hip_atomic_fetch_add(p, v, __ATOMIC_RELAXED, __HIP_MEMORY_SCOPE_AGENT); }
__device__ __forceinline__ unsigned xb_xcc_id() { return (unsigned)__builtin_amdgcn_s_getreg((3 << 11) | 20) & 0xFu; }
#define XB_SPIN(cond, bar) do { unsigned _sp = 0; while (cond) { __builtin_amdgcn_s_sleep(1); \
    if ((++_sp & 255u) == 0u) { if (xb_ld(&(bar)[XB_TMO])) break; if (_sp > XB_SPIN_CAP) { atomicAdd(&(bar)[XB_TMO], 1u); break; } } } } while (0)

struct XcdBarrier {
    unsigned* bar; unsigned x;
    volatile LAS unsigned* st;
};

__device__ __forceinline__ XcdBarrier xcd_barrier_post(unsigned* bar, volatile LAS unsigned* st) {
    XcdBarrier b; b.bar = bar; b.x = xb_xcc_id(); b.st = st;
    if (threadIdx.x == 0) (void)xb_add(&bar[XB_XCNT(b.x)], 1u);
    return b;
}
__device__ __forceinline__ void xcd_barrier_complete(unsigned* bar, unsigned x, unsigned& nloc, unsigned& nx) {
    const unsigned G = gridDim.x * gridDim.y * gridDim.z;
    unsigned sum, cnt, mine, sp = 0u;
    for (;;) {
        sum = 0u; cnt = 0u; mine = 0u;
#pragma unroll
        for (unsigned j = 0; j < 16; ++j) { const unsigned c = xb_ld(&bar[XB_XCNT(j)]); sum += c; cnt += (c > 0u) ? 1u : 0u; mine = (j == x) ? c : mine; }
        if (sum == G) break;
        __builtin_amdgcn_s_sleep(1);
        if ((++sp & 255u) == 0u) { if (xb_ld(&bar[XB_TMO])) break; if (sp > XB_SPIN_CAP) { atomicAdd(&bar[XB_TMO], 1u); break; } }
    }
    nloc = mine > 0u ? mine : 1u; nx = cnt > 0u ? cnt : 1u;
}

__device__ __forceinline__ void xcd_barrier(const XcdBarrier& b) {
    asm volatile("s_waitcnt vmcnt(0)" ::: "memory");
    __syncthreads();
    if (threadIdx.x == 0) {
        unsigned* bar = b.bar;
        __builtin_amdgcn_s_waitcnt(0);
        unsigned nloc = b.st[0], nx = b.st[1];
        if (nloc == 0u) { xcd_barrier_complete(bar, b.x, nloc, nx); b.st[0] = nloc; b.st[1] = nx; }
        const unsigned old = xb_add(&bar[XB_XSUB(b.x)], 1u);
        const unsigned gen = old / nloc;
        if (old + 1u == (gen + 1u) * nloc) {
            __builtin_amdgcn_fence(__ATOMIC_RELEASE, "agent");
            asm volatile("s_waitcnt vmcnt(0)" ::: "memory");
            const unsigned og = xb_add(&bar[XB_TOP], 1u);
            const unsigned tg = og / nx;
            if (og + 1u == (tg + 1u) * nx) xb_add(&bar[XB_TOPGEN], 1u);
            else XB_SPIN(xb_ld(&bar[XB_TOPGEN]) == tg, bar);
            __builtin_amdgcn_fence(__ATOMIC_ACQUIRE, "agent");
            xb_add(&bar[XB_XGEN(b.x)], 1u);
            asm volatile("s_waitcnt vmcnt(0)" ::: "memory");
        } else {
            XB_SPIN(xb_ld(&bar[XB_XGEN(b.x)]) == gen, bar);
            __builtin_amdgcn_fence(__ATOMIC_ACQUIRE, "agent");
            asm volatile("s_waitcnt vmcnt(0)" ::: "memory");
        }
    }
    __syncthreads();
}


constexpr int PROBE = 0;
constexpr int LDS_XB_OFF = gm::STAGE_BYTES + 1024;
constexpr int LDS_TOTAL = LDS_XB_OFF + 16;
__global__ void __launch_bounds__(512, 2) mega(Params p) {
    LAS unsigned char* lds = (LAS unsigned char*)dyn_smem;
    LAS int* tab = (LAS int*)(lds + gm::TAB_OFF);
    volatile LAS unsigned* xbw = (volatile LAS unsigned*)(lds + LDS_XB_OFF);
    if (threadIdx.x == 0) { xbw[0] = 0u; xbw[1] = 0u; xbw[2] = 0u; xbw[3] = 0u; }
    __syncthreads();
    XcdBarrier bar = xcd_barrier_post(p.bar, xbw);
    ph::mods(p, lds);
    if constexpr (PROBE == 14) { ph::mods(p, lds); ph::mods(p, lds); }
    xcd_barrier(bar);
    { const int c = blockIdx.x, G = gridDim.x;
      ph::transposer(p, lds, c, c < 320 ? (320 - c + G - 1) / G : 0, G); __syncthreads();
      ph::transposer(p, lds, 320 + c, c < 632 ? (632 - c + G - 1) / G : 0, G); __syncthreads(); }
    ph::lru_weights(p);
    ph::fold_router(p);
    ph::norm_rows<0, D8_IN0>(p, p.x, p.norm0_mix, 0, 0, nullptr);
    xcd_barrier(bar);
    { const int c = blockIdx.x, G = gridDim.x; const int tcount = c < 6144 ? (6144 - c + G - 1) / G : 0; const bool t_first = ((c >> 3) & 1) != 0;
      if (t_first) { ph::transposer(p, lds, 952 + c, tcount, G); __syncthreads(); }
      { gm::DenseSched S; S.init(T_TOK, N_IN0); EpiIn0 e; e.xin = nullptr; e.lgate = 0; if constexpr (D8_IN0) gm::gemm_phase<EpiIn0, gm::DenseSched, true>(lds, p, p.H, p.w_in0t, 0, DM / 2, S, e, W8_E8M0, A8_E8M0); else gm::gemm_phase(lds, p, p.H, p.w_in0t, 0, DM, S, e); }
      if (!t_first) { __syncthreads(); ph::transposer(p, lds, 952 + c, tcount, G); }
      if constexpr (PROBE == 21) { __syncthreads(); ph::transposer(p, lds, 952 + c, tcount, G); }
      if constexpr (PROBE == 24) { __syncthreads(); if (t_first) ph::transposer(p, lds, 952 + c, tcount, G); }
      if constexpr (PROBE == 23) { __syncthreads(); if (t_first) { ph::transposer(p, lds, 952 + c, tcount, G); __syncthreads(); }
        { gm::DenseSched S; S.init(T_TOK, N_IN0); EpiIn0 e; e.xin = nullptr; e.lgate = 0; gm::gemm_phase<EpiIn0, gm::DenseSched, true>(lds, p, p.H, p.w_in0t, 0, DM / 2, S, e, W8_E8M0, A8_E8M0); }
        if (!t_first) { __syncthreads(); ph::transposer(p, lds, 952 + c, tcount, G); } }
      if constexpr (PROBE == 20) { __syncthreads(); gm::DenseSched S; S.init(T_TOK, N_IN0); EpiIn0 e; e.xin = nullptr; e.lgate = 0; gm::gemm_phase<EpiIn0, gm::DenseSched, true>(lds, p, p.H, p.w_in0t, 0, DM / 2, S, e, W8_E8M0, A8_E8M0); } }
    xcd_barrier(bar);
    ph::attention(p, lds);
    if constexpr (PROBE == 4) ph::attention(p, lds);
    __syncthreads();
    ph::conv_gln(p, lds);
    if constexpr (PROBE == 5) ph::conv_gln(p, lds);
    xcd_barrier(bar);
    { gm::DenseSched S; S.init(T_TOK, DM); EpiOut e; e.xin = p.x; e.lgate = 0; if constexpr (D8_OUT0) gm::gemm_phase<EpiOut, gm::DenseSched, true>(lds, p, p.AO, p.w_out0t, 0, DM / 2, S, e, W8_E8M0, A8_E8M0); else gm::gemm_phase(lds, p, p.AO, p.w_out0t, 0, DM, S, e); }
    xcd_barrier(bar);
    ph::router<false, true>(p, 0, lds, p.norm0_ffn, 1);
    if constexpr (PROBE == 12) { ph::router<true>(p, 0, lds); ph::router<true>(p, 0, lds); }
    xcd_barrier(bar);
    if constexpr (PROBE == 11) { xcd_barrier(bar); xcd_barrier(bar); xcd_barrier(bar); xcd_barrier(bar); xcd_barrier(bar); xcd_barrier(bar); xcd_barrier(bar); xcd_barrier(bar); xcd_barrier(bar); xcd_barrier(bar); }
    gm::moe_tables(tab, p.cnt);
    { gm::MoeSched<true> S; S.init(tab); EpiGU e; e.xin = nullptr; e.lgate = 0; gm::gemm_phase<EpiGU, gm::MoeSched<true>, true>(lds, p, p.H, p.w_gut0, (size_t)2048 * (DM / 2), DM / 2, S, e, W8_E8M0, A8_E8M0); if constexpr (PROBE == 3) gm::gemm_phase<EpiGU, gm::MoeSched<true>, true>(lds, p, p.H, p.w_gut0, (size_t)2048 * (DM / 2), DM / 2, S, e, W8_E8M0, A8_E8M0); }
    xcd_barrier(bar);
    { gm::MoeSched<false> S; S.init(tab); EpiDown e; e.xin = nullptr; e.lgate = 0; gm::gemm_phase<EpiDown, gm::MoeSched<false>, true>(lds, p, p.ACT, p.w_dt0, (size_t)DM * (EFF / 2), EFF / 2, S, e, W8_E8M0, A8_E8M0); if constexpr (PROBE == 8) gm::gemm_phase<EpiDown, gm::MoeSched<false>, true>(lds, p, p.ACT, p.w_dt0, (size_t)DM * (EFF / 2), EFF / 2, S, e, W8_E8M0, A8_E8M0); }
    xcd_barrier(bar);
    ph::norm_rows<1, D8_IN1>(p, p.XA, p.norm1_mix, 2, 1, tab);
    xcd_barrier(bar);
    { const int c = blockIdx.x, G = gridDim.x; int tfirst, tcount, tstride;
      if (G == 256) { tstride = 1; if (c < 64) { tcount = 18; tfirst = 18 * c; } else { tcount = 26; tfirst = 1152 + 26 * (c - 64); } }
      else { tstride = G; tfirst = c; tcount = c < 6144 ? (6144 - c + G - 1) / G : 0; }
      const bool t_first = ((c >> 3) & 1) != 0;
      if (t_first) { ph::transposer(p, lds, 7096 + tfirst, tcount, tstride); __syncthreads(); }
      { gm::DenseSched S; S.init(T_TOK, N_IN1); EpiIn1 e; e.xin = nullptr; e.lgate = 0; gm::gemm_phase(lds, p, p.H, p.w_in1t, 0, DM, S, e); }
      if (!t_first) { __syncthreads(); ph::transposer(p, lds, 7096 + tfirst, tcount, tstride); } }
    xcd_barrier(bar);
    ph::lru_conv(p);
    if constexpr (PROBE == 9) { ph::lru_conv(p); ph::lru_conv(p); }
    xcd_barrier(bar);
    ph::lru(p, lds);
    if constexpr (PROBE == 6) ph::lru(p, lds);
    xcd_barrier(bar);
    { gm::DenseSched S; S.init(T_TOK, DM); EpiOut e; e.xin = p.XA; e.lgate = 2; gm::gemm_phase(lds, p, p.AO, p.w_out1t, 0, LRU_W, S, e); }
    xcd_barrier(bar);
    ph::router<false, true>(p, 1, lds, p.norm1_ffn, 3);
    xcd_barrier(bar);
    gm::moe_tables(tab, p.cnt + 32);
    { gm::MoeSched<true> S; S.init(tab); EpiGU e; e.xin = nullptr; e.lgate = 0; gm::gemm_phase<EpiGU, gm::MoeSched<true>, true>(lds, p, p.H, p.w_gut1, (size_t)2048 * (DM / 2), DM / 2, S, e, W8_E8M0, A8_E8M0); }
    xcd_barrier(bar);
    { gm::MoeSched<false> S; S.init(tab); EpiDown e; e.xin = nullptr; e.lgate = 0; gm::gemm_phase<EpiDown, gm::MoeSched<false>, true>(lds, p, p.ACT, p.w_dt1, (size_t)DM * (EFF / 2), EFF / 2, S, e, W8_E8M0, A8_E8M0); }
    xcd_barrier(bar);
    ph::norm_rows<2>(p, p.XA, p.norm_final, 0, 3, tab);
    if constexpr (PROBE == 15) { ph::norm_rows<2>(p, p.XA, p.norm_final, 0, 3, tab); ph::norm_rows<2>(p, p.XA, p.norm_final, 0, 3, tab); }
}

static inline size_t al256(size_t x) { return (x + 255) & ~(size_t)255; }

extern "C" void kernel_launch(void* const* d_in, const int* in_sizes, int n_in, void* d_out, int out_size, void* d_ws, size_t ws_size, hipStream_t stream) {
    Params p{};
    const float** ip = (const float**)&p.x;
    for (int i = 0; i < 38; ++i) ip[i] = (const float*)d_in[i];
    p.out = (float*)d_out;
    char* w = (char*)d_ws; size_t off = 0;
    auto take = [&](size_t bytes) { char* r = w + off; off += al256(bytes); return r; };
    p.bar = (unsigned*)take(16384); p.cnt = (int*)take(256);
    const size_t zero_bytes = off;
    p.mod = (float*)take(4 * 4 * 6144 * 4); p.wrt = (float*)take((size_t)2 * 4 * 48 * 2048 * 4); p.rbias = (float*)take(2 * 4 * 48 * 4);
    p.w_in0t = (bf16_t*)take((size_t)N_IN0 * DM * 2); p.w_out0t = (bf16_t*)take((size_t)DM * DM * 2);
    p.w_gut0 = (bf16_t*)take((size_t)NEXP * 2048 * DM); p.w_dt0 = (bf16_t*)take((size_t)NEXP * DM * EFF);
    p.w_in1t = (bf16_t*)take((size_t)N_IN1 * DM * 2); p.w_out1t = (bf16_t*)take((size_t)DM * LRU_W * 2);
    p.w_gut1 = (bf16_t*)take((size_t)NEXP * 2048 * DM); p.w_dt1 = (bf16_t*)take((size_t)NEXP * DM * EFF);
    p.w_lru = (bf16_t*)take((size_t)2 * 2 * 16 * 2 * 96 * 192 * 2);
    p.H = (bf16_t*)take((size_t)T_TOK * DM * 2); p.G = (bf16_t*)take((size_t)T_TOK * N_IN1 * 2); p.AO = (bf16_t*)take((size_t)T_TOK * LRU_W * 2); p.HF = (bf16_t*)take((size_t)256 * 32 * 8 * 3 * 64 * 8);
    p.XA = (float*)take((size_t)T_TOK * DM * 4); p.ACT = (bf16_t*)take((size_t)ROWS_PAD * EFF * 2); p.YB = (bf16_t*)take((size_t)ROWS_PAD * DM * 2);
    p.XC = (bf16_t*)take((size_t)T_TOK * LRU_W * 2); p.KVH = (bf16_t*)take((size_t)NBATCH * 8 * 2 * SEQ * 128 * 2);
    p.tokl = (int*)take((size_t)NEXP * ECAP * 4); p.gatel = (float*)take((size_t)NEXP * ECAP * 4); p.asg = (int*)take((size_t)T_TOK * 2 * 4);
    if (off > ws_size) return;
    (void)hipMemsetAsync(d_ws, 0, zero_bytes, stream);
    static int grid = 0;
    if (!grid) { int dev = 0, cus = 0, per_cu = 0; (void)hipGetDevice(&dev); (void)hipDeviceGetAttribute(&cus, hipDeviceAttributeMultiprocessorCount, dev);
        (void)hipFuncSetAttribute((const void*)mega, hipFuncAttributeMaxDynamicSharedMemorySize, LDS_TOTAL);
        (void)hipOccupancyMaxActiveBlocksPerMultiprocessor(&per_cu, mega, 512, LDS_TOTAL);
        grid = cus * (per_cu < 1 ? per_cu : 1); }
    if (grid > 0) mega<<<grid, 512, LDS_TOTAL, stream>>>(p);
}
```

```cpp
#include <hip/hip_runtime.h>
#include <stdint.h>

typedef unsigned short bf16_t;
typedef float f32x4 __attribute__((ext_vector_type(4)));

#define DI __device__ __forceinline__

constexpr int T_TOK = 16384, DM = 2048, SEQ = 4096, NBATCH = 4;
constexpr int N_IN0 = 5120, N_IN1 = 5376, LRU_W = 2688, LRU_BW = 168;
constexpr int NEXP = 32, EFF = 1024, ECAP = 16384, ROWS_PAD = 40960;

DI float bf2f(bf16_t b) { return __uint_as_float(((unsigned)b) << 16); }
DI bf16_t f2bf(float f) { unsigned u = __float_as_uint(f); u += 0x7FFFu + ((u >> 16) & 1u); return (bf16_t)(u >> 16); }
DI float sigmoidf_(float x) { return __builtin_amdgcn_rcpf(1.0f + __expf(-x)); }
DI float siluf_(float x) { return x * __builtin_amdgcn_rcpf(1.0f + __expf(-x)); }
DI float gelu_tanh(float x) { const float u = 0.7978845608028654f * (x + 0.044715f * x * x * x); return x * __builtin_amdgcn_rcpf(1.0f + __expf(-2.0f * u)); }
DI float wave_sum(float v) { for (int o = 32; o > 0; o >>= 1) v += __shfl_xor(v, o); return v; }
DI float wave_max(float v) { for (int o = 32; o > 0; o >>= 1) v = fmaxf(v, __shfl_xor(v, o)); return v; }

struct Params {
    const float *x, *c;
    const float *norm0_mix, *ada0_mix_w, *ada0_mix_b, *w_in0, *conv_w, *conv_b, *conv_norm_g, *conv_norm_b, *w_out0;
    const float *norm0_ffn, *ada0_ffn_w, *ada0_ffn_b, *moe0_w_group, *moe0_w_expert, *moe0_w_gate_up, *moe0_w_down;
    const float *norm1_mix, *ada1_mix_w, *ada1_mix_b, *w_in1, *lru_conv_w, *lru_conv_b, *lru_w_a, *lru_b_a, *lru_w_x, *lru_b_x, *lru_lambda, *w_out1;
    const float *norm1_ffn, *ada1_ffn_w, *ada1_ffn_b, *moe1_w_group, *moe1_w_expert, *moe1_w_gate_up, *moe1_w_down;
    const float *norm_final;
    float* out;
    unsigned* bar; int* cnt;
    float* mod;
    float* wrt;
    float* rbias;
    bf16_t *w_in0t, *w_out0t, *w_gut0, *w_dt0, *w_in1t, *w_out1t, *w_gut1, *w_dt1, *w_lru;
    bf16_t *H, *G, *AO, *HF, *ACT, *YB, *XC, *KVH;
    bf16_t* XA;
    int* tokl; float* gatel; int* asg;
};

constexpr bool YB8_E = true;
struct GUnit { int rowbase; int nvalid; int e; const int* gather; };
struct GArgs { const bf16_t* A; const bf16_t* Bt; size_t bt_estride; long long lda, K, moe_layer; const float* xin; long long lgate; };
typedef unsigned u32x4_ __attribute__((ext_vector_type(4)));
typedef __bf16 bf2v_ __attribute__((ext_vector_type(2)));
typedef float f32x2_ __attribute__((ext_vector_type(2)));
DI unsigned pk2e(float a, float b) { f32x2_ v = {a, b}; bf2v_ r = __builtin_convertvector(v, bf2v_); return __builtin_bit_cast(unsigned, r); }
DI u32x4_ pack8(f32x4 a, f32x4 b) { return (u32x4_){pk2e(a[0], a[1]), pk2e(a[2], a[3]), pk2e(b[0], b[1]), pk2e(b[2], b[3])}; }
struct EpiIn0 { static constexpr bool GATHER = false; const float* xin; int lgate; DI void operator()(const Params& p, const GUnit& u, int r, int col0, f32x4 lo0, f32x4 lo1, f32x4 hi0, f32x4 hi1) const {
    const int row = u.rowbase + r;
    if (col0 < 3072) { bf16_t* o = p.G + (size_t)row * N_IN0 + col0; *(u32x4_*)o = pack8(lo0, lo1); *(u32x4_*)(o + 128) = pack8(hi0, hi1); }
    else { const int b = row / SEQ, t = row % SEQ, i0 = (col0 - 3072) >> 7, i1 = i0 + 1;
        bf16_t* o0 = p.KVH + ((size_t)((b * 8 + (i0 & 7)) * 2 + (i0 >> 3)) * SEQ + t) * 128 + (col0 & 127);
        bf16_t* o1 = p.KVH + ((size_t)((b * 8 + (i1 & 7)) * 2 + (i1 >> 3)) * SEQ + t) * 128 + (col0 & 127);
        *(u32x4_*)o0 = pack8(lo0, lo1); *(u32x4_*)o1 = pack8(hi0, hi1); } } };
struct EpiOut { static constexpr bool GATHER = false; const float* xin; int lgate; DI void operator()(const Params& p, const GUnit& u, int r, int col0, f32x4 lo0, f32x4 lo1, f32x4 hi0, f32x4 hi1) const {
    const int row = u.rowbase + r, b = row / SEQ; const float* gt = p.mod + (lgate * 4 + b) * 6144 + 4096 + col0; bf16_t* o = p.XA + (size_t)row * DM + col0;
    f32x4 r0, r1, r2, r3;
    if (xin) { const float* xi = xin + (size_t)row * DM + col0; r0 = *(const f32x4*)xi; r1 = *(const f32x4*)(xi + 4); r2 = *(const f32x4*)(xi + 128); r3 = *(const f32x4*)(xi + 132); }
    else { const u32x4_ a = *(const u32x4_*)o, c = *(const u32x4_*)(o + 128);
        r0 = (f32x4){__uint_as_float(a[0] << 16), __uint_as_float(a[0] & 0xffff0000u), __uint_as_float(a[1] << 16), __uint_as_float(a[1] & 0xffff0000u)};
        r1 = (f32x4){__uint_as_float(a[2] << 16), __uint_as_float(a[2] & 0xffff0000u), __uint_as_float(a[3] << 16), __uint_as_float(a[3] & 0xffff0000u)};
        r2 = (f32x4){__uint_as_float(c[0] << 16), __uint_as_float(c[0] & 0xffff0000u), __uint_as_float(c[1] << 16), __uint_as_float(c[1] & 0xffff0000u)};
        r3 = (f32x4){__uint_as_float(c[2] << 16), __uint_as_float(c[2] & 0xffff0000u), __uint_as_float(c[3] << 16), __uint_as_float(c[3] & 0xffff0000u)}; }
    *(u32x4_*)o = pack8(r0 + *(const f32x4*)gt * lo0, r1 + *(const f32x4*)(gt + 4) * lo1); *(u32x4_*)(o + 128) = pack8(r2 + *(const f32x4*)(gt + 128) * hi0, r3 + *(const f32x4*)(gt + 132) * hi1); } };
DI unsigned pk4_fp8e(float a, float b, float c, float d, float sc) { a = fminf(fmaxf(a * sc, -448.f), 448.f); b = fminf(fmaxf(b * sc, -448.f), 448.f); c = fminf(fmaxf(c * sc, -448.f), 448.f); d = fminf(fmaxf(d * sc, -448.f), 448.f);
    unsigned w = 0u; w = __builtin_amdgcn_cvt_pk_fp8_f32(a, b, w, false); w = __builtin_amdgcn_cvt_pk_fp8_f32(c, d, w, true); return w; }
struct EpiGU { static constexpr bool GATHER = true; const float* xin; int lgate; DI void operator()(const Params& p, const GUnit& u, int r, int col0, f32x4 lo0, f32x4 lo1, f32x4 hi0, f32x4 hi1) const {
    f32x4 a0, a1;
#pragma unroll
    for (int j = 0; j < 4; ++j) { a0[j] = siluf_(lo0[j]) * hi0[j]; a1[j] = siluf_(lo1[j]) * hi1[j]; }
    *(uint2*)((unsigned char*)p.ACT + (size_t)(u.rowbase + r) * EFF + (col0 >> 8) * 128 + (col0 & 127)) = make_uint2(pk4_fp8e(a0[0], a0[1], a0[2], a0[3], 8.f), pk4_fp8e(a1[0], a1[1], a1[2], a1[3], 8.f)); } };
struct EpiDown { static constexpr bool GATHER = false; const float* xin; int lgate; DI void operator()(const Params& p, const GUnit& u, int r, int col0, f32x4 lo0, f32x4 lo1, f32x4 hi0, f32x4 hi1) const {
    const float g = p.gatel[(u.gather - p.tokl) + r];
    if constexpr (YB8_E) { const float gs = g * 64.f; unsigned char* o = (unsigned char*)p.YB + (size_t)(u.rowbase + r) * DM + col0;
        *(uint2*)o = make_uint2(pk4_fp8e(lo0[0], lo0[1], lo0[2], lo0[3], gs), pk4_fp8e(lo1[0], lo1[1], lo1[2], lo1[3], gs)); *(uint2*)(o + 128) = make_uint2(pk4_fp8e(hi0[0], hi0[1], hi0[2], hi0[3], gs), pk4_fp8e(hi1[0], hi1[1], hi1[2], hi1[3], gs)); }
    else { bf16_t* o = p.YB + (size_t)(u.rowbase + r) * DM + col0; *(u32x4_*)o = pack8(lo0 * g, lo1 * g); *(u32x4_*)(o + 128) = pack8(hi0 * g, hi1 * g); } } };
struct EpiIn1 { static constexpr bool GATHER = false; const float* xin; int lgate; DI void operator()(const Params& p, const GUnit& u, int r, int col0, f32x4 lo0, f32x4 lo1, f32x4 hi0, f32x4 hi1) const {
    bf16_t* o = p.G + (size_t)(u.rowbase + r) * N_IN1 + col0;
    if (col0 < LRU_W) {
#pragma unroll
        for (int j = 0; j < 4; ++j) { lo0[j] = gelu_tanh(lo0[j]); lo1[j] = gelu_tanh(lo1[j]); } }
    if (col0 + 128 < LRU_W) {
#pragma unroll
        for (int j = 0; j < 4; ++j) { hi0[j] = gelu_tanh(hi0[j]); hi1[j] = gelu_tanh(hi1[j]); } }
    *(u32x4_*)o = pack8(lo0, lo1); *(u32x4_*)(o + 128) = pack8(hi0, hi1); } };

#define LAS __attribute__((address_space(3)))
typedef short bf16x8 __attribute__((ext_vector_type(8)));
DI int opaque_tid() { int t = threadIdx.x; asm volatile("" : "+v"(t)); return t; }
namespace gm {
constexpr int BM = 256, BK = 64, HALF = 128, HTB = HALF * BK * 2, STAGE_BYTES = 8 * HTB, NXCD = 8, WGM = 4;
constexpr int TAB_OFF = STAGE_BYTES;
DI int lds_byte(int r, int c) { const int st = (r >> 4) * 2 + (c >> 5), rr = r & 15, cc = c & 31, ob = rr * 64 + cc * 2; return st * 1024 + (ob ^ (((ob >> 9) & 1) << 5)); }
DI int perm32(int rho) { const int n = rho >> 4, i = rho & 15; return 8 * (i >> 2) + 4 * n + (i & 3); }
DI void stage_rc(int b, int& R, int& C) { const int st = b / 1024, sb = b % 1024, swz = sb ^ (((sb >> 9) & 1) << 5); R = (st >> 1) * 16 + swz / 64; C = (st & 1) * 32 + (swz % 64) / 2; }
struct Unit { int arow, nvalid, orow, pn, e, goff; };
struct DenseSched {
    static constexpr bool GATHER = false, HALF_SKIP = false;
    int nM, nN, nwg, G, c;
    DI void init(int M, int N) { nM = M / BM; nN = N / BM; nwg = nM * nN; G = gridDim.x; c = blockIdx.x; }
    DI bool next(int i, Unit& u) const {
        const long L = (long)i * G + c; if (L >= nwg) return false;
        int wgid = (int)L; { const int q = nwg / NXCD, r = nwg % NXCD, xcd = wgid % NXCD, off = wgid / NXCD; wgid = (xcd < r ? xcd * (q + 1) : r * (q + 1) + (xcd - r) * q) + off; }
        const int nig = WGM * nN, gid = wgid / nig, fm = gid * WGM, gsz = (nM - fm) < WGM ? (nM - fm) : WGM;
        const int pm = fm + ((wgid % nig) % gsz); u.pn = (wgid % nig) / gsz; u.arow = pm * BM; u.orow = pm * BM; u.nvalid = BM; u.e = 0; u.goff = 0; return true;
    }
};
template <bool GATH> struct MoeSched {
    static constexpr bool GATHER = GATH, HALF_SKIP = true;
    const LAS int* tab; int G, c;
    DI void init(const LAS int* t) { tab = t; G = gridDim.x; c = blockIdx.x; }
    DI bool next(int i, Unit& u) const {
        const int L = i * G + c, mtile = L >> 3; const int total = __builtin_amdgcn_readfirstlane(tab[32]);
        if (mtile >= total) return false;
        int e = 0; for (int j = 1; j < 32; ++j) { if (__builtin_amdgcn_readfirstlane(tab[j]) <= mtile) e = j; }
        const int mt = mtile - __builtin_amdgcn_readfirstlane(tab[e]); const int cn = __builtin_amdgcn_readfirstlane(tab[64 + e]);
        u.e = e; u.pn = L & 7; u.orow = mtile * BM; u.arow = mtile * BM; u.nvalid = (cn - mt * BM) < BM ? (cn - mt * BM) : BM; u.goff = e * ECAP + mt * BM; return true;
    }
};
DI void moe_tables(LAS int* tab, const int* cnt) {
    if (threadIdx.x == 0) { int run = 0; for (int e = 0; e < 32; ++e) { const int cn = cnt[e]; tab[e] = run; tab[64 + e] = cn; run += (cn + 255) >> 8; } tab[32] = run; }
    __syncthreads();
}

typedef int i32x8 __attribute__((ext_vector_type(8)));
typedef int i32x4 __attribute__((ext_vector_type(4)));
DI void mfma8(f32x4& acc, const i32x8& w8, const i32x8& x8, int ws, int as) {
    asm volatile("v_mfma_scale_f32_16x16x128_f8f6f4 %0, %1, %2, %0, %3, %4 op_sel_hi:[0,0,0]" : "+v"(acc) : "v"(w8), "v"(x8), "v"(ws), "v"(as)); }
template <class Epi, class Sched, bool FP8 = false>
DI void gemm_phase(LAS unsigned char* lds, const Params& p, const bf16_t* A, const bf16_t* Bt, size_t bt_estride, int K, const Sched& S, const Epi& E, int wscale = 0x7f7f7f7f, int ascale = 0x7f7f7f7f) {
    const int tid = opaque_tid(), wid = __builtin_amdgcn_readfirstlane(tid >> 6), lane = tid & 63, wr = wid >> 2, wc = wid & 3, fr = lane & 15, fq = lane >> 4;
    const int nt = K / BK;
    unsigned voffA[2], voffB[2];
#pragma unroll
    for (int i = 0; i < 2; ++i) { int R, C; stage_rc(tid * 16 + i * 8192, R, C); voffA[i] = (unsigned)(R * K + C) * 2u; voffB[i] = (unsigned)(((R & ~31) + perm32(R & 31)) * K + C) * 2u; }
    const size_t kstep = (size_t)(BK * 2), hstep = (size_t)HALF * K * 2, tstep = 2 * hstep;
    const unsigned ldsw = (unsigned)wid * 1024u;
    const int aoff = lds_byte(wr * 64 + fr, fq * 8), boff = lds_byte(wc * 32 + fr, fq * 8);
#define G_SA(b, h) (((b) * 2 + (h)) * HTB)
#define G_SB(b, h) ((4 + (b) * 2 + (h)) * HTB)
#define G_STAGE(bufoff, gbase, voff) do { _Pragma("unroll") for (int _i = 0; _i < 2; ++_i) \
        __builtin_amdgcn_global_load_lds((const unsigned*)((const char*)(gbase) + (voff)[_i]), (LAS unsigned*)(lds + (bufoff) + ldsw + _i * 8192), 16, 0, 0); } while (0)
#define G_STAGE_A(bufoff, ubase, gv, h, koff) do { if constexpr (Sched::GATHER) { G_STAGE(bufoff, (const char*)A + (koff), gv[h]); } else { G_STAGE(bufoff, (ubase) + (h) * hstep + (koff), voffA); } } while (0)
#define G_LD16(off_) (*(const LAS i32x4*)(lds + (off_)))
#define G_LD16B(off_) (*(const LAS bf16x8*)(lds + (off_)))
#define G_LDA(dst, b, h) do { _Pragma("unroll") for (int m = 0; m < 4; ++m) { if constexpr (FP8) dst##8[m] = __builtin_shufflevector(G_LD16(G_SA(b, h) + aoff + m * 2048), G_LD16(G_SA(b, h) + aoff + m * 2048 + 1024), 0, 1, 2, 3, 4, 5, 6, 7); \
        else { dst[m][0] = G_LD16B(G_SA(b, h) + aoff + m * 2048); dst[m][1] = G_LD16B(G_SA(b, h) + aoff + m * 2048 + 1024); } } } while (0)
#define G_LDB(dst, b, h) do { _Pragma("unroll") for (int n = 0; n < 2; ++n) { if constexpr (FP8) dst##8[n] = __builtin_shufflevector(G_LD16(G_SB(b, h) + boff + n * 2048), G_LD16(G_SB(b, h) + boff + n * 2048 + 1024), 0, 1, 2, 3, 4, 5, 6, 7); \
        else { dst[n][0] = G_LD16B(G_SB(b, h) + boff + n * 2048); dst[n][1] = G_LD16B(G_SB(b, h) + boff + n * 2048 + 1024); } } } while (0)
#define G_MMA(ai, bj, At, Bt_) do { __builtin_amdgcn_s_setprio(1); _Pragma("unroll") for (int m = 0; m < 4; ++m) _Pragma("unroll") for (int n = 0; n < 2; ++n) { \
        if constexpr (FP8) mfma8(acc[ai][bj][m][n], Bt_##8[n], At##8[m], wscale, ascale); \
        else { _Pragma("unroll") for (int k = 0; k < 2; ++k) acc[ai][bj][m][n] = __builtin_amdgcn_mfma_f32_16x16x32_bf16(Bt_[n][k], At[m][k], acc[ai][bj][m][n], 0, 0, 0); } } \
        __builtin_amdgcn_s_setprio(0); } while (0)
#define G_WAIT_V(n) asm volatile("s_waitcnt vmcnt(" #n ")" ::: "memory")
#define G_WAIT_L(n) asm volatile("s_waitcnt lgkmcnt(" #n ")" ::: "memory")
#define G_BAR __builtin_amdgcn_s_barrier()
#define G_SCHED __builtin_amdgcn_sched_barrier(0)
    Unit cur, nxt; int ui = 0;
    if (!S.next(0, cur)) return;
    f32x4 acc[2][2][4][2];
#pragma unroll
    for (int a = 0; a < 2; ++a)
#pragma unroll
        for (int b = 0; b < 2; ++b)
#pragma unroll
            for (int m = 0; m < 4; ++m)
#pragma unroll
                for (int n = 0; n < 2; ++n) acc[a][b][m][n] = (f32x4){0.f, 0.f, 0.f, 0.f};
    bf16x8 At[4][2], B0[2][2], B1[2][2]; i32x8 At8[4], B08[2], B18[2];
    unsigned gcur[2][2] = {{0u, 0u}, {0u, 0u}}, gnxt[2][2] = {{0u, 0u}, {0u, 0u}};
    auto gather_offs = [&](const Unit& u, unsigned (&g)[2][2]) {
        if constexpr (Sched::GATHER) {
#pragma unroll
            for (int h = 0; h < 2; ++h)
#pragma unroll
                for (int i = 0; i < 2; ++i) { int tz = tid; asm volatile("" : "+v"(tz)); int R, C; stage_rc(tz * 16 + i * 8192, R, C); const int r = h * HALF + R; const int tk = p.tokl[u.goff + (r < u.nvalid ? r : 0)]; const int tok = r < u.nvalid ? tk : 0; g[h][i] = (unsigned)(tok * K + C) * 2u; }
        }
    };
    const char* cA = (const char*)A + (size_t)(cur.arow / BM) * tstep; const char* cB = (const char*)Bt + ((size_t)cur.e * bt_estride) * 2 + (size_t)cur.pn * tstep;
    gather_offs(cur, gcur);
    G_STAGE(G_SB(0, 0), cB, voffB); G_STAGE_A(G_SA(0, 0), cA, gcur, 0, 0); G_STAGE(G_SB(0, 1), cB + hstep, voffB); G_STAGE_A(G_SA(0, 1), cA, gcur, 1, 0);
    if (wr == 1) G_BAR;
    G_WAIT_V(4); G_BAR;
    G_STAGE(G_SB(1, 0), cB + kstep, voffB); G_STAGE_A(G_SA(1, 0), cA, gcur, 0, kstep); G_STAGE(G_SB(1, 1), cB + hstep + kstep, voffB);
    G_WAIT_V(6); G_BAR;
    for (;;) {
        const bool has_next = S.next(ui + 1, nxt);
        const char* nA = has_next ? (const char*)A + (size_t)(nxt.arow / BM) * tstep : cA;
        const char* nB = has_next ? (const char*)Bt + ((size_t)nxt.e * bt_estride) * 2 + (size_t)nxt.pn * tstep : cB;
        if constexpr (Sched::GATHER) { if (has_next) gather_offs(nxt, gnxt); else {
#pragma unroll
            for (int h = 0; h < 2; ++h) { gnxt[h][0] = gcur[h][0]; gnxt[h][1] = gcur[h][1]; } } }
        for (int t = 0; t < nt; t += 2) {
            const bool last = (t == nt - 2);
            const size_t k1 = (size_t)(t + 1) * kstep;
            const char* a2 = last ? nA : cA; const char* b2 = last ? nB : cB + (size_t)(t + 2) * kstep;
            const size_t k2 = last ? 0 : (size_t)(t + 2) * kstep; const size_t k3 = k2 + kstep;
            const char* b3 = b2 + kstep;
            unsigned g2[2][2];
#pragma unroll
            for (int h = 0; h < 2; ++h) { g2[h][0] = last ? gnxt[h][0] : gcur[h][0]; g2[h][1] = last ? gnxt[h][1] : gcur[h][1]; }
            G_LDB(B0, 0, 0); G_SCHED; G_LDA(At, 0, 0); G_STAGE_A(G_SA(1, 1), cA, gcur, 1, k1);
            G_WAIT_L(8); G_BAR; G_WAIT_L(0); G_MMA(0, 0, At, B0); G_BAR; G_SCHED;
            G_LDB(B1, 0, 1); G_STAGE(G_SB(0, 0), b2, voffB);
            G_BAR; G_WAIT_L(0); G_MMA(0, 1, At, B1); G_BAR;
            G_LDA(At, 0, 1); G_STAGE_A(G_SA(0, 0), a2, g2, 0, k2);
            G_BAR; G_WAIT_L(0); if (!Sched::HALF_SKIP || cur.nvalid > HALF) G_MMA(1, 0, At, B0); G_BAR; G_SCHED;
            G_STAGE(G_SB(0, 1), b2 + hstep, voffB);
            G_WAIT_V(6); G_BAR; if (!Sched::HALF_SKIP || cur.nvalid > HALF) G_MMA(1, 1, At, B1); G_BAR;
            G_LDB(B0, 1, 0); G_SCHED; G_LDA(At, 1, 0); G_STAGE_A(G_SA(0, 1), a2, g2, 1, k2);
            G_WAIT_L(8); G_BAR; G_WAIT_L(0); G_MMA(0, 0, At, B0); G_BAR; G_SCHED;
            G_LDB(B1, 1, 1); G_STAGE(G_SB(1, 0), b3, voffB);
            G_BAR; G_WAIT_L(0); G_MMA(0, 1, At, B1); G_BAR;
            G_LDA(At, 1, 1); G_STAGE_A(G_SA(1, 0), a2, g2, 0, k3);
            G_BAR; G_WAIT_L(0); if (!Sched::HALF_SKIP || cur.nvalid > HALF) G_MMA(1, 0, At, B0); G_BAR; G_SCHED;
            G_STAGE(G_SB(1, 1), b3 + hstep, voffB);
            G_WAIT_V(6); G_BAR; if (!Sched::HALF_SKIP || cur.nvalid > HALF) G_MMA(1, 1, At, B1); G_BAR;
        }
        if constexpr (FP8) asm volatile("s_nop 15\n\ts_nop 15" ::: "memory");
        { GUnit gu; gu.rowbase = cur.orow; gu.nvalid = cur.nvalid; gu.e = cur.e; gu.gather = p.tokl + cur.goff;
#pragma unroll
          for (int ai = 0; ai < 2; ++ai)
#pragma unroll
            for (int m = 0; m < 4; ++m) { const int r = ai * HALF + wr * 64 + m * 16 + fr;
              if (r < cur.nvalid) E(p, gu, r, cur.pn * BM + wc * 32 + fq * 8, acc[ai][0][m][0], acc[ai][0][m][1], acc[ai][1][m][0], acc[ai][1][m][1]); } }
        if (!has_next) break;
#pragma unroll
        for (int a = 0; a < 2; ++a)
#pragma unroll
            for (int b = 0; b < 2; ++b)
#pragma unroll
                for (int m = 0; m < 4; ++m)
#pragma unroll
                    for (int n = 0; n < 2; ++n) acc[a][b][m][n] = (f32x4){0.f, 0.f, 0.f, 0.f};
        cur = nxt; cA = nA; cB = nB; ++ui;
#pragma unroll
        for (int h = 0; h < 2; ++h) { gcur[h][0] = gnxt[h][0]; gcur[h][1] = gnxt[h][1]; }
    }
    G_WAIT_V(0);
    if (wr == 0) G_BAR;
    G_BAR;
}
}

extern __shared__ __attribute__((aligned(16))) unsigned char dyn_smem[];
constexpr int LDS_BYTES = gm::STAGE_BYTES + 1024;

typedef __bf16 bf2v __attribute__((ext_vector_type(2)));
typedef float f32x2 __attribute__((ext_vector_type(2)));
typedef float f32x16 __attribute__((ext_vector_type(16)));
typedef short s16x4 __attribute__((ext_vector_type(4)));
typedef unsigned u32x4 __attribute__((ext_vector_type(4)));
DI unsigned pk2(float a, float b) { f32x2 v = {a, b}; bf2v r = __builtin_convertvector(v, bf2v); return __builtin_bit_cast(unsigned, r); }
DI float bflo(unsigned u) { return __uint_as_float(u << 16); }
DI float bfhi(unsigned u) { return __uint_as_float(u & 0xffff0000u); }

DI unsigned pk4_fp8(float a, float b, float c, float d, float sc) {
    a = __builtin_amdgcn_fmed3f(a * sc, -448.f, 448.f); b = __builtin_amdgcn_fmed3f(b * sc, -448.f, 448.f); c = __builtin_amdgcn_fmed3f(c * sc, -448.f, 448.f); d = __builtin_amdgcn_fmed3f(d * sc, -448.f, 448.f);
    unsigned w = 0u; w = __builtin_amdgcn_cvt_pk_fp8_f32(a, b, w, false); w = __builtin_amdgcn_cvt_pk_fp8_f32(c, d, w, true); return w; }
constexpr bool D8_IN0 = true, D8_OUT0 = false, D8_IN1 = false;
constexpr bool YB8 = true;
constexpr float Y8_SCALE = 64.f;
constexpr float W8_SCALE = 256.f, A8_SCALE = 8.f;
constexpr int W8_E8M0 = 0x77777777, A8_E8M0 = 0x7c7c7c7c;
namespace ph {
DI void mods(const Params& p, LAS unsigned char* lds) {
    const int tid = opaque_tid(), wave = tid >> 6, lane = tid & 63, l8 = tid & 7, rg = tid >> 3;
    LAS float* fl = (LAS float*)lds; LAS float* red = fl + 4 * DM;
    for (int i = tid; i < 4 * DM; i += 512) fl[i] = siluf_(p.c[i]);
    __syncthreads();
    for (int u = blockIdx.x; u < 768; u += gridDim.x) {
        const int l = u / 192, c32 = u % 192;
        const float* w = l == 0 ? p.ada0_mix_w : l == 1 ? p.ada0_ffn_w : l == 2 ? p.ada1_mix_w : p.ada1_ffn_w;
        const float* bs = l == 0 ? p.ada0_mix_b : l == 1 ? p.ada0_ffn_b : l == 2 ? p.ada1_mix_b : p.ada1_ffn_b;
        f32x4 acc[4] = {{0.f, 0.f, 0.f, 0.f}, {0.f, 0.f, 0.f, 0.f}, {0.f, 0.f, 0.f, 0.f}, {0.f, 0.f, 0.f, 0.f}};
        const float* wp = w + (size_t)rg * 6144 + c32 * 32 + l8 * 4;
#pragma unroll 8
        for (int i = 0; i < 32; ++i) { const f32x4 wv = *(const f32x4*)(wp + (size_t)(64 * i) * 6144); const int k = rg + 64 * i;
#pragma unroll
            for (int b = 0; b < 4; ++b) acc[b] += fl[b * DM + k] * wv; }
#pragma unroll
        for (int b = 0; b < 4; ++b)
#pragma unroll
            for (int j = 0; j < 4; ++j) { float v = acc[b][j]; v += __shfl_xor(v, 8); v += __shfl_xor(v, 16); v += __shfl_xor(v, 32); acc[b][j] = v; }
        if (lane < 8) {
#pragma unroll
            for (int b = 0; b < 4; ++b) *(LAS f32x4*)(red + (wave * 4 + b) * 32 + lane * 4) = acc[b]; }
        __syncthreads();
        if (tid < 128) { const int b = tid >> 5, col = tid & 31; float sum = 0.f;
#pragma unroll
            for (int w8 = 0; w8 < 8; ++w8) sum += red[(w8 * 4 + b) * 32 + col];
            p.mod[(l * 4 + b) * 6144 + c32 * 32 + col] = sum + bs[c32 * 32 + col]; }
        __syncthreads();
    }
}
constexpr int NT_UNITS = (640 + 256 + 672 + 336 + 2 * (8192 + 4096)) / 2;
struct UD { const float* sp; bf16_t* dst; int K, N, mode, e, kt, ntile; };
DI UD tdecode(const Params& p, int u, int lane) {
    const float* srcs[8] = {p.w_in0, p.w_out0, p.w_in1, p.w_out1, p.moe0_w_gate_up, p.moe0_w_down, p.moe1_w_gate_up, p.moe1_w_down};
    bf16_t* dsts[8] = {p.w_in0t, p.w_out0t, p.w_in1t, p.w_out1t, p.w_gut0, p.w_dt0, p.w_gut1, p.w_dt1};
    constexpr int Ks[8] = {DM, DM, DM, LRU_W, DM, EFF, DM, EFF}, Ns[8] = {N_IN0, DM, N_IN1, DM, 2048, DM, 2048, DM}, nus[8] = {320, 128, 336, 168, 4096, 2048, 4096, 2048};
    constexpr int modes[8] = {D8_IN0 ? 2 : 0, D8_OUT0 ? 2 : 0, D8_IN1 ? 2 : 0, 0, 3, 2, 3, 2};
    int v = u, mi = 0;
#pragma unroll
    for (int m = 0; m < 8; ++m) { if (mi == m && v >= nus[m]) { v -= nus[m]; mi = m + 1; } }
    UD d; const float* src = srcs[0]; d.dst = dsts[0]; d.K = Ks[0]; d.N = Ns[0]; d.mode = modes[0];
#pragma unroll
    for (int m = 1; m < 8; ++m) if (mi == m) { src = srcs[m]; d.dst = dsts[m]; d.K = Ks[m]; d.N = Ns[m]; d.mode = modes[m]; }
    const int ntl = d.N / 256, ktl = d.K / 128; d.e = v / (ktl * ntl); const int rem = v % (ktl * ntl); d.kt = rem / ntl; d.ntile = rem % ntl;
    d.sp = src + (size_t)d.e * d.K * d.N + (size_t)(d.kt * 128) * d.N + d.ntile * 256 + lane * 4;
    return d;
}
DI void transposer(const Params& p, LAS unsigned char* lds, int first, int count, int stride) {
    const int tid = opaque_tid(), wave = tid >> 6, lane = tid & 63;
    LAS float* fl = (LAS float*)lds;
    if (count <= 0) return;
    if (tdecode(p, first, lane).mode & 2) {
        LAS unsigned* td = (LAS unsigned*)lds;
        const int nl = lane & 15, ks = lane >> 4;
        auto src_of = [&](const UD& d, int g, int j) -> const float* { const int kq = 4 * (g >> 2) + ks, nq = 16 * (g & 3) + nl; return d.sp - lane * 4 + (size_t)(4 * kq + j) * d.N + 4 * nq; };
        f32x4 va[4][4], vb[4][4];
        auto load_unit = [&](int u, f32x4 (&v)[4][4]) { const UD dd = tdecode(p, u, lane);
#pragma unroll
            for (int i = 0; i < 4; ++i)
#pragma unroll
                for (int j = 0; j < 4; ++j) v[i][j] = *(const f32x4*)src_of(dd, wave * 4 + i, j); };
        auto process = [&](int jn, f32x4 (&v)[4][4]) { const int u = first + jn * stride;
            const UD d = tdecode(p, u, lane); const int K = d.K, N = d.N, mode = d.mode, e = d.e, kt = d.kt, ntile = d.ntile;
            LAS unsigned* tile = td + (jn & 1) * (256 * 33);
#pragma unroll
            for (int i = 0; i < 4; ++i) { const int g = wave * 4 + i, kq = 4 * (g >> 2) + ks, nq = 16 * (g & 3) + nl;
#pragma unroll
                for (int en = 0; en < 4; ++en) tile[(4 * nq + en) * 33 + kq] = pk4_fp8(v[i][0][en], v[i][1][en], v[i][2][en], v[i][3][en], W8_SCALE); }
            __syncthreads();
            if (jn + 2 < count) load_unit(u + 2 * stride, v);
            { const int n = tid >> 1, kh = tid & 1; const int ng = ntile * 256 + n; const int jg = ng & 1023; const int np = (mode & 1) ? (256 * (jg >> 7) + (ng < 1024 ? 0 : 128) + (jg & 127)) : ng;
              unsigned char* dp = (unsigned char*)d.dst + (size_t)e * N * K + (size_t)np * K + kt * 128 + kh * 64;
#pragma unroll
              for (int jj = 0; jj < 4; ++jj) { const LAS unsigned* tp = tile + n * 33 + kh * 16 + jj * 4; *(uint4*)(dp + jj * 16) = make_uint4(tp[0], tp[1], tp[2], tp[3]); } } };
        load_unit(first, va); if (count > 1) load_unit(first + stride, vb);
        for (int jn = 0; jn < count; jn += 2) { process(jn, va); if (jn + 1 < count) process(jn + 1, vb); }
        __syncthreads();
        return;
    }
    f32x4 vv[16];
    { const UD d0 = tdecode(p, first, lane);
#pragma unroll
        for (int i = 0; i < 16; ++i) vv[i] = *(const f32x4*)(d0.sp + (size_t)(i * 8 + wave) * d0.N); }
    for (int j = 0; j < count; ++j) { const int u = first + j * stride;
        const UD d = tdecode(p, u, lane); const int K = d.K, N = d.N, mode = d.mode, e = d.e, kt = d.kt, ntile = d.ntile; bf16_t* dst = d.dst;
#pragma unroll
        for (int i = 0; i < 16; ++i) { LAS float* tp = fl + (i * 8 + wave) * 257 + lane * 4; tp[0] = vv[i][0]; tp[1] = vv[i][1]; tp[2] = vv[i][2]; tp[3] = vv[i][3]; }
        __syncthreads();
        if (j + 1 < count) { const UD dn = tdecode(p, u + stride, lane);
#pragma unroll
            for (int i = 0; i < 16; ++i) vv[i] = *(const f32x4*)(dn.sp + (size_t)(i * 8 + wave) * dn.N); }
        { const int n = tid >> 1, kh = tid & 1; const int ng = ntile * 256 + n; const int jg = ng & 1023; const int np = (mode & 1) ? (256 * (jg >> 7) + (ng < 1024 ? 0 : 128) + (jg & 127)) : ng;
          bf16_t* dp = dst + (size_t)e * N * K + (size_t)np * K + kt * 128 + kh * 64;
#pragma unroll
          for (int jj = 0; jj < 8; ++jj) { unsigned w4[4];
#pragma unroll
              for (int q = 0; q < 4; ++q) { const int k = kh * 64 + jj * 8 + q * 2; w4[q] = pk2(fl[k * 257 + n], fl[(k + 1) * 257 + n]); }
              *(uint4*)(dp + jj * 8) = make_uint4(w4[0], w4[1], w4[2], w4[3]); } }
        __syncthreads();
    }
}
DI void lru_weights(const Params& p) {
    const int tid = opaque_tid();
    for (size_t i = (size_t)blockIdx.x * 512 + tid; i < (size_t)2 * 2 * 16 * 4 * 48 * 192; i += (size_t)gridDim.x * 512) {
        const int k = i % 192, j = (i / 192) % 48, qt = (i / (192 * 48)) % 4, n = (i / (192 * 48 * 4)) % 16, which = (i / (192 * 48 * 4 * 16)) % 2, dir = i / (192 * 48 * 4 * 16 * 2);
        const float* w = which == 0 ? p.lru_w_a : p.lru_w_x; float v = 0.f;
        if (j < 42 && k < 168) v = w[(((size_t)dir * 16 + n) * 168 + k) * 168 + qt * 42 + j];
        p.w_lru[i] = f2bf(v);
    }
}
DI void fold_router(const Params& p) {
    const int tid = opaque_tid(), wave = tid >> 6, lane = tid & 63;
    for (size_t i = (size_t)blockIdx.x * 512 + tid; i < (size_t)2 * 4 * 48 * DM; i += (size_t)gridDim.x * 512) {
        const int k = i % DM, n = (i / DM) % 48, b = (i / (DM * 48)) % 4, l = i / (DM * 48 * 4);
        const float* g = l == 0 ? p.norm0_ffn : p.norm1_ffn; const float* md = p.mod + ((l == 0 ? 1 : 3) * 4 + b) * 6144;
        const float* we = l == 0 ? p.moe0_w_expert : p.moe1_w_expert; const float* wg = l == 0 ? p.moe0_w_group : p.moe1_w_group;
        const float w = n < 32 ? we[k * 32 + n] : n < 36 ? wg[k * 4 + (n - 32)] : 0.f;
        p.wrt[i] = g[k] * (1.f + md[2048 + k]) * w;
    }
    for (int task = blockIdx.x * 8 + wave; task < 2 * 4 * 48; task += gridDim.x * 8) {
        const int n = task % 48, b = (task / 48) % 4, l = task / (48 * 4);
        const float* md = p.mod + ((l == 0 ? 1 : 3) * 4 + b) * 6144;
        const float* we = l == 0 ? p.moe0_w_expert : p.moe1_w_expert; const float* wg = l == 0 ? p.moe0_w_group : p.moe1_w_group;
        float part = 0.f;
        for (int k = lane; k < DM; k += 64) { const float w = n < 32 ? we[k * 32 + n] : n < 36 ? wg[k * 4 + (n - 32)] : 0.f; part += md[k] * w; }
        part = wave_sum(part); if (lane == 0) p.rbias[task] = part;
    }
}
template <int MODE, bool OUT8 = false> DI void norm_rows(const Params& p, const float* xin  , const float* gain, int lmod, int lgate, const LAS int* tab) {
    const int tid = opaque_tid(), wave = tid >> 6, lane = tid & 63;
    for (int row = blockIdx.x * 8 + wave; row < T_TOK; row += gridDim.x * 8) {
        const int b = row / SEQ;
        f32x4 v[8];
        if (xin) {
#pragma unroll
            for (int i = 0; i < 8; ++i) v[i] = *(const f32x4*)(xin + (size_t)row * DM + i * 256 + lane * 4);
        } else {
#pragma unroll
            for (int i = 0; i < 8; ++i) { const uint2 a = *(const uint2*)(p.XA + (size_t)row * DM + i * 256 + lane * 4); v[i] = (f32x4){bflo(a.x), bfhi(a.x), bflo(a.y), bfhi(a.y)}; }
        }
        if constexpr (MODE >= 1) {
            const int a0 = p.asg[row * 2], a1 = p.asg[row * 2 + 1];
            const size_t r0 = (size_t)tab[a0 >> 14] * 256 + (a0 & 16383), r1 = (size_t)tab[a1 >> 14] * 256 + (a1 & 16383);
            const float* gt = p.mod + (lgate * 4 + b) * 6144 + 4096;
#pragma unroll
            for (int i = 0; i < 8; ++i) { const int col = i * 256 + lane * 4; const f32x4 g4 = *(const f32x4*)(gt + col);
                if constexpr (YB8) { const unsigned y0 = *(const unsigned*)((const unsigned char*)p.YB + r0 * DM + col), y1 = *(const unsigned*)((const unsigned char*)p.YB + r1 * DM + col);
                    const f32x2 a0 = __builtin_amdgcn_cvt_pk_f32_fp8(y0, false), a1 = __builtin_amdgcn_cvt_pk_f32_fp8(y0, true), b0 = __builtin_amdgcn_cvt_pk_f32_fp8(y1, false), b1 = __builtin_amdgcn_cvt_pk_f32_fp8(y1, true);
                    const f32x4 gq = g4 * (1.f / Y8_SCALE);
                    v[i][0] += gq[0] * (a0[0] + b0[0]); v[i][1] += gq[1] * (a0[1] + b0[1]); v[i][2] += gq[2] * (a1[0] + b1[0]); v[i][3] += gq[3] * (a1[1] + b1[1]); }
                else { const uint2 y0 = *(const uint2*)(p.YB + r0 * DM + col), y1 = *(const uint2*)(p.YB + r1 * DM + col);
                v[i][0] += g4[0] * (bflo(y0.x) + bflo(y1.x)); v[i][1] += g4[1] * (bfhi(y0.x) + bfhi(y1.x));
                v[i][2] += g4[2] * (bflo(y0.y) + bflo(y1.y)); v[i][3] += g4[3] * (bfhi(y0.y) + bfhi(y1.y)); } }
            if constexpr (MODE == 1) {
#pragma unroll
                for (int i = 0; i < 8; ++i) { const uint2 w = make_uint2(pk2(v[i][0], v[i][1]), pk2(v[i][2], v[i][3])); *(uint2*)(p.XA + (size_t)row * DM + i * 256 + lane * 4) = w;
                    v[i] = (f32x4){bflo(w.x), bfhi(w.x), bflo(w.y), bfhi(w.y)}; }
            }
        }
        float ss = 0.f;
#pragma unroll
        for (int i = 0; i < 8; ++i) ss += v[i][0] * v[i][0] + v[i][1] * v[i][1] + v[i][2] * v[i][2] + v[i][3] * v[i][3];
        ss = wave_sum(ss); const float rstd = rsqrtf(ss * (1.0f / DM) + 1e-6f);
        if constexpr (MODE == 2) {
#pragma unroll
            for (int i = 0; i < 8; ++i) { const int col = i * 256 + lane * 4; const f32x4 g4 = *(const f32x4*)(gain + col); *(f32x4*)(p.out + (size_t)row * DM + col) = v[i] * rstd * g4; }
        } else { const float* md = p.mod + (lmod * 4 + b) * 6144;
#pragma unroll
            for (int i = 0; i < 8; ++i) { const int col = i * 256 + lane * 4; const f32x4 g4 = *(const f32x4*)(gain + col), sc = *(const f32x4*)(md + 2048 + col), sh = *(const f32x4*)(md + col);
                const f32x4 h = v[i] * rstd * g4 * (1.f + sc) + sh;
                if constexpr (OUT8) *(unsigned*)((unsigned char*)p.H + (size_t)row * DM + col) = pk4_fp8(h[0], h[1], h[2], h[3], A8_SCALE);
                else *(uint2*)(p.H + (size_t)row * DM + col) = make_uint2(pk2(h[0], h[1]), pk2(h[2], h[3])); } }
    }
}
template <bool DRY = false, bool NORM = false> DI void router(const Params& p, int l, LAS unsigned char* lds, const float* gain = nullptr, int lmod = 0) {
    const int tid = opaque_tid(), wave = __builtin_amdgcn_readfirstlane(tid >> 6), lane = tid & 63;
    LAS float* lg = (LAS float*)lds + (wave & 3) * (16 * 48);
    LAS float* part = (LAS float*)lds + 4 * 16 * 48 + (wave & 3) * (64 * 13);
    LAS float* rsl = (LAS float*)lds + 4 * 16 * 48 + 4 * 64 * 13 + (wave & 3) * 16;
    for (int tg = blockIdx.x; tg < T_TOK / 64; tg += gridDim.x) {
        const int tile = tg * 4 + (wave & 3), kh = wave >> 2;
        const int row0 = tile * 16, b = row0 / SEQ, r = lane & 15, q = lane >> 4;
        const bf16_t* xa = p.XA + (size_t)(row0 + r) * DM + 4 * q + kh * (DM / 2);
        const float* wt = p.wrt + (((size_t)l * 4 + b) * 48 + r) * DM + 4 * q + kh * (DM / 2);
        f32x4 acc[3] = {{0.f, 0.f, 0.f, 0.f}, {0.f, 0.f, 0.f, 0.f}, {0.f, 0.f, 0.f, 0.f}}; float ss = 0.f;
#pragma unroll 2
        for (int s = 0; s < DM / 32; ++s) {
            const uint2 ar = *(const uint2*)(xa + 16 * s); const f32x4 a4 = {bflo(ar.x), bfhi(ar.x), bflo(ar.y), bfhi(ar.y)};
            ss += a4[0] * a4[0] + a4[1] * a4[1] + a4[2] * a4[2] + a4[3] * a4[3];
#pragma unroll
            for (int n = 0; n < 3; ++n) { const f32x4 b4 = *(const f32x4*)(wt + (size_t)n * 16 * DM + 16 * s);
#pragma unroll
                for (int j = 0; j < 4; ++j) acc[n] = __builtin_amdgcn_mfma_f32_16x16x4f32(a4[j], b4[j], acc[n], 0, 0, 0); }
        }
        if (kh == 1) {
#pragma unroll
            for (int n = 0; n < 3; ++n)
#pragma unroll
                for (int j = 0; j < 4; ++j) part[(n * 4 + j) * 64 + lane] = acc[n][j];
            part[12 * 64 + lane] = ss; }
        __syncthreads();
        if (kh == 0) {
#pragma unroll
            for (int n = 0; n < 3; ++n)
#pragma unroll
                for (int j = 0; j < 4; ++j) acc[n][j] += part[(n * 4 + j) * 64 + lane];
            ss += part[12 * 64 + lane];
        ss += __shfl_xor(ss, 16); ss += __shfl_xor(ss, 32);
        const float rstd = rsqrtf(ss * (1.0f / DM) + 1e-6f);
        if (NORM && q == 0) rsl[r] = rstd;
#pragma unroll
        for (int j = 0; j < 4; ++j) { const float rs = __shfl(rstd, 4 * q + j);
#pragma unroll
            for (int n = 0; n < 3; ++n) lg[(4 * q + j) * 48 + n * 16 + r] = acc[n][j] * rs + p.rbias[(l * 4 + b) * 48 + n * 16 + r]; }
        __builtin_amdgcn_wave_barrier();
        if (!DRY && lane < 16) {
            const LAS float* L = lg + lane * 48; const int tok = row0 + lane;
            int gs = 0; float gm = L[32];
#pragma unroll
            for (int g = 1; g < 4; ++g) if (L[32 + g] > gm) { gm = L[32 + g]; gs = g; }
            float gden = 0.f;
#pragma unroll
            for (int g = 0; g < 4; ++g) gden += __expf(L[32 + g] - gm);
            const float gprob = 1.0f / gden;
            int i0 = 0; float v0 = L[gs * 8];
            for (int j = 1; j < 8; ++j) { const float x = L[gs * 8 + j]; if (x > v0) { v0 = x; i0 = j; } }
            int i1 = -1; float v1 = -3.4e38f;
            for (int j = 0; j < 8; ++j) { const float x = L[gs * 8 + j]; if (j != i0 && x > v1) { v1 = x; i1 = j; } }
            const float e1 = __expf(v1 - v0), g0 = gprob / (1.f + e1), g1 = gprob * e1 / (1.f + e1);
            const int ea = gs * 8 + i0, eb = gs * 8 + i1;
            const int sa = atomicAdd(&p.cnt[l * 32 + ea], 1), sb = atomicAdd(&p.cnt[l * 32 + eb], 1);
            p.tokl[ea * ECAP + sa] = tok; p.gatel[ea * ECAP + sa] = g0; p.tokl[eb * ECAP + sb] = tok; p.gatel[eb * ECAP + sb] = g1;
            p.asg[tok * 2] = (ea << 14) | sa; p.asg[tok * 2 + 1] = (eb << 14) | sb;
        }
        }
        __syncthreads();
        if constexpr (NORM) {
            const float* md = p.mod + (lmod * 4 + b) * 6144;
            f32x4 g4[8], sc[8], sh[8];
#pragma unroll
            for (int i = 0; i < 8; ++i) { const int col = i * 256 + lane * 4; g4[i] = *(const f32x4*)(gain + col); sc[i] = 1.f + *(const f32x4*)(md + 2048 + col); sh[i] = *(const f32x4*)(md + col); g4[i] *= sc[i]; }
#pragma unroll 2
            for (int j = 0; j < 8; ++j) { const int row = row0 + kh * 8 + j; const float rs = rsl[kh * 8 + j];
#pragma unroll
                for (int i = 0; i < 8; ++i) { const int col = i * 256 + lane * 4; const uint2 ar = *(const uint2*)(p.XA + (size_t)row * DM + col); const f32x4 v = {bflo(ar.x), bfhi(ar.x), bflo(ar.y), bfhi(ar.y)};
                    const f32x4 h = v * rs * g4[i] + sh[i];
                    *(unsigned*)((unsigned char*)p.H + (size_t)row * DM + col) = pk4_fp8(h[0], h[1], h[2], h[3], A8_SCALE); } }
            __syncthreads();
        }
    }
}
DI void conv_gln(const Params& p, LAS unsigned char* lds) {
    const int tid = opaque_tid(), wave = tid >> 6, lane = tid & 63;
    LAS float* at = (LAS float*)lds;
    u32x4 rv[3], rg[3];
    auto load_raw = [&](int u) { const int g = u & 7, t0 = ((u >> 3) & 63) * 64, b = u >> 9;
#pragma unroll
        for (int i = 0; i < 3; ++i) { const int idx = tid + 512 * i, rr = idx >> 4, c8 = idx & 15, t = t0 - 15 + rr; rv[i] = (u32x4){0u, 0u, 0u, 0u}; rg[i] = (u32x4){0u, 0u, 0u, 0u};
            if (idx < 94 * 16 && t >= 0 && t < SEQ) { const bf16_t* row = p.G + (size_t)(b * SEQ + t) * N_IN0 + g * 128 + c8 * 8; rv[i] = *(const u32x4*)row; rg[i] = *(const u32x4*)(row + 1024); } } };
    int gcur = -1; f32x2 wk[31], bias = {0.f, 0.f}, gam = {0.f, 0.f}, bet = {0.f, 0.f};
    if ((int)blockIdx.x < 2048) load_raw(blockIdx.x);
    for (int u = blockIdx.x; u < 2048; u += gridDim.x) {
        const int g = u & 7, t0 = ((u >> 3) & 63) * 64, b = u >> 9;
        const int ch = g * 128 + 2 * lane;
        if (g != gcur) { gcur = g;
#pragma unroll
            for (int k = 0; k < 31; ++k) wk[k] = *(const f32x2*)(p.conv_w + k * 1024 + ch);
            bias = *(const f32x2*)(p.conv_b + ch); gam = *(const f32x2*)(p.conv_norm_g + ch); bet = *(const f32x2*)(p.conv_norm_b + ch); }
#pragma unroll
        for (int i = 0; i < 3; ++i) { const int idx = tid + 512 * i, rr = idx >> 4, c8 = idx & 15;
            if (idx < 94 * 16) { const u32x4 v = rv[i], gg = rg[i];
                const f32x4 lo = {bflo(v[0]) * sigmoidf_(bflo(gg[0])), bfhi(v[0]) * sigmoidf_(bfhi(gg[0])), bflo(v[1]) * sigmoidf_(bflo(gg[1])), bfhi(v[1]) * sigmoidf_(bfhi(gg[1]))};
                const f32x4 hi = {bflo(v[2]) * sigmoidf_(bflo(gg[2])), bfhi(v[2]) * sigmoidf_(bfhi(gg[2])), bflo(v[3]) * sigmoidf_(bflo(gg[3])), bfhi(v[3]) * sigmoidf_(bfhi(gg[3]))};
                *(LAS f32x4*)(at + rr * 132 + c8 * 8) = lo; *(LAS f32x4*)(at + rr * 132 + c8 * 8 + 4) = hi; } }
        __syncthreads();
        if (u + (int)gridDim.x < 2048) load_raw(u + gridDim.x);
        f32x2 acc[8];
#pragma unroll
        for (int j = 0; j < 8; ++j) acc[j] = bias;
#pragma unroll
        for (int rr = 0; rr < 38; ++rr) { const f32x2 a2 = *(const LAS f32x2*)(at + (wave * 8 + rr) * 132 + 2 * lane);
#pragma unroll
            for (int j = 0; j < 8; ++j) { const int k = rr - j; if (k >= 0 && k < 31) acc[j] += wk[k] * a2; } }
#pragma unroll
        for (int j = 0; j < 8; ++j) { const float mu = wave_sum(acc[j][0] + acc[j][1]) * (1.f / 128.f); const float d0 = acc[j][0] - mu, d1 = acc[j][1] - mu;
            const float var = wave_sum(d0 * d0 + d1 * d1) * (1.f / 128.f); const float rs = rsqrtf(var + 1e-6f);
            const float y0 = d0 * rs * gam[0] + bet[0], y1 = d1 * rs * gam[1] + bet[1];
            if constexpr (D8_OUT0) *(unsigned short*)((unsigned char*)p.AO + (size_t)(b * SEQ + t0 + wave * 8 + j) * DM + ch) = (unsigned short)(pk4_fp8(siluf_(y0), siluf_(y1), 0.f, 0.f, A8_SCALE) & 0xffffu);
            else *(unsigned*)(p.AO + (size_t)(b * SEQ + t0 + wave * 8 + j) * DM + ch) = pk2(siluf_(y0), siluf_(y1)); }
        __syncthreads();
    }
}
DI unsigned off_b(unsigned row, unsigned ch) { return 256u * row + 16u * (ch ^ (((row & 3u) << 2) | ((row >> 2) & 3u))); }
DI void tr_read4(unsigned a0, unsigned a1, s16x4& r00, s16x4& r01, s16x4& r10, s16x4& r11) {
    asm volatile("ds_read_b64_tr_b16 %0, %4\n\tds_read_b64_tr_b16 %1, %5\n\tds_read_b64_tr_b16 %2, %4 offset:4096\n\tds_read_b64_tr_b16 %3, %5 offset:4096\n\ts_waitcnt lgkmcnt(0)"
                 : "=&v"(r00), "=&v"(r01), "=&v"(r10), "=&v"(r11) : "v"(a0), "v"(a1) : "memory");
}
template <int PASS> DI void attn_wave(const Params& p, LAS unsigned char* vimg, unsigned vb0, unsigned vb1, int lane_, int b, int h, int qbase  ) {
    int lane = lane_; asm volatile("" : "+v"(lane));
    const int c = lane & 31, hh = lane >> 5, srow = lane >> 4, sch = lane & 15;
    constexpr int QS = PASS == 0 ? 16 : 1, NT = PASS == 0 ? 13 : 5;
    const int tq = qbase + QS * c;
    const bf16_t* gb = p.G + (size_t)(b * SEQ) * N_IN0; const bf16_t* kb = p.KVH + (size_t)((b * 8 + h) * 2) * SEQ * 128;
    float* st_o = (float*)p.YB + ((size_t)(b * 8 + h) * SEQ + tq) * 128;
    float* st_ml = (float*)p.YB + (size_t)NBATCH * 8 * SEQ * 128 + ((size_t)(b * 8 + h) * SEQ + tq) * 2;
    bf16x8 qf[8];
#pragma unroll
    for (int ks = 0; ks < 8; ++ks) qf[ks] = *(const bf16x8*)(gb + (size_t)tq * N_IN0 + 2048 + h * 128 + 16 * ks + 8 * hh);
    const float sc2 = 0.08838834764831845f * 1.4426950408889634f, sl2 = exp2f(-(float)(h + 1)) * 1.4426950408889634f;
    f32x16 o[4]; float m_run, l_run;
    if constexpr (PASS == 0) {
#pragma unroll
        for (int i = 0; i < 4; ++i)
#pragma unroll
            for (int j = 0; j < 16; ++j) o[i][j] = 0.f;
        m_run = -30000.f; l_run = 0.f;
    } else {
#pragma unroll
        for (int c4 = 0; c4 < 4; ++c4)
#pragma unroll
            for (int g4 = 0; g4 < 4; ++g4) { const f32x4 v = *(const f32x4*)(st_o + 32 * c4 + 8 * g4 + 4 * hh); o[c4][4 * g4] = v[0]; o[c4][4 * g4 + 1] = v[1]; o[c4][4 * g4 + 2] = v[2]; o[c4][4 * g4 + 3] = v[3]; }
        const f32x2 ml = *(const f32x2*)st_ml; m_run = ml[0]; l_run = hh == 0 ? ml[1] : 0.f;
    }
    auto tile_geom = [&](int tile, int& d, int& sb) { if constexpr (PASS == 0) { if (tile < 5) { d = 16; sb = qbase - 1024 + 512 * tile; } else { d = 4; sb = qbase - 256 + 128 * (tile - 5); } } else { d = 1; sb = qbase - 64 + 32 * tile; } };
    auto load_k = [&](int tile, bf16x8 (&kf)[8]) { int d, sb; tile_geom(tile, d, sb); int sp = sb + d * c; sp = sp < 0 ? 0 : (sp >= SEQ ? SEQ - 1 : sp);
        const bf16_t* src = kb + (unsigned)(sp * 128 + 8 * hh);
#pragma unroll
        for (int ks = 0; ks < 8; ++ks) kf[ks] = *(const bf16x8*)(src + 16 * ks); };
    auto load_v = [&](int tile, u32x4 (&vv)[8]) { int d, sb; tile_geom(tile, d, sb);
#pragma unroll
        for (int i = 0; i < 8; ++i) { int sp = sb + d * (srow + 4 * i); sp = sp < 0 ? 0 : (sp >= SEQ ? SEQ - 1 : sp); vv[i] = *(const u32x4*)(kb + (unsigned)(SEQ * 128 + sp * 128 + sch * 8)); } };
    bf16x8 kf[8]; u32x4 vv[8];
    load_k(0, kf); load_v(0, vv);
    for (int tile = 0; tile < NT; ++tile) {
        int d, sb; tile_geom(tile, d, sb);
        const int tn = tile < NT - 1 ? tile + 1 : NT - 1;
#pragma unroll
        for (int i = 0; i < 8; ++i) *(LAS u32x4*)(vimg + off_b(srow + 4 * i, sch)) = vv[i];
        load_v(tn, vv);
        f32x16 sacc;
#pragma unroll
        for (int j = 0; j < 16; ++j) sacc[j] = 0.f;
#pragma unroll
        for (int ks = 0; ks < 8; ++ks) sacc = __builtin_amdgcn_mfma_f32_32x32x16_bf16(kf[ks], qf[ks], sacc, 0, 0, 0);
        load_k(tn, kf);
        const float df = (float)d, basef = (float)(sb - tq) + df * (float)(4 * hh);
        const float lo = fmaxf(-64.f * df, -(float)tq), hi = fminf(64.f * df, (float)(SEQ - 1 - tq));
        const float mid = 0.5f * (lo + hi), half = 0.5f * (hi - lo);
        float tmax = -1e30f;
#pragma unroll
        for (int i = 0; i < 16; ++i) { const float deltaf = basef + df * (float)((i & 3) + 8 * (i >> 2));
            const bool valid = __builtin_fabsf(deltaf - mid) <= half;
            const float sv = valid ? sacc[i] * sc2 - sl2 * __builtin_fabsf(deltaf) : -1e30f; sacc[i] = sv; tmax = fmaxf(tmax, sv); }
        tmax = fmaxf(tmax, __shfl_xor(tmax, 32));
        const float m_new = tmax > m_run + 8.0f ? tmax : m_run;
        if (__any(m_new != m_run)) { const float alpha = __builtin_amdgcn_exp2f(m_run - m_new);
            l_run *= alpha;
#pragma unroll
            for (int i = 0; i < 4; ++i) o[i] *= alpha; }
        m_run = m_new;
        float psum = 0.f;
#pragma unroll
        for (int i = 0; i < 16; ++i) { const float pi = __builtin_amdgcn_exp2f(sacc[i] - m_new); psum += pi; sacc[i] = pi; }
        l_run += psum;
        bf16x8 pf[2];
#pragma unroll
        for (int s = 0; s < 2; ++s) { const unsigned w0 = pk2(sacc[8 * s], sacc[8 * s + 1]), w1 = pk2(sacc[8 * s + 2], sacc[8 * s + 3]), w2 = pk2(sacc[8 * s + 4], sacc[8 * s + 5]), w3 = pk2(sacc[8 * s + 6], sacc[8 * s + 7]);
            pf[s] = __builtin_bit_cast(bf16x8, (u32x4){w0, w1, w2, w3}); }
#pragma unroll
        for (int c4 = 0; c4 < 4; ++c4) {
            s16x4 r00, r01, r10, r11; tr_read4(vb0 ^ (unsigned)(c4 << 6), vb1 ^ (unsigned)(c4 << 6), r00, r01, r10, r11);
            const bf16x8 v0 = __builtin_shufflevector(r00, r01, 0, 1, 2, 3, 4, 5, 6, 7), v1 = __builtin_shufflevector(r10, r11, 0, 1, 2, 3, 4, 5, 6, 7);
            o[c4] = __builtin_amdgcn_mfma_f32_32x32x16_bf16(v0, pf[0], o[c4], 0, 0, 0);
            o[c4] = __builtin_amdgcn_mfma_f32_32x32x16_bf16(v1, pf[1], o[c4], 0, 0, 0); }
    }
    const float ltot = l_run + __shfl_xor(l_run, 32);
    if constexpr (PASS == 0) {
#pragma unroll
        for (int c4 = 0; c4 < 4; ++c4)
#pragma unroll
            for (int g4 = 0; g4 < 4; ++g4) *(f32x4*)(st_o + 32 * c4 + 8 * g4 + 4 * hh) = (f32x4){o[c4][4 * g4], o[c4][4 * g4 + 1], o[c4][4 * g4 + 2], o[c4][4 * g4 + 3]};
        if (hh == 0) *(f32x2*)st_ml = (f32x2){m_run, ltot};
    } else {
        const float inv = 1.0f / ltot;
        bf16_t* orow = p.AO + (size_t)(b * SEQ + tq) * DM + 1024 + h * 128;
#pragma unroll
        for (int c4 = 0; c4 < 4; ++c4)
#pragma unroll
            for (int g4 = 0; g4 < 4; ++g4) { const int dh = 32 * c4 + 8 * g4 + 4 * hh;
                if constexpr (D8_OUT0) *(unsigned*)((unsigned char*)p.AO + (size_t)(b * SEQ + tq) * DM + 1024 + h * 128 + dh) = pk4_fp8(o[c4][4 * g4] * inv, o[c4][4 * g4 + 1] * inv, o[c4][4 * g4 + 2] * inv, o[c4][4 * g4 + 3] * inv, A8_SCALE);
                else *(uint2*)(orow + dh) = make_uint2(pk2(o[c4][4 * g4] * inv, o[c4][4 * g4 + 1] * inv), pk2(o[c4][4 * g4 + 2] * inv, o[c4][4 * g4 + 3] * inv)); }
    }
}
DI void attention(const Params& p, LAS unsigned char* lds) {
    const int tid = opaque_tid(), wave = __builtin_amdgcn_readfirstlane(tid >> 6), lane = tid & 63, hh = lane >> 5;
    LAS unsigned char* vimg = lds + wave * 8192;
    const unsigned vbase = (unsigned)(uintptr_t)vimg;
    const int q4 = (lane & 15) >> 2, pp = lane & 3, blk = (lane >> 4) & 1;
    const unsigned vb0 = vbase + 256u * (4 * hh + q4) + 16u * ((2 * blk + (pp >> 1)) ^ (hh & 3)) + 8u * (pp & 1) + ((unsigned)q4 << 6);
    const unsigned vb1 = vbase + 256u * (8 + 4 * hh + q4) + 16u * ((2 * blk + (pp >> 1)) ^ ((2 + hh) & 3)) + 8u * (pp & 1) + ((unsigned)q4 << 6);
    for (int u = blockIdx.x; u < 256; u += gridDim.x) {
        const int bh = (u & 7) * 4 + ((u >> 3) >> 3), span = (u >> 3) & 7, h = bh & 7, b = bh >> 3;
#pragma unroll 1
        for (int j = 0; j < 2; ++j) attn_wave<0>(p, vimg, vb0, vb1, lane, b, h, span * 512 + wave * 2 + j);
        asm volatile("s_waitcnt vmcnt(0)" ::: "memory");
        __syncthreads();
#pragma unroll 1
        for (int j = 0; j < 2; ++j) attn_wave<1>(p, vimg, vb0, vb1, lane, b, h, span * 512 + (wave * 2 + j) * 32);
        __syncthreads();
    }
}
DI float om_exp2x(float la, float a) {
    const float x = 2.f * la;
    const float pl = x * (1.f + x * (0.5f + x * (0.16666667f + x * (0.041666668f + x * 0.008333334f))));
    return x > -0.25f ? -pl : 1.f - a * a;
}
DI void lru_conv(const Params& p) {
    const int tid = opaque_tid();
    if (tid < 336) {
        const int ch = tid * 8;
        float cw[4][8], cb[8];
#pragma unroll
        for (int j = 0; j < 4; ++j) { const f32x4 w0 = *(const f32x4*)(p.lru_conv_w + j * LRU_W + ch), w1 = *(const f32x4*)(p.lru_conv_w + j * LRU_W + ch + 4);
            cw[j][0] = w0[0]; cw[j][1] = w0[1]; cw[j][2] = w0[2]; cw[j][3] = w0[3]; cw[j][4] = w1[0]; cw[j][5] = w1[1]; cw[j][6] = w1[2]; cw[j][7] = w1[3]; }
        { const f32x4 b0 = *(const f32x4*)(p.lru_conv_b + ch), b1 = *(const f32x4*)(p.lru_conv_b + ch + 4); cb[0] = b0[0]; cb[1] = b0[1]; cb[2] = b0[2]; cb[3] = b0[3]; cb[4] = b1[0]; cb[5] = b1[1]; cb[6] = b1[2]; cb[7] = b1[3]; }
        for (int run = blockIdx.x; run < T_TOK / 32; run += gridDim.x) {
            const int tok0 = run * 32, t0 = tok0 % SEQ;
            const bf16_t* src = p.G + (size_t)tok0 * N_IN1 + LRU_W + ch;
            u32x4 rows[35];
#pragma unroll
            for (int i = 0; i < 35; ++i) { const int t = t0 - 2 + i; rows[i] = (t >= 0 && t < SEQ) ? *(const u32x4*)(src + (ptrdiff_t)(i - 2) * N_IN1) : (u32x4){0u, 0u, 0u, 0u}; }
#pragma unroll
            for (int i = 0; i < 32; ++i) { float xc[8];
#pragma unroll
                for (int e = 0; e < 8; ++e) xc[e] = cb[e];
#pragma unroll
                for (int j = 0; j < 4; ++j) { const u32x4 xv = rows[i + j];
                    xc[0] += cw[j][0] * bflo(xv[0]); xc[1] += cw[j][1] * bfhi(xv[0]); xc[2] += cw[j][2] * bflo(xv[1]); xc[3] += cw[j][3] * bfhi(xv[1]);
                    xc[4] += cw[j][4] * bflo(xv[2]); xc[5] += cw[j][5] * bfhi(xv[2]); xc[6] += cw[j][6] * bflo(xv[3]); xc[7] += cw[j][7] * bfhi(xv[3]); }
                *(u32x4*)(p.XC + (size_t)(tok0 + i) * LRU_W + ch) = (u32x4){pk2(xc[0], xc[1]), pk2(xc[2], xc[3]), pk2(xc[4], xc[5]), pk2(xc[6], xc[7])}; }
        }
    }
}
DI void lru(const Params& p, LAS unsigned char* lds) {
    const int tid = opaque_tid(), wave = __builtin_amdgcn_readfirstlane(tid >> 6), lane = tid & 63, col = lane & 15, g = lane >> 4;
    LAS unsigned char* wl = lds;
    LAS unsigned char* xs = lds + 36864;
    LAS float* sums = (LAS float*)(lds + 36864 + 86016);
    LAS float* cst = sums + 1536;
    for (int u = blockIdx.x; u < 256; u += gridDim.x) {
        const int b = u >> 6, n = (u >> 2) & 15, qt = u & 3, chq = n * LRU_BW + qt * 42;
        const char* xcb = (const char*)(p.XC + (size_t)(b * SEQ) * LRU_W + n * LRU_BW);
        const bf16_t* gb = p.G + (size_t)(b * SEQ) * N_IN1;
        unsigned poff[6];
#pragma unroll
        for (int i = 0; i < 6; ++i) { const int idx = tid + 512 * i; poff[i] = (unsigned)((idx / 21) * LRU_W + (idx % 21) * 8) * 2u; }
        auto dma_chunk = [&](int chunk, int bsel) { const char* src = xcb + (size_t)chunk * 128 * LRU_W * 2; LAS unsigned char* dst = xs + bsel * 43008 + wave * 1024;
#pragma unroll
            for (int i = 0; i < 5; ++i) __builtin_amdgcn_global_load_lds((const unsigned*)(src + poff[i]), (LAS unsigned*)(dst + i * 8192), 16, 0, 0);
            if (wave < 2) __builtin_amdgcn_global_load_lds((const unsigned*)(src + poff[5]), (LAS unsigned*)(dst + 5 * 8192), 16, 0, 0); };
        for (int dir = 0; dir < 2; ++dir) {
            __syncthreads();
            for (int i = tid; i < 2 * 48 * 24; i += 512) { const int which = i / (48 * 24), r = (i / 24) % 48, ck = i % 24; const int nt = r >> 4, cl = r & 15, ks = ck >> 2, gg = ck & 3;
                *(LAS u32x4*)(wl + ((which * 3 + nt) * 6 + ks) * 1024 + (gg * 16 + cl) * 16) = *(const u32x4*)(p.w_lru + ((((size_t)(dir * 2 + which) * 16 + n) * 4 + qt) * 48 + r) * 192 + ck * 8); }
            if (tid < 48) { const bool valid = tid < 42; const int ch = dir * LRU_W + chq + tid;
                cst[tid] = valid ? p.lru_b_a[ch] : 0.f; cst[48 + tid] = valid ? p.lru_b_x[ch] : 0.f;
                const float lam = valid ? p.lru_lambda[ch] : 0.f; const float sp = (-lam > 20.f) ? -lam : log1pf(__expf(-lam)); cst[96 + tid] = -8.0f * sp; }
            dma_chunk(dir == 0 ? 0 : 31, 0);
            asm volatile("s_waitcnt vmcnt(0)" ::: "memory");
            __syncthreads();
            float cba[3], cbx[3], cex[3];
#pragma unroll
            for (int nt = 0; nt < 3; ++nt) { cba[nt] = cst[nt * 16 + col]; cbx[nt] = cst[48 + nt * 16 + col]; cex[nt] = cst[96 + nt * 16 + col]; }
            float carry[3] = {0.f, 0.f, 0.f};
            for (int step = 0; step < 32; ++step) {
                const int c = dir == 0 ? step : 31 - step, c0 = c * 128, par = step & 1;
                const bool has_next = step < 31;
                if (has_next) dma_chunk(dir == 0 ? c + 1 : c - 1, par ^ 1);
                LAS unsigned char* xb = xs + par * 43008;
                uint2 hfv[3] = {make_uint2(0u, 0u), make_uint2(0u, 0u), make_uint2(0u, 0u)}; unsigned short gtv[3][4];
                const uint2* hfp = (const uint2*)p.HF + ((size_t)((u * 32 + c) * 8 + wave) * 3) * 64 + lane;
                if (dir == 1) {
#pragma unroll
                    for (int nt = 0; nt < 3; ++nt) { hfv[nt] = hfp[nt * 64];
#pragma unroll
                        for (int r = 0; r < 4; ++r) gtv[nt][r] = (nt * 16 + col < 42) ? gb[(size_t)(c0 + wave * 16 + 4 * g + r) * N_IN1 + chq + nt * 16 + col] : (unsigned short)0; } }
                bf16x8 af[6];
#pragma unroll
                for (int ks = 0; ks < 6; ++ks) { const int ch0 = 32 * ks + 8 * g; const bool kval = ch0 < LRU_BW; const int chl0 = kval ? ch0 : 160;
                    const u32x4 xv = *(const LAS u32x4*)(xb + (wave * 16 + col) * 336 + chl0 * 2);
                    af[ks] = __builtin_bit_cast(bf16x8, kval ? xv : (u32x4){0u, 0u, 0u, 0u}); }
                f32x4 acc[2][3];
#pragma unroll
                for (int w2 = 0; w2 < 2; ++w2)
#pragma unroll
                    for (int nt = 0; nt < 3; ++nt) { acc[w2][nt] = (f32x4){0.f, 0.f, 0.f, 0.f};
#pragma unroll
                        for (int ks = 0; ks < 6; ++ks) { const bf16x8 bfr = *(const LAS bf16x8*)(wl + ((w2 * 3 + nt) * 6 + ks) * 1024 + lane * 16);
                            acc[w2][nt] = __builtin_amdgcn_mfma_f32_16x16x32_bf16(af[ks], bfr, acc[w2][nt], 0, 0, 0); } }
                float hl[3][4], Pl[3][4];
#pragma unroll
                for (int nt = 0; nt < 3; ++nt) { const int chl = nt * 16 + col;
                    float av[4], uv[4];
#pragma unroll
                    for (int r = 0; r < 4; ++r) { const float za = acc[0][nt][r] + cba[nt], zx = acc[1][nt][r] + cbx[nt];
                        const float rg = sigmoidf_(za), ig = sigmoidf_(zx); const float la = cex[nt] * rg; const float a = __expf(la);
                        const float xcv = bf2f(*(const LAS bf16_t*)(xb + (wave * 16 + 4 * g + r) * 336 + (qt * 42 + chl) * 2));
                        av[r] = a; uv[r] = __builtin_amdgcn_sqrtf(om_exp2x(la, a)) * ig * xcv; }
                    float h[4], P[4], A, H;
                    if (dir == 0) { h[0] = uv[0]; P[0] = av[0];
#pragma unroll
                        for (int r = 1; r < 4; ++r) { h[r] = av[r] * h[r - 1] + uv[r]; P[r] = av[r] * P[r - 1]; }
                        A = P[3]; H = h[3];
                        { const float A1 = __shfl_up(A, 16), H1 = __shfl_up(H, 16); if (g >= 1) { H = A * H1 + H; A = A * A1; } }
                        { const float A2 = __shfl_up(A, 32), H2 = __shfl_up(H, 32); if (g >= 2) { H = A * H2 + H; A = A * A2; } }
                        float Ae = __shfl_up(A, 16), He = __shfl_up(H, 16); if (g == 0) { Ae = 1.f; He = 0.f; }
                        const float At = __shfl(A, 48 + col), Ht = __shfl(H, 48 + col);
#pragma unroll
                        for (int r = 0; r < 4; ++r) { hl[nt][r] = h[r] + P[r] * He; Pl[nt][r] = P[r] * Ae; }
                        if (g == 3) *(LAS f32x2*)(sums + ((par * 8 + wave) * 48 + chl) * 2) = (f32x2){At, Ht};
                    } else { h[3] = uv[3]; P[3] = av[3];
#pragma unroll
                        for (int r = 2; r >= 0; --r) { h[r] = av[r] * h[r + 1] + uv[r]; P[r] = av[r] * P[r + 1]; }
                        A = P[0]; H = h[0];
                        { const float A1 = __shfl_down(A, 16), H1 = __shfl_down(H, 16); if (g <= 2) { H = A * H1 + H; A = A * A1; } }
                        { const float A2 = __shfl_down(A, 32), H2 = __shfl_down(H, 32); if (g <= 1) { H = A * H2 + H; A = A * A2; } }
                        float Ae = __shfl_down(A, 16), He = __shfl_down(H, 16); if (g == 3) { Ae = 1.f; He = 0.f; }
                        const float At = __shfl(A, col), Ht = __shfl(H, col);
#pragma unroll
                        for (int r = 0; r < 4; ++r) { hl[nt][r] = h[r] + P[r] * He; Pl[nt][r] = P[r] * Ae; }
                        if (g == 0) *(LAS f32x2*)(sums + ((par * 8 + wave) * 48 + chl) * 2) = (f32x2){At, Ht};
                    }
                }
                asm volatile("s_waitcnt vmcnt(0)" ::: "memory");
                __syncthreads();
#pragma unroll
                for (int nt = 0; nt < 3; ++nt) { const int chl = nt * 16 + col; float C = carry[nt], Cw = 0.f;
#pragma unroll
                    for (int k = 0; k < 8; ++k) { const int w2 = dir == 0 ? k : 7 - k; const f32x2 sv = *(const LAS f32x2*)(sums + ((par * 8 + w2) * 48 + chl) * 2);
                        if (w2 == wave) Cw = C; C = sv[0] * C + sv[1]; }
                    carry[nt] = C;
                    float hv[4];
#pragma unroll
                    for (int r = 0; r < 4; ++r) hv[r] = hl[nt][r] + Pl[nt][r] * Cw;
                    if (dir == 0) ((uint2*)p.HF)[((size_t)((u * 32 + c) * 8 + wave) * 3 + nt) * 64 + lane] = make_uint2(pk2(hv[0], hv[1]), pk2(hv[2], hv[3]));
                    else if (chl < 42) { const float ff[4] = {bflo(hfv[nt].x), bfhi(hfv[nt].x), bflo(hfv[nt].y), bfhi(hfv[nt].y)};
#pragma unroll
                        for (int r = 0; r < 4; ++r) p.AO[(size_t)(b * SEQ + c0 + wave * 16 + 4 * g + r) * LRU_W + chq + chl] = f2bf(bf2f(gtv[nt][r]) * (ff[r] + hv[r])); }
                }
            }
        }
    }
}
}

#define XB_TMO      128
#define XB_XCNT(j)  (256  + 64 * (j))
#define XB_XSUB(j)  (1280 + 64 * (j))
#define XB_XGEN(j)  (2304 + 64 * (j))
#define XB_TOP      3328
#define XB_TOPGEN   3392
#define XCD_BAR_WORDS 3456
#define XB_SPIN_CAP (1u << 18)

__device__ __forceinline__ unsigned xb_ld(unsigned* p)              { return __hip_atomic_load(p, __ATOMIC_RELAXED, __HIP_MEMORY_SCOPE_AGENT); }
__device__ __forceinline__ unsigned xb_add(unsigned* p, unsigned v) { return __hip_atomic_fetch_add(p, v, __ATOMIC_RELAXED, __HIP_MEMORY_SCOPE_AGENT); }
__device__ __forceinline__ unsigned xb_xcc_id() { return (unsigned)__builtin_amdgcn_s_getreg((3 << 11) | 20) & 0xFu; }
#define XB_SPIN(cond, bar) do { unsigned _sp = 0; while (cond) { __builtin_amdgcn_s_sleep(1); \
    if ((++_sp & 255u) == 0u) { if (xb_ld(&(bar)[XB_TMO])) break; if (_sp > XB_SPIN_CAP) { atomicAdd(&(bar)[XB_TMO], 1u); break; } } } } while (0)

struct XcdBarrier {
    unsigned* bar; unsigned x;
    volatile LAS unsigned* st;
};

__device__ __forceinline__ XcdBarrier xcd_barrier_post(unsigned* bar, volatile LAS unsigned* st) {
    XcdBarrier b; b.bar = bar; b.x = xb_xcc_id(); b.st = st;
    if (threadIdx.x == 0) (void)xb_add(&bar[XB_XCNT(b.x)], 1u);
    return b;
}
__device__ __forceinline__ void xcd_barrier_complete(unsigned* bar, unsigned x, unsigned& nloc, unsigned& nx) {
    const unsigned G = gridDim.x * gridDim.y * gridDim.z;
    unsigned sum, cnt, mine, sp = 0u;
    for (;;) {
        sum = 0u; cnt = 0u; mine = 0u;
#pragma unroll
        for (unsigned j = 0; j < 16; ++j) { const unsigned c = xb_ld(&bar[XB_XCNT(j)]); sum += c; cnt += (c > 0u) ? 1u : 0u; mine = (j == x) ? c : mine; }
        if (sum == G) break;
        __builtin_amdgcn_s_sleep(1);
        if ((++sp & 255u) == 0u) { if (xb_ld(&bar[XB_TMO])) break; if (sp > XB_SPIN_CAP) { atomicAdd(&bar[XB_TMO], 1u); break; } }
    }
    nloc = mine > 0u ? mine : 1u; nx = cnt > 0u ? cnt : 1u;
}

__device__ __forceinline__ void xcd_barrier(const XcdBarrier& b) {
    asm volatile("s_waitcnt vmcnt(0)" ::: "memory");
    __syncthreads();
    if (threadIdx.x == 0) {
        unsigned* bar = b.bar;
        __builtin_amdgcn_s_waitcnt(0);
        unsigned nloc = b.st[0], nx = b.st[1];
        if (nloc == 0u) { xcd_barrier_complete(bar, b.x, nloc, nx); b.st[0] = nloc; b.st[1] = nx; }
        const unsigned old = xb_add(&bar[XB_XSUB(b.x)], 1u);
        const unsigned gen = old / nloc;
        if (old + 1u == (gen + 1u) * nloc) {
            __builtin_amdgcn_fence(__ATOMIC_RELEASE, "agent");
            asm volatile("s_waitcnt vmcnt(0)" ::: "memory");
            const unsigned og = xb_add(&bar[XB_TOP], 1u);
            const unsigned tg = og / nx;
            if (og + 1u == (tg + 1u) * nx) xb_add(&bar[XB_TOPGEN], 1u);
            else XB_SPIN(xb_ld(&bar[XB_TOPGEN]) == tg, bar);
            __builtin_amdgcn_fence(__ATOMIC_ACQUIRE, "agent");
            xb_add(&bar[XB_XGEN(b.x)], 1u);
            asm volatile("s_waitcnt vmcnt(0)" ::: "memory");
        } else {
            XB_SPIN(xb_ld(&bar[XB_XGEN(b.x)]) == gen, bar);
            __builtin_amdgcn_fence(__ATOMIC_ACQUIRE, "agent");
            asm volatile("s_waitcnt vmcnt(0)" ::: "memory");
        }
    }
    __syncthreads();
}


constexpr int PROBE = 0;
constexpr int LDS_XB_OFF = gm::STAGE_BYTES + 1024;
constexpr int LDS_TOTAL = LDS_XB_OFF + 16;
__global__ void __launch_bounds__(512, 2) mega(Params p) {
    LAS unsigned char* lds = (LAS unsigned char*)dyn_smem;
    LAS int* tab = (LAS int*)(lds + gm::TAB_OFF);
    volatile LAS unsigned* xbw = (volatile LAS unsigned*)(lds + LDS_XB_OFF);
    if (threadIdx.x == 0) { xbw[0] = 0u; xbw[1] = 0u; xbw[2] = 0u; xbw[3] = 0u; }
    __syncthreads();
    XcdBarrier bar = xcd_barrier_post(p.bar, xbw);
    ph::mods(p, lds);
    if constexpr (PROBE == 14) { ph::mods(p, lds); ph::mods(p, lds); }
    xcd_barrier(bar);
    { const int c = blockIdx.x, G = gridDim.x;
      ph::transposer(p, lds, c, c < 320 ? (320 - c + G - 1) / G : 0, G); __syncthreads();
      ph::transposer(p, lds, 320 + c, c < 632 ? (632 - c + G - 1) / G : 0, G); __syncthreads(); }
    ph::lru_weights(p);
    ph::fold_router(p);
    ph::norm_rows<0, D8_IN0>(p, p.x, p.norm0_mix, 0, 0, nullptr);
    xcd_barrier(bar);
    { const int c = blockIdx.x, G = gridDim.x; const int tcount = c < 6144 ? (6144 - c + G - 1) / G : 0; const bool t_first = ((c >> 3) & 1) != 0;
      if (t_first) { ph::transposer(p, lds, 952 + c, tcount, G); __syncthreads(); }
      { gm::DenseSched S; S.init(T_TOK, N_IN0); EpiIn0 e; e.xin = nullptr; e.lgate = 0; if constexpr (D8_IN0) gm::gemm_phase<EpiIn0, gm::DenseSched, true>(lds, p, p.H, p.w_in0t, 0, DM / 2, S, e, W8_E8M0, A8_E8M0); else gm::gemm_phase(lds, p, p.H, p.w_in0t, 0, DM, S, e); }
      if (!t_first) { __syncthreads(); ph::transposer(p, lds, 952 + c, tcount, G); }
      if constexpr (PROBE == 21) { __syncthreads(); ph::transposer(p, lds, 952 + c, tcount, G); }
      if constexpr (PROBE == 24) { __syncthreads(); if (t_first) ph::transposer(p, lds, 952 + c, tcount, G); }
      if constexpr (PROBE == 23) { __syncthreads(); if (t_first) { ph::transposer(p, lds, 952 + c, tcount, G); __syncthreads(); }
        { gm::DenseSched S; S.init(T_TOK, N_IN0); EpiIn0 e; e.xin = nullptr; e.lgate = 0; gm::gemm_phase<EpiIn0, gm::DenseSched, true>(lds, p, p.H, p.w_in0t, 0, DM / 2, S, e, W8_E8M0, A8_E8M0); }
        if (!t_first) { __syncthreads(); ph::transposer(p, lds, 952 + c, tcount, G); } }
      if constexpr (PROBE == 20) { __syncthreads(); gm::DenseSched S; S.init(T_TOK, N_IN0); EpiIn0 e; e.xin = nullptr; e.lgate = 0; gm::gemm_phase<EpiIn0, gm::DenseSched, true>(lds, p, p.H, p.w_in0t, 0, DM / 2, S, e, W8_E8M0, A8_E8M0); } }
    xcd_barrier(bar);
    ph::attention(p, lds);
    if constexpr (PROBE == 4) ph::attention(p, lds);
    __syncthreads();
    ph::conv_gln(p, lds);
    if constexpr (PROBE == 5) ph::conv_gln(p, lds);
    xcd_barrier(bar);
    { gm::DenseSched S; S.init(T_TOK, DM); EpiOut e; e.xin = p.x; e.lgate = 0; if constexpr (D8_OUT0) gm::gemm_phase<EpiOut, gm::DenseSched, true>(lds, p, p.AO, p.w_out0t, 0, DM / 2, S, e, W8_E8M0, A8_E8M0); else gm::gemm_phase(lds, p, p.AO, p.w_out0t, 0, DM, S, e); }
    xcd_barrier(bar);
    ph::router<false, true>(p, 0, lds, p.norm0_ffn, 1);
    if constexpr (PROBE == 12) { ph::router<true>(p, 0, lds); ph::router<true>(p, 0, lds); }
    xcd_barrier(bar);
    if constexpr (PROBE == 11) { xcd_barrier(bar); xcd_barrier(bar); xcd_barrier(bar); xcd_barrier(bar); xcd_barrier(bar); xcd_barrier(bar); xcd_barrier(bar); xcd_barrier(bar); xcd_barrier(bar); xcd_barrier(bar); }
    gm::moe_tables(tab, p.cnt);
    { gm::MoeSched<true> S; S.init(tab); EpiGU e; e.xin = nullptr; e.lgate = 0; gm::gemm_phase<EpiGU, gm::MoeSched<true>, true>(lds, p, p.H, p.w_gut0, (size_t)2048 * (DM / 2), DM / 2, S, e, W8_E8M0, A8_E8M0); if constexpr (PROBE == 3) gm::gemm_phase<EpiGU, gm::MoeSched<true>, true>(lds, p, p.H, p.w_gut0, (size_t)2048 * (DM / 2), DM / 2, S, e, W8_E8M0, A8_E8M0); }
    xcd_barrier(bar);
    { gm::MoeSched<false> S; S.init(tab); EpiDown e; e.xin = nullptr; e.lgate = 0; gm::gemm_phase<EpiDown, gm::MoeSched<false>, true>(lds, p, p.ACT, p.w_dt0, (size_t)DM * (EFF / 2), EFF / 2, S, e, W8_E8M0, A8_E8M0); if constexpr (PROBE == 8) gm::gemm_phase<EpiDown, gm::MoeSched<false>, true>(lds, p, p.ACT, p.w_dt0, (size_t)DM * (EFF / 2), EFF / 2, S, e, W8_E8M0, A8_E8M0); }
    xcd_barrier(bar);
    ph::norm_rows<1, D8_IN1>(p, nullptr, p.norm1_mix, 2, 1, tab);
    xcd_barrier(bar);
    { const int c = blockIdx.x, G = gridDim.x; int tfirst, tcount, tstride;
      if (G == 256) { tstride = 1; if (c < 64) { tcount = 18; tfirst = 18 * c; } else { tcount = 26; tfirst = 1152 + 26 * (c - 64); } }
      else { tstride = G; tfirst = c; tcount = c < 6144 ? (6144 - c + G - 1) / G : 0; }
      const bool t_first = ((c >> 3) & 1) != 0;
      if (t_first) { ph::transposer(p, lds, 7096 + tfirst, tcount, tstride); __syncthreads(); }
      { gm::DenseSched S; S.init(T_TOK, N_IN1); EpiIn1 e; e.xin = nullptr; e.lgate = 0; gm::gemm_phase(lds, p, p.H, p.w_in1t, 0, DM, S, e); }
      if (!t_first) { __syncthreads(); ph::transposer(p, lds, 7096 + tfirst, tcount, tstride); } }
    xcd_barrier(bar);
    ph::lru_conv(p);
    if constexpr (PROBE == 9) { ph::lru_conv(p); ph::lru_conv(p); }
    xcd_barrier(bar);
    ph::lru(p, lds);
    if constexpr (PROBE == 6) ph::lru(p, lds);
    xcd_barrier(bar);
    { gm::DenseSched S; S.init(T_TOK, DM); EpiOut e; e.xin = nullptr; e.lgate = 2; gm::gemm_phase(lds, p, p.AO, p.w_out1t, 0, LRU_W, S, e); }
    xcd_barrier(bar);
    ph::router<false, true>(p, 1, lds, p.norm1_ffn, 3);
    xcd_barrier(bar);
    gm::moe_tables(tab, p.cnt + 32);
    { gm::MoeSched<true> S; S.init(tab); EpiGU e; e.xin = nullptr; e.lgate = 0; gm::gemm_phase<EpiGU, gm::MoeSched<true>, true>(lds, p, p.H, p.w_gut1, (size_t)2048 * (DM / 2), DM / 2, S, e, W8_E8M0, A8_E8M0); }
    xcd_barrier(bar);
    { gm::MoeSched<false> S; S.init(tab); EpiDown e; e.xin = nullptr; e.lgate = 0; gm::gemm_phase<EpiDown, gm::MoeSched<false>, true>(lds, p, p.ACT, p.w_dt1, (size_t)DM * (EFF / 2), EFF / 2, S, e, W8_E8M0, A8_E8M0); }
    xcd_barrier(bar);
    ph::norm_rows<2>(p, nullptr, p.norm_final, 0, 3, tab);
}

static inline size_t al256(size_t x) { return (x + 255) & ~(size_t)255; }

extern "C" void kernel_launch(void* const* d_in, const int* in_sizes, int n_in, void* d_out, int out_size, void* d_ws, size_t ws_size, hipStream_t stream) {
    Params p{};
    const float** ip = (const float**)&p.x;
    for (int i = 0; i < 38; ++i) ip[i] = (const float*)d_in[i];
    p.out = (float*)d_out;
    char* w = (char*)d_ws; size_t off = 0;
    auto take = [&](size_t bytes) { char* r = w + off; off += al256(bytes); return r; };
    p.bar = (unsigned*)take(16384); p.cnt = (int*)take(256);
    const size_t zero_bytes = off;
    p.mod = (float*)take(4 * 4 * 6144 * 4); p.wrt = (float*)take((size_t)2 * 4 * 48 * 2048 * 4); p.rbias = (float*)take(2 * 4 * 48 * 4);
    p.w_in0t = (bf16_t*)take((size_t)N_IN0 * DM * 2); p.w_out0t = (bf16_t*)take((size_t)DM * DM * 2);
    p.w_gut0 = (bf16_t*)take((size_t)NEXP * 2048 * DM); p.w_dt0 = (bf16_t*)take((size_t)NEXP * DM * EFF);
    p.w_in1t = (bf16_t*)take((size_t)N_IN1 * DM * 2); p.w_out1t = (bf16_t*)take((size_t)DM * LRU_W * 2);
    p.w_gut1 = (bf16_t*)take((size_t)NEXP * 2048 * DM); p.w_dt1 = (bf16_t*)take((size_t)NEXP * DM * EFF);
    p.w_lru = (bf16_t*)take((size_t)2 * 2 * 16 * 2 * 96 * 192 * 2);
    p.H = (bf16_t*)take((size_t)T_TOK * DM * 2); p.G = (bf16_t*)take((size_t)T_TOK * N_IN1 * 2); p.AO = (bf16_t*)take((size_t)T_TOK * LRU_W * 2); p.HF = (bf16_t*)take((size_t)256 * 32 * 8 * 3 * 64 * 8);
    p.XA = (bf16_t*)take((size_t)T_TOK * DM * 2); p.ACT = (bf16_t*)take((size_t)ROWS_PAD * EFF * 2); p.YB = (bf16_t*)take((size_t)ROWS_PAD * DM * 2);
    p.XC = (bf16_t*)take((size_t)T_TOK * LRU_W * 2); p.KVH = (bf16_t*)take((size_t)NBATCH * 8 * 2 * SEQ * 128 * 2);
    p.tokl = (int*)take((size_t)NEXP * ECAP * 4); p.gatel = (float*)take((size_t)NEXP * ECAP * 4); p.asg = (int*)take((size_t)T_TOK * 2 * 4);
    if (off > ws_size) return;
    (void)hipMemsetAsync(d_ws, 0, zero_bytes, stream);
    static int grid = 0;
    if (!grid) { int dev = 0, cus = 0, per_cu = 0; (void)hipGetDevice(&dev); (void)hipDeviceGetAttribute(&cus, hipDeviceAttributeMultiprocessorCount, dev);
        (void)hipFuncSetAttribute((const void*)mega, hipFuncAttributeMaxDynamicSharedMemorySize, LDS_TOTAL);
        (void)hipOccupancyMaxActiveBlocksPerMultiprocessor(&per_cu, mega, 512, LDS_TOTAL);
        grid = cus * (per_cu < 1 ? per_cu : 1); }
    if (grid > 0) mega<<<grid, 512, LDS_TOTAL, stream>>>(p);
}
```

```cpp
#include <hip/hip_runtime.h>
#include <stdint.h>

typedef unsigned short bf16_t;
typedef float f32x4 __attribute__((ext_vector_type(4)));

#define DI __device__ __forceinline__

constexpr int T_TOK = 16384, DM = 2048, SEQ = 4096, NBATCH = 4;
constexpr int N_IN0 = 5120, N_IN1 = 5376, LRU_W = 2688, LRU_BW = 168;
constexpr int NEXP = 32, EFF = 1024, ECAP = 16384, ROWS_PAD = 40960;

DI float bf2f(bf16_t b) { return __uint_as_float(((unsigned)b) << 16); }
DI bf16_t f2bf(float f) { unsigned u = __float_as_uint(f); u += 0x7FFFu + ((u >> 16) & 1u); return (bf16_t)(u >> 16); }
DI float sigmoidf_(float x) { return __builtin_amdgcn_rcpf(1.0f + __expf(-x)); }
DI float siluf_(float x) { return x * __builtin_amdgcn_rcpf(1.0f + __expf(-x)); }
DI float gelu_tanh(float x) { const float u = 0.7978845608028654f * (x + 0.044715f * x * x * x); return x * __builtin_amdgcn_rcpf(1.0f + __expf(-2.0f * u)); }
DI float wave_sum(float v) { for (int o = 32; o > 0; o >>= 1) v += __shfl_xor(v, o); return v; }
DI float wave_max(float v) { for (int o = 32; o > 0; o >>= 1) v = fmaxf(v, __shfl_xor(v, o)); return v; }

struct Params {
    const float *x, *c;
    const float *norm0_mix, *ada0_mix_w, *ada0_mix_b, *w_in0, *conv_w, *conv_b, *conv_norm_g, *conv_norm_b, *w_out0;
    const float *norm0_ffn, *ada0_ffn_w, *ada0_ffn_b, *moe0_w_group, *moe0_w_expert, *moe0_w_gate_up, *moe0_w_down;
    const float *norm1_mix, *ada1_mix_w, *ada1_mix_b, *w_in1, *lru_conv_w, *lru_conv_b, *lru_w_a, *lru_b_a, *lru_w_x, *lru_b_x, *lru_lambda, *w_out1;
    const float *norm1_ffn, *ada1_ffn_w, *ada1_ffn_b, *moe1_w_group, *moe1_w_expert, *moe1_w_gate_up, *moe1_w_down;
    const float *norm_final;
    float* out;
    unsigned* bar; int* cnt;
    float* mod;
    float* wrt;
    float* rbias;
    bf16_t *w_in0t, *w_out0t, *w_gut0, *w_dt0, *w_in1t, *w_out1t, *w_gut1, *w_dt1, *w_lru;
    bf16_t *H, *G, *AO, *HF, *ACT, *YB, *XC, *KVH;
    bf16_t* XA;
    int* tokl; float* gatel; int* asg;
};

constexpr bool YB8_E = true;
struct GUnit { int rowbase; int nvalid; int e; const int* gather; };
struct GArgs { const bf16_t* A; const bf16_t* Bt; size_t bt_estride; long long lda, K, moe_layer; const float* xin; long long lgate; };
typedef unsigned u32x4_ __attribute__((ext_vector_type(4)));
typedef __bf16 bf2v_ __attribute__((ext_vector_type(2)));
typedef float f32x2_ __attribute__((ext_vector_type(2)));
DI unsigned pk2e(float a, float b) { f32x2_ v = {a, b}; bf2v_ r = __builtin_convertvector(v, bf2v_); return __builtin_bit_cast(unsigned, r); }
DI u32x4_ pack8(f32x4 a, f32x4 b) { return (u32x4_){pk2e(a[0], a[1]), pk2e(a[2], a[3]), pk2e(b[0], b[1]), pk2e(b[2], b[3])}; }
struct EpiIn0 { static constexpr bool GATHER = false; const float* xin; int lgate; DI void operator()(const Params& p, const GUnit& u, int r, int col0, f32x4 lo0, f32x4 lo1, f32x4 hi0, f32x4 hi1) const {
    const int row = u.rowbase + r;
    if (col0 < 3072) { bf16_t* o = p.G + (size_t)row * N_IN0 + col0; *(u32x4_*)o = pack8(lo0, lo1); *(u32x4_*)(o + 128) = pack8(hi0, hi1); }
    else { const int b = row / SEQ, t = row % SEQ, i0 = (col0 - 3072) >> 7, i1 = i0 + 1;
        bf16_t* o0 = p.KVH + ((size_t)((b * 8 + (i0 & 7)) * 2 + (i0 >> 3)) * SEQ + t) * 128 + (col0 & 127);
        bf16_t* o1 = p.KVH + ((size_t)((b * 8 + (i1 & 7)) * 2 + (i1 >> 3)) * SEQ + t) * 128 + (col0 & 127);
        *(u32x4_*)o0 = pack8(lo0, lo1); *(u32x4_*)o1 = pack8(hi0, hi1); } } };
struct EpiOut { static constexpr bool GATHER = false; const float* xin; int lgate; DI void operator()(const Params& p, const GUnit& u, int r, int col0, f32x4 lo0, f32x4 lo1, f32x4 hi0, f32x4 hi1) const {
    const int row = u.rowbase + r, b = row / SEQ; const float* gt = p.mod + (lgate * 4 + b) * 6144 + 4096 + col0; bf16_t* o = p.XA + (size_t)row * DM + col0;
    f32x4 r0, r1, r2, r3;
    if (xin) { const float* xi = xin + (size_t)row * DM + col0; r0 = *(const f32x4*)xi; r1 = *(const f32x4*)(xi + 4); r2 = *(const f32x4*)(xi + 128); r3 = *(const f32x4*)(xi + 132); }
    else { const u32x4_ a = *(const u32x4_*)o, c = *(const u32x4_*)(o + 128);
        r0 = (f32x4){__uint_as_float(a[0] << 16), __uint_as_float(a[0] & 0xffff0000u), __uint_as_float(a[1] << 16), __uint_as_float(a[1] & 0xffff0000u)};
        r1 = (f32x4){__uint_as_float(a[2] << 16), __uint_as_float(a[2] & 0xffff0000u), __uint_as_float(a[3] << 16), __uint_as_float(a[3] & 0xffff0000u)};
        r2 = (f32x4){__uint_as_float(c[0] << 16), __uint_as_float(c[0] & 0xffff0000u), __uint_as_float(c[1] << 16), __uint_as_float(c[1] & 0xffff0000u)};
        r3 = (f32x4){__uint_as_float(c[2] << 16), __uint_as_float(c[2] & 0xffff0000u), __uint_as_float(c[3] << 16), __uint_as_float(c[3] & 0xffff0000u)}; }
    *(u32x4_*)o = pack8(r0 + *(const f32x4*)gt * lo0, r1 + *(const f32x4*)(gt + 4) * lo1); *(u32x4_*)(o + 128) = pack8(r2 + *(const f32x4*)(gt + 128) * hi0, r3 + *(const f32x4*)(gt + 132) * hi1); } };
DI unsigned pk4_fp8e(float a, float b, float c, float d, float sc) { a = fminf(fmaxf(a * sc, -448.f), 448.f); b = fminf(fmaxf(b * sc, -448.f), 448.f); c = fminf(fmaxf(c * sc, -448.f), 448.f); d = fminf(fmaxf(d * sc, -448.f), 448.f);
    unsigned w = 0u; w = __builtin_amdgcn_cvt_pk_fp8_f32(a, b, w, false); w = __builtin_amdgcn_cvt_pk_fp8_f32(c, d, w, true); return w; }
struct EpiGU { static constexpr bool GATHER = true; const float* xin; int lgate; DI void operator()(const Params& p, const GUnit& u, int r, int col0, f32x4 lo0, f32x4 lo1, f32x4 hi0, f32x4 hi1) const {
    f32x4 a0, a1;
#pragma unroll
    for (int j = 0; j < 4; ++j) { a0[j] = siluf_(lo0[j]) * hi0[j]; a1[j] = siluf_(lo1[j]) * hi1[j]; }
    *(uint2*)((unsigned char*)p.ACT + (size_t)(u.rowbase + r) * EFF + (col0 >> 8) * 128 + (col0 & 127)) = make_uint2(pk4_fp8e(a0[0], a0[1], a0[2], a0[3], 8.f), pk4_fp8e(a1[0], a1[1], a1[2], a1[3], 8.f)); } };
struct EpiDown { static constexpr bool GATHER = false; const float* xin; int lgate; DI void operator()(const Params& p, const GUnit& u, int r, int col0, f32x4 lo0, f32x4 lo1, f32x4 hi0, f32x4 hi1) const {
    const float g = p.gatel[(u.gather - p.tokl) + r];
    if constexpr (YB8_E) { const float gs = g * 64.f; unsigned char* o = (unsigned char*)p.YB + (size_t)(u.rowbase + r) * DM + col0;
        *(uint2*)o = make_uint2(pk4_fp8e(lo0[0], lo0[1], lo0[2], lo0[3], gs), pk4_fp8e(lo1[0], lo1[1], lo1[2], lo1[3], gs)); *(uint2*)(o + 128) = make_uint2(pk4_fp8e(hi0[0], hi0[1], hi0[2], hi0[3], gs), pk4_fp8e(hi1[0], hi1[1], hi1[2], hi1[3], gs)); }
    else { bf16_t* o = p.YB + (size_t)(u.rowbase + r) * DM + col0; *(u32x4_*)o = pack8(lo0 * g, lo1 * g); *(u32x4_*)(o + 128) = pack8(hi0 * g, hi1 * g); } } };
struct EpiIn1 { static constexpr bool GATHER = false; const float* xin; int lgate; DI void operator()(const Params& p, const GUnit& u, int r, int col0, f32x4 lo0, f32x4 lo1, f32x4 hi0, f32x4 hi1) const {
    bf16_t* o = p.G + (size_t)(u.rowbase + r) * N_IN1 + col0;
    if (col0 < LRU_W) {
#pragma unroll
        for (int j = 0; j < 4; ++j) { lo0[j] = gelu_tanh(lo0[j]); lo1[j] = gelu_tanh(lo1[j]); } }
    if (col0 + 128 < LRU_W) {
#pragma unroll
        for (int j = 0; j < 4; ++j) { hi0[j] = gelu_tanh(hi0[j]); hi1[j] = gelu_tanh(hi1[j]); } }
    *(u32x4_*)o = pack8(lo0, lo1); *(u32x4_*)(o + 128) = pack8(hi0, hi1); } };

#define LAS __attribute__((address_space(3)))
typedef short bf16x8 __attribute__((ext_vector_type(8)));
DI int opaque_tid() { int t = threadIdx.x; asm volatile("" : "+v"(t)); return t; }
namespace gm {
constexpr int BM = 256, BK = 64, HALF = 128, HTB = HALF * BK * 2, STAGE_BYTES = 8 * HTB, NXCD = 8, WGM = 4;
constexpr int TAB_OFF = STAGE_BYTES;
DI int lds_byte(int r, int c) { const int st = (r >> 4) * 2 + (c >> 5), rr = r & 15, cc = c & 31, ob = rr * 64 + cc * 2; return st * 1024 + (ob ^ (((ob >> 9) & 1) << 5)); }
DI int perm32(int rho) { const int n = rho >> 4, i = rho & 15; return 8 * (i >> 2) + 4 * n + (i & 3); }
DI void stage_rc(int b, int& R, int& C) { const int st = b / 1024, sb = b % 1024, swz = sb ^ (((sb >> 9) & 1) << 5); R = (st >> 1) * 16 + swz / 64; C = (st & 1) * 32 + (swz % 64) / 2; }
struct Unit { int arow, nvalid, orow, pn, e, goff; };
struct DenseSched {
    static constexpr bool GATHER = false, HALF_SKIP = false;
    int nM, nN, nwg, G, c;
    DI void init(int M, int N) { nM = M / BM; nN = N / BM; nwg = nM * nN; G = gridDim.x; c = blockIdx.x; }
    DI bool next(int i, Unit& u) const {
        const long L = (long)i * G + c; if (L >= nwg) return false;
        int wgid = (int)L; { const int q = nwg / NXCD, r = nwg % NXCD, xcd = wgid % NXCD, off = wgid / NXCD; wgid = (xcd < r ? xcd * (q + 1) : r * (q + 1) + (xcd - r) * q) + off; }
        const int nig = WGM * nN, gid = wgid / nig, fm = gid * WGM, gsz = (nM - fm) < WGM ? (nM - fm) : WGM;
        const int pm = fm + ((wgid % nig) % gsz); u.pn = (wgid % nig) / gsz; u.arow = pm * BM; u.orow = pm * BM; u.nvalid = BM; u.e = 0; u.goff = 0; return true;
    }
};
template <bool GATH> struct MoeSched {
    static constexpr bool GATHER = GATH, HALF_SKIP = true;
    const LAS int* tab; int G, c;
    DI void init(const LAS int* t) { tab = t; G = gridDim.x; c = blockIdx.x; }
    DI bool next(int i, Unit& u) const {
        const int L = i * G + c, mtile = L >> 3; const int total = __builtin_amdgcn_readfirstlane(tab[32]);
        if (mtile >= total) return false;
        int e = 0; for (int j = 1; j < 32; ++j) { if (__builtin_amdgcn_readfirstlane(tab[j]) <= mtile) e = j; }
        const int mt = mtile - __builtin_amdgcn_readfirstlane(tab[e]); const int cn = __builtin_amdgcn_readfirstlane(tab[64 + e]);
        u.e = e; u.pn = L & 7; u.orow = mtile * BM; u.arow = mtile * BM; u.nvalid = (cn - mt * BM) < BM ? (cn - mt * BM) : BM; u.goff = e * ECAP + mt * BM; return true;
    }
};
DI void moe_tables(LAS int* tab, const int* cnt) {
    if (threadIdx.x == 0) { int run = 0; for (int e = 0; e < 32; ++e) { const int cn = cnt[e]; tab[e] = run; tab[64 + e] = cn; run += (cn + 255) >> 8; } tab[32] = run; }
    __syncthreads();
}

typedef int i32x8 __attribute__((ext_vector_type(8)));
typedef int i32x4 __attribute__((ext_vector_type(4)));
DI void mfma8(f32x4& acc, const i32x8& w8, const i32x8& x8, int ws, int as) {
    asm volatile("v_mfma_scale_f32_16x16x128_f8f6f4 %0, %1, %2, %0, %3, %4 op_sel_hi:[0,0,0]" : "+v"(acc) : "v"(w8), "v"(x8), "v"(ws), "v"(as)); }
template <class Epi, class Sched, bool FP8 = false>
DI void gemm_phase(LAS unsigned char* lds, const Params& p, const bf16_t* A, const bf16_t* Bt, size_t bt_estride, int K, const Sched& S, const Epi& E, int wscale = 0x7f7f7f7f, int ascale = 0x7f7f7f7f) {
    const int tid = opaque_tid(), wid = __builtin_amdgcn_readfirstlane(tid >> 6), lane = tid & 63, wr = wid >> 2, wc = wid & 3, fr = lane & 15, fq = lane >> 4;
    const int nt = K / BK;
    unsigned voffA[2], voffB[2];
#pragma unroll
    for (int i = 0; i < 2; ++i) { int R, C; stage_rc(tid * 16 + i * 8192, R, C); voffA[i] = (unsigned)(R * K + C) * 2u; voffB[i] = (unsigned)(((R & ~31) + perm32(R & 31)) * K + C) * 2u; }
    const size_t kstep = (size_t)(BK * 2), hstep = (size_t)HALF * K * 2, tstep = 2 * hstep;
    const unsigned ldsw = (unsigned)wid * 1024u;
    const int aoff = lds_byte(wr * 64 + fr, fq * 8), boff = lds_byte(wc * 32 + fr, fq * 8);
#define G_SA(b, h) (((b) * 2 + (h)) * HTB)
#define G_SB(b, h) ((4 + (b) * 2 + (h)) * HTB)
#define G_STAGE(bufoff, gbase, voff) do { _Pragma("unroll") for (int _i = 0; _i < 2; ++_i) \
        __builtin_amdgcn_global_load_lds((const unsigned*)((const char*)(gbase) + (voff)[_i]), (LAS unsigned*)(lds + (bufoff) + ldsw + _i * 8192), 16, 0, 0); } while (0)
#define G_STAGE_A(bufoff, ubase, gv, h, koff) do { if constexpr (Sched::GATHER) { G_STAGE(bufoff, (const char*)A + (koff), gv[h]); } else { G_STAGE(bufoff, (ubase) + (h) * hstep + (koff), voffA); } } while (0)
#define G_LD16(off_) (*(const LAS i32x4*)(lds + (off_)))
#define G_LD16B(off_) (*(const LAS bf16x8*)(lds + (off_)))
#define G_LDA(dst, b, h) do { _Pragma("unroll") for (int m = 0; m < 4; ++m) { if constexpr (FP8) dst##8[m] = __builtin_shufflevector(G_LD16(G_SA(b, h) + aoff + m * 2048), G_LD16(G_SA(b, h) + aoff + m * 2048 + 1024), 0, 1, 2, 3, 4, 5, 6, 7); \
        else { dst[m][0] = G_LD16B(G_SA(b, h) + aoff + m * 2048); dst[m][1] = G_LD16B(G_SA(b, h) + aoff + m * 2048 + 1024); } } } while (0)
#define G_LDB(dst, b, h) do { _Pragma("unroll") for (int n = 0; n < 2; ++n) { if constexpr (FP8) dst##8[n] = __builtin_shufflevector(G_LD16(G_SB(b, h) + boff + n * 2048), G_LD16(G_SB(b, h) + boff + n * 2048 + 1024), 0, 1, 2, 3, 4, 5, 6, 7); \
        else { dst[n][0] = G_LD16B(G_SB(b, h) + boff + n * 2048); dst[n][1] = G_LD16B(G_SB(b, h) + boff + n * 2048 + 1024); } } } while (0)
#define G_MMA(ai, bj, At, Bt_) do { __builtin_amdgcn_s_setprio(1); _Pragma("unroll") for (int m = 0; m < 4; ++m) _Pragma("unroll") for (int n = 0; n < 2; ++n) { \
        if constexpr (FP8) mfma8(acc[ai][bj][m][n], Bt_##8[n], At##8[m], wscale, ascale); \
        else { _Pragma("unroll") for (int k = 0; k < 2; ++k) acc[ai][bj][m][n] = __builtin_amdgcn_mfma_f32_16x16x32_bf16(Bt_[n][k], At[m][k], acc[ai][bj][m][n], 0, 0, 0); } } \
        __builtin_amdgcn_s_setprio(0); } while (0)
#define G_WAIT_V(n) asm volatile("s_waitcnt vmcnt(" #n ")" ::: "memory")
#define G_WAIT_L(n) asm volatile("s_waitcnt lgkmcnt(" #n ")" ::: "memory")
#define G_BAR __builtin_amdgcn_s_barrier()
#define G_SCHED __builtin_amdgcn_sched_barrier(0)
    Unit cur, nxt; int ui = 0;
    if (!S.next(0, cur)) return;
    f32x4 acc[2][2][4][2];
#pragma unroll
    for (int a = 0; a < 2; ++a)
#pragma unroll
        for (int b = 0; b < 2; ++b)
#pragma unroll
            for (int m = 0; m < 4; ++m)
#pragma unroll
                for (int n = 0; n < 2; ++n) acc[a][b][m][n] = (f32x4){0.f, 0.f, 0.f, 0.f};
    bf16x8 At[4][2], B0[2][2], B1[2][2]; i32x8 At8[4], B08[2], B18[2];
    unsigned gcur[2][2] = {{0u, 0u}, {0u, 0u}}, gnxt[2][2] = {{0u, 0u}, {0u, 0u}};
    auto gather_offs = [&](const Unit& u, unsigned (&g)[2][2]) {
        if constexpr (Sched::GATHER) {
#pragma unroll
            for (int h = 0; h < 2; ++h)
#pragma unroll
                for (int i = 0; i < 2; ++i) { int tz = tid; asm volatile("" : "+v"(tz)); int R, C; stage_rc(tz * 16 + i * 8192, R, C); const int r = h * HALF + R; const int tk = p.tokl[u.goff + (r < u.nvalid ? r : 0)]; const int tok = r < u.nvalid ? tk : 0; g[h][i] = (unsigned)(tok * K + C) * 2u; }
        }
    };
    const char* cA = (const char*)A + (size_t)(cur.arow / BM) * tstep; const char* cB = (const char*)Bt + ((size_t)cur.e * bt_estride) * 2 + (size_t)cur.pn * tstep;
    gather_offs(cur, gcur);
    G_STAGE(G_SB(0, 0), cB, voffB); G_STAGE_A(G_SA(0, 0), cA, gcur, 0, 0); G_STAGE(G_SB(0, 1), cB + hstep, voffB); G_STAGE_A(G_SA(0, 1), cA, gcur, 1, 0);
    if (wr == 1) G_BAR;
    G_WAIT_V(4); G_BAR;
    G_STAGE(G_SB(1, 0), cB + kstep, voffB); G_STAGE_A(G_SA(1, 0), cA, gcur, 0, kstep); G_STAGE(G_SB(1, 1), cB + hstep + kstep, voffB);
    G_WAIT_V(6); G_BAR;
    for (;;) {
        const bool has_next = S.next(ui + 1, nxt);
        const char* nA = has_next ? (const char*)A + (size_t)(nxt.arow / BM) * tstep : cA;
        const char* nB = has_next ? (const char*)Bt + ((size_t)nxt.e * bt_estride) * 2 + (size_t)nxt.pn * tstep : cB;
        if constexpr (Sched::GATHER) { if (has_next) gather_offs(nxt, gnxt); else {
#pragma unroll
            for (int h = 0; h < 2; ++h) { gnxt[h][0] = gcur[h][0]; gnxt[h][1] = gcur[h][1]; } } }
        for (int t = 0; t < nt; t += 2) {
            const bool last = (t == nt - 2);
            const size_t k1 = (size_t)(t + 1) * kstep;
            const char* a2 = last ? nA : cA; const char* b2 = last ? nB : cB + (size_t)(t + 2) * kstep;
            const size_t k2 = last ? 0 : (size_t)(t + 2) * kstep; const size_t k3 = k2 + kstep;
            const char* b3 = b2 + kstep;
            unsigned g2[2][2];
#pragma unroll
            for (int h = 0; h < 2; ++h) { g2[h][0] = last ? gnxt[h][0] : gcur[h][0]; g2[h][1] = last ? gnxt[h][1] : gcur[h][1]; }
            G_LDB(B0, 0, 0); G_SCHED; G_LDA(At, 0, 0); G_STAGE_A(G_SA(1, 1), cA, gcur, 1, k1);
            G_WAIT_L(8); G_BAR; G_WAIT_L(0); G_MMA(0, 0, At, B0); G_BAR; G_SCHED;
            G_LDB(B1, 0, 1); G_STAGE(G_SB(0, 0), b2, voffB);
            G_BAR; G_WAIT_L(0); G_MMA(0, 1, At, B1); G_BAR;
            G_LDA(At, 0, 1); G_STAGE_A(G_SA(0, 0), a2, g2, 0, k2);
            G_BAR; G_WAIT_L(0); if (!Sched::HALF_SKIP || cur.nvalid > HALF) G_MMA(1, 0, At, B0); G_BAR; G_SCHED;
            G_STAGE(G_SB(0, 1), b2 + hstep, voffB);
            G_WAIT_V(6); G_BAR; if (!Sched::HALF_SKIP || cur.nvalid > HALF) G_MMA(1, 1, At, B1); G_BAR;
            G_LDB(B0, 1, 0); G_SCHED; G_LDA(At, 1, 0); G_STAGE_A(G_SA(0, 1), a2, g2, 1, k2);
            G_WAIT_L(8); G_BAR; G_WAIT_L(0); G_MMA(0, 0, At, B0); G_BAR; G_SCHED;
            G_LDB(B1, 1, 1); G_STAGE(G_SB(1, 0), b3, voffB);
            G_BAR; G_WAIT_L(0); G_MMA(0, 1, At, B1); G_BAR;
            G_LDA(At, 1, 1); G_STAGE_A(G_SA(1, 0), a2, g2, 0, k3);
            G_BAR; G_WAIT_L(0); if (!Sched::HALF_SKIP || cur.nvalid > HALF) G_MMA(1, 0, At, B0); G_BAR; G_SCHED;
            G_STAGE(G_SB(1, 1), b3 + hstep, voffB);
            G_WAIT_V(6); G_BAR; if (!Sched::HALF_SKIP || cur.nvalid > HALF) G_MMA(1, 1, At, B1); G_BAR;
        }
        if constexpr (FP8) asm volatile("s_nop 15\n\ts_nop 15" ::: "memory");
        { GUnit gu; gu.rowbase = cur.orow; gu.nvalid = cur.nvalid; gu.e = cur.e; gu.gather = p.tokl + cur.goff;
#pragma unroll
          for (int ai = 0; ai < 2; ++ai)
#pragma unroll
            for (int m = 0; m < 4; ++m) { const int r = ai * HALF + wr * 64 + m * 16 + fr;
              if (r < cur.nvalid) E(p, gu, r, cur.pn * BM + wc * 32 + fq * 8, acc[ai][0][m][0], acc[ai][0][m][1], acc[ai][1][m][0], acc[ai][1][m][1]); } }
        if (!has_next) break;
#pragma unroll
        for (int a = 0; a < 2; ++a)
#pragma unroll
            for (int b = 0; b < 2; ++b)
#pragma unroll
                for (int m = 0; m < 4; ++m)
#pragma unroll
                    for (int n = 0; n < 2; ++n) acc[a][b][m][n] = (f32x4){0.f, 0.f, 0.f, 0.f};
        cur = nxt; cA = nA; cB = nB; ++ui;
#pragma unroll
        for (int h = 0; h < 2; ++h) { gcur[h][0] = gnxt[h][0]; gcur[h][1] = gnxt[h][1]; }
    }
    G_WAIT_V(0);
    if (wr == 0) G_BAR;
    G_BAR;
}
}

extern __shared__ __attribute__((aligned(16))) unsigned char dyn_smem[];
constexpr int LDS_BYTES = gm::STAGE_BYTES + 1024;

typedef __bf16 bf2v __attribute__((ext_vector_type(2)));
typedef float f32x2 __attribute__((ext_vector_type(2)));
typedef float f32x16 __attribute__((ext_vector_type(16)));
typedef short s16x4 __attribute__((ext_vector_type(4)));
typedef unsigned u32x4 __attribute__((ext_vector_type(4)));
DI unsigned pk2(float a, float b) { f32x2 v = {a, b}; bf2v r = __builtin_convertvector(v, bf2v); return __builtin_bit_cast(unsigned, r); }
DI float bflo(unsigned u) { return __uint_as_float(u << 16); }
DI float bfhi(unsigned u) { return __uint_as_float(u & 0xffff0000u); }

DI unsigned pk4_fp8(float a, float b, float c, float d, float sc) {
    a = __builtin_amdgcn_fmed3f(a * sc, -448.f, 448.f); b = __builtin_amdgcn_fmed3f(b * sc, -448.f, 448.f); c = __builtin_amdgcn_fmed3f(c * sc, -448.f, 448.f); d = __builtin_amdgcn_fmed3f(d * sc, -448.f, 448.f);
    unsigned w = 0u; w = __builtin_amdgcn_cvt_pk_fp8_f32(a, b, w, false); w = __builtin_amdgcn_cvt_pk_fp8_f32(c, d, w, true); return w; }
constexpr bool D8_IN0 = true, D8_OUT0 = false, D8_IN1 = false;
constexpr bool YB8 = true;
constexpr float Y8_SCALE = 64.f;
constexpr float W8_SCALE = 256.f, A8_SCALE = 8.f;
constexpr int W8_E8M0 = 0x77777777, A8_E8M0 = 0x7c7c7c7c;
namespace ph {
DI void mods(const Params& p, LAS unsigned char* lds) {
    const int tid = opaque_tid(), wave = tid >> 6, lane = tid & 63, l8 = tid & 7, rg = tid >> 3;
    LAS float* fl = (LAS float*)lds; LAS float* red = fl + 4 * DM;
    for (int i = tid; i < 4 * DM; i += 512) fl[i] = siluf_(p.c[i]);
    __syncthreads();
    for (int u = blockIdx.x; u < 768; u += gridDim.x) {
        const int l = u / 192, c32 = u % 192;
        const float* w = l == 0 ? p.ada0_mix_w : l == 1 ? p.ada0_ffn_w : l == 2 ? p.ada1_mix_w : p.ada1_ffn_w;
        const float* bs = l == 0 ? p.ada0_mix_b : l == 1 ? p.ada0_ffn_b : l == 2 ? p.ada1_mix_b : p.ada1_ffn_b;
        f32x4 acc[4] = {{0.f, 0.f, 0.f, 0.f}, {0.f, 0.f, 0.f, 0.f}, {0.f, 0.f, 0.f, 0.f}, {0.f, 0.f, 0.f, 0.f}};
        const float* wp = w + (size_t)rg * 6144 + c32 * 32 + l8 * 4;
#pragma unroll 8
        for (int i = 0; i < 32; ++i) { const f32x4 wv = *(const f32x4*)(wp + (size_t)(64 * i) * 6144); const int k = rg + 64 * i;
#pragma unroll
            for (int b = 0; b < 4; ++b) acc[b] += fl[b * DM + k] * wv; }
#pragma unroll
        for (int b = 0; b < 4; ++b)
#pragma unroll
            for (int j = 0; j < 4; ++j) { float v = acc[b][j]; v += __shfl_xor(v, 8); v += __shfl_xor(v, 16); v += __shfl_xor(v, 32); acc[b][j] = v; }
        if (lane < 8) {
#pragma unroll
            for (int b = 0; b < 4; ++b) *(LAS f32x4*)(red + (wave * 4 + b) * 32 + lane * 4) = acc[b]; }
        __syncthreads();
        if (tid < 128) { const int b = tid >> 5, col = tid & 31; float sum = 0.f;
#pragma unroll
            for (int w8 = 0; w8 < 8; ++w8) sum += red[(w8 * 4 + b) * 32 + col];
            p.mod[(l * 4 + b) * 6144 + c32 * 32 + col] = sum + bs[c32 * 32 + col]; }
        __syncthreads();
    }
}
constexpr int NT_UNITS = (640 + 256 + 672 + 336 + 2 * (8192 + 4096)) / 2;
struct UD { const float* sp; bf16_t* dst; int K, N, mode, e, kt, ntile; };
DI UD tdecode(const Params& p, int u, int lane) {
    const float* srcs[8] = {p.w_in0, p.w_out0, p.w_in1, p.w_out1, p.moe0_w_gate_up, p.moe0_w_down, p.moe1_w_gate_up, p.moe1_w_down};
    bf16_t* dsts[8] = {p.w_in0t, p.w_out0t, p.w_in1t, p.w_out1t, p.w_gut0, p.w_dt0, p.w_gut1, p.w_dt1};
    constexpr int Ks[8] = {DM, DM, DM, LRU_W, DM, EFF, DM, EFF}, Ns[8] = {N_IN0, DM, N_IN1, DM, 2048, DM, 2048, DM}, nus[8] = {320, 128, 336, 168, 4096, 2048, 4096, 2048};
    constexpr int modes[8] = {D8_IN0 ? 2 : 0, D8_OUT0 ? 2 : 0, D8_IN1 ? 2 : 0, 0, 3, 2, 3, 2};
    int v = u, mi = 0;
#pragma unroll
    for (int m = 0; m < 8; ++m) { if (mi == m && v >= nus[m]) { v -= nus[m]; mi = m + 1; } }
    UD d; const float* src = srcs[0]; d.dst = dsts[0]; d.K = Ks[0]; d.N = Ns[0]; d.mode = modes[0];
#pragma unroll
    for (int m = 1; m < 8; ++m) if (mi == m) { src = srcs[m]; d.dst = dsts[m]; d.K = Ks[m]; d.N = Ns[m]; d.mode = modes[m]; }
    const int ntl = d.N / 256, ktl = d.K / 128; d.e = v / (ktl * ntl); const int rem = v % (ktl * ntl); d.kt = rem / ntl; d.ntile = rem % ntl;
    d.sp = src + (size_t)d.e * d.K * d.N + (size_t)(d.kt * 128) * d.N + d.ntile * 256 + lane * 4;
    return d;
}
DI void transposer(const Params& p, LAS unsigned char* lds, int first, int count, int stride) {
    const int tid = opaque_tid(), wave = tid >> 6, lane = tid & 63;
    LAS float* fl = (LAS float*)lds;
    if (count <= 0) return;
    if (tdecode(p, first, lane).mode & 2) {
        LAS unsigned* td = (LAS unsigned*)lds;
        const int nl = lane & 15, ks = lane >> 4;
        auto src_of = [&](const UD& d, int g, int j) -> const float* { const int kq = 4 * (g >> 2) + ks, nq = 16 * (g & 3) + nl; return d.sp - lane * 4 + (size_t)(4 * kq + j) * d.N + 4 * nq; };
        f32x4 va[4][4], vb[4][4];
        auto load_unit = [&](int u, f32x4 (&v)[4][4]) { const UD dd = tdecode(p, u, lane);
#pragma unroll
            for (int i = 0; i < 4; ++i)
#pragma unroll
                for (int j = 0; j < 4; ++j) v[i][j] = *(const f32x4*)src_of(dd, wave * 4 + i, j); };
        auto process = [&](int jn, f32x4 (&v)[4][4]) { const int u = first + jn * stride;
            const UD d = tdecode(p, u, lane); const int K = d.K, N = d.N, mode = d.mode, e = d.e, kt = d.kt, ntile = d.ntile;
            LAS unsigned* tile = td + (jn & 1) * (256 * 33);
#pragma unroll
            for (int i = 0; i < 4; ++i) { const int g = wave * 4 + i, kq = 4 * (g >> 2) + ks, nq = 16 * (g & 3) + nl;
#pragma unroll
                for (int en = 0; en < 4; ++en) tile[(4 * nq + en) * 33 + kq] = pk4_fp8(v[i][0][en], v[i][1][en], v[i][2][en], v[i][3][en], W8_SCALE); }
            __syncthreads();
            if (jn + 2 < count) load_unit(u + 2 * stride, v);
            { const int n = tid >> 1, kh = tid & 1; const int ng = ntile * 256 + n; const int jg = ng & 1023; const int np = (mode & 1) ? (256 * (jg >> 7) + (ng < 1024 ? 0 : 128) + (jg & 127)) : ng;
              unsigned char* dp = (unsigned char*)d.dst + (size_t)e * N * K + (size_t)np * K + kt * 128 + kh * 64;
#pragma unroll
              for (int jj = 0; jj < 4; ++jj) { const LAS unsigned* tp = tile + n * 33 + kh * 16 + jj * 4; *(uint4*)(dp + jj * 16) = make_uint4(tp[0], tp[1], tp[2], tp[3]); } } };
        load_unit(first, va); if (count > 1) load_unit(first + stride, vb);
        for (int jn = 0; jn < count; jn += 2) { process(jn, va); if (jn + 1 < count) process(jn + 1, vb); }
        __syncthreads();
        return;
    }
    f32x4 vv[16];
    { const UD d0 = tdecode(p, first, lane);
#pragma unroll
        for (int i = 0; i < 16; ++i) vv[i] = *(const f32x4*)(d0.sp + (size_t)(i * 8 + wave) * d0.N); }
    for (int j = 0; j < count; ++j) { const int u = first + j * stride;
        const UD d = tdecode(p, u, lane); const int K = d.K, N = d.N, mode = d.mode, e = d.e, kt = d.kt, ntile = d.ntile; bf16_t* dst = d.dst;
#pragma unroll
        for (int i = 0; i < 16; ++i) { LAS float* tp = fl + (i * 8 + wave) * 257 + lane * 4; tp[0] = vv[i][0]; tp[1] = vv[i][1]; tp[2] = vv[i][2]; tp[3] = vv[i][3]; }
        __syncthreads();
        if (j + 1 < count) { const UD dn = tdecode(p, u + stride, lane);
#pragma unroll
            for (int i = 0; i < 16; ++i) vv[i] = *(const f32x4*)(dn.sp + (size_t)(i * 8 + wave) * dn.N); }
        { const int n = tid >> 1, kh = tid & 1; const int ng = ntile * 256 + n; const int jg = ng & 1023; const int np = (mode & 1) ? (256 * (jg >> 7) + (ng < 1024 ? 0 : 128) + (jg & 127)) : ng;
          bf16_t* dp = dst + (size_t)e * N * K + (size_t)np * K + kt * 128 + kh * 64;
#pragma unroll
          for (int jj = 0; jj < 8; ++jj) { unsigned w4[4];
#pragma unroll
              for (int q = 0; q < 4; ++q) { const int k = kh * 64 + jj * 8 + q * 2; w4[q] = pk2(fl[k * 257 + n], fl[(k + 1) * 257 + n]); }
              *(uint4*)(dp + jj * 8) = make_uint4(w4[0], w4[1], w4[2], w4[3]); } }
        __syncthreads();
    }
}
DI void lru_weights(const Params& p) {
    const int tid = opaque_tid();
    for (size_t i = (size_t)blockIdx.x * 512 + tid; i < (size_t)2 * 2 * 16 * 4 * 48 * 192; i += (size_t)gridDim.x * 512) {
        const int k = i % 192, j = (i / 192) % 48, qt = (i / (192 * 48)) % 4, n = (i / (192 * 48 * 4)) % 16, which = (i / (192 * 48 * 4 * 16)) % 2, dir = i / (192 * 48 * 4 * 16 * 2);
        const float* w = which == 0 ? p.lru_w_a : p.lru_w_x; float v = 0.f;
        if (j < 42 && k < 168) v = w[(((size_t)dir * 16 + n) * 168 + k) * 168 + qt * 42 + j];
        p.w_lru[i] = f2bf(v);
    }
}
DI void fold_router(const Params& p) {
    const int tid = opaque_tid(), wave = tid >> 6, lane = tid & 63;
    for (size_t i = (size_t)blockIdx.x * 512 + tid; i < (size_t)2 * 4 * 48 * DM; i += (size_t)gridDim.x * 512) {
        const int k = i % DM, n = (i / DM) % 48, b = (i / (DM * 48)) % 4, l = i / (DM * 48 * 4);
        const float* g = l == 0 ? p.norm0_ffn : p.norm1_ffn; const float* md = p.mod + ((l == 0 ? 1 : 3) * 4 + b) * 6144;
        const float* we = l == 0 ? p.moe0_w_expert : p.moe1_w_expert; const float* wg = l == 0 ? p.moe0_w_group : p.moe1_w_group;
        const float w = n < 32 ? we[k * 32 + n] : n < 36 ? wg[k * 4 + (n - 32)] : 0.f;
        p.wrt[i] = g[k] * (1.f + md[2048 + k]) * w;
    }
    for (int task = blockIdx.x * 8 + wave; task < 2 * 4 * 48; task += gridDim.x * 8) {
        const int n = task % 48, b = (task / 48) % 4, l = task / (48 * 4);
        const float* md = p.mod + ((l == 0 ? 1 : 3) * 4 + b) * 6144;
        const float* we = l == 0 ? p.moe0_w_expert : p.moe1_w_expert; const float* wg = l == 0 ? p.moe0_w_group : p.moe1_w_group;
        float part = 0.f;
        for (int k = lane; k < DM; k += 64) { const float w = n < 32 ? we[k * 32 + n] : n < 36 ? wg[k * 4 + (n - 32)] : 0.f; part += md[k] * w; }
        part = wave_sum(part); if (lane == 0) p.rbias[task] = part;
    }
}
template <int MODE, bool OUT8 = false> DI void norm_rows(const Params& p, const float* xin  , const float* gain, int lmod, int lgate, const LAS int* tab) {
    const int tid = opaque_tid(), wave = tid >> 6, lane = tid & 63;
    for (int row = blockIdx.x * 8 + wave; row < T_TOK; row += gridDim.x * 8) {
        const int b = row / SEQ;
        f32x4 v[8];
        if (xin) {
#pragma unroll
            for (int i = 0; i < 8; ++i) v[i] = *(const f32x4*)(xin + (size_t)row * DM + i * 256 + lane * 4);
        } else {
#pragma unroll
            for (int i = 0; i < 8; ++i) { const uint2 a = *(const uint2*)(p.XA + (size_t)row * DM + i * 256 + lane * 4); v[i] = (f32x4){bflo(a.x), bfhi(a.x), bflo(a.y), bfhi(a.y)}; }
        }
        if constexpr (MODE >= 1) {
            const int a0 = p.asg[row * 2], a1 = p.asg[row * 2 + 1];
            const size_t r0 = (size_t)tab[a0 >> 14] * 256 + (a0 & 16383), r1 = (size_t)tab[a1 >> 14] * 256 + (a1 & 16383);
            const float* gt = p.mod + (lgate * 4 + b) * 6144 + 4096;
#pragma unroll
            for (int i = 0; i < 8; ++i) { const int col = i * 256 + lane * 4; const f32x4 g4 = *(const f32x4*)(gt + col);
                if constexpr (YB8) { const unsigned y0 = *(const unsigned*)((const unsigned char*)p.YB + r0 * DM + col), y1 = *(const unsigned*)((const unsigned char*)p.YB + r1 * DM + col);
                    const f32x2 a0 = __builtin_amdgcn_cvt_pk_f32_fp8(y0, false), a1 = __builtin_amdgcn_cvt_pk_f32_fp8(y0, true), b0 = __builtin_amdgcn_cvt_pk_f32_fp8(y1, false), b1 = __builtin_amdgcn_cvt_pk_f32_fp8(y1, true);
                    const f32x4 gq = g4 * (1.f / Y8_SCALE);
                    v[i][0] += gq[0] * (a0[0] + b0[0]); v[i][1] += gq[1] * (a0[1] + b0[1]); v[i][2] += gq[2] * (a1[0] + b1[0]); v[i][3] += gq[3] * (a1[1] + b1[1]); }
                else { const uint2 y0 = *(const uint2*)(p.YB + r0 * DM + col), y1 = *(const uint2*)(p.YB + r1 * DM + col);
                v[i][0] += g4[0] * (bflo(y0.x) + bflo(y1.x)); v[i][1] += g4[1] * (bfhi(y0.x) + bfhi(y1.x));
                v[i][2] += g4[2] * (bflo(y0.y) + bflo(y1.y)); v[i][3] += g4[3] * (bfhi(y0.y) + bfhi(y1.y)); } }
            if constexpr (MODE == 1) {
#pragma unroll
                for (int i = 0; i < 8; ++i) { const uint2 w = make_uint2(pk2(v[i][0], v[i][1]), pk2(v[i][2], v[i][3])); *(uint2*)(p.XA + (size_t)row * DM + i * 256 + lane * 4) = w;
                    v[i] = (f32x4){bflo(w.x), bfhi(w.x), bflo(w.y), bfhi(w.y)}; }
            }
        }
        float ss = 0.f;
#pragma unroll
        for (int i = 0; i < 8; ++i) ss += v[i][0] * v[i][0] + v[i][1] * v[i][1] + v[i][2] * v[i][2] + v[i][3] * v[i][3];
        ss = wave_sum(ss); const float rstd = rsqrtf(ss * (1.0f / DM) + 1e-6f);
        if constexpr (MODE == 2) {
#pragma unroll
            for (int i = 0; i < 8; ++i) { const int col = i * 256 + lane * 4; const f32x4 g4 = *(const f32x4*)(gain + col); *(f32x4*)(p.out + (size_t)row * DM + col) = v[i] * rstd * g4; }
        } else { const float* md = p.mod + (lmod * 4 + b) * 6144;
#pragma unroll
            for (int i = 0; i < 8; ++i) { const int col = i * 256 + lane * 4; const f32x4 g4 = *(const f32x4*)(gain + col), sc = *(const f32x4*)(md + 2048 + col), sh = *(const f32x4*)(md + col);
                const f32x4 h = v[i] * rstd * g4 * (1.f + sc) + sh;
                if constexpr (OUT8) *(unsigned*)((unsigned char*)p.H + (size_t)row * DM + col) = pk4_fp8(h[0], h[1], h[2], h[3], A8_SCALE);
                else *(uint2*)(p.H + (size_t)row * DM + col) = make_uint2(pk2(h[0], h[1]), pk2(h[2], h[3])); } }
    }
}
template <bool DRY = false, bool NORM = false> DI void router(const Params& p, int l, LAS unsigned char* lds, const float* gain = nullptr, int lmod = 0) {
    const int tid = opaque_tid(), wave = __builtin_amdgcn_readfirstlane(tid >> 6), lane = tid & 63;
    LAS float* lg = (LAS float*)lds + (wave & 3) * (16 * 48);
    LAS float* part = (LAS float*)lds + 4 * 16 * 48 + (wave & 3) * (64 * 13);
    LAS float* rsl = (LAS float*)lds + 4 * 16 * 48 + 4 * 64 * 13 + (wave & 3) * 16;
    for (int tg = blockIdx.x; tg < T_TOK / 64; tg += gridDim.x) {
        const int tile = tg * 4 + (wave & 3), kh = wave >> 2;
        const int row0 = tile * 16, b = row0 / SEQ, r = lane & 15, q = lane >> 4;
        const bf16_t* xa = p.XA + (size_t)(row0 + r) * DM + 4 * q + kh * (DM / 2);
        const float* wt = p.wrt + (((size_t)l * 4 + b) * 48 + r) * DM + 4 * q + kh * (DM / 2);
        f32x4 acc[3] = {{0.f, 0.f, 0.f, 0.f}, {0.f, 0.f, 0.f, 0.f}, {0.f, 0.f, 0.f, 0.f}}; float ss = 0.f;
#pragma unroll 2
        for (int s = 0; s < DM / 32; ++s) {
            const uint2 ar = *(const uint2*)(xa + 16 * s); const f32x4 a4 = {bflo(ar.x), bfhi(ar.x), bflo(ar.y), bfhi(ar.y)};
            ss += a4[0] * a4[0] + a4[1] * a4[1] + a4[2] * a4[2] + a4[3] * a4[3];
#pragma unroll
            for (int n = 0; n < 3; ++n) { const f32x4 b4 = *(const f32x4*)(wt + (size_t)n * 16 * DM + 16 * s);
#pragma unroll
                for (int j = 0; j < 4; ++j) acc[n] = __builtin_amdgcn_mfma_f32_16x16x4f32(a4[j], b4[j], acc[n], 0, 0, 0); }
        }
        if (kh == 1) {
#pragma unroll
            for (int n = 0; n < 3; ++n)
#pragma unroll
                for (int j = 0; j < 4; ++j) part[(n * 4 + j) * 64 + lane] = acc[n][j];
            part[12 * 64 + lane] = ss; }
        __syncthreads();
        if (kh == 0) {
#pragma unroll
            for (int n = 0; n < 3; ++n)
#pragma unroll
                for (int j = 0; j < 4; ++j) acc[n][j] += part[(n * 4 + j) * 64 + lane];
            ss += part[12 * 64 + lane];
        ss += __shfl_xor(ss, 16); ss += __shfl_xor(ss, 32);
        const float rstd = rsqrtf(ss * (1.0f / DM) + 1e-6f);
        if (NORM && q == 0) rsl[r] = rstd;
#pragma unroll
        for (int j = 0; j < 4; ++j) { const float rs = __shfl(rstd, 4 * q + j);
#pragma unroll
            for (int n = 0; n < 3; ++n) lg[(4 * q + j) * 48 + n * 16 + r] = acc[n][j] * rs + p.rbias[(l * 4 + b) * 48 + n * 16 + r]; }
        __builtin_amdgcn_wave_barrier();
        if (!DRY && lane < 16) {
            const LAS float* L = lg + lane * 48; const int tok = row0 + lane;
            int gs = 0; float gm = L[32];
#pragma unroll
            for (int g = 1; g < 4; ++g) if (L[32 + g] > gm) { gm = L[32 + g]; gs = g; }
            float gden = 0.f;
#pragma unroll
            for (int g = 0; g < 4; ++g) gden += __expf(L[32 + g] - gm);
            const float gprob = 1.0f / gden;
            int i0 = 0; float v0 = L[gs * 8];
            for (int j = 1; j < 8; ++j) { const float x = L[gs * 8 + j]; if (x > v0) { v0 = x; i0 = j; } }
            int i1 = -1; float v1 = -3.4e38f;
            for (int j = 0; j < 8; ++j) { const float x = L[gs * 8 + j]; if (j != i0 && x > v1) { v1 = x; i1 = j; } }
            const float e1 = __expf(v1 - v0), g0 = gprob / (1.f + e1), g1 = gprob * e1 / (1.f + e1);
            const int ea = gs * 8 + i0, eb = gs * 8 + i1;
            const int sa = atomicAdd(&p.cnt[l * 32 + ea], 1), sb = atomicAdd(&p.cnt[l * 32 + eb], 1);
            p.tokl[ea * ECAP + sa] = tok; p.gatel[ea * ECAP + sa] = g0; p.tokl[eb * ECAP + sb] = tok; p.gatel[eb * ECAP + sb] = g1;
            p.asg[tok * 2] = (ea << 14) | sa; p.asg[tok * 2 + 1] = (eb << 14) | sb;
        }
        }
        __syncthreads();
        if constexpr (NORM) {
            const float* md = p.mod + (lmod * 4 + b) * 6144;
            f32x4 g4[8], sc[8], sh[8];
#pragma unroll
            for (int i = 0; i < 8; ++i) { const int col = i * 256 + lane * 4; g4[i] = *(const f32x4*)(gain + col); sc[i] = 1.f + *(const f32x4*)(md + 2048 + col); sh[i] = *(const f32x4*)(md + col); g4[i] *= sc[i]; }
#pragma unroll 2
            for (int j = 0; j < 8; ++j) { const int row = row0 + kh * 8 + j; const float rs = rsl[kh * 8 + j];
#pragma unroll
                for (int i = 0; i < 8; ++i) { const int col = i * 256 + lane * 4; const uint2 ar = *(const uint2*)(p.XA + (size_t)row * DM + col); const f32x4 v = {bflo(ar.x), bfhi(ar.x), bflo(ar.y), bfhi(ar.y)};
                    const f32x4 h = v * rs * g4[i] + sh[i];
                    *(unsigned*)((unsigned char*)p.H + (size_t)row * DM + col) = pk4_fp8(h[0], h[1], h[2], h[3], A8_SCALE); } }
            __syncthreads();
        }
    }
}
DI void conv_gln(const Params& p, LAS unsigned char* lds) {
    const int tid = opaque_tid(), wave = tid >> 6, lane = tid & 63;
    LAS float* at = (LAS float*)lds;
    u32x4 rv[3], rg[3];
    auto load_raw = [&](int u) { const int g = u & 7, t0 = ((u >> 3) & 63) * 64, b = u >> 9;
#pragma unroll
        for (int i = 0; i < 3; ++i) { const int idx = tid + 512 * i, rr = idx >> 4, c8 = idx & 15, t = t0 - 15 + rr; rv[i] = (u32x4){0u, 0u, 0u, 0u}; rg[i] = (u32x4){0u, 0u, 0u, 0u};
            if (idx < 94 * 16 && t >= 0 && t < SEQ) { const bf16_t* row = p.G + (size_t)(b * SEQ + t) * N_IN0 + g * 128 + c8 * 8; rv[i] = *(const u32x4*)row; rg[i] = *(const u32x4*)(row + 1024); } } };
    int gcur = -1; f32x2 wk[31], bias = {0.f, 0.f}, gam = {0.f, 0.f}, bet = {0.f, 0.f};
    if ((int)blockIdx.x < 2048) load_raw(blockIdx.x);
    for (int u = blockIdx.x; u < 2048; u += gridDim.x) {
        const int g = u & 7, t0 = ((u >> 3) & 63) * 64, b = u >> 9;
        const int ch = g * 128 + 2 * lane;
        if (g != gcur) { gcur = g;
#pragma unroll
            for (int k = 0; k < 31; ++k) wk[k] = *(const f32x2*)(p.conv_w + k * 1024 + ch);
            bias = *(const f32x2*)(p.conv_b + ch); gam = *(const f32x2*)(p.conv_norm_g + ch); bet = *(const f32x2*)(p.conv_norm_b + ch); }
#pragma unroll
        for (int i = 0; i < 3; ++i) { const int idx = tid + 512 * i, rr = idx >> 4, c8 = idx & 15;
            if (idx < 94 * 16) { const u32x4 v = rv[i], gg = rg[i];
                const f32x4 lo = {bflo(v[0]) * sigmoidf_(bflo(gg[0])), bfhi(v[0]) * sigmoidf_(bfhi(gg[0])), bflo(v[1]) * sigmoidf_(bflo(gg[1])), bfhi(v[1]) * sigmoidf_(bfhi(gg[1]))};
                const f32x4 hi = {bflo(v[2]) * sigmoidf_(bflo(gg[2])), bfhi(v[2]) * sigmoidf_(bfhi(gg[2])), bflo(v[3]) * sigmoidf_(bflo(gg[3])), bfhi(v[3]) * sigmoidf_(bfhi(gg[3]))};
                *(LAS f32x4*)(at + rr * 132 + c8 * 8) = lo; *(LAS f32x4*)(at + rr * 132 + c8 * 8 + 4) = hi; } }
        __syncthreads();
        if (u + (int)gridDim.x < 2048) load_raw(u + gridDim.x);
        f32x2 acc[8];
#pragma unroll
        for (int j = 0; j < 8; ++j) acc[j] = bias;
#pragma unroll
        for (int rr = 0; rr < 38; ++rr) { const f32x2 a2 = *(const LAS f32x2*)(at + (wave * 8 + rr) * 132 + 2 * lane);
#pragma unroll
            for (int j = 0; j < 8; ++j) { const int k = rr - j; if (k >= 0 && k < 31) acc[j] += wk[k] * a2; } }
#pragma unroll
        for (int j = 0; j < 8; ++j) { const float mu = wave_sum(acc[j][0] + acc[j][1]) * (1.f / 128.f); const float d0 = acc[j][0] - mu, d1 = acc[j][1] - mu;
            const float var = wave_sum(d0 * d0 + d1 * d1) * (1.f / 128.f); const float rs = rsqrtf(var + 1e-6f);
            const float y0 = d0 * rs * gam[0] + bet[0], y1 = d1 * rs * gam[1] + bet[1];
            if constexpr (D8_OUT0) *(unsigned short*)((unsigned char*)p.AO + (size_t)(b * SEQ + t0 + wave * 8 + j) * DM + ch) = (unsigned short)(pk4_fp8(siluf_(y0), siluf_(y1), 0.f, 0.f, A8_SCALE) & 0xffffu);
            else *(unsigned*)(p.AO + (size_t)(b * SEQ + t0 + wave * 8 + j) * DM + ch) = pk2(siluf_(y0), siluf_(y1)); }
        __syncthreads();
    }
}
DI unsigned off_b(unsigned row, unsigned ch) { return 256u * row + 16u * (ch ^ (((row & 3u) << 2) | ((row >> 2) & 3u))); }
DI void tr_read4(unsigned a0, unsigned a1, s16x4& r00, s16x4& r01, s16x4& r10, s16x4& r11) {
    asm volatile("ds_read_b64_tr_b16 %0, %4\n\tds_read_b64_tr_b16 %1, %5\n\tds_read_b64_tr_b16 %2, %4 offset:4096\n\tds_read_b64_tr_b16 %3, %5 offset:4096\n\ts_waitcnt lgkmcnt(0)"
                 : "=&v"(r00), "=&v"(r01), "=&v"(r10), "=&v"(r11) : "v"(a0), "v"(a1) : "memory");
}
template <int PASS> DI void attn_wave(const Params& p, LAS unsigned char* vimg, unsigned vb0, unsigned vb1, int lane_, int b, int h, int qbase  ) {
    int lane = lane_; asm volatile("" : "+v"(lane));
    const int c = lane & 31, hh = lane >> 5, srow = lane >> 4, sch = lane & 15;
    constexpr int QS = PASS == 0 ? 16 : 1, NT = PASS == 0 ? 13 : 5;
    const int tq = qbase + QS * c;
    const bf16_t* gb = p.G + (size_t)(b * SEQ) * N_IN0; const bf16_t* kb = p.KVH + (size_t)((b * 8 + h) * 2) * SEQ * 128;
    bf16_t* st_o = p.YB + ((size_t)(b * 8 + h) * SEQ + tq) * 128;
    float* st_ml = (float*)(p.YB + (size_t)NBATCH * 8 * SEQ * 128) + ((size_t)(b * 8 + h) * SEQ + tq) * 2;
    bf16x8 qf[8];
#pragma unroll
    for (int ks = 0; ks < 8; ++ks) qf[ks] = *(const bf16x8*)(gb + (size_t)tq * N_IN0 + 2048 + h * 128 + 16 * ks + 8 * hh);
    const float sc2 = 0.08838834764831845f * 1.4426950408889634f, sl2 = exp2f(-(float)(h + 1)) * 1.4426950408889634f;
    f32x16 o[4]; float m_run, l_run;
    if constexpr (PASS == 0) {
#pragma unroll
        for (int i = 0; i < 4; ++i)
#pragma unroll
            for (int j = 0; j < 16; ++j) o[i][j] = 0.f;
        m_run = -30000.f; l_run = 0.f;
    } else {
#pragma unroll
        for (int c4 = 0; c4 < 4; ++c4)
#pragma unroll
            for (int g4 = 0; g4 < 4; ++g4) { const uint2 v = *(const uint2*)(st_o + 32 * c4 + 8 * g4 + 4 * hh); o[c4][4 * g4] = bflo(v.x); o[c4][4 * g4 + 1] = bfhi(v.x); o[c4][4 * g4 + 2] = bflo(v.y); o[c4][4 * g4 + 3] = bfhi(v.y); }
        const f32x2 ml = *(const f32x2*)st_ml; m_run = ml[0]; l_run = hh == 0 ? ml[1] : 0.f;
    }
    auto tile_geom = [&](int tile, int& d, int& sb) { if constexpr (PASS == 0) { if (tile < 5) { d = 16; sb = qbase - 1024 + 512 * tile; } else { d = 4; sb = qbase - 256 + 128 * (tile - 5); } } else { d = 1; sb = qbase - 64 + 32 * tile; } };
    auto load_k = [&](int tile, bf16x8 (&kf)[8]) { int d, sb; tile_geom(tile, d, sb); int sp = sb + d * c; sp = sp < 0 ? 0 : (sp >= SEQ ? SEQ - 1 : sp);
        const bf16_t* src = kb + (unsigned)(sp * 128 + 8 * hh);
#pragma unroll
        for (int ks = 0; ks < 8; ++ks) kf[ks] = *(const bf16x8*)(src + 16 * ks); };
    auto load_v = [&](int tile, u32x4 (&vv)[8]) { int d, sb; tile_geom(tile, d, sb);
#pragma unroll
        for (int i = 0; i < 8; ++i) { int sp = sb + d * (srow + 4 * i); sp = sp < 0 ? 0 : (sp >= SEQ ? SEQ - 1 : sp); vv[i] = *(const u32x4*)(kb + (unsigned)(SEQ * 128 + sp * 128 + sch * 8)); } };
    bf16x8 kf[8]; u32x4 vv[8];
    load_k(0, kf); load_v(0, vv);
    for (int tile = 0; tile < NT; ++tile) {
        int d, sb; tile_geom(tile, d, sb);
        const int tn = tile < NT - 1 ? tile + 1 : NT - 1;
#pragma unroll
        for (int i = 0; i < 8; ++i) *(LAS u32x4*)(vimg + off_b(srow + 4 * i, sch)) = vv[i];
        load_v(tn, vv);
        f32x16 sacc;
#pragma unroll
        for (int j = 0; j < 16; ++j) sacc[j] = 0.f;
#pragma unroll
        for (int ks = 0; ks < 8; ++ks) sacc = __builtin_amdgcn_mfma_f32_32x32x16_bf16(kf[ks], qf[ks], sacc, 0, 0, 0);
        load_k(tn, kf);
        const float df = (float)d, basef = (float)(sb - tq) + df * (float)(4 * hh);
        const float lo = fmaxf(-64.f * df, -(float)tq), hi = fminf(64.f * df, (float)(SEQ - 1 - tq));
        const float mid = 0.5f * (lo + hi), half = 0.5f * (hi - lo);
        float tmax = -1e30f;
#pragma unroll
        for (int i = 0; i < 16; ++i) { const float deltaf = basef + df * (float)((i & 3) + 8 * (i >> 2));
            const bool valid = __builtin_fabsf(deltaf - mid) <= half;
            const float sv = valid ? sacc[i] * sc2 - sl2 * __builtin_fabsf(deltaf) : -1e30f; sacc[i] = sv; tmax = fmaxf(tmax, sv); }
        tmax = fmaxf(tmax, __shfl_xor(tmax, 32));
        const float m_new = tmax > m_run + 8.0f ? tmax : m_run;
        if (__any(m_new != m_run)) { const float alpha = __builtin_amdgcn_exp2f(m_run - m_new);
            l_run *= alpha;
#pragma unroll
            for (int i = 0; i < 4; ++i) o[i] *= alpha; }
        m_run = m_new;
        float psum = 0.f;
#pragma unroll
        for (int i = 0; i < 16; ++i) { const float pi = __builtin_amdgcn_exp2f(sacc[i] - m_new); psum += pi; sacc[i] = pi; }
        l_run += psum;
        bf16x8 pf[2];
#pragma unroll
        for (int s = 0; s < 2; ++s) { const unsigned w0 = pk2(sacc[8 * s], sacc[8 * s + 1]), w1 = pk2(sacc[8 * s + 2], sacc[8 * s + 3]), w2 = pk2(sacc[8 * s + 4], sacc[8 * s + 5]), w3 = pk2(sacc[8 * s + 6], sacc[8 * s + 7]);
            pf[s] = __builtin_bit_cast(bf16x8, (u32x4){w0, w1, w2, w3}); }
#pragma unroll
        for (int c4 = 0; c4 < 4; ++c4) {
            s16x4 r00, r01, r10, r11; tr_read4(vb0 ^ (unsigned)(c4 << 6), vb1 ^ (unsigned)(c4 << 6), r00, r01, r10, r11);
            const bf16x8 v0 = __builtin_shufflevector(r00, r01, 0, 1, 2, 3, 4, 5, 6, 7), v1 = __builtin_shufflevector(r10, r11, 0, 1, 2, 3, 4, 5, 6, 7);
            o[c4] = __builtin_amdgcn_mfma_f32_32x32x16_bf16(v0, pf[0], o[c4], 0, 0, 0);
            o[c4] = __builtin_amdgcn_mfma_f32_32x32x16_bf16(v1, pf[1], o[c4], 0, 0, 0); }
    }
    const float ltot = l_run + __shfl_xor(l_run, 32);
    if constexpr (PASS == 0) {
#pragma unroll
        for (int c4 = 0; c4 < 4; ++c4)
#pragma unroll
            for (int g4 = 0; g4 < 4; ++g4) *(uint2*)(st_o + 32 * c4 + 8 * g4 + 4 * hh) = make_uint2(pk2(o[c4][4 * g4], o[c4][4 * g4 + 1]), pk2(o[c4][4 * g4 + 2], o[c4][4 * g4 + 3]));
        if (hh == 0) *(f32x2*)st_ml = (f32x2){m_run, ltot};
    } else {
        const float inv = 1.0f / ltot;
        bf16_t* orow = p.AO + (size_t)(b * SEQ + tq) * DM + 1024 + h * 128;
#pragma unroll
        for (int c4 = 0; c4 < 4; ++c4)
#pragma unroll
            for (int g4 = 0; g4 < 4; ++g4) { const int dh = 32 * c4 + 8 * g4 + 4 * hh;
                if constexpr (D8_OUT0) *(unsigned*)((unsigned char*)p.AO + (size_t)(b * SEQ + tq) * DM + 1024 + h * 128 + dh) = pk4_fp8(o[c4][4 * g4] * inv, o[c4][4 * g4 + 1] * inv, o[c4][4 * g4 + 2] * inv, o[c4][4 * g4 + 3] * inv, A8_SCALE);
                else *(uint2*)(orow + dh) = make_uint2(pk2(o[c4][4 * g4] * inv, o[c4][4 * g4 + 1] * inv), pk2(o[c4][4 * g4 + 2] * inv, o[c4][4 * g4 + 3] * inv)); }
    }
}
DI void attention(const Params& p, LAS unsigned char* lds) {
    const int tid = opaque_tid(), wave = __builtin_amdgcn_readfirstlane(tid >> 6), lane = tid & 63, hh = lane >> 5;
    LAS unsigned char* vimg = lds + wave * 8192;
    const unsigned vbase = (unsigned)(uintptr_t)vimg;
    const int q4 = (lane & 15) >> 2, pp = lane & 3, blk = (lane >> 4) & 1;
    const unsigned vb0 = vbase + 256u * (4 * hh + q4) + 16u * ((2 * blk + (pp >> 1)) ^ (hh & 3)) + 8u * (pp & 1) + ((unsigned)q4 << 6);
    const unsigned vb1 = vbase + 256u * (8 + 4 * hh + q4) + 16u * ((2 * blk + (pp >> 1)) ^ ((2 + hh) & 3)) + 8u * (pp & 1) + ((unsigned)q4 << 6);
    for (int u = blockIdx.x; u < 256; u += gridDim.x) {
        const int bh = (u & 7) * 4 + ((u >> 3) >> 3), span = (u >> 3) & 7, h = bh & 7, b = bh >> 3;
#pragma unroll 1
        for (int j = 0; j < 2; ++j) attn_wave<0>(p, vimg, vb0, vb1, lane, b, h, span * 512 + wave * 2 + j);
        asm volatile("s_waitcnt vmcnt(0)" ::: "memory");
        __syncthreads();
#pragma unroll 1
        for (int j = 0; j < 2; ++j) attn_wave<1>(p, vimg, vb0, vb1, lane, b, h, span * 512 + (wave * 2 + j) * 32);
        __syncthreads();
    }
}
DI float om_exp2x(float la, float a) {
    const float x = 2.f * la;
    const float pl = x * (1.f + x * (0.5f + x * (0.16666667f + x * (0.041666668f + x * 0.008333334f))));
    return x > -0.25f ? -pl : 1.f - a * a;
}
DI void lru_conv(const Params& p) {
    const int tid = opaque_tid();
    if (tid < 336) {
        const int ch = tid * 8;
        float cw[4][8], cb[8];
#pragma unroll
        for (int j = 0; j < 4; ++j) { const f32x4 w0 = *(const f32x4*)(p.lru_conv_w + j * LRU_W + ch), w1 = *(const f32x4*)(p.lru_conv_w + j * LRU_W + ch + 4);
            cw[j][0] = w0[0]; cw[j][1] = w0[1]; cw[j][2] = w0[2]; cw[j][3] = w0[3]; cw[j][4] = w1[0]; cw[j][5] = w1[1]; cw[j][6] = w1[2]; cw[j][7] = w1[3]; }
        { const f32x4 b0 = *(const f32x4*)(p.lru_conv_b + ch), b1 = *(const f32x4*)(p.lru_conv_b + ch + 4); cb[0] = b0[0]; cb[1] = b0[1]; cb[2] = b0[2]; cb[3] = b0[3]; cb[4] = b1[0]; cb[5] = b1[1]; cb[6] = b1[2]; cb[7] = b1[3]; }
        for (int run = blockIdx.x; run < T_TOK / 32; run += gridDim.x) {
            const int tok0 = run * 32, t0 = tok0 % SEQ;
            const bf16_t* src = p.G + (size_t)tok0 * N_IN1 + LRU_W + ch;
            u32x4 rows[35];
#pragma unroll
            for (int i = 0; i < 35; ++i) { const int t = t0 - 2 + i; rows[i] = (t >= 0 && t < SEQ) ? *(const u32x4*)(src + (ptrdiff_t)(i - 2) * N_IN1) : (u32x4){0u, 0u, 0u, 0u}; }
#pragma unroll
            for (int i = 0; i < 32; ++i) { float xc[8];
#pragma unroll
                for (int e = 0; e < 8; ++e) xc[e] = cb[e];
#pragma unroll
                for (int j = 0; j < 4; ++j) { const u32x4 xv = rows[i + j];
                    xc[0] += cw[j][0] * bflo(xv[0]); xc[1] += cw[j][1] * bfhi(xv[0]); xc[2] += cw[j][2] * bflo(xv[1]); xc[3] += cw[j][3] * bfhi(xv[1]);
                    xc[4] += cw[j][4] * bflo(xv[2]); xc[5] += cw[j][5] * bfhi(xv[2]); xc[6] += cw[j][6] * bflo(xv[3]); xc[7] += cw[j][7] * bfhi(xv[3]); }
                *(u32x4*)(p.XC + (size_t)(tok0 + i) * LRU_W + ch) = (u32x4){pk2(xc[0], xc[1]), pk2(xc[2], xc[3]), pk2(xc[4], xc[5]), pk2(xc[6], xc[7])}; }
        }
    }
}
DI void lru(const Params& p, LAS unsigned char* lds) {
    const int tid = opaque_tid(), wave = __builtin_amdgcn_readfirstlane(tid >> 6), lane = tid & 63, col = lane & 15, g = lane >> 4;
    LAS unsigned char* wl = lds;
    LAS unsigned char* xs = lds + 36864;
    LAS float* sums = (LAS float*)(lds + 36864 + 86016);
    LAS float* cst = sums + 1536;
    for (int u = blockIdx.x; u < 256; u += gridDim.x) {
        const int b = u >> 6, n = (u >> 2) & 15, qt = u & 3, chq = n * LRU_BW + qt * 42;
        const char* xcb = (const char*)(p.XC + (size_t)(b * SEQ) * LRU_W + n * LRU_BW);
        const bf16_t* gb = p.G + (size_t)(b * SEQ) * N_IN1;
        unsigned poff[6];
#pragma unroll
        for (int i = 0; i < 6; ++i) { const int idx = tid + 512 * i; poff[i] = (unsigned)((idx / 21) * LRU_W + (idx % 21) * 8) * 2u; }
        auto dma_chunk = [&](int chunk, int bsel) { const char* src = xcb + (size_t)chunk * 128 * LRU_W * 2; LAS unsigned char* dst = xs + bsel * 43008 + wave * 1024;
#pragma unroll
            for (int i = 0; i < 5; ++i) __builtin_amdgcn_global_load_lds((const unsigned*)(src + poff[i]), (LAS unsigned*)(dst + i * 8192), 16, 0, 0);
            if (wave < 2) __builtin_amdgcn_global_load_lds((const unsigned*)(src + poff[5]), (LAS unsigned*)(dst + 5 * 8192), 16, 0, 0); };
        for (int dir = 0; dir < 2; ++dir) {
            __syncthreads();
            for (int i = tid; i < 2 * 48 * 24; i += 512) { const int which = i / (48 * 24), r = (i / 24) % 48, ck = i % 24; const int nt = r >> 4, cl = r & 15, ks = ck >> 2, gg = ck & 3;
                *(LAS u32x4*)(wl + ((which * 3 + nt) * 6 + ks) * 1024 + (gg * 16 + cl) * 16) = *(const u32x4*)(p.w_lru + ((((size_t)(dir * 2 + which) * 16 + n) * 4 + qt) * 48 + r) * 192 + ck * 8); }
            if (tid < 48) { const bool valid = tid < 42; const int ch = dir * LRU_W + chq + tid;
                cst[tid] = valid ? p.lru_b_a[ch] : 0.f; cst[48 + tid] = valid ? p.lru_b_x[ch] : 0.f;
                const float lam = valid ? p.lru_lambda[ch] : 0.f; const float sp = (-lam > 20.f) ? -lam : log1pf(__expf(-lam)); cst[96 + tid] = -8.0f * sp; }
            dma_chunk(dir == 0 ? 0 : 31, 0);
            asm volatile("s_waitcnt vmcnt(0)" ::: "memory");
            __syncthreads();
            float cba[3], cbx[3], cex[3];
#pragma unroll
            for (int nt = 0; nt < 3; ++nt) { cba[nt] = cst[nt * 16 + col]; cbx[nt] = cst[48 + nt * 16 + col]; cex[nt] = cst[96 + nt * 16 + col]; }
            float carry[3] = {0.f, 0.f, 0.f};
            for (int step = 0; step < 32; ++step) {
                const int c = dir == 0 ? step : 31 - step, c0 = c * 128, par = step & 1;
                const bool has_next = step < 31;
                if (has_next) dma_chunk(dir == 0 ? c + 1 : c - 1, par ^ 1);
                LAS unsigned char* xb = xs + par * 43008;
                uint2 hfv[3] = {make_uint2(0u, 0u), make_uint2(0u, 0u), make_uint2(0u, 0u)}; unsigned short gtv[3][4];
                const uint2* hfp = (const uint2*)p.HF + ((size_t)((u * 32 + c) * 8 + wave) * 3) * 64 + lane;
                if (dir == 1) {
#pragma unroll
                    for (int nt = 0; nt < 3; ++nt) { hfv[nt] = hfp[nt * 64];
#pragma unroll
                        for (int r = 0; r < 4; ++r) gtv[nt][r] = (nt * 16 + col < 42) ? gb[(size_t)(c0 + wave * 16 + 4 * g + r) * N_IN1 + chq + nt * 16 + col] : (unsigned short)0; } }
                bf16x8 af[6];
#pragma unroll
                for (int ks = 0; ks < 6; ++ks) { const int ch0 = 32 * ks + 8 * g; const bool kval = ch0 < LRU_BW; const int chl0 = kval ? ch0 : 160;
                    const u32x4 xv = *(const LAS u32x4*)(xb + (wave * 16 + col) * 336 + chl0 * 2);
                    af[ks] = __builtin_bit_cast(bf16x8, kval ? xv : (u32x4){0u, 0u, 0u, 0u}); }
                f32x4 acc[2][3];
#pragma unroll
                for (int w2 = 0; w2 < 2; ++w2)
#pragma unroll
                    for (int nt = 0; nt < 3; ++nt) { acc[w2][nt] = (f32x4){0.f, 0.f, 0.f, 0.f};
#pragma unroll
                        for (int ks = 0; ks < 6; ++ks) { const bf16x8 bfr = *(const LAS bf16x8*)(wl + ((w2 * 3 + nt) * 6 + ks) * 1024 + lane * 16);
                            acc[w2][nt] = __builtin_amdgcn_mfma_f32_16x16x32_bf16(af[ks], bfr, acc[w2][nt], 0, 0, 0); } }
                float hl[3][4], Pl[3][4];
#pragma unroll
                for (int nt = 0; nt < 3; ++nt) { const int chl = nt * 16 + col;
                    float av[4], uv[4];
#pragma unroll
                    for (int r = 0; r < 4; ++r) { const float za = acc[0][nt][r] + cba[nt], zx = acc[1][nt][r] + cbx[nt];
                        const float rg = sigmoidf_(za), ig = sigmoidf_(zx); const float la = cex[nt] * rg; const float a = __expf(la);
                        const float xcv = bf2f(*(const LAS bf16_t*)(xb + (wave * 16 + 4 * g + r) * 336 + (qt * 42 + chl) * 2));
                        av[r] = a; uv[r] = __builtin_amdgcn_sqrtf(om_exp2x(la, a)) * ig * xcv; }
                    float h[4], P[4], A, H;
                    if (dir == 0) { h[0] = uv[0]; P[0] = av[0];
#pragma unroll
                        for (int r = 1; r < 4; ++r) { h[r] = av[r] * h[r - 1] + uv[r]; P[r] = av[r] * P[r - 1]; }
                        A = P[3]; H = h[3];
                        { const float A1 = __shfl_up(A, 16), H1 = __shfl_up(H, 16); if (g >= 1) { H = A * H1 + H; A = A * A1; } }
                        { const float A2 = __shfl_up(A, 32), H2 = __shfl_up(H, 32); if (g >= 2) { H = A * H2 + H; A = A * A2; } }
                        float Ae = __shfl_up(A, 16), He = __shfl_up(H, 16); if (g == 0) { Ae = 1.f; He = 0.f; }
                        const float At = __shfl(A, 48 + col), Ht = __shfl(H, 48 + col);
#pragma unroll
                        for (int r = 0; r < 4; ++r) { hl[nt][r] = h[r] + P[r] * He; Pl[nt][r] = P[r] * Ae; }
                        if (g == 3) *(LAS f32x2*)(sums + ((par * 8 + wave) * 48 + chl) * 2) = (f32x2){At, Ht};
                    } else { h[3] = uv[3]; P[3] = av[3];
#pragma unroll
                        for (int r = 2; r >= 0; --r) { h[r] = av[r] * h[r + 1] + uv[r]; P[r] = av[r] * P[r + 1]; }
                        A = P[0]; H = h[0];
                        { const float A1 = __shfl_down(A, 16), H1 = __shfl_down(H, 16); if (g <= 2) { H = A * H1 + H; A = A * A1; } }
                        { const float A2 = __shfl_down(A, 32), H2 = __shfl_down(H, 32); if (g <= 1) { H = A * H2 + H; A = A * A2; } }
                        float Ae = __shfl_down(A, 16), He = __shfl_down(H, 16); if (g == 3) { Ae = 1.f; He = 0.f; }
                        const float At = __shfl(A, col), Ht = __shfl(H, col);
#pragma unroll
                        for (int r = 0; r < 4; ++r) { hl[nt][r] = h[r] + P[r] * He; Pl[nt][r] = P[r] * Ae; }
                        if (g == 0) *(LAS f32x2*)(sums + ((par * 8 + wave) * 48 + chl) * 2) = (f32x2){At, Ht};
                    }
                }
                asm volatile("s_waitcnt vmcnt(0)" ::: "memory");
                __syncthreads();
#pragma unroll
                for (int nt = 0; nt < 3; ++nt) { const int chl = nt * 16 + col; float C = carry[nt], Cw = 0.f;
#pragma unroll
                    for (int k = 0; k < 8; ++k) { const int w2 = dir == 0 ? k : 7 - k; const f32x2 sv = *(const LAS f32x2*)(sums + ((par * 8 + w2) * 48 + chl) * 2);
                        if (w2 == wave) Cw = C; C = sv[0] * C + sv[1]; }
                    carry[nt] = C;
                    float hv[4];
#pragma unroll
                    for (int r = 0; r < 4; ++r) hv[r] = hl[nt][r] + Pl[nt][r] * Cw;
                    if (dir == 0) ((uint2*)p.HF)[((size_t)((u * 32 + c) * 8 + wave) * 3 + nt) * 64 + lane] = make_uint2(pk2(hv[0], hv[1]), pk2(hv[2], hv[3]));
                    else if (chl < 42) { const float ff[4] = {bflo(hfv[nt].x), bfhi(hfv[nt].x), bflo(hfv[nt].y), bfhi(hfv[nt].y)};
#pragma unroll
                        for (int r = 0; r < 4; ++r) p.AO[(size_t)(b * SEQ + c0 + wave * 16 + 4 * g + r) * LRU_W + chq + chl] = f2bf(bf2f(gtv[nt][r]) * (ff[r] + hv[r])); }
                }
            }
        }
    }
}
}

#define XB_TMO      128
#define XB_XCNT(j)  (256  + 64 * (j))
#define XB_XSUB(j)  (1280 + 64 * (j))
#define XB_XGEN(j)  (2304 + 64 * (j))
#define XB_TOP      3328
#define XB_TOPGEN   3392
#define XCD_BAR_WORDS 3456
#define XB_SPIN_CAP (1u << 18)

__device__ __forceinline__ unsigned xb_ld(unsigned* p)              { return __hip_atomic_load(p, __ATOMIC_RELAXED, __HIP_MEMORY_SCOPE_AGENT); }
__device__ __forceinline__ unsigned xb_add(unsigned* p, unsigned v) { return __hip_atomic_fetch_add(p, v, __ATOMIC_RELAXED, __HIP_MEMORY_SCOPE_AGENT); }
__device__ __forceinline__ unsigned xb_xcc_id() { return (unsigned)__builtin_amdgcn_s_getreg((3 << 11) | 20) & 0xFu; }
#define XB_SPIN(cond, bar) do { unsigned _sp = 0; while (cond) { __builtin_amdgcn_s_sleep(1); \
    if ((++_sp & 255u) == 0u) { if (xb_ld(&(bar)[XB_TMO])) break; if (_sp > XB_SPIN_CAP) { atomicAdd(&(bar)[XB_TMO], 1u); break; } } } } while (0)

struct XcdBarrier {
    unsigned* bar; unsigned x;
    volatile LAS unsigned* st;
};

__device__ __forceinline__ XcdBarrier xcd_barrier_post(unsigned* bar, volatile LAS unsigned* st) {
    XcdBarrier b; b.bar = bar; b.x = xb_xcc_id(); b.st = st;
    if (threadIdx.x == 0) (void)xb_add(&bar[XB_XCNT(b.x)], 1u);
    return b;
}
__device__ __forceinline__ void xcd_barrier_complete(unsigned* bar, unsigned x, unsigned& nloc, unsigned& nx) {
    const unsigned G = gridDim.x * gridDim.y * gridDim.z;
    unsigned sum, cnt, mine, sp = 0u;
    for (;;) {
        sum = 0u; cnt = 0u; mine = 0u;
#pragma unroll
        for (unsigned j = 0; j < 16; ++j) { const unsigned c = xb_ld(&bar[XB_XCNT(j)]); sum += c; cnt += (c > 0u) ? 1u : 0u; mine = (j == x) ? c : mine; }
        if (sum == G) break;
        __builtin_amdgcn_s_sleep(1);
        if ((++sp & 255u) == 0u) { if (xb_ld(&bar[XB_TMO])) break; if (sp > XB_SPIN_CAP) { atomicAdd(&bar[XB_TMO], 1u); break; } }
    }
    nloc = mine > 0u ? mine : 1u; nx = cnt > 0u ? cnt : 1u;
}

__device__ __forceinline__ void xcd_barrier(const XcdBarrier& b) {
    asm volatile("s_waitcnt vmcnt(0)" ::: "memory");
    __syncthreads();
    if (threadIdx.x == 0) {
        unsigned* bar = b.bar;
        __builtin_amdgcn_s_waitcnt(0);
        unsigned nloc = b.st[0], nx = b.st[1];
        if (nloc == 0u) { xcd_barrier_complete(bar, b.x, nloc, nx); b.st[0] = nloc; b.st[1] = nx; }
        const unsigned old = xb_add(&bar[XB_XSUB(b.x)], 1u);
        const unsigned gen = old / nloc;
        if (old + 1u == (gen + 1u) * nloc) {
            __builtin_amdgcn_fence(__ATOMIC_RELEASE, "agent");
            asm volatile("s_waitcnt vmcnt(0)" ::: "memory");
            const unsigned og = xb_add(&bar[XB_TOP], 1u);
            const unsigned tg = og / nx;
            if (og + 1u == (tg + 1u) * nx) xb_add(&bar[XB_TOPGEN], 1u);
            else XB_SPIN(xb_ld(&bar[XB_TOPGEN]) == tg, bar);
            __builtin_amdgcn_fence(__ATOMIC_ACQUIRE, "agent");
            xb_add(&bar[XB_XGEN(b.x)], 1u);
            asm volatile("s_waitcnt vmcnt(0)" ::: "memory");
        } else {
            XB_SPIN(xb_ld(&bar[XB_XGEN(b.x)]) == gen, bar);
            __builtin_amdgcn_fence(__ATOMIC_ACQUIRE, "agent");
            asm volatile("s_waitcnt vmcnt(0)" ::: "memory");
        }
    }
    __syncthreads();
}


constexpr int PROBE = 0;
constexpr int LDS_XB_OFF = gm::STAGE_BYTES + 1024;
constexpr int LDS_TOTAL = LDS_XB_OFF + 16;
__global__ void __launch_bounds__(512, 2) mega(Params p) {
    LAS unsigned char* lds = (LAS unsigned char*)dyn_smem;
    LAS int* tab = (LAS int*)(lds + gm::TAB_OFF);
    volatile LAS unsigned* xbw = (volatile LAS unsigned*)(lds + LDS_XB_OFF);
    if (threadIdx.x == 0) { xbw[0] = 0u; xbw[1] = 0u; xbw[2] = 0u; xbw[3] = 0u; }
    __syncthreads();
    XcdBarrier bar = xcd_barrier_post(p.bar, xbw);
    ph::mods(p, lds);
    if constexpr (PROBE == 14) { ph::mods(p, lds); ph::mods(p, lds); }
    xcd_barrier(bar);
    { const int c = blockIdx.x, G = gridDim.x;
      ph::transposer(p, lds, c, c < 320 ? (320 - c + G - 1) / G : 0, G); __syncthreads();
      ph::transposer(p, lds, 320 + c, c < 632 ? (632 - c + G - 1) / G : 0, G); __syncthreads(); }
    ph::lru_weights(p);
    ph::fold_router(p);
    ph::norm_rows<0, D8_IN0>(p, p.x, p.norm0_mix, 0, 0, nullptr);
    xcd_barrier(bar);
    { const int c = blockIdx.x, G = gridDim.x; const int tcount = c < 6144 ? (6144 - c + G - 1) / G : 0; const bool t_first = ((c >> 3) & 1) != 0;
      if (t_first) { ph::transposer(p, lds, 952 + c, tcount, G); __syncthreads(); }
      { gm::DenseSched S; S.init(T_TOK, N_IN0); EpiIn0 e; e.xin = nullptr; e.lgate = 0; if constexpr (D8_IN0) gm::gemm_phase<EpiIn0, gm::DenseSched, true>(lds, p, p.H, p.w_in0t, 0, DM / 2, S, e, W8_E8M0, A8_E8M0); else gm::gemm_phase(lds, p, p.H, p.w_in0t, 0, DM, S, e); }
      if (!t_first) { __syncthreads(); ph::transposer(p, lds, 952 + c, tcount, G); }
      if constexpr (PROBE == 21) { __syncthreads(); ph::transposer(p, lds, 952 + c, tcount, G); }
      if constexpr (PROBE == 24) { __syncthreads(); if (t_first) ph::transposer(p, lds, 952 + c, tcount, G); }
      if constexpr (PROBE == 23) { __syncthreads(); if (t_first) { ph::transposer(p, lds, 952 + c, tcount, G); __syncthreads(); }
        { gm::DenseSched S; S.init(T_TOK, N_IN0); EpiIn0 e; e.xin = nullptr; e.lgate = 0; gm::gemm_phase<EpiIn0, gm::DenseSched, true>(lds, p, p.H, p.w_in0t, 0, DM / 2, S, e, W8_E8M0, A8_E8M0); }
        if (!t_first) { __syncthreads(); ph::transposer(p, lds, 952 + c, tcount, G); } }
      if constexpr (PROBE == 20) { __syncthreads(); gm::DenseSched S; S.init(T_TOK, N_IN0); EpiIn0 e; e.xin = nullptr; e.lgate = 0; gm::gemm_phase<EpiIn0, gm::DenseSched, true>(lds, p, p.H, p.w_in0t, 0, DM / 2, S, e, W8_E8M0, A8_E8M0); } }
    xcd_barrier(bar);
    ph::attention(p, lds);
    if constexpr (PROBE == 4) ph::attention(p, lds);
    __syncthreads();
    ph::conv_gln(p, lds);
    if constexpr (PROBE == 5) ph::conv_gln(p, lds);
    xcd_barrier(bar);
    { gm::DenseSched S; S.init(T_TOK, DM); EpiOut e; e.xin = p.x; e.lgate = 0; if constexpr (D8_OUT0) gm::gemm_phase<EpiOut, gm::DenseSched, true>(lds, p, p.AO, p.w_out0t, 0, DM / 2, S, e, W8_E8M0, A8_E8M0); else gm::gemm_phase(lds, p, p.AO, p.w_out0t, 0, DM, S, e); }
    xcd_barrier(bar);
    ph::router<false, true>(p, 0, lds, p.norm0_ffn, 1);
    if constexpr (PROBE == 12) { ph::router<true>(p, 0, lds); ph::router<true>(p, 0, lds); }
    xcd_barrier(bar);
    if constexpr (PROBE == 11) { xcd_barrier(bar); xcd_barrier(bar); xcd_barrier(bar); xcd_barrier(bar); xcd_barrier(bar); xcd_barrier(bar); xcd_barrier(bar); xcd_barrier(bar); xcd_barrier(bar); xcd_barrier(bar); }
    gm::moe_tables(tab, p.cnt);
    { gm::MoeSched<true> S; S.init(tab); EpiGU e; e.xin = nullptr; e.lgate = 0; gm::gemm_phase<EpiGU, gm::MoeSched<true>, true>(lds, p, p.H, p.w_gut0, (size_t)2048 * (DM / 2), DM / 2, S, e, W8_E8M0, A8_E8M0); if constexpr (PROBE == 3) gm::gemm_phase<EpiGU, gm::MoeSched<true>, true>(lds, p, p.H, p.w_gut0, (size_t)2048 * (DM / 2), DM / 2, S, e, W8_E8M0, A8_E8M0); }
    xcd_barrier(bar);
    { gm::MoeSched<false> S; S.init(tab); EpiDown e; e.xin = nullptr; e.lgate = 0; gm::gemm_phase<EpiDown, gm::MoeSched<false>, true>(lds, p, p.ACT, p.w_dt0, (size_t)DM * (EFF / 2), EFF / 2, S, e, W8_E8M0, A8_E8M0); if constexpr (PROBE == 8) gm::gemm_phase<EpiDown, gm::MoeSched<false>, true>(lds, p, p.ACT, p.w_dt0, (size_t)DM * (EFF / 2), EFF / 2, S, e, W8_E8M0, A8_E8M0); }
    xcd_barrier(bar);
    ph::norm_rows<1, D8_IN1>(p, nullptr, p.norm1_mix, 2, 1, tab);
    xcd_barrier(bar);
    { const int c = blockIdx.x, G = gridDim.x; int tfirst, tcount, tstride;
      if (G == 256) { tstride = 1; if (c < 64) { tcount = 18; tfirst = 18 * c; } else { tcount = 26; tfirst = 1152 + 26 * (c - 64); } }
      else { tstride = G; tfirst = c; tcount = c < 6144 ? (6144 - c + G - 1) / G : 0; }
      const bool t_first = ((c >> 3) & 1) != 0;
      if (t_first) { ph::transposer(p, lds, 7096 + tfirst, tcount, tstride); __syncthreads(); }
      { gm::DenseSched S; S.init(T_TOK, N_IN1); EpiIn1 e; e.xin = nullptr; e.lgate = 0; gm::gemm_phase(lds, p, p.H, p.w_in1t, 0, DM, S, e); }
      if (!t_first) { __syncthreads(); ph::transposer(p, lds, 7096 + tfirst, tcount, tstride); } }
    xcd_barrier(bar);
    ph::lru_conv(p);
    if constexpr (PROBE == 9) { ph::lru_conv(p); ph::lru_conv(p); }
    xcd_barrier(bar);
    ph::lru(p, lds);
    if constexpr (PROBE == 6) ph::lru(p, lds);
    xcd_barrier(bar);
    { gm::DenseSched S; S.init(T_TOK, DM); EpiOut e; e.xin = nullptr; e.lgate = 2; gm::gemm_phase(lds, p, p.AO, p.w_out1t, 0, LRU_W, S, e); }
    xcd_barrier(bar);
    ph::router<false, true>(p, 1, lds, p.norm1_ffn, 3);
    xcd_barrier(bar);
    gm::moe_tables(tab, p.cnt + 32);
    { gm::MoeSched<true> S; S.init(tab); EpiGU e; e.xin = nullptr; e.lgate = 0; gm::gemm_phase<EpiGU, gm::MoeSched<true>, true>(lds, p, p.H, p.w_gut1, (size_t)2048 * (DM / 2), DM / 2, S, e, W8_E8M0, A8_E8M0); }
    xcd_barrier(bar);
    { gm::MoeSched<false> S; S.init(tab); EpiDown e; e.xin = nullptr; e.lgate = 0; gm::gemm_phase<EpiDown, gm::MoeSched<false>, true>(lds, p, p.ACT, p.w_dt1, (size_t)DM * (EFF / 2), EFF / 2, S, e, W8_E8M0, A8_E8M0); }
    xcd_barrier(bar);
    ph::norm_rows<2>(p, nullptr, p.norm_final, 0, 3, tab);
}

static inline size_t al256(size_t x) { return (x + 255) & ~(size_t)255; }

extern "C" void kernel_launch(void* const* d_in, const int* in_sizes, int n_in, void* d_out, int out_size, void* d_ws, size_t ws_size, hipStream_t stream) {
    Params p{};
    const float** ip = (const float**)&p.x;
    for (int i = 0; i < 38; ++i) ip[i] = (const float*)d_in[i];
    p.out = (float*)d_out;
    char* w = (char*)d_ws; size_t off = 0;
    auto take = [&](size_t bytes) { char* r = w + off; off += al256(bytes); return r; };
    p.bar = (unsigned*)take(16384); p.cnt = (int*)take(256);
    const size_t zero_bytes = off;
    p.mod = (float*)take(4 * 4 * 6144 * 4); p.wrt = (float*)take((size_t)2 * 4 * 48 * 2048 * 4); p.rbias = (float*)take(2 * 4 * 48 * 4);
    p.w_in0t = (bf16_t*)take((size_t)N_IN0 * DM * 2); p.w_out0t = (bf16_t*)take((size_t)DM * DM * 2);
    p.w_gut0 = (bf16_t*)take((size_t)NEXP * 2048 * DM); p.w_dt0 = (bf16_t*)take((size_t)NEXP * DM * EFF);
    p.w_in1t = (bf16_t*)take((size_t)N_IN1 * DM * 2); p.w_out1t = (bf16_t*)take((size_t)DM * LRU_W * 2);
    p.w_gut1 = (bf16_t*)take((size_t)NEXP * 2048 * DM); p.w_dt1 = (bf16_t*)take((size_t)NEXP * DM * EFF);
    p.w_lru = (bf16_t*)take((size_t)2 * 2 * 16 * 2 * 96 * 192 * 2);
    p.H = (bf16_t*)take((size_t)T_TOK * DM * 2); p.G = (bf16_t*)take((size_t)T_TOK * N_IN1 * 2); p.AO = (bf16_t*)take((size_t)T_TOK * LRU_W * 2); p.HF = (bf16_t*)take((size_t)256 * 32 * 8 * 3 * 64 * 8);
    p.XA = (bf16_t*)take((size_t)T_TOK * DM * 2); p.ACT = (bf16_t*)take((size_t)ROWS_PAD * EFF * 2); p.YB = (bf16_t*)take((size_t)ROWS_PAD * DM * 2);
    p.XC = (bf16_t*)take((size_t)T_TOK * LRU_W * 2); p.KVH = (bf16_t*)take((size_t)NBATCH * 8 * 2 * SEQ * 128 * 2);
    p.tokl = (int*)take((size_t)NEXP * ECAP * 4); p.gatel = (float*)take((size_t)NEXP * ECAP * 4); p.asg = (int*)take((size_t)T_TOK * 2 * 4);
    if (off > ws_size) return;
    (void)hipMemsetAsync(d_ws, 0, zero_bytes, stream);
    static int grid = 0;
    if (!grid) { int dev = 0, cus = 0, per_cu = 0; (void)hipGetDevice(&dev); (void)hipDeviceGetAttribute(&cus, hipDeviceAttributeMultiprocessorCount, dev);
        (void)hipFuncSetAttribute((const void*)mega, hipFuncAttributeMaxDynamicSharedMemorySize, LDS_TOTAL);
        (void)hipOccupancyMaxActiveBlocksPerMultiprocessor(&per_cu, mega, 512, LDS_TOTAL);
        grid = cus * (per_cu < 1 ? per_cu : 1); }
    if (grid > 0) mega<<<grid, 512, LDS_TOTAL, stream>>>(p);
}
```

```cpp
#include <hip/hip_runtime.h>
#include <stdint.h>

typedef unsigned short bf16_t;
typedef float f32x4 __attribute__((ext_vector_type(4)));

#define DI __device__ __forceinline__

constexpr int T_TOK = 16384, DM = 2048, SEQ = 4096, NBATCH = 4;
constexpr int N_IN0 = 5120, N_IN1 = 5376, LRU_W = 2688, LRU_BW = 168;
constexpr int NEXP = 32, EFF = 1024, ECAP = 16384, ROWS_PAD = 40960;

DI float bf2f(bf16_t b) { return __uint_as_float(((unsigned)b) << 16); }
DI bf16_t f2bf(float f) { unsigned u = __float_as_uint(f); u += 0x7FFFu + ((u >> 16) & 1u); return (bf16_t)(u >> 16); }
DI float sigmoidf_(float x) { return __builtin_amdgcn_rcpf(1.0f + __expf(-x)); }
DI float siluf_(float x) { return x * __builtin_amdgcn_rcpf(1.0f + __expf(-x)); }
DI float gelu_tanh(float x) { const float u = 0.7978845608028654f * (x + 0.044715f * x * x * x); return x * __builtin_amdgcn_rcpf(1.0f + __expf(-2.0f * u)); }
DI float wave_sum(float v) { for (int o = 32; o > 0; o >>= 1) v += __shfl_xor(v, o); return v; }
DI float wave_max(float v) { for (int o = 32; o > 0; o >>= 1) v = fmaxf(v, __shfl_xor(v, o)); return v; }

struct Params {
    const float *x, *c;
    const float *norm0_mix, *ada0_mix_w, *ada0_mix_b, *w_in0, *conv_w, *conv_b, *conv_norm_g, *conv_norm_b, *w_out0;
    const float *norm0_ffn, *ada0_ffn_w, *ada0_ffn_b, *moe0_w_group, *moe0_w_expert, *moe0_w_gate_up, *moe0_w_down;
    const float *norm1_mix, *ada1_mix_w, *ada1_mix_b, *w_in1, *lru_conv_w, *lru_conv_b, *lru_w_a, *lru_b_a, *lru_w_x, *lru_b_x, *lru_lambda, *w_out1;
    const float *norm1_ffn, *ada1_ffn_w, *ada1_ffn_b, *moe1_w_group, *moe1_w_expert, *moe1_w_gate_up, *moe1_w_down;
    const float *norm_final;
    float* out;
    unsigned* bar; int* cnt;
    float* mod;
    float* wrt;
    float* rbias;
    bf16_t *w_in0t, *w_out0t, *w_gut0, *w_dt0, *w_in1t, *w_out1t, *w_gut1, *w_dt1, *w_lru;
    bf16_t *H, *G, *AO, *HF, *ACT, *YB, *XC, *KVH;
    bf16_t* XA;
    int* tokl; float* gatel; int* asg;
};

constexpr bool YB8_E = true;
struct GUnit { int rowbase; int nvalid; int e; const int* gather; };
struct GArgs { const bf16_t* A; const bf16_t* Bt; size_t bt_estride; long long lda, K, moe_layer; const float* xin; long long lgate; };
typedef unsigned u32x4_ __attribute__((ext_vector_type(4)));
typedef __bf16 bf2v_ __attribute__((ext_vector_type(2)));
typedef float f32x2_ __attribute__((ext_vector_type(2)));
DI unsigned pk2e(float a, float b) { f32x2_ v = {a, b}; bf2v_ r = __builtin_convertvector(v, bf2v_); return __builtin_bit_cast(unsigned, r); }
DI u32x4_ pack8(f32x4 a, f32x4 b) { return (u32x4_){pk2e(a[0], a[1]), pk2e(a[2], a[3]), pk2e(b[0], b[1]), pk2e(b[2], b[3])}; }
struct EpiIn0 { static constexpr bool GATHER = false; const float* xin; int lgate; DI void operator()(const Params& p, const GUnit& u, int r, int col0, f32x4 lo0, f32x4 lo1, f32x4 hi0, f32x4 hi1) const {
    const int row = u.rowbase + r;
    if (col0 < 3072) { bf16_t* o = p.G + (size_t)row * N_IN0 + col0; *(u32x4_*)o = pack8(lo0, lo1); *(u32x4_*)(o + 128) = pack8(hi0, hi1); }
    else { const int b = row / SEQ, t = row % SEQ, i0 = (col0 - 3072) >> 7, i1 = i0 + 1;
        bf16_t* o0 = p.KVH + ((size_t)((b * 8 + (i0 & 7)) * 2 + (i0 >> 3)) * SEQ + t) * 128 + (col0 & 127);
        bf16_t* o1 = p.KVH + ((size_t)((b * 8 + (i1 & 7)) * 2 + (i1 >> 3)) * SEQ + t) * 128 + (col0 & 127);
        *(u32x4_*)o0 = pack8(lo0, lo1); *(u32x4_*)o1 = pack8(hi0, hi1); } } };
struct EpiOut { static constexpr bool GATHER = false; const float* xin; int lgate; DI void operator()(const Params& p, const GUnit& u, int r, int col0, f32x4 lo0, f32x4 lo1, f32x4 hi0, f32x4 hi1) const {
    const int row = u.rowbase + r, b = row / SEQ; const float* gt = p.mod + (lgate * 4 + b) * 6144 + 4096 + col0; bf16_t* o = p.XA + (size_t)row * DM + col0;
    f32x4 r0, r1, r2, r3;
    if (xin) { const float* xi = xin + (size_t)row * DM + col0; r0 = *(const f32x4*)xi; r1 = *(const f32x4*)(xi + 4); r2 = *(const f32x4*)(xi + 128); r3 = *(const f32x4*)(xi + 132); }
    else { const u32x4_ a = *(const u32x4_*)o, c = *(const u32x4_*)(o + 128);
        r0 = (f32x4){__uint_as_float(a[0] << 16), __uint_as_float(a[0] & 0xffff0000u), __uint_as_float(a[1] << 16), __uint_as_float(a[1] & 0xffff0000u)};
        r1 = (f32x4){__uint_as_float(a[2] << 16), __uint_as_float(a[2] & 0xffff0000u), __uint_as_float(a[3] << 16), __uint_as_float(a[3] & 0xffff0000u)};
        r2 = (f32x4){__uint_as_float(c[0] << 16), __uint_as_float(c[0] & 0xffff0000u), __uint_as_float(c[1] << 16), __uint_as_float(c[1] & 0xffff0000u)};
        r3 = (f32x4){__uint_as_float(c[2] << 16), __uint_as_float(c[2] & 0xffff0000u), __uint_as_float(c[3] << 16), __uint_as_float(c[3] & 0xffff0000u)}; }
    *(u32x4_*)o = pack8(r0 + *(const f32x4*)gt * lo0, r1 + *(const f32x4*)(gt + 4) * lo1); *(u32x4_*)(o + 128) = pack8(r2 + *(const f32x4*)(gt + 128) * hi0, r3 + *(const f32x4*)(gt + 132) * hi1); } };
DI unsigned pk4_fp8e(float a, float b, float c, float d, float sc) { a = fminf(fmaxf(a * sc, -448.f), 448.f); b = fminf(fmaxf(b * sc, -448.f), 448.f); c = fminf(fmaxf(c * sc, -448.f), 448.f); d = fminf(fmaxf(d * sc, -448.f), 448.f);
    unsigned w = 0u; w = __builtin_amdgcn_cvt_pk_fp8_f32(a, b, w, false); w = __builtin_amdgcn_cvt_pk_fp8_f32(c, d, w, true); return w; }
struct EpiGU { static constexpr bool GATHER = true; const float* xin; int lgate; DI void operator()(const Params& p, const GUnit& u, int r, int col0, f32x4 lo0, f32x4 lo1, f32x4 hi0, f32x4 hi1) const {
    f32x4 a0, a1;
#pragma unroll
    for (int j = 0; j < 4; ++j) { a0[j] = siluf_(lo0[j]) * hi0[j]; a1[j] = siluf_(lo1[j]) * hi1[j]; }
    *(uint2*)((unsigned char*)p.ACT + (size_t)(u.rowbase + r) * EFF + (col0 >> 8) * 128 + (col0 & 127)) = make_uint2(pk4_fp8e(a0[0], a0[1], a0[2], a0[3], 8.f), pk4_fp8e(a1[0], a1[1], a1[2], a1[3], 8.f)); } };
struct EpiDown { static constexpr bool GATHER = false; const float* xin; int lgate; DI void operator()(const Params& p, const GUnit& u, int r, int col0, f32x4 lo0, f32x4 lo1, f32x4 hi0, f32x4 hi1) const {
    const float g = p.gatel[(u.gather - p.tokl) + r];
    if constexpr (YB8_E) { const float gs = g * 64.f; unsigned char* o = (unsigned char*)p.YB + (size_t)(u.rowbase + r) * DM + col0;
        *(uint2*)o = make_uint2(pk4_fp8e(lo0[0], lo0[1], lo0[2], lo0[3], gs), pk4_fp8e(lo1[0], lo1[1], lo1[2], lo1[3], gs)); *(uint2*)(o + 128) = make_uint2(pk4_fp8e(hi0[0], hi0[1], hi0[2], hi0[3], gs), pk4_fp8e(hi1[0], hi1[1], hi1[2], hi1[3], gs)); }
    else { bf16_t* o = p.YB + (size_t)(u.rowbase + r) * DM + col0; *(u32x4_*)o = pack8(lo0 * g, lo1 * g); *(u32x4_*)(o + 128) = pack8(hi0 * g, hi1 * g); } } };
struct EpiIn1 { static constexpr bool GATHER = false; const float* xin; int lgate; DI void operator()(const Params& p, const GUnit& u, int r, int col0, f32x4 lo0, f32x4 lo1, f32x4 hi0, f32x4 hi1) const {
    bf16_t* o = p.G + (size_t)(u.rowbase + r) * N_IN1 + col0;
    if (col0 < LRU_W) {
#pragma unroll
        for (int j = 0; j < 4; ++j) { lo0[j] = gelu_tanh(lo0[j]); lo1[j] = gelu_tanh(lo1[j]); } }
    if (col0 + 128 < LRU_W) {
#pragma unroll
        for (int j = 0; j < 4; ++j) { hi0[j] = gelu_tanh(hi0[j]); hi1[j] = gelu_tanh(hi1[j]); } }
    *(u32x4_*)o = pack8(lo0, lo1); *(u32x4_*)(o + 128) = pack8(hi0, hi1); } };

#define LAS __attribute__((address_space(3)))
typedef short bf16x8 __attribute__((ext_vector_type(8)));
DI int opaque_tid() { int t = threadIdx.x; asm volatile("" : "+v"(t)); return t; }
namespace gm {
constexpr int BM = 256, BK = 64, HALF = 128, HTB = HALF * BK * 2, STAGE_BYTES = 8 * HTB, NXCD = 8, WGM = 4;
constexpr int TAB_OFF = STAGE_BYTES;
DI int lds_byte(int r, int c) { const int st = (r >> 4) * 2 + (c >> 5), rr = r & 15, cc = c & 31, ob = rr * 64 + cc * 2; return st * 1024 + (ob ^ (((ob >> 9) & 1) << 5)); }
DI int perm32(int rho) { const int n = rho >> 4, i = rho & 15; return 8 * (i >> 2) + 4 * n + (i & 3); }
DI void stage_rc(int b, int& R, int& C) { const int st = b / 1024, sb = b % 1024, swz = sb ^ (((sb >> 9) & 1) << 5); R = (st >> 1) * 16 + swz / 64; C = (st & 1) * 32 + (swz % 64) / 2; }
struct Unit { int arow, nvalid, orow, pn, e, goff; };
struct DenseSched {
    static constexpr bool GATHER = false, HALF_SKIP = false;
    int nM, nN, nwg, G, c;
    DI void init(int M, int N) { nM = M / BM; nN = N / BM; nwg = nM * nN; G = gridDim.x; c = blockIdx.x; }
    DI bool next(int i, Unit& u) const {
        const long L = (long)i * G + c; if (L >= nwg) return false;
        int wgid = (int)L; { const int q = nwg / NXCD, r = nwg % NXCD, xcd = wgid % NXCD, off = wgid / NXCD; wgid = (xcd < r ? xcd * (q + 1) : r * (q + 1) + (xcd - r) * q) + off; }
        const int nig = WGM * nN, gid = wgid / nig, fm = gid * WGM, gsz = (nM - fm) < WGM ? (nM - fm) : WGM;
        const int pm = fm + ((wgid % nig) % gsz); u.pn = (wgid % nig) / gsz; u.arow = pm * BM; u.orow = pm * BM; u.nvalid = BM; u.e = 0; u.goff = 0; return true;
    }
};
template <bool GATH> struct MoeSched {
    static constexpr bool GATHER = GATH, HALF_SKIP = true;
    const LAS int* tab; int G, c;
    DI void init(const LAS int* t) { tab = t; G = gridDim.x; c = blockIdx.x; }
    DI bool next(int i, Unit& u) const {
        const int L = i * G + c, mtile = L >> 3; const int total = __builtin_amdgcn_readfirstlane(tab[32]);
        if (mtile >= total) return false;
        int e = 0; for (int j = 1; j < 32; ++j) { if (__builtin_amdgcn_readfirstlane(tab[j]) <= mtile) e = j; }
        const int mt = mtile - __builtin_amdgcn_readfirstlane(tab[e]); const int cn = __builtin_amdgcn_readfirstlane(tab[64 + e]);
        u.e = e; u.pn = L & 7; u.orow = mtile * BM; u.arow = mtile * BM; u.nvalid = (cn - mt * BM) < BM ? (cn - mt * BM) : BM; u.goff = e * ECAP + mt * BM; return true;
    }
};
DI void moe_tables(LAS int* tab, const int* cnt) {
    if (threadIdx.x == 0) { int run = 0; for (int e = 0; e < 32; ++e) { const int cn = cnt[e]; tab[e] = run; tab[64 + e] = cn; run += (cn + 255) >> 8; } tab[32] = run; }
    __syncthreads();
}

typedef int i32x8 __attribute__((ext_vector_type(8)));
typedef int i32x4 __attribute__((ext_vector_type(4)));
DI void mfma8(f32x4& acc, const i32x8& w8, const i32x8& x8, int ws, int as) {
    asm volatile("v_mfma_scale_f32_16x16x128_f8f6f4 %0, %1, %2, %0, %3, %4 op_sel_hi:[0,0,0]" : "+v"(acc) : "v"(w8), "v"(x8), "v"(ws), "v"(as)); }
template <class Epi, class Sched, bool FP8 = false>
DI void gemm_phase(LAS unsigned char* lds, const Params& p, const bf16_t* A, const bf16_t* Bt, size_t bt_estride, int K, const Sched& S, const Epi& E, int wscale = 0x7f7f7f7f, int ascale = 0x7f7f7f7f) {
    const int tid = opaque_tid(), wid = __builtin_amdgcn_readfirstlane(tid >> 6), lane = tid & 63, wr = wid >> 2, wc = wid & 3, fr = lane & 15, fq = lane >> 4;
    const int nt = K / BK;
    unsigned voffA[2], voffB[2];
#pragma unroll
    for (int i = 0; i < 2; ++i) { int R, C; stage_rc(tid * 16 + i * 8192, R, C); voffA[i] = (unsigned)(R * K + C) * 2u; voffB[i] = (unsigned)(((R & ~31) + perm32(R & 31)) * K + C) * 2u; }
    const size_t kstep = (size_t)(BK * 2), hstep = (size_t)HALF * K * 2, tstep = 2 * hstep;
    const unsigned ldsw = (unsigned)wid * 1024u;
    const int aoff = lds_byte(wr * 64 + fr, fq * 8), boff = lds_byte(wc * 32 + fr, fq * 8);
#define G_SA(b, h) (((b) * 2 + (h)) * HTB)
#define G_SB(b, h) ((4 + (b) * 2 + (h)) * HTB)
#define G_STAGE(bufoff, gbase, voff) do { _Pragma("unroll") for (int _i = 0; _i < 2; ++_i) \
        __builtin_amdgcn_global_load_lds((const unsigned*)((const char*)(gbase) + (voff)[_i]), (LAS unsigned*)(lds + (bufoff) + ldsw + _i * 8192), 16, 0, 0); } while (0)
#define G_STAGE_A(bufoff, ubase, gv, h, koff) do { if constexpr (Sched::GATHER) { G_STAGE(bufoff, (const char*)A + (koff), gv[h]); } else { G_STAGE(bufoff, (ubase) + (h) * hstep + (koff), voffA); } } while (0)
#define G_LD16(off_) (*(const LAS i32x4*)(lds + (off_)))
#define G_LD16B(off_) (*(const LAS bf16x8*)(lds + (off_)))
#define G_LDA(dst, b, h) do { _Pragma("unroll") for (int m = 0; m < 4; ++m) { if constexpr (FP8) dst##8[m] = __builtin_shufflevector(G_LD16(G_SA(b, h) + aoff + m * 2048), G_LD16(G_SA(b, h) + aoff + m * 2048 + 1024), 0, 1, 2, 3, 4, 5, 6, 7); \
        else { dst[m][0] = G_LD16B(G_SA(b, h) + aoff + m * 2048); dst[m][1] = G_LD16B(G_SA(b, h) + aoff + m * 2048 + 1024); } } } while (0)
#define G_LDB(dst, b, h) do { _Pragma("unroll") for (int n = 0; n < 2; ++n) { if constexpr (FP8) dst##8[n] = __builtin_shufflevector(G_LD16(G_SB(b, h) + boff + n * 2048), G_LD16(G_SB(b, h) + boff + n * 2048 + 1024), 0, 1, 2, 3, 4, 5, 6, 7); \
        else { dst[n][0] = G_LD16B(G_SB(b, h) + boff + n * 2048); dst[n][1] = G_LD16B(G_SB(b, h) + boff + n * 2048 + 1024); } } } while (0)
#define G_MMA(ai, bj, At, Bt_) do { __builtin_amdgcn_s_setprio(1); _Pragma("unroll") for (int m = 0; m < 4; ++m) _Pragma("unroll") for (int n = 0; n < 2; ++n) { \
        if constexpr (FP8) mfma8(acc[ai][bj][m][n], Bt_##8[n], At##8[m], wscale, ascale); \
        else { _Pragma("unroll") for (int k = 0; k < 2; ++k) acc[ai][bj][m][n] = __builtin_amdgcn_mfma_f32_16x16x32_bf16(Bt_[n][k], At[m][k], acc[ai][bj][m][n], 0, 0, 0); } } \
        __builtin_amdgcn_s_setprio(0); } while (0)
#define G_WAIT_V(n) asm volatile("s_waitcnt vmcnt(" #n ")" ::: "memory")
#define G_WAIT_L(n) asm volatile("s_waitcnt lgkmcnt(" #n ")" ::: "memory")
#define G_BAR __builtin_amdgcn_s_barrier()
#define G_SCHED __builtin_amdgcn_sched_barrier(0)
    Unit cur, nxt; int ui = 0;
    if (!S.next(0, cur)) return;
    f32x4 acc[2][2][4][2];
#pragma unroll
    for (int a = 0; a < 2; ++a)
#pragma unroll
        for (int b = 0; b < 2; ++b)
#pragma unroll
            for (int m = 0; m < 4; ++m)
#pragma unroll
                for (int n = 0; n < 2; ++n) acc[a][b][m][n] = (f32x4){0.f, 0.f, 0.f, 0.f};
    bf16x8 At[4][2], B0[2][2], B1[2][2]; i32x8 At8[4], B08[2], B18[2];
    unsigned gcur[2][2] = {{0u, 0u}, {0u, 0u}}, gnxt[2][2] = {{0u, 0u}, {0u, 0u}};
    auto gather_offs = [&](const Unit& u, unsigned (&g)[2][2]) {
        if constexpr (Sched::GATHER) {
#pragma unroll
            for (int h = 0; h < 2; ++h)
#pragma unroll
                for (int i = 0; i < 2; ++i) { int tz = tid; asm volatile("" : "+v"(tz)); int R, C; stage_rc(tz * 16 + i * 8192, R, C); const int r = h * HALF + R; const int tk = p.tokl[u.goff + (r < u.nvalid ? r : 0)]; const int tok = r < u.nvalid ? tk : 0; g[h][i] = (unsigned)(tok * K + C) * 2u; }
        }
    };
    const char* cA = (const char*)A + (size_t)(cur.arow / BM) * tstep; const char* cB = (const char*)Bt + ((size_t)cur.e * bt_estride) * 2 + (size_t)cur.pn * tstep;
    gather_offs(cur, gcur);
    G_STAGE(G_SB(0, 0), cB, voffB); G_STAGE_A(G_SA(0, 0), cA, gcur, 0, 0); G_STAGE(G_SB(0, 1), cB + hstep, voffB); G_STAGE_A(G_SA(0, 1), cA, gcur, 1, 0);
    if (wr == 1) G_BAR;
    G_WAIT_V(4); G_BAR;
    G_STAGE(G_SB(1, 0), cB + kstep, voffB); G_STAGE_A(G_SA(1, 0), cA, gcur, 0, kstep); G_STAGE(G_SB(1, 1), cB + hstep + kstep, voffB);
    G_WAIT_V(6); G_BAR;
    for (;;) {
        const bool has_next = S.next(ui + 1, nxt);
        const char* nA = has_next ? (const char*)A + (size_t)(nxt.arow / BM) * tstep : cA;
        const char* nB = has_next ? (const char*)Bt + ((size_t)nxt.e * bt_estride) * 2 + (size_t)nxt.pn * tstep : cB;
        if constexpr (Sched::GATHER) { if (has_next) gather_offs(nxt, gnxt); else {
#pragma unroll
            for (int h = 0; h < 2; ++h) { gnxt[h][0] = gcur[h][0]; gnxt[h][1] = gcur[h][1]; } } }
        for (int t = 0; t < nt; t += 2) {
            const bool last = (t == nt - 2);
            const size_t k1 = (size_t)(t + 1) * kstep;
            const char* a2 = last ? nA : cA; const char* b2 = last ? nB : cB + (size_t)(t + 2) * kstep;
            const size_t k2 = last ? 0 : (size_t)(t + 2) * kstep; const size_t k3 = k2 + kstep;
            const char* b3 = b2 + kstep;
            unsigned g2[2][2];
#pragma unroll
            for (int h = 0; h < 2; ++h) { g2[h][0] = last ? gnxt[h][0] : gcur[h][0]; g2[h][1] = last ? gnxt[h][1] : gcur[h][1]; }
            G_LDB(B0, 0, 0); G_SCHED; G_LDA(At, 0, 0); G_STAGE_A(G_SA(1, 1), cA, gcur, 1, k1);
            G_WAIT_L(8); G_BAR; G_WAIT_L(0); G_MMA(0, 0, At, B0); G_BAR; G_SCHED;
            G_LDB(B1, 0, 1); G_STAGE(G_SB(0, 0), b2, voffB);
            G_BAR; G_WAIT_L(0); G_MMA(0, 1, At, B1); G_BAR;
            G_LDA(At, 0, 1); G_STAGE_A(G_SA(0, 0), a2, g2, 0, k2);
            G_BAR; G_WAIT_L(0); if (!Sched::HALF_SKIP || cur.nvalid > HALF) G_MMA(1, 0, At, B0); G_BAR; G_SCHED;
            G_STAGE(G_SB(0, 1), b2 + hstep, voffB);
            G_WAIT_V(6); G_BAR; if (!Sched::HALF_SKIP || cur.nvalid > HALF) G_MMA(1, 1, At, B1); G_BAR;
            G_LDB(B0, 1, 0); G_SCHED; G_LDA(At, 1, 0); G_STAGE_A(G_SA(0, 1), a2, g2, 1, k2);
            G_WAIT_L(8); G_BAR; G_WAIT_L(0); G_MMA(0, 0, At, B0); G_BAR; G_SCHED;
            G_LDB(B1, 1, 1); G_STAGE(G_SB(1, 0), b3, voffB);
            G_BAR; G_WAIT_L(0); G_MMA(0, 1, At, B1); G_BAR;
            G_LDA(At, 1, 1); G_STAGE_A(G_SA(1, 0), a2, g2, 0, k3);
            G_BAR; G_WAIT_L(0); if (!Sched::HALF_SKIP || cur.nvalid > HALF) G_MMA(1, 0, At, B0); G_BAR; G_SCHED;
            G_STAGE(G_SB(1, 1), b3 + hstep, voffB);
            G_WAIT_V(6); G_BAR; if (!Sched::HALF_SKIP || cur.nvalid > HALF) G_MMA(1, 1, At, B1); G_BAR;
        }
        if constexpr (FP8) asm volatile("s_nop 15\n\ts_nop 15" ::: "memory");
        { GUnit gu; gu.rowbase = cur.orow; gu.nvalid = cur.nvalid; gu.e = cur.e; gu.gather = p.tokl + cur.goff;
#pragma unroll
          for (int ai = 0; ai < 2; ++ai)
#pragma unroll
            for (int m = 0; m < 4; ++m) { const int r = ai * HALF + wr * 64 + m * 16 + fr;
              if (r < cur.nvalid) E(p, gu, r, cur.pn * BM + wc * 32 + fq * 8, acc[ai][0][m][0], acc[ai][0][m][1], acc[ai][1][m][0], acc[ai][1][m][1]); } }
        if (!has_next) break;
#pragma unroll
        for (int a = 0; a < 2; ++a)
#pragma unroll
            for (int b = 0; b < 2; ++b)
#pragma unroll
                for (int m = 0; m < 4; ++m)
#pragma unroll
                    for (int n = 0; n < 2; ++n) acc[a][b][m][n] = (f32x4){0.f, 0.f, 0.f, 0.f};
        cur = nxt; cA = nA; cB = nB; ++ui;
#pragma unroll
        for (int h = 0; h < 2; ++h) { gcur[h][0] = gnxt[h][0]; gcur[h][1] = gnxt[h][1]; }
    }
    G_WAIT_V(0);
    if (wr == 0) G_BAR;
    G_BAR;
}
}

extern __shared__ __attribute__((aligned(16))) unsigned char dyn_smem[];
constexpr int LDS_BYTES = gm::STAGE_BYTES + 1024;

typedef __bf16 bf2v __attribute__((ext_vector_type(2)));
typedef float f32x2 __attribute__((ext_vector_type(2)));
typedef float f32x16 __attribute__((ext_vector_type(16)));
typedef short s16x4 __attribute__((ext_vector_type(4)));
typedef unsigned u32x4 __attribute__((ext_vector_type(4)));
DI unsigned pk2(float a, float b) { f32x2 v = {a, b}; bf2v r = __builtin_convertvector(v, bf2v); return __builtin_bit_cast(unsigned, r); }
DI float bflo(unsigned u) { return __uint_as_float(u << 16); }
DI float bfhi(unsigned u) { return __uint_as_float(u & 0xffff0000u); }

DI unsigned pk4_fp8(float a, float b, float c, float d, float sc) {
    a = __builtin_amdgcn_fmed3f(a * sc, -448.f, 448.f); b = __builtin_amdgcn_fmed3f(b * sc, -448.f, 448.f); c = __builtin_amdgcn_fmed3f(c * sc, -448.f, 448.f); d = __builtin_amdgcn_fmed3f(d * sc, -448.f, 448.f);
    unsigned w = 0u; w = __builtin_amdgcn_cvt_pk_fp8_f32(a, b, w, false); w = __builtin_amdgcn_cvt_pk_fp8_f32(c, d, w, true); return w; }
constexpr bool D8_IN0 = true, D8_OUT0 = false, D8_IN1 = false;
constexpr bool YB8 = true;
constexpr float Y8_SCALE = 64.f;
constexpr float W8_SCALE = 256.f, A8_SCALE = 8.f;
constexpr int W8_E8M0 = 0x77777777, A8_E8M0 = 0x7c7c7c7c;
namespace ph {
DI void mods(const Params& p, LAS unsigned char* lds) {
    const int tid = opaque_tid(), wave = tid >> 6, lane = tid & 63, l8 = tid & 7, rg = tid >> 3;
    LAS float* fl = (LAS float*)lds; LAS float* red = fl + 4 * DM;
    for (int i = tid; i < 4 * DM; i += 512) fl[i] = siluf_(p.c[i]);
    __syncthreads();
    for (int u = blockIdx.x; u < 768; u += gridDim.x) {
        const int l = u / 192, c32 = u % 192;
        const float* w = l == 0 ? p.ada0_mix_w : l == 1 ? p.ada0_ffn_w : l == 2 ? p.ada1_mix_w : p.ada1_ffn_w;
        const float* bs = l == 0 ? p.ada0_mix_b : l == 1 ? p.ada0_ffn_b : l == 2 ? p.ada1_mix_b : p.ada1_ffn_b;
        f32x4 acc[4] = {{0.f, 0.f, 0.f, 0.f}, {0.f, 0.f, 0.f, 0.f}, {0.f, 0.f, 0.f, 0.f}, {0.f, 0.f, 0.f, 0.f}};
        const float* wp = w + (size_t)rg * 6144 + c32 * 32 + l8 * 4;
#pragma unroll 8
        for (int i = 0; i < 32; ++i) { const f32x4 wv = *(const f32x4*)(wp + (size_t)(64 * i) * 6144); const int k = rg + 64 * i;
#pragma unroll
            for (int b = 0; b < 4; ++b) acc[b] += fl[b * DM + k] * wv; }
#pragma unroll
        for (int b = 0; b < 4; ++b)
#pragma unroll
            for (int j = 0; j < 4; ++j) { float v = acc[b][j]; v += __shfl_xor(v, 8); v += __shfl_xor(v, 16); v += __shfl_xor(v, 32); acc[b][j] = v; }
        if (lane < 8) {
#pragma unroll
            for (int b = 0; b < 4; ++b) *(LAS f32x4*)(red + (wave * 4 + b) * 32 + lane * 4) = acc[b]; }
        __syncthreads();
        if (tid < 128) { const int b = tid >> 5, col = tid & 31; float sum = 0.f;
#pragma unroll
            for (int w8 = 0; w8 < 8; ++w8) sum += red[(w8 * 4 + b) * 32 + col];
            p.mod[(l * 4 + b) * 6144 + c32 * 32 + col] = sum + bs[c32 * 32 + col]; }
        __syncthreads();
    }
}
constexpr int NT_UNITS = (640 + 256 + 672 + 336 + 2 * (8192 + 4096)) / 2;
struct UD { const float* sp; bf16_t* dst; int K, N, mode, e, kt, ntile; };
DI UD tdecode(const Params& p, int u, int lane) {
    const float* srcs[8] = {p.w_in0, p.w_out0, p.w_in1, p.w_out1, p.moe0_w_gate_up, p.moe0_w_down, p.moe1_w_gate_up, p.moe1_w_down};
    bf16_t* dsts[8] = {p.w_in0t, p.w_out0t, p.w_in1t, p.w_out1t, p.w_gut0, p.w_dt0, p.w_gut1, p.w_dt1};
    constexpr int Ks[8] = {DM, DM, DM, LRU_W, DM, EFF, DM, EFF}, Ns[8] = {N_IN0, DM, N_IN1, DM, 2048, DM, 2048, DM}, nus[8] = {320, 128, 336, 168, 4096, 2048, 4096, 2048};
    constexpr int modes[8] = {D8_IN0 ? 2 : 0, D8_OUT0 ? 2 : 0, D8_IN1 ? 2 : 0, 0, 3, 2, 3, 2};
    int v = u, mi = 0;
#pragma unroll
    for (int m = 0; m < 8; ++m) { if (mi == m && v >= nus[m]) { v -= nus[m]; mi = m + 1; } }
    UD d; const float* src = srcs[0]; d.dst = dsts[0]; d.K = Ks[0]; d.N = Ns[0]; d.mode = modes[0];
#pragma unroll
    for (int m = 1; m < 8; ++m) if (mi == m) { src = srcs[m]; d.dst = dsts[m]; d.K = Ks[m]; d.N = Ns[m]; d.mode = modes[m]; }
    const int ntl = d.N / 256, ktl = d.K / 128; d.e = v / (ktl * ntl); const int rem = v % (ktl * ntl); d.kt = rem / ntl; d.ntile = rem % ntl;
    d.sp = src + (size_t)d.e * d.K * d.N + (size_t)(d.kt * 128) * d.N + d.ntile * 256 + lane * 4;
    return d;
}
DI void transposer(const Params& p, LAS unsigned char* lds, int first, int count, int stride) {
    const int tid = opaque_tid(), wave = tid >> 6, lane = tid & 63;
    LAS float* fl = (LAS float*)lds;
    if (count <= 0) return;
    if (tdecode(p, first, lane).mode & 2) {
        LAS unsigned* td = (LAS unsigned*)lds;
        const int nl = lane & 15, ks = lane >> 4;
        auto src_of = [&](const UD& d, int g, int j) -> const float* { const int kq = 4 * (g >> 2) + ks, nq = 16 * (g & 3) + nl; return d.sp - lane * 4 + (size_t)(4 * kq + j) * d.N + 4 * nq; };
        f32x4 va[4][4], vb[4][4];
        auto load_unit = [&](int u, f32x4 (&v)[4][4]) { const UD dd = tdecode(p, u, lane);
#pragma unroll
            for (int i = 0; i < 4; ++i)
#pragma unroll
                for (int j = 0; j < 4; ++j) v[i][j] = *(const f32x4*)src_of(dd, wave * 4 + i, j); };
        auto process = [&](int jn, f32x4 (&v)[4][4]) { const int u = first + jn * stride;
            const UD d = tdecode(p, u, lane); const int K = d.K, N = d.N, mode = d.mode, e = d.e, kt = d.kt, ntile = d.ntile;
            LAS unsigned* tile = td + (jn & 1) * (256 * 33);
#pragma unroll
            for (int i = 0; i < 4; ++i) { const int g = wave * 4 + i, kq = 4 * (g >> 2) + ks, nq = 16 * (g & 3) + nl;
#pragma unroll
                for (int en = 0; en < 4; ++en) tile[(4 * nq + en) * 33 + kq] = pk4_fp8(v[i][0][en], v[i][1][en], v[i][2][en], v[i][3][en], W8_SCALE); }
            __syncthreads();
            if (jn + 2 < count) load_unit(u + 2 * stride, v);
            { const int n = tid >> 1, kh = tid & 1; const int ng = ntile * 256 + n; const int jg = ng & 1023; const int np = (mode & 1) ? (256 * (jg >> 7) + (ng < 1024 ? 0 : 128) + (jg & 127)) : ng;
              unsigned char* dp = (unsigned char*)d.dst + (size_t)e * N * K + (size_t)np * K + kt * 128 + kh * 64;
#pragma unroll
              for (int jj = 0; jj < 4; ++jj) { const LAS unsigned* tp = tile + n * 33 + kh * 16 + jj * 4; *(uint4*)(dp + jj * 16) = make_uint4(tp[0], tp[1], tp[2], tp[3]); } } };
        load_unit(first, va); if (count > 1) load_unit(first + stride, vb);
        for (int jn = 0; jn < count; jn += 2) { process(jn, va); if (jn + 1 < count) process(jn + 1, vb); }
        __syncthreads();
        return;
    }
    f32x4 vv[16];
    { const UD d0 = tdecode(p, first, lane);
#pragma unroll
        for (int i = 0; i < 16; ++i) vv[i] = *(const f32x4*)(d0.sp + (size_t)(i * 8 + wave) * d0.N); }
    for (int j = 0; j < count; ++j) { const int u = first + j * stride;
        const UD d = tdecode(p, u, lane); const int K = d.K, N = d.N, mode = d.mode, e = d.e, kt = d.kt, ntile = d.ntile; bf16_t* dst = d.dst;
#pragma unroll
        for (int i = 0; i < 16; ++i) { LAS float* tp = fl + (i * 8 + wave) * 257 + lane * 4; tp[0] = vv[i][0]; tp[1] = vv[i][1]; tp[2] = vv[i][2]; tp[3] = vv[i][3]; }
        __syncthreads();
        if (j + 1 < count) { const UD dn = tdecode(p, u + stride, lane);
#pragma unroll
            for (int i = 0; i < 16; ++i) vv[i] = *(const f32x4*)(dn.sp + (size_t)(i * 8 + wave) * dn.N); }
        { const int n = tid >> 1, kh = tid & 1; const int ng = ntile * 256 + n; const int jg = ng & 1023; const int np = (mode & 1) ? (256 * (jg >> 7) + (ng < 1024 ? 0 : 128) + (jg & 127)) : ng;
          bf16_t* dp = dst + (size_t)e * N * K + (size_t)np * K + kt * 128 + kh * 64;
#pragma unroll
          for (int jj = 0; jj < 8; ++jj) { unsigned w4[4];
#pragma unroll
              for (int q = 0; q < 4; ++q) { const int k = kh * 64 + jj * 8 + q * 2; w4[q] = pk2(fl[k * 257 + n], fl[(k + 1) * 257 + n]); }
              *(uint4*)(dp + jj * 8) = make_uint4(w4[0], w4[1], w4[2], w4[3]); } }
        __syncthreads();
    }
}
DI void lru_weights(const Params& p) {
    const int tid = opaque_tid();
    for (size_t i = (size_t)blockIdx.x * 512 + tid; i < (size_t)2 * 2 * 16 * 4 * 48 * 192; i += (size_t)gridDim.x * 512) {
        const int k = i % 192, j = (i / 192) % 48, qt = (i / (192 * 48)) % 4, n = (i / (192 * 48 * 4)) % 16, which = (i / (192 * 48 * 4 * 16)) % 2, dir = i / (192 * 48 * 4 * 16 * 2);
        const float* w = which == 0 ? p.lru_w_a : p.lru_w_x; float v = 0.f;
        if (j < 42 && k < 168) v = w[(((size_t)dir * 16 + n) * 168 + k) * 168 + qt * 42 + j];
        p.w_lru[i] = f2bf(v);
    }
}
DI void fold_router(const Params& p) {
    const int tid = opaque_tid(), wave = tid >> 6, lane = tid & 63;
    for (size_t i = (size_t)blockIdx.x * 512 + tid; i < (size_t)2 * 4 * 48 * DM; i += (size_t)gridDim.x * 512) {
        const int k = i % DM, n = (i / DM) % 48, b = (i / (DM * 48)) % 4, l = i / (DM * 48 * 4);
        const float* g = l == 0 ? p.norm0_ffn : p.norm1_ffn; const float* md = p.mod + ((l == 0 ? 1 : 3) * 4 + b) * 6144;
        const float* we = l == 0 ? p.moe0_w_expert : p.moe1_w_expert; const float* wg = l == 0 ? p.moe0_w_group : p.moe1_w_group;
        const float w = n < 32 ? we[k * 32 + n] : n < 36 ? wg[k * 4 + (n - 32)] : 0.f;
        p.wrt[i] = g[k] * (1.f + md[2048 + k]) * w;
    }
    for (int task = blockIdx.x * 8 + wave; task < 2 * 4 * 48; task += gridDim.x * 8) {
        const int n = task % 48, b = (task / 48) % 4, l = task / (48 * 4);
        const float* md = p.mod + ((l == 0 ? 1 : 3) * 4 + b) * 6144;
        const float* we = l == 0 ? p.moe0_w_expert : p.moe1_w_expert; const float* wg = l == 0 ? p.moe0_w_group : p.moe1_w_group;
        float part = 0.f;
        for (int k = lane; k < DM; k += 64) { const float w = n < 32 ? we[k * 32 + n] : n < 36 ? wg[k * 4 + (n - 32)] : 0.f; part += md[k] * w; }
        part = wave_sum(part); if (lane == 0) p.rbias[task] = part;
    }
}
template <int MODE, bool OUT8 = false> DI void norm_rows(const Params& p, const float* xin  , const float* gain, int lmod, int lgate, const LAS int* tab) {
    const int tid = opaque_tid(), wave = tid >> 6, lane = tid & 63;
    for (int row = blockIdx.x * 8 + wave; row < T_TOK; row += gridDim.x * 8) {
        const int b = row / SEQ;
        f32x4 v[8];
        if (xin) {
#pragma unroll
            for (int i = 0; i < 8; ++i) v[i] = *(const f32x4*)(xin + (size_t)row * DM + i * 256 + lane * 4);
        } else {
#pragma unroll
            for (int i = 0; i < 8; ++i) { const uint2 a = *(const uint2*)(p.XA + (size_t)row * DM + i * 256 + lane * 4); v[i] = (f32x4){bflo(a.x), bfhi(a.x), bflo(a.y), bfhi(a.y)}; }
        }
        if constexpr (MODE >= 1) {
            const int a0 = p.asg[row * 2], a1 = p.asg[row * 2 + 1];
            const size_t r0 = (size_t)tab[a0 >> 14] * 256 + (a0 & 16383), r1 = (size_t)tab[a1 >> 14] * 256 + (a1 & 16383);
            const float* gt = p.mod + (lgate * 4 + b) * 6144 + 4096;
#pragma unroll
            for (int i = 0; i < 8; ++i) { const int col = i * 256 + lane * 4; const f32x4 g4 = *(const f32x4*)(gt + col);
                if constexpr (YB8) { const unsigned y0 = *(const unsigned*)((const unsigned char*)p.YB + r0 * DM + col), y1 = *(const unsigned*)((const unsigned char*)p.YB + r1 * DM + col);
                    const f32x2 a0 = __builtin_amdgcn_cvt_pk_f32_fp8(y0, false), a1 = __builtin_amdgcn_cvt_pk_f32_fp8(y0, true), b0 = __builtin_amdgcn_cvt_pk_f32_fp8(y1, false), b1 = __builtin_amdgcn_cvt_pk_f32_fp8(y1, true);
                    const f32x4 gq = g4 * (1.f / Y8_SCALE);
                    v[i][0] += gq[0] * (a0[0] + b0[0]); v[i][1] += gq[1] * (a0[1] + b0[1]); v[i][2] += gq[2] * (a1[0] + b1[0]); v[i][3] += gq[3] * (a1[1] + b1[1]); }
                else { const uint2 y0 = *(const uint2*)(p.YB + r0 * DM + col), y1 = *(const uint2*)(p.YB + r1 * DM + col);
                v[i][0] += g4[0] * (bflo(y0.x) + bflo(y1.x)); v[i][1] += g4[1] * (bfhi(y0.x) + bfhi(y1.x));
                v[i][2] += g4[2] * (bflo(y0.y) + bflo(y1.y)); v[i][3] += g4[3] * (bfhi(y0.y) + bfhi(y1.y)); } }
            if constexpr (MODE == 1) {
#pragma unroll
                for (int i = 0; i < 8; ++i) { const uint2 w = make_uint2(pk2(v[i][0], v[i][1]), pk2(v[i][2], v[i][3])); *(uint2*)(p.XA + (size_t)row * DM + i * 256 + lane * 4) = w;
                    v[i] = (f32x4){bflo(w.x), bfhi(w.x), bflo(w.y), bfhi(w.y)}; }
            }
        }
        float ss = 0.f;
#pragma unroll
        for (int i = 0; i < 8; ++i) ss += v[i][0] * v[i][0] + v[i][1] * v[i][1] + v[i][2] * v[i][2] + v[i][3] * v[i][3];
        ss = wave_sum(ss); const float rstd = rsqrtf(ss * (1.0f / DM) + 1e-6f);
        if constexpr (MODE == 2) {
#pragma unroll
            for (int i = 0; i < 8; ++i) { const int col = i * 256 + lane * 4; const f32x4 g4 = *(const f32x4*)(gain + col); *(f32x4*)(p.out + (size_t)row * DM + col) = v[i] * rstd * g4; }
        } else { const float* md = p.mod + (lmod * 4 + b) * 6144;
#pragma unroll
            for (int i = 0; i < 8; ++i) { const int col = i * 256 + lane * 4; const f32x4 g4 = *(const f32x4*)(gain + col), sc = *(const f32x4*)(md + 2048 + col), sh = *(const f32x4*)(md + col);
                const f32x4 h = v[i] * rstd * g4 * (1.f + sc) + sh;
                if constexpr (OUT8) *(unsigned*)((unsigned char*)p.H + (size_t)row * DM + col) = pk4_fp8(h[0], h[1], h[2], h[3], A8_SCALE);
                else *(uint2*)(p.H + (size_t)row * DM + col) = make_uint2(pk2(h[0], h[1]), pk2(h[2], h[3])); } }
    }
}
template <bool DRY = false, bool NORM = false> DI void router(const Params& p, int l, LAS unsigned char* lds, const float* gain = nullptr, int lmod = 0) {
    const int tid = opaque_tid(), wave = __builtin_amdgcn_readfirstlane(tid >> 6), lane = tid & 63;
    LAS float* lg = (LAS float*)lds + (wave & 3) * (16 * 48);
    LAS float* part = (LAS float*)lds + 4 * 16 * 48 + (wave & 3) * (64 * 13);
    LAS float* rsl = (LAS float*)lds + 4 * 16 * 48 + 4 * 64 * 13 + (wave & 3) * 16;
    for (int tg = blockIdx.x; tg < T_TOK / 64; tg += gridDim.x) {
        const int tile = tg * 4 + (wave & 3), kh = wave >> 2;
        const int row0 = tile * 16, b = row0 / SEQ, r = lane & 15, q = lane >> 4;
        const bf16_t* xa = p.XA + (size_t)(row0 + r) * DM + 4 * q + kh * (DM / 2);
        const float* wt = p.wrt + (((size_t)l * 4 + b) * 48 + r) * DM + 4 * q + kh * (DM / 2);
        f32x4 acc[3] = {{0.f, 0.f, 0.f, 0.f}, {0.f, 0.f, 0.f, 0.f}, {0.f, 0.f, 0.f, 0.f}}; float ss = 0.f;
#pragma unroll 2
        for (int s = 0; s < DM / 32; ++s) {
            const uint2 ar = *(const uint2*)(xa + 16 * s); const f32x4 a4 = {bflo(ar.x), bfhi(ar.x), bflo(ar.y), bfhi(ar.y)};
            ss += a4[0] * a4[0] + a4[1] * a4[1] + a4[2] * a4[2] + a4[3] * a4[3];
#pragma unroll
            for (int n = 0; n < 3; ++n) { const f32x4 b4 = *(const f32x4*)(wt + (size_t)n * 16 * DM + 16 * s);
#pragma unroll
                for (int j = 0; j < 4; ++j) acc[n] = __builtin_amdgcn_mfma_f32_16x16x4f32(a4[j], b4[j], acc[n], 0, 0, 0); }
        }
        if (kh == 1) {
#pragma unroll
            for (int n = 0; n < 3; ++n)
#pragma unroll
                for (int j = 0; j < 4; ++j) part[(n * 4 + j) * 64 + lane] = acc[n][j];
            part[12 * 64 + lane] = ss; }
        __syncthreads();
        if (kh == 0) {
#pragma unroll
            for (int n = 0; n < 3; ++n)
#pragma unroll
                for (int j = 0; j < 4; ++j) acc[n][j] += part[(n * 4 + j) * 64 + lane];
            ss += part[12 * 64 + lane];
        ss += __shfl_xor(ss, 16); ss += __shfl_xor(ss, 32);
        const float rstd = rsqrtf(ss * (1.0f / DM) + 1e-6f);
        if (NORM && q == 0) rsl[r] = rstd;
#pragma unroll
        for (int j = 0; j < 4; ++j) { const float rs = __shfl(rstd, 4 * q + j);
#pragma unroll
            for (int n = 0; n < 3; ++n) lg[(4 * q + j) * 48 + n * 16 + r] = acc[n][j] * rs + p.rbias[(l * 4 + b) * 48 + n * 16 + r]; }
        __builtin_amdgcn_wave_barrier();
        if (!DRY && lane < 16) {
            const LAS float* L = lg + lane * 48; const int tok = row0 + lane;
            int gs = 0; float gm = L[32];
#pragma unroll
            for (int g = 1; g < 4; ++g) if (L[32 + g] > gm) { gm = L[32 + g]; gs = g; }
            float gden = 0.f;
#pragma unroll
            for (int g = 0; g < 4; ++g) gden += __expf(L[32 + g] - gm);
            const float gprob = 1.0f / gden;
            int i0 = 0; float v0 = L[gs * 8];
            for (int j = 1; j < 8; ++j) { const float x = L[gs * 8 + j]; if (x > v0) { v0 = x; i0 = j; } }
            int i1 = -1; float v1 = -3.4e38f;
            for (int j = 0; j < 8; ++j) { const float x = L[gs * 8 + j]; if (j != i0 && x > v1) { v1 = x; i1 = j; } }
            const float e1 = __expf(v1 - v0), g0 = gprob / (1.f + e1), g1 = gprob * e1 / (1.f + e1);
            const int ea = gs * 8 + i0, eb = gs * 8 + i1;
            const int sa = atomicAdd(&p.cnt[l * 32 + ea], 1), sb = atomicAdd(&p.cnt[l * 32 + eb], 1);
            p.tokl[ea * ECAP + sa] = tok; p.gatel[ea * ECAP + sa] = g0; p.tokl[eb * ECAP + sb] = tok; p.gatel[eb * ECAP + sb] = g1;
            p.asg[tok * 2] = (ea << 14) | sa; p.asg[tok * 2 + 1] = (eb << 14) | sb;
        }
        }
        __syncthreads();
        if constexpr (NORM) {
            const float* md = p.mod + (lmod * 4 + b) * 6144;
            f32x4 g4[8], sc[8], sh[8];
#pragma unroll
            for (int i = 0; i < 8; ++i) { const int col = i * 256 + lane * 4; g4[i] = *(const f32x4*)(gain + col); sc[i] = 1.f + *(const f32x4*)(md + 2048 + col); sh[i] = *(const f32x4*)(md + col); g4[i] *= sc[i]; }
#pragma unroll 2
            for (int j = 0; j < 8; ++j) { const int row = row0 + kh * 8 + j; const float rs = rsl[kh * 8 + j];
#pragma unroll
                for (int i = 0; i < 8; ++i) { const int col = i * 256 + lane * 4; const uint2 ar = *(const uint2*)(p.XA + (size_t)row * DM + col); const f32x4 v = {bflo(ar.x), bfhi(ar.x), bflo(ar.y), bfhi(ar.y)};
                    const f32x4 h = v * rs * g4[i] + sh[i];
                    *(unsigned*)((unsigned char*)p.H + (size_t)row * DM + col) = pk4_fp8(h[0], h[1], h[2], h[3], A8_SCALE); } }
            __syncthreads();
        }
    }
}
DI void conv_gln(const Params& p, LAS unsigned char* lds) {
    const int tid = opaque_tid(), wave = tid >> 6, lane = tid & 63;
    LAS float* at = (LAS float*)lds;
    u32x4 rv[3], rg[3];
    auto load_raw = [&](int u) { const int g = u & 7, t0 = ((u >> 3) & 63) * 64, b = u >> 9;
#pragma unroll
        for (int i = 0; i < 3; ++i) { const int idx = tid + 512 * i, rr = idx >> 4, c8 = idx & 15, t = t0 - 15 + rr; rv[i] = (u32x4){0u, 0u, 0u, 0u}; rg[i] = (u32x4){0u, 0u, 0u, 0u};
            if (idx < 94 * 16 && t >= 0 && t < SEQ) { const bf16_t* row = p.G + (size_t)(b * SEQ + t) * N_IN0 + g * 128 + c8 * 8; rv[i] = *(const u32x4*)row; rg[i] = *(const u32x4*)(row + 1024); } } };
    int gcur = -1; f32x2 wk[31], bias = {0.f, 0.f}, gam = {0.f, 0.f}, bet = {0.f, 0.f};
    if ((int)blockIdx.x < 2048) load_raw(blockIdx.x);
    for (int u = blockIdx.x; u < 2048; u += gridDim.x) {
        const int g = u & 7, t0 = ((u >> 3) & 63) * 64, b = u >> 9;
        const int ch = g * 128 + 2 * lane;
        if (g != gcur) { gcur = g;
#pragma unroll
            for (int k = 0; k < 31; ++k) wk[k] = *(const f32x2*)(p.conv_w + k * 1024 + ch);
            bias = *(const f32x2*)(p.conv_b + ch); gam = *(const f32x2*)(p.conv_norm_g + ch); bet = *(const f32x2*)(p.conv_norm_b + ch); }
#pragma unroll
        for (int i = 0; i < 3; ++i) { const int idx = tid + 512 * i, rr = idx >> 4, c8 = idx & 15;
            if (idx < 94 * 16) { const u32x4 v = rv[i], gg = rg[i];
                const f32x4 lo = {bflo(v[0]) * sigmoidf_(bflo(gg[0])), bfhi(v[0]) * sigmoidf_(bfhi(gg[0])), bflo(v[1]) * sigmoidf_(bflo(gg[1])), bfhi(v[1]) * sigmoidf_(bfhi(gg[1]))};
                const f32x4 hi = {bflo(v[2]) * sigmoidf_(bflo(gg[2])), bfhi(v[2]) * sigmoidf_(bfhi(gg[2])), bflo(v[3]) * sigmoidf_(bflo(gg[3])), bfhi(v[3]) * sigmoidf_(bfhi(gg[3]))};
                *(LAS f32x4*)(at + rr * 132 + c8 * 8) = lo; *(LAS f32x4*)(at + rr * 132 + c8 * 8 + 4) = hi; } }
        __syncthreads();
        if (u + (int)gridDim.x < 2048) load_raw(u + gridDim.x);
        f32x2 acc[8];
#pragma unroll
        for (int j = 0; j < 8; ++j) acc[j] = bias;
#pragma unroll
        for (int rr = 0; rr < 38; ++rr) { const f32x2 a2 = *(const LAS f32x2*)(at + (wave * 8 + rr) * 132 + 2 * lane);
#pragma unroll
            for (int j = 0; j < 8; ++j) { const int k = rr - j; if (k >= 0 && k < 31) acc[j] += wk[k] * a2; } }
#pragma unroll
        for (int j = 0; j < 8; ++j) { const float mu = wave_sum(acc[j][0] + acc[j][1]) * (1.f / 128.f); const float d0 = acc[j][0] - mu, d1 = acc[j][1] - mu;
            const float var = wave_sum(d0 * d0 + d1 * d1) * (1.f / 128.f); const float rs = rsqrtf(var + 1e-6f);
            const float y0 = d0 * rs * gam[0] + bet[0], y1 = d1 * rs * gam[1] + bet[1];
            if constexpr (D8_OUT0) *(unsigned short*)((unsigned char*)p.AO + (size_t)(b * SEQ + t0 + wave * 8 + j) * DM + ch) = (unsigned short)(pk4_fp8(siluf_(y0), siluf_(y1), 0.f, 0.f, A8_SCALE) & 0xffffu);
            else *(unsigned*)(p.AO + (size_t)(b * SEQ + t0 + wave * 8 + j) * DM + ch) = pk2(siluf_(y0), siluf_(y1)); }
        __syncthreads();
    }
}
DI unsigned off_b(unsigned row, unsigned ch) { return 256u * row + 16u * (ch ^ (((row & 3u) << 2) | ((row >> 2) & 3u))); }
DI void tr_read4(unsigned a0, unsigned a1, s16x4& r00, s16x4& r01, s16x4& r10, s16x4& r11) {
    asm volatile("ds_read_b64_tr_b16 %0, %4\n\tds_read_b64_tr_b16 %1, %5\n\tds_read_b64_tr_b16 %2, %4 offset:4096\n\tds_read_b64_tr_b16 %3, %5 offset:4096\n\ts_waitcnt lgkmcnt(0)"
                 : "=&v"(r00), "=&v"(r01), "=&v"(r10), "=&v"(r11) : "v"(a0), "v"(a1) : "memory");
}
template <int PASS> DI void attn_wave(const Params& p, LAS unsigned char* vimg, unsigned vb0, unsigned vb1, int lane_, int b, int h, int qbase  ) {
    int lane = lane_; asm volatile("" : "+v"(lane));
    const int c = lane & 31, hh = lane >> 5, srow = lane >> 4, sch = lane & 15;
    constexpr int QS = PASS == 0 ? 16 : 1, NT = PASS == 0 ? 13 : 5;
    const int tq = qbase + QS * c;
    const bf16_t* gb = p.G + (size_t)(b * SEQ) * N_IN0; const bf16_t* kb = p.KVH + (size_t)((b * 8 + h) * 2) * SEQ * 128;
    bf16_t* st_o = p.YB + ((size_t)(b * 8 + h) * SEQ + tq) * 128;
    float* st_ml = (float*)(p.YB + (size_t)NBATCH * 8 * SEQ * 128) + ((size_t)(b * 8 + h) * SEQ + tq) * 2;
    bf16x8 qf[8];
#pragma unroll
    for (int ks = 0; ks < 8; ++ks) qf[ks] = *(const bf16x8*)(gb + (size_t)tq * N_IN0 + 2048 + h * 128 + 16 * ks + 8 * hh);
    const float sc2 = 0.08838834764831845f * 1.4426950408889634f, sl2 = exp2f(-(float)(h + 1)) * 1.4426950408889634f;
    f32x16 o[4]; float m_run, l_run;
    if constexpr (PASS == 0) {
#pragma unroll
        for (int i = 0; i < 4; ++i)
#pragma unroll
            for (int j = 0; j < 16; ++j) o[i][j] = 0.f;
        m_run = -30000.f; l_run = 0.f;
    } else {
#pragma unroll
        for (int c4 = 0; c4 < 4; ++c4)
#pragma unroll
            for (int g4 = 0; g4 < 4; ++g4) { const uint2 v = *(const uint2*)(st_o + 32 * c4 + 8 * g4 + 4 * hh); o[c4][4 * g4] = bflo(v.x); o[c4][4 * g4 + 1] = bfhi(v.x); o[c4][4 * g4 + 2] = bflo(v.y); o[c4][4 * g4 + 3] = bfhi(v.y); }
        const f32x2 ml = *(const f32x2*)st_ml; m_run = ml[0]; l_run = hh == 0 ? ml[1] : 0.f;
    }
    auto tile_geom = [&](int tile, int& d, int& sb) { if constexpr (PASS == 0) { if (tile < 5) { d = 16; sb = qbase - 1024 + 512 * tile; } else { d = 4; sb = qbase - 256 + 128 * (tile - 5); } } else { d = 1; sb = qbase - 64 + 32 * tile; } };
    auto load_k = [&](int tile, bf16x8 (&kf)[8]) { int d, sb; tile_geom(tile, d, sb); int sp = sb + d * c; sp = sp < 0 ? 0 : (sp >= SEQ ? SEQ - 1 : sp);
        const bf16_t* src = kb + (unsigned)(sp * 128 + 8 * hh);
#pragma unroll
        for (int ks = 0; ks < 8; ++ks) kf[ks] = *(const bf16x8*)(src + 16 * ks); };
    auto load_v = [&](int tile, u32x4 (&vv)[8]) { int d, sb; tile_geom(tile, d, sb);
#pragma unroll
        for (int i = 0; i < 8; ++i) { int sp = sb + d * (srow + 4 * i); sp = sp < 0 ? 0 : (sp >= SEQ ? SEQ - 1 : sp); vv[i] = *(const u32x4*)(kb + (unsigned)(SEQ * 128 + sp * 128 + sch * 8)); } };
    bf16x8 kf[8]; u32x4 vv[8];
    load_k(0, kf); load_v(0, vv);
    for (int tile = 0; tile < NT; ++tile) {
        int d, sb; tile_geom(tile, d, sb);
        const int tn = tile < NT - 1 ? tile + 1 : NT - 1;
#pragma unroll
        for (int i = 0; i < 8; ++i) *(LAS u32x4*)(vimg + off_b(srow + 4 * i, sch)) = vv[i];
        load_v(tn, vv);
        f32x16 sacc;
#pragma unroll
        for (int j = 0; j < 16; ++j) sacc[j] = 0.f;
#pragma unroll
        for (int ks = 0; ks < 8; ++ks) sacc = __builtin_amdgcn_mfma_f32_32x32x16_bf16(kf[ks], qf[ks], sacc, 0, 0, 0);
        load_k(tn, kf);
        const float df = (float)d, basef = (float)(sb - tq) + df * (float)(4 * hh);
        const float lo = fmaxf(-64.f * df, -(float)tq), hi = fminf(64.f * df, (float)(SEQ - 1 - tq));
        const float mid = 0.5f * (lo + hi), half = 0.5f * (hi - lo);
        float tmax = -1e30f;
#pragma unroll
        for (int i = 0; i < 16; ++i) { const float deltaf = basef + df * (float)((i & 3) + 8 * (i >> 2));
            const bool valid = __builtin_fabsf(deltaf - mid) <= half;
            const float sv = valid ? sacc[i] * sc2 - sl2 * __builtin_fabsf(deltaf) : -1e30f; sacc[i] = sv; tmax = fmaxf(tmax, sv); }
        tmax = fmaxf(tmax, __shfl_xor(tmax, 32));
        const float m_new = tmax > m_run + 8.0f ? tmax : m_run;
        if (__any(m_new != m_run)) { const float alpha = __builtin_amdgcn_exp2f(m_run - m_new);
            l_run *= alpha;
#pragma unroll
            for (int i = 0; i < 4; ++i) o[i] *= alpha; }
        m_run = m_new;
        float psum = 0.f;
#pragma unroll
        for (int i = 0; i < 16; ++i) { const float pi = __builtin_amdgcn_exp2f(sacc[i] - m_new); psum += pi; sacc[i] = pi; }
        l_run += psum;
        bf16x8 pf[2];
#pragma unroll
        for (int s = 0; s < 2; ++s) { const unsigned w0 = pk2(sacc[8 * s], sacc[8 * s + 1]), w1 = pk2(sacc[8 * s + 2], sacc[8 * s + 3]), w2 = pk2(sacc[8 * s + 4], sacc[8 * s + 5]), w3 = pk2(sacc[8 * s + 6], sacc[8 * s + 7]);
            pf[s] = __builtin_bit_cast(bf16x8, (u32x4){w0, w1, w2, w3}); }
#pragma unroll
        for (int c4 = 0; c4 < 4; ++c4) {
            s16x4 r00, r01, r10, r11; tr_read4(vb0 ^ (unsigned)(c4 << 6), vb1 ^ (unsigned)(c4 << 6), r00, r01, r10, r11);
            const bf16x8 v0 = __builtin_shufflevector(r00, r01, 0, 1, 2, 3, 4, 5, 6, 7), v1 = __builtin_shufflevector(r10, r11, 0, 1, 2, 3, 4, 5, 6, 7);
            o[c4] = __builtin_amdgcn_mfma_f32_32x32x16_bf16(v0, pf[0], o[c4], 0, 0, 0);
            o[c4] = __builtin_amdgcn_mfma_f32_32x32x16_bf16(v1, pf[1], o[c4], 0, 0, 0); }
    }
    const float ltot = l_run + __shfl_xor(l_run, 32);
    if constexpr (PASS == 0) {
#pragma unroll
        for (int c4 = 0; c4 < 4; ++c4)
#pragma unroll
            for (int g4 = 0; g4 < 4; ++g4) *(uint2*)(st_o + 32 * c4 + 8 * g4 + 4 * hh) = make_uint2(pk2(o[c4][4 * g4], o[c4][4 * g4 + 1]), pk2(o[c4][4 * g4 + 2], o[c4][4 * g4 + 3]));
        if (hh == 0) *(f32x2*)st_ml = (f32x2){m_run, ltot};
    } else {
        const float inv = 1.0f / ltot;
        bf16_t* orow = p.AO + (size_t)(b * SEQ + tq) * DM + 1024 + h * 128;
#pragma unroll
        for (int c4 = 0; c4 < 4; ++c4)
#pragma unroll
            for (int g4 = 0; g4 < 4; ++g4) { const int dh = 32 * c4 + 8 * g4 + 4 * hh;
                if constexpr (D8_OUT0) *(unsigned*)((unsigned char*)p.AO + (size_t)(b * SEQ + tq) * DM + 1024 + h * 128 + dh) = pk4_fp8(o[c4][4 * g4] * inv, o[c4][4 * g4 + 1] * inv, o[c4][4 * g4 + 2] * inv, o[c4][4 * g4 + 3] * inv, A8_SCALE);
                else *(uint2*)(orow + dh) = make_uint2(pk2(o[c4][4 * g4] * inv, o[c4][4 * g4 + 1] * inv), pk2(o[c4][4 * g4 + 2] * inv, o[c4][4 * g4 + 3] * inv)); }
    }
}
DI void attention(const Params& p, LAS unsigned char* lds) {
    const int tid = opaque_tid(), wave = __builtin_amdgcn_readfirstlane(tid >> 6), lane = tid & 63, hh = lane >> 5;
    LAS unsigned char* vimg = lds + wave * 8192;
    const unsigned vbase = (unsigned)(uintptr_t)vimg;
    const int q4 = (lane & 15) >> 2, pp = lane & 3, blk = (lane >> 4) & 1;
    const unsigned vb0 = vbase + 256u * (4 * hh + q4) + 16u * ((2 * blk + (pp >> 1)) ^ (hh & 3)) + 8u * (pp & 1) + ((unsigned)q4 << 6);
    const unsigned vb1 = vbase + 256u * (8 + 4 * hh + q4) + 16u * ((2 * blk + (pp >> 1)) ^ ((2 + hh) & 3)) + 8u * (pp & 1) + ((unsigned)q4 << 6);
    for (int u = blockIdx.x; u < 256; u += gridDim.x) {
        const int bh = (u & 7) * 4 + ((u >> 3) >> 3), span = (u >> 3) & 7, h = bh & 7, b = bh >> 3;
#pragma unroll 1
        for (int j = 0; j < 2; ++j) attn_wave<0>(p, vimg, vb0, vb1, lane, b, h, span * 512 + wave * 2 + j);
        asm volatile("s_waitcnt vmcnt(0)" ::: "memory");
        __syncthreads();
#pragma unroll 1
        for (int j = 0; j < 2; ++j) attn_wave<1>(p, vimg, vb0, vb1, lane, b, h, span * 512 + (wave * 2 + j) * 32);
        __syncthreads();
    }
}
DI float om_exp2x(float la, float a) {
    const float x = 2.f * la;
    const float pl = x * (1.f + x * (0.5f + x * (0.16666667f + x * (0.041666668f + x * 0.008333334f))));
    return x > -0.25f ? -pl : 1.f - a * a;
}
DI void lru_conv(const Params& p) {
    const int tid = opaque_tid();
    if (tid < 336) {
        const int ch = tid * 8;
        float cw[4][8], cb[8];
#pragma unroll
        for (int j = 0; j < 4; ++j) { const f32x4 w0 = *(const f32x4*)(p.lru_conv_w + j * LRU_W + ch), w1 = *(const f32x4*)(p.lru_conv_w + j * LRU_W + ch + 4);
            cw[j][0] = w0[0]; cw[j][1] = w0[1]; cw[j][2] = w0[2]; cw[j][3] = w0[3]; cw[j][4] = w1[0]; cw[j][5] = w1[1]; cw[j][6] = w1[2]; cw[j][7] = w1[3]; }
        { const f32x4 b0 = *(const f32x4*)(p.lru_conv_b + ch), b1 = *(const f32x4*)(p.lru_conv_b + ch + 4); cb[0] = b0[0]; cb[1] = b0[1]; cb[2] = b0[2]; cb[3] = b0[3]; cb[4] = b1[0]; cb[5] = b1[1]; cb[6] = b1[2]; cb[7] = b1[3]; }
        for (int run = blockIdx.x; run < T_TOK / 32; run += gridDim.x) {
            const int tok0 = run * 32, t0 = tok0 % SEQ;
            const bf16_t* src = p.G + (size_t)tok0 * N_IN1 + LRU_W + ch;
            u32x4 rows[35];
#pragma unroll
            for (int i = 0; i < 35; ++i) { const int t = t0 - 2 + i; rows[i] = (t >= 0 && t < SEQ) ? *(const u32x4*)(src + (ptrdiff_t)(i - 2) * N_IN1) : (u32x4){0u, 0u, 0u, 0u}; }
#pragma unroll
            for (int i = 0; i < 32; ++i) { float xc[8];
#pragma unroll
                for (int e = 0; e < 8; ++e) xc[e] = cb[e];
#pragma unroll
                for (int j = 0; j < 4; ++j) { const u32x4 xv = rows[i + j];
                    xc[0] += cw[j][0] * bflo(xv[0]); xc[1] += cw[j][1] * bfhi(xv[0]); xc[2] += cw[j][2] * bflo(xv[1]); xc[3] += cw[j][3] * bfhi(xv[1]);
                    xc[4] += cw[j][4] * bflo(xv[2]); xc[5] += cw[j][5] * bfhi(xv[2]); xc[6] += cw[j][6] * bflo(xv[3]); xc[7] += cw[j][7] * bfhi(xv[3]); }
                *(u32x4*)(p.XC + (size_t)(tok0 + i) * LRU_W + ch) = (u32x4){pk2(xc[0], xc[1]), pk2(xc[2], xc[3]), pk2(xc[4], xc[5]), pk2(xc[6], xc[7])}; }
        }
    }
}
DI void lru(const Params& p, LAS unsigned char* lds) {
    const int tid = opaque_tid(), wave = __builtin_amdgcn_readfirstlane(tid >> 6), lane = tid & 63, col = lane & 15, g = lane >> 4;
    LAS unsigned char* wl = lds;
    LAS unsigned char* xs = lds + 36864;
    LAS float* sums = (LAS float*)(lds + 36864 + 86016);
    LAS float* cst = sums + 1536;
    for (int u = blockIdx.x; u < 256; u += gridDim.x) {
        const int b = u >> 6, n = (u >> 2) & 15, qt = u & 3, chq = n * LRU_BW + qt * 42;
        const char* xcb = (const char*)(p.XC + (size_t)(b * SEQ) * LRU_W + n * LRU_BW);
        const bf16_t* gb = p.G + (size_t)(b * SEQ) * N_IN1;
        unsigned poff[6];
#pragma unroll
        for (int i = 0; i < 6; ++i) { const int idx = tid + 512 * i; poff[i] = (unsigned)((idx / 21) * LRU_W + (idx % 21) * 8) * 2u; }
        auto dma_chunk = [&](int chunk, int bsel) { const char* src = xcb + (size_t)chunk * 128 * LRU_W * 2; LAS unsigned char* dst = xs + bsel * 43008 + wave * 1024;
#pragma unroll
            for (int i = 0; i < 5; ++i) __builtin_amdgcn_global_load_lds((const unsigned*)(src + poff[i]), (LAS unsigned*)(dst + i * 8192), 16, 0, 0);
            if (wave < 2) __builtin_amdgcn_global_load_lds((const unsigned*)(src + poff[5]), (LAS unsigned*)(dst + 5 * 8192), 16, 0, 0); };
        for (int dir = 0; dir < 2; ++dir) {
            __syncthreads();
            for (int i = tid; i < 2 * 48 * 24; i += 512) { const int which = i / (48 * 24), r = (i / 24) % 48, ck = i % 24; const int nt = r >> 4, cl = r & 15, ks = ck >> 2, gg = ck & 3;
                *(LAS u32x4*)(wl + ((which * 3 + nt) * 6 + ks) * 1024 + (gg * 16 + cl) * 16) = *(const u32x4*)(p.w_lru + ((((size_t)(dir * 2 + which) * 16 + n) * 4 + qt) * 48 + r) * 192 + ck * 8); }
            if (tid < 48) { const bool valid = tid < 42; const int ch = dir * LRU_W + chq + tid;
                cst[tid] = valid ? -1.44269504f * p.lru_b_a[ch] : 0.f; cst[48 + tid] = valid ? -1.44269504f * p.lru_b_x[ch] : 0.f;
                const float lam = valid ? p.lru_lambda[ch] : 0.f; const float sp = (-lam > 20.f) ? -lam : log1pf(__expf(-lam)); cst[96 + tid] = -8.0f * 1.44269504f * sp; }
            dma_chunk(dir == 0 ? 0 : 31, 0);
            asm volatile("s_waitcnt vmcnt(0)" ::: "memory");
            __syncthreads();
            float cba[3], cbx[3], cex[3];
#pragma unroll
            for (int nt = 0; nt < 3; ++nt) { cba[nt] = cst[nt * 16 + col]; cbx[nt] = cst[48 + nt * 16 + col]; cex[nt] = cst[96 + nt * 16 + col]; }
            float carry[3] = {0.f, 0.f, 0.f};
            for (int step = 0; step < 32; ++step) {
                const int c = dir == 0 ? step : 31 - step, c0 = c * 128, par = step & 1;
                const bool has_next = step < 31;
                if (has_next) dma_chunk(dir == 0 ? c + 1 : c - 1, par ^ 1);
                LAS unsigned char* xb = xs + par * 43008;
                uint2 hfv[3] = {make_uint2(0u, 0u), make_uint2(0u, 0u), make_uint2(0u, 0u)}; unsigned short gtv[3][4];
                const uint2* hfp = (const uint2*)p.HF + ((size_t)((u * 32 + c) * 8 + wave) * 3) * 64 + lane;
                const bf16_t* gbw = gb + (size_t)(c0 + wave * 16) * N_IN1 + chq;
                bf16_t* aow = p.AO + (size_t)(b * SEQ + c0 + wave * 16) * LRU_W + chq;
                if (dir == 1) {
#pragma unroll
                    for (int nt = 0; nt < 3; ++nt) { hfv[nt] = hfp[nt * 64];
#pragma unroll
                        for (int r = 0; r < 4; ++r) gtv[nt][r] = (nt * 16 + col < 42) ? gbw[(unsigned)((4 * g + r) * N_IN1 + nt * 16 + col)] : (unsigned short)0; } }
                bf16x8 af[6];
#pragma unroll
                for (int ks = 0; ks < 6; ++ks) { const int ch0 = 32 * ks + 8 * g; const bool kval = ch0 < LRU_BW; const int chl0 = kval ? ch0 : 160;
                    const u32x4 xv = *(const LAS u32x4*)(xb + (wave * 16 + col) * 336 + chl0 * 2);
                    af[ks] = __builtin_bit_cast(bf16x8, kval ? xv : (u32x4){0u, 0u, 0u, 0u}); }
                f32x4 acc[2][3];
#pragma unroll
                for (int w2 = 0; w2 < 2; ++w2)
#pragma unroll
                    for (int nt = 0; nt < 3; ++nt) { acc[w2][nt] = (f32x4){0.f, 0.f, 0.f, 0.f};
#pragma unroll
                        for (int ks = 0; ks < 6; ++ks) { const bf16x8 bfr = *(const LAS bf16x8*)(wl + ((w2 * 3 + nt) * 6 + ks) * 1024 + lane * 16);
                            acc[w2][nt] = __builtin_amdgcn_mfma_f32_16x16x32_bf16(af[ks], bfr, acc[w2][nt], 0, 0, 0); } }
                float hl[3][4], Pl[3][4];
#pragma unroll
                for (int nt = 0; nt < 3; ++nt) { const int chl = nt * 16 + col;
                    float av[4], uv[4];
#pragma unroll
                    for (int r = 0; r < 4; ++r) {
                        const float rg = __builtin_amdgcn_rcpf(1.0f + __builtin_amdgcn_exp2f(__builtin_fmaf(acc[0][nt][r], -1.44269504f, cba[nt])));
                        const float ig = __builtin_amdgcn_rcpf(1.0f + __builtin_amdgcn_exp2f(__builtin_fmaf(acc[1][nt][r], -1.44269504f, cbx[nt])));
                        const float a = __builtin_amdgcn_exp2f(cex[nt] * rg);
                        const float xcv = bf2f(*(const LAS bf16_t*)(xb + (wave * 16 + 4 * g + r) * 336 + (qt * 42 + chl) * 2));
                        av[r] = a; uv[r] = __builtin_amdgcn_sqrtf(__builtin_fmaf(-a, a, 1.0f)) * (ig * xcv); }
                    float h[4], P[4], A, H;
                    if (dir == 0) { h[0] = uv[0]; P[0] = av[0];
#pragma unroll
                        for (int r = 1; r < 4; ++r) { h[r] = av[r] * h[r - 1] + uv[r]; P[r] = av[r] * P[r - 1]; }
                        A = P[3]; H = h[3];
                        { const float A1 = __shfl_up(A, 16), H1 = __shfl_up(H, 16); if (g >= 1) { H = A * H1 + H; A = A * A1; } }
                        { const float A2 = __shfl_up(A, 32), H2 = __shfl_up(H, 32); if (g >= 2) { H = A * H2 + H; A = A * A2; } }
                        float Ae = __shfl_up(A, 16), He = __shfl_up(H, 16); if (g == 0) { Ae = 1.f; He = 0.f; }
                        const float At = __shfl(A, 48 + col), Ht = __shfl(H, 48 + col);
#pragma unroll
                        for (int r = 0; r < 4; ++r) { hl[nt][r] = h[r] + P[r] * He; Pl[nt][r] = P[r] * Ae; }
                        if (g == 3) *(LAS f32x2*)(sums + ((par * 8 + wave) * 48 + chl) * 2) = (f32x2){At, Ht};
                    } else { h[3] = uv[3]; P[3] = av[3];
#pragma unroll
                        for (int r = 2; r >= 0; --r) { h[r] = av[r] * h[r + 1] + uv[r]; P[r] = av[r] * P[r + 1]; }
                        A = P[0]; H = h[0];
                        { const float A1 = __shfl_down(A, 16), H1 = __shfl_down(H, 16); if (g <= 2) { H = A * H1 + H; A = A * A1; } }
                        { const float A2 = __shfl_down(A, 32), H2 = __shfl_down(H, 32); if (g <= 1) { H = A * H2 + H; A = A * A2; } }
                        float Ae = __shfl_down(A, 16), He = __shfl_down(H, 16); if (g == 3) { Ae = 1.f; He = 0.f; }
                        const float At = __shfl(A, col), Ht = __shfl(H, col);
#pragma unroll
                        for (int r = 0; r < 4; ++r) { hl[nt][r] = h[r] + P[r] * He; Pl[nt][r] = P[r] * Ae; }
                        if (g == 0) *(LAS f32x2*)(sums + ((par * 8 + wave) * 48 + chl) * 2) = (f32x2){At, Ht};
                    }
                }
                asm volatile("s_waitcnt vmcnt(0)" ::: "memory");
                __syncthreads();
#pragma unroll
                for (int nt = 0; nt < 3; ++nt) { const int chl = nt * 16 + col; float C = carry[nt], Cw = 0.f;
#pragma unroll
                    for (int k = 0; k < 8; ++k) { const int w2 = dir == 0 ? k : 7 - k; const f32x2 sv = *(const LAS f32x2*)(sums + ((par * 8 + w2) * 48 + chl) * 2);
                        if (w2 == wave) Cw = C; C = sv[0] * C + sv[1]; }
                    carry[nt] = C;
                    float hv[4];
#pragma unroll
                    for (int r = 0; r < 4; ++r) hv[r] = hl[nt][r] + Pl[nt][r] * Cw;
                    if (dir == 0) ((uint2*)p.HF)[((size_t)((u * 32 + c) * 8 + wave) * 3 + nt) * 64 + lane] = make_uint2(pk2(hv[0], hv[1]), pk2(hv[2], hv[3]));
                    else if (chl < 42) { const float ff[4] = {bflo(hfv[nt].x), bfhi(hfv[nt].x), bflo(hfv[nt].y), bfhi(hfv[nt].y)};
#pragma unroll
                        for (int r = 0; r < 4; ++r) aow[(unsigned)((4 * g + r) * LRU_W + chl)] = f2bf(bf2f(gtv[nt][r]) * (ff[r] + hv[r])); }
                }
            }
        }
    }
}
}

#define XB_TMO      128
#define XB_XCNT(j)  (256  + 64 * (j))
#define XB_XSUB(j)  (1280 + 64 * (j))
#define XB_XGEN(j)  (2304 + 64 * (j))
#define XB_TOP      3328
#define XB_TOPGEN   3392
#define XCD_BAR_WORDS 3456
#define XB_SPIN_CAP (1u << 18)

__device__ __forceinline__ unsigned xb_ld(unsigned* p)              { return __hip_atomic_load(p, __ATOMIC_RELAXED, __HIP_MEMORY_SCOPE_AGENT); }
__device__ __forceinline__ unsigned xb_add(unsigned* p, unsigned v) { return __hip_atomic_fetch_add(p, v, __ATOMIC_RELAXED, __HIP_MEMORY_SCOPE_AGENT); }
__device__ __forceinline__ unsigned xb_xcc_id() { return (unsigned)__builtin_amdgcn_s_getreg((3 << 11) | 20) & 0xFu; }
#define XB_SPIN(cond, bar) do { unsigned _sp = 0; while (cond) { __builtin_amdgcn_s_sleep(1); \
    if ((++_sp & 255u) == 0u) { if (xb_ld(&(bar)[XB_TMO])) break; if (_sp > XB_SPIN_CAP) { atomicAdd(&(bar)[XB_TMO], 1u); break; } } } } while (0)

struct XcdBarrier {
    unsigned* bar; unsigned x;
    volatile LAS unsigned* st;
};

__device__ __forceinline__ XcdBarrier xcd_barrier_post(unsigned* bar, volatile LAS unsigned* st) {
    XcdBarrier b; b.bar = bar; b.x = xb_xcc_id(); b.st = st;
    if (threadIdx.x == 0) (void)xb_add(&bar[XB_XCNT(b.x)], 1u);
    return b;
}
__device__ __forceinline__ void xcd_barrier_complete(unsigned* bar, unsigned x, unsigned& nloc, unsigned& nx) {
    const unsigned G = gridDim.x * gridDim.y * gridDim.z;
    unsigned sum, cnt, mine, sp = 0u;
    for (;;) {
        sum = 0u; cnt = 0u; mine = 0u;
#pragma unroll
        for (unsigned j = 0; j < 16; ++j) { const unsigned c = xb_ld(&bar[XB_XCNT(j)]); sum += c; cnt += (c > 0u) ? 1u : 0u; mine = (j == x) ? c : mine; }
        if (sum == G) break;
        __builtin_amdgcn_s_sleep(1);
        if ((++sp & 255u) == 0u) { if (xb_ld(&bar[XB_TMO])) break; if (sp > XB_SPIN_CAP) { atomicAdd(&bar[XB_TMO], 1u); break; } }
    }
    nloc = mine > 0u ? mine : 1u; nx = cnt > 0u ? cnt : 1u;
}

__device__ __forceinline__ void xcd_barrier(const XcdBarrier& b) {
    asm volatile("s_waitcnt vmcnt(0)" ::: "memory");
    __syncthreads();
    if (threadIdx.x == 0) {
        unsigned* bar = b.bar;
        __builtin_amdgcn_s_waitcnt(0);
        unsigned nloc = b.st[0], nx = b.st[1];
        if (nloc == 0u) { xcd_barrier_complete(bar, b.x, nloc, nx); b.st[0] = nloc; b.st[1] = nx; }
        const unsigned old = xb_add(&bar[XB_XSUB(b.x)], 1u);
        const unsigned gen = old / nloc;
        if (old + 1u == (gen + 1u) * nloc) {
            __builtin_amdgcn_fence(__ATOMIC_RELEASE, "agent");
            asm volatile("s_waitcnt vmcnt(0)" ::: "memory");
            const unsigned og = xb_add(&bar[XB_TOP], 1u);
            const unsigned tg = og / nx;
            if (og + 1u == (tg + 1u) * nx) xb_add(&bar[XB_TOPGEN], 1u);
            else XB_SPIN(xb_ld(&bar[XB_TOPGEN]) == tg, bar);
            __builtin_amdgcn_fence(__ATOMIC_ACQUIRE, "agent");
            xb_add(&bar[XB_XGEN(b.x)], 1u);
            asm volatile("s_waitcnt vmcnt(0)" ::: "memory");
        } else {
            XB_SPIN(xb_ld(&bar[XB_XGEN(b.x)]) == gen, bar);
            __builtin_amdgcn_fence(__ATOMIC_ACQUIRE, "agent");
            asm volatile("s_waitcnt vmcnt(0)" ::: "memory");
        }
    }
    __syncthreads();
}


constexpr int PROBE = 0;
constexpr int LDS_XB_OFF = gm::STAGE_BYTES + 1024;
constexpr int LDS_TOTAL = LDS_XB_OFF + 16;
__global__ void __launch_bounds__(512, 2) mega(Params p) {
    LAS unsigned char* lds = (LAS unsigned char*)dyn_smem;
    LAS int* tab = (LAS int*)(lds + gm::TAB_OFF);
    volatile LAS unsigned* xbw = (volatile LAS unsigned*)(lds + LDS_XB_OFF);
    if (threadIdx.x == 0) { xbw[0] = 0u; xbw[1] = 0u; xbw[2] = 0u; xbw[3] = 0u; }
    __syncthreads();
    XcdBarrier bar = xcd_barrier_post(p.bar, xbw);
    ph::mods(p, lds);
    if constexpr (PROBE == 14) { ph::mods(p, lds); ph::mods(p, lds); }
    xcd_barrier(bar);
    { const int c = blockIdx.x, G = gridDim.x;
      ph::transposer(p, lds, c, c < 320 ? (320 - c + G - 1) / G : 0, G); __syncthreads();
      ph::transposer(p, lds, 320 + c, c < 632 ? (632 - c + G - 1) / G : 0, G); __syncthreads(); }
    ph::lru_weights(p);
    ph::fold_router(p);
    ph::norm_rows<0, D8_IN0>(p, p.x, p.norm0_mix, 0, 0, nullptr);
    xcd_barrier(bar);
    { const int c = blockIdx.x, G = gridDim.x; const int tcount = c < 6144 ? (6144 - c + G - 1) / G : 0; const bool t_first = ((c >> 3) & 1) != 0;
      if (t_first) { ph::transposer(p, lds, 952 + c, tcount, G); __syncthreads(); }
      { gm::DenseSched S; S.init(T_TOK, N_IN0); EpiIn0 e; e.xin = nullptr; e.lgate = 0; if constexpr (D8_IN0) gm::gemm_phase<EpiIn0, gm::DenseSched, true>(lds, p, p.H, p.w_in0t, 0, DM / 2, S, e, W8_E8M0, A8_E8M0); else gm::gemm_phase(lds, p, p.H, p.w_in0t, 0, DM, S, e); }
      if (!t_first) { __syncthreads(); ph::transposer(p, lds, 952 + c, tcount, G); }
      if constexpr (PROBE == 21) { __syncthreads(); ph::transposer(p, lds, 952 + c, tcount, G); }
      if constexpr (PROBE == 24) { __syncthreads(); if (t_first) ph::transposer(p, lds, 952 + c, tcount, G); }
      if constexpr (PROBE == 23) { __syncthreads(); if (t_first) { ph::transposer(p, lds, 952 + c, tcount, G); __syncthreads(); }
        { gm::DenseSched S; S.init(T_TOK, N_IN0); EpiIn0 e; e.xin = nullptr; e.lgate = 0; gm::gemm_phase<EpiIn0, gm::DenseSched, true>(lds, p, p.H, p.w_in0t, 0, DM / 2, S, e, W8_E8M0, A8_E8M0); }
        if (!t_first) { __syncthreads(); ph::transposer(p, lds, 952 + c, tcount, G); } }
      if constexpr (PROBE == 20) { __syncthreads(); gm::DenseSched S; S.init(T_TOK, N_IN0); EpiIn0 e; e.xin = nullptr; e.lgate = 0; gm::gemm_phase<EpiIn0, gm::DenseSched, true>(lds, p, p.H, p.w_in0t, 0, DM / 2, S, e, W8_E8M0, A8_E8M0); } }
    xcd_barrier(bar);
    ph::attention(p, lds);
    if constexpr (PROBE == 4) ph::attention(p, lds);
    __syncthreads();
    ph::conv_gln(p, lds);
    if constexpr (PROBE == 5) ph::conv_gln(p, lds);
    xcd_barrier(bar);
    { gm::DenseSched S; S.init(T_TOK, DM); EpiOut e; e.xin = p.x; e.lgate = 0; if constexpr (D8_OUT0) gm::gemm_phase<EpiOut, gm::DenseSched, true>(lds, p, p.AO, p.w_out0t, 0, DM / 2, S, e, W8_E8M0, A8_E8M0); else gm::gemm_phase(lds, p, p.AO, p.w_out0t, 0, DM, S, e); }
    xcd_barrier(bar);
    ph::router<false, true>(p, 0, lds, p.norm0_ffn, 1);
    if constexpr (PROBE == 12) { ph::router<true>(p, 0, lds); ph::router<true>(p, 0, lds); }
    xcd_barrier(bar);
    if constexpr (PROBE == 11) { xcd_barrier(bar); xcd_barrier(bar); xcd_barrier(bar); xcd_barrier(bar); xcd_barrier(bar); xcd_barrier(bar); xcd_barrier(bar); xcd_barrier(bar); xcd_barrier(bar); xcd_barrier(bar); }
    gm::moe_tables(tab, p.cnt);
    { gm::MoeSched<true> S; S.init(tab); EpiGU e; e.xin = nullptr; e.lgate = 0; gm::gemm_phase<EpiGU, gm::MoeSched<true>, true>(lds, p, p.H, p.w_gut0, (size_t)2048 * (DM / 2), DM / 2, S, e, W8_E8M0, A8_E8M0); if constexpr (PROBE == 3) gm::gemm_phase<EpiGU, gm::MoeSched<true>, true>(lds, p, p.H, p.w_gut0, (size_t)2048 * (DM / 2), DM / 2, S, e, W8_E8M0, A8_E8M0); }
    xcd_barrier(bar);
    { gm::MoeSched<false> S; S.init(tab); EpiDown e; e.xin = nullptr; e.lgate = 0; gm::gemm_phase<EpiDown, gm::MoeSched<false>, true>(lds, p, p.ACT, p.w_dt0, (size_t)DM * (EFF / 2), EFF / 2, S, e, W8_E8M0, A8_E8M0); if constexpr (PROBE == 8) gm::gemm_phase<EpiDown, gm::MoeSched<false>, true>(lds, p, p.ACT, p.w_dt0, (size_t)DM * (EFF / 2), EFF / 2, S, e, W8_E8M0, A8_E8M0); }
    xcd_barrier(bar);
    ph::norm_rows<1, D8_IN1>(p, nullptr, p.norm1_mix, 2, 1, tab);
    xcd_barrier(bar);
    { const int c = blockIdx.x, G = gridDim.x; int tfirst, tcount, tstride;
      if (G == 256) { tstride = 1; if (c < 64) { tcount = 18; tfirst = 18 * c; } else { tcount = 26; tfirst = 1152 + 26 * (c - 64); } }
      else { tstride = G; tfirst = c; tcount = c < 6144 ? (6144 - c + G - 1) / G : 0; }
      const bool t_first = ((c >> 3) & 1) != 0;
      if (t_first) { ph::transposer(p, lds, 7096 + tfirst, tcount, tstride); __syncthreads(); }
      { gm::DenseSched S; S.init(T_TOK, N_IN1); EpiIn1 e; e.xin = nullptr; e.lgate = 0; gm::gemm_phase(lds, p, p.H, p.w_in1t, 0, DM, S, e); }
      if (!t_first) { __syncthreads(); ph::transposer(p, lds, 7096 + tfirst, tcount, tstride); } }
    xcd_barrier(bar);
    ph::lru_conv(p);
    if constexpr (PROBE == 9) { ph::lru_conv(p); ph::lru_conv(p); }
    xcd_barrier(bar);
    ph::lru(p, lds);
    if constexpr (PROBE == 6) ph::lru(p, lds);
    xcd_barrier(bar);
    { gm::DenseSched S; S.init(T_TOK, DM); EpiOut e; e.xin = nullptr; e.lgate = 2; gm::gemm_phase(lds, p, p.AO, p.w_out1t, 0, LRU_W, S, e); }
    xcd_barrier(bar);
    ph::router<false, true>(p, 1, lds, p.norm1_ffn, 3);
    xcd_barrier(bar);
    gm::moe_tables(tab, p.cnt + 32);
    { gm::MoeSched<true> S; S.init(tab); EpiGU e; e.xin = nullptr; e.lgate = 0; gm::gemm_phase<EpiGU, gm::MoeSched<true>, true>(lds, p, p.H, p.w_gut1, (size_t)2048 * (DM / 2), DM / 2, S, e, W8_E8M0, A8_E8M0); }
    xcd_barrier(bar);
    { gm::MoeSched<false> S; S.init(tab); EpiDown e; e.xin = nullptr; e.lgate = 0; gm::gemm_phase<EpiDown, gm::MoeSched<false>, true>(lds, p, p.ACT, p.w_dt1, (size_t)DM * (EFF / 2), EFF / 2, S, e, W8_E8M0, A8_E8M0); }
    xcd_barrier(bar);
    ph::norm_rows<2>(p, nullptr, p.norm_final, 0, 3, tab);
}

static inline size_t al256(size_t x) { return (x + 255) & ~(size_t)255; }

extern "C" void kernel_launch(void* const* d_in, const int* in_sizes, int n_in, void* d_out, int out_size, void* d_ws, size_t ws_size, hipStream_t stream) {
    Params p{};
    const float** ip = (const float**)&p.x;
    for (int i = 0; i < 38; ++i) ip[i] = (const float*)d_in[i];
    p.out = (float*)d_out;
    char* w = (char*)d_ws; size_t off = 0;
    auto take = [&](size_t bytes) { char* r = w + off; off += al256(bytes); return r; };
    p.bar = (unsigned*)take(16384); p.cnt = (int*)take(256);
    const size_t zero_bytes = off;
    p.mod = (float*)take(4 * 4 * 6144 * 4); p.wrt = (float*)take((size_t)2 * 4 * 48 * 2048 * 4); p.rbias = (float*)take(2 * 4 * 48 * 4);
    p.w_in0t = (bf16_t*)take((size_t)N_IN0 * DM * 2); p.w_out0t = (bf16_t*)take((size_t)DM * DM * 2);
    p.w_gut0 = (bf16_t*)take((size_t)NEXP * 2048 * DM); p.w_dt0 = (bf16_t*)take((size_t)NEXP * DM * EFF);
    p.w_in1t = (bf16_t*)take((size_t)N_IN1 * DM * 2); p.w_out1t = (bf16_t*)take((size_t)DM * LRU_W * 2);
    p.w_gut1 = (bf16_t*)take((size_t)NEXP * 2048 * DM); p.w_dt1 = (bf16_t*)take((size_t)NEXP * DM * EFF);
    p.w_lru = (bf16_t*)take((size_t)2 * 2 * 16 * 2 * 96 * 192 * 2);
    p.H = (bf16_t*)take((size_t)T_TOK * DM * 2); p.G = (bf16_t*)take((size_t)T_TOK * N_IN1 * 2); p.AO = (bf16_t*)take((size_t)T_TOK * LRU_W * 2); p.HF = (bf16_t*)take((size_t)256 * 32 * 8 * 3 * 64 * 8);
    p.XA = (bf16_t*)take((size_t)T_TOK * DM * 2); p.ACT = (bf16_t*)take((size_t)ROWS_PAD * EFF * 2); p.YB = (bf16_t*)take((size_t)ROWS_PAD * DM * 2);
    p.XC = (bf16_t*)take((size_t)T_TOK * LRU_W * 2); p.KVH = (bf16_t*)take((size_t)NBATCH * 8 * 2 * SEQ * 128 * 2);
    p.tokl = (int*)take((size_t)NEXP * ECAP * 4); p.gatel = (float*)take((size_t)NEXP * ECAP * 4); p.asg = (int*)take((size_t)T_TOK * 2 * 4);
    if (off > ws_size) return;
    (void)hipMemsetAsync(d_ws, 0, zero_bytes, stream);
    static int grid = 0;
    if (!grid) { int dev = 0, cus = 0, per_cu = 0; (void)hipGetDevice(&dev); (void)hipDeviceGetAttribute(&cus, hipDeviceAttributeMultiprocessorCount, dev);
        (void)hipFuncSetAttribute((const void*)mega, hipFuncAttributeMaxDynamicSharedMemorySize, LDS_TOTAL);
        (void)hipOccupancyMaxActiveBlocksPerMultiprocessor(&per_cu, mega, 512, LDS_TOTAL);
        grid = cus * (per_cu < 1 ? per_cu : 1); }
    if (grid > 0) mega<<<grid, 512, LDS_TOTAL, stream>>>(p);
}
```

```cpp
#include <hip/hip_runtime.h>
#include <stdint.h>

typedef unsigned short bf16_t;
typedef float f32x4 __attribute__((ext_vector_type(4)));

#define DI __device__ __forceinline__

constexpr int T_TOK = 16384, DM = 2048, SEQ = 4096, NBATCH = 4;
constexpr int N_IN0 = 5120, N_IN1 = 5376, LRU_W = 2688, LRU_BW = 168;
constexpr int NEXP = 32, EFF = 1024, ECAP = 16384, ROWS_PAD = 40960;

DI float bf2f(bf16_t b) { return __uint_as_float(((unsigned)b) << 16); }
DI bf16_t f2bf(float f) { unsigned u = __float_as_uint(f); u += 0x7FFFu + ((u >> 16) & 1u); return (bf16_t)(u >> 16); }
DI float sigmoidf_(float x) { return __builtin_amdgcn_rcpf(1.0f + __expf(-x)); }
DI float siluf_(float x) { return x * __builtin_amdgcn_rcpf(1.0f + __expf(-x)); }
DI float gelu_tanh(float x) { const float u = 0.7978845608028654f * (x + 0.044715f * x * x * x); return x * __builtin_amdgcn_rcpf(1.0f + __expf(-2.0f * u)); }
DI float wave_sum(float v) { for (int o = 32; o > 0; o >>= 1) v += __shfl_xor(v, o); return v; }
DI float wave_max(float v) { for (int o = 32; o > 0; o >>= 1) v = fmaxf(v, __shfl_xor(v, o)); return v; }

struct Params {
    const float *x, *c;
    const float *norm0_mix, *ada0_mix_w, *ada0_mix_b, *w_in0, *conv_w, *conv_b, *conv_norm_g, *conv_norm_b, *w_out0;
    const float *norm0_ffn, *ada0_ffn_w, *ada0_ffn_b, *moe0_w_group, *moe0_w_expert, *moe0_w_gate_up, *moe0_w_down;
    const float *norm1_mix, *ada1_mix_w, *ada1_mix_b, *w_in1, *lru_conv_w, *lru_conv_b, *lru_w_a, *lru_b_a, *lru_w_x, *lru_b_x, *lru_lambda, *w_out1;
    const float *norm1_ffn, *ada1_ffn_w, *ada1_ffn_b, *moe1_w_group, *moe1_w_expert, *moe1_w_gate_up, *moe1_w_down;
    const float *norm_final;
    float* out;
    unsigned* bar; int* cnt;
    float* mod;
    float* wrt;
    float* rbias;
    bf16_t *w_in0t, *w_out0t, *w_gut0, *w_dt0, *w_in1t, *w_out1t, *w_gut1, *w_dt1, *w_lru;
    bf16_t *H, *G, *AO, *HF, *ACT, *YB, *XC, *KVH;
    bf16_t* XA;
    int* tokl; float* gatel; int* asg;
};

constexpr bool YB8_E = true;
struct GUnit { int rowbase; int nvalid; int e; const int* gather; };
struct GArgs { const bf16_t* A; const bf16_t* Bt; size_t bt_estride; long long lda, K, moe_layer; const float* xin; long long lgate; };
typedef unsigned u32x4_ __attribute__((ext_vector_type(4)));
typedef __bf16 bf2v_ __attribute__((ext_vector_type(2)));
typedef float f32x2_ __attribute__((ext_vector_type(2)));
DI unsigned pk2e(float a, float b) { f32x2_ v = {a, b}; bf2v_ r = __builtin_convertvector(v, bf2v_); return __builtin_bit_cast(unsigned, r); }
DI u32x4_ pack8(f32x4 a, f32x4 b) { return (u32x4_){pk2e(a[0], a[1]), pk2e(a[2], a[3]), pk2e(b[0], b[1]), pk2e(b[2], b[3])}; }
struct EpiIn0 { static constexpr bool GATHER = false; const float* xin; int lgate; DI void operator()(const Params& p, const GUnit& u, int r, int col0, f32x4 lo0, f32x4 lo1, f32x4 hi0, f32x4 hi1) const {
    const int row = u.rowbase + r;
    if (col0 < 3072) { bf16_t* o = p.G + (size_t)row * N_IN0 + col0; *(u32x4_*)o = pack8(lo0, lo1); *(u32x4_*)(o + 128) = pack8(hi0, hi1); }
    else { const int b = row / SEQ, t = row % SEQ, i0 = (col0 - 3072) >> 7, i1 = i0 + 1;
        bf16_t* o0 = p.KVH + ((size_t)((b * 8 + (i0 & 7)) * 2 + (i0 >> 3)) * SEQ + t) * 128 + (col0 & 127);
        bf16_t* o1 = p.KVH + ((size_t)((b * 8 + (i1 & 7)) * 2 + (i1 >> 3)) * SEQ + t) * 128 + (col0 & 127);
        *(u32x4_*)o0 = pack8(lo0, lo1); *(u32x4_*)o1 = pack8(hi0, hi1); } } };
struct EpiOut { static constexpr bool GATHER = false; const float* xin; int lgate; DI void operator()(const Params& p, const GUnit& u, int r, int col0, f32x4 lo0, f32x4 lo1, f32x4 hi0, f32x4 hi1) const {
    const int row = u.rowbase + r, b = row / SEQ; const float* gt = p.mod + (lgate * 4 + b) * 6144 + 4096 + col0; bf16_t* o = p.XA + (size_t)row * DM + col0;
    f32x4 r0, r1, r2, r3;
    if (xin) { const float* xi = xin + (size_t)row * DM + col0; r0 = *(const f32x4*)xi; r1 = *(const f32x4*)(xi + 4); r2 = *(const f32x4*)(xi + 128); r3 = *(const f32x4*)(xi + 132); }
    else { const u32x4_ a = *(const u32x4_*)o, c = *(const u32x4_*)(o + 128);
        r0 = (f32x4){__uint_as_float(a[0] << 16), __uint_as_float(a[0] & 0xffff0000u), __uint_as_float(a[1] << 16), __uint_as_float(a[1] & 0xffff0000u)};
        r1 = (f32x4){__uint_as_float(a[2] << 16), __uint_as_float(a[2] & 0xffff0000u), __uint_as_float(a[3] << 16), __uint_as_float(a[3] & 0xffff0000u)};
        r2 = (f32x4){__uint_as_float(c[0] << 16), __uint_as_float(c[0] & 0xffff0000u), __uint_as_float(c[1] << 16), __uint_as_float(c[1] & 0xffff0000u)};
        r3 = (f32x4){__uint_as_float(c[2] << 16), __uint_as_float(c[2] & 0xffff0000u), __uint_as_float(c[3] << 16), __uint_as_float(c[3] & 0xffff0000u)}; }
    *(u32x4_*)o = pack8(r0 + *(const f32x4*)gt * lo0, r1 + *(const f32x4*)(gt + 4) * lo1); *(u32x4_*)(o + 128) = pack8(r2 + *(const f32x4*)(gt + 128) * hi0, r3 + *(const f32x4*)(gt + 132) * hi1); } };
DI unsigned pk4_fp8e(float a, float b, float c, float d, float sc) { a = fminf(fmaxf(a * sc, -448.f), 448.f); b = fminf(fmaxf(b * sc, -448.f), 448.f); c = fminf(fmaxf(c * sc, -448.f), 448.f); d = fminf(fmaxf(d * sc, -448.f), 448.f);
    unsigned w = 0u; w = __builtin_amdgcn_cvt_pk_fp8_f32(a, b, w, false); w = __builtin_amdgcn_cvt_pk_fp8_f32(c, d, w, true); return w; }
struct EpiGU { static constexpr bool GATHER = true; const float* xin; int lgate; DI void operator()(const Params& p, const GUnit& u, int r, int col0, f32x4 lo0, f32x4 lo1, f32x4 hi0, f32x4 hi1) const {
    f32x4 a0, a1;
#pragma unroll
    for (int j = 0; j < 4; ++j) { a0[j] = siluf_(lo0[j]) * hi0[j]; a1[j] = siluf_(lo1[j]) * hi1[j]; }
    *(uint2*)((unsigned char*)p.ACT + (size_t)(u.rowbase + r) * EFF + (col0 >> 8) * 128 + (col0 & 127)) = make_uint2(pk4_fp8e(a0[0], a0[1], a0[2], a0[3], 8.f), pk4_fp8e(a1[0], a1[1], a1[2], a1[3], 8.f)); } };
struct EpiDown { static constexpr bool GATHER = false; const float* xin; int lgate; DI void operator()(const Params& p, const GUnit& u, int r, int col0, f32x4 lo0, f32x4 lo1, f32x4 hi0, f32x4 hi1) const {
    const float g = p.gatel[(u.gather - p.tokl) + r];
    if constexpr (YB8_E) { const float gs = g * 64.f; unsigned char* o = (unsigned char*)p.YB + (size_t)(u.rowbase + r) * DM + col0;
        *(uint2*)o = make_uint2(pk4_fp8e(lo0[0], lo0[1], lo0[2], lo0[3], gs), pk4_fp8e(lo1[0], lo1[1], lo1[2], lo1[3], gs)); *(uint2*)(o + 128) = make_uint2(pk4_fp8e(hi0[0], hi0[1], hi0[2], hi0[3], gs), pk4_fp8e(hi1[0], hi1[1], hi1[2], hi1[3], gs)); }
    else { bf16_t* o = p.YB + (size_t)(u.rowbase + r) * DM + col0; *(u32x4_*)o = pack8(lo0 * g, lo1 * g); *(u32x4_*)(o + 128) = pack8(hi0 * g, hi1 * g); } } };
struct EpiIn1 { static constexpr bool GATHER = false; const float* xin; int lgate; DI void operator()(const Params& p, const GUnit& u, int r, int col0, f32x4 lo0, f32x4 lo1, f32x4 hi0, f32x4 hi1) const {
    bf16_t* o = p.G + (size_t)(u.rowbase + r) * N_IN1 + col0;
    if (col0 < LRU_W) {
#pragma unroll
        for (int j = 0; j < 4; ++j) { lo0[j] = gelu_tanh(lo0[j]); lo1[j] = gelu_tanh(lo1[j]); } }
    if (col0 + 128 < LRU_W) {
#pragma unroll
        for (int j = 0; j < 4; ++j) { hi0[j] = gelu_tanh(hi0[j]); hi1[j] = gelu_tanh(hi1[j]); } }
    *(u32x4_*)o = pack8(lo0, lo1); *(u32x4_*)(o + 128) = pack8(hi0, hi1); } };

#define LAS __attribute__((address_space(3)))
typedef short bf16x8 __attribute__((ext_vector_type(8)));
DI int opaque_tid() { int t = threadIdx.x; asm volatile("" : "+v"(t)); return t; }
namespace gm {
constexpr int BM = 256, BK = 64, HALF = 128, HTB = HALF * BK * 2, STAGE_BYTES = 8 * HTB, NXCD = 8, WGM = 4;
constexpr int TAB_OFF = STAGE_BYTES;
DI int lds_byte(int r, int c) { const int st = (r >> 4) * 2 + (c >> 5), rr = r & 15, cc = c & 31, ob = rr * 64 + cc * 2; return st * 1024 + (ob ^ (((ob >> 9) & 1) << 5)); }
DI int perm32(int rho) { const int n = rho >> 4, i = rho & 15; return 8 * (i >> 2) + 4 * n + (i & 3); }
DI void stage_rc(int b, int& R, int& C) { const int st = b / 1024, sb = b % 1024, swz = sb ^ (((sb >> 9) & 1) << 5); R = (st >> 1) * 16 + swz / 64; C = (st & 1) * 32 + (swz % 64) / 2; }
struct Unit { int arow, nvalid, orow, pn, e, goff; };
struct DenseSched {
    static constexpr bool GATHER = false, HALF_SKIP = false;
    int nM, nN, nwg, G, c;
    DI void init(int M, int N) { nM = M / BM; nN = N / BM; nwg = nM * nN; G = gridDim.x; c = blockIdx.x; }
    DI bool next(int i, Unit& u) const {
        const long L = (long)i * G + c; if (L >= nwg) return false;
        int wgid = (int)L; { const int q = nwg / NXCD, r = nwg % NXCD, xcd = wgid % NXCD, off = wgid / NXCD; wgid = (xcd < r ? xcd * (q + 1) : r * (q + 1) + (xcd - r) * q) + off; }
        const int nig = WGM * nN, gid = wgid / nig, fm = gid * WGM, gsz = (nM - fm) < WGM ? (nM - fm) : WGM;
        const int pm = fm + ((wgid % nig) % gsz); u.pn = (wgid % nig) / gsz; u.arow = pm * BM; u.orow = pm * BM; u.nvalid = BM; u.e = 0; u.goff = 0; return true;
    }
};
template <bool GATH> struct MoeSched {
    static constexpr bool GATHER = GATH, HALF_SKIP = true;
    const LAS int* tab; int G, c;
    DI void init(const LAS int* t) { tab = t; G = gridDim.x; c = blockIdx.x; }
    DI bool next(int i, Unit& u) const {
        const int L = i * G + c, mtile = L >> 3; const int total = __builtin_amdgcn_readfirstlane(tab[32]);
        if (mtile >= total) return false;
        int e = 0; for (int j = 1; j < 32; ++j) { if (__builtin_amdgcn_readfirstlane(tab[j]) <= mtile) e = j; }
        const int mt = mtile - __builtin_amdgcn_readfirstlane(tab[e]); const int cn = __builtin_amdgcn_readfirstlane(tab[64 + e]);
        u.e = e; u.pn = L & 7; u.orow = mtile * BM; u.arow = mtile * BM; u.nvalid = (cn - mt * BM) < BM ? (cn - mt * BM) : BM; u.goff = e * ECAP + mt * BM; return true;
    }
};
DI void moe_tables(LAS int* tab, const int* cnt) {
    if (threadIdx.x == 0) { int run = 0; for (int e = 0; e < 32; ++e) { const int cn = cnt[e]; tab[e] = run; tab[64 + e] = cn; run += (cn + 255) >> 8; } tab[32] = run; }
    __syncthreads();
}

typedef int i32x8 __attribute__((ext_vector_type(8)));
typedef int i32x4 __attribute__((ext_vector_type(4)));
DI void mfma8(f32x4& acc, const i32x8& w8, const i32x8& x8, int ws, int as) {
    asm volatile("v_mfma_scale_f32_16x16x128_f8f6f4 %0, %1, %2, %0, %3, %4 op_sel_hi:[0,0,0]" : "+v"(acc) : "v"(w8), "v"(x8), "v"(ws), "v"(as)); }
template <class Epi, class Sched, bool FP8 = false>
DI void gemm_phase(LAS unsigned char* lds, const Params& p, const bf16_t* A, const bf16_t* Bt, size_t bt_estride, int K, const Sched& S, const Epi& E, int wscale = 0x7f7f7f7f, int ascale = 0x7f7f7f7f) {
    const int tid = opaque_tid(), wid = __builtin_amdgcn_readfirstlane(tid >> 6), lane = tid & 63, wr = wid >> 2, wc = wid & 3, fr = lane & 15, fq = lane >> 4;
    const int nt = K / BK;
    unsigned voffA[2], voffB[2];
#pragma unroll
    for (int i = 0; i < 2; ++i) { int R, C; stage_rc(tid * 16 + i * 8192, R, C); voffA[i] = (unsigned)(R * K + C) * 2u; voffB[i] = (unsigned)(((R & ~31) + perm32(R & 31)) * K + C) * 2u; }
    const size_t kstep = (size_t)(BK * 2), hstep = (size_t)HALF * K * 2, tstep = 2 * hstep;
    const unsigned ldsw = (unsigned)wid * 1024u;
    const int aoff = lds_byte(wr * 64 + fr, fq * 8), boff = lds_byte(wc * 32 + fr, fq * 8);
#define G_SA(b, h) (((b) * 2 + (h)) * HTB)
#define G_SB(b, h) ((4 + (b) * 2 + (h)) * HTB)
#define G_STAGE(bufoff, gbase, voff) do { _Pragma("unroll") for (int _i = 0; _i < 2; ++_i) \
        __builtin_amdgcn_global_load_lds((const unsigned*)((const char*)(gbase) + (voff)[_i]), (LAS unsigned*)(lds + (bufoff) + ldsw + _i * 8192), 16, 0, 0); } while (0)
#define G_STAGE_A(bufoff, ubase, gv, h, koff) do { if constexpr (Sched::GATHER) { G_STAGE(bufoff, (const char*)A + (koff), gv[h]); } else { G_STAGE(bufoff, (ubase) + (h) * hstep + (koff), voffA); } } while (0)
#define G_LD16(off_) (*(const LAS i32x4*)(lds + (off_)))
#define G_LD16B(off_) (*(const LAS bf16x8*)(lds + (off_)))
#define G_LDA(dst, b, h) do { _Pragma("unroll") for (int m = 0; m < 4; ++m) { if constexpr (FP8) dst##8[m] = __builtin_shufflevector(G_LD16(G_SA(b, h) + aoff + m * 2048), G_LD16(G_SA(b, h) + aoff + m * 2048 + 1024), 0, 1, 2, 3, 4, 5, 6, 7); \
        else { dst[m][0] = G_LD16B(G_SA(b, h) + aoff + m * 2048); dst[m][1] = G_LD16B(G_SA(b, h) + aoff + m * 2048 + 1024); } } } while (0)
#define G_LDB(dst, b, h) do { _Pragma("unroll") for (int n = 0; n < 2; ++n) { if constexpr (FP8) dst##8[n] = __builtin_shufflevector(G_LD16(G_SB(b, h) + boff + n * 2048), G_LD16(G_SB(b, h) + boff + n * 2048 + 1024), 0, 1, 2, 3, 4, 5, 6, 7); \
        else { dst[n][0] = G_LD16B(G_SB(b, h) + boff + n * 2048); dst[n][1] = G_LD16B(G_SB(b, h) + boff + n * 2048 + 1024); } } } while (0)
#define G_MMA(ai, bj, At, Bt_) do { __builtin_amdgcn_s_setprio(1); _Pragma("unroll") for (int m = 0; m < 4; ++m) _Pragma("unroll") for (int n = 0; n < 2; ++n) { \
        if constexpr (FP8) mfma8(acc[ai][bj][m][n], Bt_##8[n], At##8[m], wscale, ascale); \
        else { _Pragma("unroll") for (int k = 0; k < 2; ++k) acc[ai][bj][m][n] = __builtin_amdgcn_mfma_f32_16x16x32_bf16(Bt_[n][k], At[m][k], acc[ai][bj][m][n], 0, 0, 0); } } \
        __builtin_amdgcn_s_setprio(0); } while (0)
#define G_WAIT_V(n) asm volatile("s_waitcnt vmcnt(" #n ")" ::: "memory")
#define G_WAIT_L(n) asm volatile("s_waitcnt lgkmcnt(" #n ")" ::: "memory")
#define G_BAR __builtin_amdgcn_s_barrier()
#define G_SCHED __builtin_amdgcn_sched_barrier(0)
    Unit cur, nxt; int ui = 0;
    if (!S.next(0, cur)) return;
    f32x4 acc[2][2][4][2];
#pragma unroll
    for (int a = 0; a < 2; ++a)
#pragma unroll
        for (int b = 0; b < 2; ++b)
#pragma unroll
            for (int m = 0; m < 4; ++m)
#pragma unroll
                for (int n = 0; n < 2; ++n) acc[a][b][m][n] = (f32x4){0.f, 0.f, 0.f, 0.f};
    bf16x8 At[4][2], B0[2][2], B1[2][2]; i32x8 At8[4], B08[2], B18[2];
    unsigned gcur[2][2] = {{0u, 0u}, {0u, 0u}}, gnxt[2][2] = {{0u, 0u}, {0u, 0u}};
    auto gather_offs = [&](const Unit& u, unsigned (&g)[2][2]) {
        if constexpr (Sched::GATHER) {
#pragma unroll
            for (int h = 0; h < 2; ++h)
#pragma unroll
                for (int i = 0; i < 2; ++i) { int tz = tid; asm volatile("" : "+v"(tz)); int R, C; stage_rc(tz * 16 + i * 8192, R, C); const int r = h * HALF + R; const int tk = p.tokl[u.goff + (r < u.nvalid ? r : 0)]; const int tok = r < u.nvalid ? tk : 0; g[h][i] = (unsigned)(tok * K + C) * 2u; }
        }
    };
    const char* cA = (const char*)A + (size_t)(cur.arow / BM) * tstep; const char* cB = (const char*)Bt + ((size_t)cur.e * bt_estride) * 2 + (size_t)cur.pn * tstep;
    gather_offs(cur, gcur);
    G_STAGE(G_SB(0, 0), cB, voffB); G_STAGE_A(G_SA(0, 0), cA, gcur, 0, 0); G_STAGE(G_SB(0, 1), cB + hstep, voffB); G_STAGE_A(G_SA(0, 1), cA, gcur, 1, 0);
    if (wr == 1) G_BAR;
    G_WAIT_V(4); G_BAR;
    G_STAGE(G_SB(1, 0), cB + kstep, voffB); G_STAGE_A(G_SA(1, 0), cA, gcur, 0, kstep); G_STAGE(G_SB(1, 1), cB + hstep + kstep, voffB);
    G_WAIT_V(6); G_BAR;
    for (;;) {
        const bool has_next = S.next(ui + 1, nxt);
        const char* nA = has_next ? (const char*)A + (size_t)(nxt.arow / BM) * tstep : cA;
        const char* nB = has_next ? (const char*)Bt + ((size_t)nxt.e * bt_estride) * 2 + (size_t)nxt.pn * tstep : cB;
        if constexpr (Sched::GATHER) { if (has_next) gather_offs(nxt, gnxt); else {
#pragma unroll
            for (int h = 0; h < 2; ++h) { gnxt[h][0] = gcur[h][0]; gnxt[h][1] = gcur[h][1]; } } }
        for (int t = 0; t < nt; t += 2) {
            const bool last = (t == nt - 2);
            const size_t k1 = (size_t)(t + 1) * kstep;
            const char* a2 = last ? nA : cA; const char* b2 = last ? nB : cB + (size_t)(t + 2) * kstep;
            const size_t k2 = last ? 0 : (size_t)(t + 2) * kstep; const size_t k3 = k2 + kstep;
            const char* b3 = b2 + kstep;
            unsigned g2[2][2];
#pragma unroll
            for (int h = 0; h < 2; ++h) { g2[h][0] = last ? gnxt[h][0] : gcur[h][0]; g2[h][1] = last ? gnxt[h][1] : gcur[h][1]; }
            G_LDB(B0, 0, 0); G_SCHED; G_LDA(At, 0, 0); G_STAGE_A(G_SA(1, 1), cA, gcur, 1, k1);
            G_WAIT_L(8); G_BAR; G_WAIT_L(0); G_MMA(0, 0, At, B0); G_BAR; G_SCHED;
            G_LDB(B1, 0, 1); G_STAGE(G_SB(0, 0), b2, voffB);
            G_BAR; G_WAIT_L(0); G_MMA(0, 1, At, B1); G_BAR;
            G_LDA(At, 0, 1); G_STAGE_A(G_SA(0, 0), a2, g2, 0, k2);
            G_BAR; G_WAIT_L(0); if (!Sched::HALF_SKIP || cur.nvalid > HALF) G_MMA(1, 0, At, B0); G_BAR; G_SCHED;
            G_STAGE(G_SB(0, 1), b2 + hstep, voffB);
            G_WAIT_V(6); G_BAR; if (!Sched::HALF_SKIP || cur.nvalid > HALF) G_MMA(1, 1, At, B1); G_BAR;
            G_LDB(B0, 1, 0); G_SCHED; G_LDA(At, 1, 0); G_STAGE_A(G_SA(0, 1), a2, g2, 1, k2);
            G_WAIT_L(8); G_BAR; G_WAIT_L(0); G_MMA(0, 0, At, B0); G_BAR; G_SCHED;
            G_LDB(B1, 1, 1); G_STAGE(G_SB(1, 0), b3, voffB);
            G_BAR; G_WAIT_L(0); G_MMA(0, 1, At, B1); G_BAR;
            G_LDA(At, 1, 1); G_STAGE_A(G_SA(1, 0), a2, g2, 0, k3);
            G_BAR; G_WAIT_L(0); if (!Sched::HALF_SKIP || cur.nvalid > HALF) G_MMA(1, 0, At, B0); G_BAR; G_SCHED;
            G_STAGE(G_SB(1, 1), b3 + hstep, voffB);
            G_WAIT_V(6); G_BAR; if (!Sched::HALF_SKIP || cur.nvalid > HALF) G_MMA(1, 1, At, B1); G_BAR;
        }
        if constexpr (FP8) asm volatile("s_nop 15\n\ts_nop 15" ::: "memory");
        { GUnit gu; gu.rowbase = cur.orow; gu.nvalid = cur.nvalid; gu.e = cur.e; gu.gather = p.tokl + cur.goff;
#pragma unroll
          for (int ai = 0; ai < 2; ++ai)
#pragma unroll
            for (int m = 0; m < 4; ++m) { const int r = ai * HALF + wr * 64 + m * 16 + fr;
              if (r < cur.nvalid) E(p, gu, r, cur.pn * BM + wc * 32 + fq * 8, acc[ai][0][m][0], acc[ai][0][m][1], acc[ai][1][m][0], acc[ai][1][m][1]); } }
        if (!has_next) break;
#pragma unroll
        for (int a = 0; a < 2; ++a)
#pragma unroll
            for (int b = 0; b < 2; ++b)
#pragma unroll
                for (int m = 0; m < 4; ++m)
#pragma unroll
                    for (int n = 0; n < 2; ++n) acc[a][b][m][n] = (f32x4){0.f, 0.f, 0.f, 0.f};
        cur = nxt; cA = nA; cB = nB; ++ui;
#pragma unroll
        for (int h = 0; h < 2; ++h) { gcur[h][0] = gnxt[h][0]; gcur[h][1] = gnxt[h][1]; }
    }
    G_WAIT_V(0);
    if (wr == 0) G_BAR;
    G_BAR;
}
}

extern __shared__ __attribute__((aligned(16))) unsigned char dyn_smem[];
constexpr int LDS_BYTES = gm::STAGE_BYTES + 1024;

typedef __bf16 bf2v __attribute__((ext_vector_type(2)));
typedef float f32x2 __attribute__((ext_vector_type(2)));
typedef float f32x16 __attribute__((ext_vector_type(16)));
typedef short s16x4 __attribute__((ext_vector_type(4)));
typedef unsigned u32x4 __attribute__((ext_vector_type(4)));
DI unsigned pk2(float a, float b) { f32x2 v = {a, b}; bf2v r = __builtin_convertvector(v, bf2v); return __builtin_bit_cast(unsigned, r); }
DI float bflo(unsigned u) { return __uint_as_float(u << 16); }
DI float bfhi(unsigned u) { return __uint_as_float(u & 0xffff0000u); }

DI unsigned pk4_fp8(float a, float b, float c, float d, float sc) {
    a = __builtin_amdgcn_fmed3f(a * sc, -448.f, 448.f); b = __builtin_amdgcn_fmed3f(b * sc, -448.f, 448.f); c = __builtin_amdgcn_fmed3f(c * sc, -448.f, 448.f); d = __builtin_amdgcn_fmed3f(d * sc, -448.f, 448.f);
    unsigned w = 0u; w = __builtin_amdgcn_cvt_pk_fp8_f32(a, b, w, false); w = __builtin_amdgcn_cvt_pk_fp8_f32(c, d, w, true); return w; }
constexpr bool D8_IN0 = true, D8_OUT0 = false, D8_IN1 = false;
constexpr bool YB8 = true;
constexpr float Y8_SCALE = 64.f;
constexpr float W8_SCALE = 256.f, A8_SCALE = 8.f;
constexpr int W8_E8M0 = 0x77777777, A8_E8M0 = 0x7c7c7c7c;
namespace ph {
DI void mods(const Params& p, LAS unsigned char* lds) {
    const int tid = opaque_tid(), wave = tid >> 6, lane = tid & 63, l8 = tid & 7, rg = tid >> 3;
    LAS float* fl = (LAS float*)lds; LAS float* red = fl + 4 * DM;
    for (int i = tid; i < 4 * DM; i += 512) fl[i] = siluf_(p.c[i]);
    __syncthreads();
    for (int u = blockIdx.x; u < 768; u += gridDim.x) {
        const int l = u / 192, c32 = u % 192;
        const float* w = l == 0 ? p.ada0_mix_w : l == 1 ? p.ada0_ffn_w : l == 2 ? p.ada1_mix_w : p.ada1_ffn_w;
        const float* bs = l == 0 ? p.ada0_mix_b : l == 1 ? p.ada0_ffn_b : l == 2 ? p.ada1_mix_b : p.ada1_ffn_b;
        f32x4 acc[4] = {{0.f, 0.f, 0.f, 0.f}, {0.f, 0.f, 0.f, 0.f}, {0.f, 0.f, 0.f, 0.f}, {0.f, 0.f, 0.f, 0.f}};
        const float* wp = w + (size_t)rg * 6144 + c32 * 32 + l8 * 4;
#pragma unroll 8
        for (int i = 0; i < 32; ++i) { const f32x4 wv = *(const f32x4*)(wp + (size_t)(64 * i) * 6144); const int k = rg + 64 * i;
#pragma unroll
            for (int b = 0; b < 4; ++b) acc[b] += fl[b * DM + k] * wv; }
#pragma unroll
        for (int b = 0; b < 4; ++b)
#pragma unroll
            for (int j = 0; j < 4; ++j) { float v = acc[b][j]; v += __shfl_xor(v, 8); v += __shfl_xor(v, 16); v += __shfl_xor(v, 32); acc[b][j] = v; }
        if (lane < 8) {
#pragma unroll
            for (int b = 0; b < 4; ++b) *(LAS f32x4*)(red + (wave * 4 + b) * 32 + lane * 4) = acc[b]; }
        __syncthreads();
        if (tid < 128) { const int b = tid >> 5, col = tid & 31; float sum = 0.f;
#pragma unroll
            for (int w8 = 0; w8 < 8; ++w8) sum += red[(w8 * 4 + b) * 32 + col];
            p.mod[(l * 4 + b) * 6144 + c32 * 32 + col] = sum + bs[c32 * 32 + col]; }
        __syncthreads();
    }
}
constexpr int NT_UNITS = (640 + 256 + 672 + 336 + 2 * (8192 + 4096)) / 2;
struct UD { const float* sp; bf16_t* dst; int K, N, mode, e, kt, ntile; };
DI UD tdecode(const Params& p, int u, int lane) {
    const float* srcs[8] = {p.w_in0, p.w_out0, p.w_in1, p.w_out1, p.moe0_w_gate_up, p.moe0_w_down, p.moe1_w_gate_up, p.moe1_w_down};
    bf16_t* dsts[8] = {p.w_in0t, p.w_out0t, p.w_in1t, p.w_out1t, p.w_gut0, p.w_dt0, p.w_gut1, p.w_dt1};
    constexpr int Ks[8] = {DM, DM, DM, LRU_W, DM, EFF, DM, EFF}, Ns[8] = {N_IN0, DM, N_IN1, DM, 2048, DM, 2048, DM}, nus[8] = {320, 128, 336, 168, 4096, 2048, 4096, 2048};
    constexpr int modes[8] = {D8_IN0 ? 2 : 0, D8_OUT0 ? 2 : 0, D8_IN1 ? 2 : 0, 0, 3, 2, 3, 2};
    int v = u, mi = 0;
#pragma unroll
    for (int m = 0; m < 8; ++m) { if (mi == m && v >= nus[m]) { v -= nus[m]; mi = m + 1; } }
    UD d; const float* src = srcs[0]; d.dst = dsts[0]; d.K = Ks[0]; d.N = Ns[0]; d.mode = modes[0];
#pragma unroll
    for (int m = 1; m < 8; ++m) if (mi == m) { src = srcs[m]; d.dst = dsts[m]; d.K = Ks[m]; d.N = Ns[m]; d.mode = modes[m]; }
    const int ntl = d.N / 256, ktl = d.K / 128; d.e = v / (ktl * ntl); const int rem = v % (ktl * ntl); d.kt = rem / ntl; d.ntile = rem % ntl;
    d.sp = src + (size_t)d.e * d.K * d.N + (size_t)(d.kt * 128) * d.N + d.ntile * 256 + lane * 4;
    return d;
}
DI void transposer(const Params& p, LAS unsigned char* lds, int first, int count, int stride) {
    const int tid = opaque_tid(), wave = tid >> 6, lane = tid & 63;
    LAS float* fl = (LAS float*)lds;
    if (count <= 0) return;
    if (tdecode(p, first, lane).mode & 2) {
        LAS unsigned* td = (LAS unsigned*)lds;
        const int nl = lane & 15, ks = lane >> 4;
        auto src_of = [&](const UD& d, int g, int j) -> const float* { const int kq = 4 * (g >> 2) + ks, nq = 16 * (g & 3) + nl; return d.sp - lane * 4 + (size_t)(4 * kq + j) * d.N + 4 * nq; };
        f32x4 va[4][4], vb[4][4];
        auto load_unit = [&](int u, f32x4 (&v)[4][4]) { const UD dd = tdecode(p, u, lane);
#pragma unroll
            for (int i = 0; i < 4; ++i)
#pragma unroll
                for (int j = 0; j < 4; ++j) v[i][j] = *(const f32x4*)src_of(dd, wave * 4 + i, j); };
        auto process = [&](int jn, f32x4 (&v)[4][4]) { const int u = first + jn * stride;
            const UD d = tdecode(p, u, lane); const int K = d.K, N = d.N, mode = d.mode, e = d.e, kt = d.kt, ntile = d.ntile;
            LAS unsigned* tile = td + (jn & 1) * (256 * 33);
#pragma unroll
            for (int i = 0; i < 4; ++i) { const int g = wave * 4 + i, kq = 4 * (g >> 2) + ks, nq = 16 * (g & 3) + nl;
#pragma unroll
                for (int en = 0; en < 4; ++en) tile[(4 * nq + en) * 33 + kq] = pk4_fp8(v[i][0][en], v[i][1][en], v[i][2][en], v[i][3][en], W8_SCALE); }
            __syncthreads();
            if (jn + 2 < count) load_unit(u + 2 * stride, v);
            { const int n = tid >> 1, kh = tid & 1; const int ng = ntile * 256 + n; const int jg = ng & 1023; const int np = (mode & 1) ? (256 * (jg >> 7) + (ng < 1024 ? 0 : 128) + (jg & 127)) : ng;
              unsigned char* dp = (unsigned char*)d.dst + (size_t)e * N * K + (size_t)np * K + kt * 128 + kh * 64;
#pragma unroll
              for (int jj = 0; jj < 4; ++jj) { const LAS unsigned* tp = tile + n * 33 + kh * 16 + jj * 4; *(uint4*)(dp + jj * 16) = make_uint4(tp[0], tp[1], tp[2], tp[3]); } } };
        load_unit(first, va); if (count > 1) load_unit(first + stride, vb);
        for (int jn = 0; jn < count; jn += 2) { process(jn, va); if (jn + 1 < count) process(jn + 1, vb); }
        __syncthreads();
        return;
    }
    f32x4 vv[16];
    { const UD d0 = tdecode(p, first, lane);
#pragma unroll
        for (int i = 0; i < 16; ++i) vv[i] = *(const f32x4*)(d0.sp + (size_t)(i * 8 + wave) * d0.N); }
    for (int j = 0; j < count; ++j) { const int u = first + j * stride;
        const UD d = tdecode(p, u, lane); const int K = d.K, N = d.N, mode = d.mode, e = d.e, kt = d.kt, ntile = d.ntile; bf16_t* dst = d.dst;
#pragma unroll
        for (int i = 0; i < 16; ++i) { LAS float* tp = fl + (i * 8 + wave) * 257 + lane * 4; tp[0] = vv[i][0]; tp[1] = vv[i][1]; tp[2] = vv[i][2]; tp[3] = vv[i][3]; }
        __syncthreads();
        if (j + 1 < count) { const UD dn = tdecode(p, u + stride, lane);
#pragma unroll
            for (int i = 0; i < 16; ++i) vv[i] = *(const f32x4*)(dn.sp + (size_t)(i * 8 + wave) * dn.N); }
        { const int n = tid >> 1, kh = tid & 1; const int ng = ntile * 256 + n; const int jg = ng & 1023; const int np = (mode & 1) ? (256 * (jg >> 7) + (ng < 1024 ? 0 : 128) + (jg & 127)) : ng;
          bf16_t* dp = dst + (size_t)e * N * K + (size_t)np * K + kt * 128 + kh * 64;
#pragma unroll
          for (int jj = 0; jj < 8; ++jj) { unsigned w4[4];
#pragma unroll
              for (int q = 0; q < 4; ++q) { const int k = kh * 64 + jj * 8 + q * 2; w4[q] = pk2(fl[k * 257 + n], fl[(k + 1) * 257 + n]); }
              *(uint4*)(dp + jj * 8) = make_uint4(w4[0], w4[1], w4[2], w4[3]); } }
        __syncthreads();
    }
}
DI void lru_weights(const Params& p) {
    const int tid = opaque_tid();
    for (size_t i = (size_t)blockIdx.x * 512 + tid; i < (size_t)2 * 2 * 16 * 4 * 48 * 192; i += (size_t)gridDim.x * 512) {
        const int k = i % 192, j = (i / 192) % 48, qt = (i / (192 * 48)) % 4, n = (i / (192 * 48 * 4)) % 16, which = (i / (192 * 48 * 4 * 16)) % 2, dir = i / (192 * 48 * 4 * 16 * 2);
        const float* w = which == 0 ? p.lru_w_a : p.lru_w_x; float v = 0.f;
        if (j < 42 && k < 168) v = w[(((size_t)dir * 16 + n) * 168 + k) * 168 + qt * 42 + j];
        p.w_lru[i] = f2bf(v);
    }
}
DI void fold_router(const Params& p) {
    const int tid = opaque_tid(), wave = tid >> 6, lane = tid & 63;
    for (size_t i = (size_t)blockIdx.x * 512 + tid; i < (size_t)2 * 4 * 48 * DM; i += (size_t)gridDim.x * 512) {
        const int k = i % DM, n = (i / DM) % 48, b = (i / (DM * 48)) % 4, l = i / (DM * 48 * 4);
        const float* g = l == 0 ? p.norm0_ffn : p.norm1_ffn; const float* md = p.mod + ((l == 0 ? 1 : 3) * 4 + b) * 6144;
        const float* we = l == 0 ? p.moe0_w_expert : p.moe1_w_expert; const float* wg = l == 0 ? p.moe0_w_group : p.moe1_w_group;
        const float w = n < 32 ? we[k * 32 + n] : n < 36 ? wg[k * 4 + (n - 32)] : 0.f;
        p.wrt[i] = g[k] * (1.f + md[2048 + k]) * w;
    }
    for (int task = blockIdx.x * 8 + wave; task < 2 * 4 * 48; task += gridDim.x * 8) {
        const int n = task % 48, b = (task / 48) % 4, l = task / (48 * 4);
        const float* md = p.mod + ((l == 0 ? 1 : 3) * 4 + b) * 6144;
        const float* we = l == 0 ? p.moe0_w_expert : p.moe1_w_expert; const float* wg = l == 0 ? p.moe0_w_group : p.moe1_w_group;
        float part = 0.f;
        for (int k = lane; k < DM; k += 64) { const float w = n < 32 ? we[k * 32 + n] : n < 36 ? wg[k * 4 + (n - 32)] : 0.f; part += md[k] * w; }
        part = wave_sum(part); if (lane == 0) p.rbias[task] = part;
    }
}
template <int MODE, bool OUT8 = false> DI void norm_rows(const Params& p, const float* xin  , const float* gain, int lmod, int lgate, const LAS int* tab) {
    const int tid = opaque_tid(), wave = tid >> 6, lane = tid & 63;
    for (int row = blockIdx.x * 8 + wave; row < T_TOK; row += gridDim.x * 8) {
        const int b = row / SEQ;
        f32x4 v[8];
        if (xin) {
#pragma unroll
            for (int i = 0; i < 8; ++i) v[i] = *(const f32x4*)(xin + (size_t)row * DM + i * 256 + lane * 4);
        } else {
#pragma unroll
            for (int i = 0; i < 8; ++i) { const uint2 a = *(const uint2*)(p.XA + (size_t)row * DM + i * 256 + lane * 4); v[i] = (f32x4){bflo(a.x), bfhi(a.x), bflo(a.y), bfhi(a.y)}; }
        }
        if constexpr (MODE >= 1) {
            const int a0 = p.asg[row * 2], a1 = p.asg[row * 2 + 1];
            const size_t r0 = (size_t)tab[a0 >> 14] * 256 + (a0 & 16383), r1 = (size_t)tab[a1 >> 14] * 256 + (a1 & 16383);
            const float* gt = p.mod + (lgate * 4 + b) * 6144 + 4096;
#pragma unroll
            for (int i = 0; i < 8; ++i) { const int col = i * 256 + lane * 4; const f32x4 g4 = *(const f32x4*)(gt + col);
                if constexpr (YB8) { const unsigned y0 = *(const unsigned*)((const unsigned char*)p.YB + r0 * DM + col), y1 = *(const unsigned*)((const unsigned char*)p.YB + r1 * DM + col);
                    const f32x2 a0 = __builtin_amdgcn_cvt_pk_f32_fp8(y0, false), a1 = __builtin_amdgcn_cvt_pk_f32_fp8(y0, true), b0 = __builtin_amdgcn_cvt_pk_f32_fp8(y1, false), b1 = __builtin_amdgcn_cvt_pk_f32_fp8(y1, true);
                    const f32x4 gq = g4 * (1.f / Y8_SCALE);
                    v[i][0] += gq[0] * (a0[0] + b0[0]); v[i][1] += gq[1] * (a0[1] + b0[1]); v[i][2] += gq[2] * (a1[0] + b1[0]); v[i][3] += gq[3] * (a1[1] + b1[1]); }
                else { const uint2 y0 = *(const uint2*)(p.YB + r0 * DM + col), y1 = *(const uint2*)(p.YB + r1 * DM + col);
                v[i][0] += g4[0] * (bflo(y0.x) + bflo(y1.x)); v[i][1] += g4[1] * (bfhi(y0.x) + bfhi(y1.x));
                v[i][2] += g4[2] * (bflo(y0.y) + bflo(y1.y)); v[i][3] += g4[3] * (bfhi(y0.y) + bfhi(y1.y)); } }
            if constexpr (MODE == 1) {
#pragma unroll
                for (int i = 0; i < 8; ++i) { const uint2 w = make_uint2(pk2(v[i][0], v[i][1]), pk2(v[i][2], v[i][3])); *(uint2*)(p.XA + (size_t)row * DM + i * 256 + lane * 4) = w;
                    v[i] = (f32x4){bflo(w.x), bfhi(w.x), bflo(w.y), bfhi(w.y)}; }
            }
        }
        float ss = 0.f;
#pragma unroll
        for (int i = 0; i < 8; ++i) ss += v[i][0] * v[i][0] + v[i][1] * v[i][1] + v[i][2] * v[i][2] + v[i][3] * v[i][3];
        ss = wave_sum(ss); const float rstd = rsqrtf(ss * (1.0f / DM) + 1e-6f);
        if constexpr (MODE == 2) {
#pragma unroll
            for (int i = 0; i < 8; ++i) { const int col = i * 256 + lane * 4; const f32x4 g4 = *(const f32x4*)(gain + col); *(f32x4*)(p.out + (size_t)row * DM + col) = v[i] * rstd * g4; }
        } else { const float* md = p.mod + (lmod * 4 + b) * 6144;
#pragma unroll
            for (int i = 0; i < 8; ++i) { const int col = i * 256 + lane * 4; const f32x4 g4 = *(const f32x4*)(gain + col), sc = *(const f32x4*)(md + 2048 + col), sh = *(const f32x4*)(md + col);
                const f32x4 h = v[i] * rstd * g4 * (1.f + sc) + sh;
                if constexpr (OUT8) *(unsigned*)((unsigned char*)p.H + (size_t)row * DM + col) = pk4_fp8(h[0], h[1], h[2], h[3], A8_SCALE);
                else *(uint2*)(p.H + (size_t)row * DM + col) = make_uint2(pk2(h[0], h[1]), pk2(h[2], h[3])); } }
    }
}
template <bool DRY = false, bool NORM = false> DI void router(const Params& p, int l, LAS unsigned char* lds, const float* gain = nullptr, int lmod = 0) {
    const int tid = opaque_tid(), wave = __builtin_amdgcn_readfirstlane(tid >> 6), lane = tid & 63;
    LAS float* lg = (LAS float*)lds + (wave & 3) * (16 * 48);
    LAS float* part = (LAS float*)lds + 4 * 16 * 48 + (wave & 3) * (64 * 13);
    LAS float* rsl = (LAS float*)lds + 4 * 16 * 48 + 4 * 64 * 13 + (wave & 3) * 16;
    for (int tg = blockIdx.x; tg < T_TOK / 64; tg += gridDim.x) {
        const int tile = tg * 4 + (wave & 3), kh = wave >> 2;
        const int row0 = tile * 16, b = row0 / SEQ, r = lane & 15, q = lane >> 4;
        const bf16_t* xa = p.XA + (size_t)(row0 + r) * DM + 4 * q + kh * (DM / 2);
        const float* wt = p.wrt + (((size_t)l * 4 + b) * 48 + r) * DM + 4 * q + kh * (DM / 2);
        f32x4 acc[3] = {{0.f, 0.f, 0.f, 0.f}, {0.f, 0.f, 0.f, 0.f}, {0.f, 0.f, 0.f, 0.f}}; float ss = 0.f;
#pragma unroll 2
        for (int s = 0; s < DM / 32; ++s) {
            const uint2 ar = *(const uint2*)(xa + 16 * s); const f32x4 a4 = {bflo(ar.x), bfhi(ar.x), bflo(ar.y), bfhi(ar.y)};
            ss += a4[0] * a4[0] + a4[1] * a4[1] + a4[2] * a4[2] + a4[3] * a4[3];
#pragma unroll
            for (int n = 0; n < 3; ++n) { const f32x4 b4 = *(const f32x4*)(wt + (size_t)n * 16 * DM + 16 * s);
#pragma unroll
                for (int j = 0; j < 4; ++j) acc[n] = __builtin_amdgcn_mfma_f32_16x16x4f32(a4[j], b4[j], acc[n], 0, 0, 0); }
        }
        if (kh == 1) {
#pragma unroll
            for (int n = 0; n < 3; ++n)
#pragma unroll
                for (int j = 0; j < 4; ++j) part[(n * 4 + j) * 64 + lane] = acc[n][j];
            part[12 * 64 + lane] = ss; }
        __syncthreads();
        if (kh == 0) {
#pragma unroll
            for (int n = 0; n < 3; ++n)
#pragma unroll
                for (int j = 0; j < 4; ++j) acc[n][j] += part[(n * 4 + j) * 64 + lane];
            ss += part[12 * 64 + lane];
        ss += __shfl_xor(ss, 16); ss += __shfl_xor(ss, 32);
        const float rstd = rsqrtf(ss * (1.0f / DM) + 1e-6f);
        if (NORM && q == 0) rsl[r] = rstd;
#pragma unroll
        for (int j = 0; j < 4; ++j) { const float rs = __shfl(rstd, 4 * q + j);
#pragma unroll
            for (int n = 0; n < 3; ++n) lg[(4 * q + j) * 48 + n * 16 + r] = acc[n][j] * rs + p.rbias[(l * 4 + b) * 48 + n * 16 + r]; }
        __builtin_amdgcn_wave_barrier();
        if (!DRY && lane < 16) {
            const LAS float* L = lg + lane * 48; const int tok = row0 + lane;
            int gs = 0; float gm = L[32];
#pragma unroll
            for (int g = 1; g < 4; ++g) if (L[32 + g] > gm) { gm = L[32 + g]; gs = g; }
            float gden = 0.f;
#pragma unroll
            for (int g = 0; g < 4; ++g) gden += __expf(L[32 + g] - gm);
            const float gprob = 1.0f / gden;
            int i0 = 0; float v0 = L[gs * 8];
            for (int j = 1; j < 8; ++j) { const float x = L[gs * 8 + j]; if (x > v0) { v0 = x; i0 = j; } }
            int i1 = -1; float v1 = -3.4e38f;
            for (int j = 0; j < 8; ++j) { const float x = L[gs * 8 + j]; if (j != i0 && x > v1) { v1 = x; i1 = j; } }
            const float e1 = __expf(v1 - v0), g0 = gprob / (1.f + e1), g1 = gprob * e1 / (1.f + e1);
            const int ea = gs * 8 + i0, eb = gs * 8 + i1;
            const int sa = atomicAdd(&p.cnt[l * 32 + ea], 1), sb = atomicAdd(&p.cnt[l * 32 + eb], 1);
            p.tokl[ea * ECAP + sa] = tok; p.gatel[ea * ECAP + sa] = g0; p.tokl[eb * ECAP + sb] = tok; p.gatel[eb * ECAP + sb] = g1;
            p.asg[tok * 2] = (ea << 14) | sa; p.asg[tok * 2 + 1] = (eb << 14) | sb;
        }
        }
        __syncthreads();
        if constexpr (NORM) {
            const float* md = p.mod + (lmod * 4 + b) * 6144;
            f32x4 g4[8], sc[8], sh[8];
#pragma unroll
            for (int i = 0; i < 8; ++i) { const int col = i * 256 + lane * 4; g4[i] = *(const f32x4*)(gain + col); sc[i] = 1.f + *(const f32x4*)(md + 2048 + col); sh[i] = *(const f32x4*)(md + col); g4[i] *= sc[i]; }
#pragma unroll 2
            for (int j = 0; j < 8; ++j) { const int row = row0 + kh * 8 + j; const float rs = rsl[kh * 8 + j];
#pragma unroll
                for (int i = 0; i < 8; ++i) { const int col = i * 256 + lane * 4; const uint2 ar = *(const uint2*)(p.XA + (size_t)row * DM + col); const f32x4 v = {bflo(ar.x), bfhi(ar.x), bflo(ar.y), bfhi(ar.y)};
                    const f32x4 h = v * rs * g4[i] + sh[i];
                    *(unsigned*)((unsigned char*)p.H + (size_t)row * DM + col) = pk4_fp8(h[0], h[1], h[2], h[3], A8_SCALE); } }
            __syncthreads();
        }
    }
}
DI void conv_gln(const Params& p, LAS unsigned char* lds) {
    const int tid = opaque_tid(), wave = tid >> 6, lane = tid & 63;
    LAS float* at = (LAS float*)lds;
    u32x4 rv[3], rg[3];
    auto load_raw = [&](int u) { const int g = u & 7, t0 = ((u >> 3) & 63) * 64, b = u >> 9;
#pragma unroll
        for (int i = 0; i < 3; ++i) { const int idx = tid + 512 * i, rr = idx >> 4, c8 = idx & 15, t = t0 - 15 + rr; rv[i] = (u32x4){0u, 0u, 0u, 0u}; rg[i] = (u32x4){0u, 0u, 0u, 0u};
            if (idx < 94 * 16 && t >= 0 && t < SEQ) { const bf16_t* row = p.G + (size_t)(b * SEQ + t) * N_IN0 + g * 128 + c8 * 8; rv[i] = *(const u32x4*)row; rg[i] = *(const u32x4*)(row + 1024); } } };
    int gcur = -1; f32x2 wk[31], bias = {0.f, 0.f}, gam = {0.f, 0.f}, bet = {0.f, 0.f};
    if ((int)blockIdx.x < 2048) load_raw(blockIdx.x);
    for (int u = blockIdx.x; u < 2048; u += gridDim.x) {
        const int g = u & 7, t0 = ((u >> 3) & 63) * 64, b = u >> 9;
        const int ch = g * 128 + 2 * lane;
        if (g != gcur) { gcur = g;
#pragma unroll
            for (int k = 0; k < 31; ++k) wk[k] = *(const f32x2*)(p.conv_w + k * 1024 + ch);
            bias = *(const f32x2*)(p.conv_b + ch); gam = *(const f32x2*)(p.conv_norm_g + ch); bet = *(const f32x2*)(p.conv_norm_b + ch); }
#pragma unroll
        for (int i = 0; i < 3; ++i) { const int idx = tid + 512 * i, rr = idx >> 4, c8 = idx & 15;
            if (idx < 94 * 16) { const u32x4 v = rv[i], gg = rg[i];
                const f32x4 lo = {bflo(v[0]) * sigmoidf_(bflo(gg[0])), bfhi(v[0]) * sigmoidf_(bfhi(gg[0])), bflo(v[1]) * sigmoidf_(bflo(gg[1])), bfhi(v[1]) * sigmoidf_(bfhi(gg[1]))};
                const f32x4 hi = {bflo(v[2]) * sigmoidf_(bflo(gg[2])), bfhi(v[2]) * sigmoidf_(bfhi(gg[2])), bflo(v[3]) * sigmoidf_(bflo(gg[3])), bfhi(v[3]) * sigmoidf_(bfhi(gg[3]))};
                *(LAS f32x4*)(at + rr * 132 + c8 * 8) = lo; *(LAS f32x4*)(at + rr * 132 + c8 * 8 + 4) = hi; } }
        __syncthreads();
        if (u + (int)gridDim.x < 2048) load_raw(u + gridDim.x);
        f32x2 acc[8];
#pragma unroll
        for (int j = 0; j < 8; ++j) acc[j] = bias;
#pragma unroll
        for (int rr = 0; rr < 38; ++rr) { const f32x2 a2 = *(const LAS f32x2*)(at + (wave * 8 + rr) * 132 + 2 * lane);
#pragma unroll
            for (int j = 0; j < 8; ++j) { const int k = rr - j; if (k >= 0 && k < 31) acc[j] += wk[k] * a2; } }
#pragma unroll
        for (int j = 0; j < 8; ++j) { const float mu = wave_sum(acc[j][0] + acc[j][1]) * (1.f / 128.f); const float d0 = acc[j][0] - mu, d1 = acc[j][1] - mu;
            const float var = wave_sum(d0 * d0 + d1 * d1) * (1.f / 128.f); const float rs = rsqrtf(var + 1e-6f);
            const float y0 = d0 * rs * gam[0] + bet[0], y1 = d1 * rs * gam[1] + bet[1];
            if constexpr (D8_OUT0) *(unsigned short*)((unsigned char*)p.AO + (size_t)(b * SEQ + t0 + wave * 8 + j) * DM + ch) = (unsigned short)(pk4_fp8(siluf_(y0), siluf_(y1), 0.f, 0.f, A8_SCALE) & 0xffffu);
            else *(unsigned*)(p.AO + (size_t)(b * SEQ + t0 + wave * 8 + j) * DM + ch) = pk2(siluf_(y0), siluf_(y1)); }
        __syncthreads();
    }
}
DI unsigned off_b(unsigned row, unsigned ch) { return 256u * row + 16u * (ch ^ (((row & 3u) << 2) | ((row >> 2) & 3u))); }
DI void tr_read4(unsigned a0, unsigned a1, s16x4& r00, s16x4& r01, s16x4& r10, s16x4& r11) {
    asm volatile("ds_read_b64_tr_b16 %0, %4\n\tds_read_b64_tr_b16 %1, %5\n\tds_read_b64_tr_b16 %2, %4 offset:4096\n\tds_read_b64_tr_b16 %3, %5 offset:4096\n\ts_waitcnt lgkmcnt(0)"
                 : "=&v"(r00), "=&v"(r01), "=&v"(r10), "=&v"(r11) : "v"(a0), "v"(a1) : "memory");
}
template <int PASS> DI void attn_wave(const Params& p, LAS unsigned char* vimg, unsigned vb0, unsigned vb1, int lane_, int b, int h, int qbase  ) {
    int lane = lane_; asm volatile("" : "+v"(lane));
    const int c = lane & 31, hh = lane >> 5, srow = lane >> 4, sch = lane & 15;
    constexpr int QS = PASS == 0 ? 16 : 1, NT = PASS == 0 ? 13 : 5;
    const int tq = qbase + QS * c;
    const bf16_t* gb = p.G + (size_t)(b * SEQ) * N_IN0; const bf16_t* kb = p.KVH + (size_t)((b * 8 + h) * 2) * SEQ * 128;
    bf16_t* st_o = p.YB + ((size_t)(b * 8 + h) * SEQ + tq) * 128;
    float* st_ml = (float*)(p.YB + (size_t)NBATCH * 8 * SEQ * 128) + ((size_t)(b * 8 + h) * SEQ + tq) * 2;
    bf16x8 qf[8];
#pragma unroll
    for (int ks = 0; ks < 8; ++ks) qf[ks] = *(const bf16x8*)(gb + (size_t)tq * N_IN0 + 2048 + h * 128 + 16 * ks + 8 * hh);
    const float sc2 = 0.08838834764831845f * 1.4426950408889634f, sl2 = exp2f(-(float)(h + 1)) * 1.4426950408889634f;
    f32x16 o[4]; float m_run, l_run;
    if constexpr (PASS == 0) {
#pragma unroll
        for (int i = 0; i < 4; ++i)
#pragma unroll
            for (int j = 0; j < 16; ++j) o[i][j] = 0.f;
        m_run = -30000.f; l_run = 0.f;
    } else {
#pragma unroll
        for (int c4 = 0; c4 < 4; ++c4)
#pragma unroll
            for (int g4 = 0; g4 < 4; ++g4) { const uint2 v = *(const uint2*)(st_o + 32 * c4 + 8 * g4 + 4 * hh); o[c4][4 * g4] = bflo(v.x); o[c4][4 * g4 + 1] = bfhi(v.x); o[c4][4 * g4 + 2] = bflo(v.y); o[c4][4 * g4 + 3] = bfhi(v.y); }
        const f32x2 ml = *(const f32x2*)st_ml; m_run = ml[0]; l_run = hh == 0 ? ml[1] : 0.f;
    }
    auto tile_geom = [&](int tile, int& d, int& sb) { if constexpr (PASS == 0) { if (tile < 5) { d = 16; sb = qbase - 1024 + 512 * tile; } else { d = 4; sb = qbase - 256 + 128 * (tile - 5); } } else { d = 1; sb = qbase - 64 + 32 * tile; } };
    auto load_k = [&](int tile, bf16x8 (&kf)[8]) { int d, sb; tile_geom(tile, d, sb); int sp = sb + d * c; sp = sp < 0 ? 0 : (sp >= SEQ ? SEQ - 1 : sp);
        const bf16_t* src = kb + (unsigned)(sp * 128 + 8 * hh);
#pragma unroll
        for (int ks = 0; ks < 8; ++ks) kf[ks] = *(const bf16x8*)(src + 16 * ks); };
    auto load_v = [&](int tile, u32x4 (&vv)[8]) { int d, sb; tile_geom(tile, d, sb);
#pragma unroll
        for (int i = 0; i < 8; ++i) { int sp = sb + d * (srow + 4 * i); sp = sp < 0 ? 0 : (sp >= SEQ ? SEQ - 1 : sp); vv[i] = *(const u32x4*)(kb + (unsigned)(SEQ * 128 + sp * 128 + sch * 8)); } };
    bf16x8 kf[8]; u32x4 vv[8];
    load_k(0, kf); load_v(0, vv);
    for (int tile = 0; tile < NT; ++tile) {
        int d, sb; tile_geom(tile, d, sb);
        const int tn = tile < NT - 1 ? tile + 1 : NT - 1;
#pragma unroll
        for (int i = 0; i < 8; ++i) *(LAS u32x4*)(vimg + off_b(srow + 4 * i, sch)) = vv[i];
        load_v(tn, vv);
        f32x16 sacc;
#pragma unroll
        for (int j = 0; j < 16; ++j) sacc[j] = 0.f;
#pragma unroll
        for (int ks = 0; ks < 8; ++ks) sacc = __builtin_amdgcn_mfma_f32_32x32x16_bf16(kf[ks], qf[ks], sacc, 0, 0, 0);
        load_k(tn, kf);
        const float df = (float)d, basef = (float)(sb - tq) + df * (float)(4 * hh);
        const float lo = fmaxf(-64.f * df, -(float)tq), hi = fminf(64.f * df, (float)(SEQ - 1 - tq));
        const float mid = 0.5f * (lo + hi), half = 0.5f * (hi - lo);
        float tmax = -1e30f;
#pragma unroll
        for (int i = 0; i < 16; ++i) { const float deltaf = basef + df * (float)((i & 3) + 8 * (i >> 2));
            const bool valid = __builtin_fabsf(deltaf - mid) <= half;
            const float sv = valid ? sacc[i] * sc2 - sl2 * __builtin_fabsf(deltaf) : -1e30f; sacc[i] = sv; tmax = fmaxf(tmax, sv); }
        tmax = fmaxf(tmax, __shfl_xor(tmax, 32));
        const float m_new = tmax > m_run + 8.0f ? tmax : m_run;
        if (__any(m_new != m_run)) { const float alpha = __builtin_amdgcn_exp2f(m_run - m_new);
            l_run *= alpha;
#pragma unroll
            for (int i = 0; i < 4; ++i) o[i] *= alpha; }
        m_run = m_new;
        float psum = 0.f;
#pragma unroll
        for (int i = 0; i < 16; ++i) { const float pi = __builtin_amdgcn_exp2f(sacc[i] - m_new); psum += pi; sacc[i] = pi; }
        l_run += psum;
        bf16x8 pf[2];
#pragma unroll
        for (int s = 0; s < 2; ++s) { const unsigned w0 = pk2(sacc[8 * s], sacc[8 * s + 1]), w1 = pk2(sacc[8 * s + 2], sacc[8 * s + 3]), w2 = pk2(sacc[8 * s + 4], sacc[8 * s + 5]), w3 = pk2(sacc[8 * s + 6], sacc[8 * s + 7]);
            pf[s] = __builtin_bit_cast(bf16x8, (u32x4){w0, w1, w2, w3}); }
#pragma unroll
        for (int c4 = 0; c4 < 4; ++c4) {
            s16x4 r00, r01, r10, r11; tr_read4(vb0 ^ (unsigned)(c4 << 6), vb1 ^ (unsigned)(c4 << 6), r00, r01, r10, r11);
            const bf16x8 v0 = __builtin_shufflevector(r00, r01, 0, 1, 2, 3, 4, 5, 6, 7), v1 = __builtin_shufflevector(r10, r11, 0, 1, 2, 3, 4, 5, 6, 7);
            o[c4] = __builtin_amdgcn_mfma_f32_32x32x16_bf16(v0, pf[0], o[c4], 0, 0, 0);
            o[c4] = __builtin_amdgcn_mfma_f32_32x32x16_bf16(v1, pf[1], o[c4], 0, 0, 0); }
    }
    const float ltot = l_run + __shfl_xor(l_run, 32);
    if constexpr (PASS == 0) {
#pragma unroll
        for (int c4 = 0; c4 < 4; ++c4)
#pragma unroll
            for (int g4 = 0; g4 < 4; ++g4) *(uint2*)(st_o + 32 * c4 + 8 * g4 + 4 * hh) = make_uint2(pk2(o[c4][4 * g4], o[c4][4 * g4 + 1]), pk2(o[c4][4 * g4 + 2], o[c4][4 * g4 + 3]));
        if (hh == 0) *(f32x2*)st_ml = (f32x2){m_run, ltot};
    } else {
        const float inv = 1.0f / ltot;
        bf16_t* orow = p.AO + (size_t)(b * SEQ + tq) * DM + 1024 + h * 128;
#pragma unroll
        for (int c4 = 0; c4 < 4; ++c4)
#pragma unroll
            for (int g4 = 0; g4 < 4; ++g4) { const int dh = 32 * c4 + 8 * g4 + 4 * hh;
                if constexpr (D8_OUT0) *(unsigned*)((unsigned char*)p.AO + (size_t)(b * SEQ + tq) * DM + 1024 + h * 128 + dh) = pk4_fp8(o[c4][4 * g4] * inv, o[c4][4 * g4 + 1] * inv, o[c4][4 * g4 + 2] * inv, o[c4][4 * g4 + 3] * inv, A8_SCALE);
                else *(uint2*)(orow + dh) = make_uint2(pk2(o[c4][4 * g4] * inv, o[c4][4 * g4 + 1] * inv), pk2(o[c4][4 * g4 + 2] * inv, o[c4][4 * g4 + 3] * inv)); }
    }
}
DI void attention(const Params& p, LAS unsigned char* lds) {
    const int tid = opaque_tid(), wave = __builtin_amdgcn_readfirstlane(tid >> 6), lane = tid & 63, hh = lane >> 5;
    LAS unsigned char* vimg = lds + wave * 8192;
    const unsigned vbase = (unsigned)(uintptr_t)vimg;
    const int q4 = (lane & 15) >> 2, pp = lane & 3, blk = (lane >> 4) & 1;
    const unsigned vb0 = vbase + 256u * (4 * hh + q4) + 16u * ((2 * blk + (pp >> 1)) ^ (hh & 3)) + 8u * (pp & 1) + ((unsigned)q4 << 6);
    const unsigned vb1 = vbase + 256u * (8 + 4 * hh + q4) + 16u * ((2 * blk + (pp >> 1)) ^ ((2 + hh) & 3)) + 8u * (pp & 1) + ((unsigned)q4 << 6);
    for (int u = blockIdx.x; u < 256; u += gridDim.x) {
        const int bh = (u & 7) * 4 + ((u >> 3) >> 3), span = (u >> 3) & 7, h = bh & 7, b = bh >> 3;
#pragma unroll 1
        for (int j = 0; j < 2; ++j) attn_wave<0>(p, vimg, vb0, vb1, lane, b, h, span * 512 + wave * 2 + j);
        asm volatile("s_waitcnt vmcnt(0)" ::: "memory");
        __syncthreads();
#pragma unroll 1
        for (int j = 0; j < 2; ++j) attn_wave<1>(p, vimg, vb0, vb1, lane, b, h, span * 512 + (wave * 2 + j) * 32);
        __syncthreads();
    }
}
DI float om_exp2x(float la, float a) {
    const float x = 2.f * la;
    const float pl = x * (1.f + x * (0.5f + x * (0.16666667f + x * (0.041666668f + x * 0.008333334f))));
    return x > -0.25f ? -pl : 1.f - a * a;
}
DI void lru_conv(const Params& p) {
    const int tid = opaque_tid();
    if (tid < 336) {
        const int ch = tid * 8;
        float cw[4][8], cb[8];
#pragma unroll
        for (int j = 0; j < 4; ++j) { const f32x4 w0 = *(const f32x4*)(p.lru_conv_w + j * LRU_W + ch), w1 = *(const f32x4*)(p.lru_conv_w + j * LRU_W + ch + 4);
            cw[j][0] = w0[0]; cw[j][1] = w0[1]; cw[j][2] = w0[2]; cw[j][3] = w0[3]; cw[j][4] = w1[0]; cw[j][5] = w1[1]; cw[j][6] = w1[2]; cw[j][7] = w1[3]; }
        { const f32x4 b0 = *(const f32x4*)(p.lru_conv_b + ch), b1 = *(const f32x4*)(p.lru_conv_b + ch + 4); cb[0] = b0[0]; cb[1] = b0[1]; cb[2] = b0[2]; cb[3] = b0[3]; cb[4] = b1[0]; cb[5] = b1[1]; cb[6] = b1[2]; cb[7] = b1[3]; }
        for (int run = blockIdx.x; run < T_TOK / 32; run += gridDim.x) {
            const int tok0 = run * 32, t0 = tok0 % SEQ;
            const bf16_t* src = p.G + (size_t)tok0 * N_IN1 + LRU_W + ch;
            u32x4 rows[35];
#pragma unroll
            for (int i = 0; i < 35; ++i) { const int t = t0 - 2 + i; rows[i] = (t >= 0 && t < SEQ) ? *(const u32x4*)(src + (ptrdiff_t)(i - 2) * N_IN1) : (u32x4){0u, 0u, 0u, 0u}; }
#pragma unroll
            for (int i = 0; i < 32; ++i) { float xc[8];
#pragma unroll
                for (int e = 0; e < 8; ++e) xc[e] = cb[e];
#pragma unroll
                for (int j = 0; j < 4; ++j) { const u32x4 xv = rows[i + j];
                    xc[0] += cw[j][0] * bflo(xv[0]); xc[1] += cw[j][1] * bfhi(xv[0]); xc[2] += cw[j][2] * bflo(xv[1]); xc[3] += cw[j][3] * bfhi(xv[1]);
                    xc[4] += cw[j][4] * bflo(xv[2]); xc[5] += cw[j][5] * bfhi(xv[2]); xc[6] += cw[j][6] * bflo(xv[3]); xc[7] += cw[j][7] * bfhi(xv[3]); }
                *(u32x4*)(p.XC + (size_t)(tok0 + i) * LRU_W + ch) = (u32x4){pk2(xc[0], xc[1]), pk2(xc[2], xc[3]), pk2(xc[4], xc[5]), pk2(xc[6], xc[7])}; }
        }
    }
}
DI void lru(const Params& p, LAS unsigned char* lds) {
    const int tid = opaque_tid(), wave = __builtin_amdgcn_readfirstlane(tid >> 6), lane = tid & 63, col = lane & 15, g = lane >> 4;
    LAS unsigned char* wl = lds;
    LAS unsigned char* xs = lds + 36864;
    LAS float* sums = (LAS float*)(lds + 36864 + 86016);
    LAS float* cst = sums + 1536;
    for (int u = blockIdx.x; u < 256; u += gridDim.x) {
        const int b = u >> 6, n = (u >> 2) & 15, qt = u & 3, chq = n * LRU_BW + qt * 42;
        const char* xcb = (const char*)(p.XC + (size_t)(b * SEQ) * LRU_W + n * LRU_BW);
        const bf16_t* gb = p.G + (size_t)(b * SEQ) * N_IN1;
        unsigned poff[6];
#pragma unroll
        for (int i = 0; i < 6; ++i) { const int idx = tid + 512 * i; poff[i] = (unsigned)((idx / 21) * LRU_W + (idx % 21) * 8) * 2u; }
        auto dma_chunk = [&](int chunk, int bsel) { const char* src = xcb + (size_t)chunk * 128 * LRU_W * 2; LAS unsigned char* dst = xs + bsel * 43008 + wave * 1024;
#pragma unroll
            for (int i = 0; i < 5; ++i) __builtin_amdgcn_global_load_lds((const unsigned*)(src + poff[i]), (LAS unsigned*)(dst + i * 8192), 16, 0, 0);
            if (wave < 2) __builtin_amdgcn_global_load_lds((const unsigned*)(src + poff[5]), (LAS unsigned*)(dst + 5 * 8192), 16, 0, 0); };
        for (int dir = 0; dir < 2; ++dir) {
            __syncthreads();
            for (int i = tid; i < 2 * 48 * 24; i += 512) { const int which = i / (48 * 24), r = (i / 24) % 48, ck = i % 24; const int nt = r >> 4, cl = r & 15, ks = ck >> 2, gg = ck & 3;
                *(LAS u32x4*)(wl + ((which * 3 + nt) * 6 + ks) * 1024 + (gg * 16 + cl) * 16) = *(const u32x4*)(p.w_lru + ((((size_t)(dir * 2 + which) * 16 + n) * 4 + qt) * 48 + r) * 192 + ck * 8); }
            if (tid < 48) { const bool valid = tid < 42; const int ch = dir * LRU_W + chq + tid;
                cst[tid] = valid ? -1.44269504f * p.lru_b_a[ch] : 0.f; cst[48 + tid] = valid ? -1.44269504f * p.lru_b_x[ch] : 0.f;
                const float lam = valid ? p.lru_lambda[ch] : 0.f; const float sp = (-lam > 20.f) ? -lam : log1pf(__expf(-lam)); cst[96 + tid] = -8.0f * 1.44269504f * sp; }
            dma_chunk(dir == 0 ? 0 : 31, 0);
            asm volatile("s_waitcnt vmcnt(0)" ::: "memory");
            __syncthreads();
            float cba[3], cbx[3], cex[3];
#pragma unroll
            for (int nt = 0; nt < 3; ++nt) { cba[nt] = cst[nt * 16 + col]; cbx[nt] = cst[48 + nt * 16 + col]; cex[nt] = cst[96 + nt * 16 + col]; }
            bf16x8 breg[3][6];
#pragma unroll
            for (int nt = 0; nt < 3; ++nt)
#pragma unroll
                for (int ks = 0; ks < 6; ++ks) { breg[nt][ks] = *(const LAS bf16x8*)(wl + (nt * 6 + ks) * 1024 + lane * 16); asm volatile("" : "+v"(breg[nt][ks])); }
            float carry[3] = {0.f, 0.f, 0.f};
            for (int step = 0; step < 32; ++step) {
                const int c = dir == 0 ? step : 31 - step, c0 = c * 128, par = step & 1;
                const bool has_next = step < 31;
                if (has_next) dma_chunk(dir == 0 ? c + 1 : c - 1, par ^ 1);
                LAS unsigned char* xb = xs + par * 43008;
                uint2 hfv[3] = {make_uint2(0u, 0u), make_uint2(0u, 0u), make_uint2(0u, 0u)}; unsigned short gtv[3][4];
                const uint2* hfp = (const uint2*)p.HF + ((size_t)((u * 32 + c) * 8 + wave) * 3) * 64 + lane;
                const bf16_t* gbw = gb + (size_t)(c0 + wave * 16) * N_IN1 + chq;
                bf16_t* aow = p.AO + (size_t)(b * SEQ + c0 + wave * 16) * LRU_W + chq;
                if (dir == 1) {
#pragma unroll
                    for (int nt = 0; nt < 3; ++nt) { hfv[nt] = hfp[nt * 64];
#pragma unroll
                        for (int r = 0; r < 4; ++r) gtv[nt][r] = (nt * 16 + col < 42) ? gbw[(unsigned)((4 * g + r) * N_IN1 + nt * 16 + col)] : (unsigned short)0; } }
                bf16x8 af[6];
#pragma unroll
                for (int ks = 0; ks < 6; ++ks) { const int ch0 = 32 * ks + 8 * g; const bool kval = ch0 < LRU_BW; const int chl0 = kval ? ch0 : 160;
                    const u32x4 xv = *(const LAS u32x4*)(xb + (wave * 16 + col) * 336 + chl0 * 2);
                    af[ks] = __builtin_bit_cast(bf16x8, kval ? xv : (u32x4){0u, 0u, 0u, 0u}); }
                f32x4 acc[2][3];
#pragma unroll
                for (int w2 = 0; w2 < 2; ++w2)
#pragma unroll
                    for (int nt = 0; nt < 3; ++nt) { acc[w2][nt] = (f32x4){0.f, 0.f, 0.f, 0.f};
#pragma unroll
                        for (int ks = 0; ks < 6; ++ks) { const bf16x8 bfr = w2 == 0 ? breg[nt][ks] : *(const LAS bf16x8*)(wl + ((w2 * 3 + nt) * 6 + ks) * 1024 + lane * 16);
                            acc[w2][nt] = __builtin_amdgcn_mfma_f32_16x16x32_bf16(af[ks], bfr, acc[w2][nt], 0, 0, 0); } }
                float hl[3][4], Pl[3][4];
#pragma unroll
                for (int nt = 0; nt < 3; ++nt) { const int chl = nt * 16 + col;
                    float av[4], uv[4];
#pragma unroll
                    for (int r = 0; r < 4; ++r) {
                        const float rg = __builtin_amdgcn_rcpf(1.0f + __builtin_amdgcn_exp2f(__builtin_fmaf(acc[0][nt][r], -1.44269504f, cba[nt])));
                        const float ig = __builtin_amdgcn_rcpf(1.0f + __builtin_amdgcn_exp2f(__builtin_fmaf(acc[1][nt][r], -1.44269504f, cbx[nt])));
                        const float a = __builtin_amdgcn_exp2f(cex[nt] * rg);
                        const float xcv = bf2f(*(const LAS bf16_t*)(xb + (wave * 16 + 4 * g + r) * 336 + (qt * 42 + chl) * 2));
                        av[r] = a; uv[r] = __builtin_amdgcn_sqrtf(__builtin_fmaf(-a, a, 1.0f)) * (ig * xcv); }
                    float h[4], P[4], A, H;
                    if (dir == 0) { h[0] = uv[0]; P[0] = av[0];
#pragma unroll
                        for (int r = 1; r < 4; ++r) { h[r] = av[r] * h[r - 1] + uv[r]; P[r] = av[r] * P[r - 1]; }
                        A = P[3]; H = h[3];
                        { const float A1 = __shfl_up(A, 16), H1 = __shfl_up(H, 16); if (g >= 1) { H = A * H1 + H; A = A * A1; } }
                        { const float A2 = __shfl_up(A, 32), H2 = __shfl_up(H, 32); if (g >= 2) { H = A * H2 + H; A = A * A2; } }
                        float Ae = __shfl_up(A, 16), He = __shfl_up(H, 16); if (g == 0) { Ae = 1.f; He = 0.f; }
                        const float At = __shfl(A, 48 + col), Ht = __shfl(H, 48 + col);
#pragma unroll
                        for (int r = 0; r < 4; ++r) { hl[nt][r] = h[r] + P[r] * He; Pl[nt][r] = P[r] * Ae; }
                        if (g == 3) *(LAS f32x2*)(sums + ((par * 8 + wave) * 48 + chl) * 2) = (f32x2){At, Ht};
                    } else { h[3] = uv[3]; P[3] = av[3];
#pragma unroll
                        for (int r = 2; r >= 0; --r) { h[r] = av[r] * h[r + 1] + uv[r]; P[r] = av[r] * P[r + 1]; }
                        A = P[0]; H = h[0];
                        { const float A1 = __shfl_down(A, 16), H1 = __shfl_down(H, 16); if (g <= 2) { H = A * H1 + H; A = A * A1; } }
                        { const float A2 = __shfl_down(A, 32), H2 = __shfl_down(H, 32); if (g <= 1) { H = A * H2 + H; A = A * A2; } }
                        float Ae = __shfl_down(A, 16), He = __shfl_down(H, 16); if (g == 3) { Ae = 1.f; He = 0.f; }
                        const float At = __shfl(A, col), Ht = __shfl(H, col);
#pragma unroll
                        for (int r = 0; r < 4; ++r) { hl[nt][r] = h[r] + P[r] * He; Pl[nt][r] = P[r] * Ae; }
                        if (g == 0) *(LAS f32x2*)(sums + ((par * 8 + wave) * 48 + chl) * 2) = (f32x2){At, Ht};
                    }
                }
                asm volatile("s_waitcnt vmcnt(0)" ::: "memory");
                __syncthreads();
#pragma unroll
                for (int nt = 0; nt < 3; ++nt) { const int chl = nt * 16 + col; float C = carry[nt], Cw = 0.f;
#pragma unroll
                    for (int k = 0; k < 8; ++k) { const int w2 = dir == 0 ? k : 7 - k; const f32x2 sv = *(const LAS f32x2*)(sums + ((par * 8 + w2) * 48 + chl) * 2);
                        if (w2 == wave) Cw = C; C = sv[0] * C + sv[1]; }
                    carry[nt] = C;
                    float hv[4];
#pragma unroll
                    for (int r = 0; r < 4; ++r) hv[r] = hl[nt][r] + Pl[nt][r] * Cw;
                    if (dir == 0) ((uint2*)p.HF)[((size_t)((u * 32 + c) * 8 + wave) * 3 + nt) * 64 + lane] = make_uint2(pk2(hv[0], hv[1]), pk2(hv[2], hv[3]));
                    else if (chl < 42) { const float ff[4] = {bflo(hfv[nt].x), bfhi(hfv[nt].x), bflo(hfv[nt].y), bfhi(hfv[nt].y)};
#pragma unroll
                        for (int r = 0; r < 4; ++r) aow[(unsigned)((4 * g + r) * LRU_W + chl)] = f2bf(bf2f(gtv[nt][r]) * (ff[r] + hv[r])); }
                }
            }
        }
    }
}
}

#define XB_TMO      128
#define XB_XCNT(j)  (256  + 64 * (j))
#define XB_XSUB(j)  (1280 + 64 * (j))
#define XB_XGEN(j)  (2304 + 64 * (j))
#define XB_TOP      3328
#define XB_TOPGEN   3392
#define XCD_BAR_WORDS 3456
#define XB_SPIN_CAP (1u << 18)

__device__ __forceinline__ unsigned xb_ld(unsigned* p)              { return __hip_atomic_load(p, __ATOMIC_RELAXED, __HIP_MEMORY_SCOPE_AGENT); }
__device__ __forceinline__ unsigned xb_add(unsigned* p, unsigned v) { return __hip_atomic_fetch_add(p, v, __ATOMIC_RELAXED, __HIP_MEMORY_SCOPE_AGENT); }
__device__ __forceinline__ unsigned xb_xcc_id() { return (unsigned)__builtin_amdgcn_s_getreg((3 << 11) | 20) & 0xFu; }
#define XB_SPIN(cond, bar) do { unsigned _sp = 0; while (cond) { __builtin_amdgcn_s_sleep(1); \
    if ((++_sp & 255u) == 0u) { if (xb_ld(&(bar)[XB_TMO])) break; if (_sp > XB_SPIN_CAP) { atomicAdd(&(bar)[XB_TMO], 1u); break; } } } } while (0)

struct XcdBarrier {
    unsigned* bar; unsigned x;
    volatile LAS unsigned* st;
};

__device__ __forceinline__ XcdBarrier xcd_barrier_post(unsigned* bar, volatile LAS unsigned* st) {
    XcdBarrier b; b.bar = bar; b.x = xb_xcc_id(); b.st = st;
    if (threadIdx.x == 0) (void)xb_add(&bar[XB_XCNT(b.x)], 1u);
    return b;
}
__device__ __forceinline__ void xcd_barrier_complete(unsigned* bar, unsigned x, unsigned& nloc, unsigned& nx) {
    const unsigned G = gridDim.x * gridDim.y * gridDim.z;
    unsigned sum, cnt, mine, sp = 0u;
    for (;;) {
        sum = 0u; cnt = 0u; mine = 0u;
#pragma unroll
        for (unsigned j = 0; j < 16; ++j) { const unsigned c = xb_ld(&bar[XB_XCNT(j)]); sum += c; cnt += (c > 0u) ? 1u : 0u; mine = (j == x) ? c : mine; }
        if (sum == G) break;
        __builtin_amdgcn_s_sleep(1);
        if ((++sp & 255u) == 0u) { if (xb_ld(&bar[XB_TMO])) break; if (sp > XB_SPIN_CAP) { atomicAdd(&bar[XB_TMO], 1u); break; } }
    }
    nloc = mine > 0u ? mine : 1u; nx = cnt > 0u ? cnt : 1u;
}

__device__ __forceinline__ void xcd_barrier(const XcdBarrier& b) {
    asm volatile("s_waitcnt vmcnt(0)" ::: "memory");
    __syncthreads();
    if (threadIdx.x == 0) {
        unsigned* bar = b.bar;
        __builtin_amdgcn_s_waitcnt(0);
        unsigned nloc = b.st[0], nx = b.st[1];
        if (nloc == 0u) { xcd_barrier_complete(bar, b.x, nloc, nx); b.st[0] = nloc; b.st[1] = nx; }
        const unsigned old = xb_add(&bar[XB_XSUB(b.x)], 1u);
        const unsigned gen = old / nloc;
        if (old + 1u == (gen + 1u) * nloc) {
            __builtin_amdgcn_fence(__ATOMIC_RELEASE, "agent");
            asm volatile("s_waitcnt vmcnt(0)" ::: "memory");
            const unsigned og = xb_add(&bar[XB_TOP], 1u);
            const unsigned tg = og / nx;
            if (og + 1u == (tg + 1u) * nx) xb_add(&bar[XB_TOPGEN], 1u);
            else XB_SPIN(xb_ld(&bar[XB_TOPGEN]) == tg, bar);
            __builtin_amdgcn_fence(__ATOMIC_ACQUIRE, "agent");
            xb_add(&bar[XB_XGEN(b.x)], 1u);
            asm volatile("s_waitcnt vmcnt(0)" ::: "memory");
        } else {
            XB_SPIN(xb_ld(&bar[XB_XGEN(b.x)]) == gen, bar);
            __builtin_amdgcn_fence(__ATOMIC_ACQUIRE, "agent");
            asm volatile("s_waitcnt vmcnt(0)" ::: "memory");
        }
    }
    __syncthreads();
}


constexpr int PROBE = 0;
constexpr int LDS_XB_OFF = gm::STAGE_BYTES + 1024;
constexpr int LDS_TOTAL = LDS_XB_OFF + 16;
__global__ void __launch_bounds__(512, 2) mega(Params p) {
    LAS unsigned char* lds = (LAS unsigned char*)dyn_smem;
    LAS int* tab = (LAS int*)(lds + gm::TAB_OFF);
    volatile LAS unsigned* xbw = (volatile LAS unsigned*)(lds + LDS_XB_OFF);
    if (threadIdx.x == 0) { xbw[0] = 0u; xbw[1] = 0u; xbw[2] = 0u; xbw[3] = 0u; }
    __syncthreads();
    XcdBarrier bar = xcd_barrier_post(p.bar, xbw);
    ph::mods(p, lds);
    if constexpr (PROBE == 14) { ph::mods(p, lds); ph::mods(p, lds); }
    xcd_barrier(bar);
    { const int c = blockIdx.x, G = gridDim.x;
      ph::transposer(p, lds, c, c < 320 ? (320 - c + G - 1) / G : 0, G); __syncthreads();
      ph::transposer(p, lds, 320 + c, c < 632 ? (632 - c + G - 1) / G : 0, G); __syncthreads(); }
    ph::lru_weights(p);
    ph::fold_router(p);
    ph::norm_rows<0, D8_IN0>(p, p.x, p.norm0_mix, 0, 0, nullptr);
    xcd_barrier(bar);
    { const int c = blockIdx.x, G = gridDim.x; const int tcount = c < 6144 ? (6144 - c + G - 1) / G : 0; const bool t_first = ((c >> 3) & 1) != 0;
      if (t_first) { ph::transposer(p, lds, 952 + c, tcount, G); __syncthreads(); }
      { gm::DenseSched S; S.init(T_TOK, N_IN0); EpiIn0 e; e.xin = nullptr; e.lgate = 0; if constexpr (D8_IN0) gm::gemm_phase<EpiIn0, gm::DenseSched, true>(lds, p, p.H, p.w_in0t, 0, DM / 2, S, e, W8_E8M0, A8_E8M0); else gm::gemm_phase(lds, p, p.H, p.w_in0t, 0, DM, S, e); }
      if (!t_first) { __syncthreads(); ph::transposer(p, lds, 952 + c, tcount, G); }
      if constexpr (PROBE == 21) { __syncthreads(); ph::transposer(p, lds, 952 + c, tcount, G); }
      if constexpr (PROBE == 24) { __syncthreads(); if (t_first) ph::transposer(p, lds, 952 + c, tcount, G); }
      if constexpr (PROBE == 23) { __syncthreads(); if (t_first) { ph::transposer(p, lds, 952 + c, tcount, G); __syncthreads(); }
        { gm::DenseSched S; S.init(T_TOK, N_IN0); EpiIn0 e; e.xin = nullptr; e.lgate = 0; gm::gemm_phase<EpiIn0, gm::DenseSched, true>(lds, p, p.H, p.w_in0t, 0, DM / 2, S, e, W8_E8M0, A8_E8M0); }
        if (!t_first) { __syncthreads(); ph::transposer(p, lds, 952 + c, tcount, G); } }
      if constexpr (PROBE == 20) { __syncthreads(); gm::DenseSched S; S.init(T_TOK, N_IN0); EpiIn0 e; e.xin = nullptr; e.lgate = 0; gm::gemm_phase<EpiIn0, gm::DenseSched, true>(lds, p, p.H, p.w_in0t, 0, DM / 2, S, e, W8_E8M0, A8_E8M0); } }
    xcd_barrier(bar);
    ph::attention(p, lds);
    if constexpr (PROBE == 4) ph::attention(p, lds);
    __syncthreads();
    ph::conv_gln(p, lds);
    if constexpr (PROBE == 5) ph::conv_gln(p, lds);
    xcd_barrier(bar);
    { gm::DenseSched S; S.init(T_TOK, DM); EpiOut e; e.xin = p.x; e.lgate = 0; if constexpr (D8_OUT0) gm::gemm_phase<EpiOut, gm::DenseSched, true>(lds, p, p.AO, p.w_out0t, 0, DM / 2, S, e, W8_E8M0, A8_E8M0); else gm::gemm_phase(lds, p, p.AO, p.w_out0t, 0, DM, S, e); }
    xcd_barrier(bar);
    ph::router<false, true>(p, 0, lds, p.norm0_ffn, 1);
    if constexpr (PROBE == 12) { ph::router<true>(p, 0, lds); ph::router<true>(p, 0, lds); }
    xcd_barrier(bar);
    if constexpr (PROBE == 11) { xcd_barrier(bar); xcd_barrier(bar); xcd_barrier(bar); xcd_barrier(bar); xcd_barrier(bar); xcd_barrier(bar); xcd_barrier(bar); xcd_barrier(bar); xcd_barrier(bar); xcd_barrier(bar); }
    gm::moe_tables(tab, p.cnt);
    { gm::MoeSched<true> S; S.init(tab); EpiGU e; e.xin = nullptr; e.lgate = 0; gm::gemm_phase<EpiGU, gm::MoeSched<true>, true>(lds, p, p.H, p.w_gut0, (size_t)2048 * (DM / 2), DM / 2, S, e, W8_E8M0, A8_E8M0); if constexpr (PROBE == 3) gm::gemm_phase<EpiGU, gm::MoeSched<true>, true>(lds, p, p.H, p.w_gut0, (size_t)2048 * (DM / 2), DM / 2, S, e, W8_E8M0, A8_E8M0); }
    xcd_barrier(bar);
    { gm::MoeSched<false> S; S.init(tab); EpiDown e; e.xin = nullptr; e.lgate = 0; gm::gemm_phase<EpiDown, gm::MoeSched<false>, true>(lds, p, p.ACT, p.w_dt0, (size_t)DM * (EFF / 2), EFF / 2, S, e, W8_E8M0, A8_E8M0); if constexpr (PROBE == 8) gm::gemm_phase<EpiDown, gm::MoeSched<false>, true>(lds, p, p.ACT, p.w_dt0, (size_t)DM * (EFF / 2), EFF / 2, S, e, W8_E8M0, A8_E8M0); }
    xcd_barrier(bar);
    ph::norm_rows<1, D8_IN1>(p, nullptr, p.norm1_mix, 2, 1, tab);
    xcd_barrier(bar);
    { const int c = blockIdx.x, G = gridDim.x; int tfirst, tcount, tstride;
      if (G == 256) { tstride = 1; if (c < 64) { tcount = 18; tfirst = 18 * c; } else { tcount = 26; tfirst = 1152 + 26 * (c - 64); } }
      else { tstride = G; tfirst = c; tcount = c < 6144 ? (6144 - c + G - 1) / G : 0; }
      const bool t_first = ((c >> 3) & 1) != 0;
      if (t_first) { ph::transposer(p, lds, 7096 + tfirst, tcount, tstride); __syncthreads(); }
      { gm::DenseSched S; S.init(T_TOK, N_IN1); EpiIn1 e; e.xin = nullptr; e.lgate = 0; gm::gemm_phase(lds, p, p.H, p.w_in1t, 0, DM, S, e); }
      if (!t_first) { __syncthreads(); ph::transposer(p, lds, 7096 + tfirst, tcount, tstride); } }
    xcd_barrier(bar);
    ph::lru_conv(p);
    if constexpr (PROBE == 9) { ph::lru_conv(p); ph::lru_conv(p); }
    xcd_barrier(bar);
    ph::lru(p, lds);
    if constexpr (PROBE == 6) ph::lru(p, lds);
    xcd_barrier(bar);
    { gm::DenseSched S; S.init(T_TOK, DM); EpiOut e; e.xin = nullptr; e.lgate = 2; gm::gemm_phase(lds, p, p.AO, p.w_out1t, 0, LRU_W, S, e); }
    xcd_barrier(bar);
    ph::router<false, true>(p, 1, lds, p.norm1_ffn, 3);
    xcd_barrier(bar);
    gm::moe_tables(tab, p.cnt + 32);
    { gm::MoeSched<true> S; S.init(tab); EpiGU e; e.xin = nullptr; e.lgate = 0; gm::gemm_phase<EpiGU, gm::MoeSched<true>, true>(lds, p, p.H, p.w_gut1, (size_t)2048 * (DM / 2), DM / 2, S, e, W8_E8M0, A8_E8M0); }
    xcd_barrier(bar);
    { gm::MoeSched<false> S; S.init(tab); EpiDown e; e.xin = nullptr; e.lgate = 0; gm::gemm_phase<EpiDown, gm::MoeSched<false>, true>(lds, p, p.ACT, p.w_dt1, (size_t)DM * (EFF / 2), EFF / 2, S, e, W8_E8M0, A8_E8M0); }
    xcd_barrier(bar);
    ph::norm_rows<2>(p, nullptr, p.norm_final, 0, 3, tab);
}

static inline size_t al256(size_t x) { return (x + 255) & ~(size_t)255; }

extern "C" void kernel_launch(void* const* d_in, const int* in_sizes, int n_in, void* d_out, int out_size, void* d_ws, size_t ws_size, hipStream_t stream) {
    Params p{};
    const float** ip = (const float**)&p.x;
    for (int i = 0; i < 38; ++i) ip[i] = (const float*)d_in[i];
    p.out = (float*)d_out;
    char* w = (char*)d_ws; size_t off = 0;
    auto take = [&](size_t bytes) { char* r = w + off; off += al256(bytes); return r; };
    p.bar = (unsigned*)take(16384); p.cnt = (int*)take(256);
    const size_t zero_bytes = off;
    p.mod = (float*)take(4 * 4 * 6144 * 4); p.wrt = (float*)take((size_t)2 * 4 * 48 * 2048 * 4); p.rbias = (float*)take(2 * 4 * 48 * 4);
    p.w_in0t = (bf16_t*)take((size_t)N_IN0 * DM * 2); p.w_out0t = (bf16_t*)take((size_t)DM * DM * 2);
    p.w_gut0 = (bf16_t*)take((size_t)NEXP * 2048 * DM); p.w_dt0 = (bf16_t*)take((size_t)NEXP * DM * EFF);
    p.w_in1t = (bf16_t*)take((size_t)N_IN1 * DM * 2); p.w_out1t = (bf16_t*)take((size_t)DM * LRU_W * 2);
    p.w_gut1 = (bf16_t*)take((size_t)NEXP * 2048 * DM); p.w_dt1 = (bf16_t*)take((size_t)NEXP * DM * EFF);
    p.w_lru = (bf16_t*)take((size_t)2 * 2 * 16 * 2 * 96 * 192 * 2);
    p.H = (bf16_t*)take((size_t)T_TOK * DM * 2); p.G = (bf16_t*)take((size_t)T_TOK * N_IN1 * 2); p.AO = (bf16_t*)take((size_t)T_TOK * LRU_W * 2); p.HF = (bf16_t*)take((size_t)256 * 32 * 8 * 3 * 64 * 8);
    p.XA = (bf16_t*)take((size_t)T_TOK * DM * 2); p.ACT = (bf16_t*)take((size_t)ROWS_PAD * EFF * 2); p.YB = (bf16_t*)take((size_t)ROWS_PAD * DM * 2);
    p.XC = (bf16_t*)take((size_t)T_TOK * LRU_W * 2); p.KVH = (bf16_t*)take((size_t)NBATCH * 8 * 2 * SEQ * 128 * 2);
    p.tokl = (int*)take((size_t)NEXP * ECAP * 4); p.gatel = (float*)take((size_t)NEXP * ECAP * 4); p.asg = (int*)take((size_t)T_TOK * 2 * 4);
    if (off > ws_size) return;
    (void)hipMemsetAsync(d_ws, 0, zero_bytes, stream);
    static int grid = 0;
    if (!grid) { int dev = 0, cus = 0, per_cu = 0; (void)hipGetDevice(&dev); (void)hipDeviceGetAttribute(&cus, hipDeviceAttributeMultiprocessorCount, dev);
        (void)hipFuncSetAttribute((const void*)mega, hipFuncAttributeMaxDynamicSharedMemorySize, LDS_TOTAL);
        (void)hipOccupancyMaxActiveBlocksPerMultiprocessor(&per_cu, mega, 512, LDS_TOTAL);
        grid = cus * (per_cu < 1 ? per_cu : 1); }
    if (grid > 0) mega<<<grid, 512, LDS_TOTAL, stream>>>(p);
}
```

```cpp
#include <hip/hip_runtime.h>
#include <stdint.h>

typedef unsigned short bf16_t;
typedef float f32x4 __attribute__((ext_vector_type(4)));

#define DI __device__ __forceinline__

constexpr int T_TOK = 16384, DM = 2048, SEQ = 4096, NBATCH = 4;
constexpr int N_IN0 = 5120, N_IN1 = 5376, LRU_W = 2688, LRU_BW = 168;
constexpr int NEXP = 32, EFF = 1024, ECAP = 16384, ROWS_PAD = 40960;

DI float bf2f(bf16_t b) { return __uint_as_float(((unsigned)b) << 16); }
DI bf16_t f2bf(float f) { unsigned u = __float_as_uint(f); u += 0x7FFFu + ((u >> 16) & 1u); return (bf16_t)(u >> 16); }
DI float sigmoidf_(float x) { return __builtin_amdgcn_rcpf(1.0f + __expf(-x)); }
DI float siluf_(float x) { return x * __builtin_amdgcn_rcpf(1.0f + __expf(-x)); }
DI float gelu_tanh(float x) { const float u = 0.7978845608028654f * (x + 0.044715f * x * x * x); return x * __builtin_amdgcn_rcpf(1.0f + __expf(-2.0f * u)); }
DI float wave_sum(float v) { for (int o = 32; o > 0; o >>= 1) v += __shfl_xor(v, o); return v; }
DI float wave_max(float v) { for (int o = 32; o > 0; o >>= 1) v = fmaxf(v, __shfl_xor(v, o)); return v; }

struct Params {
    const float *x, *c;
    const float *norm0_mix, *ada0_mix_w, *ada0_mix_b, *w_in0, *conv_w, *conv_b, *conv_norm_g, *conv_norm_b, *w_out0;
    const float *norm0_ffn, *ada0_ffn_w, *ada0_ffn_b, *moe0_w_group, *moe0_w_expert, *moe0_w_gate_up, *moe0_w_down;
    const float *norm1_mix, *ada1_mix_w, *ada1_mix_b, *w_in1, *lru_conv_w, *lru_conv_b, *lru_w_a, *lru_b_a, *lru_w_x, *lru_b_x, *lru_lambda, *w_out1;
    const float *norm1_ffn, *ada1_ffn_w, *ada1_ffn_b, *moe1_w_group, *moe1_w_expert, *moe1_w_gate_up, *moe1_w_down;
    const float *norm_final;
    float* out;
    unsigned* bar; int* cnt;
    float* mod;
    float* wrt;
    float* rbias;
    bf16_t *w_in0t, *w_out0t, *w_gut0, *w_dt0, *w_in1t, *w_out1t, *w_gut1, *w_dt1, *w_lru;
    bf16_t *H, *G, *AO, *HF, *ACT, *YB, *XC, *KVH;
    bf16_t* XA;
    int* tokl; float* gatel; int* asg;
};

constexpr bool YB8_E = true;
struct GUnit { int rowbase; int nvalid; int e; const int* gather; };
struct GArgs { const bf16_t* A; const bf16_t* Bt; size_t bt_estride; long long lda, K, moe_layer; const float* xin; long long lgate; };
typedef unsigned u32x4_ __attribute__((ext_vector_type(4)));
typedef __bf16 bf2v_ __attribute__((ext_vector_type(2)));
typedef float f32x2_ __attribute__((ext_vector_type(2)));
DI unsigned pk2e(float a, float b) { f32x2_ v = {a, b}; bf2v_ r = __builtin_convertvector(v, bf2v_); return __builtin_bit_cast(unsigned, r); }
DI u32x4_ pack8(f32x4 a, f32x4 b) { return (u32x4_){pk2e(a[0], a[1]), pk2e(a[2], a[3]), pk2e(b[0], b[1]), pk2e(b[2], b[3])}; }
struct EpiIn0 { static constexpr bool GATHER = false; const float* xin; int lgate; DI void operator()(const Params& p, const GUnit& u, int r, int col0, f32x4 lo0, f32x4 lo1, f32x4 hi0, f32x4 hi1) const {
    const int row = u.rowbase + r;
    if (col0 < 3072) { bf16_t* o = p.G + (size_t)row * N_IN0 + col0; *(u32x4_*)o = pack8(lo0, lo1); *(u32x4_*)(o + 128) = pack8(hi0, hi1); }
    else { const int b = row / SEQ, t = row % SEQ, i0 = (col0 - 3072) >> 7, i1 = i0 + 1;
        bf16_t* o0 = p.KVH + ((size_t)((b * 8 + (i0 & 7)) * 2 + (i0 >> 3)) * SEQ + t) * 128 + (col0 & 127);
        bf16_t* o1 = p.KVH + ((size_t)((b * 8 + (i1 & 7)) * 2 + (i1 >> 3)) * SEQ + t) * 128 + (col0 & 127);
        *(u32x4_*)o0 = pack8(lo0, lo1); *(u32x4_*)o1 = pack8(hi0, hi1); } } };
struct EpiOut { static constexpr bool GATHER = false; const float* xin; int lgate; DI void operator()(const Params& p, const GUnit& u, int r, int col0, f32x4 lo0, f32x4 lo1, f32x4 hi0, f32x4 hi1) const {
    const int row = u.rowbase + r, b = row / SEQ; const float* gt = p.mod + (lgate * 4 + b) * 6144 + 4096 + col0; bf16_t* o = p.XA + (size_t)row * DM + col0;
    f32x4 r0, r1, r2, r3;
    if (xin) { const float* xi = xin + (size_t)row * DM + col0; r0 = *(const f32x4*)xi; r1 = *(const f32x4*)(xi + 4); r2 = *(const f32x4*)(xi + 128); r3 = *(const f32x4*)(xi + 132); }
    else { const u32x4_ a = *(const u32x4_*)o, c = *(const u32x4_*)(o + 128);
        r0 = (f32x4){__uint_as_float(a[0] << 16), __uint_as_float(a[0] & 0xffff0000u), __uint_as_float(a[1] << 16), __uint_as_float(a[1] & 0xffff0000u)};
        r1 = (f32x4){__uint_as_float(a[2] << 16), __uint_as_float(a[2] & 0xffff0000u), __uint_as_float(a[3] << 16), __uint_as_float(a[3] & 0xffff0000u)};
        r2 = (f32x4){__uint_as_float(c[0] << 16), __uint_as_float(c[0] & 0xffff0000u), __uint_as_float(c[1] << 16), __uint_as_float(c[1] & 0xffff0000u)};
        r3 = (f32x4){__uint_as_float(c[2] << 16), __uint_as_float(c[2] & 0xffff0000u), __uint_as_float(c[3] << 16), __uint_as_float(c[3] & 0xffff0000u)}; }
    *(u32x4_*)o = pack8(r0 + *(const f32x4*)gt * lo0, r1 + *(const f32x4*)(gt + 4) * lo1); *(u32x4_*)(o + 128) = pack8(r2 + *(const f32x4*)(gt + 128) * hi0, r3 + *(const f32x4*)(gt + 132) * hi1); } };
DI unsigned pk4_fp8e(float a, float b, float c, float d, float sc) { a = fminf(fmaxf(a * sc, -448.f), 448.f); b = fminf(fmaxf(b * sc, -448.f), 448.f); c = fminf(fmaxf(c * sc, -448.f), 448.f); d = fminf(fmaxf(d * sc, -448.f), 448.f);
    unsigned w = 0u; w = __builtin_amdgcn_cvt_pk_fp8_f32(a, b, w, false); w = __builtin_amdgcn_cvt_pk_fp8_f32(c, d, w, true); return w; }
struct EpiGU { static constexpr bool GATHER = true; const float* xin; int lgate; DI void operator()(const Params& p, const GUnit& u, int r, int col0, f32x4 lo0, f32x4 lo1, f32x4 hi0, f32x4 hi1) const {
    f32x4 a0, a1;
#pragma unroll
    for (int j = 0; j < 4; ++j) { a0[j] = siluf_(lo0[j]) * hi0[j]; a1[j] = siluf_(lo1[j]) * hi1[j]; }
    *(uint2*)((unsigned char*)p.ACT + (size_t)(u.rowbase + r) * EFF + (col0 >> 8) * 128 + (col0 & 127)) = make_uint2(pk4_fp8e(a0[0], a0[1], a0[2], a0[3], 8.f), pk4_fp8e(a1[0], a1[1], a1[2], a1[3], 8.f)); } };
struct EpiDown { static constexpr bool GATHER = false; const float* xin; int lgate; DI void operator()(const Params& p, const GUnit& u, int r, int col0, f32x4 lo0, f32x4 lo1, f32x4 hi0, f32x4 hi1) const {
    const float g = p.gatel[(u.gather - p.tokl) + r];
    if constexpr (YB8_E) { const float gs = g * 64.f; unsigned char* o = (unsigned char*)p.YB + (size_t)(u.rowbase + r) * DM + col0;
        *(uint2*)o = make_uint2(pk4_fp8e(lo0[0], lo0[1], lo0[2], lo0[3], gs), pk4_fp8e(lo1[0], lo1[1], lo1[2], lo1[3], gs)); *(uint2*)(o + 128) = make_uint2(pk4_fp8e(hi0[0], hi0[1], hi0[2], hi0[3], gs), pk4_fp8e(hi1[0], hi1[1], hi1[2], hi1[3], gs)); }
    else { bf16_t* o = p.YB + (size_t)(u.rowbase + r) * DM + col0; *(u32x4_*)o = pack8(lo0 * g, lo1 * g); *(u32x4_*)(o + 128) = pack8(hi0 * g, hi1 * g); } } };
struct EpiIn1 { static constexpr bool GATHER = false; const float* xin; int lgate; DI void operator()(const Params& p, const GUnit& u, int r, int col0, f32x4 lo0, f32x4 lo1, f32x4 hi0, f32x4 hi1) const {
    bf16_t* o = p.G + (size_t)(u.rowbase + r) * N_IN1 + col0;
    if (col0 < LRU_W) {
#pragma unroll
        for (int j = 0; j < 4; ++j) { lo0[j] = gelu_tanh(lo0[j]); lo1[j] = gelu_tanh(lo1[j]); } }
    if (col0 + 128 < LRU_W) {
#pragma unroll
        for (int j = 0; j < 4; ++j) { hi0[j] = gelu_tanh(hi0[j]); hi1[j] = gelu_tanh(hi1[j]); } }
    *(u32x4_*)o = pack8(lo0, lo1); *(u32x4_*)(o + 128) = pack8(hi0, hi1); } };

#define LAS __attribute__((address_space(3)))
typedef short bf16x8 __attribute__((ext_vector_type(8)));
DI int opaque_tid() { int t = threadIdx.x; asm volatile("" : "+v"(t)); return t; }
namespace gm {
constexpr int BM = 256, BK = 64, HALF = 128, HTB = HALF * BK * 2, STAGE_BYTES = 8 * HTB, NXCD = 8, WGM = 4;
constexpr int TAB_OFF = STAGE_BYTES;
DI int lds_byte(int r, int c) { const int st = (r >> 4) * 2 + (c >> 5), rr = r & 15, cc = c & 31, ob = rr * 64 + cc * 2; return st * 1024 + (ob ^ (((ob >> 9) & 1) << 5)); }
DI int perm32(int rho) { const int n = rho >> 4, i = rho & 15; return 8 * (i >> 2) + 4 * n + (i & 3); }
DI void stage_rc(int b, int& R, int& C) { const int st = b / 1024, sb = b % 1024, swz = sb ^ (((sb >> 9) & 1) << 5); R = (st >> 1) * 16 + swz / 64; C = (st & 1) * 32 + (swz % 64) / 2; }
struct Unit { int arow, nvalid, orow, pn, e, goff; };
struct DenseSched {
    static constexpr bool GATHER = false, HALF_SKIP = false;
    int nM, nN, nwg, G, c;
    DI void init(int M, int N) { nM = M / BM; nN = N / BM; nwg = nM * nN; G = gridDim.x; c = blockIdx.x; }
    DI bool next(int i, Unit& u) const {
        const long L = (long)i * G + c; if (L >= nwg) return false;
        int wgid = (int)L; { const int q = nwg / NXCD, r = nwg % NXCD, xcd = wgid % NXCD, off = wgid / NXCD; wgid = (xcd < r ? xcd * (q + 1) : r * (q + 1) + (xcd - r) * q) + off; }
        const int nig = WGM * nN, gid = wgid / nig, fm = gid * WGM, gsz = (nM - fm) < WGM ? (nM - fm) : WGM;
        const int pm = fm + ((wgid % nig) % gsz); u.pn = (wgid % nig) / gsz; u.arow = pm * BM; u.orow = pm * BM; u.nvalid = BM; u.e = 0; u.goff = 0; return true;
    }
};
template <bool GATH> struct MoeSched {
    static constexpr bool GATHER = GATH, HALF_SKIP = true;
    const LAS int* tab; int G, c;
    DI void init(const LAS int* t) { tab = t; G = gridDim.x; c = blockIdx.x; }
    DI bool next(int i, Unit& u) const {
        const int L = i * G + c, mtile = L >> 3; const int total = __builtin_amdgcn_readfirstlane(tab[32]);
        if (mtile >= total) return false;
        int e = 0; for (int j = 1; j < 32; ++j) { if (__builtin_amdgcn_readfirstlane(tab[j]) <= mtile) e = j; }
        const int mt = mtile - __builtin_amdgcn_readfirstlane(tab[e]); const int cn = __builtin_amdgcn_readfirstlane(tab[64 + e]);
        u.e = e; u.pn = L & 7; u.orow = mtile * BM; u.arow = mtile * BM; u.nvalid = (cn - mt * BM) < BM ? (cn - mt * BM) : BM; u.goff = e * ECAP + mt * BM; return true;
    }
};
DI void moe_tables(LAS int* tab, const int* cnt) {
    if (threadIdx.x == 0) { int run = 0; for (int e = 0; e < 32; ++e) { const int cn = cnt[e]; tab[e] = run; tab[64 + e] = cn; run += (cn + 255) >> 8; } tab[32] = run; }
    __syncthreads();
}

typedef int i32x8 __attribute__((ext_vector_type(8)));
typedef int i32x4 __attribute__((ext_vector_type(4)));
DI void mfma8(f32x4& acc, const i32x8& w8, const i32x8& x8, int ws, int as) {
    asm volatile("v_mfma_scale_f32_16x16x128_f8f6f4 %0, %1, %2, %0, %3, %4 op_sel_hi:[0,0,0]" : "+v"(acc) : "v"(w8), "v"(x8), "v"(ws), "v"(as)); }
template <class Epi, class Sched, bool FP8 = false>
DI void gemm_phase(LAS unsigned char* lds, const Params& p, const bf16_t* A, const bf16_t* Bt, size_t bt_estride, int K, const Sched& S, const Epi& E, int wscale = 0x7f7f7f7f, int ascale = 0x7f7f7f7f) {
    const int tid = opaque_tid(), wid = __builtin_amdgcn_readfirstlane(tid >> 6), lane = tid & 63, wr = wid >> 2, wc = wid & 3, fr = lane & 15, fq = lane >> 4;
    const int nt = K / BK;
    unsigned voffA[2], voffB[2];
#pragma unroll
    for (int i = 0; i < 2; ++i) { int R, C; stage_rc(tid * 16 + i * 8192, R, C); voffA[i] = (unsigned)(R * K + C) * 2u; voffB[i] = (unsigned)(((R & ~31) + perm32(R & 31)) * K + C) * 2u; }
    const size_t kstep = (size_t)(BK * 2), hstep = (size_t)HALF * K * 2, tstep = 2 * hstep;
    const unsigned ldsw = (unsigned)wid * 1024u;
    const int aoff = lds_byte(wr * 64 + fr, fq * 8), boff = lds_byte(wc * 32 + fr, fq * 8);
#define G_SA(b, h) (((b) * 2 + (h)) * HTB)
#define G_SB(b, h) ((4 + (b) * 2 + (h)) * HTB)
#define G_STAGE(bufoff, gbase, voff) do { _Pragma("unroll") for (int _i = 0; _i < 2; ++_i) \
        __builtin_amdgcn_global_load_lds((const unsigned*)((const char*)(gbase) + (voff)[_i]), (LAS unsigned*)(lds + (bufoff) + ldsw + _i * 8192), 16, 0, 0); } while (0)
#define G_STAGE_A(bufoff, ubase, gv, h, koff) do { if constexpr (Sched::GATHER) { G_STAGE(bufoff, (const char*)A + (koff), gv[h]); } else { G_STAGE(bufoff, (ubase) + (h) * hstep + (koff), voffA); } } while (0)
#define G_LD16(off_) (*(const LAS i32x4*)(lds + (off_)))
#define G_LD16B(off_) (*(const LAS bf16x8*)(lds + (off_)))
#define G_LDA(dst, b, h) do { _Pragma("unroll") for (int m = 0; m < 4; ++m) { if constexpr (FP8) dst##8[m] = __builtin_shufflevector(G_LD16(G_SA(b, h) + aoff + m * 2048), G_LD16(G_SA(b, h) + aoff + m * 2048 + 1024), 0, 1, 2, 3, 4, 5, 6, 7); \
        else { dst[m][0] = G_LD16B(G_SA(b, h) + aoff + m * 2048); dst[m][1] = G_LD16B(G_SA(b, h) + aoff + m * 2048 + 1024); } } } while (0)
#define G_LDB(dst, b, h) do { _Pragma("unroll") for (int n = 0; n < 2; ++n) { if constexpr (FP8) dst##8[n] = __builtin_shufflevector(G_LD16(G_SB(b, h) + boff + n * 2048), G_LD16(G_SB(b, h) + boff + n * 2048 + 1024), 0, 1, 2, 3, 4, 5, 6, 7); \
        else { dst[n][0] = G_LD16B(G_SB(b, h) + boff + n * 2048); dst[n][1] = G_LD16B(G_SB(b, h) + boff + n * 2048 + 1024); } } } while (0)
#define G_MMA(ai, bj, At, Bt_) do { __builtin_amdgcn_s_setprio(1); _Pragma("unroll") for (int m = 0; m < 4; ++m) _Pragma("unroll") for (int n = 0; n < 2; ++n) { \
        if constexpr (FP8) mfma8(acc[ai][bj][m][n], Bt_##8[n], At##8[m], wscale, ascale); \
        else { _Pragma("unroll") for (int k = 0; k < 2; ++k) acc[ai][bj][m][n] = __builtin_amdgcn_mfma_f32_16x16x32_bf16(Bt_[n][k], At[m][k], acc[ai][bj][m][n], 0, 0, 0); } } \
        __builtin_amdgcn_s_setprio(0); } while (0)
#define G_WAIT_V(n) asm volatile("s_waitcnt vmcnt(" #n ")" ::: "memory")
#define G_WAIT_L(n) asm volatile("s_waitcnt lgkmcnt(" #n ")" ::: "memory")
#define G_BAR __builtin_amdgcn_s_barrier()
#define G_SCHED __builtin_amdgcn_sched_barrier(0)
    Unit cur, nxt; int ui = 0;
    if (!S.next(0, cur)) return;
    f32x4 acc[2][2][4][2];
#pragma unroll
    for (int a = 0; a < 2; ++a)
#pragma unroll
        for (int b = 0; b < 2; ++b)
#pragma unroll
            for (int m = 0; m < 4; ++m)
#pragma unroll
                for (int n = 0; n < 2; ++n) acc[a][b][m][n] = (f32x4){0.f, 0.f, 0.f, 0.f};
    bf16x8 At[4][2], B0[2][2], B1[2][2]; i32x8 At8[4], B08[2], B18[2];
    unsigned gcur[2][2] = {{0u, 0u}, {0u, 0u}}, gnxt[2][2] = {{0u, 0u}, {0u, 0u}};
    auto gather_offs = [&](const Unit& u, unsigned (&g)[2][2]) {
        if constexpr (Sched::GATHER) {
#pragma unroll
            for (int h = 0; h < 2; ++h)
#pragma unroll
                for (int i = 0; i < 2; ++i) { int tz = tid; asm volatile("" : "+v"(tz)); int R, C; stage_rc(tz * 16 + i * 8192, R, C); const int r = h * HALF + R; const int tk = p.tokl[u.goff + (r < u.nvalid ? r : 0)]; const int tok = r < u.nvalid ? tk : 0; g[h][i] = (unsigned)(tok * K + C) * 2u; }
        }
    };
    const char* cA = (const char*)A + (size_t)(cur.arow / BM) * tstep; const char* cB = (const char*)Bt + ((size_t)cur.e * bt_estride) * 2 + (size_t)cur.pn * tstep;
    gather_offs(cur, gcur);
    G_STAGE(G_SB(0, 0), cB, voffB); G_STAGE_A(G_SA(0, 0), cA, gcur, 0, 0); G_STAGE(G_SB(0, 1), cB + hstep, voffB); G_STAGE_A(G_SA(0, 1), cA, gcur, 1, 0);
    if (wr == 1) G_BAR;
    G_WAIT_V(4); G_BAR;
    G_STAGE(G_SB(1, 0), cB + kstep, voffB); G_STAGE_A(G_SA(1, 0), cA, gcur, 0, kstep); G_STAGE(G_SB(1, 1), cB + hstep + kstep, voffB);
    G_WAIT_V(6); G_BAR;
    for (;;) {
        const bool has_next = S.next(ui + 1, nxt);
        const char* nA = has_next ? (const char*)A + (size_t)(nxt.arow / BM) * tstep : cA;
        const char* nB = has_next ? (const char*)Bt + ((size_t)nxt.e * bt_estride) * 2 + (size_t)nxt.pn * tstep : cB;
        if constexpr (Sched::GATHER) { if (has_next) gather_offs(nxt, gnxt); else {
#pragma unroll
            for (int h = 0; h < 2; ++h) { gnxt[h][0] = gcur[h][0]; gnxt[h][1] = gcur[h][1]; } } }
        for (int t = 0; t < nt; t += 2) {
            const bool last = (t == nt - 2);
            const size_t k1 = (size_t)(t + 1) * kstep;
            const char* a2 = last ? nA : cA; const char* b2 = last ? nB : cB + (size_t)(t + 2) * kstep;
            const size_t k2 = last ? 0 : (size_t)(t + 2) * kstep; const size_t k3 = k2 + kstep;
            const char* b3 = b2 + kstep;
            unsigned g2[2][2];
#pragma unroll
            for (int h = 0; h < 2; ++h) { g2[h][0] = last ? gnxt[h][0] : gcur[h][0]; g2[h][1] = last ? gnxt[h][1] : gcur[h][1]; }
            G_LDB(B0, 0, 0); G_SCHED; G_LDA(At, 0, 0); G_STAGE_A(G_SA(1, 1), cA, gcur, 1, k1);
            G_WAIT_L(8); G_BAR; G_WAIT_L(0); G_MMA(0, 0, At, B0); G_BAR; G_SCHED;
            G_LDB(B1, 0, 1); G_STAGE(G_SB(0, 0), b2, voffB);
            G_BAR; G_WAIT_L(0); G_MMA(0, 1, At, B1); G_BAR;
            G_LDA(At, 0, 1); G_STAGE_A(G_SA(0, 0), a2, g2, 0, k2);
            G_BAR; G_WAIT_L(0); if (!Sched::HALF_SKIP || cur.nvalid > HALF) G_MMA(1, 0, At, B0); G_BAR; G_SCHED;
            G_STAGE(G_SB(0, 1), b2 + hstep, voffB);
            G_WAIT_V(6); G_BAR; if (!Sched::HALF_SKIP || cur.nvalid > HALF) G_MMA(1, 1, At, B1); G_BAR;
            G_LDB(B0, 1, 0); G_SCHED; G_LDA(At, 1, 0); G_STAGE_A(G_SA(0, 1), a2, g2, 1, k2);
            G_WAIT_L(8); G_BAR; G_WAIT_L(0); G_MMA(0, 0, At, B0); G_BAR; G_SCHED;
            G_LDB(B1, 1, 1); G_STAGE(G_SB(1, 0), b3, voffB);
            G_BAR; G_WAIT_L(0); G_MMA(0, 1, At, B1); G_BAR;
            G_LDA(At, 1, 1); G_STAGE_A(G_SA(1, 0), a2, g2, 0, k3);
            G_BAR; G_WAIT_L(0); if (!Sched::HALF_SKIP || cur.nvalid > HALF) G_MMA(1, 0, At, B0); G_BAR; G_SCHED;
            G_STAGE(G_SB(1, 1), b3 + hstep, voffB);
            G_WAIT_V(6); G_BAR; if (!Sched::HALF_SKIP || cur.nvalid > HALF) G_MMA(1, 1, At, B1); G_BAR;
        }
        if constexpr (FP8) asm volatile("s_nop 15\n\ts_nop 15" ::: "memory");
        { GUnit gu; gu.rowbase = cur.orow; gu.nvalid = cur.nvalid; gu.e = cur.e; gu.gather = p.tokl + cur.goff;
#pragma unroll
          for (int ai = 0; ai < 2; ++ai)
#pragma unroll
            for (int m = 0; m < 4; ++m) { const int r = ai * HALF + wr * 64 + m * 16 + fr;
              if (r < cur.nvalid) E(p, gu, r, cur.pn * BM + wc * 32 + fq * 8, acc[ai][0][m][0], acc[ai][0][m][1], acc[ai][1][m][0], acc[ai][1][m][1]); } }
        if (!has_next) break;
#pragma unroll
        for (int a = 0; a < 2; ++a)
#pragma unroll
            for (int b = 0; b < 2; ++b)
#pragma unroll
                for (int m = 0; m < 4; ++m)
#pragma unroll
                    for (int n = 0; n < 2; ++n) acc[a][b][m][n] = (f32x4){0.f, 0.f, 0.f, 0.f};
        cur = nxt; cA = nA; cB = nB; ++ui;
#pragma unroll
        for (int h = 0; h < 2; ++h) { gcur[h][0] = gnxt[h][0]; gcur[h][1] = gnxt[h][1]; }
    }
    G_WAIT_V(0);
    if (wr == 0) G_BAR;
    G_BAR;
}
}

extern __shared__ __attribute__((aligned(16))) unsigned char dyn_smem[];
constexpr int LDS_BYTES = gm::STAGE_BYTES + 1024;

typedef __bf16 bf2v __attribute__((ext_vector_type(2)));
typedef float f32x2 __attribute__((ext_vector_type(2)));
typedef float f32x16 __attribute__((ext_vector_type(16)));
typedef short s16x4 __attribute__((ext_vector_type(4)));
typedef unsigned u32x4 __attribute__((ext_vector_type(4)));
DI unsigned pk2(float a, float b) { f32x2 v = {a, b}; bf2v r = __builtin_convertvector(v, bf2v); return __builtin_bit_cast(unsigned, r); }
DI float bflo(unsigned u) { return __uint_as_float(u << 16); }
DI float bfhi(unsigned u) { return __uint_as_float(u & 0xffff0000u); }

DI unsigned pk4_fp8(float a, float b, float c, float d, float sc) {
    a = __builtin_amdgcn_fmed3f(a * sc, -448.f, 448.f); b = __builtin_amdgcn_fmed3f(b * sc, -448.f, 448.f); c = __builtin_amdgcn_fmed3f(c * sc, -448.f, 448.f); d = __builtin_amdgcn_fmed3f(d * sc, -448.f, 448.f);
    unsigned w = 0u; w = __builtin_amdgcn_cvt_pk_fp8_f32(a, b, w, false); w = __builtin_amdgcn_cvt_pk_fp8_f32(c, d, w, true); return w; }
constexpr bool D8_IN0 = true, D8_OUT0 = false, D8_IN1 = false;
constexpr bool YB8 = true;
constexpr float Y8_SCALE = 64.f;
constexpr float W8_SCALE = 256.f, A8_SCALE = 8.f;
constexpr int W8_E8M0 = 0x77777777, A8_E8M0 = 0x7c7c7c7c;
namespace ph {
DI void mods(const Params& p, LAS unsigned char* lds) {
    const int tid = opaque_tid(), wave = tid >> 6, lane = tid & 63, l8 = tid & 7, rg = tid >> 3;
    LAS float* fl = (LAS float*)lds; LAS float* red = fl + 4 * DM;
    for (int i = tid; i < 4 * DM; i += 512) fl[i] = siluf_(p.c[i]);
    __syncthreads();
    for (int u = blockIdx.x; u < 768; u += gridDim.x) {
        const int l = u / 192, c32 = u % 192;
        const float* w = l == 0 ? p.ada0_mix_w : l == 1 ? p.ada0_ffn_w : l == 2 ? p.ada1_mix_w : p.ada1_ffn_w;
        const float* bs = l == 0 ? p.ada0_mix_b : l == 1 ? p.ada0_ffn_b : l == 2 ? p.ada1_mix_b : p.ada1_ffn_b;
        f32x4 acc[4] = {{0.f, 0.f, 0.f, 0.f}, {0.f, 0.f, 0.f, 0.f}, {0.f, 0.f, 0.f, 0.f}, {0.f, 0.f, 0.f, 0.f}};
        const float* wp = w + (size_t)rg * 6144 + c32 * 32 + l8 * 4;
#pragma unroll 8
        for (int i = 0; i < 32; ++i) { const f32x4 wv = *(const f32x4*)(wp + (size_t)(64 * i) * 6144); const int k = rg + 64 * i;
#pragma unroll
            for (int b = 0; b < 4; ++b) acc[b] += fl[b * DM + k] * wv; }
#pragma unroll
        for (int b = 0; b < 4; ++b)
#pragma unroll
            for (int j = 0; j < 4; ++j) { float v = acc[b][j]; v += __shfl_xor(v, 8); v += __shfl_xor(v, 16); v += __shfl_xor(v, 32); acc[b][j] = v; }
        if (lane < 8) {
#pragma unroll
            for (int b = 0; b < 4; ++b) *(LAS f32x4*)(red + (wave * 4 + b) * 32 + lane * 4) = acc[b]; }
        __syncthreads();
        if (tid < 128) { const int b = tid >> 5, col = tid & 31; float sum = 0.f;
#pragma unroll
            for (int w8 = 0; w8 < 8; ++w8) sum += red[(w8 * 4 + b) * 32 + col];
            p.mod[(l * 4 + b) * 6144 + c32 * 32 + col] = sum + bs[c32 * 32 + col]; }
        __syncthreads();
    }
}
constexpr int NT_UNITS = (640 + 256 + 672 + 336 + 2 * (8192 + 4096)) / 2;
struct UD { const float* sp; bf16_t* dst; int K, N, mode, e, kt, ntile; };
DI UD tdecode(const Params& p, int u, int lane) {
    const float* srcs[8] = {p.w_in0, p.w_out0, p.w_in1, p.w_out1, p.moe0_w_gate_up, p.moe0_w_down, p.moe1_w_gate_up, p.moe1_w_down};
    bf16_t* dsts[8] = {p.w_in0t, p.w_out0t, p.w_in1t, p.w_out1t, p.w_gut0, p.w_dt0, p.w_gut1, p.w_dt1};
    constexpr int Ks[8] = {DM, DM, DM, LRU_W, DM, EFF, DM, EFF}, Ns[8] = {N_IN0, DM, N_IN1, DM, 2048, DM, 2048, DM}, nus[8] = {320, 128, 336, 168, 4096, 2048, 4096, 2048};
    constexpr int modes[8] = {D8_IN0 ? 2 : 0, D8_OUT0 ? 2 : 0, D8_IN1 ? 2 : 0, 0, 3, 2, 3, 2};
    int v = u, mi = 0;
#pragma unroll
    for (int m = 0; m < 8; ++m) { if (mi == m && v >= nus[m]) { v -= nus[m]; mi = m + 1; } }
    UD d; const float* src = srcs[0]; d.dst = dsts[0]; d.K = Ks[0]; d.N = Ns[0]; d.mode = modes[0];
#pragma unroll
    for (int m = 1; m < 8; ++m) if (mi == m) { src = srcs[m]; d.dst = dsts[m]; d.K = Ks[m]; d.N = Ns[m]; d.mode = modes[m]; }
    const int ntl = d.N / 256, ktl = d.K / 128; d.e = v / (ktl * ntl); const int rem = v % (ktl * ntl); d.kt = rem / ntl; d.ntile = rem % ntl;
    d.sp = src + (size_t)d.e * d.K * d.N + (size_t)(d.kt * 128) * d.N + d.ntile * 256 + lane * 4;
    return d;
}
DI void transposer(const Params& p, LAS unsigned char* lds, int first, int count, int stride) {
    const int tid = opaque_tid(), wave = tid >> 6, lane = tid & 63;
    LAS float* fl = (LAS float*)lds;
    if (count <= 0) return;
    if (tdecode(p, first, lane).mode & 2) {
        LAS unsigned* td = (LAS unsigned*)lds;
        const int nl = lane & 15, ks = lane >> 4;
        auto src_of = [&](const UD& d, int g, int j) -> const float* { const int kq = 4 * (g >> 2) + ks, nq = 16 * (g & 3) + nl; return d.sp - lane * 4 + (size_t)(4 * kq + j) * d.N + 4 * nq; };
        f32x4 va[4][4], vb[4][4];
        auto load_unit = [&](int u, f32x4 (&v)[4][4]) { const UD dd = tdecode(p, u, lane);
#pragma unroll
            for (int i = 0; i < 4; ++i)
#pragma unroll
                for (int j = 0; j < 4; ++j) v[i][j] = *(const f32x4*)src_of(dd, wave * 4 + i, j); };
        auto process = [&](int jn, f32x4 (&v)[4][4]) { const int u = first + jn * stride;
            const UD d = tdecode(p, u, lane); const int K = d.K, N = d.N, mode = d.mode, e = d.e, kt = d.kt, ntile = d.ntile;
            LAS unsigned* tile = td + (jn & 1) * (256 * 33);
#pragma unroll
            for (int i = 0; i < 4; ++i) { const int g = wave * 4 + i, kq = 4 * (g >> 2) + ks, nq = 16 * (g & 3) + nl;
#pragma unroll
                for (int en = 0; en < 4; ++en) tile[(4 * nq + en) * 33 + kq] = pk4_fp8(v[i][0][en], v[i][1][en], v[i][2][en], v[i][3][en], W8_SCALE); }
            __syncthreads();
            if (jn + 2 < count) load_unit(u + 2 * stride, v);
            { const int n = tid >> 1, kh = tid & 1; const int ng = ntile * 256 + n; const int jg = ng & 1023; const int np = (mode & 1) ? (256 * (jg >> 7) + (ng < 1024 ? 0 : 128) + (jg & 127)) : ng;
              unsigned char* dp = (unsigned char*)d.dst + (size_t)e * N * K + (size_t)np * K + kt * 128 + kh * 64;
#pragma unroll
              for (int jj = 0; jj < 4; ++jj) { const LAS unsigned* tp = tile + n * 33 + kh * 16 + jj * 4; *(uint4*)(dp + jj * 16) = make_uint4(tp[0], tp[1], tp[2], tp[3]); } } };
        load_unit(first, va); if (count > 1) load_unit(first + stride, vb);
        for (int jn = 0; jn < count; jn += 2) { process(jn, va); if (jn + 1 < count) process(jn + 1, vb); }
        __syncthreads();
        return;
    }
    f32x4 vv[16];
    { const UD d0 = tdecode(p, first, lane);
#pragma unroll
        for (int i = 0; i < 16; ++i) vv[i] = *(const f32x4*)(d0.sp + (size_t)(i * 8 + wave) * d0.N); }
    for (int j = 0; j < count; ++j) { const int u = first + j * stride;
        const UD d = tdecode(p, u, lane); const int K = d.K, N = d.N, mode = d.mode, e = d.e, kt = d.kt, ntile = d.ntile; bf16_t* dst = d.dst;
#pragma unroll
        for (int i = 0; i < 16; ++i) { LAS float* tp = fl + (i * 8 + wave) * 257 + lane * 4; tp[0] = vv[i][0]; tp[1] = vv[i][1]; tp[2] = vv[i][2]; tp[3] = vv[i][3]; }
        __syncthreads();
        if (j + 1 < count) { const UD dn = tdecode(p, u + stride, lane);
#pragma unroll
            for (int i = 0; i < 16; ++i) vv[i] = *(const f32x4*)(dn.sp + (size_t)(i * 8 + wave) * dn.N); }
        { const int n = tid >> 1, kh = tid & 1; const int ng = ntile * 256 + n; const int jg = ng & 1023; const int np = (mode & 1) ? (256 * (jg >> 7) + (ng < 1024 ? 0 : 128) + (jg & 127)) : ng;
          bf16_t* dp = dst + (size_t)e * N * K + (size_t)np * K + kt * 128 + kh * 64;
#pragma unroll
          for (int jj = 0; jj < 8; ++jj) { unsigned w4[4];
#pragma unroll
              for (int q = 0; q < 4; ++q) { const int k = kh * 64 + jj * 8 + q * 2; w4[q] = pk2(fl[k * 257 + n], fl[(k + 1) * 257 + n]); }
              *(uint4*)(dp + jj * 8) = make_uint4(w4[0], w4[1], w4[2], w4[3]); } }
        __syncthreads();
    }
}
DI void lru_weights(const Params& p) {
    const int tid = opaque_tid();
    for (size_t i = (size_t)blockIdx.x * 512 + tid; i < (size_t)2 * 2 * 16 * 4 * 48 * 192; i += (size_t)gridDim.x * 512) {
        const int k = i % 192, j = (i / 192) % 48, qt = (i / (192 * 48)) % 4, n = (i / (192 * 48 * 4)) % 16, which = (i / (192 * 48 * 4 * 16)) % 2, dir = i / (192 * 48 * 4 * 16 * 2);
        const float* w = which == 0 ? p.lru_w_a : p.lru_w_x; float v = 0.f;
        if (j < 42 && k < 168) v = w[(((size_t)dir * 16 + n) * 168 + k) * 168 + qt * 42 + j];
        p.w_lru[i] = f2bf(v);
    }
}
DI void fold_router(const Params& p) {
    const int tid = opaque_tid(), wave = tid >> 6, lane = tid & 63;
    for (size_t i = (size_t)blockIdx.x * 512 + tid; i < (size_t)2 * 4 * 48 * DM; i += (size_t)gridDim.x * 512) {
        const int k = i % DM, n = (i / DM) % 48, b = (i / (DM * 48)) % 4, l = i / (DM * 48 * 4);
        const float* g = l == 0 ? p.norm0_ffn : p.norm1_ffn; const float* md = p.mod + ((l == 0 ? 1 : 3) * 4 + b) * 6144;
        const float* we = l == 0 ? p.moe0_w_expert : p.moe1_w_expert; const float* wg = l == 0 ? p.moe0_w_group : p.moe1_w_group;
        const float w = n < 32 ? we[k * 32 + n] : n < 36 ? wg[k * 4 + (n - 32)] : 0.f;
        p.wrt[i] = g[k] * (1.f + md[2048 + k]) * w;
    }
    for (int task = blockIdx.x * 8 + wave; task < 2 * 4 * 48; task += gridDim.x * 8) {
        const int n = task % 48, b = (task / 48) % 4, l = task / (48 * 4);
        const float* md = p.mod + ((l == 0 ? 1 : 3) * 4 + b) * 6144;
        const float* we = l == 0 ? p.moe0_w_expert : p.moe1_w_expert; const float* wg = l == 0 ? p.moe0_w_group : p.moe1_w_group;
        float part = 0.f;
        for (int k = lane; k < DM; k += 64) { const float w = n < 32 ? we[k * 32 + n] : n < 36 ? wg[k * 4 + (n - 32)] : 0.f; part += md[k] * w; }
        part = wave_sum(part); if (lane == 0) p.rbias[task] = part;
    }
}
template <int MODE, bool OUT8 = false> DI void norm_rows(const Params& p, const float* xin  , const float* gain, int lmod, int lgate, const LAS int* tab) {
    const int tid = opaque_tid(), wave = tid >> 6, lane = tid & 63;
    for (int row = blockIdx.x * 8 + wave; row < T_TOK; row += gridDim.x * 8) {
        const int b = row / SEQ;
        f32x4 v[8];
        if (xin) {
#pragma unroll
            for (int i = 0; i < 8; ++i) v[i] = *(const f32x4*)(xin + (size_t)row * DM + i * 256 + lane * 4);
        } else {
#pragma unroll
            for (int i = 0; i < 8; ++i) { const uint2 a = *(const uint2*)(p.XA + (size_t)row * DM + i * 256 + lane * 4); v[i] = (f32x4){bflo(a.x), bfhi(a.x), bflo(a.y), bfhi(a.y)}; }
        }
        if constexpr (MODE >= 1) {
            const int a0 = p.asg[row * 2], a1 = p.asg[row * 2 + 1];
            const size_t r0 = (size_t)tab[a0 >> 14] * 256 + (a0 & 16383), r1 = (size_t)tab[a1 >> 14] * 256 + (a1 & 16383);
            const float* gt = p.mod + (lgate * 4 + b) * 6144 + 4096;
#pragma unroll
            for (int i = 0; i < 8; ++i) { const int col = i * 256 + lane * 4; const f32x4 g4 = *(const f32x4*)(gt + col);
                if constexpr (YB8) { const unsigned y0 = *(const unsigned*)((const unsigned char*)p.YB + r0 * DM + col), y1 = *(const unsigned*)((const unsigned char*)p.YB + r1 * DM + col);
                    const f32x2 a0 = __builtin_amdgcn_cvt_pk_f32_fp8(y0, false), a1 = __builtin_amdgcn_cvt_pk_f32_fp8(y0, true), b0 = __builtin_amdgcn_cvt_pk_f32_fp8(y1, false), b1 = __builtin_amdgcn_cvt_pk_f32_fp8(y1, true);
                    const f32x4 gq = g4 * (1.f / Y8_SCALE);
                    v[i][0] += gq[0] * (a0[0] + b0[0]); v[i][1] += gq[1] * (a0[1] + b0[1]); v[i][2] += gq[2] * (a1[0] + b1[0]); v[i][3] += gq[3] * (a1[1] + b1[1]); }
                else { const uint2 y0 = *(const uint2*)(p.YB + r0 * DM + col), y1 = *(const uint2*)(p.YB + r1 * DM + col);
                v[i][0] += g4[0] * (bflo(y0.x) + bflo(y1.x)); v[i][1] += g4[1] * (bfhi(y0.x) + bfhi(y1.x));
                v[i][2] += g4[2] * (bflo(y0.y) + bflo(y1.y)); v[i][3] += g4[3] * (bfhi(y0.y) + bfhi(y1.y)); } }
            if constexpr (MODE == 1) {
#pragma unroll
                for (int i = 0; i < 8; ++i) { const uint2 w = make_uint2(pk2(v[i][0], v[i][1]), pk2(v[i][2], v[i][3])); *(uint2*)(p.XA + (size_t)row * DM + i * 256 + lane * 4) = w;
                    v[i] = (f32x4){bflo(w.x), bfhi(w.x), bflo(w.y), bfhi(w.y)}; }
            }
        }
        float ss = 0.f;
#pragma unroll
        for (int i = 0; i < 8; ++i) ss += v[i][0] * v[i][0] + v[i][1] * v[i][1] + v[i][2] * v[i][2] + v[i][3] * v[i][3];
        ss = wave_sum(ss); const float rstd = rsqrtf(ss * (1.0f / DM) + 1e-6f);
        if constexpr (MODE == 2) {
#pragma unroll
            for (int i = 0; i < 8; ++i) { const int col = i * 256 + lane * 4; const f32x4 g4 = *(const f32x4*)(gain + col); *(f32x4*)(p.out + (size_t)row * DM + col) = v[i] * rstd * g4; }
        } else { const float* md = p.mod + (lmod * 4 + b) * 6144;
#pragma unroll
            for (int i = 0; i < 8; ++i) { const int col = i * 256 + lane * 4; const f32x4 g4 = *(const f32x4*)(gain + col), sc = *(const f32x4*)(md + 2048 + col), sh = *(const f32x4*)(md + col);
                const f32x4 h = v[i] * rstd * g4 * (1.f + sc) + sh;
                if constexpr (OUT8) *(unsigned*)((unsigned char*)p.H + (size_t)row * DM + col) = pk4_fp8(h[0], h[1], h[2], h[3], A8_SCALE);
                else *(uint2*)(p.H + (size_t)row * DM + col) = make_uint2(pk2(h[0], h[1]), pk2(h[2], h[3])); } }
    }
}
template <bool DRY = false, bool NORM = false> DI void router(const Params& p, int l, LAS unsigned char* lds, const float* gain = nullptr, int lmod = 0) {
    const int tid = opaque_tid(), wave = __builtin_amdgcn_readfirstlane(tid >> 6), lane = tid & 63;
    LAS float* lg = (LAS float*)lds + (wave & 3) * (16 * 48);
    LAS float* part = (LAS float*)lds + 4 * 16 * 48 + (wave & 3) * (64 * 13);
    LAS float* rsl = (LAS float*)lds + 4 * 16 * 48 + 4 * 64 * 13 + (wave & 3) * 16;
    for (int tg = blockIdx.x; tg < T_TOK / 64; tg += gridDim.x) {
        const int tile = tg * 4 + (wave & 3), kh = wave >> 2;
        const int row0 = tile * 16, b = row0 / SEQ, r = lane & 15, q = lane >> 4;
        const bf16_t* xa = p.XA + (size_t)(row0 + r) * DM + 4 * q + kh * (DM / 2);
        const float* wt = p.wrt + (((size_t)l * 4 + b) * 48 + r) * DM + 4 * q + kh * (DM / 2);
        f32x4 acc[3] = {{0.f, 0.f, 0.f, 0.f}, {0.f, 0.f, 0.f, 0.f}, {0.f, 0.f, 0.f, 0.f}}; float ss = 0.f;
#pragma unroll 2
        for (int s = 0; s < DM / 32; ++s) {
            const uint2 ar = *(const uint2*)(xa + 16 * s); const f32x4 a4 = {bflo(ar.x), bfhi(ar.x), bflo(ar.y), bfhi(ar.y)};
            ss += a4[0] * a4[0] + a4[1] * a4[1] + a4[2] * a4[2] + a4[3] * a4[3];
#pragma unroll
            for (int n = 0; n < 3; ++n) { const f32x4 b4 = *(const f32x4*)(wt + (size_t)n * 16 * DM + 16 * s);
#pragma unroll
                for (int j = 0; j < 4; ++j) acc[n] = __builtin_amdgcn_mfma_f32_16x16x4f32(a4[j], b4[j], acc[n], 0, 0, 0); }
        }
        if (kh == 1) {
#pragma unroll
            for (int n = 0; n < 3; ++n)
#pragma unroll
                for (int j = 0; j < 4; ++j) part[(n * 4 + j) * 64 + lane] = acc[n][j];
            part[12 * 64 + lane] = ss; }
        __syncthreads();
        if (kh == 0) {
#pragma unroll
            for (int n = 0; n < 3; ++n)
#pragma unroll
                for (int j = 0; j < 4; ++j) acc[n][j] += part[(n * 4 + j) * 64 + lane];
            ss += part[12 * 64 + lane];
        ss += __shfl_xor(ss, 16); ss += __shfl_xor(ss, 32);
        const float rstd = rsqrtf(ss * (1.0f / DM) + 1e-6f);
        if (NORM && q == 0) rsl[r] = rstd;
#pragma unroll
        for (int j = 0; j < 4; ++j) { const float rs = __shfl(rstd, 4 * q + j);
#pragma unroll
            for (int n = 0; n < 3; ++n) lg[(4 * q + j) * 48 + n * 16 + r] = acc[n][j] * rs + p.rbias[(l * 4 + b) * 48 + n * 16 + r]; }
        __builtin_amdgcn_wave_barrier();
        if (!DRY && lane < 16) {
            const LAS float* L = lg + lane * 48; const int tok = row0 + lane;
            int gs = 0; float gm = L[32];
#pragma unroll
            for (int g = 1; g < 4; ++g) if (L[32 + g] > gm) { gm = L[32 + g]; gs = g; }
            float gden = 0.f;
#pragma unroll
            for (int g = 0; g < 4; ++g) gden += __expf(L[32 + g] - gm);
            const float gprob = 1.0f / gden;
            int i0 = 0; float v0 = L[gs * 8];
            for (int j = 1; j < 8; ++j) { const float x = L[gs * 8 + j]; if (x > v0) { v0 = x; i0 = j; } }
            int i1 = -1; float v1 = -3.4e38f;
            for (int j = 0; j < 8; ++j) { const float x = L[gs * 8 + j]; if (j != i0 && x > v1) { v1 = x; i1 = j; } }
            const float e1 = __expf(v1 - v0), g0 = gprob / (1.f + e1), g1 = gprob * e1 / (1.f + e1);
            const int ea = gs * 8 + i0, eb = gs * 8 + i1;
            const int sa = atomicAdd(&p.cnt[l * 32 + ea], 1), sb = atomicAdd(&p.cnt[l * 32 + eb], 1);
            p.tokl[ea * ECAP + sa] = tok; p.gatel[ea * ECAP + sa] = g0; p.tokl[eb * ECAP + sb] = tok; p.gatel[eb * ECAP + sb] = g1;
            p.asg[tok * 2] = (ea << 14) | sa; p.asg[tok * 2 + 1] = (eb << 14) | sb;
        }
        }
        __syncthreads();
        if constexpr (NORM) {
            const float* md = p.mod + (lmod * 4 + b) * 6144;
            f32x4 g4[8], sc[8], sh[8];
#pragma unroll
            for (int i = 0; i < 8; ++i) { const int col = i * 256 + lane * 4; g4[i] = *(const f32x4*)(gain + col); sc[i] = 1.f + *(const f32x4*)(md + 2048 + col); sh[i] = *(const f32x4*)(md + col); g4[i] *= sc[i]; }
#pragma unroll 2
            for (int j = 0; j < 8; ++j) { const int row = row0 + kh * 8 + j; const float rs = rsl[kh * 8 + j];
#pragma unroll
                for (int i = 0; i < 8; ++i) { const int col = i * 256 + lane * 4; const uint2 ar = *(const uint2*)(p.XA + (size_t)row * DM + col); const f32x4 v = {bflo(ar.x), bfhi(ar.x), bflo(ar.y), bfhi(ar.y)};
                    const f32x4 h = v * rs * g4[i] + sh[i];
                    *(unsigned*)((unsigned char*)p.H + (size_t)row * DM + col) = pk4_fp8(h[0], h[1], h[2], h[3], A8_SCALE); } }
            __syncthreads();
        }
    }
}
DI void conv_gln(const Params& p, LAS unsigned char* lds) {
    const int tid = opaque_tid(), wave = tid >> 6, lane = tid & 63;
    LAS float* at = (LAS float*)lds;
    u32x4 rv[3], rg[3];
    auto load_raw = [&](int u) { const int g = u & 7, t0 = ((u >> 3) & 63) * 64, b = u >> 9;
#pragma unroll
        for (int i = 0; i < 3; ++i) { const int idx = tid + 512 * i, rr = idx >> 4, c8 = idx & 15, t = t0 - 15 + rr; rv[i] = (u32x4){0u, 0u, 0u, 0u}; rg[i] = (u32x4){0u, 0u, 0u, 0u};
            if (idx < 94 * 16 && t >= 0 && t < SEQ) { const bf16_t* row = p.G + (size_t)(b * SEQ + t) * N_IN0 + g * 128 + c8 * 8; rv[i] = *(const u32x4*)row; rg[i] = *(const u32x4*)(row + 1024); } } };
    int gcur = -1; f32x2 wk[31], bias = {0.f, 0.f}, gam = {0.f, 0.f}, bet = {0.f, 0.f};
    if ((int)blockIdx.x < 2048) load_raw(blockIdx.x);
    for (int u = blockIdx.x; u < 2048; u += gridDim.x) {
        const int g = u & 7, t0 = ((u >> 3) & 63) * 64, b = u >> 9;
        const int ch = g * 128 + 2 * lane;
        if (g != gcur) { gcur = g;
#pragma unroll
            for (int k = 0; k < 31; ++k) wk[k] = *(const f32x2*)(p.conv_w + k * 1024 + ch);
            bias = *(const f32x2*)(p.conv_b + ch); gam = *(const f32x2*)(p.conv_norm_g + ch); bet = *(const f32x2*)(p.conv_norm_b + ch); }
#pragma unroll
        for (int i = 0; i < 3; ++i) { const int idx = tid + 512 * i, rr = idx >> 4, c8 = idx & 15;
            if (idx < 94 * 16) { const u32x4 v = rv[i], gg = rg[i];
                const f32x4 lo = {bflo(v[0]) * sigmoidf_(bflo(gg[0])), bfhi(v[0]) * sigmoidf_(bfhi(gg[0])), bflo(v[1]) * sigmoidf_(bflo(gg[1])), bfhi(v[1]) * sigmoidf_(bfhi(gg[1]))};
                const f32x4 hi = {bflo(v[2]) * sigmoidf_(bflo(gg[2])), bfhi(v[2]) * sigmoidf_(bfhi(gg[2])), bflo(v[3]) * sigmoidf_(bflo(gg[3])), bfhi(v[3]) * sigmoidf_(bfhi(gg[3]))};
                *(LAS f32x4*)(at + rr * 132 + c8 * 8) = lo; *(LAS f32x4*)(at + rr * 132 + c8 * 8 + 4) = hi; } }
        __syncthreads();
        if (u + (int)gridDim.x < 2048) load_raw(u + gridDim.x);
        f32x2 acc[8];
#pragma unroll
        for (int j = 0; j < 8; ++j) acc[j] = bias;
#pragma unroll
        for (int rr = 0; rr < 38; ++rr) { const f32x2 a2 = *(const LAS f32x2*)(at + (wave * 8 + rr) * 132 + 2 * lane);
#pragma unroll
            for (int j = 0; j < 8; ++j) { const int k = rr - j; if (k >= 0 && k < 31) acc[j] += wk[k] * a2; } }
#pragma unroll
        for (int j = 0; j < 8; ++j) { const float mu = wave_sum(acc[j][0] + acc[j][1]) * (1.f / 128.f); const float d0 = acc[j][0] - mu, d1 = acc[j][1] - mu;
            const float var = wave_sum(d0 * d0 + d1 * d1) * (1.f / 128.f); const float rs = rsqrtf(var + 1e-6f);
            const float y0 = d0 * rs * gam[0] + bet[0], y1 = d1 * rs * gam[1] + bet[1];
            if constexpr (D8_OUT0) *(unsigned short*)((unsigned char*)p.AO + (size_t)(b * SEQ + t0 + wave * 8 + j) * DM + ch) = (unsigned short)(pk4_fp8(siluf_(y0), siluf_(y1), 0.f, 0.f, A8_SCALE) & 0xffffu);
            else *(unsigned*)(p.AO + (size_t)(b * SEQ + t0 + wave * 8 + j) * DM + ch) = pk2(siluf_(y0), siluf_(y1)); }
        __syncthreads();
    }
}
DI unsigned off_b(unsigned row, unsigned ch) { return 256u * row + 16u * (ch ^ (((row & 3u) << 2) | ((row >> 2) & 3u))); }
DI void tr_read4(unsigned a0, unsigned a1, s16x4& r00, s16x4& r01, s16x4& r10, s16x4& r11) {
    asm volatile("ds_read_b64_tr_b16 %0, %4\n\tds_read_b64_tr_b16 %1, %5\n\tds_read_b64_tr_b16 %2, %4 offset:4096\n\tds_read_b64_tr_b16 %3, %5 offset:4096\n\ts_waitcnt lgkmcnt(0)"
                 : "=&v"(r00), "=&v"(r01), "=&v"(r10), "=&v"(r11) : "v"(a0), "v"(a1) : "memory");
}
template <int PASS> DI void attn_wave(const Params& p, LAS unsigned char* vimg, unsigned vb0, unsigned vb1, int lane_, int b, int h, int qbase  ) {
    int lane = lane_; asm volatile("" : "+v"(lane));
    const int c = lane & 31, hh = lane >> 5, srow = lane >> 4, sch = lane & 15;
    constexpr int QS = PASS == 0 ? 16 : 1, NT = PASS == 0 ? 13 : 5;
    const int tq = qbase + QS * c;
    const bf16_t* gb = p.G + (size_t)(b * SEQ) * N_IN0; const bf16_t* kb = p.KVH + (size_t)((b * 8 + h) * 2) * SEQ * 128;
    bf16_t* st_o = p.YB + ((size_t)(b * 8 + h) * SEQ + tq) * 128;
    float* st_ml = (float*)(p.YB + (size_t)NBATCH * 8 * SEQ * 128) + ((size_t)(b * 8 + h) * SEQ + tq) * 2;
    bf16x8 qf[8];
#pragma unroll
    for (int ks = 0; ks < 8; ++ks) qf[ks] = *(const bf16x8*)(gb + (size_t)tq * N_IN0 + 2048 + h * 128 + 16 * ks + 8 * hh);
    const float sc2 = 0.08838834764831845f * 1.4426950408889634f, sl2 = exp2f(-(float)(h + 1)) * 1.4426950408889634f;
    f32x16 o[4]; float m_run, l_run;
    if constexpr (PASS == 0) {
#pragma unroll
        for (int i = 0; i < 4; ++i)
#pragma unroll
            for (int j = 0; j < 16; ++j) o[i][j] = 0.f;
        m_run = -30000.f; l_run = 0.f;
    } else {
#pragma unroll
        for (int c4 = 0; c4 < 4; ++c4)
#pragma unroll
            for (int g4 = 0; g4 < 4; ++g4) { const uint2 v = *(const uint2*)(st_o + 32 * c4 + 8 * g4 + 4 * hh); o[c4][4 * g4] = bflo(v.x); o[c4][4 * g4 + 1] = bfhi(v.x); o[c4][4 * g4 + 2] = bflo(v.y); o[c4][4 * g4 + 3] = bfhi(v.y); }
        const f32x2 ml = *(const f32x2*)st_ml; m_run = ml[0]; l_run = hh == 0 ? ml[1] : 0.f;
    }
    auto tile_geom = [&](int tile, int& d, int& sb) { if constexpr (PASS == 0) { if (tile < 5) { d = 16; sb = qbase - 1024 + 512 * tile; } else { d = 4; sb = qbase - 256 + 128 * (tile - 5); } } else { d = 1; sb = qbase - 64 + 32 * tile; } };
    auto load_k = [&](int tile, bf16x8 (&kf)[8]) { int d, sb; tile_geom(tile, d, sb); int sp = sb + d * c; sp = sp < 0 ? 0 : (sp >= SEQ ? SEQ - 1 : sp);
        const bf16_t* src = kb + (unsigned)(sp * 128 + 8 * hh);
#pragma unroll
        for (int ks = 0; ks < 8; ++ks) kf[ks] = *(const bf16x8*)(src + 16 * ks); };
    auto load_v = [&](int tile, u32x4 (&vv)[8]) { int d, sb; tile_geom(tile, d, sb);
#pragma unroll
        for (int i = 0; i < 8; ++i) { int sp = sb + d * (srow + 4 * i); sp = sp < 0 ? 0 : (sp >= SEQ ? SEQ - 1 : sp); vv[i] = *(const u32x4*)(kb + (unsigned)(SEQ * 128 + sp * 128 + sch * 8)); } };
    bf16x8 kf[8]; u32x4 vv[8];
    load_k(0, kf); load_v(0, vv);
    for (int tile = 0; tile < NT; ++tile) {
        int d, sb; tile_geom(tile, d, sb);
        const int tn = tile < NT - 1 ? tile + 1 : NT - 1;
#pragma unroll
        for (int i = 0; i < 8; ++i) *(LAS u32x4*)(vimg + off_b(srow + 4 * i, sch)) = vv[i];
        load_v(tn, vv);
        f32x16 sacc;
#pragma unroll
        for (int j = 0; j < 16; ++j) sacc[j] = 0.f;
#pragma unroll
        for (int ks = 0; ks < 8; ++ks) sacc = __builtin_amdgcn_mfma_f32_32x32x16_bf16(kf[ks], qf[ks], sacc, 0, 0, 0);
        load_k(tn, kf);
        const float df = (float)d, basef = (float)(sb - tq) + df * (float)(4 * hh);
        const float lo = fmaxf(-64.f * df, -(float)tq), hi = fminf(64.f * df, (float)(SEQ - 1 - tq));
        const float mid = 0.5f * (lo + hi), half = 0.5f * (hi - lo);
        float tmax = -1e30f;
#pragma unroll
        for (int i = 0; i < 16; ++i) { const float deltaf = basef + df * (float)((i & 3) + 8 * (i >> 2));
            const bool valid = __builtin_fabsf(deltaf - mid) <= half;
            const float sv = valid ? sacc[i] * sc2 - sl2 * __builtin_fabsf(deltaf) : -1e30f; sacc[i] = sv; tmax = fmaxf(tmax, sv); }
        tmax = fmaxf(tmax, __shfl_xor(tmax, 32));
        const float m_new = tmax > m_run + 8.0f ? tmax : m_run;
        if (__any(m_new != m_run)) { const float alpha = __builtin_amdgcn_exp2f(m_run - m_new);
            l_run *= alpha;
#pragma unroll
            for (int i = 0; i < 4; ++i) o[i] *= alpha; }
        m_run = m_new;
        float psum = 0.f;
#pragma unroll
        for (int i = 0; i < 16; ++i) { const float pi = __builtin_amdgcn_exp2f(sacc[i] - m_new); psum += pi; sacc[i] = pi; }
        l_run += psum;
        bf16x8 pf[2];
#pragma unroll
        for (int s = 0; s < 2; ++s) { const unsigned w0 = pk2(sacc[8 * s], sacc[8 * s + 1]), w1 = pk2(sacc[8 * s + 2], sacc[8 * s + 3]), w2 = pk2(sacc[8 * s + 4], sacc[8 * s + 5]), w3 = pk2(sacc[8 * s + 6], sacc[8 * s + 7]);
            pf[s] = __builtin_bit_cast(bf16x8, (u32x4){w0, w1, w2, w3}); }
#pragma unroll
        for (int c4 = 0; c4 < 4; ++c4) {
            s16x4 r00, r01, r10, r11; tr_read4(vb0 ^ (unsigned)(c4 << 6), vb1 ^ (unsigned)(c4 << 6), r00, r01, r10, r11);
            const bf16x8 v0 = __builtin_shufflevector(r00, r01, 0, 1, 2, 3, 4, 5, 6, 7), v1 = __builtin_shufflevector(r10, r11, 0, 1, 2, 3, 4, 5, 6, 7);
            o[c4] = __builtin_amdgcn_mfma_f32_32x32x16_bf16(v0, pf[0], o[c4], 0, 0, 0);
            o[c4] = __builtin_amdgcn_mfma_f32_32x32x16_bf16(v1, pf[1], o[c4], 0, 0, 0); }
    }
    const float ltot = l_run + __shfl_xor(l_run, 32);
    if constexpr (PASS == 0) {
#pragma unroll
        for (int c4 = 0; c4 < 4; ++c4)
#pragma unroll
            for (int g4 = 0; g4 < 4; ++g4) *(uint2*)(st_o + 32 * c4 + 8 * g4 + 4 * hh) = make_uint2(pk2(o[c4][4 * g4], o[c4][4 * g4 + 1]), pk2(o[c4][4 * g4 + 2], o[c4][4 * g4 + 3]));
        if (hh == 0) *(f32x2*)st_ml = (f32x2){m_run, ltot};
    } else {
        const float inv = 1.0f / ltot;
        bf16_t* orow = p.AO + (size_t)(b * SEQ + tq) * DM + 1024 + h * 128;
#pragma unroll
        for (int c4 = 0; c4 < 4; ++c4)
#pragma unroll
            for (int g4 = 0; g4 < 4; ++g4) { const int dh = 32 * c4 + 8 * g4 + 4 * hh;
                if constexpr (D8_OUT0) *(unsigned*)((unsigned char*)p.AO + (size_t)(b * SEQ + tq) * DM + 1024 + h * 128 + dh) = pk4_fp8(o[c4][4 * g4] * inv, o[c4][4 * g4 + 1] * inv, o[c4][4 * g4 + 2] * inv, o[c4][4 * g4 + 3] * inv, A8_SCALE);
                else *(uint2*)(orow + dh) = make_uint2(pk2(o[c4][4 * g4] * inv, o[c4][4 * g4 + 1] * inv), pk2(o[c4][4 * g4 + 2] * inv, o[c4][4 * g4 + 3] * inv)); }
    }
}
DI void attention(const Params& p, LAS unsigned char* lds) {
    const int tid = opaque_tid(), wave = __builtin_amdgcn_readfirstlane(tid >> 6), lane = tid & 63, hh = lane >> 5;
    LAS unsigned char* vimg = lds + wave * 8192;
    const unsigned vbase = (unsigned)(uintptr_t)vimg;
    const int q4 = (lane & 15) >> 2, pp = lane & 3, blk = (lane >> 4) & 1;
    const unsigned vb0 = vbase + 256u * (4 * hh + q4) + 16u * ((2 * blk + (pp >> 1)) ^ (hh & 3)) + 8u * (pp & 1) + ((unsigned)q4 << 6);
    const unsigned vb1 = vbase + 256u * (8 + 4 * hh + q4) + 16u * ((2 * blk + (pp >> 1)) ^ ((2 + hh) & 3)) + 8u * (pp & 1) + ((unsigned)q4 << 6);
    for (int u = blockIdx.x; u < 256; u += gridDim.x) {
        const int bh = (u & 7) * 4 + ((u >> 3) >> 3), span = (u >> 3) & 7, h = bh & 7, b = bh >> 3;
#pragma unroll 1
        for (int j = 0; j < 2; ++j) attn_wave<0>(p, vimg, vb0, vb1, lane, b, h, span * 512 + wave * 2 + j);
        asm volatile("s_waitcnt vmcnt(0)" ::: "memory");
        __syncthreads();
#pragma unroll 1
        for (int j = 0; j < 2; ++j) attn_wave<1>(p, vimg, vb0, vb1, lane, b, h, span * 512 + (wave * 2 + j) * 32);
        __syncthreads();
    }
}
DI float om_exp2x(float la, float a) {
    const float x = 2.f * la;
    const float pl = x * (1.f + x * (0.5f + x * (0.16666667f + x * (0.041666668f + x * 0.008333334f))));
    return x > -0.25f ? -pl : 1.f - a * a;
}
DI void lru_conv(const Params& p) {
    const int tid = opaque_tid();
    if (tid < 336) {
        const int ch = tid * 8;
        float cw[4][8], cb[8];
#pragma unroll
        for (int j = 0; j < 4; ++j) { const f32x4 w0 = *(const f32x4*)(p.lru_conv_w + j * LRU_W + ch), w1 = *(const f32x4*)(p.lru_conv_w + j * LRU_W + ch + 4);
            cw[j][0] = w0[0]; cw[j][1] = w0[1]; cw[j][2] = w0[2]; cw[j][3] = w0[3]; cw[j][4] = w1[0]; cw[j][5] = w1[1]; cw[j][6] = w1[2]; cw[j][7] = w1[3]; }
        { const f32x4 b0 = *(const f32x4*)(p.lru_conv_b + ch), b1 = *(const f32x4*)(p.lru_conv_b + ch + 4); cb[0] = b0[0]; cb[1] = b0[1]; cb[2] = b0[2]; cb[3] = b0[3]; cb[4] = b1[0]; cb[5] = b1[1]; cb[6] = b1[2]; cb[7] = b1[3]; }
        for (int run = blockIdx.x; run < T_TOK / 32; run += gridDim.x) {
            const int tok0 = run * 32, t0 = tok0 % SEQ;
            const bf16_t* src = p.G + (size_t)tok0 * N_IN1 + LRU_W + ch;
            u32x4 rows[35];
#pragma unroll
            for (int i = 0; i < 35; ++i) { const int t = t0 - 2 + i; rows[i] = (t >= 0 && t < SEQ) ? *(const u32x4*)(src + (ptrdiff_t)(i - 2) * N_IN1) : (u32x4){0u, 0u, 0u, 0u}; }
#pragma unroll
            for (int i = 0; i < 32; ++i) { float xc[8];
#pragma unroll
                for (int e = 0; e < 8; ++e) xc[e] = cb[e];
#pragma unroll
                for (int j = 0; j < 4; ++j) { const u32x4 xv = rows[i + j];
                    xc[0] += cw[j][0] * bflo(xv[0]); xc[1] += cw[j][1] * bfhi(xv[0]); xc[2] += cw[j][2] * bflo(xv[1]); xc[3] += cw[j][3] * bfhi(xv[1]);
                    xc[4] += cw[j][4] * bflo(xv[2]); xc[5] += cw[j][5] * bfhi(xv[2]); xc[6] += cw[j][6] * bflo(xv[3]); xc[7] += cw[j][7] * bfhi(xv[3]); }
                *(u32x4*)(p.XC + (size_t)(tok0 + i) * LRU_W + ch) = (u32x4){pk2(xc[0], xc[1]), pk2(xc[2], xc[3]), pk2(xc[4], xc[5]), pk2(xc[6], xc[7])}; }
        }
    }
}
DI void lru(const Params& p, LAS unsigned char* lds) {
    const int tid = opaque_tid(), wave = __builtin_amdgcn_readfirstlane(tid >> 6), lane = tid & 63, col = lane & 15, g = lane >> 4;
    LAS unsigned char* wl = lds;
    LAS unsigned char* xs = lds + 36864;
    LAS float* sums = (LAS float*)(lds + 36864 + 86016);
    LAS float* cst = sums + 1920;
    for (int u = blockIdx.x; u < 256; u += gridDim.x) {
        const int b = u >> 6, n = (u >> 2) & 15, qt = u & 3, chq = n * LRU_BW + qt * 42;
        const char* xcb = (const char*)(p.XC + (size_t)(b * SEQ) * LRU_W + n * LRU_BW);
        const bf16_t* gb = p.G + (size_t)(b * SEQ) * N_IN1;
        unsigned poff[6];
#pragma unroll
        for (int i = 0; i < 6; ++i) { const int idx = tid + 512 * i; poff[i] = (unsigned)((idx / 21) * LRU_W + (idx % 21) * 8) * 2u; }
        auto dma_chunk = [&](int chunk, int bsel) { const char* src = xcb + (size_t)chunk * 128 * LRU_W * 2; LAS unsigned char* dst = xs + bsel * 43008 + wave * 1024;
#pragma unroll
            for (int i = 0; i < 5; ++i) __builtin_amdgcn_global_load_lds((const unsigned*)(src + poff[i]), (LAS unsigned*)(dst + i * 8192), 16, 0, 0);
            if (wave < 2) __builtin_amdgcn_global_load_lds((const unsigned*)(src + poff[5]), (LAS unsigned*)(dst + 5 * 8192), 16, 0, 0); };
        for (int dir = 0; dir < 2; ++dir) {
            __syncthreads();
            for (int i = tid; i < 2 * 48 * 24; i += 512) { const int which = i / (48 * 24), r = (i / 24) % 48, ck = i % 24; const int nt = r >> 4, cl = r & 15, ks = ck >> 2, gg = ck & 3;
                *(LAS u32x4*)(wl + ((which * 3 + nt) * 6 + ks) * 1024 + (gg * 16 + cl) * 16) = *(const u32x4*)(p.w_lru + ((((size_t)(dir * 2 + which) * 16 + n) * 4 + qt) * 48 + r) * 192 + ck * 8); }
            if (tid < 48) { const bool valid = tid < 42; const int ch = dir * LRU_W + chq + tid;
                cst[tid] = valid ? -1.44269504f * p.lru_b_a[ch] : 0.f; cst[48 + tid] = valid ? -1.44269504f * p.lru_b_x[ch] : 0.f;
                const float lam = valid ? p.lru_lambda[ch] : 0.f; const float sp = (-lam > 20.f) ? -lam : log1pf(__expf(-lam)); cst[96 + tid] = -8.0f * 1.44269504f * sp; }
            dma_chunk(dir == 0 ? 0 : 31, 0);
            asm volatile("s_waitcnt vmcnt(0)" ::: "memory");
            __syncthreads();
            float cba[3], cbx[3], cex[3];
#pragma unroll
            for (int nt = 0; nt < 3; ++nt) { cba[nt] = cst[nt * 16 + col]; cbx[nt] = cst[48 + nt * 16 + col]; cex[nt] = cst[96 + nt * 16 + col]; }
            bf16x8 breg[3][6];
#pragma unroll
            for (int nt = 0; nt < 3; ++nt)
#pragma unroll
                for (int ks = 0; ks < 6; ++ks) { breg[nt][ks] = *(const LAS bf16x8*)(wl + (nt * 6 + ks) * 1024 + lane * 16); asm volatile("" : "+v"(breg[nt][ks])); }
            const int wpos = dir == 0 ? wave : 7 - wave;
            float carry[3] = {0.f, 0.f, 0.f};
            for (int step = 0; step < 32; ++step) {
                const int c = dir == 0 ? step : 31 - step, c0 = c * 128, par = step & 1;
                const bool has_next = step < 31;
                if (has_next) dma_chunk(dir == 0 ? c + 1 : c - 1, par ^ 1);
                LAS unsigned char* xb = xs + par * 43008;
                uint2 hfv[3] = {make_uint2(0u, 0u), make_uint2(0u, 0u), make_uint2(0u, 0u)}; unsigned short gtv[3][4];
                const uint2* hfp = (const uint2*)p.HF + ((size_t)((u * 32 + c) * 8 + wave) * 3) * 64 + lane;
                const bf16_t* gbw = gb + (size_t)(c0 + wave * 16) * N_IN1 + chq;
                bf16_t* aow = p.AO + (size_t)(b * SEQ + c0 + wave * 16) * LRU_W + chq;
                if (dir == 1) {
#pragma unroll
                    for (int nt = 0; nt < 3; ++nt) { hfv[nt] = hfp[nt * 64];
#pragma unroll
                        for (int r = 0; r < 4; ++r) gtv[nt][r] = (nt * 16 + col < 42) ? gbw[(unsigned)((4 * g + r) * N_IN1 + nt * 16 + col)] : (unsigned short)0; } }
                bf16x8 af[6];
#pragma unroll
                for (int ks = 0; ks < 6; ++ks) { const int ch0 = 32 * ks + 8 * g; const bool kval = ch0 < LRU_BW; const int chl0 = kval ? ch0 : 160;
                    const u32x4 xv = *(const LAS u32x4*)(xb + (wave * 16 + col) * 336 + chl0 * 2);
                    af[ks] = __builtin_bit_cast(bf16x8, kval ? xv : (u32x4){0u, 0u, 0u, 0u}); }
                f32x4 acc[2][3];
#pragma unroll
                for (int w2 = 0; w2 < 2; ++w2)
#pragma unroll
                    for (int nt = 0; nt < 3; ++nt) { acc[w2][nt] = (f32x4){0.f, 0.f, 0.f, 0.f};
#pragma unroll
                        for (int ks = 0; ks < 6; ++ks) { const bf16x8 bfr = w2 == 0 ? breg[nt][ks] : *(const LAS bf16x8*)(wl + ((w2 * 3 + nt) * 6 + ks) * 1024 + lane * 16);
                            acc[w2][nt] = __builtin_amdgcn_mfma_f32_16x16x32_bf16(af[ks], bfr, acc[w2][nt], 0, 0, 0); } }
                float hl[3][4], Pl[3][4];
#pragma unroll
                for (int nt = 0; nt < 3; ++nt) { const int chl = nt * 16 + col;
                    float av[4], uv[4];
#pragma unroll
                    for (int r = 0; r < 4; ++r) {
                        const float rg = __builtin_amdgcn_rcpf(1.0f + __builtin_amdgcn_exp2f(__builtin_fmaf(acc[0][nt][r], -1.44269504f, cba[nt])));
                        const float ig = __builtin_amdgcn_rcpf(1.0f + __builtin_amdgcn_exp2f(__builtin_fmaf(acc[1][nt][r], -1.44269504f, cbx[nt])));
                        const float a = __builtin_amdgcn_exp2f(cex[nt] * rg);
                        const float xcv = bf2f(*(const LAS bf16_t*)(xb + (wave * 16 + 4 * g + r) * 336 + (qt * 42 + chl) * 2));
                        av[r] = a; uv[r] = __builtin_amdgcn_sqrtf(__builtin_fmaf(-a, a, 1.0f)) * (ig * xcv); }
                    float h[4], P[4], A, H;
                    if (dir == 0) { h[0] = uv[0]; P[0] = av[0];
#pragma unroll
                        for (int r = 1; r < 4; ++r) { h[r] = av[r] * h[r - 1] + uv[r]; P[r] = av[r] * P[r - 1]; }
                        A = P[3]; H = h[3];
                        { const float A1 = __shfl_up(A, 16), H1 = __shfl_up(H, 16); if (g >= 1) { H = A * H1 + H; A = A * A1; } }
                        { const float A2 = __shfl_up(A, 32), H2 = __shfl_up(H, 32); if (g >= 2) { H = A * H2 + H; A = A * A2; } }
                        float Ae = __shfl_up(A, 16), He = __shfl_up(H, 16); if (g == 0) { Ae = 1.f; He = 0.f; }
#pragma unroll
                        for (int r = 0; r < 4; ++r) { hl[nt][r] = h[r] + P[r] * He; Pl[nt][r] = P[r] * Ae; }
                        if (g == 3) *(LAS f32x2*)(sums + (par * 48 + chl) * 20 + wpos * 2) = (f32x2){A, H};
                    } else { h[3] = uv[3]; P[3] = av[3];
#pragma unroll
                        for (int r = 2; r >= 0; --r) { h[r] = av[r] * h[r + 1] + uv[r]; P[r] = av[r] * P[r + 1]; }
                        A = P[0]; H = h[0];
                        { const float A1 = __shfl_down(A, 16), H1 = __shfl_down(H, 16); if (g <= 2) { H = A * H1 + H; A = A * A1; } }
                        { const float A2 = __shfl_down(A, 32), H2 = __shfl_down(H, 32); if (g <= 1) { H = A * H2 + H; A = A * A2; } }
                        float Ae = __shfl_down(A, 16), He = __shfl_down(H, 16); if (g == 3) { Ae = 1.f; He = 0.f; }
#pragma unroll
                        for (int r = 0; r < 4; ++r) { hl[nt][r] = h[r] + P[r] * He; Pl[nt][r] = P[r] * Ae; }
                        if (g == 0) *(LAS f32x2*)(sums + (par * 48 + chl) * 20 + wpos * 2) = (f32x2){A, H};
                    }
                }
                asm volatile("s_waitcnt vmcnt(0)" ::: "memory");
                __syncthreads();
                f32x4 sv[3][4];
#pragma unroll
                for (int nt = 0; nt < 3; ++nt)
#pragma unroll
                    for (int j = 0; j < 4; ++j) sv[nt][j] = *(const LAS f32x4*)(sums + (par * 48 + nt * 16 + col) * 20 + j * 4);
#pragma unroll
                for (int nt = 0; nt < 3; ++nt) { const int chl = nt * 16 + col; float C = carry[nt], Cw = 0.f;
#pragma unroll
                    for (int k = 0; k < 8; ++k) { if (k == wpos) Cw = C; C = sv[nt][k >> 1][(k & 1) * 2] * C + sv[nt][k >> 1][(k & 1) * 2 + 1]; }
                    carry[nt] = C;
                    float hv[4];
#pragma unroll
                    for (int r = 0; r < 4; ++r) hv[r] = hl[nt][r] + Pl[nt][r] * Cw;
                    if (dir == 0) ((uint2*)p.HF)[((size_t)((u * 32 + c) * 8 + wave) * 3 + nt) * 64 + lane] = make_uint2(pk2(hv[0], hv[1]), pk2(hv[2], hv[3]));
                    else if (chl < 42) { const float ff[4] = {bflo(hfv[nt].x), bfhi(hfv[nt].x), bflo(hfv[nt].y), bfhi(hfv[nt].y)};
#pragma unroll
                        for (int r = 0; r < 4; ++r) aow[(unsigned)((4 * g + r) * LRU_W + chl)] = f2bf(bf2f(gtv[nt][r]) * (ff[r] + hv[r])); }
                }
            }
        }
    }
}
}

#define XB_TMO      128
#define XB_XCNT(j)  (256  + 64 * (j))
#define XB_XSUB(j)  (1280 + 64 * (j))
#define XB_XGEN(j)  (2304 + 64 * (j))
#define XB_TOP      3328
#define XB_TOPGEN   3392
#define XCD_BAR_WORDS 3456
#define XB_SPIN_CAP (1u << 18)

__device__ __forceinline__ unsigned xb_ld(unsigned* p)              { return __hip_atomic_load(p, __ATOMIC_RELAXED, __HIP_MEMORY_SCOPE_AGENT); }
__device__ __forceinline__ unsigned xb_add(unsigned* p, unsigned v) { return __hip_atomic_fetch_add(p, v, __ATOMIC_RELAXED, __HIP_MEMORY_SCOPE_AGENT); }
__device__ __forceinline__ unsigned xb_xcc_id() { return (unsigned)__builtin_amdgcn_s_getreg((3 << 11) | 20) & 0xFu; }
#define XB_SPIN(cond, bar) do { unsigned _sp = 0; while (cond) { __builtin_amdgcn_s_sleep(1); \
    if ((++_sp & 255u) == 0u) { if (xb_ld(&(bar)[XB_TMO])) break; if (_sp > XB_SPIN_CAP) { atomicAdd(&(bar)[XB_TMO], 1u); break; } } } } while (0)

struct XcdBarrier {
    unsigned* bar; unsigned x;
    volatile LAS unsigned* st;
};

__device__ __forceinline__ XcdBarrier xcd_barrier_post(unsigned* bar, volatile LAS unsigned* st) {
    XcdBarrier b; b.bar = bar; b.x = xb_xcc_id(); b.st = st;
    if (threadIdx.x == 0) (void)xb_add(&bar[XB_XCNT(b.x)], 1u);
    return b;
}
__device__ __forceinline__ void xcd_barrier_complete(unsigned* bar, unsigned x, unsigned& nloc, unsigned& nx) {
    const unsigned G = gridDim.x * gridDim.y * gridDim.z;
    unsigned sum, cnt, mine, sp = 0u;
    for (;;) {
        sum = 0u; cnt = 0u; mine = 0u;
#pragma unroll
        for (unsigned j = 0; j < 16; ++j) { const unsigned c = xb_ld(&bar[XB_XCNT(j)]); sum += c; cnt += (c > 0u) ? 1u : 0u; mine = (j == x) ? c : mine; }
        if (sum == G) break;
        __builtin_amdgcn_s_sleep(1);
        if ((++sp & 255u) == 0u) { if (xb_ld(&bar[XB_TMO])) break; if (sp > XB_SPIN_CAP) { atomicAdd(&bar[XB_TMO], 1u); break; } }
    }
    nloc = mine > 0u ? mine : 1u; nx = cnt > 0u ? cnt : 1u;
}

__device__ __forceinline__ void xcd_barrier(const XcdBarrier& b) {
    asm volatile("s_waitcnt vmcnt(0)" ::: "memory");
    __syncthreads();
    if (threadIdx.x == 0) {
        unsigned* bar = b.bar;
        __builtin_amdgcn_s_waitcnt(0);
        unsigned nloc = b.st[0], nx = b.st[1];
        if (nloc == 0u) { xcd_barrier_complete(bar, b.x, nloc, nx); b.st[0] = nloc; b.st[1] = nx; }
        const unsigned old = xb_add(&bar[XB_XSUB(b.x)], 1u);
        const unsigned gen = old / nloc;
        if (old + 1u == (gen + 1u) * nloc) {
            __builtin_amdgcn_fence(__ATOMIC_RELEASE, "agent");
            asm volatile("s_waitcnt vmcnt(0)" ::: "memory");
            const unsigned og = xb_add(&bar[XB_TOP], 1u);
            const unsigned tg = og / nx;
            if (og + 1u == (tg + 1u) * nx) xb_add(&bar[XB_TOPGEN], 1u);
            else XB_SPIN(xb_ld(&bar[XB_TOPGEN]) == tg, bar);
            __builtin_amdgcn_fence(__ATOMIC_ACQUIRE, "agent");
            xb_add(&bar[XB_XGEN(b.x)], 1u);
            asm volatile("s_waitcnt vmcnt(0)" ::: "memory");
        } else {
            XB_SPIN(xb_ld(&bar[XB_XGEN(b.x)]) == gen, bar);
            __builtin_amdgcn_fence(__ATOMIC_ACQUIRE, "agent");
            asm volatile("s_waitcnt vmcnt(0)" ::: "memory");
        }
    }
    __syncthreads();
}


constexpr int PROBE = 0;
constexpr int LDS_XB_OFF = gm::STAGE_BYTES + 1024;
constexpr int LDS_TOTAL = LDS_XB_OFF + 16;
__global__ void __launch_bounds__(512, 2) mega(Params p) {
    LAS unsigned char* lds = (LAS unsigned char*)dyn_smem;
    LAS int* tab = (LAS int*)(lds + gm::TAB_OFF);
    volatile LAS unsigned* xbw = (volatile LAS unsigned*)(lds + LDS_XB_OFF);
    if (threadIdx.x == 0) { xbw[0] = 0u; xbw[1] = 0u; xbw[2] = 0u; xbw[3] = 0u; }
    __syncthreads();
    XcdBarrier bar = xcd_barrier_post(p.bar, xbw);
    ph::mods(p, lds);
    if constexpr (PROBE == 14) { ph::mods(p, lds); ph::mods(p, lds); }
    xcd_barrier(bar);
    { const int c = blockIdx.x, G = gridDim.x;
      ph::transposer(p, lds, c, c < 320 ? (320 - c + G - 1) / G : 0, G); __syncthreads();
      ph::transposer(p, lds, 320 + c, c < 632 ? (632 - c + G - 1) / G : 0, G); __syncthreads(); }
    ph::lru_weights(p);
    ph::fold_router(p);
    ph::norm_rows<0, D8_IN0>(p, p.x, p.norm0_mix, 0, 0, nullptr);
    xcd_barrier(bar);
    { const int c = blockIdx.x, G = gridDim.x; const int tcount = c < 6144 ? (6144 - c + G - 1) / G : 0; const bool t_first = ((c >> 3) & 1) != 0;
      if (t_first) { ph::transposer(p, lds, 952 + c, tcount, G); __syncthreads(); }
      { gm::DenseSched S; S.init(T_TOK, N_IN0); EpiIn0 e; e.xin = nullptr; e.lgate = 0; if constexpr (D8_IN0) gm::gemm_phase<EpiIn0, gm::DenseSched, true>(lds, p, p.H, p.w_in0t, 0, DM / 2, S, e, W8_E8M0, A8_E8M0); else gm::gemm_phase(lds, p, p.H, p.w_in0t, 0, DM, S, e); }
      if (!t_first) { __syncthreads(); ph::transposer(p, lds, 952 + c, tcount, G); }
      if constexpr (PROBE == 21) { __syncthreads(); ph::transposer(p, lds, 952 + c, tcount, G); }
      if constexpr (PROBE == 24) { __syncthreads(); if (t_first) ph::transposer(p, lds, 952 + c, tcount, G); }
      if constexpr (PROBE == 23) { __syncthreads(); if (t_first) { ph::transposer(p, lds, 952 + c, tcount, G); __syncthreads(); }
        { gm::DenseSched S; S.init(T_TOK, N_IN0); EpiIn0 e; e.xin = nullptr; e.lgate = 0; gm::gemm_phase<EpiIn0, gm::DenseSched, true>(lds, p, p.H, p.w_in0t, 0, DM / 2, S, e, W8_E8M0, A8_E8M0); }
        if (!t_first) { __syncthreads(); ph::transposer(p, lds, 952 + c, tcount, G); } }
      if constexpr (PROBE == 20) { __syncthreads(); gm::DenseSched S; S.init(T_TOK, N_IN0); EpiIn0 e; e.xin = nullptr; e.lgate = 0; gm::gemm_phase<EpiIn0, gm::DenseSched, true>(lds, p, p.H, p.w_in0t, 0, DM / 2, S, e, W8_E8M0, A8_E8M0); } }
    xcd_barrier(bar);
    ph::attention(p, lds);
    if constexpr (PROBE == 4) ph::attention(p, lds);
    __syncthreads();
    ph::conv_gln(p, lds);
    if constexpr (PROBE == 5) ph::conv_gln(p, lds);
    xcd_barrier(bar);
    { gm::DenseSched S; S.init(T_TOK, DM); EpiOut e; e.xin = p.x; e.lgate = 0; if constexpr (D8_OUT0) gm::gemm_phase<EpiOut, gm::DenseSched, true>(lds, p, p.AO, p.w_out0t, 0, DM / 2, S, e, W8_E8M0, A8_E8M0); else gm::gemm_phase(lds, p, p.AO, p.w_out0t, 0, DM, S, e); }
    xcd_barrier(bar);
    ph::router<false, true>(p, 0, lds, p.norm0_ffn, 1);
    if constexpr (PROBE == 12) { ph::router<true>(p, 0, lds); ph::router<true>(p, 0, lds); }
    xcd_barrier(bar);
    if constexpr (PROBE == 11) { xcd_barrier(bar); xcd_barrier(bar); xcd_barrier(bar); xcd_barrier(bar); xcd_barrier(bar); xcd_barrier(bar); xcd_barrier(bar); xcd_barrier(bar); xcd_barrier(bar); xcd_barrier(bar); }
    gm::moe_tables(tab, p.cnt);
    { gm::MoeSched<true> S; S.init(tab); EpiGU e; e.xin = nullptr; e.lgate = 0; gm::gemm_phase<EpiGU, gm::MoeSched<true>, true>(lds, p, p.H, p.w_gut0, (size_t)2048 * (DM / 2), DM / 2, S, e, W8_E8M0, A8_E8M0); if constexpr (PROBE == 3) gm::gemm_phase<EpiGU, gm::MoeSched<true>, true>(lds, p, p.H, p.w_gut0, (size_t)2048 * (DM / 2), DM / 2, S, e, W8_E8M0, A8_E8M0); }
    xcd_barrier(bar);
    { gm::MoeSched<false> S; S.init(tab); EpiDown e; e.xin = nullptr; e.lgate = 0; gm::gemm_phase<EpiDown, gm::MoeSched<false>, true>(lds, p, p.ACT, p.w_dt0, (size_t)DM * (EFF / 2), EFF / 2, S, e, W8_E8M0, A8_E8M0); if constexpr (PROBE == 8) gm::gemm_phase<EpiDown, gm::MoeSched<false>, true>(lds, p, p.ACT, p.w_dt0, (size_t)DM * (EFF / 2), EFF / 2, S, e, W8_E8M0, A8_E8M0); }
    xcd_barrier(bar);
    ph::norm_rows<1, D8_IN1>(p, nullptr, p.norm1_mix, 2, 1, tab);
    xcd_barrier(bar);
    { const int c = blockIdx.x, G = gridDim.x; int tfirst, tcount, tstride;
      if (G == 256) { tstride = 1; if (c < 64) { tcount = 18; tfirst = 18 * c; } else { tcount = 26; tfirst = 1152 + 26 * (c - 64); } }
      else { tstride = G; tfirst = c; tcount = c < 6144 ? (6144 - c + G - 1) / G : 0; }
      const bool t_first = ((c >> 3) & 1) != 0;
      if (t_first) { ph::transposer(p, lds, 7096 + tfirst, tcount, tstride); __syncthreads(); }
      { gm::DenseSched S; S.init(T_TOK, N_IN1); EpiIn1 e; e.xin = nullptr; e.lgate = 0; gm::gemm_phase(lds, p, p.H, p.w_in1t, 0, DM, S, e); }
      if (!t_first) { __syncthreads(); ph::transposer(p, lds, 7096 + tfirst, tcount, tstride); } }
    xcd_barrier(bar);
    ph::lru_conv(p);
    if constexpr (PROBE == 9) { ph::lru_conv(p); ph::lru_conv(p); }
    xcd_barrier(bar);
    ph::lru(p, lds);
    if constexpr (PROBE == 6) ph::lru(p, lds);
    xcd_barrier(bar);
    { gm::DenseSched S; S.init(T_TOK, DM); EpiOut e; e.xin = nullptr; e.lgate = 2; gm::gemm_phase(lds, p, p.AO, p.w_out1t, 0, LRU_W, S, e); }
    xcd_barrier(bar);
    ph::router<false, true>(p, 1, lds, p.norm1_ffn, 3);
    xcd_barrier(bar);
    gm::moe_tables(tab, p.cnt + 32);
    { gm::MoeSched<true> S; S.init(tab); EpiGU e; e.xin = nullptr; e.lgate = 0; gm::gemm_phase<EpiGU, gm::MoeSched<true>, true>(lds, p, p.H, p.w_gut1, (size_t)2048 * (DM / 2), DM / 2, S, e, W8_E8M0, A8_E8M0); }
    xcd_barrier(bar);
    { gm::MoeSched<false> S; S.init(tab); EpiDown e; e.xin = nullptr; e.lgate = 0; gm::gemm_phase<EpiDown, gm::MoeSched<false>, true>(lds, p, p.ACT, p.w_dt1, (size_t)DM * (EFF / 2), EFF / 2, S, e, W8_E8M0, A8_E8M0); }
    xcd_barrier(bar);
    ph::norm_rows<2>(p, nullptr, p.norm_final, 0, 3, tab);
}

static inline size_t al256(size_t x) { return (x + 255) & ~(size_t)255; }

extern "C" void kernel_launch(void* const* d_in, const int* in_sizes, int n_in, void* d_out, int out_size, void* d_ws, size_t ws_size, hipStream_t stream) {
    Params p{};
    const float** ip = (const float**)&p.x;
    for (int i = 0; i < 38; ++i) ip[i] = (const float*)d_in[i];
    p.out = (float*)d_out;
    char* w = (char*)d_ws; size_t off = 0;
    auto take = [&](size_t bytes) { char* r = w + off; off += al256(bytes); return r; };
    p.bar = (unsigned*)take(16384); p.cnt = (int*)take(256);
    const size_t zero_bytes = off;
    p.mod = (float*)take(4 * 4 * 6144 * 4); p.wrt = (float*)take((size_t)2 * 4 * 48 * 2048 * 4); p.rbias = (float*)take(2 * 4 * 48 * 4);
    p.w_in0t = (bf16_t*)take((size_t)N_IN0 * DM * 2); p.w_out0t = (bf16_t*)take((size_t)DM * DM * 2);
    p.w_gut0 = (bf16_t*)take((size_t)NEXP * 2048 * DM); p.w_dt0 = (bf16_t*)take((size_t)NEXP * DM * EFF);
    p.w_in1t = (bf16_t*)take((size_t)N_IN1 * DM * 2); p.w_out1t = (bf16_t*)take((size_t)DM * LRU_W * 2);
    p.w_gut1 = (bf16_t*)take((size_t)NEXP * 2048 * DM); p.w_dt1 = (bf16_t*)take((size_t)NEXP * DM * EFF);
    p.w_lru = (bf16_t*)take((size_t)2 * 2 * 16 * 2 * 96 * 192 * 2);
    p.H = (bf16_t*)take((size_t)T_TOK * DM * 2); p.G = (bf16_t*)take((size_t)T_TOK * N_IN1 * 2); p.AO = (bf16_t*)take((size_t)T_TOK * LRU_W * 2); p.HF = (bf16_t*)take((size_t)256 * 32 * 8 * 3 * 64 * 8);
    p.XA = (bf16_t*)take((size_t)T_TOK * DM * 2); p.ACT = (bf16_t*)take((size_t)ROWS_PAD * EFF * 2); p.YB = (bf16_t*)take((size_t)ROWS_PAD * DM * 2);
    p.XC = (bf16_t*)take((size_t)T_TOK * LRU_W * 2); p.KVH = (bf16_t*)take((size_t)NBATCH * 8 * 2 * SEQ * 128 * 2);
    p.tokl = (int*)take((size_t)NEXP * ECAP * 4); p.gatel = (float*)take((size_t)NEXP * ECAP * 4); p.asg = (int*)take((size_t)T_TOK * 2 * 4);
    if (off > ws_size) return;
    (void)hipMemsetAsync(d_ws, 0, zero_bytes, stream);
    static int grid = 0;
    if (!grid) { int dev = 0, cus = 0, per_cu = 0; (void)hipGetDevice(&dev); (void)hipDeviceGetAttribute(&cus, hipDeviceAttributeMultiprocessorCount, dev);
        (void)hipFuncSetAttribute((const void*)mega, hipFuncAttributeMaxDynamicSharedMemorySize, LDS_TOTAL);
        (void)hipOccupancyMaxActiveBlocksPerMultiprocessor(&per_cu, mega, 512, LDS_TOTAL);
        grid = cus * (per_cu < 1 ? per_cu : 1); }
    if (grid > 0) mega<<<grid, 512, LDS_TOTAL, stream>>>(p);
}
```

```cpp
#include <hip/hip_runtime.h>
#include <stdint.h>

typedef unsigned short bf16_t;
typedef float f32x4 __attribute__((ext_vector_type(4)));

#define DI __device__ __forceinline__

constexpr int T_TOK = 16384, DM = 2048, SEQ = 4096, NBATCH = 4;
constexpr int N_IN0 = 5120, N_IN1 = 5376, LRU_W = 2688, LRU_BW = 168;
constexpr int NEXP = 32, EFF = 1024, ECAP = 16384, ROWS_PAD = 40960;

DI float bf2f(bf16_t b) { return __uint_as_float(((unsigned)b) << 16); }
DI bf16_t f2bf(float f) { unsigned u = __float_as_uint(f); u += 0x7FFFu + ((u >> 16) & 1u); return (bf16_t)(u >> 16); }
DI float sigmoidf_(float x) { return __builtin_amdgcn_rcpf(1.0f + __expf(-x)); }
DI float siluf_(float x) { return x * __builtin_amdgcn_rcpf(1.0f + __expf(-x)); }
DI float gelu_tanh(float x) { const float u = 0.7978845608028654f * (x + 0.044715f * x * x * x); return x * __builtin_amdgcn_rcpf(1.0f + __expf(-2.0f * u)); }
DI float wave_sum(float v) { for (int o = 32; o > 0; o >>= 1) v += __shfl_xor(v, o); return v; }
DI float wave_max(float v) { for (int o = 32; o > 0; o >>= 1) v = fmaxf(v, __shfl_xor(v, o)); return v; }

struct Params {
    const float *x, *c;
    const float *norm0_mix, *ada0_mix_w, *ada0_mix_b, *w_in0, *conv_w, *conv_b, *conv_norm_g, *conv_norm_b, *w_out0;
    const float *norm0_ffn, *ada0_ffn_w, *ada0_ffn_b, *moe0_w_group, *moe0_w_expert, *moe0_w_gate_up, *moe0_w_down;
    const float *norm1_mix, *ada1_mix_w, *ada1_mix_b, *w_in1, *lru_conv_w, *lru_conv_b, *lru_w_a, *lru_b_a, *lru_w_x, *lru_b_x, *lru_lambda, *w_out1;
    const float *norm1_ffn, *ada1_ffn_w, *ada1_ffn_b, *moe1_w_group, *moe1_w_expert, *moe1_w_gate_up, *moe1_w_down;
    const float *norm_final;
    float* out;
    unsigned* bar; int* cnt;
    float* mod;
    float* wrt;
    float* rbias;
    bf16_t *w_in0t, *w_out0t, *w_gut0, *w_dt0, *w_in1t, *w_out1t, *w_gut1, *w_dt1, *w_lru;
    bf16_t *H, *G, *AO, *HF, *ACT, *YB, *XC, *KVH;
    bf16_t* XA;
    int* tokl; float* gatel; int* asg;
};

constexpr bool YB8_E = true;
struct GUnit { int rowbase; int nvalid; int e; const int* gather; };
struct GArgs { const bf16_t* A; const bf16_t* Bt; size_t bt_estride; long long lda, K, moe_layer; const float* xin; long long lgate; };
typedef unsigned u32x4_ __attribute__((ext_vector_type(4)));
typedef __bf16 bf2v_ __attribute__((ext_vector_type(2)));
typedef float f32x2_ __attribute__((ext_vector_type(2)));
DI unsigned pk2e(float a, float b) { f32x2_ v = {a, b}; bf2v_ r = __builtin_convertvector(v, bf2v_); return __builtin_bit_cast(unsigned, r); }
DI u32x4_ pack8(f32x4 a, f32x4 b) { return (u32x4_){pk2e(a[0], a[1]), pk2e(a[2], a[3]), pk2e(b[0], b[1]), pk2e(b[2], b[3])}; }
struct EpiIn0 { static constexpr bool GATHER = false; const float* xin; int lgate; DI void operator()(const Params& p, const GUnit& u, int r, int col0, f32x4 lo0, f32x4 lo1, f32x4 hi0, f32x4 hi1) const {
    const int row = u.rowbase + r;
    if (col0 < 3072) { bf16_t* o = p.G + (size_t)row * N_IN0 + col0; *(u32x4_*)o = pack8(lo0, lo1); *(u32x4_*)(o + 128) = pack8(hi0, hi1); }
    else { const int b = row / SEQ, t = row % SEQ, i0 = (col0 - 3072) >> 7, i1 = i0 + 1;
        bf16_t* o0 = p.KVH + ((size_t)((b * 8 + (i0 & 7)) * 2 + (i0 >> 3)) * SEQ + t) * 128 + (col0 & 127);
        bf16_t* o1 = p.KVH + ((size_t)((b * 8 + (i1 & 7)) * 2 + (i1 >> 3)) * SEQ + t) * 128 + (col0 & 127);
        *(u32x4_*)o0 = pack8(lo0, lo1); *(u32x4_*)o1 = pack8(hi0, hi1); } } };
struct EpiOut { static constexpr bool GATHER = false; const float* xin; int lgate; DI void operator()(const Params& p, const GUnit& u, int r, int col0, f32x4 lo0, f32x4 lo1, f32x4 hi0, f32x4 hi1) const {
    const int row = u.rowbase + r, b = row / SEQ; const float* gt = p.mod + (lgate * 4 + b) * 6144 + 4096 + col0; bf16_t* o = p.XA + (size_t)row * DM + col0;
    f32x4 r0, r1, r2, r3;
    if (xin) { const float* xi = xin + (size_t)row * DM + col0; r0 = *(const f32x4*)xi; r1 = *(const f32x4*)(xi + 4); r2 = *(const f32x4*)(xi + 128); r3 = *(const f32x4*)(xi + 132); }
    else { const u32x4_ a = *(const u32x4_*)o, c = *(const u32x4_*)(o + 128);
        r0 = (f32x4){__uint_as_float(a[0] << 16), __uint_as_float(a[0] & 0xffff0000u), __uint_as_float(a[1] << 16), __uint_as_float(a[1] & 0xffff0000u)};
        r1 = (f32x4){__uint_as_float(a[2] << 16), __uint_as_float(a[2] & 0xffff0000u), __uint_as_float(a[3] << 16), __uint_as_float(a[3] & 0xffff0000u)};
        r2 = (f32x4){__uint_as_float(c[0] << 16), __uint_as_float(c[0] & 0xffff0000u), __uint_as_float(c[1] << 16), __uint_as_float(c[1] & 0xffff0000u)};
        r3 = (f32x4){__uint_as_float(c[2] << 16), __uint_as_float(c[2] & 0xffff0000u), __uint_as_float(c[3] << 16), __uint_as_float(c[3] & 0xffff0000u)}; }
    *(u32x4_*)o = pack8(r0 + *(const f32x4*)gt * lo0, r1 + *(const f32x4*)(gt + 4) * lo1); *(u32x4_*)(o + 128) = pack8(r2 + *(const f32x4*)(gt + 128) * hi0, r3 + *(const f32x4*)(gt + 132) * hi1); } };
DI unsigned pk4_fp8e(float a, float b, float c, float d, float sc) { a = fminf(fmaxf(a * sc, -448.f), 448.f); b = fminf(fmaxf(b * sc, -448.f), 448.f); c = fminf(fmaxf(c * sc, -448.f), 448.f); d = fminf(fmaxf(d * sc, -448.f), 448.f);
    unsigned w = 0u; w = __builtin_amdgcn_cvt_pk_fp8_f32(a, b, w, false); w = __builtin_amdgcn_cvt_pk_fp8_f32(c, d, w, true); return w; }
struct EpiGU { static constexpr bool GATHER = true; const float* xin; int lgate; DI void operator()(const Params& p, const GUnit& u, int r, int col0, f32x4 lo0, f32x4 lo1, f32x4 hi0, f32x4 hi1) const {
    f32x4 a0, a1;
#pragma unroll
    for (int j = 0; j < 4; ++j) { a0[j] = siluf_(lo0[j]) * hi0[j]; a1[j] = siluf_(lo1[j]) * hi1[j]; }
    *(uint2*)((unsigned char*)p.ACT + (size_t)(u.rowbase + r) * EFF + (col0 >> 8) * 128 + (col0 & 127)) = make_uint2(pk4_fp8e(a0[0], a0[1], a0[2], a0[3], 8.f), pk4_fp8e(a1[0], a1[1], a1[2], a1[3], 8.f)); } };
struct EpiDown { static constexpr bool GATHER = false; const float* xin; int lgate; DI void operator()(const Params& p, const GUnit& u, int r, int col0, f32x4 lo0, f32x4 lo1, f32x4 hi0, f32x4 hi1) const {
    const float g = p.gatel[(u.gather - p.tokl) + r];
    if constexpr (YB8_E) { const float gs = g * 64.f; unsigned char* o = (unsigned char*)p.YB + (size_t)(u.rowbase + r) * DM + col0;
        *(uint2*)o = make_uint2(pk4_fp8e(lo0[0], lo0[1], lo0[2], lo0[3], gs), pk4_fp8e(lo1[0], lo1[1], lo1[2], lo1[3], gs)); *(uint2*)(o + 128) = make_uint2(pk4_fp8e(hi0[0], hi0[1], hi0[2], hi0[3], gs), pk4_fp8e(hi1[0], hi1[1], hi1[2], hi1[3], gs)); }
    else { bf16_t* o = p.YB + (size_t)(u.rowbase + r) * DM + col0; *(u32x4_*)o = pack8(lo0 * g, lo1 * g); *(u32x4_*)(o + 128) = pack8(hi0 * g, hi1 * g); } } };
struct EpiIn1 { static constexpr bool GATHER = false; const float* xin; int lgate; DI void operator()(const Params& p, const GUnit& u, int r, int col0, f32x4 lo0, f32x4 lo1, f32x4 hi0, f32x4 hi1) const {
    bf16_t* o = p.G + (size_t)(u.rowbase + r) * N_IN1 + col0;
    if (col0 < LRU_W) {
#pragma unroll
        for (int j = 0; j < 4; ++j) { lo0[j] = gelu_tanh(lo0[j]); lo1[j] = gelu_tanh(lo1[j]); } }
    if (col0 + 128 < LRU_W) {
#pragma unroll
        for (int j = 0; j < 4; ++j) { hi0[j] = gelu_tanh(hi0[j]); hi1[j] = gelu_tanh(hi1[j]); } }
    *(u32x4_*)o = pack8(lo0, lo1); *(u32x4_*)(o + 128) = pack8(hi0, hi1); } };

#define LAS __attribute__((address_space(3)))
typedef short bf16x8 __attribute__((ext_vector_type(8)));
DI int opaque_tid() { int t = threadIdx.x; asm volatile("" : "+v"(t)); return t; }
namespace gm {
constexpr int BM = 256, BK = 64, HALF = 128, HTB = HALF * BK * 2, STAGE_BYTES = 8 * HTB, NXCD = 8, WGM = 4;
constexpr int TAB_OFF = STAGE_BYTES;
DI int lds_byte(int r, int c) { const int st = (r >> 4) * 2 + (c >> 5), rr = r & 15, cc = c & 31, ob = rr * 64 + cc * 2; return st * 1024 + (ob ^ (((ob >> 9) & 1) << 5)); }
DI int perm32(int rho) { const int n = rho >> 4, i = rho & 15; return 8 * (i >> 2) + 4 * n + (i & 3); }
DI void stage_rc(int b, int& R, int& C) { const int st = b / 1024, sb = b % 1024, swz = sb ^ (((sb >> 9) & 1) << 5); R = (st >> 1) * 16 + swz / 64; C = (st & 1) * 32 + (swz % 64) / 2; }
struct Unit { int arow, nvalid, orow, pn, e, goff; };
struct DenseSched {
    static constexpr bool GATHER = false, HALF_SKIP = false;
    int nM, nN, nwg, G, c;
    DI void init(int M, int N) { nM = M / BM; nN = N / BM; nwg = nM * nN; G = gridDim.x; c = blockIdx.x; }
    DI bool next(int i, Unit& u) const {
        const long L = (long)i * G + c; if (L >= nwg) return false;
        int wgid = (int)L; { const int q = nwg / NXCD, r = nwg % NXCD, xcd = wgid % NXCD, off = wgid / NXCD; wgid = (xcd < r ? xcd * (q + 1) : r * (q + 1) + (xcd - r) * q) + off; }
        const int nig = WGM * nN, gid = wgid / nig, fm = gid * WGM, gsz = (nM - fm) < WGM ? (nM - fm) : WGM;
        const int pm = fm + ((wgid % nig) % gsz); u.pn = (wgid % nig) / gsz; u.arow = pm * BM; u.orow = pm * BM; u.nvalid = BM; u.e = 0; u.goff = 0; return true;
    }
};
template <bool GATH> struct MoeSched {
    static constexpr bool GATHER = GATH, HALF_SKIP = true;
    const LAS int* tab; int G, c;
    DI void init(const LAS int* t) { tab = t; G = gridDim.x; c = blockIdx.x; }
    DI bool next(int i, Unit& u) const {
        const int L = i * G + c, mtile = L >> 3; const int total = __builtin_amdgcn_readfirstlane(tab[32]);
        if (mtile >= total) return false;
        int e = 0; for (int j = 1; j < 32; ++j) { if (__builtin_amdgcn_readfirstlane(tab[j]) <= mtile) e = j; }
        const int mt = mtile - __builtin_amdgcn_readfirstlane(tab[e]); const int cn = __builtin_amdgcn_readfirstlane(tab[64 + e]);
        u.e = e; u.pn = L & 7; u.orow = mtile * BM; u.arow = mtile * BM; u.nvalid = (cn - mt * BM) < BM ? (cn - mt * BM) : BM; u.goff = e * ECAP + mt * BM; return true;
    }
};
DI void moe_tables(LAS int* tab, const int* cnt) {
    if (threadIdx.x == 0) { int run = 0; for (int e = 0; e < 32; ++e) { const int cn = cnt[e]; tab[e] = run; tab[64 + e] = cn; run += (cn + 255) >> 8; } tab[32] = run; }
    __syncthreads();
}

typedef int i32x8 __attribute__((ext_vector_type(8)));
typedef int i32x4 __attribute__((ext_vector_type(4)));
DI void mfma8(f32x4& acc, const i32x8& w8, const i32x8& x8, int ws, int as) {
    asm volatile("v_mfma_scale_f32_16x16x128_f8f6f4 %0, %1, %2, %0, %3, %4 op_sel_hi:[0,0,0]" : "+v"(acc) : "v"(w8), "v"(x8), "v"(ws), "v"(as)); }
template <class Epi, class Sched, bool FP8 = false>
DI void gemm_phase(LAS unsigned char* lds, const Params& p, const bf16_t* A, const bf16_t* Bt, size_t bt_estride, int K, const Sched& S, const Epi& E, int wscale = 0x7f7f7f7f, int ascale = 0x7f7f7f7f) {
    const int tid = opaque_tid(), wid = __builtin_amdgcn_readfirstlane(tid >> 6), lane = tid & 63, wr = wid >> 2, wc = wid & 3, fr = lane & 15, fq = lane >> 4;
    const int nt = K / BK;
    unsigned voffA[2], voffB[2];
#pragma unroll
    for (int i = 0; i < 2; ++i) { int R, C; stage_rc(tid * 16 + i * 8192, R, C); voffA[i] = (unsigned)(R * K + C) * 2u; voffB[i] = (unsigned)(((R & ~31) + perm32(R & 31)) * K + C) * 2u; }
    const size_t kstep = (size_t)(BK * 2), hstep = (size_t)HALF * K * 2, tstep = 2 * hstep;
    const unsigned ldsw = (unsigned)wid * 1024u;
    const int aoff = lds_byte(wr * 64 + fr, fq * 8), boff = lds_byte(wc * 32 + fr, fq * 8);
#define G_SA(b, h) (((b) * 2 + (h)) * HTB)
#define G_SB(b, h) ((4 + (b) * 2 + (h)) * HTB)
#define G_STAGE(bufoff, gbase, voff) do { _Pragma("unroll") for (int _i = 0; _i < 2; ++_i) \
        __builtin_amdgcn_global_load_lds((const unsigned*)((const char*)(gbase) + (voff)[_i]), (LAS unsigned*)(lds + (bufoff) + ldsw + _i * 8192), 16, 0, 0); } while (0)
#define G_STAGE_A(bufoff, ubase, gv, h, koff) do { if constexpr (Sched::GATHER) { G_STAGE(bufoff, (const char*)A + (koff), gv[h]); } else { G_STAGE(bufoff, (ubase) + (h) * hstep + (koff), voffA); } } while (0)
#define G_LD16(off_) (*(const LAS i32x4*)(lds + (off_)))
#define G_LD16B(off_) (*(const LAS bf16x8*)(lds + (off_)))
#define G_LDA(dst, b, h) do { _Pragma("unroll") for (int m = 0; m < 4; ++m) { if constexpr (FP8) dst##8[m] = __builtin_shufflevector(G_LD16(G_SA(b, h) + aoff + m * 2048), G_LD16(G_SA(b, h) + aoff + m * 2048 + 1024), 0, 1, 2, 3, 4, 5, 6, 7); \
        else { dst[m][0] = G_LD16B(G_SA(b, h) + aoff + m * 2048); dst[m][1] = G_LD16B(G_SA(b, h) + aoff + m * 2048 + 1024); } } } while (0)
#define G_LDB(dst, b, h) do { _Pragma("unroll") for (int n = 0; n < 2; ++n) { if constexpr (FP8) dst##8[n] = __builtin_shufflevector(G_LD16(G_SB(b, h) + boff + n * 2048), G_LD16(G_SB(b, h) + boff + n * 2048 + 1024), 0, 1, 2, 3, 4, 5, 6, 7); \
        else { dst[n][0] = G_LD16B(G_SB(b, h) + boff + n * 2048); dst[n][1] = G_LD16B(G_SB(b, h) + boff + n * 2048 + 1024); } } } while (0)
#define G_MMA(ai, bj, At, Bt_) do { __builtin_amdgcn_s_setprio(1); _Pragma("unroll") for (int m = 0; m < 4; ++m) _Pragma("unroll") for (int n = 0; n < 2; ++n) { \
        if constexpr (FP8) mfma8(acc[ai][bj][m][n], Bt_##8[n], At##8[m], wscale, ascale); \
        else { _Pragma("unroll") for (int k = 0; k < 2; ++k) acc[ai][bj][m][n] = __builtin_amdgcn_mfma_f32_16x16x32_bf16(Bt_[n][k], At[m][k], acc[ai][bj][m][n], 0, 0, 0); } } \
        __builtin_amdgcn_s_setprio(0); } while (0)
#define G_WAIT_V(n) asm volatile("s_waitcnt vmcnt(" #n ")" ::: "memory")
#define G_WAIT_L(n) asm volatile("s_waitcnt lgkmcnt(" #n ")" ::: "memory")
#define G_BAR __builtin_amdgcn_s_barrier()
#define G_SCHED __builtin_amdgcn_sched_barrier(0)
    Unit cur, nxt; int ui = 0;
    if (!S.next(0, cur)) return;
    f32x4 acc[2][2][4][2];
#pragma unroll
    for (int a = 0; a < 2; ++a)
#pragma unroll
        for (int b = 0; b < 2; ++b)
#pragma unroll
            for (int m = 0; m < 4; ++m)
#pragma unroll
                for (int n = 0; n < 2; ++n) acc[a][b][m][n] = (f32x4){0.f, 0.f, 0.f, 0.f};
    bf16x8 At[4][2], B0[2][2], B1[2][2]; i32x8 At8[4], B08[2], B18[2];
    unsigned gcur[2][2] = {{0u, 0u}, {0u, 0u}}, gnxt[2][2] = {{0u, 0u}, {0u, 0u}};
    auto gather_offs = [&](const Unit& u, unsigned (&g)[2][2]) {
        if constexpr (Sched::GATHER) {
#pragma unroll
            for (int h = 0; h < 2; ++h)
#pragma unroll
                for (int i = 0; i < 2; ++i) { int tz = tid; asm volatile("" : "+v"(tz)); int R, C; stage_rc(tz * 16 + i * 8192, R, C); const int r = h * HALF + R; const int tk = p.tokl[u.goff + (r < u.nvalid ? r : 0)]; const int tok = r < u.nvalid ? tk : 0; g[h][i] = (unsigned)(tok * K + C) * 2u; }
        }
    };
    const char* cA = (const char*)A + (size_t)(cur.arow / BM) * tstep; const char* cB = (const char*)Bt + ((size_t)cur.e * bt_estride) * 2 + (size_t)cur.pn * tstep;
    gather_offs(cur, gcur);
    G_STAGE(G_SB(0, 0), cB, voffB); G_STAGE_A(G_SA(0, 0), cA, gcur, 0, 0); G_STAGE(G_SB(0, 1), cB + hstep, voffB); G_STAGE_A(G_SA(0, 1), cA, gcur, 1, 0);
    if (wr == 1) G_BAR;
    G_WAIT_V(4); G_BAR;
    G_STAGE(G_SB(1, 0), cB + kstep, voffB); G_STAGE_A(G_SA(1, 0), cA, gcur, 0, kstep); G_STAGE(G_SB(1, 1), cB + hstep + kstep, voffB);
    G_WAIT_V(6); G_BAR;
    for (;;) {
        const bool has_next = S.next(ui + 1, nxt);
        const char* nA = has_next ? (const char*)A + (size_t)(nxt.arow / BM) * tstep : cA;
        const char* nB = has_next ? (const char*)Bt + ((size_t)nxt.e * bt_estride) * 2 + (size_t)nxt.pn * tstep : cB;
        if constexpr (Sched::GATHER) { if (has_next) gather_offs(nxt, gnxt); else {
#pragma unroll
            for (int h = 0; h < 2; ++h) { gnxt[h][0] = gcur[h][0]; gnxt[h][1] = gcur[h][1]; } } }
        for (int t = 0; t < nt; t += 2) {
            const bool last = (t == nt - 2);
            const size_t k1 = (size_t)(t + 1) * kstep;
            const char* a2 = last ? nA : cA; const char* b2 = last ? nB : cB + (size_t)(t + 2) * kstep;
            const size_t k2 = last ? 0 : (size_t)(t + 2) * kstep; const size_t k3 = k2 + kstep;
            const char* b3 = b2 + kstep;
            unsigned g2[2][2];
#pragma unroll
            for (int h = 0; h < 2; ++h) { g2[h][0] = last ? gnxt[h][0] : gcur[h][0]; g2[h][1] = last ? gnxt[h][1] : gcur[h][1]; }
            G_LDB(B0, 0, 0); G_SCHED; G_LDA(At, 0, 0); G_STAGE_A(G_SA(1, 1), cA, gcur, 1, k1);
            G_WAIT_L(8); G_BAR; G_WAIT_L(0); G_MMA(0, 0, At, B0); G_BAR; G_SCHED;
            G_LDB(B1, 0, 1); G_STAGE(G_SB(0, 0), b2, voffB);
            G_BAR; G_WAIT_L(0); G_MMA(0, 1, At, B1); G_BAR;
            G_LDA(At, 0, 1); G_STAGE_A(G_SA(0, 0), a2, g2, 0, k2);
            G_BAR; G_WAIT_L(0); if (!Sched::HALF_SKIP || cur.nvalid > HALF) G_MMA(1, 0, At, B0); G_BAR; G_SCHED;
            G_STAGE(G_SB(0, 1), b2 + hstep, voffB);
            G_WAIT_V(6); G_BAR; if (!Sched::HALF_SKIP || cur.nvalid > HALF) G_MMA(1, 1, At, B1); G_BAR;
            G_LDB(B0, 1, 0); G_SCHED; G_LDA(At, 1, 0); G_STAGE_A(G_SA(0, 1), a2, g2, 1, k2);
            G_WAIT_L(8); G_BAR; G_WAIT_L(0); G_MMA(0, 0, At, B0); G_BAR; G_SCHED;
            G_LDB(B1, 1, 1); G_STAGE(G_SB(1, 0), b3, voffB);
            G_BAR; G_WAIT_L(0); G_MMA(0, 1, At, B1); G_BAR;
            G_LDA(At, 1, 1); G_STAGE_A(G_SA(1, 0), a2, g2, 0, k3);
            G_BAR; G_WAIT_L(0); if (!Sched::HALF_SKIP || cur.nvalid > HALF) G_MMA(1, 0, At, B0); G_BAR; G_SCHED;
            G_STAGE(G_SB(1, 1), b3 + hstep, voffB);
            G_WAIT_V(6); G_BAR; if (!Sched::HALF_SKIP || cur.nvalid > HALF) G_MMA(1, 1, At, B1); G_BAR;
        }
        if constexpr (FP8) asm volatile("s_nop 15\n\ts_nop 15" ::: "memory");
        { GUnit gu; gu.rowbase = cur.orow; gu.nvalid = cur.nvalid; gu.e = cur.e; gu.gather = p.tokl + cur.goff;
#pragma unroll
          for (int ai = 0; ai < 2; ++ai)
#pragma unroll
            for (int m = 0; m < 4; ++m) { const int r = ai * HALF + wr * 64 + m * 16 + fr;
              if (r < cur.nvalid) E(p, gu, r, cur.pn * BM + wc * 32 + fq * 8, acc[ai][0][m][0], acc[ai][0][m][1], acc[ai][1][m][0], acc[ai][1][m][1]); } }
        if (!has_next) break;
#pragma unroll
        for (int a = 0; a < 2; ++a)
#pragma unroll
            for (int b = 0; b < 2; ++b)
#pragma unroll
                for (int m = 0; m < 4; ++m)
#pragma unroll
                    for (int n = 0; n < 2; ++n) acc[a][b][m][n] = (f32x4){0.f, 0.f, 0.f, 0.f};
        cur = nxt; cA = nA; cB = nB; ++ui;
#pragma unroll
        for (int h = 0; h < 2; ++h) { gcur[h][0] = gnxt[h][0]; gcur[h][1] = gnxt[h][1]; }
    }
    G_WAIT_V(0);
    if (wr == 0) G_BAR;
    G_BAR;
}
}

extern __shared__ __attribute__((aligned(16))) unsigned char dyn_smem[];
constexpr int LDS_BYTES = gm::STAGE_BYTES + 1024;

typedef __bf16 bf2v __attribute__((ext_vector_type(2)));
typedef float f32x2 __attribute__((ext_vector_type(2)));
typedef float f32x16 __attribute__((ext_vector_type(16)));
typedef short s16x4 __attribute__((ext_vector_type(4)));
typedef unsigned u32x4 __attribute__((ext_vector_type(4)));
DI unsigned pk2(float a, float b) { f32x2 v = {a, b}; bf2v r = __builtin_convertvector(v, bf2v); return __builtin_bit_cast(unsigned, r); }
DI float bflo(unsigned u) { return __uint_as_float(u << 16); }
DI float bfhi(unsigned u) { return __uint_as_float(u & 0xffff0000u); }

DI unsigned pk4_fp8(float a, float b, float c, float d, float sc) {
    a = __builtin_amdgcn_fmed3f(a * sc, -448.f, 448.f); b = __builtin_amdgcn_fmed3f(b * sc, -448.f, 448.f); c = __builtin_amdgcn_fmed3f(c * sc, -448.f, 448.f); d = __builtin_amdgcn_fmed3f(d * sc, -448.f, 448.f);
    unsigned w = 0u; w = __builtin_amdgcn_cvt_pk_fp8_f32(a, b, w, false); w = __builtin_amdgcn_cvt_pk_fp8_f32(c, d, w, true); return w; }
constexpr bool D8_IN0 = true, D8_OUT0 = false, D8_IN1 = false;
constexpr bool YB8 = true;
constexpr float Y8_SCALE = 64.f;
constexpr float W8_SCALE = 256.f, A8_SCALE = 8.f;
constexpr int W8_E8M0 = 0x77777777, A8_E8M0 = 0x7c7c7c7c;
namespace ph {
DI void mods(const Params& p, LAS unsigned char* lds) {
    const int tid = opaque_tid(), wave = tid >> 6, lane = tid & 63, l8 = tid & 7, rg = tid >> 3;
    LAS float* fl = (LAS float*)lds; LAS float* red = fl + 4 * DM;
    for (int i = tid; i < 4 * DM; i += 512) fl[i] = siluf_(p.c[i]);
    __syncthreads();
    for (int u = blockIdx.x; u < 768; u += gridDim.x) {
        const int l = u / 192, c32 = u % 192;
        const float* w = l == 0 ? p.ada0_mix_w : l == 1 ? p.ada0_ffn_w : l == 2 ? p.ada1_mix_w : p.ada1_ffn_w;
        const float* bs = l == 0 ? p.ada0_mix_b : l == 1 ? p.ada0_ffn_b : l == 2 ? p.ada1_mix_b : p.ada1_ffn_b;
        f32x4 acc[4] = {{0.f, 0.f, 0.f, 0.f}, {0.f, 0.f, 0.f, 0.f}, {0.f, 0.f, 0.f, 0.f}, {0.f, 0.f, 0.f, 0.f}};
        const float* wp = w + (size_t)rg * 6144 + c32 * 32 + l8 * 4;
#pragma unroll 8
        for (int i = 0; i < 32; ++i) { const f32x4 wv = *(const f32x4*)(wp + (size_t)(64 * i) * 6144); const int k = rg + 64 * i;
#pragma unroll
            for (int b = 0; b < 4; ++b) acc[b] += fl[b * DM + k] * wv; }
#pragma unroll
        for (int b = 0; b < 4; ++b)
#pragma unroll
            for (int j = 0; j < 4; ++j) { float v = acc[b][j]; v += __shfl_xor(v, 8); v += __shfl_xor(v, 16); v += __shfl_xor(v, 32); acc[b][j] = v; }
        if (lane < 8) {
#pragma unroll
            for (int b = 0; b < 4; ++b) *(LAS f32x4*)(red + (wave * 4 + b) * 32 + lane * 4) = acc[b]; }
        __syncthreads();
        if (tid < 128) { const int b = tid >> 5, col = tid & 31; float sum = 0.f;
#pragma unroll
            for (int w8 = 0; w8 < 8; ++w8) sum += red[(w8 * 4 + b) * 32 + col];
            p.mod[(l * 4 + b) * 6144 + c32 * 32 + col] = sum + bs[c32 * 32 + col]; }
        __syncthreads();
    }
}
constexpr int NT_UNITS = (640 + 256 + 672 + 336 + 2 * (8192 + 4096)) / 2;
struct UD { const float* sp; bf16_t* dst; int K, N, mode, e, kt, ntile; };
DI UD tdecode(const Params& p, int u, int lane) {
    const float* srcs[8] = {p.w_in0, p.w_out0, p.w_in1, p.w_out1, p.moe0_w_gate_up, p.moe0_w_down, p.moe1_w_gate_up, p.moe1_w_down};
    bf16_t* dsts[8] = {p.w_in0t, p.w_out0t, p.w_in1t, p.w_out1t, p.w_gut0, p.w_dt0, p.w_gut1, p.w_dt1};
    constexpr int Ks[8] = {DM, DM, DM, LRU_W, DM, EFF, DM, EFF}, Ns[8] = {N_IN0, DM, N_IN1, DM, 2048, DM, 2048, DM}, nus[8] = {320, 128, 336, 168, 4096, 2048, 4096, 2048};
    constexpr int modes[8] = {D8_IN0 ? 2 : 0, D8_OUT0 ? 2 : 0, D8_IN1 ? 2 : 0, 0, 3, 2, 3, 2};
    int v = u, mi = 0;
#pragma unroll
    for (int m = 0; m < 8; ++m) { if (mi == m && v >= nus[m]) { v -= nus[m]; mi = m + 1; } }
    UD d; const float* src = srcs[0]; d.dst = dsts[0]; d.K = Ks[0]; d.N = Ns[0]; d.mode = modes[0];
#pragma unroll
    for (int m = 1; m < 8; ++m) if (mi == m) { src = srcs[m]; d.dst = dsts[m]; d.K = Ks[m]; d.N = Ns[m]; d.mode = modes[m]; }
    const int ntl = d.N / 256, ktl = d.K / 128; d.e = v / (ktl * ntl); const int rem = v % (ktl * ntl); d.kt = rem / ntl; d.ntile = rem % ntl;
    d.sp = src + (size_t)d.e * d.K * d.N + (size_t)(d.kt * 128) * d.N + d.ntile * 256 + lane * 4;
    return d;
}
DI void transposer(const Params& p, LAS unsigned char* lds, int first, int count, int stride) {
    const int tid = opaque_tid(), wave = tid >> 6, lane = tid & 63;
    LAS float* fl = (LAS float*)lds;
    if (count <= 0) return;
    if (tdecode(p, first, lane).mode & 2) {
        LAS unsigned* td = (LAS unsigned*)lds;
        const int nl = lane & 15, ks = lane >> 4;
        auto src_of = [&](const UD& d, int g, int j) -> const float* { const int kq = 4 * (g >> 2) + ks, nq = 16 * (g & 3) + nl; return d.sp - lane * 4 + (size_t)(4 * kq + j) * d.N + 4 * nq; };
        f32x4 va[4][4], vb[4][4];
        auto load_unit = [&](int u, f32x4 (&v)[4][4]) { const UD dd = tdecode(p, u, lane);
#pragma unroll
            for (int i = 0; i < 4; ++i)
#pragma unroll
                for (int j = 0; j < 4; ++j) v[i][j] = *(const f32x4*)src_of(dd, wave * 4 + i, j); };
        auto process = [&](int jn, f32x4 (&v)[4][4]) { const int u = first + jn * stride;
            const UD d = tdecode(p, u, lane); const int K = d.K, N = d.N, mode = d.mode, e = d.e, kt = d.kt, ntile = d.ntile;
            LAS unsigned* tile = td + (jn & 1) * (256 * 33);
#pragma unroll
            for (int i = 0; i < 4; ++i) { const int g = wave * 4 + i, kq = 4 * (g >> 2) + ks, nq = 16 * (g & 3) + nl;
#pragma unroll
                for (int en = 0; en < 4; ++en) tile[(4 * nq + en) * 33 + kq] = pk4_fp8(v[i][0][en], v[i][1][en], v[i][2][en], v[i][3][en], W8_SCALE); }
            __syncthreads();
            if (jn + 2 < count) load_unit(u + 2 * stride, v);
            { const int n = tid >> 1, kh = tid & 1; const int ng = ntile * 256 + n; const int jg = ng & 1023; const int np = (mode & 1) ? (256 * (jg >> 7) + (ng < 1024 ? 0 : 128) + (jg & 127)) : ng;
              unsigned char* dp = (unsigned char*)d.dst + (size_t)e * N * K + (size_t)np * K + kt * 128 + kh * 64;
#pragma unroll
              for (int jj = 0; jj < 4; ++jj) { const LAS unsigned* tp = tile + n * 33 + kh * 16 + jj * 4; *(uint4*)(dp + jj * 16) = make_uint4(tp[0], tp[1], tp[2], tp[3]); } } };
        load_unit(first, va); if (count > 1) load_unit(first + stride, vb);
        for (int jn = 0; jn < count; jn += 2) { process(jn, va); if (jn + 1 < count) process(jn + 1, vb); }
        __syncthreads();
        return;
    }
    f32x4 vv[16];
    { const UD d0 = tdecode(p, first, lane);
#pragma unroll
        for (int i = 0; i < 16; ++i) vv[i] = *(const f32x4*)(d0.sp + (size_t)(i * 8 + wave) * d0.N); }
    for (int j = 0; j < count; ++j) { const int u = first + j * stride;
        const UD d = tdecode(p, u, lane); const int K = d.K, N = d.N, mode = d.mode, e = d.e, kt = d.kt, ntile = d.ntile; bf16_t* dst = d.dst;
#pragma unroll
        for (int i = 0; i < 16; ++i) { LAS float* tp = fl + (i * 8 + wave) * 257 + lane * 4; tp[0] = vv[i][0]; tp[1] = vv[i][1]; tp[2] = vv[i][2]; tp[3] = vv[i][3]; }
        __syncthreads();
        if (j + 1 < count) { const UD dn = tdecode(p, u + stride, lane);
#pragma unroll
            for (int i = 0; i < 16; ++i) vv[i] = *(const f32x4*)(dn.sp + (size_t)(i * 8 + wave) * dn.N); }
        { const int n = tid >> 1, kh = tid & 1; const int ng = ntile * 256 + n; const int jg = ng & 1023; const int np = (mode & 1) ? (256 * (jg >> 7) + (ng < 1024 ? 0 : 128) + (jg & 127)) : ng;
          bf16_t* dp = dst + (size_t)e * N * K + (size_t)np * K + kt * 128 + kh * 64;
#pragma unroll
          for (int jj = 0; jj < 8; ++jj) { unsigned w4[4];
#pragma unroll
              for (int q = 0; q < 4; ++q) { const int k = kh * 64 + jj * 8 + q * 2; w4[q] = pk2(fl[k * 257 + n], fl[(k + 1) * 257 + n]); }
              *(uint4*)(dp + jj * 8) = make_uint4(w4[0], w4[1], w4[2], w4[3]); } }
        __syncthreads();
    }
}
DI void lru_weights(const Params& p) {
    const int tid = opaque_tid();
    for (size_t i = (size_t)blockIdx.x * 512 + tid; i < (size_t)2 * 2 * 16 * 4 * 48 * 192; i += (size_t)gridDim.x * 512) {
        const int k = i % 192, j = (i / 192) % 48, qt = (i / (192 * 48)) % 4, n = (i / (192 * 48 * 4)) % 16, which = (i / (192 * 48 * 4 * 16)) % 2, dir = i / (192 * 48 * 4 * 16 * 2);
        const float* w = which == 0 ? p.lru_w_a : p.lru_w_x; float v = 0.f;
        if (j < 42 && k < 168) v = w[(((size_t)dir * 16 + n) * 168 + k) * 168 + qt * 42 + j];
        p.w_lru[i] = f2bf(v);
    }
}
DI void fold_router(const Params& p) {
    const int tid = opaque_tid(), wave = tid >> 6, lane = tid & 63;
    for (size_t i = (size_t)blockIdx.x * 512 + tid; i < (size_t)2 * 4 * 48 * DM; i += (size_t)gridDim.x * 512) {
        const int k = i % DM, n = (i / DM) % 48, b = (i / (DM * 48)) % 4, l = i / (DM * 48 * 4);
        const float* g = l == 0 ? p.norm0_ffn : p.norm1_ffn; const float* md = p.mod + ((l == 0 ? 1 : 3) * 4 + b) * 6144;
        const float* we = l == 0 ? p.moe0_w_expert : p.moe1_w_expert; const float* wg = l == 0 ? p.moe0_w_group : p.moe1_w_group;
        const float w = n < 32 ? we[k * 32 + n] : n < 36 ? wg[k * 4 + (n - 32)] : 0.f;
        p.wrt[i] = g[k] * (1.f + md[2048 + k]) * w;
    }
    for (int task = blockIdx.x * 8 + wave; task < 2 * 4 * 48; task += gridDim.x * 8) {
        const int n = task % 48, b = (task / 48) % 4, l = task / (48 * 4);
        const float* md = p.mod + ((l == 0 ? 1 : 3) * 4 + b) * 6144;
        const float* we = l == 0 ? p.moe0_w_expert : p.moe1_w_expert; const float* wg = l == 0 ? p.moe0_w_group : p.moe1_w_group;
        float part = 0.f;
        for (int k = lane; k < DM; k += 64) { const float w = n < 32 ? we[k * 32 + n] : n < 36 ? wg[k * 4 + (n - 32)] : 0.f; part += md[k] * w; }
        part = wave_sum(part); if (lane == 0) p.rbias[task] = part;
    }
}
template <int MODE, bool OUT8 = false> DI void norm_rows(const Params& p, const float* xin  , const float* gain, int lmod, int lgate, const LAS int* tab) {
    const int tid = opaque_tid(), wave = tid >> 6, lane = tid & 63;
    for (int row = blockIdx.x * 8 + wave; row < T_TOK; row += gridDim.x * 8) {
        const int b = row / SEQ;
        f32x4 v[8];
        if (xin) {
#pragma unroll
            for (int i = 0; i < 8; ++i) v[i] = *(const f32x4*)(xin + (size_t)row * DM + i * 256 + lane * 4);
        } else {
#pragma unroll
            for (int i = 0; i < 8; ++i) { const uint2 a = *(const uint2*)(p.XA + (size_t)row * DM + i * 256 + lane * 4); v[i] = (f32x4){bflo(a.x), bfhi(a.x), bflo(a.y), bfhi(a.y)}; }
        }
        if constexpr (MODE >= 1) {
            const int a0 = p.asg[row * 2], a1 = p.asg[row * 2 + 1];
            const size_t r0 = (size_t)tab[a0 >> 14] * 256 + (a0 & 16383), r1 = (size_t)tab[a1 >> 14] * 256 + (a1 & 16383);
            const float* gt = p.mod + (lgate * 4 + b) * 6144 + 4096;
#pragma unroll
            for (int i = 0; i < 8; ++i) { const int col = i * 256 + lane * 4; const f32x4 g4 = *(const f32x4*)(gt + col);
                if constexpr (YB8) { const unsigned y0 = *(const unsigned*)((const unsigned char*)p.YB + r0 * DM + col), y1 = *(const unsigned*)((const unsigned char*)p.YB + r1 * DM + col);
                    const f32x2 a0 = __builtin_amdgcn_cvt_pk_f32_fp8(y0, false), a1 = __builtin_amdgcn_cvt_pk_f32_fp8(y0, true), b0 = __builtin_amdgcn_cvt_pk_f32_fp8(y1, false), b1 = __builtin_amdgcn_cvt_pk_f32_fp8(y1, true);
                    const f32x4 gq = g4 * (1.f / Y8_SCALE);
                    v[i][0] += gq[0] * (a0[0] + b0[0]); v[i][1] += gq[1] * (a0[1] + b0[1]); v[i][2] += gq[2] * (a1[0] + b1[0]); v[i][3] += gq[3] * (a1[1] + b1[1]); }
                else { const uint2 y0 = *(const uint2*)(p.YB + r0 * DM + col), y1 = *(const uint2*)(p.YB + r1 * DM + col);
                v[i][0] += g4[0] * (bflo(y0.x) + bflo(y1.x)); v[i][1] += g4[1] * (bfhi(y0.x) + bfhi(y1.x));
                v[i][2] += g4[2] * (bflo(y0.y) + bflo(y1.y)); v[i][3] += g4[3] * (bfhi(y0.y) + bfhi(y1.y)); } }
            if constexpr (MODE == 1) {
#pragma unroll
                for (int i = 0; i < 8; ++i) { const uint2 w = make_uint2(pk2(v[i][0], v[i][1]), pk2(v[i][2], v[i][3])); *(uint2*)(p.XA + (size_t)row * DM + i * 256 + lane * 4) = w;
                    v[i] = (f32x4){bflo(w.x), bfhi(w.x), bflo(w.y), bfhi(w.y)}; }
            }
        }
        float ss = 0.f;
#pragma unroll
        for (int i = 0; i < 8; ++i) ss += v[i][0] * v[i][0] + v[i][1] * v[i][1] + v[i][2] * v[i][2] + v[i][3] * v[i][3];
        ss = wave_sum(ss); const float rstd = rsqrtf(ss * (1.0f / DM) + 1e-6f);
        if constexpr (MODE == 2) {
#pragma unroll
            for (int i = 0; i < 8; ++i) { const int col = i * 256 + lane * 4; const f32x4 g4 = *(const f32x4*)(gain + col); *(f32x4*)(p.out + (size_t)row * DM + col) = v[i] * rstd * g4; }
        } else { const float* md = p.mod + (lmod * 4 + b) * 6144;
#pragma unroll
            for (int i = 0; i < 8; ++i) { const int col = i * 256 + lane * 4; const f32x4 g4 = *(const f32x4*)(gain + col), sc = *(const f32x4*)(md + 2048 + col), sh = *(const f32x4*)(md + col);
                const f32x4 h = v[i] * rstd * g4 * (1.f + sc) + sh;
                if constexpr (OUT8) *(unsigned*)((unsigned char*)p.H + (size_t)row * DM + col) = pk4_fp8(h[0], h[1], h[2], h[3], A8_SCALE);
                else *(uint2*)(p.H + (size_t)row * DM + col) = make_uint2(pk2(h[0], h[1]), pk2(h[2], h[3])); } }
    }
}
template <bool DRY = false, bool NORM = false> DI void router(const Params& p, int l, LAS unsigned char* lds, const float* gain = nullptr, int lmod = 0) {
    const int tid = opaque_tid(), wave = __builtin_amdgcn_readfirstlane(tid >> 6), lane = tid & 63;
    LAS float* lg = (LAS float*)lds + (wave & 3) * (16 * 48);
    LAS float* part = (LAS float*)lds + 4 * 16 * 48 + (wave & 3) * (64 * 13);
    LAS float* rsl = (LAS float*)lds + 4 * 16 * 48 + 4 * 64 * 13 + (wave & 3) * 16;
    for (int tg = blockIdx.x; tg < T_TOK / 64; tg += gridDim.x) {
        const int tile = tg * 4 + (wave & 3), kh = wave >> 2;
        const int row0 = tile * 16, b = row0 / SEQ, r = lane & 15, q = lane >> 4;
        const bf16_t* xa = p.XA + (size_t)(row0 + r) * DM + 4 * q + kh * (DM / 2);
        const float* wt = p.wrt + (((size_t)l * 4 + b) * 48 + r) * DM + 4 * q + kh * (DM / 2);
        f32x4 acc[3] = {{0.f, 0.f, 0.f, 0.f}, {0.f, 0.f, 0.f, 0.f}, {0.f, 0.f, 0.f, 0.f}}; float ss = 0.f;
#pragma unroll 2
        for (int s = 0; s < DM / 32; ++s) {
            const uint2 ar = *(const uint2*)(xa + 16 * s); const f32x4 a4 = {bflo(ar.x), bfhi(ar.x), bflo(ar.y), bfhi(ar.y)};
            ss += a4[0] * a4[0] + a4[1] * a4[1] + a4[2] * a4[2] + a4[3] * a4[3];
#pragma unroll
            for (int n = 0; n < 3; ++n) { const f32x4 b4 = *(const f32x4*)(wt + (size_t)n * 16 * DM + 16 * s);
#pragma unroll
                for (int j = 0; j < 4; ++j) acc[n] = __builtin_amdgcn_mfma_f32_16x16x4f32(a4[j], b4[j], acc[n], 0, 0, 0); }
        }
        if (kh == 1) {
#pragma unroll
            for (int n = 0; n < 3; ++n)
#pragma unroll
                for (int j = 0; j < 4; ++j) part[(n * 4 + j) * 64 + lane] = acc[n][j];
            part[12 * 64 + lane] = ss; }
        __syncthreads();
        if (kh == 0) {
#pragma unroll
            for (int n = 0; n < 3; ++n)
#pragma unroll
                for (int j = 0; j < 4; ++j) acc[n][j] += part[(n * 4 + j) * 64 + lane];
            ss += part[12 * 64 + lane];
        ss += __shfl_xor(ss, 16); ss += __shfl_xor(ss, 32);
        const float rstd = rsqrtf(ss * (1.0f / DM) + 1e-6f);
        if (NORM && q == 0) rsl[r] = rstd;
#pragma unroll
        for (int j = 0; j < 4; ++j) { const float rs = __shfl(rstd, 4 * q + j);
#pragma unroll
            for (int n = 0; n < 3; ++n) lg[(4 * q + j) * 48 + n * 16 + r] = acc[n][j] * rs + p.rbias[(l * 4 + b) * 48 + n * 16 + r]; }
        __builtin_amdgcn_wave_barrier();
        if (!DRY && lane < 16) {
            const LAS float* L = lg + lane * 48; const int tok = row0 + lane;
            int gs = 0; float gm = L[32];
#pragma unroll
            for (int g = 1; g < 4; ++g) if (L[32 + g] > gm) { gm = L[32 + g]; gs = g; }
            float gden = 0.f;
#pragma unroll
            for (int g = 0; g < 4; ++g) gden += __expf(L[32 + g] - gm);
            const float gprob = 1.0f / gden;
            int i0 = 0; float v0 = L[gs * 8];
            for (int j = 1; j < 8; ++j) { const float x = L[gs * 8 + j]; if (x > v0) { v0 = x; i0 = j; } }
            int i1 = -1; float v1 = -3.4e38f;
            for (int j = 0; j < 8; ++j) { const float x = L[gs * 8 + j]; if (j != i0 && x > v1) { v1 = x; i1 = j; } }
            const float e1 = __expf(v1 - v0), g0 = gprob / (1.f + e1), g1 = gprob * e1 / (1.f + e1);
            const int ea = gs * 8 + i0, eb = gs * 8 + i1;
            const int sa = atomicAdd(&p.cnt[l * 32 + ea], 1), sb = atomicAdd(&p.cnt[l * 32 + eb], 1);
            p.tokl[ea * ECAP + sa] = tok; p.gatel[ea * ECAP + sa] = g0; p.tokl[eb * ECAP + sb] = tok; p.gatel[eb * ECAP + sb] = g1;
            p.asg[tok * 2] = (ea << 14) | sa; p.asg[tok * 2 + 1] = (eb << 14) | sb;
        }
        }
        __syncthreads();
        if constexpr (NORM) {
            const float* md = p.mod + (lmod * 4 + b) * 6144;
            f32x4 g4[8], sc[8], sh[8];
#pragma unroll
            for (int i = 0; i < 8; ++i) { const int col = i * 256 + lane * 4; g4[i] = *(const f32x4*)(gain + col); sc[i] = 1.f + *(const f32x4*)(md + 2048 + col); sh[i] = *(const f32x4*)(md + col); g4[i] *= sc[i]; }
#pragma unroll 2
            for (int j = 0; j < 8; ++j) { const int row = row0 + kh * 8 + j; const float rs = rsl[kh * 8 + j];
#pragma unroll
                for (int i = 0; i < 8; ++i) { const int col = i * 256 + lane * 4; const uint2 ar = *(const uint2*)(p.XA + (size_t)row * DM + col); const f32x4 v = {bflo(ar.x), bfhi(ar.x), bflo(ar.y), bfhi(ar.y)};
                    const f32x4 h = v * rs * g4[i] + sh[i];
                    *(unsigned*)((unsigned char*)p.H + (size_t)row * DM + col) = pk4_fp8(h[0], h[1], h[2], h[3], A8_SCALE); } }
            __syncthreads();
        }
    }
}
DI void conv_gln(const Params& p, LAS unsigned char* lds) {
    const int tid = opaque_tid(), wave = tid >> 6, lane = tid & 63;
    LAS float* at = (LAS float*)lds;
    u32x4 rv[3], rg[3];
    auto load_raw = [&](int u) { const int g = u & 7, t0 = ((u >> 3) & 63) * 64, b = u >> 9;
#pragma unroll
        for (int i = 0; i < 3; ++i) { const int idx = tid + 512 * i, rr = idx >> 4, c8 = idx & 15, t = t0 - 15 + rr; rv[i] = (u32x4){0u, 0u, 0u, 0u}; rg[i] = (u32x4){0u, 0u, 0u, 0u};
            if (idx < 94 * 16 && t >= 0 && t < SEQ) { const bf16_t* row = p.G + (size_t)(b * SEQ + t) * N_IN0 + g * 128 + c8 * 8; rv[i] = *(const u32x4*)row; rg[i] = *(const u32x4*)(row + 1024); } } };
    int gcur = -1; f32x2 wk[31], bias = {0.f, 0.f}, gam = {0.f, 0.f}, bet = {0.f, 0.f};
    if ((int)blockIdx.x < 2048) load_raw(blockIdx.x);
    for (int u = blockIdx.x; u < 2048; u += gridDim.x) {
        const int g = u & 7, t0 = ((u >> 3) & 63) * 64, b = u >> 9;
        const int ch = g * 128 + 2 * lane;
        if (g != gcur) { gcur = g;
#pragma unroll
            for (int k = 0; k < 31; ++k) wk[k] = *(const f32x2*)(p.conv_w + k * 1024 + ch);
            bias = *(const f32x2*)(p.conv_b + ch); gam = *(const f32x2*)(p.conv_norm_g + ch); bet = *(const f32x2*)(p.conv_norm_b + ch); }
#pragma unroll
        for (int i = 0; i < 3; ++i) { const int idx = tid + 512 * i, rr = idx >> 4, c8 = idx & 15;
            if (idx < 94 * 16) { const u32x4 v = rv[i], gg = rg[i];
                const f32x4 lo = {bflo(v[0]) * sigmoidf_(bflo(gg[0])), bfhi(v[0]) * sigmoidf_(bfhi(gg[0])), bflo(v[1]) * sigmoidf_(bflo(gg[1])), bfhi(v[1]) * sigmoidf_(bfhi(gg[1]))};
                const f32x4 hi = {bflo(v[2]) * sigmoidf_(bflo(gg[2])), bfhi(v[2]) * sigmoidf_(bfhi(gg[2])), bflo(v[3]) * sigmoidf_(bflo(gg[3])), bfhi(v[3]) * sigmoidf_(bfhi(gg[3]))};
                *(LAS f32x4*)(at + rr * 132 + c8 * 8) = lo; *(LAS f32x4*)(at + rr * 132 + c8 * 8 + 4) = hi; } }
        __syncthreads();
        if (u + (int)gridDim.x < 2048) load_raw(u + gridDim.x);
        f32x2 acc[8];
#pragma unroll
        for (int j = 0; j < 8; ++j) acc[j] = bias;
#pragma unroll
        for (int rr = 0; rr < 38; ++rr) { const f32x2 a2 = *(const LAS f32x2*)(at + (wave * 8 + rr) * 132 + 2 * lane);
#pragma unroll
            for (int j = 0; j < 8; ++j) { const int k = rr - j; if (k >= 0 && k < 31) acc[j] += wk[k] * a2; } }
#pragma unroll
        for (int j = 0; j < 8; ++j) { const float mu = wave_sum(acc[j][0] + acc[j][1]) * (1.f / 128.f); const float d0 = acc[j][0] - mu, d1 = acc[j][1] - mu;
            const float var = wave_sum(d0 * d0 + d1 * d1) * (1.f / 128.f); const float rs = rsqrtf(var + 1e-6f);
            const float y0 = d0 * rs * gam[0] + bet[0], y1 = d1 * rs * gam[1] + bet[1];
            if constexpr (D8_OUT0) *(unsigned short*)((unsigned char*)p.AO + (size_t)(b * SEQ + t0 + wave * 8 + j) * DM + ch) = (unsigned short)(pk4_fp8(siluf_(y0), siluf_(y1), 0.f, 0.f, A8_SCALE) & 0xffffu);
            else *(unsigned*)(p.AO + (size_t)(b * SEQ + t0 + wave * 8 + j) * DM + ch) = pk2(siluf_(y0), siluf_(y1)); }
        __syncthreads();
    }
}
DI unsigned off_b(unsigned row, unsigned ch) { return 256u * row + 16u * (ch ^ (((row & 3u) << 2) | ((row >> 2) & 3u))); }
DI void tr_read4(unsigned a0, unsigned a1, s16x4& r00, s16x4& r01, s16x4& r10, s16x4& r11) {
    asm volatile("ds_read_b64_tr_b16 %0, %4\n\tds_read_b64_tr_b16 %1, %5\n\tds_read_b64_tr_b16 %2, %4 offset:4096\n\tds_read_b64_tr_b16 %3, %5 offset:4096\n\ts_waitcnt lgkmcnt(0)"
                 : "=&v"(r00), "=&v"(r01), "=&v"(r10), "=&v"(r11) : "v"(a0), "v"(a1) : "memory");
}
template <int PASS> DI void attn_wave(const Params& p, LAS unsigned char* vimg, unsigned vb0, unsigned vb1, int lane_, int b, int h, int qbase  ) {
    int lane = lane_; asm volatile("" : "+v"(lane));
    const int c = lane & 31, hh = lane >> 5, srow = lane >> 4, sch = lane & 15;
    constexpr int QS = PASS == 0 ? 16 : 1, NT = PASS == 0 ? 13 : 5;
    const int tq = qbase + QS * c;
    const bf16_t* gb = p.G + (size_t)(b * SEQ) * N_IN0; const bf16_t* kb = p.KVH + (size_t)((b * 8 + h) * 2) * SEQ * 128;
    bf16_t* st_o = p.YB + ((size_t)(b * 8 + h) * SEQ + tq) * 128;
    float* st_ml = (float*)(p.YB + (size_t)NBATCH * 8 * SEQ * 128) + ((size_t)(b * 8 + h) * SEQ + tq) * 2;
    bf16x8 qf[8];
#pragma unroll
    for (int ks = 0; ks < 8; ++ks) qf[ks] = *(const bf16x8*)(gb + (size_t)tq * N_IN0 + 2048 + h * 128 + 16 * ks + 8 * hh);
    const float sc2 = 0.08838834764831845f * 1.4426950408889634f, sl2 = exp2f(-(float)(h + 1)) * 1.4426950408889634f;
    f32x16 o[4]; float m_run, l_run;
    if constexpr (PASS == 0) {
#pragma unroll
        for (int i = 0; i < 4; ++i)
#pragma unroll
            for (int j = 0; j < 16; ++j) o[i][j] = 0.f;
        m_run = -30000.f; l_run = 0.f;
    } else {
#pragma unroll
        for (int c4 = 0; c4 < 4; ++c4)
#pragma unroll
            for (int g4 = 0; g4 < 4; ++g4) { const uint2 v = *(const uint2*)(st_o + 32 * c4 + 8 * g4 + 4 * hh); o[c4][4 * g4] = bflo(v.x); o[c4][4 * g4 + 1] = bfhi(v.x); o[c4][4 * g4 + 2] = bflo(v.y); o[c4][4 * g4 + 3] = bfhi(v.y); }
        const f32x2 ml = *(const f32x2*)st_ml; m_run = ml[0]; l_run = hh == 0 ? ml[1] : 0.f;
    }
    auto tile_geom = [&](int tile, int& d, int& sb) { if constexpr (PASS == 0) { if (tile < 5) { d = 16; sb = qbase - 1024 + 512 * tile; } else { d = 4; sb = qbase - 256 + 128 * (tile - 5); } } else { d = 1; sb = qbase - 64 + 32 * tile; } };
    auto load_k = [&](int tile, bf16x8 (&kf)[8]) { int d, sb; tile_geom(tile, d, sb); int sp = sb + d * c; sp = sp < 0 ? 0 : (sp >= SEQ ? SEQ - 1 : sp);
        const bf16_t* src = kb + (unsigned)(sp * 128 + 8 * hh);
#pragma unroll
        for (int ks = 0; ks < 8; ++ks) kf[ks] = *(const bf16x8*)(src + 16 * ks); };
    auto load_v = [&](int tile, u32x4 (&vv)[8]) { int d, sb; tile_geom(tile, d, sb);
#pragma unroll
        for (int i = 0; i < 8; ++i) { int sp = sb + d * (srow + 4 * i); sp = sp < 0 ? 0 : (sp >= SEQ ? SEQ - 1 : sp); vv[i] = *(const u32x4*)(kb + (unsigned)(SEQ * 128 + sp * 128 + sch * 8)); } };
    bf16x8 kf[8]; u32x4 vv[8];
    load_k(0, kf); load_v(0, vv);
    for (int tile = 0; tile < NT; ++tile) {
        int d, sb; tile_geom(tile, d, sb);
        const int tn = tile < NT - 1 ? tile + 1 : NT - 1;
#pragma unroll
        for (int i = 0; i < 8; ++i) *(LAS u32x4*)(vimg + off_b(srow + 4 * i, sch)) = vv[i];
        load_v(tn, vv);
        f32x16 sacc;
#pragma unroll
        for (int j = 0; j < 16; ++j) sacc[j] = 0.f;
#pragma unroll
        for (int ks = 0; ks < 8; ++ks) sacc = __builtin_amdgcn_mfma_f32_32x32x16_bf16(kf[ks], qf[ks], sacc, 0, 0, 0);
        load_k(tn, kf);
        const float df = (float)d, basef = (float)(sb - tq) + df * (float)(4 * hh);
        const float lo = fmaxf(-64.f * df, -(float)tq), hi = fminf(64.f * df, (float)(SEQ - 1 - tq));
        const float mid = 0.5f * (lo + hi), half = 0.5f * (hi - lo);
        float tmax = -1e30f;
#pragma unroll
        for (int i = 0; i < 16; ++i) { const float deltaf = basef + df * (float)((i & 3) + 8 * (i >> 2));
            const bool valid = __builtin_fabsf(deltaf - mid) <= half;
            const float sv = valid ? sacc[i] * sc2 - sl2 * __builtin_fabsf(deltaf) : -1e30f; sacc[i] = sv; tmax = fmaxf(tmax, sv); }
        tmax = fmaxf(tmax, __shfl_xor(tmax, 32));
        const float m_new = tmax > m_run + 8.0f ? tmax : m_run;
        if (__any(m_new != m_run)) { const float alpha = __builtin_amdgcn_exp2f(m_run - m_new);
            l_run *= alpha;
#pragma unroll
            for (int i = 0; i < 4; ++i) o[i] *= alpha; }
        m_run = m_new;
        float psum = 0.f;
#pragma unroll
        for (int i = 0; i < 16; ++i) { const float pi = __builtin_amdgcn_exp2f(sacc[i] - m_new); psum += pi; sacc[i] = pi; }
        l_run += psum;
        bf16x8 pf[2];
#pragma unroll
        for (int s = 0; s < 2; ++s) { const unsigned w0 = pk2(sacc[8 * s], sacc[8 * s + 1]), w1 = pk2(sacc[8 * s + 2], sacc[8 * s + 3]), w2 = pk2(sacc[8 * s + 4], sacc[8 * s + 5]), w3 = pk2(sacc[8 * s + 6], sacc[8 * s + 7]);
            pf[s] = __builtin_bit_cast(bf16x8, (u32x4){w0, w1, w2, w3}); }
#pragma unroll
        for (int c4 = 0; c4 < 4; ++c4) {
            s16x4 r00, r01, r10, r11; tr_read4(vb0 ^ (unsigned)(c4 << 6), vb1 ^ (unsigned)(c4 << 6), r00, r01, r10, r11);
            const bf16x8 v0 = __builtin_shufflevector(r00, r01, 0, 1, 2, 3, 4, 5, 6, 7), v1 = __builtin_shufflevector(r10, r11, 0, 1, 2, 3, 4, 5, 6, 7);
            o[c4] = __builtin_amdgcn_mfma_f32_32x32x16_bf16(v0, pf[0], o[c4], 0, 0, 0);
            o[c4] = __builtin_amdgcn_mfma_f32_32x32x16_bf16(v1, pf[1], o[c4], 0, 0, 0); }
    }
    const float ltot = l_run + __shfl_xor(l_run, 32);
    if constexpr (PASS == 0) {
#pragma unroll
        for (int c4 = 0; c4 < 4; ++c4)
#pragma unroll
            for (int g4 = 0; g4 < 4; ++g4) *(uint2*)(st_o + 32 * c4 + 8 * g4 + 4 * hh) = make_uint2(pk2(o[c4][4 * g4], o[c4][4 * g4 + 1]), pk2(o[c4][4 * g4 + 2], o[c4][4 * g4 + 3]));
        if (hh == 0) *(f32x2*)st_ml = (f32x2){m_run, ltot};
    } else {
        const float inv = 1.0f / ltot;
        bf16_t* orow = p.AO + (size_t)(b * SEQ + tq) * DM + 1024 + h * 128;
#pragma unroll
        for (int c4 = 0; c4 < 4; ++c4)
#pragma unroll
            for (int g4 = 0; g4 < 4; ++g4) { const int dh = 32 * c4 + 8 * g4 + 4 * hh;
                if constexpr (D8_OUT0) *(unsigned*)((unsigned char*)p.AO + (size_t)(b * SEQ + tq) * DM + 1024 + h * 128 + dh) = pk4_fp8(o[c4][4 * g4] * inv, o[c4][4 * g4 + 1] * inv, o[c4][4 * g4 + 2] * inv, o[c4][4 * g4 + 3] * inv, A8_SCALE);
                else *(uint2*)(orow + dh) = make_uint2(pk2(o[c4][4 * g4] * inv, o[c4][4 * g4 + 1] * inv), pk2(o[c4][4 * g4 + 2] * inv, o[c4][4 * g4 + 3] * inv)); }
    }
}
DI void attention(const Params& p, LAS unsigned char* lds) {
    const int tid = opaque_tid(), wave = __builtin_amdgcn_readfirstlane(tid >> 6), lane = tid & 63, hh = lane >> 5;
    LAS unsigned char* vimg = lds + wave * 8192;
    const unsigned vbase = (unsigned)(uintptr_t)vimg;
    const int q4 = (lane & 15) >> 2, pp = lane & 3, blk = (lane >> 4) & 1;
    const unsigned vb0 = vbase + 256u * (4 * hh + q4) + 16u * ((2 * blk + (pp >> 1)) ^ (hh & 3)) + 8u * (pp & 1) + ((unsigned)q4 << 6);
    const unsigned vb1 = vbase + 256u * (8 + 4 * hh + q4) + 16u * ((2 * blk + (pp >> 1)) ^ ((2 + hh) & 3)) + 8u * (pp & 1) + ((unsigned)q4 << 6);
    for (int u = blockIdx.x; u < 256; u += gridDim.x) {
        const int bh = (u & 7) * 4 + ((u >> 3) >> 3), span = (u >> 3) & 7, h = bh & 7, b = bh >> 3;
#pragma unroll 1
        for (int j = 0; j < 2; ++j) attn_wave<0>(p, vimg, vb0, vb1, lane, b, h, span * 512 + wave * 2 + j);
        asm volatile("s_waitcnt vmcnt(0)" ::: "memory");
        __syncthreads();
#pragma unroll 1
        for (int j = 0; j < 2; ++j) attn_wave<1>(p, vimg, vb0, vb1, lane, b, h, span * 512 + (wave * 2 + j) * 32);
        __syncthreads();
    }
}
DI float om_exp2x(float la, float a) {
    const float x = 2.f * la;
    const float pl = x * (1.f + x * (0.5f + x * (0.16666667f + x * (0.041666668f + x * 0.008333334f))));
    return x > -0.25f ? -pl : 1.f - a * a;
}
DI void lru_conv(const Params& p) {
    const int tid = opaque_tid();
    if (tid < 336) {
        const int ch = tid * 8;
        float cw[4][8], cb[8];
#pragma unroll
        for (int j = 0; j < 4; ++j) { const f32x4 w0 = *(const f32x4*)(p.lru_conv_w + j * LRU_W + ch), w1 = *(const f32x4*)(p.lru_conv_w + j * LRU_W + ch + 4);
            cw[j][0] = w0[0]; cw[j][1] = w0[1]; cw[j][2] = w0[2]; cw[j][3] = w0[3]; cw[j][4] = w1[0]; cw[j][5] = w1[1]; cw[j][6] = w1[2]; cw[j][7] = w1[3]; }
        { const f32x4 b0 = *(const f32x4*)(p.lru_conv_b + ch), b1 = *(const f32x4*)(p.lru_conv_b + ch + 4); cb[0] = b0[0]; cb[1] = b0[1]; cb[2] = b0[2]; cb[3] = b0[3]; cb[4] = b1[0]; cb[5] = b1[1]; cb[6] = b1[2]; cb[7] = b1[3]; }
        for (int run = blockIdx.x; run < T_TOK / 32; run += gridDim.x) {
            const int tok0 = run * 32, t0 = tok0 % SEQ;
            const bf16_t* src = p.G + (size_t)tok0 * N_IN1 + LRU_W + ch;
            u32x4 rows[35];
#pragma unroll
            for (int i = 0; i < 35; ++i) { const int t = t0 - 2 + i; rows[i] = (t >= 0 && t < SEQ) ? *(const u32x4*)(src + (ptrdiff_t)(i - 2) * N_IN1) : (u32x4){0u, 0u, 0u, 0u}; }
#pragma unroll
            for (int i = 0; i < 32; ++i) { float xc[8];
#pragma unroll
                for (int e = 0; e < 8; ++e) xc[e] = cb[e];
#pragma unroll
                for (int j = 0; j < 4; ++j) { const u32x4 xv = rows[i + j];
                    xc[0] += cw[j][0] * bflo(xv[0]); xc[1] += cw[j][1] * bfhi(xv[0]); xc[2] += cw[j][2] * bflo(xv[1]); xc[3] += cw[j][3] * bfhi(xv[1]);
                    xc[4] += cw[j][4] * bflo(xv[2]); xc[5] += cw[j][5] * bfhi(xv[2]); xc[6] += cw[j][6] * bflo(xv[3]); xc[7] += cw[j][7] * bfhi(xv[3]); }
                *(u32x4*)(p.XC + (size_t)(tok0 + i) * LRU_W + ch) = (u32x4){pk2(xc[0], xc[1]), pk2(xc[2], xc[3]), pk2(xc[4], xc[5]), pk2(xc[6], xc[7])}; }
        }
    }
}
DI void lru(const Params& p, LAS unsigned char* lds) {
    const int tid = opaque_tid(), wave = __builtin_amdgcn_readfirstlane(tid >> 6), lane = tid & 63, col = lane & 15, g = lane >> 4;
    LAS unsigned char* wl = lds;
    LAS unsigned char* xs = lds + 36864;
    LAS float* sums = (LAS float*)(lds + 36864 + 86016);
    LAS float* cst = sums + 1920;
    for (int u = blockIdx.x; u < 256; u += gridDim.x) {
        const int b = u >> 6, n = (u >> 2) & 15, qt = u & 3, chq = n * LRU_BW + qt * 42;
        const char* xcb = (const char*)(p.XC + (size_t)(b * SEQ) * LRU_W + n * LRU_BW);
        const bf16_t* gb = p.G + (size_t)(b * SEQ) * N_IN1;
        unsigned poff[6];
#pragma unroll
        for (int i = 0; i < 6; ++i) { const int idx = tid + 512 * i; poff[i] = (unsigned)((idx / 21) * LRU_W + (idx % 21) * 8) * 2u; }
        auto dma_chunk = [&](int chunk, int bsel) { const char* src = xcb + (size_t)chunk * 128 * LRU_W * 2; LAS unsigned char* dst = xs + bsel * 43008 + wave * 1024;
#pragma unroll
            for (int i = 0; i < 5; ++i) __builtin_amdgcn_global_load_lds((const unsigned*)(src + poff[i]), (LAS unsigned*)(dst + i * 8192), 16, 0, 0);
            if (wave < 2) __builtin_amdgcn_global_load_lds((const unsigned*)(src + poff[5]), (LAS unsigned*)(dst + 5 * 8192), 16, 0, 0); };
        for (int dir = 0; dir < 2; ++dir) {
            __syncthreads();
            for (int i = tid; i < 2 * 48 * 24; i += 512) { const int which = i / (48 * 24), r = (i / 24) % 48, ck = i % 24; const int nt = r >> 4, cl = r & 15, ks = ck >> 2, gg = ck & 3;
                *(LAS u32x4*)(wl + ((which * 3 + nt) * 6 + ks) * 1024 + (gg * 16 + cl) * 16) = *(const u32x4*)(p.w_lru + ((((size_t)(dir * 2 + which) * 16 + n) * 4 + qt) * 48 + r) * 192 + ck * 8); }
            if (tid < 48) { const bool valid = tid < 42; const int ch = dir * LRU_W + chq + tid;
                cst[tid] = valid ? -1.44269504f * p.lru_b_a[ch] : 0.f; cst[48 + tid] = valid ? -1.44269504f * p.lru_b_x[ch] : 0.f;
                const float lam = valid ? p.lru_lambda[ch] : 0.f; const float sp = (-lam > 20.f) ? -lam : log1pf(__expf(-lam)); cst[96 + tid] = -8.0f * 1.44269504f * sp; }
            dma_chunk(dir == 0 ? 0 : 31, 0);
            asm volatile("s_waitcnt vmcnt(0)" ::: "memory");
            __syncthreads();
            float cba[3], cbx[3], cex[3];
#pragma unroll
            for (int nt = 0; nt < 3; ++nt) { cba[nt] = cst[nt * 16 + col]; cbx[nt] = cst[48 + nt * 16 + col]; cex[nt] = cst[96 + nt * 16 + col]; }
            bf16x8 breg[3][6];
#pragma unroll
            for (int nt = 0; nt < 3; ++nt)
#pragma unroll
                for (int ks = 0; ks < 6; ++ks) { breg[nt][ks] = *(const LAS bf16x8*)(wl + (nt * 6 + ks) * 1024 + lane * 16); asm volatile("" : "+v"(breg[nt][ks])); }
            const int wpos = dir == 0 ? wave : 7 - wave;
            float carry[3] = {0.f, 0.f, 0.f};
            for (int step = 0; step < 32; ++step) {
                const int c = dir == 0 ? step : 31 - step, c0 = c * 128, par = step & 1;
                const bool has_next = step < 31;
                if (has_next) dma_chunk(dir == 0 ? c + 1 : c - 1, par ^ 1);
                LAS unsigned char* xb = xs + par * 43008;
                uint2 hfv[3] = {make_uint2(0u, 0u), make_uint2(0u, 0u), make_uint2(0u, 0u)}; unsigned short gtv[3][4];
                const uint2* hfp = (const uint2*)p.HF + ((size_t)((u * 32 + c) * 8 + wave) * 3) * 64 + lane;
                const bf16_t* gbw = gb + (size_t)(c0 + wave * 16) * N_IN1 + chq;
                bf16_t* aow = p.AO + (size_t)(b * SEQ + c0 + wave * 16) * LRU_W + chq;
                if (dir == 1) {
#pragma unroll
                    for (int nt = 0; nt < 3; ++nt) { hfv[nt] = hfp[nt * 64];
#pragma unroll
                        for (int r = 0; r < 4; ++r) gtv[nt][r] = (nt * 16 + col < 42) ? gbw[(unsigned)((4 * g + r) * N_IN1 + nt * 16 + col)] : (unsigned short)0; } }
                bf16x8 af[6];
#pragma unroll
                for (int ks = 0; ks < 6; ++ks) { const int ch0 = 32 * ks + 8 * g; const bool kval = ch0 < LRU_BW; const int chl0 = kval ? ch0 : 160;
                    const u32x4 xv = *(const LAS u32x4*)(xb + (wave * 16 + col) * 336 + chl0 * 2);
                    af[ks] = __builtin_bit_cast(bf16x8, kval ? xv : (u32x4){0u, 0u, 0u, 0u}); }
                f32x4 acc[2][3];
                {
                    bf16x8 bl[6];
                    const LAS unsigned char* wl1 = wl + 18 * 1024 + lane * 16;
#pragma unroll
                    for (int ks = 0; ks < 6; ++ks) bl[ks] = *(const LAS bf16x8*)(wl1 + ks * 1024);
#pragma unroll
                    for (int nt = 0; nt < 3; ++nt) {
                        acc[0][nt] = (f32x4){0.f, 0.f, 0.f, 0.f}; acc[1][nt] = (f32x4){0.f, 0.f, 0.f, 0.f};
#pragma unroll
                        for (int ks = 0; ks < 6; ++ks) acc[0][nt] = __builtin_amdgcn_mfma_f32_16x16x32_bf16(af[ks], breg[nt][ks], acc[0][nt], 0, 0, 0);
#pragma unroll
                        for (int ks = 0; ks < 6; ++ks) { acc[1][nt] = __builtin_amdgcn_mfma_f32_16x16x32_bf16(af[ks], bl[ks], acc[1][nt], 0, 0, 0);
                            if (nt < 2) bl[ks] = *(const LAS bf16x8*)(wl1 + ((nt + 1) * 6 + ks) * 1024); }
                    }
                }
                float hl[3][4], Pl[3][4];
#pragma unroll
                for (int nt = 0; nt < 3; ++nt) { const int chl = nt * 16 + col;
                    float av[4], uv[4];
#pragma unroll
                    for (int r = 0; r < 4; ++r) {
                        const float rg = __builtin_amdgcn_rcpf(1.0f + __builtin_amdgcn_exp2f(__builtin_fmaf(acc[0][nt][r], -1.44269504f, cba[nt])));
                        const float ig = __builtin_amdgcn_rcpf(1.0f + __builtin_amdgcn_exp2f(__builtin_fmaf(acc[1][nt][r], -1.44269504f, cbx[nt])));
                        const float a = __builtin_amdgcn_exp2f(cex[nt] * rg);
                        const float xcv = bf2f(*(const LAS bf16_t*)(xb + (wave * 16 + 4 * g + r) * 336 + (qt * 42 + chl) * 2));
                        av[r] = a; uv[r] = __builtin_amdgcn_sqrtf(__builtin_fmaf(-a, a, 1.0f)) * (ig * xcv); }
                    float h[4], P[4], A, H;
                    if (dir == 0) { h[0] = uv[0]; P[0] = av[0];
#pragma unroll
                        for (int r = 1; r < 4; ++r) { h[r] = av[r] * h[r - 1] + uv[r]; P[r] = av[r] * P[r - 1]; }
                        A = P[3]; H = h[3];
                        { const float A1 = __shfl_up(A, 16), H1 = __shfl_up(H, 16); if (g >= 1) { H = A * H1 + H; A = A * A1; } }
                        { const float A2 = __shfl_up(A, 32), H2 = __shfl_up(H, 32); if (g >= 2) { H = A * H2 + H; A = A * A2; } }
                        float Ae = __shfl_up(A, 16), He = __shfl_up(H, 16); if (g == 0) { Ae = 1.f; He = 0.f; }
#pragma unroll
                        for (int r = 0; r < 4; ++r) { hl[nt][r] = h[r] + P[r] * He; Pl[nt][r] = P[r] * Ae; }
                        if (g == 3) *(LAS f32x2*)(sums + (par * 48 + chl) * 20 + wpos * 2) = (f32x2){A, H};
                    } else { h[3] = uv[3]; P[3] = av[3];
#pragma unroll
                        for (int r = 2; r >= 0; --r) { h[r] = av[r] * h[r + 1] + uv[r]; P[r] = av[r] * P[r + 1]; }
                        A = P[0]; H = h[0];
                        { const float A1 = __shfl_down(A, 16), H1 = __shfl_down(H, 16); if (g <= 2) { H = A * H1 + H; A = A * A1; } }
                        { const float A2 = __shfl_down(A, 32), H2 = __shfl_down(H, 32); if (g <= 1) { H = A * H2 + H; A = A * A2; } }
                        float Ae = __shfl_down(A, 16), He = __shfl_down(H, 16); if (g == 3) { Ae = 1.f; He = 0.f; }
#pragma unroll
                        for (int r = 0; r < 4; ++r) { hl[nt][r] = h[r] + P[r] * He; Pl[nt][r] = P[r] * Ae; }
                        if (g == 0) *(LAS f32x2*)(sums + (par * 48 + chl) * 20 + wpos * 2) = (f32x2){A, H};
                    }
                }
                asm volatile("s_waitcnt vmcnt(0)" ::: "memory");
                __syncthreads();
                f32x4 sv[3][4];
#pragma unroll
                for (int nt = 0; nt < 3; ++nt)
#pragma unroll
                    for (int j = 0; j < 4; ++j) sv[nt][j] = *(const LAS f32x4*)(sums + (par * 48 + nt * 16 + col) * 20 + j * 4);
#pragma unroll
                for (int nt = 0; nt < 3; ++nt) { const int chl = nt * 16 + col; float C = carry[nt], Cw = 0.f;
#pragma unroll
                    for (int k = 0; k < 8; ++k) { if (k == wpos) Cw = C; C = sv[nt][k >> 1][(k & 1) * 2] * C + sv[nt][k >> 1][(k & 1) * 2 + 1]; }
                    carry[nt] = C;
                    float hv[4];
#pragma unroll
                    for (int r = 0; r < 4; ++r) hv[r] = hl[nt][r] + Pl[nt][r] * Cw;
                    if (dir == 0) ((uint2*)p.HF)[((size_t)((u * 32 + c) * 8 + wave) * 3 + nt) * 64 + lane] = make_uint2(pk2(hv[0], hv[1]), pk2(hv[2], hv[3]));
                    else if (chl < 42) { const float ff[4] = {bflo(hfv[nt].x), bfhi(hfv[nt].x), bflo(hfv[nt].y), bfhi(hfv[nt].y)};
#pragma unroll
                        for (int r = 0; r < 4; ++r) aow[(unsigned)((4 * g + r) * LRU_W + chl)] = f2bf(bf2f(gtv[nt][r]) * (ff[r] + hv[r])); }
                }
            }
        }
    }
}
}

#define XB_TMO      128
#define XB_XCNT(j)  (256  + 64 * (j))
#define XB_XSUB(j)  (1280 + 64 * (j))
#define XB_XGEN(j)  (2304 + 64 * (j))
#define XB_TOP      3328
#define XB_TOPGEN   3392
#define XCD_BAR_WORDS 3456
#define XB_SPIN_CAP (1u << 18)

__device__ __forceinline__ unsigned xb_ld(unsigned* p)              { return __hip_atomic_load(p, __ATOMIC_RELAXED, __HIP_MEMORY_SCOPE_AGENT); }
__device__ __forceinline__ unsigned xb_add(unsigned* p, unsigned v) { return __hip_atomic_fetch_add(p, v, __ATOMIC_RELAXED, __HIP_MEMORY_SCOPE_AGENT); }
__device__ __forceinline__ unsigned xb_xcc_id() { return (unsigned)__builtin_amdgcn_s_getreg((3 << 11) | 20) & 0xFu; }
#define XB_SPIN(cond, bar) do { unsigned _sp = 0; while (cond) { __builtin_amdgcn_s_sleep(1); \
    if ((++_sp & 255u) == 0u) { if (xb_ld(&(bar)[XB_TMO])) break; if (_sp > XB_SPIN_CAP) { atomicAdd(&(bar)[XB_TMO], 1u); break; } } } } while (0)

struct XcdBarrier {
    unsigned* bar; unsigned x;
    volatile LAS unsigned* st;
};

__device__ __forceinline__ XcdBarrier xcd_barrier_post(unsigned* bar, volatile LAS unsigned* st) {
    XcdBarrier b; b.bar = bar; b.x = xb_xcc_id(); b.st = st;
    if (threadIdx.x == 0) (void)xb_add(&bar[XB_XCNT(b.x)], 1u);
    return b;
}
__device__ __forceinline__ void xcd_barrier_complete(unsigned* bar, unsigned x, unsigned& nloc, unsigned& nx) {
    const unsigned G = gridDim.x * gridDim.y * gridDim.z;
    unsigned sum, cnt, mine, sp = 0u;
    for (;;) {
        sum = 0u; cnt = 0u; mine = 0u;
#pragma unroll
        for (unsigned j = 0; j < 16; ++j) { const unsigned c = xb_ld(&bar[XB_XCNT(j)]); sum += c; cnt += (c > 0u) ? 1u : 0u; mine = (j == x) ? c : mine; }
        if (sum == G) break;
        __builtin_amdgcn_s_sleep(1);
        if ((++sp & 255u) == 0u) { if (xb_ld(&bar[XB_TMO])) break; if (sp > XB_SPIN_CAP) { atomicAdd(&bar[XB_TMO], 1u); break; } }
    }
    nloc = mine > 0u ? mine : 1u; nx = cnt > 0u ? cnt : 1u;
}

__device__ __forceinline__ void xcd_barrier(const XcdBarrier& b) {
    asm volatile("s_waitcnt vmcnt(0)" ::: "memory");
    __syncthreads();
    if (threadIdx.x == 0) {
        unsigned* bar = b.bar;
        __builtin_amdgcn_s_waitcnt(0);
        unsigned nloc = b.st[0], nx = b.st[1];
        if (nloc == 0u) { xcd_barrier_complete(bar, b.x, nloc, nx); b.st[0] = nloc; b.st[1] = nx; }
        const unsigned old = xb_add(&bar[XB_XSUB(b.x)], 1u);
        const unsigned gen = old / nloc;
        if (old + 1u == (gen + 1u) * nloc) {
            __builtin_amdgcn_fence(__ATOMIC_RELEASE, "agent");
            asm volatile("s_waitcnt vmcnt(0)" ::: "memory");
            const unsigned og = xb_add(&bar[XB_TOP], 1u);
            const unsigned tg = og / nx;
            if (og + 1u == (tg + 1u) * nx) xb_add(&bar[XB_TOPGEN], 1u);
            else XB_SPIN(xb_ld(&bar[XB_TOPGEN]) == tg, bar);
            __builtin_amdgcn_fence(__ATOMIC_ACQUIRE, "agent");
            xb_add(&bar[XB_XGEN(b.x)], 1u);
            asm volatile("s_waitcnt vmcnt(0)" ::: "memory");
        } else {
            XB_SPIN(xb_ld(&bar[XB_XGEN(b.x)]) == gen, bar);
            __builtin_amdgcn_fence(__ATOMIC_ACQUIRE, "agent");
            asm volatile("s_waitcnt vmcnt(0)" ::: "memory");
        }
    }
    __syncthreads();
}


constexpr int PROBE = 0;
constexpr int LDS_XB_OFF = gm::STAGE_BYTES + 1024;
constexpr int LDS_TOTAL = LDS_XB_OFF + 16;
__global__ void __launch_bounds__(512, 2) mega(Params p) {
    LAS unsigned char* lds = (LAS unsigned char*)dyn_smem;
    LAS int* tab = (LAS int*)(lds + gm::TAB_OFF);
    volatile LAS unsigned* xbw = (volatile LAS unsigned*)(lds + LDS_XB_OFF);
    if (threadIdx.x == 0) { xbw[0] = 0u; xbw[1] = 0u; xbw[2] = 0u; xbw[3] = 0u; }
    __syncthreads();
    XcdBarrier bar = xcd_barrier_post(p.bar, xbw);
    ph::mods(p, lds);
    if constexpr (PROBE == 14) { ph::mods(p, lds); ph::mods(p, lds); }
    xcd_barrier(bar);
    { const int c = blockIdx.x, G = gridDim.x;
      ph::transposer(p, lds, c, c < 320 ? (320 - c + G - 1) / G : 0, G); __syncthreads();
      ph::transposer(p, lds, 320 + c, c < 632 ? (632 - c + G - 1) / G : 0, G); __syncthreads(); }
    ph::lru_weights(p);
    ph::fold_router(p);
    ph::norm_rows<0, D8_IN0>(p, p.x, p.norm0_mix, 0, 0, nullptr);
    xcd_barrier(bar);
    { const int c = blockIdx.x, G = gridDim.x; const int tcount = c < 6144 ? (6144 - c + G - 1) / G : 0; const bool t_first = ((c >> 3) & 1) != 0;
      if (t_first) { ph::transposer(p, lds, 952 + c, tcount, G); __syncthreads(); }
      { gm::DenseSched S; S.init(T_TOK, N_IN0); EpiIn0 e; e.xin = nullptr; e.lgate = 0; if constexpr (D8_IN0) gm::gemm_phase<EpiIn0, gm::DenseSched, true>(lds, p, p.H, p.w_in0t, 0, DM / 2, S, e, W8_E8M0, A8_E8M0); else gm::gemm_phase(lds, p, p.H, p.w_in0t, 0, DM, S, e); }
      if (!t_first) { __syncthreads(); ph::transposer(p, lds, 952 + c, tcount, G); }
      if constexpr (PROBE == 21) { __syncthreads(); ph::transposer(p, lds, 952 + c, tcount, G); }
      if constexpr (PROBE == 24) { __syncthreads(); if (t_first) ph::transposer(p, lds, 952 + c, tcount, G); }
      if constexpr (PROBE == 23) { __syncthreads(); if (t_first) { ph::transposer(p, lds, 952 + c, tcount, G); __syncthreads(); }
        { gm::DenseSched S; S.init(T_TOK, N_IN0); EpiIn0 e; e.xin = nullptr; e.lgate = 0; gm::gemm_phase<EpiIn0, gm::DenseSched, true>(lds, p, p.H, p.w_in0t, 0, DM / 2, S, e, W8_E8M0, A8_E8M0); }
        if (!t_first) { __syncthreads(); ph::transposer(p, lds, 952 + c, tcount, G); } }
      if constexpr (PROBE == 20) { __syncthreads(); gm::DenseSched S; S.init(T_TOK, N_IN0); EpiIn0 e; e.xin = nullptr; e.lgate = 0; gm::gemm_phase<EpiIn0, gm::DenseSched, true>(lds, p, p.H, p.w_in0t, 0, DM / 2, S, e, W8_E8M0, A8_E8M0); } }
    xcd_barrier(bar);
    ph::attention(p, lds);
    if constexpr (PROBE == 4) ph::attention(p, lds);
    __syncthreads();
    ph::conv_gln(p, lds);
    if constexpr (PROBE == 5) ph::conv_gln(p, lds);
    xcd_barrier(bar);
    { gm::DenseSched S; S.init(T_TOK, DM); EpiOut e; e.xin = p.x; e.lgate = 0; if constexpr (D8_OUT0) gm::gemm_phase<EpiOut, gm::DenseSched, true>(lds, p, p.AO, p.w_out0t, 0, DM / 2, S, e, W8_E8M0, A8_E8M0); else gm::gemm_phase(lds, p, p.AO, p.w_out0t, 0, DM, S, e); }
    xcd_barrier(bar);
    ph::router<false, true>(p, 0, lds, p.norm0_ffn, 1);
    if constexpr (PROBE == 12) { ph::router<true>(p, 0, lds); ph::router<true>(p, 0, lds); }
    xcd_barrier(bar);
    if constexpr (PROBE == 11) { xcd_barrier(bar); xcd_barrier(bar); xcd_barrier(bar); xcd_barrier(bar); xcd_barrier(bar); xcd_barrier(bar); xcd_barrier(bar); xcd_barrier(bar); xcd_barrier(bar); xcd_barrier(bar); }
    gm::moe_tables(tab, p.cnt);
    { gm::MoeSched<true> S; S.init(tab); EpiGU e; e.xin = nullptr; e.lgate = 0; gm::gemm_phase<EpiGU, gm::MoeSched<true>, true>(lds, p, p.H, p.w_gut0, (size_t)2048 * (DM / 2), DM / 2, S, e, W8_E8M0, A8_E8M0); if constexpr (PROBE == 3) gm::gemm_phase<EpiGU, gm::MoeSched<true>, true>(lds, p, p.H, p.w_gut0, (size_t)2048 * (DM / 2), DM / 2, S, e, W8_E8M0, A8_E8M0); }
    xcd_barrier(bar);
    { gm::MoeSched<false> S; S.init(tab); EpiDown e; e.xin = nullptr; e.lgate = 0; gm::gemm_phase<EpiDown, gm::MoeSched<false>, true>(lds, p, p.ACT, p.w_dt0, (size_t)DM * (EFF / 2), EFF / 2, S, e, W8_E8M0, A8_E8M0); if constexpr (PROBE == 8) gm::gemm_phase<EpiDown, gm::MoeSched<false>, true>(lds, p, p.ACT, p.w_dt0, (size_t)DM * (EFF / 2), EFF / 2, S, e, W8_E8M0, A8_E8M0); }
    xcd_barrier(bar);
    ph::norm_rows<1, D8_IN1>(p, nullptr, p.norm1_mix, 2, 1, tab);
    xcd_barrier(bar);
    { const int c = blockIdx.x, G = gridDim.x; int tfirst, tcount, tstride;
      if (G == 256) { tstride = 1; if (c < 64) { tcount = 18; tfirst = 18 * c; } else { tcount = 26; tfirst = 1152 + 26 * (c - 64); } }
      else { tstride = G; tfirst = c; tcount = c < 6144 ? (6144 - c + G - 1) / G : 0; }
      const bool t_first = ((c >> 3) & 1) != 0;
      if (t_first) { ph::transposer(p, lds, 7096 + tfirst, tcount, tstride); __syncthreads(); }
      { gm::DenseSched S; S.init(T_TOK, N_IN1); EpiIn1 e; e.xin = nullptr; e.lgate = 0; gm::gemm_phase(lds, p, p.H, p.w_in1t, 0, DM, S, e); }
      if (!t_first) { __syncthreads(); ph::transposer(p, lds, 7096 + tfirst, tcount, tstride); } }
    xcd_barrier(bar);
    ph::lru_conv(p);
    if constexpr (PROBE == 9) { ph::lru_conv(p); ph::lru_conv(p); }
    xcd_barrier(bar);
    ph::lru(p, lds);
    if constexpr (PROBE == 6) ph::lru(p, lds);
    xcd_barrier(bar);
    { gm::DenseSched S; S.init(T_TOK, DM); EpiOut e; e.xin = nullptr; e.lgate = 2; gm::gemm_phase(lds, p, p.AO, p.w_out1t, 0, LRU_W, S, e); }
    xcd_barrier(bar);
    ph::router<false, true>(p, 1, lds, p.norm1_ffn, 3);
    xcd_barrier(bar);
    gm::moe_tables(tab, p.cnt + 32);
    { gm::MoeSched<true> S; S.init(tab); EpiGU e; e.xin = nullptr; e.lgate = 0; gm::gemm_phase<EpiGU, gm::MoeSched<true>, true>(lds, p, p.H, p.w_gut1, (size_t)2048 * (DM / 2), DM / 2, S, e, W8_E8M0, A8_E8M0); }
    xcd_barrier(bar);
    { gm::MoeSched<false> S; S.init(tab); EpiDown e; e.xin = nullptr; e.lgate = 0; gm::gemm_phase<EpiDown, gm::MoeSched<false>, true>(lds, p, p.ACT, p.w_dt1, (size_t)DM * (EFF / 2), EFF / 2, S, e, W8_E8M0, A8_E8M0); }
    xcd_barrier(bar);
    ph::norm_rows<2>(p, nullptr, p.norm_final, 0, 3, tab);
}

static inline size_t al256(size_t x) { return (x + 255) & ~(size_t)255; }

extern "C" void kernel_launch(void* const* d_in, const int* in_sizes, int n_in, void* d_out, int out_size, void* d_ws, size_t ws_size, hipStream_t stream) {
    Params p{};
    const float** ip = (const float**)&p.x;
    for (int i = 0; i < 38; ++i) ip[i] = (const float*)d_in[i];
    p.out = (float*)d_out;
    char* w = (char*)d_ws; size_t off = 0;
    auto take = [&](size_t bytes) { char* r = w + off; off += al256(bytes); return r; };
    p.bar = (unsigned*)take(16384); p.cnt = (int*)take(256);
    const size_t zero_bytes = off;
    p.mod = (float*)take(4 * 4 * 6144 * 4); p.wrt = (float*)take((size_t)2 * 4 * 48 * 2048 * 4); p.rbias = (float*)take(2 * 4 * 48 * 4);
    p.w_in0t = (bf16_t*)take((size_t)N_IN0 * DM * 2); p.w_out0t = (bf16_t*)take((size_t)DM * DM * 2);
    p.w_gut0 = (bf16_t*)take((size_t)NEXP * 2048 * DM); p.w_dt0 = (bf16_t*)take((size_t)NEXP * DM * EFF);
    p.w_in1t = (bf16_t*)take((size_t)N_IN1 * DM * 2); p.w_out1t = (bf16_t*)take((size_t)DM * LRU_W * 2);
    p.w_gut1 = (bf16_t*)take((size_t)NEXP * 2048 * DM); p.w_dt1 = (bf16_t*)take((size_t)NEXP * DM * EFF);
    p.w_lru = (bf16_t*)take((size_t)2 * 2 * 16 * 2 * 96 * 192 * 2);
    p.H = (bf16_t*)take((size_t)T_TOK * DM * 2); p.G = (bf16_t*)take((size_t)T_TOK * N_IN1 * 2); p.AO = (bf16_t*)take((size_t)T_TOK * LRU_W * 2); p.HF = (bf16_t*)take((size_t)256 * 32 * 8 * 3 * 64 * 8);
    p.XA = (bf16_t*)take((size_t)T_TOK * DM * 2); p.ACT = (bf16_t*)take((size_t)ROWS_PAD * EFF * 2); p.YB = (bf16_t*)take((size_t)ROWS_PAD * DM * 2);
    p.XC = (bf16_t*)take((size_t)T_TOK * LRU_W * 2); p.KVH = (bf16_t*)take((size_t)NBATCH * 8 * 2 * SEQ * 128 * 2);
    p.tokl = (int*)take((size_t)NEXP * ECAP * 4); p.gatel = (float*)take((size_t)NEXP * ECAP * 4); p.asg = (int*)take((size_t)T_TOK * 2 * 4);
    if (off > ws_size) return;
    (void)hipMemsetAsync(d_ws, 0, zero_bytes, stream);
    static int grid = 0;
    if (!grid) { int dev = 0, cus = 0, per_cu = 0; (void)hipGetDevice(&dev); (void)hipDeviceGetAttribute(&cus, hipDeviceAttributeMultiprocessorCount, dev);
        (void)hipFuncSetAttribute((const void*)mega, hipFuncAttributeMaxDynamicSharedMemorySize, LDS_TOTAL);
        (void)hipOccupancyMaxActiveBlocksPerMultiprocessor(&per_cu, mega, 512, LDS_TOTAL);
        grid = cus * (per_cu < 1 ? per_cu : 1); }
    if (grid > 0) mega<<<grid, 512, LDS_TOTAL, stream>>>(p);
}
```

```cpp
#include <hip/hip_runtime.h>
#include <stdint.h>

typedef unsigned short bf16_t;
typedef float f32x4 __attribute__((ext_vector_type(4)));

#define DI __device__ __forceinline__

constexpr int T_TOK = 16384, DM = 2048, SEQ = 4096, NBATCH = 4;
constexpr int N_IN0 = 5120, N_IN1 = 5376, LRU_W = 2688, LRU_BW = 168;
constexpr int NEXP = 32, EFF = 1024, ECAP = 16384, ROWS_PAD = 40960;

DI float bf2f(bf16_t b) { return __uint_as_float(((unsigned)b) << 16); }
DI bf16_t f2bf(float f) { unsigned u = __float_as_uint(f); u += 0x7FFFu + ((u >> 16) & 1u); return (bf16_t)(u >> 16); }
DI float sigmoidf_(float x) { return __builtin_amdgcn_rcpf(1.0f + __expf(-x)); }
DI float siluf_(float x) { return x * __builtin_amdgcn_rcpf(1.0f + __expf(-x)); }
DI float gelu_tanh(float x) { const float u = 0.7978845608028654f * (x + 0.044715f * x * x * x); return x * __builtin_amdgcn_rcpf(1.0f + __expf(-2.0f * u)); }
DI float wave_sum(float v) { for (int o = 32; o > 0; o >>= 1) v += __shfl_xor(v, o); return v; }
DI float wave_max(float v) { for (int o = 32; o > 0; o >>= 1) v = fmaxf(v, __shfl_xor(v, o)); return v; }

struct Params {
    const float *x, *c;
    const float *norm0_mix, *ada0_mix_w, *ada0_mix_b, *w_in0, *conv_w, *conv_b, *conv_norm_g, *conv_norm_b, *w_out0;
    const float *norm0_ffn, *ada0_ffn_w, *ada0_ffn_b, *moe0_w_group, *moe0_w_expert, *moe0_w_gate_up, *moe0_w_down;
    const float *norm1_mix, *ada1_mix_w, *ada1_mix_b, *w_in1, *lru_conv_w, *lru_conv_b, *lru_w_a, *lru_b_a, *lru_w_x, *lru_b_x, *lru_lambda, *w_out1;
    const float *norm1_ffn, *ada1_ffn_w, *ada1_ffn_b, *moe1_w_group, *moe1_w_expert, *moe1_w_gate_up, *moe1_w_down;
    const float *norm_final;
    float* out;
    unsigned* bar; int* cnt;
    float* mod;
    bf16_t* wrt;
    float* rbias;
    bf16_t *w_in0t, *w_out0t, *w_gut0, *w_dt0, *w_in1t, *w_out1t, *w_gut1, *w_dt1, *w_lru;
    bf16_t *H, *G, *AO, *HF, *ACT, *YB, *XC, *KVH;
    bf16_t* XA;
    int* tokl; float* gatel; int* asg;
};

constexpr bool YB8_E = true;
struct GUnit { int rowbase; int nvalid; int e; const int* gather; };
struct GArgs { const bf16_t* A; const bf16_t* Bt; size_t bt_estride; long long lda, K, moe_layer; const float* xin; long long lgate; };
typedef unsigned u32x4_ __attribute__((ext_vector_type(4)));
typedef __bf16 bf2v_ __attribute__((ext_vector_type(2)));
typedef float f32x2_ __attribute__((ext_vector_type(2)));
DI unsigned pk2e(float a, float b) { f32x2_ v = {a, b}; bf2v_ r = __builtin_convertvector(v, bf2v_); return __builtin_bit_cast(unsigned, r); }
DI u32x4_ pack8(f32x4 a, f32x4 b) { return (u32x4_){pk2e(a[0], a[1]), pk2e(a[2], a[3]), pk2e(b[0], b[1]), pk2e(b[2], b[3])}; }
struct EpiIn0 { static constexpr bool GATHER = false; const float* xin; int lgate; DI void operator()(const Params& p, const GUnit& u, int r, int col0, f32x4 lo0, f32x4 lo1, f32x4 hi0, f32x4 hi1) const {
    const int row = u.rowbase + r;
    if (col0 < 3072) { bf16_t* o = p.G + (size_t)row * N_IN0 + col0; *(u32x4_*)o = pack8(lo0, lo1); *(u32x4_*)(o + 128) = pack8(hi0, hi1); }
    else { const int b = row / SEQ, t = row % SEQ, i0 = (col0 - 3072) >> 7, i1 = i0 + 1;
        bf16_t* o0 = p.KVH + ((size_t)((b * 8 + (i0 & 7)) * 2 + (i0 >> 3)) * SEQ + t) * 128 + (col0 & 127);
        bf16_t* o1 = p.KVH + ((size_t)((b * 8 + (i1 & 7)) * 2 + (i1 >> 3)) * SEQ + t) * 128 + (col0 & 127);
        *(u32x4_*)o0 = pack8(lo0, lo1); *(u32x4_*)o1 = pack8(hi0, hi1); } } };
struct EpiOut { static constexpr bool GATHER = false; const float* xin; int lgate; DI void operator()(const Params& p, const GUnit& u, int r, int col0, f32x4 lo0, f32x4 lo1, f32x4 hi0, f32x4 hi1) const {
    const int row = u.rowbase + r, b = row / SEQ; const float* gt = p.mod + (lgate * 4 + b) * 6144 + 4096 + col0; bf16_t* o = p.XA + (size_t)row * DM + col0;
    f32x4 r0, r1, r2, r3;
    if (xin) { const float* xi = xin + (size_t)row * DM + col0; r0 = *(const f32x4*)xi; r1 = *(const f32x4*)(xi + 4); r2 = *(const f32x4*)(xi + 128); r3 = *(const f32x4*)(xi + 132); }
    else { const u32x4_ a = *(const u32x4_*)o, c = *(const u32x4_*)(o + 128);
        r0 = (f32x4){__uint_as_float(a[0] << 16), __uint_as_float(a[0] & 0xffff0000u), __uint_as_float(a[1] << 16), __uint_as_float(a[1] & 0xffff0000u)};
        r1 = (f32x4){__uint_as_float(a[2] << 16), __uint_as_float(a[2] & 0xffff0000u), __uint_as_float(a[3] << 16), __uint_as_float(a[3] & 0xffff0000u)};
        r2 = (f32x4){__uint_as_float(c[0] << 16), __uint_as_float(c[0] & 0xffff0000u), __uint_as_float(c[1] << 16), __uint_as_float(c[1] & 0xffff0000u)};
        r3 = (f32x4){__uint_as_float(c[2] << 16), __uint_as_float(c[2] & 0xffff0000u), __uint_as_float(c[3] << 16), __uint_as_float(c[3] & 0xffff0000u)}; }
    *(u32x4_*)o = pack8(r0 + *(const f32x4*)gt * lo0, r1 + *(const f32x4*)(gt + 4) * lo1); *(u32x4_*)(o + 128) = pack8(r2 + *(const f32x4*)(gt + 128) * hi0, r3 + *(const f32x4*)(gt + 132) * hi1); } };
DI unsigned pk4_fp8e(float a, float b, float c, float d, float sc) { a = fminf(fmaxf(a * sc, -448.f), 448.f); b = fminf(fmaxf(b * sc, -448.f), 448.f); c = fminf(fmaxf(c * sc, -448.f), 448.f); d = fminf(fmaxf(d * sc, -448.f), 448.f);
    unsigned w = 0u; w = __builtin_amdgcn_cvt_pk_fp8_f32(a, b, w, false); w = __builtin_amdgcn_cvt_pk_fp8_f32(c, d, w, true); return w; }
struct EpiGU { static constexpr bool GATHER = true; const float* xin; int lgate; DI void operator()(const Params& p, const GUnit& u, int r, int col0, f32x4 lo0, f32x4 lo1, f32x4 hi0, f32x4 hi1) const {
    f32x4 a0, a1;
#pragma unroll
    for (int j = 0; j < 4; ++j) { a0[j] = siluf_(lo0[j]) * hi0[j]; a1[j] = siluf_(lo1[j]) * hi1[j]; }
    *(uint2*)((unsigned char*)p.ACT + (size_t)(u.rowbase + r) * EFF + (col0 >> 8) * 128 + (col0 & 127)) = make_uint2(pk4_fp8e(a0[0], a0[1], a0[2], a0[3], 8.f), pk4_fp8e(a1[0], a1[1], a1[2], a1[3], 8.f)); } };
struct EpiDown { static constexpr bool GATHER = false; const float* xin; int lgate; DI void operator()(const Params& p, const GUnit& u, int r, int col0, f32x4 lo0, f32x4 lo1, f32x4 hi0, f32x4 hi1) const {
    const float g = p.gatel[(u.gather - p.tokl) + r];
    if constexpr (YB8_E) { const float gs = g * 64.f; unsigned char* o = (unsigned char*)p.YB + (size_t)(u.rowbase + r) * DM + col0;
        *(uint2*)o = make_uint2(pk4_fp8e(lo0[0], lo0[1], lo0[2], lo0[3], gs), pk4_fp8e(lo1[0], lo1[1], lo1[2], lo1[3], gs)); *(uint2*)(o + 128) = make_uint2(pk4_fp8e(hi0[0], hi0[1], hi0[2], hi0[3], gs), pk4_fp8e(hi1[0], hi1[1], hi1[2], hi1[3], gs)); }
    else { bf16_t* o = p.YB + (size_t)(u.rowbase + r) * DM + col0; *(u32x4_*)o = pack8(lo0 * g, lo1 * g); *(u32x4_*)(o + 128) = pack8(hi0 * g, hi1 * g); } } };
struct EpiIn1 { static constexpr bool GATHER = false; const float* xin; int lgate; DI void operator()(const Params& p, const GUnit& u, int r, int col0, f32x4 lo0, f32x4 lo1, f32x4 hi0, f32x4 hi1) const {
    bf16_t* o = p.G + (size_t)(u.rowbase + r) * N_IN1 + col0;
    if (col0 < LRU_W) {
#pragma unroll
        for (int j = 0; j < 4; ++j) { lo0[j] = gelu_tanh(lo0[j]); lo1[j] = gelu_tanh(lo1[j]); } }
    if (col0 + 128 < LRU_W) {
#pragma unroll
        for (int j = 0; j < 4; ++j) { hi0[j] = gelu_tanh(hi0[j]); hi1[j] = gelu_tanh(hi1[j]); } }
    *(u32x4_*)o = pack8(lo0, lo1); *(u32x4_*)(o + 128) = pack8(hi0, hi1); } };

#define LAS __attribute__((address_space(3)))
typedef short bf16x8 __attribute__((ext_vector_type(8)));
DI int opaque_tid() { int t = threadIdx.x; asm volatile("" : "+v"(t)); return t; }
namespace gm {
constexpr int BM = 256, BK = 64, HALF = 128, HTB = HALF * BK * 2, STAGE_BYTES = 8 * HTB, NXCD = 8, WGM = 4;
constexpr int TAB_OFF = STAGE_BYTES;
DI int lds_byte(int r, int c) { const int st = (r >> 4) * 2 + (c >> 5), rr = r & 15, cc = c & 31, ob = rr * 64 + cc * 2; return st * 1024 + (ob ^ (((ob >> 9) & 1) << 5)); }
DI int perm32(int rho) { const int n = rho >> 4, i = rho & 15; return 8 * (i >> 2) + 4 * n + (i & 3); }
DI void stage_rc(int b, int& R, int& C) { const int st = b / 1024, sb = b % 1024, swz = sb ^ (((sb >> 9) & 1) << 5); R = (st >> 1) * 16 + swz / 64; C = (st & 1) * 32 + (swz % 64) / 2; }
struct Unit { int arow, nvalid, orow, pn, e, goff; };
struct DenseSched {
    static constexpr bool GATHER = false, HALF_SKIP = false;
    int nM, nN, nwg, G, c;
    DI void init(int M, int N) { nM = M / BM; nN = N / BM; nwg = nM * nN; G = gridDim.x; c = blockIdx.x; }
    DI bool next(int i, Unit& u) const {
        const long L = (long)i * G + c; if (L >= nwg) return false;
        int wgid = (int)L; { const int q = nwg / NXCD, r = nwg % NXCD, xcd = wgid % NXCD, off = wgid / NXCD; wgid = (xcd < r ? xcd * (q + 1) : r * (q + 1) + (xcd - r) * q) + off; }
        const int nig = WGM * nN, gid = wgid / nig, fm = gid * WGM, gsz = (nM - fm) < WGM ? (nM - fm) : WGM;
        const int pm = fm + ((wgid % nig) % gsz); u.pn = (wgid % nig) / gsz; u.arow = pm * BM; u.orow = pm * BM; u.nvalid = BM; u.e = 0; u.goff = 0; return true;
    }
};
template <bool GATH> struct MoeSched {
    static constexpr bool GATHER = GATH, HALF_SKIP = true;
    const LAS int* tab; int G, c;
    DI void init(const LAS int* t) { tab = t; G = gridDim.x; c = blockIdx.x; }
    DI bool next(int i, Unit& u) const {
        const int L = i * G + c, mtile = L >> 3; const int total = __builtin_amdgcn_readfirstlane(tab[32]);
        if (mtile >= total) return false;
        int e = 0; for (int j = 1; j < 32; ++j) { if (__builtin_amdgcn_readfirstlane(tab[j]) <= mtile) e = j; }
        const int mt = mtile - __builtin_amdgcn_readfirstlane(tab[e]); const int cn = __builtin_amdgcn_readfirstlane(tab[64 + e]);
        u.e = e; u.pn = L & 7; u.orow = mtile * BM; u.arow = mtile * BM; u.nvalid = (cn - mt * BM) < BM ? (cn - mt * BM) : BM; u.goff = e * ECAP + mt * BM; return true;
    }
};
DI void moe_tables(LAS int* tab, const int* cnt) {
    if (threadIdx.x == 0) { int run = 0; for (int e = 0; e < 32; ++e) { const int cn = cnt[e]; tab[e] = run; tab[64 + e] = cn; run += (cn + 255) >> 8; } tab[32] = run; }
    __syncthreads();
}

typedef int i32x8 __attribute__((ext_vector_type(8)));
typedef int i32x4 __attribute__((ext_vector_type(4)));
DI void mfma8(f32x4& acc, const i32x8& w8, const i32x8& x8, int ws, int as) {
    asm volatile("v_mfma_scale_f32_16x16x128_f8f6f4 %0, %1, %2, %0, %3, %4 op_sel_hi:[0,0,0]" : "+v"(acc) : "v"(w8), "v"(x8), "v"(ws), "v"(as)); }
template <class Epi, class Sched, bool FP8 = false>
DI void gemm_phase(LAS unsigned char* lds, const Params& p, const bf16_t* A, const bf16_t* Bt, size_t bt_estride, int K, const Sched& S, const Epi& E, int wscale = 0x7f7f7f7f, int ascale = 0x7f7f7f7f) {
    const int tid = opaque_tid(), wid = __builtin_amdgcn_readfirstlane(tid >> 6), lane = tid & 63, wr = wid >> 2, wc = wid & 3, fr = lane & 15, fq = lane >> 4;
    const int nt = K / BK;
    unsigned voffA[2], voffB[2];
#pragma unroll
    for (int i = 0; i < 2; ++i) { int R, C; stage_rc(tid * 16 + i * 8192, R, C); voffA[i] = (unsigned)(R * K + C) * 2u; voffB[i] = (unsigned)(((R & ~31) + perm32(R & 31)) * K + C) * 2u; }
    const size_t kstep = (size_t)(BK * 2), hstep = (size_t)HALF * K * 2, tstep = 2 * hstep;
    const unsigned ldsw = (unsigned)wid * 1024u;
    const int aoff = lds_byte(wr * 64 + fr, fq * 8), boff = lds_byte(wc * 32 + fr, fq * 8);
#define G_SA(b, h) (((b) * 2 + (h)) * HTB)
#define G_SB(b, h) ((4 + (b) * 2 + (h)) * HTB)
#define G_STAGE(bufoff, gbase, voff) do { _Pragma("unroll") for (int _i = 0; _i < 2; ++_i) \
        __builtin_amdgcn_global_load_lds((const unsigned*)((const char*)(gbase) + (voff)[_i]), (LAS unsigned*)(lds + (bufoff) + ldsw + _i * 8192), 16, 0, 0); } while (0)
#define G_STAGE_A(bufoff, ubase, gv, h, koff) do { if constexpr (Sched::GATHER) { G_STAGE(bufoff, (const char*)A + (koff), gv[h]); } else { G_STAGE(bufoff, (ubase) + (h) * hstep + (koff), voffA); } } while (0)
#define G_LD16(off_) (*(const LAS i32x4*)(lds + (off_)))
#define G_LD16B(off_) (*(const LAS bf16x8*)(lds + (off_)))
#define G_LDA(dst, b, h) do { _Pragma("unroll") for (int m = 0; m < 4; ++m) { if constexpr (FP8) dst##8[m] = __builtin_shufflevector(G_LD16(G_SA(b, h) + aoff + m * 2048), G_LD16(G_SA(b, h) + aoff + m * 2048 + 1024), 0, 1, 2, 3, 4, 5, 6, 7); \
        else { dst[m][0] = G_LD16B(G_SA(b, h) + aoff + m * 2048); dst[m][1] = G_LD16B(G_SA(b, h) + aoff + m * 2048 + 1024); } } } while (0)
#define G_LDB(dst, b, h) do { _Pragma("unroll") for (int n = 0; n < 2; ++n) { if constexpr (FP8) dst##8[n] = __builtin_shufflevector(G_LD16(G_SB(b, h) + boff + n * 2048), G_LD16(G_SB(b, h) + boff + n * 2048 + 1024), 0, 1, 2, 3, 4, 5, 6, 7); \
        else { dst[n][0] = G_LD16B(G_SB(b, h) + boff + n * 2048); dst[n][1] = G_LD16B(G_SB(b, h) + boff + n * 2048 + 1024); } } } while (0)
#define G_MMA(ai, bj, At, Bt_) do { __builtin_amdgcn_s_setprio(1); _Pragma("unroll") for (int m = 0; m < 4; ++m) _Pragma("unroll") for (int n = 0; n < 2; ++n) { \
        if constexpr (FP8) mfma8(acc[ai][bj][m][n], Bt_##8[n], At##8[m], wscale, ascale); \
        else { _Pragma("unroll") for (int k = 0; k < 2; ++k) acc[ai][bj][m][n] = __builtin_amdgcn_mfma_f32_16x16x32_bf16(Bt_[n][k], At[m][k], acc[ai][bj][m][n], 0, 0, 0); } } \
        __builtin_amdgcn_s_setprio(0); } while (0)
#define G_WAIT_V(n) asm volatile("s_waitcnt vmcnt(" #n ")" ::: "memory")
#define G_WAIT_L(n) asm volatile("s_waitcnt lgkmcnt(" #n ")" ::: "memory")
#define G_BAR __builtin_amdgcn_s_barrier()
#define G_SCHED __builtin_amdgcn_sched_barrier(0)
    Unit cur, nxt; int ui = 0;
    if (!S.next(0, cur)) return;
    f32x4 acc[2][2][4][2];
#pragma unroll
    for (int a = 0; a < 2; ++a)
#pragma unroll
        for (int b = 0; b < 2; ++b)
#pragma unroll
            for (int m = 0; m < 4; ++m)
#pragma unroll
                for (int n = 0; n < 2; ++n) acc[a][b][m][n] = (f32x4){0.f, 0.f, 0.f, 0.f};
    bf16x8 At[4][2], B0[2][2], B1[2][2]; i32x8 At8[4], B08[2], B18[2];
    unsigned gcur[2][2] = {{0u, 0u}, {0u, 0u}}, gnxt[2][2] = {{0u, 0u}, {0u, 0u}};
    auto gather_offs = [&](const Unit& u, unsigned (&g)[2][2]) {
        if constexpr (Sched::GATHER) {
#pragma unroll
            for (int h = 0; h < 2; ++h)
#pragma unroll
                for (int i = 0; i < 2; ++i) { int tz = tid; asm volatile("" : "+v"(tz)); int R, C; stage_rc(tz * 16 + i * 8192, R, C); const int r = h * HALF + R; const int tk = p.tokl[u.goff + (r < u.nvalid ? r : 0)]; const int tok = r < u.nvalid ? tk : 0; g[h][i] = (unsigned)(tok * K + C) * 2u; }
        }
    };
    const char* cA = (const char*)A + (size_t)(cur.arow / BM) * tstep; const char* cB = (const char*)Bt + ((size_t)cur.e * bt_estride) * 2 + (size_t)cur.pn * tstep;
    gather_offs(cur, gcur);
    G_STAGE(G_SB(0, 0), cB, voffB); G_STAGE_A(G_SA(0, 0), cA, gcur, 0, 0); G_STAGE(G_SB(0, 1), cB + hstep, voffB); G_STAGE_A(G_SA(0, 1), cA, gcur, 1, 0);
    if (wr == 1) G_BAR;
    G_WAIT_V(4); G_BAR;
    G_STAGE(G_SB(1, 0), cB + kstep, voffB); G_STAGE_A(G_SA(1, 0), cA, gcur, 0, kstep); G_STAGE(G_SB(1, 1), cB + hstep + kstep, voffB);
    G_WAIT_V(6); G_BAR;
    for (;;) {
        const bool has_next = S.next(ui + 1, nxt);
        const char* nA = has_next ? (const char*)A + (size_t)(nxt.arow / BM) * tstep : cA;
        const char* nB = has_next ? (const char*)Bt + ((size_t)nxt.e * bt_estride) * 2 + (size_t)nxt.pn * tstep : cB;
        if constexpr (Sched::GATHER) { if (has_next) gather_offs(nxt, gnxt); else {
#pragma unroll
            for (int h = 0; h < 2; ++h) { gnxt[h][0] = gcur[h][0]; gnxt[h][1] = gcur[h][1]; } } }
        for (int t = 0; t < nt; t += 2) {
            const bool last = (t == nt - 2);
            const size_t k1 = (size_t)(t + 1) * kstep;
            const char* a2 = last ? nA : cA; const char* b2 = last ? nB : cB + (size_t)(t + 2) * kstep;
            const size_t k2 = last ? 0 : (size_t)(t + 2) * kstep; const size_t k3 = k2 + kstep;
            const char* b3 = b2 + kstep;
            unsigned g2[2][2];
#pragma unroll
            for (int h = 0; h < 2; ++h) { g2[h][0] = last ? gnxt[h][0] : gcur[h][0]; g2[h][1] = last ? gnxt[h][1] : gcur[h][1]; }
            G_LDB(B0, 0, 0); G_SCHED; G_LDA(At, 0, 0); G_STAGE_A(G_SA(1, 1), cA, gcur, 1, k1);
            G_WAIT_L(8); G_BAR; G_WAIT_L(0); G_MMA(0, 0, At, B0); G_BAR; G_SCHED;
            G_LDB(B1, 0, 1); G_STAGE(G_SB(0, 0), b2, voffB);
            G_BAR; G_WAIT_L(0); G_MMA(0, 1, At, B1); G_BAR;
            G_LDA(At, 0, 1); G_STAGE_A(G_SA(0, 0), a2, g2, 0, k2);
            G_BAR; G_WAIT_L(0); if (!Sched::HALF_SKIP || cur.nvalid > HALF) G_MMA(1, 0, At, B0); G_BAR; G_SCHED;
            G_STAGE(G_SB(0, 1), b2 + hstep, voffB);
            G_WAIT_V(6); G_BAR; if (!Sched::HALF_SKIP || cur.nvalid > HALF) G_MMA(1, 1, At, B1); G_BAR;
            G_LDB(B0, 1, 0); G_SCHED; G_LDA(At, 1, 0); G_STAGE_A(G_SA(0, 1), a2, g2, 1, k2);
            G_WAIT_L(8); G_BAR; G_WAIT_L(0); G_MMA(0, 0, At, B0); G_BAR; G_SCHED;
            G_LDB(B1, 1, 1); G_STAGE(G_SB(1, 0), b3, voffB);
            G_BAR; G_WAIT_L(0); G_MMA(0, 1, At, B1); G_BAR;
            G_LDA(At, 1, 1); G_STAGE_A(G_SA(1, 0), a2, g2, 0, k3);
            G_BAR; G_WAIT_L(0); if (!Sched::HALF_SKIP || cur.nvalid > HALF) G_MMA(1, 0, At, B0); G_BAR; G_SCHED;
            G_STAGE(G_SB(1, 1), b3 + hstep, voffB);
            G_WAIT_V(6); G_BAR; if (!Sched::HALF_SKIP || cur.nvalid > HALF) G_MMA(1, 1, At, B1); G_BAR;
        }
        if constexpr (FP8) asm volatile("s_nop 15\n\ts_nop 15" ::: "memory");
        { GUnit gu; gu.rowbase = cur.orow; gu.nvalid = cur.nvalid; gu.e = cur.e; gu.gather = p.tokl + cur.goff;
#pragma unroll
          for (int ai = 0; ai < 2; ++ai)
#pragma unroll
            for (int m = 0; m < 4; ++m) { const int r = ai * HALF + wr * 64 + m * 16 + fr;
              if (r < cur.nvalid) E(p, gu, r, cur.pn * BM + wc * 32 + fq * 8, acc[ai][0][m][0], acc[ai][0][m][1], acc[ai][1][m][0], acc[ai][1][m][1]); } }
        if (!has_next) break;
#pragma unroll
        for (int a = 0; a < 2; ++a)
#pragma unroll
            for (int b = 0; b < 2; ++b)
#pragma unroll
                for (int m = 0; m < 4; ++m)
#pragma unroll
                    for (int n = 0; n < 2; ++n) acc[a][b][m][n] = (f32x4){0.f, 0.f, 0.f, 0.f};
        cur = nxt; cA = nA; cB = nB; ++ui;
#pragma unroll
        for (int h = 0; h < 2; ++h) { gcur[h][0] = gnxt[h][0]; gcur[h][1] = gnxt[h][1]; }
    }
    G_WAIT_V(0);
    if (wr == 0) G_BAR;
    G_BAR;
}
}

extern __shared__ __attribute__((aligned(16))) unsigned char dyn_smem[];
constexpr int LDS_BYTES = gm::STAGE_BYTES + 1024;

typedef __bf16 bf2v __attribute__((ext_vector_type(2)));
typedef float f32x2 __attribute__((ext_vector_type(2)));
typedef float f32x16 __attribute__((ext_vector_type(16)));
typedef short s16x4 __attribute__((ext_vector_type(4)));
typedef unsigned u32x4 __attribute__((ext_vector_type(4)));
DI unsigned pk2(float a, float b) { f32x2 v = {a, b}; bf2v r = __builtin_convertvector(v, bf2v); return __builtin_bit_cast(unsigned, r); }
DI float bflo(unsigned u) { return __uint_as_float(u << 16); }
DI float bfhi(unsigned u) { return __uint_as_float(u & 0xffff0000u); }

DI unsigned pk4_fp8(float a, float b, float c, float d, float sc) {
    a = __builtin_amdgcn_fmed3f(a * sc, -448.f, 448.f); b = __builtin_amdgcn_fmed3f(b * sc, -448.f, 448.f); c = __builtin_amdgcn_fmed3f(c * sc, -448.f, 448.f); d = __builtin_amdgcn_fmed3f(d * sc, -448.f, 448.f);
    unsigned w = 0u; w = __builtin_amdgcn_cvt_pk_fp8_f32(a, b, w, false); w = __builtin_amdgcn_cvt_pk_fp8_f32(c, d, w, true); return w; }
constexpr bool D8_IN0 = true, D8_OUT0 = false, D8_IN1 = false;
constexpr bool YB8 = true;
constexpr float Y8_SCALE = 64.f;
constexpr float W8_SCALE = 256.f, A8_SCALE = 8.f;
constexpr int W8_E8M0 = 0x77777777, A8_E8M0 = 0x7c7c7c7c;
namespace ph {
DI void mods(const Params& p, LAS unsigned char* lds) {
    const int tid = opaque_tid(), wave = tid >> 6, lane = tid & 63, l8 = tid & 7, rg = tid >> 3;
    LAS float* fl = (LAS float*)lds; LAS float* red = fl + 4 * DM;
    for (int i = tid; i < 4 * DM; i += 512) fl[i] = siluf_(p.c[i]);
    __syncthreads();
    for (int u = blockIdx.x; u < 768; u += gridDim.x) {
        const int l = u / 192, c32 = u % 192;
        const float* w = l == 0 ? p.ada0_mix_w : l == 1 ? p.ada0_ffn_w : l == 2 ? p.ada1_mix_w : p.ada1_ffn_w;
        const float* bs = l == 0 ? p.ada0_mix_b : l == 1 ? p.ada0_ffn_b : l == 2 ? p.ada1_mix_b : p.ada1_ffn_b;
        f32x4 acc[4] = {{0.f, 0.f, 0.f, 0.f}, {0.f, 0.f, 0.f, 0.f}, {0.f, 0.f, 0.f, 0.f}, {0.f, 0.f, 0.f, 0.f}};
        const float* wp = w + (size_t)rg * 6144 + c32 * 32 + l8 * 4;
#pragma unroll 8
        for (int i = 0; i < 32; ++i) { const f32x4 wv = *(const f32x4*)(wp + (size_t)(64 * i) * 6144); const int k = rg + 64 * i;
#pragma unroll
            for (int b = 0; b < 4; ++b) acc[b] += fl[b * DM + k] * wv; }
#pragma unroll
        for (int b = 0; b < 4; ++b)
#pragma unroll
            for (int j = 0; j < 4; ++j) { float v = acc[b][j]; v += __shfl_xor(v, 8); v += __shfl_xor(v, 16); v += __shfl_xor(v, 32); acc[b][j] = v; }
        if (lane < 8) {
#pragma unroll
            for (int b = 0; b < 4; ++b) *(LAS f32x4*)(red + (wave * 4 + b) * 32 + lane * 4) = acc[b]; }
        __syncthreads();
        if (tid < 128) { const int b = tid >> 5, col = tid & 31; float sum = 0.f;
#pragma unroll
            for (int w8 = 0; w8 < 8; ++w8) sum += red[(w8 * 4 + b) * 32 + col];
            p.mod[(l * 4 + b) * 6144 + c32 * 32 + col] = sum + bs[c32 * 32 + col]; }
        __syncthreads();
    }
}
constexpr int NT_UNITS = (640 + 256 + 672 + 336 + 2 * (8192 + 4096)) / 2;
struct UD { const float* sp; bf16_t* dst; int K, N, mode, e, kt, ntile; };
DI UD tdecode(const Params& p, int u, int lane) {
    const float* srcs[8] = {p.w_in0, p.w_out0, p.w_in1, p.w_out1, p.moe0_w_gate_up, p.moe0_w_down, p.moe1_w_gate_up, p.moe1_w_down};
    bf16_t* dsts[8] = {p.w_in0t, p.w_out0t, p.w_in1t, p.w_out1t, p.w_gut0, p.w_dt0, p.w_gut1, p.w_dt1};
    constexpr int Ks[8] = {DM, DM, DM, LRU_W, DM, EFF, DM, EFF}, Ns[8] = {N_IN0, DM, N_IN1, DM, 2048, DM, 2048, DM}, nus[8] = {320, 128, 336, 168, 4096, 2048, 4096, 2048};
    constexpr int modes[8] = {D8_IN0 ? 2 : 0, D8_OUT0 ? 2 : 0, D8_IN1 ? 2 : 0, 0, 3, 2, 3, 2};
    int v = u, mi = 0;
#pragma unroll
    for (int m = 0; m < 8; ++m) { if (mi == m && v >= nus[m]) { v -= nus[m]; mi = m + 1; } }
    UD d; const float* src = srcs[0]; d.dst = dsts[0]; d.K = Ks[0]; d.N = Ns[0]; d.mode = modes[0];
#pragma unroll
    for (int m = 1; m < 8; ++m) if (mi == m) { src = srcs[m]; d.dst = dsts[m]; d.K = Ks[m]; d.N = Ns[m]; d.mode = modes[m]; }
    const int ntl = d.N / 256, ktl = d.K / 128; d.e = v / (ktl * ntl); const int rem = v % (ktl * ntl); d.kt = rem / ntl; d.ntile = rem % ntl;
    d.sp = src + (size_t)d.e * d.K * d.N + (size_t)(d.kt * 128) * d.N + d.ntile * 256 + lane * 4;
    return d;
}
DI void transposer(const Params& p, LAS unsigned char* lds, int first, int count, int stride) {
    const int tid = opaque_tid(), wave = tid >> 6, lane = tid & 63;
    LAS float* fl = (LAS float*)lds;
    if (count <= 0) return;
    if (tdecode(p, first, lane).mode & 2) {
        LAS unsigned* td = (LAS unsigned*)lds;
        const int nl = lane & 15, ks = lane >> 4;
        auto src_of = [&](const UD& d, int g, int j) -> const float* { const int kq = 4 * (g >> 2) + ks, nq = 16 * (g & 3) + nl; return d.sp - lane * 4 + (size_t)(4 * kq + j) * d.N + 4 * nq; };
        f32x4 va[4][4], vb[4][4];
        auto load_unit = [&](int u, f32x4 (&v)[4][4]) { const UD dd = tdecode(p, u, lane);
#pragma unroll
            for (int i = 0; i < 4; ++i)
#pragma unroll
                for (int j = 0; j < 4; ++j) v[i][j] = *(const f32x4*)src_of(dd, wave * 4 + i, j); };
        auto process = [&](int jn, f32x4 (&v)[4][4]) { const int u = first + jn * stride;
            const UD d = tdecode(p, u, lane); const int K = d.K, N = d.N, mode = d.mode, e = d.e, kt = d.kt, ntile = d.ntile;
            LAS unsigned* tile = td + (jn & 1) * (256 * 33);
#pragma unroll
            for (int i = 0; i < 4; ++i) { const int g = wave * 4 + i, kq = 4 * (g >> 2) + ks, nq = 16 * (g & 3) + nl;
#pragma unroll
                for (int en = 0; en < 4; ++en) tile[(4 * nq + en) * 33 + kq] = pk4_fp8(v[i][0][en], v[i][1][en], v[i][2][en], v[i][3][en], W8_SCALE); }
            __syncthreads();
            if (jn + 2 < count) load_unit(u + 2 * stride, v);
            { const int n = tid >> 1, kh = tid & 1; const int ng = ntile * 256 + n; const int jg = ng & 1023; const int np = (mode & 1) ? (256 * (jg >> 7) + (ng < 1024 ? 0 : 128) + (jg & 127)) : ng;
              unsigned char* dp = (unsigned char*)d.dst + (size_t)e * N * K + (size_t)np * K + kt * 128 + kh * 64;
#pragma unroll
              for (int jj = 0; jj < 4; ++jj) { const LAS unsigned* tp = tile + n * 33 + kh * 16 + jj * 4; *(uint4*)(dp + jj * 16) = make_uint4(tp[0], tp[1], tp[2], tp[3]); } } };
        load_unit(first, va); if (count > 1) load_unit(first + stride, vb);
        for (int jn = 0; jn < count; jn += 2) { process(jn, va); if (jn + 1 < count) process(jn + 1, vb); }
        __syncthreads();
        return;
    }
    f32x4 vv[16];
    { const UD d0 = tdecode(p, first, lane);
#pragma unroll
        for (int i = 0; i < 16; ++i) vv[i] = *(const f32x4*)(d0.sp + (size_t)(i * 8 + wave) * d0.N); }
    for (int j = 0; j < count; ++j) { const int u = first + j * stride;
        const UD d = tdecode(p, u, lane); const int K = d.K, N = d.N, mode = d.mode, e = d.e, kt = d.kt, ntile = d.ntile; bf16_t* dst = d.dst;
#pragma unroll
        for (int i = 0; i < 16; ++i) { LAS float* tp = fl + (i * 8 + wave) * 257 + lane * 4; tp[0] = vv[i][0]; tp[1] = vv[i][1]; tp[2] = vv[i][2]; tp[3] = vv[i][3]; }
        __syncthreads();
        if (j + 1 < count) { const UD dn = tdecode(p, u + stride, lane);
#pragma unroll
            for (int i = 0; i < 16; ++i) vv[i] = *(const f32x4*)(dn.sp + (size_t)(i * 8 + wave) * dn.N); }
        { const int n = tid >> 1, kh = tid & 1; const int ng = ntile * 256 + n; const int jg = ng & 1023; const int np = (mode & 1) ? (256 * (jg >> 7) + (ng < 1024 ? 0 : 128) + (jg & 127)) : ng;
          bf16_t* dp = dst + (size_t)e * N * K + (size_t)np * K + kt * 128 + kh * 64;
#pragma unroll
          for (int jj = 0; jj < 8; ++jj) { unsigned w4[4];
#pragma unroll
              for (int q = 0; q < 4; ++q) { const int k = kh * 64 + jj * 8 + q * 2; w4[q] = pk2(fl[k * 257 + n], fl[(k + 1) * 257 + n]); }
              *(uint4*)(dp + jj * 8) = make_uint4(w4[0], w4[1], w4[2], w4[3]); } }
        __syncthreads();
    }
}
DI void lru_weights(const Params& p) {
    const int tid = opaque_tid();
    for (size_t i = (size_t)blockIdx.x * 512 + tid; i < (size_t)2 * 2 * 16 * 4 * 48 * 192; i += (size_t)gridDim.x * 512) {
        const int k = i % 192, j = (i / 192) % 48, qt = (i / (192 * 48)) % 4, n = (i / (192 * 48 * 4)) % 16, which = (i / (192 * 48 * 4 * 16)) % 2, dir = i / (192 * 48 * 4 * 16 * 2);
        const float* w = which == 0 ? p.lru_w_a : p.lru_w_x; float v = 0.f;
        if (j < 42 && k < 168) v = w[(((size_t)dir * 16 + n) * 168 + k) * 168 + qt * 42 + j];
        p.w_lru[i] = f2bf(v);
    }
}
DI void fold_router(const Params& p) {
    const int tid = opaque_tid(), wave = tid >> 6, lane = tid & 63;
    for (size_t i = (size_t)blockIdx.x * 512 + tid; i < (size_t)2 * 4 * 48 * DM; i += (size_t)gridDim.x * 512) {
        const int k = i % DM, n = (i / DM) % 48, b = (i / (DM * 48)) % 4, l = i / (DM * 48 * 4);
        const float* g = l == 0 ? p.norm0_ffn : p.norm1_ffn; const float* md = p.mod + ((l == 0 ? 1 : 3) * 4 + b) * 6144;
        const float* we = l == 0 ? p.moe0_w_expert : p.moe1_w_expert; const float* wg = l == 0 ? p.moe0_w_group : p.moe1_w_group;
        const float w = n < 32 ? we[k * 32 + n] : n < 36 ? wg[k * 4 + (n - 32)] : 0.f;
        const float wf = g[k] * (1.f + md[2048 + k]) * w;
        const bf16_t hi = f2bf(wf); const float r1 = wf - bf2f(hi); const bf16_t mid = f2bf(r1); const bf16_t lo = f2bf(r1 - bf2f(mid));
        bf16_t* dst = p.wrt + ((size_t)((l * 4 + b) * 3) * 48 + n) * DM + k;
        dst[0] = hi; dst[(size_t)48 * DM] = mid; dst[(size_t)96 * DM] = lo;
    }
    for (int task = blockIdx.x * 8 + wave; task < 2 * 4 * 48; task += gridDim.x * 8) {
        const int n = task % 48, b = (task / 48) % 4, l = task / (48 * 4);
        const float* md = p.mod + ((l == 0 ? 1 : 3) * 4 + b) * 6144;
        const float* we = l == 0 ? p.moe0_w_expert : p.moe1_w_expert; const float* wg = l == 0 ? p.moe0_w_group : p.moe1_w_group;
        float part = 0.f;
        for (int k = lane; k < DM; k += 64) { const float w = n < 32 ? we[k * 32 + n] : n < 36 ? wg[k * 4 + (n - 32)] : 0.f; part += md[k] * w; }
        part = wave_sum(part); if (lane == 0) p.rbias[task] = part;
    }
}
template <int MODE, bool OUT8 = false> DI void norm_rows(const Params& p, const float* xin  , const float* gain, int lmod, int lgate, const LAS int* tab) {
    const int tid = opaque_tid(), wave = tid >> 6, lane = tid & 63;
    for (int row = blockIdx.x * 8 + wave; row < T_TOK; row += gridDim.x * 8) {
        const int b = row / SEQ;
        f32x4 v[8];
        if (xin) {
#pragma unroll
            for (int i = 0; i < 8; ++i) v[i] = *(const f32x4*)(xin + (size_t)row * DM + i * 256 + lane * 4);
        } else {
#pragma unroll
            for (int i = 0; i < 8; ++i) { const uint2 a = *(const uint2*)(p.XA + (size_t)row * DM + i * 256 + lane * 4); v[i] = (f32x4){bflo(a.x), bfhi(a.x), bflo(a.y), bfhi(a.y)}; }
        }
        if constexpr (MODE >= 1) {
            const int a0 = p.asg[row * 2], a1 = p.asg[row * 2 + 1];
            const size_t r0 = (size_t)tab[a0 >> 14] * 256 + (a0 & 16383), r1 = (size_t)tab[a1 >> 14] * 256 + (a1 & 16383);
            const float* gt = p.mod + (lgate * 4 + b) * 6144 + 4096;
#pragma unroll
            for (int i = 0; i < 8; ++i) { const int col = i * 256 + lane * 4; const f32x4 g4 = *(const f32x4*)(gt + col);
                if constexpr (YB8) { const unsigned y0 = *(const unsigned*)((const unsigned char*)p.YB + r0 * DM + col), y1 = *(const unsigned*)((const unsigned char*)p.YB + r1 * DM + col);
                    const f32x2 a0 = __builtin_amdgcn_cvt_pk_f32_fp8(y0, false), a1 = __builtin_amdgcn_cvt_pk_f32_fp8(y0, true), b0 = __builtin_amdgcn_cvt_pk_f32_fp8(y1, false), b1 = __builtin_amdgcn_cvt_pk_f32_fp8(y1, true);
                    const f32x4 gq = g4 * (1.f / Y8_SCALE);
                    v[i][0] += gq[0] * (a0[0] + b0[0]); v[i][1] += gq[1] * (a0[1] + b0[1]); v[i][2] += gq[2] * (a1[0] + b1[0]); v[i][3] += gq[3] * (a1[1] + b1[1]); }
                else { const uint2 y0 = *(const uint2*)(p.YB + r0 * DM + col), y1 = *(const uint2*)(p.YB + r1 * DM + col);
                v[i][0] += g4[0] * (bflo(y0.x) + bflo(y1.x)); v[i][1] += g4[1] * (bfhi(y0.x) + bfhi(y1.x));
                v[i][2] += g4[2] * (bflo(y0.y) + bflo(y1.y)); v[i][3] += g4[3] * (bfhi(y0.y) + bfhi(y1.y)); } }
            if constexpr (MODE == 1) {
#pragma unroll
                for (int i = 0; i < 8; ++i) { const uint2 w = make_uint2(pk2(v[i][0], v[i][1]), pk2(v[i][2], v[i][3])); *(uint2*)(p.XA + (size_t)row * DM + i * 256 + lane * 4) = w;
                    v[i] = (f32x4){bflo(w.x), bfhi(w.x), bflo(w.y), bfhi(w.y)}; }
            }
        }
        float ss = 0.f;
#pragma unroll
        for (int i = 0; i < 8; ++i) ss += v[i][0] * v[i][0] + v[i][1] * v[i][1] + v[i][2] * v[i][2] + v[i][3] * v[i][3];
        ss = wave_sum(ss); const float rstd = rsqrtf(ss * (1.0f / DM) + 1e-6f);
        if constexpr (MODE == 2) {
#pragma unroll
            for (int i = 0; i < 8; ++i) { const int col = i * 256 + lane * 4; const f32x4 g4 = *(const f32x4*)(gain + col); *(f32x4*)(p.out + (size_t)row * DM + col) = v[i] * rstd * g4; }
        } else { const float* md = p.mod + (lmod * 4 + b) * 6144;
#pragma unroll
            for (int i = 0; i < 8; ++i) { const int col = i * 256 + lane * 4; const f32x4 g4 = *(const f32x4*)(gain + col), sc = *(const f32x4*)(md + 2048 + col), sh = *(const f32x4*)(md + col);
                const f32x4 h = v[i] * rstd * g4 * (1.f + sc) + sh;
                if constexpr (OUT8) *(unsigned*)((unsigned char*)p.H + (size_t)row * DM + col) = pk4_fp8(h[0], h[1], h[2], h[3], A8_SCALE);
                else *(uint2*)(p.H + (size_t)row * DM + col) = make_uint2(pk2(h[0], h[1]), pk2(h[2], h[3])); } }
    }
}
template <bool DRY = false, bool NORM = false> DI void router(const Params& p, int l, LAS unsigned char* lds, const float* gain = nullptr, int lmod = 0) {
    const int tid = opaque_tid(), wave = __builtin_amdgcn_readfirstlane(tid >> 6), lane = tid & 63;
    LAS float* lg = (LAS float*)lds + (wave & 3) * (16 * 48);
    LAS float* rsl = (LAS float*)lds + 4 * 16 * 48 + (wave & 3) * 16;
    LAS f32x4* part = (LAS f32x4*)(lds + 16384);
    LAS float* ssp = (LAS float*)(lds + 16384 + 98304);
    for (int tg = blockIdx.x; tg < T_TOK / 64; tg += gridDim.x) {
        const int b = (tg * 64) / SEQ, r = lane & 15, q = lane >> 4;
        const bf16_t* xa = p.XA + (size_t)(tg * 64 + r) * DM + wave * 256 + 8 * q;
        const bf16_t* wt = p.wrt + ((size_t)((l * 4 + b) * 3) * 48 + r) * DM + wave * 256 + 8 * q;
        f32x4 acc[4][3]; float ss[4] = {0.f, 0.f, 0.f, 0.f};
#pragma unroll
        for (int t = 0; t < 4; ++t)
#pragma unroll
            for (int n = 0; n < 3; ++n) acc[t][n] = (f32x4){0.f, 0.f, 0.f, 0.f};
        u32x4 aA[4], aB[4], bA[9], bB[9];
        auto ld = [&](int st, u32x4 (&aa)[4], u32x4 (&bb)[9]) {
#pragma unroll
            for (int t = 0; t < 4; ++t) aa[t] = *(const u32x4*)(xa + (size_t)t * 16 * DM + st * 32);
#pragma unroll
            for (int i = 0; i < 9; ++i) bb[i] = *(const u32x4*)(wt + (size_t)i * 16 * DM + st * 32); };
        auto mm = [&](const u32x4 (&aa)[4], const u32x4 (&bb)[9]) {
#pragma unroll
            for (int t = 0; t < 4; ++t) {
#pragma unroll
                for (int e = 0; e < 4; ++e) { const float x0 = bflo(aa[t][e]), x1 = bfhi(aa[t][e]); ss[t] += x0 * x0 + x1 * x1; }
#pragma unroll
                for (int i = 0; i < 9; ++i) acc[t][i % 3] = __builtin_amdgcn_mfma_f32_16x16x32_bf16(__builtin_bit_cast(bf16x8, aa[t]), __builtin_bit_cast(bf16x8, bb[i]), acc[t][i % 3], 0, 0, 0); } };
        ld(0, aA, bA);
        for (int st = 0; st < 8; st += 2) {
            ld(st + 1, aB, bB);
            mm(aA, bA);
            if (st + 2 < 8) ld(st + 2, aA, bA);
            mm(aB, bB);
        }
#pragma unroll
        for (int t = 0; t < 4; ++t) {
#pragma unroll
            for (int n = 0; n < 3; ++n) part[((wave * 4 + t) * 3 + n) * 64 + lane] = acc[t][n];
            float sq = ss[t]; sq += __shfl_xor(sq, 16); sq += __shfl_xor(sq, 32);
            if (q == 0) ssp[(wave * 4 + t) * 16 + r] = sq; }
        __syncthreads();
        if (wave < 4) {
        const int tile = tg * 4 + wave, row0 = tile * 16;
        f32x4 a3[3] = {{0.f, 0.f, 0.f, 0.f}, {0.f, 0.f, 0.f, 0.f}, {0.f, 0.f, 0.f, 0.f}}; float ssr = 0.f;
#pragma unroll
        for (int w2 = 0; w2 < 8; ++w2) {
#pragma unroll
            for (int n = 0; n < 3; ++n) a3[n] += part[((w2 * 4 + wave) * 3 + n) * 64 + lane];
            ssr += ssp[(w2 * 4 + wave) * 16 + r]; }
        const float rstd = rsqrtf(ssr * (1.0f / DM) + 1e-6f);
        if (NORM && q == 0) rsl[r] = rstd;
#pragma unroll
        for (int j = 0; j < 4; ++j) { const float rs = __shfl(rstd, 4 * q + j);
#pragma unroll
            for (int n = 0; n < 3; ++n) lg[(4 * q + j) * 48 + n * 16 + r] = a3[n][j] * rs + p.rbias[(l * 4 + b) * 48 + n * 16 + r]; }
        __builtin_amdgcn_wave_barrier();
        if (!DRY && lane < 16) {
            const LAS float* L = lg + lane * 48; const int tok = row0 + lane;
            int gs = 0; float gm = L[32];
#pragma unroll
            for (int g = 1; g < 4; ++g) if (L[32 + g] > gm) { gm = L[32 + g]; gs = g; }
            float gden = 0.f;
#pragma unroll
            for (int g = 0; g < 4; ++g) gden += __expf(L[32 + g] - gm);
            const float gprob = 1.0f / gden;
            int i0 = 0; float v0 = L[gs * 8];
            for (int j = 1; j < 8; ++j) { const float x = L[gs * 8 + j]; if (x > v0) { v0 = x; i0 = j; } }
            int i1 = -1; float v1 = -3.4e38f;
            for (int j = 0; j < 8; ++j) { const float x = L[gs * 8 + j]; if (j != i0 && x > v1) { v1 = x; i1 = j; } }
            const float e1 = __expf(v1 - v0), g0 = gprob / (1.f + e1), g1 = gprob * e1 / (1.f + e1);
            const int ea = gs * 8 + i0, eb = gs * 8 + i1;
            const int sa = atomicAdd(&p.cnt[l * 32 + ea], 1), sb = atomicAdd(&p.cnt[l * 32 + eb], 1);
            p.tokl[ea * ECAP + sa] = tok; p.gatel[ea * ECAP + sa] = g0; p.tokl[eb * ECAP + sb] = tok; p.gatel[eb * ECAP + sb] = g1;
            p.asg[tok * 2] = (ea << 14) | sa; p.asg[tok * 2 + 1] = (eb << 14) | sb;
        }
        }
        __syncthreads();
        if constexpr (NORM) {
            const int kh = wave >> 2, row0 = (tg * 4 + (wave & 3)) * 16;
            const float* md = p.mod + (lmod * 4 + b) * 6144;
            f32x4 g4[8], sc[8], sh[8];
#pragma unroll
            for (int i = 0; i < 8; ++i) { const int col = i * 256 + lane * 4; g4[i] = *(const f32x4*)(gain + col); sc[i] = 1.f + *(const f32x4*)(md + 2048 + col); sh[i] = *(const f32x4*)(md + col); g4[i] *= sc[i]; }
#pragma unroll 2
            for (int j = 0; j < 8; ++j) { const int row = row0 + kh * 8 + j; const float rs = rsl[kh * 8 + j];
#pragma unroll
                for (int i = 0; i < 8; ++i) { const int col = i * 256 + lane * 4; const uint2 ar = *(const uint2*)(p.XA + (size_t)row * DM + col); const f32x4 v = {bflo(ar.x), bfhi(ar.x), bflo(ar.y), bfhi(ar.y)};
                    const f32x4 h = v * rs * g4[i] + sh[i];
                    *(unsigned*)((unsigned char*)p.H + (size_t)row * DM + col) = pk4_fp8(h[0], h[1], h[2], h[3], A8_SCALE); } }
            __syncthreads();
        }
    }
}
DI void conv_gln(const Params& p, LAS unsigned char* lds) {
    const int tid = opaque_tid(), wave = tid >> 6, lane = tid & 63;
    LAS float* at = (LAS float*)lds;
    u32x4 rv[3], rg[3];
    auto load_raw = [&](int u) { const int g = u & 7, t0 = ((u >> 3) & 63) * 64, b = u >> 9;
#pragma unroll
        for (int i = 0; i < 3; ++i) { const int idx = tid + 512 * i, rr = idx >> 4, c8 = idx & 15, t = t0 - 15 + rr; rv[i] = (u32x4){0u, 0u, 0u, 0u}; rg[i] = (u32x4){0u, 0u, 0u, 0u};
            if (idx < 94 * 16 && t >= 0 && t < SEQ) { const bf16_t* row = p.G + (size_t)(b * SEQ + t) * N_IN0 + g * 128 + c8 * 8; rv[i] = *(const u32x4*)row; rg[i] = *(const u32x4*)(row + 1024); } } };
    int gcur = -1; f32x2 wk[31], bias = {0.f, 0.f}, gam = {0.f, 0.f}, bet = {0.f, 0.f};
    if ((int)blockIdx.x < 2048) load_raw(blockIdx.x);
    for (int u = blockIdx.x; u < 2048; u += gridDim.x) {
        const int g = u & 7, t0 = ((u >> 3) & 63) * 64, b = u >> 9;
        const int ch = g * 128 + 2 * lane;
        if (g != gcur) { gcur = g;
#pragma unroll
            for (int k = 0; k < 31; ++k) wk[k] = *(const f32x2*)(p.conv_w + k * 1024 + ch);
            bias = *(const f32x2*)(p.conv_b + ch); gam = *(const f32x2*)(p.conv_norm_g + ch); bet = *(const f32x2*)(p.conv_norm_b + ch); }
#pragma unroll
        for (int i = 0; i < 3; ++i) { const int idx = tid + 512 * i, rr = idx >> 4, c8 = idx & 15;
            if (idx < 94 * 16) { const u32x4 v = rv[i], gg = rg[i];
                const f32x4 lo = {bflo(v[0]) * sigmoidf_(bflo(gg[0])), bfhi(v[0]) * sigmoidf_(bfhi(gg[0])), bflo(v[1]) * sigmoidf_(bflo(gg[1])), bfhi(v[1]) * sigmoidf_(bfhi(gg[1]))};
                const f32x4 hi = {bflo(v[2]) * sigmoidf_(bflo(gg[2])), bfhi(v[2]) * sigmoidf_(bfhi(gg[2])), bflo(v[3]) * sigmoidf_(bflo(gg[3])), bfhi(v[3]) * sigmoidf_(bfhi(gg[3]))};
                *(LAS f32x4*)(at + rr * 132 + c8 * 8) = lo; *(LAS f32x4*)(at + rr * 132 + c8 * 8 + 4) = hi; } }
        __syncthreads();
        if (u + (int)gridDim.x < 2048) load_raw(u + gridDim.x);
        f32x2 acc[8];
#pragma unroll
        for (int j = 0; j < 8; ++j) acc[j] = bias;
#pragma unroll
        for (int rr = 0; rr < 38; ++rr) { const f32x2 a2 = *(const LAS f32x2*)(at + (wave * 8 + rr) * 132 + 2 * lane);
#pragma unroll
            for (int j = 0; j < 8; ++j) { const int k = rr - j; if (k >= 0 && k < 31) acc[j] += wk[k] * a2; } }
#pragma unroll
        for (int j = 0; j < 8; ++j) { const float mu = wave_sum(acc[j][0] + acc[j][1]) * (1.f / 128.f); const float d0 = acc[j][0] - mu, d1 = acc[j][1] - mu;
            const float var = wave_sum(d0 * d0 + d1 * d1) * (1.f / 128.f); const float rs = rsqrtf(var + 1e-6f);
            const float y0 = d0 * rs * gam[0] + bet[0], y1 = d1 * rs * gam[1] + bet[1];
            if constexpr (D8_OUT0) *(unsigned short*)((unsigned char*)p.AO + (size_t)(b * SEQ + t0 + wave * 8 + j) * DM + ch) = (unsigned short)(pk4_fp8(siluf_(y0), siluf_(y1), 0.f, 0.f, A8_SCALE) & 0xffffu);
            else *(unsigned*)(p.AO + (size_t)(b * SEQ + t0 + wave * 8 + j) * DM + ch) = pk2(siluf_(y0), siluf_(y1)); }
        __syncthreads();
    }
}
DI unsigned off_b(unsigned row, unsigned ch) { return 256u * row + 16u * (ch ^ (((row & 3u) << 2) | ((row >> 2) & 3u))); }
DI void tr_read4(unsigned a0, unsigned a1, s16x4& r00, s16x4& r01, s16x4& r10, s16x4& r11) {
    asm volatile("ds_read_b64_tr_b16 %0, %4\n\tds_read_b64_tr_b16 %1, %5\n\tds_read_b64_tr_b16 %2, %4 offset:4096\n\tds_read_b64_tr_b16 %3, %5 offset:4096\n\ts_waitcnt lgkmcnt(0)"
                 : "=&v"(r00), "=&v"(r01), "=&v"(r10), "=&v"(r11) : "v"(a0), "v"(a1) : "memory");
}
template <int PASS> DI void attn_wave(const Params& p, LAS unsigned char* vimg, unsigned vb0, unsigned vb1, int lane_, int b, int h, int qbase  ) {
    int lane = lane_; asm volatile("" : "+v"(lane));
    const int c = lane & 31, hh = lane >> 5, srow = lane >> 4, sch = lane & 15;
    constexpr int QS = PASS == 0 ? 16 : 1, NT = PASS == 0 ? 13 : 5;
    const int tq = qbase + QS * c;
    const bf16_t* gb = p.G + (size_t)(b * SEQ) * N_IN0; const bf16_t* kb = p.KVH + (size_t)((b * 8 + h) * 2) * SEQ * 128;
    bf16_t* st_o = p.YB + ((size_t)(b * 8 + h) * SEQ + tq) * 128;
    float* st_ml = (float*)(p.YB + (size_t)NBATCH * 8 * SEQ * 128) + ((size_t)(b * 8 + h) * SEQ + tq) * 2;
    bf16x8 qf[8];
#pragma unroll
    for (int ks = 0; ks < 8; ++ks) qf[ks] = *(const bf16x8*)(gb + (size_t)tq * N_IN0 + 2048 + h * 128 + 16 * ks + 8 * hh);
    const float sc2 = 0.08838834764831845f * 1.4426950408889634f, sl2 = exp2f(-(float)(h + 1)) * 1.4426950408889634f;
    f32x16 o[4]; float m_run, l_run;
    if constexpr (PASS == 0) {
#pragma unroll
        for (int i = 0; i < 4; ++i)
#pragma unroll
            for (int j = 0; j < 16; ++j) o[i][j] = 0.f;
        m_run = -30000.f; l_run = 0.f;
    } else {
#pragma unroll
        for (int c4 = 0; c4 < 4; ++c4)
#pragma unroll
            for (int g4 = 0; g4 < 4; ++g4) { const uint2 v = *(const uint2*)(st_o + 32 * c4 + 8 * g4 + 4 * hh); o[c4][4 * g4] = bflo(v.x); o[c4][4 * g4 + 1] = bfhi(v.x); o[c4][4 * g4 + 2] = bflo(v.y); o[c4][4 * g4 + 3] = bfhi(v.y); }
        const f32x2 ml = *(const f32x2*)st_ml; m_run = ml[0]; l_run = hh == 0 ? ml[1] : 0.f;
    }
    auto tile_geom = [&](int tile, int& d, int& sb) { if constexpr (PASS == 0) { if (tile < 5) { d = 16; sb = qbase - 1024 + 512 * tile; } else { d = 4; sb = qbase - 256 + 128 * (tile - 5); } } else { d = 1; sb = qbase - 64 + 32 * tile; } };
    auto load_k = [&](int tile, bf16x8 (&kf)[8]) { int d, sb; tile_geom(tile, d, sb); int sp = sb + d * c; sp = sp < 0 ? 0 : (sp >= SEQ ? SEQ - 1 : sp);
        const bf16_t* src = kb + (unsigned)(sp * 128 + 8 * hh);
#pragma unroll
        for (int ks = 0; ks < 8; ++ks) kf[ks] = *(const bf16x8*)(src + 16 * ks); };
    auto load_v = [&](int tile, u32x4 (&vv)[8]) { int d, sb; tile_geom(tile, d, sb);
#pragma unroll
        for (int i = 0; i < 8; ++i) { int sp = sb + d * (srow + 4 * i); sp = sp < 0 ? 0 : (sp >= SEQ ? SEQ - 1 : sp); vv[i] = *(const u32x4*)(kb + (unsigned)(SEQ * 128 + sp * 128 + sch * 8)); } };
    bf16x8 kf[8]; u32x4 vv[8];
    load_k(0, kf); load_v(0, vv);
    for (int tile = 0; tile < NT; ++tile) {
        int d, sb; tile_geom(tile, d, sb);
        const int tn = tile < NT - 1 ? tile + 1 : NT - 1;
#pragma unroll
        for (int i = 0; i < 8; ++i) *(LAS u32x4*)(vimg + off_b(srow + 4 * i, sch)) = vv[i];
        load_v(tn, vv);
        f32x16 sacc;
#pragma unroll
        for (int j = 0; j < 16; ++j) sacc[j] = 0.f;
#pragma unroll
        for (int ks = 0; ks < 8; ++ks) sacc = __builtin_amdgcn_mfma_f32_32x32x16_bf16(kf[ks], qf[ks], sacc, 0, 0, 0);
        load_k(tn, kf);
        const float df = (float)d, basef = (float)(sb - tq) + df * (float)(4 * hh);
        const float lo = fmaxf(-64.f * df, -(float)tq), hi = fminf(64.f * df, (float)(SEQ - 1 - tq));
        const float mid = 0.5f * (lo + hi), half = 0.5f * (hi - lo);
        float tmax = -1e30f;
#pragma unroll
        for (int i = 0; i < 16; ++i) { const float deltaf = basef + df * (float)((i & 3) + 8 * (i >> 2));
            const bool valid = __builtin_fabsf(deltaf - mid) <= half;
            const float sv = valid ? sacc[i] * sc2 - sl2 * __builtin_fabsf(deltaf) : -1e30f; sacc[i] = sv; tmax = fmaxf(tmax, sv); }
        tmax = fmaxf(tmax, __shfl_xor(tmax, 32));
        const float m_new = tmax > m_run + 8.0f ? tmax : m_run;
        if (__any(m_new != m_run)) { const float alpha = __builtin_amdgcn_exp2f(m_run - m_new);
            l_run *= alpha;
#pragma unroll
            for (int i = 0; i < 4; ++i) o[i] *= alpha; }
        m_run = m_new;
        float psum = 0.f;
#pragma unroll
        for (int i = 0; i < 16; ++i) { const float pi = __builtin_amdgcn_exp2f(sacc[i] - m_new); psum += pi; sacc[i] = pi; }
        l_run += psum;
        bf16x8 pf[2];
#pragma unroll
        for (int s = 0; s < 2; ++s) { const unsigned w0 = pk2(sacc[8 * s], sacc[8 * s + 1]), w1 = pk2(sacc[8 * s + 2], sacc[8 * s + 3]), w2 = pk2(sacc[8 * s + 4], sacc[8 * s + 5]), w3 = pk2(sacc[8 * s + 6], sacc[8 * s + 7]);
            pf[s] = __builtin_bit_cast(bf16x8, (u32x4){w0, w1, w2, w3}); }
#pragma unroll
        for (int c4 = 0; c4 < 4; ++c4) {
            s16x4 r00, r01, r10, r11; tr_read4(vb0 ^ (unsigned)(c4 << 6), vb1 ^ (unsigned)(c4 << 6), r00, r01, r10, r11);
            const bf16x8 v0 = __builtin_shufflevector(r00, r01, 0, 1, 2, 3, 4, 5, 6, 7), v1 = __builtin_shufflevector(r10, r11, 0, 1, 2, 3, 4, 5, 6, 7);
            o[c4] = __builtin_amdgcn_mfma_f32_32x32x16_bf16(v0, pf[0], o[c4], 0, 0, 0);
            o[c4] = __builtin_amdgcn_mfma_f32_32x32x16_bf16(v1, pf[1], o[c4], 0, 0, 0); }
    }
    const float ltot = l_run + __shfl_xor(l_run, 32);
    if constexpr (PASS == 0) {
#pragma unroll
        for (int c4 = 0; c4 < 4; ++c4)
#pragma unroll
            for (int g4 = 0; g4 < 4; ++g4) *(uint2*)(st_o + 32 * c4 + 8 * g4 + 4 * hh) = make_uint2(pk2(o[c4][4 * g4], o[c4][4 * g4 + 1]), pk2(o[c4][4 * g4 + 2], o[c4][4 * g4 + 3]));
        if (hh == 0) *(f32x2*)st_ml = (f32x2){m_run, ltot};
    } else {
        const float inv = 1.0f / ltot;
        bf16_t* orow = p.AO + (size_t)(b * SEQ + tq) * DM + 1024 + h * 128;
#pragma unroll
        for (int c4 = 0; c4 < 4; ++c4)
#pragma unroll
            for (int g4 = 0; g4 < 4; ++g4) { const int dh = 32 * c4 + 8 * g4 + 4 * hh;
                if constexpr (D8_OUT0) *(unsigned*)((unsigned char*)p.AO + (size_t)(b * SEQ + tq) * DM + 1024 + h * 128 + dh) = pk4_fp8(o[c4][4 * g4] * inv, o[c4][4 * g4 + 1] * inv, o[c4][4 * g4 + 2] * inv, o[c4][4 * g4 + 3] * inv, A8_SCALE);
                else *(uint2*)(orow + dh) = make_uint2(pk2(o[c4][4 * g4] * inv, o[c4][4 * g4 + 1] * inv), pk2(o[c4][4 * g4 + 2] * inv, o[c4][4 * g4 + 3] * inv)); }
    }
}
DI void attention(const Params& p, LAS unsigned char* lds) {
    const int tid = opaque_tid(), wave = __builtin_amdgcn_readfirstlane(tid >> 6), lane = tid & 63, hh = lane >> 5;
    LAS unsigned char* vimg = lds + wave * 8192;
    const unsigned vbase = (unsigned)(uintptr_t)vimg;
    const int q4 = (lane & 15) >> 2, pp = lane & 3, blk = (lane >> 4) & 1;
    const unsigned vb0 = vbase + 256u * (4 * hh + q4) + 16u * ((2 * blk + (pp >> 1)) ^ (hh & 3)) + 8u * (pp & 1) + ((unsigned)q4 << 6);
    const unsigned vb1 = vbase + 256u * (8 + 4 * hh + q4) + 16u * ((2 * blk + (pp >> 1)) ^ ((2 + hh) & 3)) + 8u * (pp & 1) + ((unsigned)q4 << 6);
    for (int u = blockIdx.x; u < 256; u += gridDim.x) {
        const int bh = (u & 7) * 4 + ((u >> 3) >> 3), span = (u >> 3) & 7, h = bh & 7, b = bh >> 3;
#pragma unroll 1
        for (int j = 0; j < 2; ++j) attn_wave<0>(p, vimg, vb0, vb1, lane, b, h, span * 512 + wave * 2 + j);
        asm volatile("s_waitcnt vmcnt(0)" ::: "memory");
        __syncthreads();
#pragma unroll 1
        for (int j = 0; j < 2; ++j) attn_wave<1>(p, vimg, vb0, vb1, lane, b, h, span * 512 + (wave * 2 + j) * 32);
        __syncthreads();
    }
}
DI float om_exp2x(float la, float a) {
    const float x = 2.f * la;
    const float pl = x * (1.f + x * (0.5f + x * (0.16666667f + x * (0.041666668f + x * 0.008333334f))));
    return x > -0.25f ? -pl : 1.f - a * a;
}
DI void lru_conv(const Params& p) {
    const int tid = opaque_tid();
    if (tid < 336) {
        const int ch = tid * 8;
        float cw[4][8], cb[8];
#pragma unroll
        for (int j = 0; j < 4; ++j) { const f32x4 w0 = *(const f32x4*)(p.lru_conv_w + j * LRU_W + ch), w1 = *(const f32x4*)(p.lru_conv_w + j * LRU_W + ch + 4);
            cw[j][0] = w0[0]; cw[j][1] = w0[1]; cw[j][2] = w0[2]; cw[j][3] = w0[3]; cw[j][4] = w1[0]; cw[j][5] = w1[1]; cw[j][6] = w1[2]; cw[j][7] = w1[3]; }
        { const f32x4 b0 = *(const f32x4*)(p.lru_conv_b + ch), b1 = *(const f32x4*)(p.lru_conv_b + ch + 4); cb[0] = b0[0]; cb[1] = b0[1]; cb[2] = b0[2]; cb[3] = b0[3]; cb[4] = b1[0]; cb[5] = b1[1]; cb[6] = b1[2]; cb[7] = b1[3]; }
        for (int run = blockIdx.x; run < T_TOK / 32; run += gridDim.x) {
            const int tok0 = run * 32, t0 = tok0 % SEQ;
            const bf16_t* src = p.G + (size_t)tok0 * N_IN1 + LRU_W + ch;
            u32x4 rows[35];
#pragma unroll
            for (int i = 0; i < 35; ++i) { const int t = t0 - 2 + i; rows[i] = (t >= 0 && t < SEQ) ? *(const u32x4*)(src + (ptrdiff_t)(i - 2) * N_IN1) : (u32x4){0u, 0u, 0u, 0u}; }
#pragma unroll
            for (int i = 0; i < 32; ++i) { float xc[8];
#pragma unroll
                for (int e = 0; e < 8; ++e) xc[e] = cb[e];
#pragma unroll
                for (int j = 0; j < 4; ++j) { const u32x4 xv = rows[i + j];
                    xc[0] += cw[j][0] * bflo(xv[0]); xc[1] += cw[j][1] * bfhi(xv[0]); xc[2] += cw[j][2] * bflo(xv[1]); xc[3] += cw[j][3] * bfhi(xv[1]);
                    xc[4] += cw[j][4] * bflo(xv[2]); xc[5] += cw[j][5] * bfhi(xv[2]); xc[6] += cw[j][6] * bflo(xv[3]); xc[7] += cw[j][7] * bfhi(xv[3]); }
                *(u32x4*)(p.XC + (size_t)(tok0 + i) * LRU_W + ch) = (u32x4){pk2(xc[0], xc[1]), pk2(xc[2], xc[3]), pk2(xc[4], xc[5]), pk2(xc[6], xc[7])}; }
        }
    }
}
DI void lru(const Params& p, LAS unsigned char* lds) {
    const int tid = opaque_tid(), wave = __builtin_amdgcn_readfirstlane(tid >> 6), lane = tid & 63, col = lane & 15, g = lane >> 4;
    LAS unsigned char* wl = lds;
    LAS unsigned char* xs = lds + 36864;
    LAS float* sums = (LAS float*)(lds + 36864 + 86016);
    LAS float* cst = sums + 1920;
    for (int u = blockIdx.x; u < 256; u += gridDim.x) {
        const int b = u >> 6, n = (u >> 2) & 15, qt = u & 3, chq = n * LRU_BW + qt * 42;
        const char* xcb = (const char*)(p.XC + (size_t)(b * SEQ) * LRU_W + n * LRU_BW);
        const bf16_t* gb = p.G + (size_t)(b * SEQ) * N_IN1;
        unsigned poff[6];
#pragma unroll
        for (int i = 0; i < 6; ++i) { const int idx = tid + 512 * i; poff[i] = (unsigned)((idx / 21) * LRU_W + (idx % 21) * 8) * 2u; }
        auto dma_chunk = [&](int chunk, int bsel) { const char* src = xcb + (size_t)chunk * 128 * LRU_W * 2; LAS unsigned char* dst = xs + bsel * 43008 + wave * 1024;
#pragma unroll
            for (int i = 0; i < 5; ++i) __builtin_amdgcn_global_load_lds((const unsigned*)(src + poff[i]), (LAS unsigned*)(dst + i * 8192), 16, 0, 0);
            if (wave < 2) __builtin_amdgcn_global_load_lds((const unsigned*)(src + poff[5]), (LAS unsigned*)(dst + 5 * 8192), 16, 0, 0); };
        for (int dir = 0; dir < 2; ++dir) {
            __syncthreads();
            for (int i = tid; i < 2 * 48 * 24; i += 512) { const int which = i / (48 * 24), r = (i / 24) % 48, ck = i % 24; const int nt = r >> 4, cl = r & 15, ks = ck >> 2, gg = ck & 3;
                *(LAS u32x4*)(wl + ((which * 3 + nt) * 6 + ks) * 1024 + (gg * 16 + cl) * 16) = *(const u32x4*)(p.w_lru + ((((size_t)(dir * 2 + which) * 16 + n) * 4 + qt) * 48 + r) * 192 + ck * 8); }
            if (tid < 48) { const bool valid = tid < 42; const int ch = dir * LRU_W + chq + tid;
                cst[tid] = valid ? -1.44269504f * p.lru_b_a[ch] : 0.f; cst[48 + tid] = valid ? -1.44269504f * p.lru_b_x[ch] : 0.f;
                const float lam = valid ? p.lru_lambda[ch] : 0.f; const float sp = (-lam > 20.f) ? -lam : log1pf(__expf(-lam)); cst[96 + tid] = -8.0f * 1.44269504f * sp; }
            dma_chunk(dir == 0 ? 0 : 31, 0);
            asm volatile("s_waitcnt vmcnt(0)" ::: "memory");
            __syncthreads();
            float cba[3], cbx[3], cex[3];
#pragma unroll
            for (int nt = 0; nt < 3; ++nt) { cba[nt] = cst[nt * 16 + col]; cbx[nt] = cst[48 + nt * 16 + col]; cex[nt] = cst[96 + nt * 16 + col]; }
            bf16x8 breg[3][6];
#pragma unroll
            for (int nt = 0; nt < 3; ++nt)
#pragma unroll
                for (int ks = 0; ks < 6; ++ks) { breg[nt][ks] = *(const LAS bf16x8*)(wl + (nt * 6 + ks) * 1024 + lane * 16); asm volatile("" : "+v"(breg[nt][ks])); }
            const int wpos = dir == 0 ? wave : 7 - wave;
            float carry[3] = {0.f, 0.f, 0.f};
            for (int step = 0; step < 32; ++step) {
                const int c = dir == 0 ? step : 31 - step, c0 = c * 128, par = step & 1;
                const bool has_next = step < 31;
                if (has_next) dma_chunk(dir == 0 ? c + 1 : c - 1, par ^ 1);
                LAS unsigned char* xb = xs + par * 43008;
                uint2 hfv[3] = {make_uint2(0u, 0u), make_uint2(0u, 0u), make_uint2(0u, 0u)}; unsigned short gtv[3][4];
                const uint2* hfp = (const uint2*)p.HF + ((size_t)((u * 32 + c) * 8 + wave) * 3) * 64 + lane;
                const bf16_t* gbw = gb + (size_t)(c0 + wave * 16) * N_IN1 + chq;
                bf16_t* aow = p.AO + (size_t)(b * SEQ + c0 + wave * 16) * LRU_W + chq;
                if (dir == 1) {
#pragma unroll
                    for (int nt = 0; nt < 3; ++nt) { hfv[nt] = hfp[nt * 64];
#pragma unroll
                        for (int r = 0; r < 4; ++r) gtv[nt][r] = (nt * 16 + col < 42) ? gbw[(unsigned)((4 * g + r) * N_IN1 + nt * 16 + col)] : (unsigned short)0; } }
                bf16x8 af[6];
#pragma unroll
                for (int ks = 0; ks < 6; ++ks) { const int ch0 = 32 * ks + 8 * g; const bool kval = ch0 < LRU_BW; const int chl0 = kval ? ch0 : 160;
                    const u32x4 xv = *(const LAS u32x4*)(xb + (wave * 16 + col) * 336 + chl0 * 2);
                    af[ks] = __builtin_bit_cast(bf16x8, kval ? xv : (u32x4){0u, 0u, 0u, 0u}); }
                f32x4 acc[2][3];
                {
                    bf16x8 bl[6];
                    const LAS unsigned char* wl1 = wl + 18 * 1024 + lane * 16;
#pragma unroll
                    for (int ks = 0; ks < 6; ++ks) bl[ks] = *(const LAS bf16x8*)(wl1 + ks * 1024);
#pragma unroll
                    for (int nt = 0; nt < 3; ++nt) {
                        acc[0][nt] = (f32x4){0.f, 0.f, 0.f, 0.f}; acc[1][nt] = (f32x4){0.f, 0.f, 0.f, 0.f};
#pragma unroll
                        for (int ks = 0; ks < 6; ++ks) acc[0][nt] = __builtin_amdgcn_mfma_f32_16x16x32_bf16(af[ks], breg[nt][ks], acc[0][nt], 0, 0, 0);
#pragma unroll
                        for (int ks = 0; ks < 6; ++ks) { acc[1][nt] = __builtin_amdgcn_mfma_f32_16x16x32_bf16(af[ks], bl[ks], acc[1][nt], 0, 0, 0);
                            if (nt < 2) bl[ks] = *(const LAS bf16x8*)(wl1 + ((nt + 1) * 6 + ks) * 1024); }
                    }
                }
                float hl[3][4], Pl[3][4];
#pragma unroll
                for (int nt = 0; nt < 3; ++nt) { const int chl = nt * 16 + col;
                    float av[4], uv[4];
#pragma unroll
                    for (int r = 0; r < 4; ++r) {
                        const float rg = __builtin_amdgcn_rcpf(1.0f + __builtin_amdgcn_exp2f(__builtin_fmaf(acc[0][nt][r], -1.44269504f, cba[nt])));
                        const float ig = __builtin_amdgcn_rcpf(1.0f + __builtin_amdgcn_exp2f(__builtin_fmaf(acc[1][nt][r], -1.44269504f, cbx[nt])));
                        const float a = __builtin_amdgcn_exp2f(cex[nt] * rg);
                        const float xcv = bf2f(*(const LAS bf16_t*)(xb + (wave * 16 + 4 * g + r) * 336 + (qt * 42 + chl) * 2));
                        av[r] = a; uv[r] = __builtin_amdgcn_sqrtf(__builtin_fmaf(-a, a, 1.0f)) * (ig * xcv); }
                    float h[4], P[4], A, H;
                    if (dir == 0) { h[0] = uv[0]; P[0] = av[0];
#pragma unroll
                        for (int r = 1; r < 4; ++r) { h[r] = av[r] * h[r - 1] + uv[r]; P[r] = av[r] * P[r - 1]; }
                        A = P[3]; H = h[3];
                        { const float A1 = __shfl_up(A, 16), H1 = __shfl_up(H, 16); if (g >= 1) { H = A * H1 + H; A = A * A1; } }
                        { const float A2 = __shfl_up(A, 32), H2 = __shfl_up(H, 32); if (g >= 2) { H = A * H2 + H; A = A * A2; } }
                        float Ae = __shfl_up(A, 16), He = __shfl_up(H, 16); if (g == 0) { Ae = 1.f; He = 0.f; }
#pragma unroll
                        for (int r = 0; r < 4; ++r) { hl[nt][r] = h[r] + P[r] * He; Pl[nt][r] = P[r] * Ae; }
                        if (g == 3) *(LAS f32x2*)(sums + (par * 48 + chl) * 20 + wpos * 2) = (f32x2){A, H};
                    } else { h[3] = uv[3]; P[3] = av[3];
#pragma unroll
                        for (int r = 2; r >= 0; --r) { h[r] = av[r] * h[r + 1] + uv[r]; P[r] = av[r] * P[r + 1]; }
                        A = P[0]; H = h[0];
                        { const float A1 = __shfl_down(A, 16), H1 = __shfl_down(H, 16); if (g <= 2) { H = A * H1 + H; A = A * A1; } }
                        { const float A2 = __shfl_down(A, 32), H2 = __shfl_down(H, 32); if (g <= 1) { H = A * H2 + H; A = A * A2; } }
                        float Ae = __shfl_down(A, 16), He = __shfl_down(H, 16); if (g == 3) { Ae = 1.f; He = 0.f; }
#pragma unroll
                        for (int r = 0; r < 4; ++r) { hl[nt][r] = h[r] + P[r] * He; Pl[nt][r] = P[r] * Ae; }
                        if (g == 0) *(LAS f32x2*)(sums + (par * 48 + chl) * 20 + wpos * 2) = (f32x2){A, H};
                    }
                }
                asm volatile("s_waitcnt vmcnt(0)" ::: "memory");
                __syncthreads();
                f32x4 sv[3][4];
#pragma unroll
                for (int nt = 0; nt < 3; ++nt)
#pragma unroll
                    for (int j = 0; j < 4; ++j) sv[nt][j] = *(const LAS f32x4*)(sums + (par * 48 + nt * 16 + col) * 20 + j * 4);
#pragma unroll
                for (int nt = 0; nt < 3; ++nt) { const int chl = nt * 16 + col; float C = carry[nt], Cw = 0.f;
#pragma unroll
                    for (int k = 0; k < 8; ++k) { if (k == wpos) Cw = C; C = sv[nt][k >> 1][(k & 1) * 2] * C + sv[nt][k >> 1][(k & 1) * 2 + 1]; }
                    carry[nt] = C;
                    float hv[4];
#pragma unroll
                    for (int r = 0; r < 4; ++r) hv[r] = hl[nt][r] + Pl[nt][r] * Cw;
                    if (dir == 0) ((uint2*)p.HF)[((size_t)((u * 32 + c) * 8 + wave) * 3 + nt) * 64 + lane] = make_uint2(pk2(hv[0], hv[1]), pk2(hv[2], hv[3]));
                    else if (chl < 42) { const float ff[4] = {bflo(hfv[nt].x), bfhi(hfv[nt].x), bflo(hfv[nt].y), bfhi(hfv[nt].y)};
#pragma unroll
                        for (int r = 0; r < 4; ++r) aow[(unsigned)((4 * g + r) * LRU_W + chl)] = f2bf(bf2f(gtv[nt][r]) * (ff[r] + hv[r])); }
                }
            }
        }
    }
}
}

#define XB_TMO      128
#define XB_XCNT(j)  (256  + 64 * (j))
#define XB_XSUB(j)  (1280 + 64 * (j))
#define XB_XGEN(j)  (2304 + 64 * (j))
#define XB_TOP      3328
#define XB_TOPGEN   3392
#define XCD_BAR_WORDS 3456
#define XB_SPIN_CAP (1u << 18)

__device__ __forceinline__ unsigned xb_ld(unsigned* p)              { return __hip_atomic_load(p, __ATOMIC_RELAXED, __HIP_MEMORY_SCOPE_AGENT); }
__device__ __forceinline__ unsigned xb_add(unsigned* p, unsigned v) { return __hip_atomic_fetch_add(p, v, __ATOMIC_RELAXED, __HIP_MEMORY_SCOPE_AGENT); }
__device__ __forceinline__ unsigned xb_xcc_id() { return (unsigned)__builtin_amdgcn_s_getreg((3 << 11) | 20) & 0xFu; }
#define XB_SPIN(cond, bar) do { unsigned _sp = 0; while (cond) { __builtin_amdgcn_s_sleep(1); \
    if ((++_sp & 255u) == 0u) { if (xb_ld(&(bar)[XB_TMO])) break; if (_sp > XB_SPIN_CAP) { atomicAdd(&(bar)[XB_TMO], 1u); break; } } } } while (0)

struct XcdBarrier {
    unsigned* bar; unsigned x;
    volatile LAS unsigned* st;
};

__device__ __forceinline__ XcdBarrier xcd_barrier_post(unsigned* bar, volatile LAS unsigned* st) {
    XcdBarrier b; b.bar = bar; b.x = xb_xcc_id(); b.st = st;
    if (threadIdx.x == 0) (void)xb_add(&bar[XB_XCNT(b.x)], 1u);
    return b;
}
__device__ __forceinline__ void xcd_barrier_complete(unsigned* bar, unsigned x, unsigned& nloc, unsigned& nx) {
    const unsigned G = gridDim.x * gridDim.y * gridDim.z;
    unsigned sum, cnt, mine, sp = 0u;
    for (;;) {
        sum = 0u; cnt = 0u; mine = 0u;
#pragma unroll
        for (unsigned j = 0; j < 16; ++j) { const unsigned c = xb_ld(&bar[XB_XCNT(j)]); sum += c; cnt += (c > 0u) ? 1u : 0u; mine = (j == x) ? c : mine; }
        if (sum == G) break;
        __builtin_amdgcn_s_sleep(1);
        if ((++sp & 255u) == 0u) { if (xb_ld(&bar[XB_TMO])) break; if (sp > XB_SPIN_CAP) { atomicAdd(&bar[XB_TMO], 1u); break; } }
    }
    nloc = mine > 0u ? mine : 1u; nx = cnt > 0u ? cnt : 1u;
}

__device__ __forceinline__ void xcd_barrier(const XcdBarrier& b) {
    asm volatile("s_waitcnt vmcnt(0)" ::: "memory");
    __syncthreads();
    if (threadIdx.x == 0) {
        unsigned* bar = b.bar;
        __builtin_amdgcn_s_waitcnt(0);
        unsigned nloc = b.st[0], nx = b.st[1];
        if (nloc == 0u) { xcd_barrier_complete(bar, b.x, nloc, nx); b.st[0] = nloc; b.st[1] = nx; }
        const unsigned old = xb_add(&bar[XB_XSUB(b.x)], 1u);
        const unsigned gen = old / nloc;
        if (old + 1u == (gen + 1u) * nloc) {
            __builtin_amdgcn_fence(__ATOMIC_RELEASE, "agent");
            asm volatile("s_waitcnt vmcnt(0)" ::: "memory");
            const unsigned og = xb_add(&bar[XB_TOP], 1u);
            const unsigned tg = og / nx;
            if (og + 1u == (tg + 1u) * nx) xb_add(&bar[XB_TOPGEN], 1u);
            else XB_SPIN(xb_ld(&bar[XB_TOPGEN]) == tg, bar);
            __builtin_amdgcn_fence(__ATOMIC_ACQUIRE, "agent");
            xb_add(&bar[XB_XGEN(b.x)], 1u);
            asm volatile("s_waitcnt vmcnt(0)" ::: "memory");
        } else {
            XB_SPIN(xb_ld(&bar[XB_XGEN(b.x)]) == gen, bar);
            __builtin_amdgcn_fence(__ATOMIC_ACQUIRE, "agent");
            asm volatile("s_waitcnt vmcnt(0)" ::: "memory");
        }
    }
    __syncthreads();
}


constexpr int PROBE = 0;
constexpr int LDS_XB_OFF = gm::STAGE_BYTES + 1024;
constexpr int LDS_TOTAL = LDS_XB_OFF + 16;
__global__ void __launch_bounds__(512, 2) mega(Params p) {
    LAS unsigned char* lds = (LAS unsigned char*)dyn_smem;
    LAS int* tab = (LAS int*)(lds + gm::TAB_OFF);
    volatile LAS unsigned* xbw = (volatile LAS unsigned*)(lds + LDS_XB_OFF);
    if (threadIdx.x == 0) { xbw[0] = 0u; xbw[1] = 0u; xbw[2] = 0u; xbw[3] = 0u; }
    __syncthreads();
    XcdBarrier bar = xcd_barrier_post(p.bar, xbw);
    ph::mods(p, lds);
    if constexpr (PROBE == 14) { ph::mods(p, lds); ph::mods(p, lds); }
    xcd_barrier(bar);
    { const int c = blockIdx.x, G = gridDim.x;
      ph::transposer(p, lds, c, c < 320 ? (320 - c + G - 1) / G : 0, G); __syncthreads();
      ph::transposer(p, lds, 320 + c, c < 632 ? (632 - c + G - 1) / G : 0, G); __syncthreads(); }
    ph::lru_weights(p);
    ph::fold_router(p);
    ph::norm_rows<0, D8_IN0>(p, p.x, p.norm0_mix, 0, 0, nullptr);
    xcd_barrier(bar);
    { const int c = blockIdx.x, G = gridDim.x; const int tcount = c < 6144 ? (6144 - c + G - 1) / G : 0; const bool t_first = ((c >> 3) & 1) != 0;
      if (t_first) { ph::transposer(p, lds, 952 + c, tcount, G); __syncthreads(); }
      { gm::DenseSched S; S.init(T_TOK, N_IN0); EpiIn0 e; e.xin = nullptr; e.lgate = 0; if constexpr (D8_IN0) gm::gemm_phase<EpiIn0, gm::DenseSched, true>(lds, p, p.H, p.w_in0t, 0, DM / 2, S, e, W8_E8M0, A8_E8M0); else gm::gemm_phase(lds, p, p.H, p.w_in0t, 0, DM, S, e); }
      if (!t_first) { __syncthreads(); ph::transposer(p, lds, 952 + c, tcount, G); }
      if constexpr (PROBE == 21) { __syncthreads(); ph::transposer(p, lds, 952 + c, tcount, G); }
      if constexpr (PROBE == 24) { __syncthreads(); if (t_first) ph::transposer(p, lds, 952 + c, tcount, G); }
      if constexpr (PROBE == 23) { __syncthreads(); if (t_first) { ph::transposer(p, lds, 952 + c, tcount, G); __syncthreads(); }
        { gm::DenseSched S; S.init(T_TOK, N_IN0); EpiIn0 e; e.xin = nullptr; e.lgate = 0; gm::gemm_phase<EpiIn0, gm::DenseSched, true>(lds, p, p.H, p.w_in0t, 0, DM / 2, S, e, W8_E8M0, A8_E8M0); }
        if (!t_first) { __syncthreads(); ph::transposer(p, lds, 952 + c, tcount, G); } }
      if constexpr (PROBE == 20) { __syncthreads(); gm::DenseSched S; S.init(T_TOK, N_IN0); EpiIn0 e; e.xin = nullptr; e.lgate = 0; gm::gemm_phase<EpiIn0, gm::DenseSched, true>(lds, p, p.H, p.w_in0t, 0, DM / 2, S, e, W8_E8M0, A8_E8M0); } }
    xcd_barrier(bar);
    ph::attention(p, lds);
    if constexpr (PROBE == 4) ph::attention(p, lds);
    __syncthreads();
    ph::conv_gln(p, lds);
    if constexpr (PROBE == 5) ph::conv_gln(p, lds);
    xcd_barrier(bar);
    { gm::DenseSched S; S.init(T_TOK, DM); EpiOut e; e.xin = p.x; e.lgate = 0; if constexpr (D8_OUT0) gm::gemm_phase<EpiOut, gm::DenseSched, true>(lds, p, p.AO, p.w_out0t, 0, DM / 2, S, e, W8_E8M0, A8_E8M0); else gm::gemm_phase(lds, p, p.AO, p.w_out0t, 0, DM, S, e); }
    xcd_barrier(bar);
    ph::router<false, true>(p, 0, lds, p.norm0_ffn, 1);
    if constexpr (PROBE == 12) { ph::router<true>(p, 0, lds); ph::router<true>(p, 0, lds); }
    xcd_barrier(bar);
    if constexpr (PROBE == 11) { xcd_barrier(bar); xcd_barrier(bar); xcd_barrier(bar); xcd_barrier(bar); xcd_barrier(bar); xcd_barrier(bar); xcd_barrier(bar); xcd_barrier(bar); xcd_barrier(bar); xcd_barrier(bar); }
    gm::moe_tables(tab, p.cnt);
    { gm::MoeSched<true> S; S.init(tab); EpiGU e; e.xin = nullptr; e.lgate = 0; gm::gemm_phase<EpiGU, gm::MoeSched<true>, true>(lds, p, p.H, p.w_gut0, (size_t)2048 * (DM / 2), DM / 2, S, e, W8_E8M0, A8_E8M0); if constexpr (PROBE == 3) gm::gemm_phase<EpiGU, gm::MoeSched<true>, true>(lds, p, p.H, p.w_gut0, (size_t)2048 * (DM / 2), DM / 2, S, e, W8_E8M0, A8_E8M0); }
    xcd_barrier(bar);
    { gm::MoeSched<false> S; S.init(tab); EpiDown e; e.xin = nullptr; e.lgate = 0; gm::gemm_phase<EpiDown, gm::MoeSched<false>, true>(lds, p, p.ACT, p.w_dt0, (size_t)DM * (EFF / 2), EFF / 2, S, e, W8_E8M0, A8_E8M0); if constexpr (PROBE == 8) gm::gemm_phase<EpiDown, gm::MoeSched<false>, true>(lds, p, p.ACT, p.w_dt0, (size_t)DM * (EFF / 2), EFF / 2, S, e, W8_E8M0, A8_E8M0); }
    xcd_barrier(bar);
    ph::norm_rows<1, D8_IN1>(p, nullptr, p.norm1_mix, 2, 1, tab);
    xcd_barrier(bar);
    { const int c = blockIdx.x, G = gridDim.x; int tfirst, tcount, tstride;
      if (G == 256) { tstride = 1; if (c < 64) { tcount = 18; tfirst = 18 * c; } else { tcount = 26; tfirst = 1152 + 26 * (c - 64); } }
      else { tstride = G; tfirst = c; tcount = c < 6144 ? (6144 - c + G - 1) / G : 0; }
      const bool t_first = ((c >> 3) & 1) != 0;
      if (t_first) { ph::transposer(p, lds, 7096 + tfirst, tcount, tstride); __syncthreads(); }
      { gm::DenseSched S; S.init(T_TOK, N_IN1); EpiIn1 e; e.xin = nullptr; e.lgate = 0; gm::gemm_phase(lds, p, p.H, p.w_in1t, 0, DM, S, e); }
      if (!t_first) { __syncthreads(); ph::transposer(p, lds, 7096 + tfirst, tcount, tstride); } }
    xcd_barrier(bar);
    ph::lru_conv(p);
    if constexpr (PROBE == 9) { ph::lru_conv(p); ph::lru_conv(p); }
    xcd_barrier(bar);
    ph::lru(p, lds);
    if constexpr (PROBE == 6) ph::lru(p, lds);
    xcd_barrier(bar);
    { gm::DenseSched S; S.init(T_TOK, DM); EpiOut e; e.xin = nullptr; e.lgate = 2; gm::gemm_phase(lds, p, p.AO, p.w_out1t, 0, LRU_W, S, e); }
    xcd_barrier(bar);
    ph::router<false, true>(p, 1, lds, p.norm1_ffn, 3);
    xcd_barrier(bar);
    gm::moe_tables(tab, p.cnt + 32);
    { gm::MoeSched<true> S; S.init(tab); EpiGU e; e.xin = nullptr; e.lgate = 0; gm::gemm_phase<EpiGU, gm::MoeSched<true>, true>(lds, p, p.H, p.w_gut1, (size_t)2048 * (DM / 2), DM / 2, S, e, W8_E8M0, A8_E8M0); }
    xcd_barrier(bar);
    { gm::MoeSched<false> S; S.init(tab); EpiDown e; e.xin = nullptr; e.lgate = 0; gm::gemm_phase<EpiDown, gm::MoeSched<false>, true>(lds, p, p.ACT, p.w_dt1, (size_t)DM * (EFF / 2), EFF / 2, S, e, W8_E8M0, A8_E8M0); }
    xcd_barrier(bar);
    ph::norm_rows<2>(p, nullptr, p.norm_final, 0, 3, tab);
}

static inline size_t al256(size_t x) { return (x + 255) & ~(size_t)255; }

extern "C" void kernel_launch(void* const* d_in, const int* in_sizes, int n_in, void* d_out, int out_size, void* d_ws, size_t ws_size, hipStream_t stream) {
    Params p{};
    const float** ip = (const float**)&p.x;
    for (int i = 0; i < 38; ++i) ip[i] = (const float*)d_in[i];
    p.out = (float*)d_out;
    char* w = (char*)d_ws; size_t off = 0;
    auto take = [&](size_t bytes) { char* r = w + off; off += al256(bytes); return r; };
    p.bar = (unsigned*)take(16384); p.cnt = (int*)take(256);
    const size_t zero_bytes = off;
    p.mod = (float*)take(4 * 4 * 6144 * 4); p.wrt = (bf16_t*)take((size_t)2 * 4 * 3 * 48 * 2048 * 2); p.rbias = (float*)take(2 * 4 * 48 * 4);
    p.w_in0t = (bf16_t*)take((size_t)N_IN0 * DM * 2); p.w_out0t = (bf16_t*)take((size_t)DM * DM * 2);
    p.w_gut0 = (bf16_t*)take((size_t)NEXP * 2048 * DM); p.w_dt0 = (bf16_t*)take((size_t)NEXP * DM * EFF);
    p.w_in1t = (bf16_t*)take((size_t)N_IN1 * DM * 2); p.w_out1t = (bf16_t*)take((size_t)DM * LRU_W * 2);
    p.w_gut1 = (bf16_t*)take((size_t)NEXP * 2048 * DM); p.w_dt1 = (bf16_t*)take((size_t)NEXP * DM * EFF);
    p.w_lru = (bf16_t*)take((size_t)2 * 2 * 16 * 2 * 96 * 192 * 2);
    p.H = (bf16_t*)take((size_t)T_TOK * DM * 2); p.G = (bf16_t*)take((size_t)T_TOK * N_IN1 * 2); p.AO = (bf16_t*)take((size_t)T_TOK * LRU_W * 2); p.HF = (bf16_t*)take((size_t)256 * 32 * 8 * 3 * 64 * 8);
    p.XA = (bf16_t*)take((size_t)T_TOK * DM * 2); p.ACT = (bf16_t*)take((size_t)ROWS_PAD * EFF * 2); p.YB = (bf16_t*)take((size_t)ROWS_PAD * DM * 2);
    p.XC = (bf16_t*)take((size_t)T_TOK * LRU_W * 2); p.KVH = (bf16_t*)take((size_t)NBATCH * 8 * 2 * SEQ * 128 * 2);
    p.tokl = (int*)take((size_t)NEXP * ECAP * 4); p.gatel = (float*)take((size_t)NEXP * ECAP * 4); p.asg = (int*)take((size_t)T_TOK * 2 * 4);
    if (off > ws_size) return;
    (void)hipMemsetAsync(d_ws, 0, zero_bytes, stream);
    static int grid = 0;
    if (!grid) { int dev = 0, cus = 0, per_cu = 0; (void)hipGetDevice(&dev); (void)hipDeviceGetAttribute(&cus, hipDeviceAttributeMultiprocessorCount, dev);
        (void)hipFuncSetAttribute((const void*)mega, hipFuncAttributeMaxDynamicSharedMemorySize, LDS_TOTAL);
        (void)hipOccupancyMaxActiveBlocksPerMultiprocessor(&per_cu, mega, 512, LDS_TOTAL);
        grid = cus * (per_cu < 1 ? per_cu : 1); }
    if (grid > 0) mega<<<grid, 512, LDS_TOTAL, stream>>>(p);
}
```

```cpp
#include <hip/hip_runtime.h>
#include <stdint.h>

typedef unsigned short bf16_t;
typedef float f32x4 __attribute__((ext_vector_type(4)));

#define DI __device__ __forceinline__

constexpr int T_TOK = 16384, DM = 2048, SEQ = 4096, NBATCH = 4;
constexpr int N_IN0 = 5120, N_IN1 = 5376, LRU_W = 2688, LRU_BW = 168;
constexpr int NEXP = 32, EFF = 1024, ECAP = 16384, ROWS_PAD = 40960;

DI float bf2f(bf16_t b) { return __uint_as_float(((unsigned)b) << 16); }
DI bf16_t f2bf(float f) { unsigned u = __float_as_uint(f); u += 0x7FFFu + ((u >> 16) & 1u); return (bf16_t)(u >> 16); }
DI float sigmoidf_(float x) { return __builtin_amdgcn_rcpf(1.0f + __expf(-x)); }
DI float siluf_(float x) { return x * __builtin_amdgcn_rcpf(1.0f + __expf(-x)); }
DI float gelu_tanh(float x) { const float u = 0.7978845608028654f * (x + 0.044715f * x * x * x); return x * __builtin_amdgcn_rcpf(1.0f + __expf(-2.0f * u)); }
DI float wave_sum(float v) { for (int o = 32; o > 0; o >>= 1) v += __shfl_xor(v, o); return v; }
DI float wave_max(float v) { for (int o = 32; o > 0; o >>= 1) v = fmaxf(v, __shfl_xor(v, o)); return v; }

struct Params {
    const float *x, *c;
    const float *norm0_mix, *ada0_mix_w, *ada0_mix_b, *w_in0, *conv_w, *conv_b, *conv_norm_g, *conv_norm_b, *w_out0;
    const float *norm0_ffn, *ada0_ffn_w, *ada0_ffn_b, *moe0_w_group, *moe0_w_expert, *moe0_w_gate_up, *moe0_w_down;
    const float *norm1_mix, *ada1_mix_w, *ada1_mix_b, *w_in1, *lru_conv_w, *lru_conv_b, *lru_w_a, *lru_b_a, *lru_w_x, *lru_b_x, *lru_lambda, *w_out1;
    const float *norm1_ffn, *ada1_ffn_w, *ada1_ffn_b, *moe1_w_group, *moe1_w_expert, *moe1_w_gate_up, *moe1_w_down;
    const float *norm_final;
    float* out;
    unsigned* bar; int* cnt;
    float* mod;
    bf16_t* wrt;
    float* rbias;
    bf16_t *w_in0t, *w_out0t, *w_gut0, *w_dt0, *w_in1t, *w_out1t, *w_gut1, *w_dt1, *w_lru;
    bf16_t *H, *G, *AO, *HF, *ACT, *YB, *XC, *KVH;
    bf16_t* XA;
    int* tokl; float* gatel; int* asg;
};

constexpr bool YB8_E = true;
struct GUnit { int rowbase; int nvalid; int e; const int* gather; };
struct GArgs { const bf16_t* A; const bf16_t* Bt; size_t bt_estride; long long lda, K, moe_layer; const float* xin; long long lgate; };
typedef unsigned u32x4_ __attribute__((ext_vector_type(4)));
typedef __bf16 bf2v_ __attribute__((ext_vector_type(2)));
typedef float f32x2_ __attribute__((ext_vector_type(2)));
DI unsigned pk2e(float a, float b) { f32x2_ v = {a, b}; bf2v_ r = __builtin_convertvector(v, bf2v_); return __builtin_bit_cast(unsigned, r); }
DI u32x4_ pack8(f32x4 a, f32x4 b) { return (u32x4_){pk2e(a[0], a[1]), pk2e(a[2], a[3]), pk2e(b[0], b[1]), pk2e(b[2], b[3])}; }
struct EpiIn0 { static constexpr bool GATHER = false, PRE = false; const float* xin; int lgate; DI void operator()(const Params& p, const GUnit& u, int r, int col0, f32x4 lo0, f32x4 lo1, f32x4 hi0, f32x4 hi1) const {
    const int row = u.rowbase + r;
    if (col0 < 3072) { bf16_t* o = p.G + (size_t)row * N_IN0 + col0; *(u32x4_*)o = pack8(lo0, lo1); *(u32x4_*)(o + 128) = pack8(hi0, hi1); }
    else { const int b = row / SEQ, t = row % SEQ, i0 = (col0 - 3072) >> 7, i1 = i0 + 1;
        bf16_t* o0 = p.KVH + ((size_t)((b * 8 + (i0 & 7)) * 2 + (i0 >> 3)) * SEQ + t) * 128 + (col0 & 127);
        bf16_t* o1 = p.KVH + ((size_t)((b * 8 + (i1 & 7)) * 2 + (i1 >> 3)) * SEQ + t) * 128 + (col0 & 127);
        *(u32x4_*)o0 = pack8(lo0, lo1); *(u32x4_*)o1 = pack8(hi0, hi1); } } };
template <bool F32RES> struct EpiOutT { static constexpr bool GATHER = false, PRE = true; const float* xin; int lgate;
    struct UPre { f32x4 g0, g1, g2, g3; };
    struct Pre { f32x4 x0, x1, x2, x3; u32x4_ a, c; };
    DI UPre unit_pre(const Params& p, const GUnit& u, int col0) const { const int b = u.rowbase / SEQ; const float* gt = p.mod + (lgate * 4 + b) * 6144 + 4096 + col0;
        UPre q; q.g0 = *(const f32x4*)gt; q.g1 = *(const f32x4*)(gt + 4); q.g2 = *(const f32x4*)(gt + 128); q.g3 = *(const f32x4*)(gt + 132); return q; }
    DI Pre pre(const Params& p, const GUnit& u, int r, int col0) const { const size_t off = (size_t)(u.rowbase + r) * DM + col0; Pre q;
        if constexpr (F32RES) { const float* xi = xin + off; q.x0 = *(const f32x4*)xi; q.x1 = *(const f32x4*)(xi + 4); q.x2 = *(const f32x4*)(xi + 128); q.x3 = *(const f32x4*)(xi + 132); }
        else { const bf16_t* o = p.XA + off; q.a = *(const u32x4_*)o; q.c = *(const u32x4_*)(o + 128); }
        return q; }
    DI void fin(const Params& p, const GUnit& u, int r, int col0, const UPre& g, const Pre& q, f32x4 lo0, f32x4 lo1, f32x4 hi0, f32x4 hi1) const {
        bf16_t* o = p.XA + (size_t)(u.rowbase + r) * DM + col0;
        f32x4 r0, r1, r2, r3;
        if constexpr (F32RES) { r0 = q.x0; r1 = q.x1; r2 = q.x2; r3 = q.x3; }
        else { const u32x4_ a = q.a, c = q.c;
            r0 = (f32x4){__uint_as_float(a[0] << 16), __uint_as_float(a[0] & 0xffff0000u), __uint_as_float(a[1] << 16), __uint_as_float(a[1] & 0xffff0000u)};
            r1 = (f32x4){__uint_as_float(a[2] << 16), __uint_as_float(a[2] & 0xffff0000u), __uint_as_float(a[3] << 16), __uint_as_float(a[3] & 0xffff0000u)};
            r2 = (f32x4){__uint_as_float(c[0] << 16), __uint_as_float(c[0] & 0xffff0000u), __uint_as_float(c[1] << 16), __uint_as_float(c[1] & 0xffff0000u)};
            r3 = (f32x4){__uint_as_float(c[2] << 16), __uint_as_float(c[2] & 0xffff0000u), __uint_as_float(c[3] << 16), __uint_as_float(c[3] & 0xffff0000u)}; }
        *(u32x4_*)o = pack8(r0 + g.g0 * lo0, r1 + g.g1 * lo1); *(u32x4_*)(o + 128) = pack8(r2 + g.g2 * hi0, r3 + g.g3 * hi1); } };
DI unsigned pk4_fp8e(float a, float b, float c, float d, float sc) { a = fminf(fmaxf(a * sc, -448.f), 448.f); b = fminf(fmaxf(b * sc, -448.f), 448.f); c = fminf(fmaxf(c * sc, -448.f), 448.f); d = fminf(fmaxf(d * sc, -448.f), 448.f);
    unsigned w = 0u; w = __builtin_amdgcn_cvt_pk_fp8_f32(a, b, w, false); w = __builtin_amdgcn_cvt_pk_fp8_f32(c, d, w, true); return w; }
struct EpiGU { static constexpr bool GATHER = true, PRE = false; const float* xin; int lgate; DI void operator()(const Params& p, const GUnit& u, int r, int col0, f32x4 lo0, f32x4 lo1, f32x4 hi0, f32x4 hi1) const {
    f32x4 a0, a1;
#pragma unroll
    for (int j = 0; j < 4; ++j) { a0[j] = siluf_(lo0[j]) * hi0[j]; a1[j] = siluf_(lo1[j]) * hi1[j]; }
    *(uint2*)((unsigned char*)p.ACT + (size_t)(u.rowbase + r) * EFF + (col0 >> 8) * 128 + (col0 & 127)) = make_uint2(pk4_fp8e(a0[0], a0[1], a0[2], a0[3], 8.f), pk4_fp8e(a1[0], a1[1], a1[2], a1[3], 8.f)); } };
struct EpiDown { static constexpr bool GATHER = false, PRE = true; const float* xin; int lgate;
    struct UPre { int none; };
    struct Pre { float g; };
    DI UPre unit_pre(const Params&, const GUnit&, int) const { return UPre{0}; }
    DI Pre pre(const Params& p, const GUnit& u, int r, int) const { return Pre{p.gatel[(u.gather - p.tokl) + r]}; }
    DI void fin(const Params& p, const GUnit& u, int r, int col0, const UPre&, const Pre& q, f32x4 lo0, f32x4 lo1, f32x4 hi0, f32x4 hi1) const {
    const float g = q.g;
    if constexpr (YB8_E) { const float gs = g * 64.f; unsigned char* o = (unsigned char*)p.YB + (size_t)(u.rowbase + r) * DM + col0;
        *(uint2*)o = make_uint2(pk4_fp8e(lo0[0], lo0[1], lo0[2], lo0[3], gs), pk4_fp8e(lo1[0], lo1[1], lo1[2], lo1[3], gs)); *(uint2*)(o + 128) = make_uint2(pk4_fp8e(hi0[0], hi0[1], hi0[2], hi0[3], gs), pk4_fp8e(hi1[0], hi1[1], hi1[2], hi1[3], gs)); }
    else { bf16_t* o = p.YB + (size_t)(u.rowbase + r) * DM + col0; *(u32x4_*)o = pack8(lo0 * g, lo1 * g); *(u32x4_*)(o + 128) = pack8(hi0 * g, hi1 * g); } } };
struct EpiIn1 { static constexpr bool GATHER = false, PRE = false; const float* xin; int lgate; DI void operator()(const Params& p, const GUnit& u, int r, int col0, f32x4 lo0, f32x4 lo1, f32x4 hi0, f32x4 hi1) const {
    bf16_t* o = p.G + (size_t)(u.rowbase + r) * N_IN1 + col0;
    if (col0 < LRU_W) {
#pragma unroll
        for (int j = 0; j < 4; ++j) { lo0[j] = gelu_tanh(lo0[j]); lo1[j] = gelu_tanh(lo1[j]); } }
    if (col0 + 128 < LRU_W) {
#pragma unroll
        for (int j = 0; j < 4; ++j) { hi0[j] = gelu_tanh(hi0[j]); hi1[j] = gelu_tanh(hi1[j]); } }
    *(u32x4_*)o = pack8(lo0, lo1); *(u32x4_*)(o + 128) = pack8(hi0, hi1); } };

#define LAS __attribute__((address_space(3)))
typedef short bf16x8 __attribute__((ext_vector_type(8)));
DI int opaque_tid() { int t = threadIdx.x; asm volatile("" : "+v"(t)); return t; }
namespace gm {
constexpr int BM = 256, BK = 64, HALF = 128, HTB = HALF * BK * 2, STAGE_BYTES = 8 * HTB, NXCD = 8, WGM = 4;
constexpr int TAB_OFF = STAGE_BYTES;
DI int lds_byte(int r, int c) { const int st = (r >> 4) * 2 + (c >> 5), rr = r & 15, cc = c & 31, ob = rr * 64 + cc * 2; return st * 1024 + (ob ^ (((ob >> 9) & 1) << 5)); }
DI int perm32(int rho) { const int n = rho >> 4, i = rho & 15; return 8 * (i >> 2) + 4 * n + (i & 3); }
DI void stage_rc(int b, int& R, int& C) { const int st = b / 1024, sb = b % 1024, swz = sb ^ (((sb >> 9) & 1) << 5); R = (st >> 1) * 16 + swz / 64; C = (st & 1) * 32 + (swz % 64) / 2; }
struct Unit { int arow, nvalid, orow, pn, e, goff; };
struct DenseSched {
    static constexpr bool GATHER = false, HALF_SKIP = false;
    int nM, nN, nwg, G, c;
    DI void init(int M, int N) { nM = M / BM; nN = N / BM; nwg = nM * nN; G = gridDim.x; c = blockIdx.x; }
    DI bool next(int i, Unit& u) const {
        const long L = (long)i * G + c; if (L >= nwg) return false;
        int wgid = (int)L; { const int q = nwg / NXCD, r = nwg % NXCD, xcd = wgid % NXCD, off = wgid / NXCD; wgid = (xcd < r ? xcd * (q + 1) : r * (q + 1) + (xcd - r) * q) + off; }
        const int nig = WGM * nN, gid = wgid / nig, fm = gid * WGM, gsz = (nM - fm) < WGM ? (nM - fm) : WGM;
        const int pm = fm + ((wgid % nig) % gsz); u.pn = (wgid % nig) / gsz; u.arow = pm * BM; u.orow = pm * BM; u.nvalid = BM; u.e = 0; u.goff = 0; return true;
    }
};
template <bool GATH> struct MoeSched {
    static constexpr bool GATHER = GATH, HALF_SKIP = true;
    const LAS int* tab; int G, c;
    DI void init(const LAS int* t) { tab = t; G = gridDim.x; c = blockIdx.x; }
    DI bool next(int i, Unit& u) const {
        const int L = i * G + c, mtile = L >> 3; const int total = __builtin_amdgcn_readfirstlane(tab[32]);
        if (mtile >= total) return false;
        int e = 0; for (int j = 1; j < 32; ++j) { if (__builtin_amdgcn_readfirstlane(tab[j]) <= mtile) e = j; }
        const int mt = mtile - __builtin_amdgcn_readfirstlane(tab[e]); const int cn = __builtin_amdgcn_readfirstlane(tab[64 + e]);
        u.e = e; u.pn = L & 7; u.orow = mtile * BM; u.arow = mtile * BM; u.nvalid = (cn - mt * BM) < BM ? (cn - mt * BM) : BM; u.goff = e * ECAP + mt * BM; return true;
    }
};
DI void moe_tables(LAS int* tab, const int* cnt) {
    if (threadIdx.x == 0) { int run = 0; for (int e = 0; e < 32; ++e) { const int cn = cnt[e]; tab[e] = run; tab[64 + e] = cn; run += (cn + 255) >> 8; } tab[32] = run; }
    __syncthreads();
}

typedef int i32x8 __attribute__((ext_vector_type(8)));
typedef int i32x4 __attribute__((ext_vector_type(4)));
DI void mfma8(f32x4& acc, const i32x8& w8, const i32x8& x8, int ws, int as) {
    asm volatile("v_mfma_scale_f32_16x16x128_f8f6f4 %0, %1, %2, %0, %3, %4 op_sel_hi:[0,0,0]" : "+v"(acc) : "v"(w8), "v"(x8), "v"(ws), "v"(as)); }
template <class Epi, class Sched, bool FP8 = false>
DI void gemm_phase(LAS unsigned char* lds, const Params& p, const bf16_t* A, const bf16_t* Bt, size_t bt_estride, int K, const Sched& S, const Epi& E, int wscale = 0x7f7f7f7f, int ascale = 0x7f7f7f7f) {
    const int tid = opaque_tid(), wid = __builtin_amdgcn_readfirstlane(tid >> 6), lane = tid & 63, wr = wid >> 2, wc = wid & 3, fr = lane & 15, fq = lane >> 4;
    const int nt = K / BK;
    unsigned voffA[2], voffB[2];
#pragma unroll
    for (int i = 0; i < 2; ++i) { int R, C; stage_rc(tid * 16 + i * 8192, R, C); voffA[i] = (unsigned)(R * K + C) * 2u; voffB[i] = (unsigned)(((R & ~31) + perm32(R & 31)) * K + C) * 2u; }
    const size_t kstep = (size_t)(BK * 2), hstep = (size_t)HALF * K * 2, tstep = 2 * hstep;
    const unsigned ldsw = (unsigned)wid * 1024u;
    const int aoff = lds_byte(wr * 64 + fr, fq * 8), boff = lds_byte(wc * 32 + fr, fq * 8);
#define G_SA(b, h) (((b) * 2 + (h)) * HTB)
#define G_SB(b, h) ((4 + (b) * 2 + (h)) * HTB)
#define G_STAGE(bufoff, gbase, voff) do { _Pragma("unroll") for (int _i = 0; _i < 2; ++_i) \
        __builtin_amdgcn_global_load_lds((const unsigned*)((const char*)(gbase) + (voff)[_i]), (LAS unsigned*)(lds + (bufoff) + ldsw + _i * 8192), 16, 0, 0); } while (0)
#define G_STAGE_A(bufoff, ubase, gv, h, koff) do { if constexpr (Sched::GATHER) { G_STAGE(bufoff, (const char*)A + (koff), gv[h]); } else { G_STAGE(bufoff, (ubase) + (h) * hstep + (koff), voffA); } } while (0)
#define G_LD16(off_) (*(const LAS i32x4*)(lds + (off_)))
#define G_LD16B(off_) (*(const LAS bf16x8*)(lds + (off_)))
#define G_LDA(dst, b, h) do { _Pragma("unroll") for (int m = 0; m < 4; ++m) { if constexpr (FP8) dst##8[m] = __builtin_shufflevector(G_LD16(G_SA(b, h) + aoff + m * 2048), G_LD16(G_SA(b, h) + aoff + m * 2048 + 1024), 0, 1, 2, 3, 4, 5, 6, 7); \
        else { dst[m][0] = G_LD16B(G_SA(b, h) + aoff + m * 2048); dst[m][1] = G_LD16B(G_SA(b, h) + aoff + m * 2048 + 1024); } } } while (0)
#define G_LDB(dst, b, h) do { _Pragma("unroll") for (int n = 0; n < 2; ++n) { if constexpr (FP8) dst##8[n] = __builtin_shufflevector(G_LD16(G_SB(b, h) + boff + n * 2048), G_LD16(G_SB(b, h) + boff + n * 2048 + 1024), 0, 1, 2, 3, 4, 5, 6, 7); \
        else { dst[n][0] = G_LD16B(G_SB(b, h) + boff + n * 2048); dst[n][1] = G_LD16B(G_SB(b, h) + boff + n * 2048 + 1024); } } } while (0)
#define G_MMA(ai, bj, At, Bt_) do { __builtin_amdgcn_s_setprio(1); _Pragma("unroll") for (int m = 0; m < 4; ++m) _Pragma("unroll") for (int n = 0; n < 2; ++n) { \
        if constexpr (FP8) mfma8(acc[ai][bj][m][n], Bt_##8[n], At##8[m], wscale, ascale); \
        else { _Pragma("unroll") for (int k = 0; k < 2; ++k) acc[ai][bj][m][n] = __builtin_amdgcn_mfma_f32_16x16x32_bf16(Bt_[n][k], At[m][k], acc[ai][bj][m][n], 0, 0, 0); } } \
        __builtin_amdgcn_s_setprio(0); } while (0)
#define G_WAIT_V(n) asm volatile("s_waitcnt vmcnt(" #n ")" ::: "memory")
#define G_WAIT_L(n) asm volatile("s_waitcnt lgkmcnt(" #n ")" ::: "memory")
#define G_BAR __builtin_amdgcn_s_barrier()
#define G_SCHED __builtin_amdgcn_sched_barrier(0)
    Unit cur, nxt; int ui = 0;
    if (!S.next(0, cur)) return;
    f32x4 acc[2][2][4][2];
#pragma unroll
    for (int a = 0; a < 2; ++a)
#pragma unroll
        for (int b = 0; b < 2; ++b)
#pragma unroll
            for (int m = 0; m < 4; ++m)
#pragma unroll
                for (int n = 0; n < 2; ++n) acc[a][b][m][n] = (f32x4){0.f, 0.f, 0.f, 0.f};
    bf16x8 At[4][2], B0[2][2], B1[2][2]; i32x8 At8[4], B08[2], B18[2];
    unsigned gcur[2][2] = {{0u, 0u}, {0u, 0u}}, gnxt[2][2] = {{0u, 0u}, {0u, 0u}};
    auto gather_offs = [&](const Unit& u, unsigned (&g)[2][2]) {
        if constexpr (Sched::GATHER) {
#pragma unroll
            for (int h = 0; h < 2; ++h)
#pragma unroll
                for (int i = 0; i < 2; ++i) { int tz = tid; asm volatile("" : "+v"(tz)); int R, C; stage_rc(tz * 16 + i * 8192, R, C); const int r = h * HALF + R; const int tk = p.tokl[u.goff + (r < u.nvalid ? r : 0)]; const int tok = r < u.nvalid ? tk : 0; g[h][i] = (unsigned)(tok * K + C) * 2u; }
        }
    };
    const char* cA = (const char*)A + (size_t)(cur.arow / BM) * tstep; const char* cB = (const char*)Bt + ((size_t)cur.e * bt_estride) * 2 + (size_t)cur.pn * tstep;
    gather_offs(cur, gcur);
    G_STAGE(G_SB(0, 0), cB, voffB); G_STAGE_A(G_SA(0, 0), cA, gcur, 0, 0); G_STAGE(G_SB(0, 1), cB + hstep, voffB); G_STAGE_A(G_SA(0, 1), cA, gcur, 1, 0);
    if (wr == 1) G_BAR;
    G_WAIT_V(4); G_BAR;
    G_STAGE(G_SB(1, 0), cB + kstep, voffB); G_STAGE_A(G_SA(1, 0), cA, gcur, 0, kstep); G_STAGE(G_SB(1, 1), cB + hstep + kstep, voffB);
    G_WAIT_V(6); G_BAR;
    for (;;) {
        const bool has_next = S.next(ui + 1, nxt);
        const char* nA = has_next ? (const char*)A + (size_t)(nxt.arow / BM) * tstep : cA;
        const char* nB = has_next ? (const char*)Bt + ((size_t)nxt.e * bt_estride) * 2 + (size_t)nxt.pn * tstep : cB;
        if constexpr (Sched::GATHER) { if (has_next) gather_offs(nxt, gnxt); else {
#pragma unroll
            for (int h = 0; h < 2; ++h) { gnxt[h][0] = gcur[h][0]; gnxt[h][1] = gcur[h][1]; } } }
        for (int t = 0; t < nt; t += 2) {
            const bool last = (t == nt - 2);
            const size_t k1 = (size_t)(t + 1) * kstep;
            const char* a2 = last ? nA : cA; const char* b2 = last ? nB : cB + (size_t)(t + 2) * kstep;
            const size_t k2 = last ? 0 : (size_t)(t + 2) * kstep; const size_t k3 = k2 + kstep;
            const char* b3 = b2 + kstep;
            unsigned g2[2][2];
#pragma unroll
            for (int h = 0; h < 2; ++h) { g2[h][0] = last ? gnxt[h][0] : gcur[h][0]; g2[h][1] = last ? gnxt[h][1] : gcur[h][1]; }
            G_LDB(B0, 0, 0); G_SCHED; G_LDA(At, 0, 0); G_STAGE_A(G_SA(1, 1), cA, gcur, 1, k1);
            G_WAIT_L(8); G_BAR; G_WAIT_L(0); G_MMA(0, 0, At, B0); G_BAR; G_SCHED;
            G_LDB(B1, 0, 1); G_STAGE(G_SB(0, 0), b2, voffB);
            G_BAR; G_WAIT_L(0); G_MMA(0, 1, At, B1); G_BAR;
            G_LDA(At, 0, 1); G_STAGE_A(G_SA(0, 0), a2, g2, 0, k2);
            G_BAR; G_WAIT_L(0); if (!Sched::HALF_SKIP || cur.nvalid > HALF) G_MMA(1, 0, At, B0); G_BAR; G_SCHED;
            G_STAGE(G_SB(0, 1), b2 + hstep, voffB);
            G_WAIT_V(6); G_BAR; if (!Sched::HALF_SKIP || cur.nvalid > HALF) G_MMA(1, 1, At, B1); G_BAR;
            G_LDB(B0, 1, 0); G_SCHED; G_LDA(At, 1, 0); G_STAGE_A(G_SA(0, 1), a2, g2, 1, k2);
            G_WAIT_L(8); G_BAR; G_WAIT_L(0); G_MMA(0, 0, At, B0); G_BAR; G_SCHED;
            G_LDB(B1, 1, 1); G_STAGE(G_SB(1, 0), b3, voffB);
            G_BAR; G_WAIT_L(0); G_MMA(0, 1, At, B1); G_BAR;
            G_LDA(At, 1, 1); G_STAGE_A(G_SA(1, 0), a2, g2, 0, k3);
            G_BAR; G_WAIT_L(0); if (!Sched::HALF_SKIP || cur.nvalid > HALF) G_MMA(1, 0, At, B0); G_BAR; G_SCHED;
            G_STAGE(G_SB(1, 1), b3 + hstep, voffB);
            G_WAIT_V(6); G_BAR; if (!Sched::HALF_SKIP || cur.nvalid > HALF) G_MMA(1, 1, At, B1); G_BAR;
        }
        if constexpr (FP8) asm volatile("s_nop 15\n\ts_nop 15" ::: "memory");
        { GUnit gu; gu.rowbase = cur.orow; gu.nvalid = cur.nvalid; gu.e = cur.e; gu.gather = p.tokl + cur.goff;
          if constexpr (Epi::PRE) {
            const int col0 = cur.pn * BM + wc * 32 + fq * 8; const auto up = E.unit_pre(p, gu, col0);
#pragma unroll
            for (int ai = 0; ai < 2; ++ai) { typename Epi::Pre pr[4];
#pragma unroll
              for (int m = 0; m < 4; ++m) pr[m] = E.pre(p, gu, ai * HALF + wr * 64 + m * 16 + fr, col0);
              asm volatile("" ::: "memory");
#pragma unroll
              for (int m = 0; m < 4; ++m) { const int r = ai * HALF + wr * 64 + m * 16 + fr;
                if (!Sched::HALF_SKIP || r < cur.nvalid) E.fin(p, gu, r, col0, up, pr[m], acc[ai][0][m][0], acc[ai][0][m][1], acc[ai][1][m][0], acc[ai][1][m][1]); } }
          } else {
#pragma unroll
          for (int ai = 0; ai < 2; ++ai)
#pragma unroll
            for (int m = 0; m < 4; ++m) { const int r = ai * HALF + wr * 64 + m * 16 + fr;
              if (!Sched::HALF_SKIP || r < cur.nvalid) E(p, gu, r, cur.pn * BM + wc * 32 + fq * 8, acc[ai][0][m][0], acc[ai][0][m][1], acc[ai][1][m][0], acc[ai][1][m][1]); } } }
        if (!has_next) break;
#pragma unroll
        for (int a = 0; a < 2; ++a)
#pragma unroll
            for (int b = 0; b < 2; ++b)
#pragma unroll
                for (int m = 0; m < 4; ++m)
#pragma unroll
                    for (int n = 0; n < 2; ++n) acc[a][b][m][n] = (f32x4){0.f, 0.f, 0.f, 0.f};
        cur = nxt; cA = nA; cB = nB; ++ui;
#pragma unroll
        for (int h = 0; h < 2; ++h) { gcur[h][0] = gnxt[h][0]; gcur[h][1] = gnxt[h][1]; }
    }
    G_WAIT_V(0);
    if (wr == 0) G_BAR;
    G_BAR;
}
}

extern __shared__ __attribute__((aligned(16))) unsigned char dyn_smem[];
constexpr int LDS_BYTES = gm::STAGE_BYTES + 1024;

typedef __bf16 bf2v __attribute__((ext_vector_type(2)));
typedef float f32x2 __attribute__((ext_vector_type(2)));
typedef float f32x16 __attribute__((ext_vector_type(16)));
typedef short s16x4 __attribute__((ext_vector_type(4)));
typedef unsigned u32x4 __attribute__((ext_vector_type(4)));
DI unsigned pk2(float a, float b) { f32x2 v = {a, b}; bf2v r = __builtin_convertvector(v, bf2v); return __builtin_bit_cast(unsigned, r); }
DI float bflo(unsigned u) { return __uint_as_float(u << 16); }
DI float bfhi(unsigned u) { return __uint_as_float(u & 0xffff0000u); }

DI unsigned pk4_fp8(float a, float b, float c, float d, float sc) {
    a = __builtin_amdgcn_fmed3f(a * sc, -448.f, 448.f); b = __builtin_amdgcn_fmed3f(b * sc, -448.f, 448.f); c = __builtin_amdgcn_fmed3f(c * sc, -448.f, 448.f); d = __builtin_amdgcn_fmed3f(d * sc, -448.f, 448.f);
    unsigned w = 0u; w = __builtin_amdgcn_cvt_pk_fp8_f32(a, b, w, false); w = __builtin_amdgcn_cvt_pk_fp8_f32(c, d, w, true); return w; }
constexpr bool D8_IN0 = true, D8_OUT0 = false, D8_IN1 = false;
constexpr bool YB8 = true;
constexpr float Y8_SCALE = 64.f;
constexpr float W8_SCALE = 256.f, A8_SCALE = 8.f;
constexpr int W8_E8M0 = 0x77777777, A8_E8M0 = 0x7c7c7c7c;
namespace ph {
DI void mods(const Params& p, LAS unsigned char* lds) {
    const int tid = opaque_tid(), wave = tid >> 6, lane = tid & 63, l8 = tid & 7, rg = tid >> 3;
    LAS float* fl = (LAS float*)lds; LAS float* red = fl + 4 * DM;
    for (int i = tid; i < 4 * DM; i += 512) fl[i] = siluf_(p.c[i]);
    __syncthreads();
    for (int u = blockIdx.x; u < 768; u += gridDim.x) {
        const int l = u / 192, c32 = u % 192;
        const float* w = l == 0 ? p.ada0_mix_w : l == 1 ? p.ada0_ffn_w : l == 2 ? p.ada1_mix_w : p.ada1_ffn_w;
        const float* bs = l == 0 ? p.ada0_mix_b : l == 1 ? p.ada0_ffn_b : l == 2 ? p.ada1_mix_b : p.ada1_ffn_b;
        f32x4 acc[4] = {{0.f, 0.f, 0.f, 0.f}, {0.f, 0.f, 0.f, 0.f}, {0.f, 0.f, 0.f, 0.f}, {0.f, 0.f, 0.f, 0.f}};
        const float* wp = w + (size_t)rg * 6144 + c32 * 32 + l8 * 4;
#pragma unroll 8
        for (int i = 0; i < 32; ++i) { const f32x4 wv = *(const f32x4*)(wp + (size_t)(64 * i) * 6144); const int k = rg + 64 * i;
#pragma unroll
            for (int b = 0; b < 4; ++b) acc[b] += fl[b * DM + k] * wv; }
#pragma unroll
        for (int b = 0; b < 4; ++b)
#pragma unroll
            for (int j = 0; j < 4; ++j) { float v = acc[b][j]; v += __shfl_xor(v, 8); v += __shfl_xor(v, 16); v += __shfl_xor(v, 32); acc[b][j] = v; }
        if (lane < 8) {
#pragma unroll
            for (int b = 0; b < 4; ++b) *(LAS f32x4*)(red + (wave * 4 + b) * 32 + lane * 4) = acc[b]; }
        __syncthreads();
        if (tid < 128) { const int b = tid >> 5, col = tid & 31; float sum = 0.f;
#pragma unroll
            for (int w8 = 0; w8 < 8; ++w8) sum += red[(w8 * 4 + b) * 32 + col];
            p.mod[(l * 4 + b) * 6144 + c32 * 32 + col] = sum + bs[c32 * 32 + col]; }
        __syncthreads();
    }
}
constexpr int NT_UNITS = (640 + 256 + 672 + 336 + 2 * (8192 + 4096)) / 2;
struct UD { const float* sp; bf16_t* dst; int K, N, mode, e, kt, ntile; };
DI UD tdecode(const Params& p, int u, int lane) {
    const float* srcs[8] = {p.w_in0, p.w_out0, p.w_in1, p.w_out1, p.moe0_w_gate_up, p.moe0_w_down, p.moe1_w_gate_up, p.moe1_w_down};
    bf16_t* dsts[8] = {p.w_in0t, p.w_out0t, p.w_in1t, p.w_out1t, p.w_gut0, p.w_dt0, p.w_gut1, p.w_dt1};
    constexpr int Ks[8] = {DM, DM, DM, LRU_W, DM, EFF, DM, EFF}, Ns[8] = {N_IN0, DM, N_IN1, DM, 2048, DM, 2048, DM}, nus[8] = {320, 128, 336, 168, 4096, 2048, 4096, 2048};
    constexpr int modes[8] = {D8_IN0 ? 2 : 0, D8_OUT0 ? 2 : 0, D8_IN1 ? 2 : 0, 0, 3, 2, 3, 2};
    int v = u, mi = 0;
#pragma unroll
    for (int m = 0; m < 8; ++m) { if (mi == m && v >= nus[m]) { v -= nus[m]; mi = m + 1; } }
    UD d; const float* src = srcs[0]; d.dst = dsts[0]; d.K = Ks[0]; d.N = Ns[0]; d.mode = modes[0];
#pragma unroll
    for (int m = 1; m < 8; ++m) if (mi == m) { src = srcs[m]; d.dst = dsts[m]; d.K = Ks[m]; d.N = Ns[m]; d.mode = modes[m]; }
    const int ntl = d.N / 256, ktl = d.K / 128; d.e = v / (ktl * ntl); const int rem = v % (ktl * ntl); d.kt = rem / ntl; d.ntile = rem % ntl;
    d.sp = src + (size_t)d.e * d.K * d.N + (size_t)(d.kt * 128) * d.N + d.ntile * 256 + lane * 4;
    return d;
}
DI void transposer(const Params& p, LAS unsigned char* lds, int first, int count, int stride) {
    const int tid = opaque_tid(), wave = tid >> 6, lane = tid & 63;
    LAS float* fl = (LAS float*)lds;
    if (count <= 0) return;
    if (tdecode(p, first, lane).mode & 2) {
        LAS unsigned* td = (LAS unsigned*)lds;
        const int nl = lane & 15, ks = lane >> 4;
        auto src_of = [&](const UD& d, int g, int j) -> const float* { const int kq = 4 * (g >> 2) + ks, nq = 16 * (g & 3) + nl; return d.sp - lane * 4 + (size_t)(4 * kq + j) * d.N + 4 * nq; };
        f32x4 va[4][4], vb[4][4];
        auto load_unit = [&](int u, f32x4 (&v)[4][4]) { const UD dd = tdecode(p, u, lane);
#pragma unroll
            for (int i = 0; i < 4; ++i)
#pragma unroll
                for (int j = 0; j < 4; ++j) v[i][j] = *(const f32x4*)src_of(dd, wave * 4 + i, j); };
        auto process = [&](int jn, f32x4 (&v)[4][4]) { const int u = first + jn * stride;
            const UD d = tdecode(p, u, lane); const int K = d.K, N = d.N, mode = d.mode, e = d.e, kt = d.kt, ntile = d.ntile;
            LAS unsigned* tile = td + (jn & 1) * (256 * 33);
#pragma unroll
            for (int i = 0; i < 4; ++i) { const int g = wave * 4 + i, kq = 4 * (g >> 2) + ks, nq = 16 * (g & 3) + nl;
#pragma unroll
                for (int en = 0; en < 4; ++en) tile[(4 * nq + en) * 33 + kq] = pk4_fp8(v[i][0][en], v[i][1][en], v[i][2][en], v[i][3][en], W8_SCALE); }
            __syncthreads();
            if (jn + 2 < count) load_unit(u + 2 * stride, v);
            { const int n = tid >> 1, kh = tid & 1; const int ng = ntile * 256 + n; const int jg = ng & 1023; const int np = (mode & 1) ? (256 * (jg >> 7) + (ng < 1024 ? 0 : 128) + (jg & 127)) : ng;
              unsigned char* dp = (unsigned char*)d.dst + (size_t)e * N * K + (size_t)np * K + kt * 128 + kh * 64;
#pragma unroll
              for (int jj = 0; jj < 4; ++jj) { const LAS unsigned* tp = tile + n * 33 + kh * 16 + jj * 4; *(uint4*)(dp + jj * 16) = make_uint4(tp[0], tp[1], tp[2], tp[3]); } } };
        load_unit(first, va); if (count > 1) load_unit(first + stride, vb);
        for (int jn = 0; jn < count; jn += 2) { process(jn, va); if (jn + 1 < count) process(jn + 1, vb); }
        __syncthreads();
        return;
    }
    f32x4 vv[16];
    { const UD d0 = tdecode(p, first, lane);
#pragma unroll
        for (int i = 0; i < 16; ++i) vv[i] = *(const f32x4*)(d0.sp + (size_t)(i * 8 + wave) * d0.N); }
    for (int j = 0; j < count; ++j) { const int u = first + j * stride;
        const UD d = tdecode(p, u, lane); const int K = d.K, N = d.N, mode = d.mode, e = d.e, kt = d.kt, ntile = d.ntile; bf16_t* dst = d.dst;
#pragma unroll
        for (int i = 0; i < 16; ++i) { LAS float* tp = fl + (i * 8 + wave) * 257 + lane * 4; tp[0] = vv[i][0]; tp[1] = vv[i][1]; tp[2] = vv[i][2]; tp[3] = vv[i][3]; }
        __syncthreads();
        if (j + 1 < count) { const UD dn = tdecode(p, u + stride, lane);
#pragma unroll
            for (int i = 0; i < 16; ++i) vv[i] = *(const f32x4*)(dn.sp + (size_t)(i * 8 + wave) * dn.N); }
        { const int n = tid >> 1, kh = tid & 1; const int ng = ntile * 256 + n; const int jg = ng & 1023; const int np = (mode & 1) ? (256 * (jg >> 7) + (ng < 1024 ? 0 : 128) + (jg & 127)) : ng;
          bf16_t* dp = dst + (size_t)e * N * K + (size_t)np * K + kt * 128 + kh * 64;
#pragma unroll
          for (int jj = 0; jj < 8; ++jj) { unsigned w4[4];
#pragma unroll
              for (int q = 0; q < 4; ++q) { const int k = kh * 64 + jj * 8 + q * 2; w4[q] = pk2(fl[k * 257 + n], fl[(k + 1) * 257 + n]); }
              *(uint4*)(dp + jj * 8) = make_uint4(w4[0], w4[1], w4[2], w4[3]); } }
        __syncthreads();
    }
}
DI void lru_weights(const Params& p) {
    const int tid = opaque_tid();
    for (size_t i = (size_t)blockIdx.x * 512 + tid; i < (size_t)2 * 2 * 16 * 4 * 48 * 192; i += (size_t)gridDim.x * 512) {
        const int k = i % 192, j = (i / 192) % 48, qt = (i / (192 * 48)) % 4, n = (i / (192 * 48 * 4)) % 16, which = (i / (192 * 48 * 4 * 16)) % 2, dir = i / (192 * 48 * 4 * 16 * 2);
        const float* w = which == 0 ? p.lru_w_a : p.lru_w_x; float v = 0.f;
        if (j < 42 && k < 168) v = w[(((size_t)dir * 16 + n) * 168 + k) * 168 + qt * 42 + j];
        p.w_lru[i] = f2bf(v);
    }
}
DI void fold_router(const Params& p) {
    const int tid = opaque_tid(), wave = tid >> 6, lane = tid & 63;
    for (size_t i = (size_t)blockIdx.x * 512 + tid; i < (size_t)2 * 4 * 48 * DM; i += (size_t)gridDim.x * 512) {
        const int k = i % DM, n = (i / DM) % 48, b = (i / (DM * 48)) % 4, l = i / (DM * 48 * 4);
        const float* g = l == 0 ? p.norm0_ffn : p.norm1_ffn; const float* md = p.mod + ((l == 0 ? 1 : 3) * 4 + b) * 6144;
        const float* we = l == 0 ? p.moe0_w_expert : p.moe1_w_expert; const float* wg = l == 0 ? p.moe0_w_group : p.moe1_w_group;
        const float w = n < 32 ? we[k * 32 + n] : n < 36 ? wg[k * 4 + (n - 32)] : 0.f;
        const float wf = g[k] * (1.f + md[2048 + k]) * w;
        const bf16_t hi = f2bf(wf); const float r1 = wf - bf2f(hi); const bf16_t mid = f2bf(r1); const bf16_t lo = f2bf(r1 - bf2f(mid));
        bf16_t* dst = p.wrt + ((size_t)((l * 4 + b) * 3) * 48 + n) * DM + k;
        dst[0] = hi; dst[(size_t)48 * DM] = mid; dst[(size_t)96 * DM] = lo;
    }
    for (int task = blockIdx.x * 8 + wave; task < 2 * 4 * 48; task += gridDim.x * 8) {
        const int n = task % 48, b = (task / 48) % 4, l = task / (48 * 4);
        const float* md = p.mod + ((l == 0 ? 1 : 3) * 4 + b) * 6144;
        const float* we = l == 0 ? p.moe0_w_expert : p.moe1_w_expert; const float* wg = l == 0 ? p.moe0_w_group : p.moe1_w_group;
        float part = 0.f;
        for (int k = lane; k < DM; k += 64) { const float w = n < 32 ? we[k * 32 + n] : n < 36 ? wg[k * 4 + (n - 32)] : 0.f; part += md[k] * w; }
        part = wave_sum(part); if (lane == 0) p.rbias[task] = part;
    }
}
template <int MODE, bool OUT8 = false> DI void norm_rows(const Params& p, const float* xin  , const float* gain, int lmod, int lgate, const LAS int* tab) {
    const int tid = opaque_tid(), wave = tid >> 6, lane = tid & 63;
    for (int row = blockIdx.x * 8 + wave; row < T_TOK; row += gridDim.x * 8) {
        const int b = row / SEQ;
        f32x4 v[8];
        if (xin) {
#pragma unroll
            for (int i = 0; i < 8; ++i) v[i] = *(const f32x4*)(xin + (size_t)row * DM + i * 256 + lane * 4);
        } else {
#pragma unroll
            for (int i = 0; i < 8; ++i) { const uint2 a = *(const uint2*)(p.XA + (size_t)row * DM + i * 256 + lane * 4); v[i] = (f32x4){bflo(a.x), bfhi(a.x), bflo(a.y), bfhi(a.y)}; }
        }
        if constexpr (MODE >= 1) {
            const int a0 = p.asg[row * 2], a1 = p.asg[row * 2 + 1];
            const size_t r0 = (size_t)tab[a0 >> 14] * 256 + (a0 & 16383), r1 = (size_t)tab[a1 >> 14] * 256 + (a1 & 16383);
            const float* gt = p.mod + (lgate * 4 + b) * 6144 + 4096;
#pragma unroll
            for (int i = 0; i < 8; ++i) { const int col = i * 256 + lane * 4; const f32x4 g4 = *(const f32x4*)(gt + col);
                if constexpr (YB8) { const unsigned y0 = *(const unsigned*)((const unsigned char*)p.YB + r0 * DM + col), y1 = *(const unsigned*)((const unsigned char*)p.YB + r1 * DM + col);
                    const f32x2 a0 = __builtin_amdgcn_cvt_pk_f32_fp8(y0, false), a1 = __builtin_amdgcn_cvt_pk_f32_fp8(y0, true), b0 = __builtin_amdgcn_cvt_pk_f32_fp8(y1, false), b1 = __builtin_amdgcn_cvt_pk_f32_fp8(y1, true);
                    const f32x4 gq = g4 * (1.f / Y8_SCALE);
                    v[i][0] += gq[0] * (a0[0] + b0[0]); v[i][1] += gq[1] * (a0[1] + b0[1]); v[i][2] += gq[2] * (a1[0] + b1[0]); v[i][3] += gq[3] * (a1[1] + b1[1]); }
                else { const uint2 y0 = *(const uint2*)(p.YB + r0 * DM + col), y1 = *(const uint2*)(p.YB + r1 * DM + col);
                v[i][0] += g4[0] * (bflo(y0.x) + bflo(y1.x)); v[i][1] += g4[1] * (bfhi(y0.x) + bfhi(y1.x));
                v[i][2] += g4[2] * (bflo(y0.y) + bflo(y1.y)); v[i][3] += g4[3] * (bfhi(y0.y) + bfhi(y1.y)); } }
            if constexpr (MODE == 1) {
#pragma unroll
                for (int i = 0; i < 8; ++i) { const uint2 w = make_uint2(pk2(v[i][0], v[i][1]), pk2(v[i][2], v[i][3])); *(uint2*)(p.XA + (size_t)row * DM + i * 256 + lane * 4) = w;
                    v[i] = (f32x4){bflo(w.x), bfhi(w.x), bflo(w.y), bfhi(w.y)}; }
            }
        }
        float ss = 0.f;
#pragma unroll
        for (int i = 0; i < 8; ++i) ss += v[i][0] * v[i][0] + v[i][1] * v[i][1] + v[i][2] * v[i][2] + v[i][3] * v[i][3];
        ss = wave_sum(ss); const float rstd = rsqrtf(ss * (1.0f / DM) + 1e-6f);
        if constexpr (MODE == 2) {
#pragma unroll
            for (int i = 0; i < 8; ++i) { const int col = i * 256 + lane * 4; const f32x4 g4 = *(const f32x4*)(gain + col); *(f32x4*)(p.out + (size_t)row * DM + col) = v[i] * rstd * g4; }
        } else { const float* md = p.mod + (lmod * 4 + b) * 6144;
#pragma unroll
            for (int i = 0; i < 8; ++i) { const int col = i * 256 + lane * 4; const f32x4 g4 = *(const f32x4*)(gain + col), sc = *(const f32x4*)(md + 2048 + col), sh = *(const f32x4*)(md + col);
                const f32x4 h = v[i] * rstd * g4 * (1.f + sc) + sh;
                if constexpr (OUT8) *(unsigned*)((unsigned char*)p.H + (size_t)row * DM + col) = pk4_fp8(h[0], h[1], h[2], h[3], A8_SCALE);
                else *(uint2*)(p.H + (size_t)row * DM + col) = make_uint2(pk2(h[0], h[1]), pk2(h[2], h[3])); } }
    }
}
template <bool DRY = false, bool NORM = false> DI void router(const Params& p, int l, LAS unsigned char* lds, const float* gain = nullptr, int lmod = 0) {
    const int tid = opaque_tid(), wave = __builtin_amdgcn_readfirstlane(tid >> 6), lane = tid & 63;
    LAS float* lg = (LAS float*)lds + (wave & 3) * (16 * 48);
    LAS float* rsl = (LAS float*)lds + 4 * 16 * 48 + (wave & 3) * 16;
    LAS f32x4* part = (LAS f32x4*)(lds + 16384);
    LAS float* ssp = (LAS float*)(lds + 16384 + 98304);
    for (int tg = blockIdx.x; tg < T_TOK / 64; tg += gridDim.x) {
        const int b = (tg * 64) / SEQ, r = lane & 15, q = lane >> 4;
        const bf16_t* xa = p.XA + (size_t)(tg * 64 + r) * DM + wave * 256 + 8 * q;
        const bf16_t* wt = p.wrt + ((size_t)((l * 4 + b) * 3) * 48 + r) * DM + wave * 256 + 8 * q;
        f32x4 acc[4][3]; float ss[4] = {0.f, 0.f, 0.f, 0.f};
#pragma unroll
        for (int t = 0; t < 4; ++t)
#pragma unroll
            for (int n = 0; n < 3; ++n) acc[t][n] = (f32x4){0.f, 0.f, 0.f, 0.f};
        u32x4 aA[4], aB[4], bA[9], bB[9];
        auto ld = [&](int st, u32x4 (&aa)[4], u32x4 (&bb)[9]) {
#pragma unroll
            for (int t = 0; t < 4; ++t) aa[t] = *(const u32x4*)(xa + (size_t)t * 16 * DM + st * 32);
#pragma unroll
            for (int i = 0; i < 9; ++i) bb[i] = *(const u32x4*)(wt + (size_t)i * 16 * DM + st * 32); };
        auto mm = [&](const u32x4 (&aa)[4], const u32x4 (&bb)[9]) {
#pragma unroll
            for (int t = 0; t < 4; ++t) {
#pragma unroll
                for (int e = 0; e < 4; ++e) { const float x0 = bflo(aa[t][e]), x1 = bfhi(aa[t][e]); ss[t] += x0 * x0 + x1 * x1; }
#pragma unroll
                for (int i = 0; i < 9; ++i) acc[t][i % 3] = __builtin_amdgcn_mfma_f32_16x16x32_bf16(__builtin_bit_cast(bf16x8, aa[t]), __builtin_bit_cast(bf16x8, bb[i]), acc[t][i % 3], 0, 0, 0); } };
        ld(0, aA, bA);
        for (int st = 0; st < 8; st += 2) {
            ld(st + 1, aB, bB);
            mm(aA, bA);
            if (st + 2 < 8) ld(st + 2, aA, bA);
            mm(aB, bB);
        }
#pragma unroll
        for (int t = 0; t < 4; ++t) {
#pragma unroll
            for (int n = 0; n < 3; ++n) part[((wave * 4 + t) * 3 + n) * 64 + lane] = acc[t][n];
            float sq = ss[t]; sq += __shfl_xor(sq, 16); sq += __shfl_xor(sq, 32);
            if (q == 0) ssp[(wave * 4 + t) * 16 + r] = sq; }
        __syncthreads();
        if (wave < 4) {
        const int tile = tg * 4 + wave, row0 = tile * 16;
        f32x4 a3[3] = {{0.f, 0.f, 0.f, 0.f}, {0.f, 0.f, 0.f, 0.f}, {0.f, 0.f, 0.f, 0.f}}; float ssr = 0.f;
#pragma unroll
        for (int w2 = 0; w2 < 8; ++w2) {
#pragma unroll
            for (int n = 0; n < 3; ++n) a3[n] += part[((w2 * 4 + wave) * 3 + n) * 64 + lane];
            ssr += ssp[(w2 * 4 + wave) * 16 + r]; }
        const float rstd = rsqrtf(ssr * (1.0f / DM) + 1e-6f);
        if (NORM && q == 0) rsl[r] = rstd;
#pragma unroll
        for (int j = 0; j < 4; ++j) { const float rs = __shfl(rstd, 4 * q + j);
#pragma unroll
            for (int n = 0; n < 3; ++n) lg[(4 * q + j) * 48 + n * 16 + r] = a3[n][j] * rs + p.rbias[(l * 4 + b) * 48 + n * 16 + r]; }
        __builtin_amdgcn_wave_barrier();
        if (!DRY && lane < 16) {
            const LAS float* L = lg + lane * 48; const int tok = row0 + lane;
            int gs = 0; float gm = L[32];
#pragma unroll
            for (int g = 1; g < 4; ++g) if (L[32 + g] > gm) { gm = L[32 + g]; gs = g; }
            float gden = 0.f;
#pragma unroll
            for (int g = 0; g < 4; ++g) gden += __expf(L[32 + g] - gm);
            const float gprob = 1.0f / gden;
            int i0 = 0; float v0 = L[gs * 8];
            for (int j = 1; j < 8; ++j) { const float x = L[gs * 8 + j]; if (x > v0) { v0 = x; i0 = j; } }
            int i1 = -1; float v1 = -3.4e38f;
            for (int j = 0; j < 8; ++j) { const float x = L[gs * 8 + j]; if (j != i0 && x > v1) { v1 = x; i1 = j; } }
            const float e1 = __expf(v1 - v0), g0 = gprob / (1.f + e1), g1 = gprob * e1 / (1.f + e1);
            const int ea = gs * 8 + i0, eb = gs * 8 + i1;
            const int sa = atomicAdd(&p.cnt[l * 32 + ea], 1), sb = atomicAdd(&p.cnt[l * 32 + eb], 1);
            p.tokl[ea * ECAP + sa] = tok; p.gatel[ea * ECAP + sa] = g0; p.tokl[eb * ECAP + sb] = tok; p.gatel[eb * ECAP + sb] = g1;
            p.asg[tok * 2] = (ea << 14) | sa; p.asg[tok * 2 + 1] = (eb << 14) | sb;
        }
        }
        __syncthreads();
        if constexpr (NORM) {
            const int kh = wave >> 2, row0 = (tg * 4 + (wave & 3)) * 16;
            const float* md = p.mod + (lmod * 4 + b) * 6144;
            f32x4 g4[8], sc[8], sh[8];
#pragma unroll
            for (int i = 0; i < 8; ++i) { const int col = i * 256 + lane * 4; g4[i] = *(const f32x4*)(gain + col); sc[i] = 1.f + *(const f32x4*)(md + 2048 + col); sh[i] = *(const f32x4*)(md + col); g4[i] *= sc[i]; }
#pragma unroll 2
            for (int j = 0; j < 8; ++j) { const int row = row0 + kh * 8 + j; const float rs = rsl[kh * 8 + j];
#pragma unroll
                for (int i = 0; i < 8; ++i) { const int col = i * 256 + lane * 4; const uint2 ar = *(const uint2*)(p.XA + (size_t)row * DM + col); const f32x4 v = {bflo(ar.x), bfhi(ar.x), bflo(ar.y), bfhi(ar.y)};
                    const f32x4 h = v * rs * g4[i] + sh[i];
                    *(unsigned*)((unsigned char*)p.H + (size_t)row * DM + col) = pk4_fp8(h[0], h[1], h[2], h[3], A8_SCALE); } }
            __syncthreads();
        }
    }
}
DI void conv_gln(const Params& p, LAS unsigned char* lds) {
    const int tid = opaque_tid(), wave = tid >> 6, lane = tid & 63;
    LAS float* at = (LAS float*)lds;
    u32x4 rv[3], rg[3];
    auto load_raw = [&](int u) { const int g = u & 7, t0 = ((u >> 3) & 63) * 64, b = u >> 9;
#pragma unroll
        for (int i = 0; i < 3; ++i) { const int idx = tid + 512 * i, rr = idx >> 4, c8 = idx & 15, t = t0 - 15 + rr; rv[i] = (u32x4){0u, 0u, 0u, 0u}; rg[i] = (u32x4){0u, 0u, 0u, 0u};
            if (idx < 94 * 16 && t >= 0 && t < SEQ) { const bf16_t* row = p.G + (size_t)(b * SEQ + t) * N_IN0 + g * 128 + c8 * 8; rv[i] = *(const u32x4*)row; rg[i] = *(const u32x4*)(row + 1024); } } };
    int gcur = -1; f32x2 wk[31], bias = {0.f, 0.f}, gam = {0.f, 0.f}, bet = {0.f, 0.f};
    if ((int)blockIdx.x < 2048) load_raw(blockIdx.x);
    for (int u = blockIdx.x; u < 2048; u += gridDim.x) {
        const int g = u & 7, t0 = ((u >> 3) & 63) * 64, b = u >> 9;
        const int ch = g * 128 + 2 * lane;
        if (g != gcur) { gcur = g;
#pragma unroll
            for (int k = 0; k < 31; ++k) wk[k] = *(const f32x2*)(p.conv_w + k * 1024 + ch);
            bias = *(const f32x2*)(p.conv_b + ch); gam = *(const f32x2*)(p.conv_norm_g + ch); bet = *(const f32x2*)(p.conv_norm_b + ch); }
#pragma unroll
        for (int i = 0; i < 3; ++i) { const int idx = tid + 512 * i, rr = idx >> 4, c8 = idx & 15;
            if (idx < 94 * 16) { const u32x4 v = rv[i], gg = rg[i];
                const f32x4 lo = {bflo(v[0]) * sigmoidf_(bflo(gg[0])), bfhi(v[0]) * sigmoidf_(bfhi(gg[0])), bflo(v[1]) * sigmoidf_(bflo(gg[1])), bfhi(v[1]) * sigmoidf_(bfhi(gg[1]))};
                const f32x4 hi = {bflo(v[2]) * sigmoidf_(bflo(gg[2])), bfhi(v[2]) * sigmoidf_(bfhi(gg[2])), bflo(v[3]) * sigmoidf_(bflo(gg[3])), bfhi(v[3]) * sigmoidf_(bfhi(gg[3]))};
                *(LAS f32x4*)(at + rr * 132 + c8 * 8) = lo; *(LAS f32x4*)(at + rr * 132 + c8 * 8 + 4) = hi; } }
        __syncthreads();
        if (u + (int)gridDim.x < 2048) load_raw(u + gridDim.x);
        f32x2 acc[8];
#pragma unroll
        for (int j = 0; j < 8; ++j) acc[j] = bias;
#pragma unroll
        for (int rr = 0; rr < 38; ++rr) { const f32x2 a2 = *(const LAS f32x2*)(at + (wave * 8 + rr) * 132 + 2 * lane);
#pragma unroll
            for (int j = 0; j < 8; ++j) { const int k = rr - j; if (k >= 0 && k < 31) acc[j] += wk[k] * a2; } }
#pragma unroll
        for (int j = 0; j < 8; ++j) { const float mu = wave_sum(acc[j][0] + acc[j][1]) * (1.f / 128.f); const float d0 = acc[j][0] - mu, d1 = acc[j][1] - mu;
            const float var = wave_sum(d0 * d0 + d1 * d1) * (1.f / 128.f); const float rs = rsqrtf(var + 1e-6f);
            const float y0 = d0 * rs * gam[0] + bet[0], y1 = d1 * rs * gam[1] + bet[1];
            if constexpr (D8_OUT0) *(unsigned short*)((unsigned char*)p.AO + (size_t)(b * SEQ + t0 + wave * 8 + j) * DM + ch) = (unsigned short)(pk4_fp8(siluf_(y0), siluf_(y1), 0.f, 0.f, A8_SCALE) & 0xffffu);
            else *(unsigned*)(p.AO + (size_t)(b * SEQ + t0 + wave * 8 + j) * DM + ch) = pk2(siluf_(y0), siluf_(y1)); }
        __syncthreads();
    }
}
DI unsigned off_b(unsigned row, unsigned ch) { return 256u * row + 16u * (ch ^ (((row & 3u) << 2) | ((row >> 2) & 3u))); }
DI void tr_read4(unsigned a0, unsigned a1, s16x4& r00, s16x4& r01, s16x4& r10, s16x4& r11) {
    asm volatile("ds_read_b64_tr_b16 %0, %4\n\tds_read_b64_tr_b16 %1, %5\n\tds_read_b64_tr_b16 %2, %4 offset:4096\n\tds_read_b64_tr_b16 %3, %5 offset:4096\n\ts_waitcnt lgkmcnt(0)"
                 : "=&v"(r00), "=&v"(r01), "=&v"(r10), "=&v"(r11) : "v"(a0), "v"(a1) : "memory");
}
template <int PASS> DI void attn_wave(const Params& p, LAS unsigned char* vimg, unsigned vb0, unsigned vb1, int lane_, int b, int h, int qbase  ) {
    int lane = lane_; asm volatile("" : "+v"(lane));
    const int c = lane & 31, hh = lane >> 5, srow = lane >> 4, sch = lane & 15;
    constexpr int QS = PASS == 0 ? 16 : 1, NT = PASS == 0 ? 13 : 5;
    const int tq = qbase + QS * c;
    const bf16_t* gb = p.G + (size_t)(b * SEQ) * N_IN0; const bf16_t* kb = p.KVH + (size_t)((b * 8 + h) * 2) * SEQ * 128;
    bf16_t* st_o = p.YB + ((size_t)(b * 8 + h) * SEQ + tq) * 128;
    float* st_ml = (float*)(p.YB + (size_t)NBATCH * 8 * SEQ * 128) + ((size_t)(b * 8 + h) * SEQ + tq) * 2;
    bf16x8 qf[8];
#pragma unroll
    for (int ks = 0; ks < 8; ++ks) qf[ks] = *(const bf16x8*)(gb + (size_t)tq * N_IN0 + 2048 + h * 128 + 16 * ks + 8 * hh);
    const float sc2 = 0.08838834764831845f * 1.4426950408889634f, sl2 = exp2f(-(float)(h + 1)) * 1.4426950408889634f;
    f32x16 o[4]; float m_run, l_run;
    if constexpr (PASS == 0) {
#pragma unroll
        for (int i = 0; i < 4; ++i)
#pragma unroll
            for (int j = 0; j < 16; ++j) o[i][j] = 0.f;
        m_run = -30000.f; l_run = 0.f;
    } else {
#pragma unroll
        for (int c4 = 0; c4 < 4; ++c4)
#pragma unroll
            for (int g4 = 0; g4 < 4; ++g4) { const uint2 v = *(const uint2*)(st_o + 32 * c4 + 8 * g4 + 4 * hh); o[c4][4 * g4] = bflo(v.x); o[c4][4 * g4 + 1] = bfhi(v.x); o[c4][4 * g4 + 2] = bflo(v.y); o[c4][4 * g4 + 3] = bfhi(v.y); }
        const f32x2 ml = *(const f32x2*)st_ml; m_run = ml[0]; l_run = hh == 0 ? ml[1] : 0.f;
    }
    auto tile_geom = [&](int tile, int& d, int& sb) { if constexpr (PASS == 0) { if (tile < 5) { d = 16; sb = qbase - 1024 + 512 * tile; } else { d = 4; sb = qbase - 256 + 128 * (tile - 5); } } else { d = 1; sb = qbase - 64 + 32 * tile; } };
    auto load_k = [&](int tile, bf16x8 (&kf)[8]) { int d, sb; tile_geom(tile, d, sb); int sp = sb + d * c; sp = sp < 0 ? 0 : (sp >= SEQ ? SEQ - 1 : sp);
        const bf16_t* src = kb + (unsigned)(sp * 128 + 8 * hh);
#pragma unroll
        for (int ks = 0; ks < 8; ++ks) kf[ks] = *(const bf16x8*)(src + 16 * ks); };
    auto load_v = [&](int tile, u32x4 (&vv)[8]) { int d, sb; tile_geom(tile, d, sb);
#pragma unroll
        for (int i = 0; i < 8; ++i) { int sp = sb + d * (srow + 4 * i); sp = sp < 0 ? 0 : (sp >= SEQ ? SEQ - 1 : sp); vv[i] = *(const u32x4*)(kb + (unsigned)(SEQ * 128 + sp * 128 + sch * 8)); } };
    bf16x8 kf[8]; u32x4 vv[8];
    load_k(0, kf); load_v(0, vv);
    for (int tile = 0; tile < NT; ++tile) {
        int d, sb; tile_geom(tile, d, sb);
        const int tn = tile < NT - 1 ? tile + 1 : NT - 1;
#pragma unroll
        for (int i = 0; i < 8; ++i) *(LAS u32x4*)(vimg + off_b(srow + 4 * i, sch)) = vv[i];
        load_v(tn, vv);
        f32x16 sacc;
#pragma unroll
        for (int j = 0; j < 16; ++j) sacc[j] = 0.f;
#pragma unroll
        for (int ks = 0; ks < 8; ++ks) sacc = __builtin_amdgcn_mfma_f32_32x32x16_bf16(kf[ks], qf[ks], sacc, 0, 0, 0);
        load_k(tn, kf);
        const float df = (float)d, basef = (float)(sb - tq) + df * (float)(4 * hh);
        const float lo = fmaxf(-64.f * df, -(float)tq), hi = fminf(64.f * df, (float)(SEQ - 1 - tq));
        const float mid = 0.5f * (lo + hi), half = 0.5f * (hi - lo);
        float tmax = -1e30f;
#pragma unroll
        for (int i = 0; i < 16; ++i) { const float deltaf = basef + df * (float)((i & 3) + 8 * (i >> 2));
            const bool valid = __builtin_fabsf(deltaf - mid) <= half;
            const float sv = valid ? sacc[i] * sc2 - sl2 * __builtin_fabsf(deltaf) : -1e30f; sacc[i] = sv; tmax = fmaxf(tmax, sv); }
        tmax = fmaxf(tmax, __shfl_xor(tmax, 32));
        const float m_new = tmax > m_run + 8.0f ? tmax : m_run;
        if (__any(m_new != m_run)) { const float alpha = __builtin_amdgcn_exp2f(m_run - m_new);
            l_run *= alpha;
#pragma unroll
            for (int i = 0; i < 4; ++i) o[i] *= alpha; }
        m_run = m_new;
        float psum = 0.f;
#pragma unroll
        for (int i = 0; i < 16; ++i) { const float pi = __builtin_amdgcn_exp2f(sacc[i] - m_new); psum += pi; sacc[i] = pi; }
        l_run += psum;
        bf16x8 pf[2];
#pragma unroll
        for (int s = 0; s < 2; ++s) { const unsigned w0 = pk2(sacc[8 * s], sacc[8 * s + 1]), w1 = pk2(sacc[8 * s + 2], sacc[8 * s + 3]), w2 = pk2(sacc[8 * s + 4], sacc[8 * s + 5]), w3 = pk2(sacc[8 * s + 6], sacc[8 * s + 7]);
            pf[s] = __builtin_bit_cast(bf16x8, (u32x4){w0, w1, w2, w3}); }
#pragma unroll
        for (int c4 = 0; c4 < 4; ++c4) {
            s16x4 r00, r01, r10, r11; tr_read4(vb0 ^ (unsigned)(c4 << 6), vb1 ^ (unsigned)(c4 << 6), r00, r01, r10, r11);
            const bf16x8 v0 = __builtin_shufflevector(r00, r01, 0, 1, 2, 3, 4, 5, 6, 7), v1 = __builtin_shufflevector(r10, r11, 0, 1, 2, 3, 4, 5, 6, 7);
            o[c4] = __builtin_amdgcn_mfma_f32_32x32x16_bf16(v0, pf[0], o[c4], 0, 0, 0);
            o[c4] = __builtin_amdgcn_mfma_f32_32x32x16_bf16(v1, pf[1], o[c4], 0, 0, 0); }
    }
    const float ltot = l_run + __shfl_xor(l_run, 32);
    if constexpr (PASS == 0) {
#pragma unroll
        for (int c4 = 0; c4 < 4; ++c4)
#pragma unroll
            for (int g4 = 0; g4 < 4; ++g4) *(uint2*)(st_o + 32 * c4 + 8 * g4 + 4 * hh) = make_uint2(pk2(o[c4][4 * g4], o[c4][4 * g4 + 1]), pk2(o[c4][4 * g4 + 2], o[c4][4 * g4 + 3]));
        if (hh == 0) *(f32x2*)st_ml = (f32x2){m_run, ltot};
    } else {
        const float inv = 1.0f / ltot;
        bf16_t* orow = p.AO + (size_t)(b * SEQ + tq) * DM + 1024 + h * 128;
#pragma unroll
        for (int c4 = 0; c4 < 4; ++c4)
#pragma unroll
            for (int g4 = 0; g4 < 4; ++g4) { const int dh = 32 * c4 + 8 * g4 + 4 * hh;
                if constexpr (D8_OUT0) *(unsigned*)((unsigned char*)p.AO + (size_t)(b * SEQ + tq) * DM + 1024 + h * 128 + dh) = pk4_fp8(o[c4][4 * g4] * inv, o[c4][4 * g4 + 1] * inv, o[c4][4 * g4 + 2] * inv, o[c4][4 * g4 + 3] * inv, A8_SCALE);
                else *(uint2*)(orow + dh) = make_uint2(pk2(o[c4][4 * g4] * inv, o[c4][4 * g4 + 1] * inv), pk2(o[c4][4 * g4 + 2] * inv, o[c4][4 * g4 + 3] * inv)); }
    }
}
DI void attention(const Params& p, LAS unsigned char* lds) {
    const int tid = opaque_tid(), wave = __builtin_amdgcn_readfirstlane(tid >> 6), lane = tid & 63, hh = lane >> 5;
    LAS unsigned char* vimg = lds + wave * 8192;
    const unsigned vbase = (unsigned)(uintptr_t)vimg;
    const int q4 = (lane & 15) >> 2, pp = lane & 3, blk = (lane >> 4) & 1;
    const unsigned vb0 = vbase + 256u * (4 * hh + q4) + 16u * ((2 * blk + (pp >> 1)) ^ (hh & 3)) + 8u * (pp & 1) + ((unsigned)q4 << 6);
    const unsigned vb1 = vbase + 256u * (8 + 4 * hh + q4) + 16u * ((2 * blk + (pp >> 1)) ^ ((2 + hh) & 3)) + 8u * (pp & 1) + ((unsigned)q4 << 6);
    for (int u = blockIdx.x; u < 256; u += gridDim.x) {
        const int bh = (u & 7) * 4 + ((u >> 3) >> 3), span = (u >> 3) & 7, h = bh & 7, b = bh >> 3;
#pragma unroll 1
        for (int j = 0; j < 2; ++j) attn_wave<0>(p, vimg, vb0, vb1, lane, b, h, span * 512 + wave * 2 + j);
        asm volatile("s_waitcnt vmcnt(0)" ::: "memory");
        __syncthreads();
#pragma unroll 1
        for (int j = 0; j < 2; ++j) attn_wave<1>(p, vimg, vb0, vb1, lane, b, h, span * 512 + (wave * 2 + j) * 32);
        __syncthreads();
    }
}
DI float om_exp2x(float la, float a) {
    const float x = 2.f * la;
    const float pl = x * (1.f + x * (0.5f + x * (0.16666667f + x * (0.041666668f + x * 0.008333334f))));
    return x > -0.25f ? -pl : 1.f - a * a;
}
DI void lru_conv(const Params& p) {
    const int tid = opaque_tid();
    if (tid < 336) {
        const int ch = tid * 8;
        float cw[4][8], cb[8];
#pragma unroll
        for (int j = 0; j < 4; ++j) { const f32x4 w0 = *(const f32x4*)(p.lru_conv_w + j * LRU_W + ch), w1 = *(const f32x4*)(p.lru_conv_w + j * LRU_W + ch + 4);
            cw[j][0] = w0[0]; cw[j][1] = w0[1]; cw[j][2] = w0[2]; cw[j][3] = w0[3]; cw[j][4] = w1[0]; cw[j][5] = w1[1]; cw[j][6] = w1[2]; cw[j][7] = w1[3]; }
        { const f32x4 b0 = *(const f32x4*)(p.lru_conv_b + ch), b1 = *(const f32x4*)(p.lru_conv_b + ch + 4); cb[0] = b0[0]; cb[1] = b0[1]; cb[2] = b0[2]; cb[3] = b0[3]; cb[4] = b1[0]; cb[5] = b1[1]; cb[6] = b1[2]; cb[7] = b1[3]; }
        for (int run = blockIdx.x; run < T_TOK / 32; run += gridDim.x) {
            const int tok0 = run * 32, t0 = tok0 % SEQ;
            const bf16_t* src = p.G + (size_t)tok0 * N_IN1 + LRU_W + ch;
            u32x4 rows[35];
#pragma unroll
            for (int i = 0; i < 35; ++i) { const int t = t0 - 2 + i; rows[i] = (t >= 0 && t < SEQ) ? *(const u32x4*)(src + (ptrdiff_t)(i - 2) * N_IN1) : (u32x4){0u, 0u, 0u, 0u}; }
#pragma unroll
            for (int i = 0; i < 32; ++i) { float xc[8];
#pragma unroll
                for (int e = 0; e < 8; ++e) xc[e] = cb[e];
#pragma unroll
                for (int j = 0; j < 4; ++j) { const u32x4 xv = rows[i + j];
                    xc[0] += cw[j][0] * bflo(xv[0]); xc[1] += cw[j][1] * bfhi(xv[0]); xc[2] += cw[j][2] * bflo(xv[1]); xc[3] += cw[j][3] * bfhi(xv[1]);
                    xc[4] += cw[j][4] * bflo(xv[2]); xc[5] += cw[j][5] * bfhi(xv[2]); xc[6] += cw[j][6] * bflo(xv[3]); xc[7] += cw[j][7] * bfhi(xv[3]); }
                *(u32x4*)(p.XC + (size_t)(tok0 + i) * LRU_W + ch) = (u32x4){pk2(xc[0], xc[1]), pk2(xc[2], xc[3]), pk2(xc[4], xc[5]), pk2(xc[6], xc[7])}; }
        }
    }
}
DI void lru(const Params& p, LAS unsigned char* lds) {
    const int tid = opaque_tid(), wave = __builtin_amdgcn_readfirstlane(tid >> 6), lane = tid & 63, col = lane & 15, g = lane >> 4;
    LAS unsigned char* wl = lds;
    LAS unsigned char* xs = lds + 36864;
    LAS float* sums = (LAS float*)(lds + 36864 + 86016);
    LAS float* cst = sums + 1920;
    for (int u = blockIdx.x; u < 256; u += gridDim.x) {
        const int b = u >> 6, n = (u >> 2) & 15, qt = u & 3, chq = n * LRU_BW + qt * 42;
        const char* xcb = (const char*)(p.XC + (size_t)(b * SEQ) * LRU_W + n * LRU_BW);
        const bf16_t* gb = p.G + (size_t)(b * SEQ) * N_IN1;
        unsigned poff[6];
#pragma unroll
        for (int i = 0; i < 6; ++i) { const int idx = tid + 512 * i; poff[i] = (unsigned)((idx / 21) * LRU_W + (idx % 21) * 8) * 2u; }
        auto dma_chunk = [&](int chunk, int bsel) { const char* src = xcb + (size_t)chunk * 128 * LRU_W * 2; LAS unsigned char* dst = xs + bsel * 43008 + wave * 1024;
#pragma unroll
            for (int i = 0; i < 5; ++i) __builtin_amdgcn_global_load_lds((const unsigned*)(src + poff[i]), (LAS unsigned*)(dst + i * 8192), 16, 0, 0);
            if (wave < 2) __builtin_amdgcn_global_load_lds((const unsigned*)(src + poff[5]), (LAS unsigned*)(dst + 5 * 8192), 16, 0, 0); };
        for (int dir = 0; dir < 2; ++dir) {
            __syncthreads();
            for (int i = tid; i < 2 * 48 * 24; i += 512) { const int which = i / (48 * 24), r = (i / 24) % 48, ck = i % 24; const int nt = r >> 4, cl = r & 15, ks = ck >> 2, gg = ck & 3;
                *(LAS u32x4*)(wl + ((which * 3 + nt) * 6 + ks) * 1024 + (gg * 16 + cl) * 16) = *(const u32x4*)(p.w_lru + ((((size_t)(dir * 2 + which) * 16 + n) * 4 + qt) * 48 + r) * 192 + ck * 8); }
            if (tid < 48) { const bool valid = tid < 42; const int ch = dir * LRU_W + chq + tid;
                cst[tid] = valid ? -1.44269504f * p.lru_b_a[ch] : 0.f; cst[48 + tid] = valid ? -1.44269504f * p.lru_b_x[ch] : 0.f;
                const float lam = valid ? p.lru_lambda[ch] : 0.f; const float sp = (-lam > 20.f) ? -lam : log1pf(__expf(-lam)); cst[96 + tid] = -8.0f * 1.44269504f * sp; }
            dma_chunk(dir == 0 ? 0 : 31, 0);
            asm volatile("s_waitcnt vmcnt(0)" ::: "memory");
            __syncthreads();
            float cba[3], cbx[3], cex[3];
#pragma unroll
            for (int nt = 0; nt < 3; ++nt) { cba[nt] = cst[nt * 16 + col]; cbx[nt] = cst[48 + nt * 16 + col]; cex[nt] = cst[96 + nt * 16 + col]; }
            bf16x8 breg[3][6];
#pragma unroll
            for (int nt = 0; nt < 3; ++nt)
#pragma unroll
                for (int ks = 0; ks < 6; ++ks) { breg[nt][ks] = *(const LAS bf16x8*)(wl + (nt * 6 + ks) * 1024 + lane * 16); asm volatile("" : "+v"(breg[nt][ks])); }
            const int wpos = dir == 0 ? wave : 7 - wave;
            float carry[3] = {0.f, 0.f, 0.f};
            for (int step = 0; step < 32; ++step) {
                const int c = dir == 0 ? step : 31 - step, c0 = c * 128, par = step & 1;
                const bool has_next = step < 31;
                if (has_next) dma_chunk(dir == 0 ? c + 1 : c - 1, par ^ 1);
                LAS unsigned char* xb = xs + par * 43008;
                uint2 hfv[3] = {make_uint2(0u, 0u), make_uint2(0u, 0u), make_uint2(0u, 0u)}; unsigned short gtv[3][4];
                const uint2* hfp = (const uint2*)p.HF + ((size_t)((u * 32 + c) * 8 + wave) * 3) * 64 + lane;
                const bf16_t* gbw = gb + (size_t)(c0 + wave * 16) * N_IN1 + chq;
                bf16_t* aow = p.AO + (size_t)(b * SEQ + c0 + wave * 16) * LRU_W + chq;
                if (dir == 1) {
#pragma unroll
                    for (int nt = 0; nt < 3; ++nt) { hfv[nt] = hfp[nt * 64];
#pragma unroll
                        for (int r = 0; r < 4; ++r) gtv[nt][r] = (nt * 16 + col < 42) ? gbw[(unsigned)((4 * g + r) * N_IN1 + nt * 16 + col)] : (unsigned short)0; } }
                bf16x8 af[6];
#pragma unroll
                for (int ks = 0; ks < 6; ++ks) { const int ch0 = 32 * ks + 8 * g; const bool kval = ch0 < LRU_BW; const int chl0 = kval ? ch0 : 160;
                    const u32x4 xv = *(const LAS u32x4*)(xb + (wave * 16 + col) * 336 + chl0 * 2);
                    af[ks] = __builtin_bit_cast(bf16x8, kval ? xv : (u32x4){0u, 0u, 0u, 0u}); }
                f32x4 acc[2][3];
                {
                    bf16x8 bl[6];
                    const LAS unsigned char* wl1 = wl + 18 * 1024 + lane * 16;
#pragma unroll
                    for (int ks = 0; ks < 6; ++ks) bl[ks] = *(const LAS bf16x8*)(wl1 + ks * 1024);
#pragma unroll
                    for (int nt = 0; nt < 3; ++nt) {
                        acc[0][nt] = (f32x4){0.f, 0.f, 0.f, 0.f}; acc[1][nt] = (f32x4){0.f, 0.f, 0.f, 0.f};
#pragma unroll
                        for (int ks = 0; ks < 6; ++ks) acc[0][nt] = __builtin_amdgcn_mfma_f32_16x16x32_bf16(af[ks], breg[nt][ks], acc[0][nt], 0, 0, 0);
#pragma unroll
                        for (int ks = 0; ks < 6; ++ks) { acc[1][nt] = __builtin_amdgcn_mfma_f32_16x16x32_bf16(af[ks], bl[ks], acc[1][nt], 0, 0, 0);
                            if (nt < 2) bl[ks] = *(const LAS bf16x8*)(wl1 + ((nt + 1) * 6 + ks) * 1024); }
                    }
                }
                float hl[3][4], Pl[3][4];
#pragma unroll
                for (int nt = 0; nt < 3; ++nt) { const int chl = nt * 16 + col;
                    float av[4], uv[4];
#pragma unroll
                    for (int r = 0; r < 4; ++r) {
                        const float rg = __builtin_amdgcn_rcpf(1.0f + __builtin_amdgcn_exp2f(__builtin_fmaf(acc[0][nt][r], -1.44269504f, cba[nt])));
                        const float ig = __builtin_amdgcn_rcpf(1.0f + __builtin_amdgcn_exp2f(__builtin_fmaf(acc[1][nt][r], -1.44269504f, cbx[nt])));
                        const float a = __builtin_amdgcn_exp2f(cex[nt] * rg);
                        const float xcv = bf2f(*(const LAS bf16_t*)(xb + (wave * 16 + 4 * g + r) * 336 + (qt * 42 + chl) * 2));
                        av[r] = a; uv[r] = __builtin_amdgcn_sqrtf(__builtin_fmaf(-a, a, 1.0f)) * (ig * xcv); }
                    float h[4], P[4], A, H;
                    if (dir == 0) { h[0] = uv[0]; P[0] = av[0];
#pragma unroll
                        for (int r = 1; r < 4; ++r) { h[r] = av[r] * h[r - 1] + uv[r]; P[r] = av[r] * P[r - 1]; }
                        A = P[3]; H = h[3];
                        { const float A1 = __shfl_up(A, 16), H1 = __shfl_up(H, 16); if (g >= 1) { H = A * H1 + H; A = A * A1; } }
                        { const float A2 = __shfl_up(A, 32), H2 = __shfl_up(H, 32); if (g >= 2) { H = A * H2 + H; A = A * A2; } }
                        float Ae = __shfl_up(A, 16), He = __shfl_up(H, 16); if (g == 0) { Ae = 1.f; He = 0.f; }
#pragma unroll
                        for (int r = 0; r < 4; ++r) { hl[nt][r] = h[r] + P[r] * He; Pl[nt][r] = P[r] * Ae; }
                        if (g == 3) *(LAS f32x2*)(sums + (par * 48 + chl) * 20 + wpos * 2) = (f32x2){A, H};
                    } else { h[3] = uv[3]; P[3] = av[3];
#pragma unroll
                        for (int r = 2; r >= 0; --r) { h[r] = av[r] * h[r + 1] + uv[r]; P[r] = av[r] * P[r + 1]; }
                        A = P[0]; H = h[0];
                        { const float A1 = __shfl_down(A, 16), H1 = __shfl_down(H, 16); if (g <= 2) { H = A * H1 + H; A = A * A1; } }
                        { const float A2 = __shfl_down(A, 32), H2 = __shfl_down(H, 32); if (g <= 1) { H = A * H2 + H; A = A * A2; } }
                        float Ae = __shfl_down(A, 16), He = __shfl_down(H, 16); if (g == 3) { Ae = 1.f; He = 0.f; }
#pragma unroll
                        for (int r = 0; r < 4; ++r) { hl[nt][r] = h[r] + P[r] * He; Pl[nt][r] = P[r] * Ae; }
                        if (g == 0) *(LAS f32x2*)(sums + (par * 48 + chl) * 20 + wpos * 2) = (f32x2){A, H};
                    }
                }
                asm volatile("s_waitcnt vmcnt(0)" ::: "memory");
                __syncthreads();
                f32x4 sv[3][4];
#pragma unroll
                for (int nt = 0; nt < 3; ++nt)
#pragma unroll
                    for (int j = 0; j < 4; ++j) sv[nt][j] = *(const LAS f32x4*)(sums + (par * 48 + nt * 16 + col) * 20 + j * 4);
#pragma unroll
                for (int nt = 0; nt < 3; ++nt) { const int chl = nt * 16 + col; float C = carry[nt], Cw = 0.f;
#pragma unroll
                    for (int k = 0; k < 8; ++k) { if (k == wpos) Cw = C; C = sv[nt][k >> 1][(k & 1) * 2] * C + sv[nt][k >> 1][(k & 1) * 2 + 1]; }
                    carry[nt] = C;
                    float hv[4];
#pragma unroll
                    for (int r = 0; r < 4; ++r) hv[r] = hl[nt][r] + Pl[nt][r] * Cw;
                    if (dir == 0) ((uint2*)p.HF)[((size_t)((u * 32 + c) * 8 + wave) * 3 + nt) * 64 + lane] = make_uint2(pk2(hv[0], hv[1]), pk2(hv[2], hv[3]));
                    else if (chl < 42) { const float ff[4] = {bflo(hfv[nt].x), bfhi(hfv[nt].x), bflo(hfv[nt].y), bfhi(hfv[nt].y)};
#pragma unroll
                        for (int r = 0; r < 4; ++r) aow[(unsigned)((4 * g + r) * LRU_W + chl)] = f2bf(bf2f(gtv[nt][r]) * (ff[r] + hv[r])); }
                }
            }
        }
    }
}
}

#define XB_TMO      128
#define XB_XCNT(j)  (256  + 64 * (j))
#define XB_XSUB(j)  (1280 + 64 * (j))
#define XB_XGEN(j)  (2304 + 64 * (j))
#define XB_TOP      3328
#define XB_TOPGEN   3392
#define XCD_BAR_WORDS 3456
#define XB_SPIN_CAP (1u << 18)

__device__ __forceinline__ unsigned xb_ld(unsigned* p)              { return __hip_atomic_load(p, __ATOMIC_RELAXED, __HIP_MEMORY_SCOPE_AGENT); }
__device__ __forceinline__ unsigned xb_add(unsigned* p, unsigned v) { return __hip_atomic_fetch_add(p, v, __ATOMIC_RELAXED, __HIP_MEMORY_SCOPE_AGENT); }
__device__ __forceinline__ unsigned xb_xcc_id() { return (unsigned)__builtin_amdgcn_s_getreg((3 << 11) | 20) & 0xFu; }
#define XB_SPIN(cond, bar) do { unsigned _sp = 0; while (cond) { __builtin_amdgcn_s_sleep(1); \
    if ((++_sp & 255u) == 0u) { if (xb_ld(&(bar)[XB_TMO])) break; if (_sp > XB_SPIN_CAP) { atomicAdd(&(bar)[XB_TMO], 1u); break; } } } } while (0)

struct XcdBarrier {
    unsigned* bar; unsigned x;
    volatile LAS unsigned* st;
};

__device__ __forceinline__ XcdBarrier xcd_barrier_post(unsigned* bar, volatile LAS unsigned* st) {
    XcdBarrier b; b.bar = bar; b.x = xb_xcc_id(); b.st = st;
    if (threadIdx.x == 0) (void)xb_add(&bar[XB_XCNT(b.x)], 1u);
    return b;
}
__device__ __forceinline__ void xcd_barrier_complete(unsigned* bar, unsigned x, unsigned& nloc, unsigned& nx) {
    const unsigned G = gridDim.x * gridDim.y * gridDim.z;
    unsigned sum, cnt, mine, sp = 0u;
    for (;;) {
        sum = 0u; cnt = 0u; mine = 0u;
#pragma unroll
        for (unsigned j = 0; j < 16; ++j) { const unsigned c = xb_ld(&bar[XB_XCNT(j)]); sum += c; cnt += (c > 0u) ? 1u : 0u; mine = (j == x) ? c : mine; }
        if (sum == G) break;
        __builtin_amdgcn_s_sleep(1);
        if ((++sp & 255u) == 0u) { if (xb_ld(&bar[XB_TMO])) break; if (sp > XB_SPIN_CAP) { atomicAdd(&bar[XB_TMO], 1u); break; } }
    }
    nloc = mine > 0u ? mine : 1u; nx = cnt > 0u ? cnt : 1u;
}

__device__ __forceinline__ void xcd_barrier(const XcdBarrier& b) {
    asm volatile("s_waitcnt vmcnt(0)" ::: "memory");
    __syncthreads();
    if (threadIdx.x == 0) {
        unsigned* bar = b.bar;
        __builtin_amdgcn_s_waitcnt(0);
        unsigned nloc = b.st[0], nx = b.st[1];
        if (nloc == 0u) { xcd_barrier_complete(bar, b.x, nloc, nx); b.st[0] = nloc; b.st[1] = nx; }
        const unsigned old = xb_add(&bar[XB_XSUB(b.x)], 1u);
        const unsigned gen = old / nloc;
        if (old + 1u == (gen + 1u) * nloc) {
            __builtin_amdgcn_fence(__ATOMIC_RELEASE, "agent");
            asm volatile("s_waitcnt vmcnt(0)" ::: "memory");
            const unsigned og = xb_add(&bar[XB_TOP], 1u);
            const unsigned tg = og / nx;
            if (og + 1u == (tg + 1u) * nx) xb_add(&bar[XB_TOPGEN], 1u);
            else XB_SPIN(xb_ld(&bar[XB_TOPGEN]) == tg, bar);
            __builtin_amdgcn_fence(__ATOMIC_ACQUIRE, "agent");
            xb_add(&bar[XB_XGEN(b.x)], 1u);
            asm volatile("s_waitcnt vmcnt(0)" ::: "memory");
        } else {
            XB_SPIN(xb_ld(&bar[XB_XGEN(b.x)]) == gen, bar);
            __builtin_amdgcn_fence(__ATOMIC_ACQUIRE, "agent");
            asm volatile("s_waitcnt vmcnt(0)" ::: "memory");
        }
    }
    __syncthreads();
}


constexpr int PROBE = 0;
constexpr int LDS_XB_OFF = gm::STAGE_BYTES + 1024;
constexpr int LDS_TOTAL = LDS_XB_OFF + 16;
__global__ void __launch_bounds__(512, 2) mega(Params p) {
    LAS unsigned char* lds = (LAS unsigned char*)dyn_smem;
    LAS int* tab = (LAS int*)(lds + gm::TAB_OFF);
    volatile LAS unsigned* xbw = (volatile LAS unsigned*)(lds + LDS_XB_OFF);
    if (threadIdx.x == 0) { xbw[0] = 0u; xbw[1] = 0u; xbw[2] = 0u; xbw[3] = 0u; }
    __syncthreads();
    XcdBarrier bar = xcd_barrier_post(p.bar, xbw);
    ph::mods(p, lds);
    if constexpr (PROBE == 14) { ph::mods(p, lds); ph::mods(p, lds); }
    xcd_barrier(bar);
    { const int c = blockIdx.x, G = gridDim.x;
      ph::transposer(p, lds, c, c < 320 ? (320 - c + G - 1) / G : 0, G); __syncthreads();
      ph::transposer(p, lds, 320 + c, c < 632 ? (632 - c + G - 1) / G : 0, G); __syncthreads(); }
    ph::lru_weights(p);
    ph::fold_router(p);
    ph::norm_rows<0, D8_IN0>(p, p.x, p.norm0_mix, 0, 0, nullptr);
    xcd_barrier(bar);
    { const int c = blockIdx.x, G = gridDim.x; const int tcount = c < 6144 ? (6144 - c + G - 1) / G : 0; const bool t_first = ((c >> 3) & 1) != 0;
      if (t_first) { ph::transposer(p, lds, 952 + c, tcount, G); __syncthreads(); }
      { gm::DenseSched S; S.init(T_TOK, N_IN0); EpiIn0 e; e.xin = nullptr; e.lgate = 0; if constexpr (D8_IN0) gm::gemm_phase<EpiIn0, gm::DenseSched, true>(lds, p, p.H, p.w_in0t, 0, DM / 2, S, e, W8_E8M0, A8_E8M0); else gm::gemm_phase(lds, p, p.H, p.w_in0t, 0, DM, S, e); }
      if (!t_first) { __syncthreads(); ph::transposer(p, lds, 952 + c, tcount, G); }
      if constexpr (PROBE == 21) { __syncthreads(); ph::transposer(p, lds, 952 + c, tcount, G); }
      if constexpr (PROBE == 24) { __syncthreads(); if (t_first) ph::transposer(p, lds, 952 + c, tcount, G); }
      if constexpr (PROBE == 23) { __syncthreads(); if (t_first) { ph::transposer(p, lds, 952 + c, tcount, G); __syncthreads(); }
        { gm::DenseSched S; S.init(T_TOK, N_IN0); EpiIn0 e; e.xin = nullptr; e.lgate = 0; gm::gemm_phase<EpiIn0, gm::DenseSched, true>(lds, p, p.H, p.w_in0t, 0, DM / 2, S, e, W8_E8M0, A8_E8M0); }
        if (!t_first) { __syncthreads(); ph::transposer(p, lds, 952 + c, tcount, G); } }
      if constexpr (PROBE == 20) { __syncthreads(); gm::DenseSched S; S.init(T_TOK, N_IN0); EpiIn0 e; e.xin = nullptr; e.lgate = 0; gm::gemm_phase<EpiIn0, gm::DenseSched, true>(lds, p, p.H, p.w_in0t, 0, DM / 2, S, e, W8_E8M0, A8_E8M0); } }
    xcd_barrier(bar);
    ph::attention(p, lds);
    if constexpr (PROBE == 4) ph::attention(p, lds);
    __syncthreads();
    ph::conv_gln(p, lds);
    if constexpr (PROBE == 5) ph::conv_gln(p, lds);
    xcd_barrier(bar);
    { gm::DenseSched S; S.init(T_TOK, DM); EpiOutT<true> e; e.xin = p.x; e.lgate = 0; if constexpr (D8_OUT0) gm::gemm_phase<EpiOutT<true>, gm::DenseSched, true>(lds, p, p.AO, p.w_out0t, 0, DM / 2, S, e, W8_E8M0, A8_E8M0); else gm::gemm_phase(lds, p, p.AO, p.w_out0t, 0, DM, S, e); }
    xcd_barrier(bar);
    ph::router<false, true>(p, 0, lds, p.norm0_ffn, 1);
    if constexpr (PROBE == 12) { ph::router<true>(p, 0, lds); ph::router<true>(p, 0, lds); }
    xcd_barrier(bar);
    if constexpr (PROBE == 11) { xcd_barrier(bar); xcd_barrier(bar); xcd_barrier(bar); xcd_barrier(bar); xcd_barrier(bar); xcd_barrier(bar); xcd_barrier(bar); xcd_barrier(bar); xcd_barrier(bar); xcd_barrier(bar); }
    gm::moe_tables(tab, p.cnt);
    { gm::MoeSched<true> S; S.init(tab); EpiGU e; e.xin = nullptr; e.lgate = 0; gm::gemm_phase<EpiGU, gm::MoeSched<true>, true>(lds, p, p.H, p.w_gut0, (size_t)2048 * (DM / 2), DM / 2, S, e, W8_E8M0, A8_E8M0); if constexpr (PROBE == 3) gm::gemm_phase<EpiGU, gm::MoeSched<true>, true>(lds, p, p.H, p.w_gut0, (size_t)2048 * (DM / 2), DM / 2, S, e, W8_E8M0, A8_E8M0); }
    xcd_barrier(bar);
    { gm::MoeSched<false> S; S.init(tab); EpiDown e; e.xin = nullptr; e.lgate = 0; gm::gemm_phase<EpiDown, gm::MoeSched<false>, true>(lds, p, p.ACT, p.w_dt0, (size_t)DM * (EFF / 2), EFF / 2, S, e, W8_E8M0, A8_E8M0); if constexpr (PROBE == 8) gm::gemm_phase<EpiDown, gm::MoeSched<false>, true>(lds, p, p.ACT, p.w_dt0, (size_t)DM * (EFF / 2), EFF / 2, S, e, W8_E8M0, A8_E8M0); }
    xcd_barrier(bar);
    ph::norm_rows<1, D8_IN1>(p, nullptr, p.norm1_mix, 2, 1, tab);
    xcd_barrier(bar);
    { const int c = blockIdx.x, G = gridDim.x; int tfirst, tcount, tstride;
      if (G == 256) { tstride = 1; if (c < 64) { tcount = 18; tfirst = 18 * c; } else { tcount = 26; tfirst = 1152 + 26 * (c - 64); } }
      else { tstride = G; tfirst = c; tcount = c < 6144 ? (6144 - c + G - 1) / G : 0; }
      const bool t_first = ((c >> 3) & 1) != 0;
      if (t_first) { ph::transposer(p, lds, 7096 + tfirst, tcount, tstride); __syncthreads(); }
      { gm::DenseSched S; S.init(T_TOK, N_IN1); EpiIn1 e; e.xin = nullptr; e.lgate = 0; gm::gemm_phase(lds, p, p.H, p.w_in1t, 0, DM, S, e); }
      if (!t_first) { __syncthreads(); ph::transposer(p, lds, 7096 + tfirst, tcount, tstride); } }
    xcd_barrier(bar);
    ph::lru_conv(p);
    if constexpr (PROBE == 9) { ph::lru_conv(p); ph::lru_conv(p); }
    xcd_barrier(bar);
    ph::lru(p, lds);
    if constexpr (PROBE == 6) ph::lru(p, lds);
    xcd_barrier(bar);
    { gm::DenseSched S; S.init(T_TOK, DM); EpiOutT<false> e; e.xin = nullptr; e.lgate = 2; gm::gemm_phase(lds, p, p.AO, p.w_out1t, 0, LRU_W, S, e); }
    xcd_barrier(bar);
    ph::router<false, true>(p, 1, lds, p.norm1_ffn, 3);
    xcd_barrier(bar);
    gm::moe_tables(tab, p.cnt + 32);
    { gm::MoeSched<true> S; S.init(tab); EpiGU e; e.xin = nullptr; e.lgate = 0; gm::gemm_phase<EpiGU, gm::MoeSched<true>, true>(lds, p, p.H, p.w_gut1, (size_t)2048 * (DM / 2), DM / 2, S, e, W8_E8M0, A8_E8M0); }
    xcd_barrier(bar);
    { gm::MoeSched<false> S; S.init(tab); EpiDown e; e.xin = nullptr; e.lgate = 0; gm::gemm_phase<EpiDown, gm::MoeSched<false>, true>(lds, p, p.ACT, p.w_dt1, (size_t)DM * (EFF / 2), EFF / 2, S, e, W8_E8M0, A8_E8M0); }
    xcd_barrier(bar);
    ph::norm_rows<2>(p, nullptr, p.norm_final, 0, 3, tab);
}

static inline size_t al256(size_t x) { return (x + 255) & ~(size_t)255; }

extern "C" void kernel_launch(void* const* d_in, const int* in_sizes, int n_in, void* d_out, int out_size, void* d_ws, size_t ws_size, hipStream_t stream) {
    Params p{};
    const float** ip = (const float**)&p.x;
    for (int i = 0; i < 38; ++i) ip[i] = (const float*)d_in[i];
    p.out = (float*)d_out;
    char* w = (char*)d_ws; size_t off = 0;
    auto take = [&](size_t bytes) { char* r = w + off; off += al256(bytes); return r; };
    p.bar = (unsigned*)take(16384); p.cnt = (int*)take(256);
    const size_t zero_bytes = off;
    p.mod = (float*)take(4 * 4 * 6144 * 4); p.wrt = (bf16_t*)take((size_t)2 * 4 * 3 * 48 * 2048 * 2); p.rbias = (float*)take(2 * 4 * 48 * 4);
    p.w_in0t = (bf16_t*)take((size_t)N_IN0 * DM * 2); p.w_out0t = (bf16_t*)take((size_t)DM * DM * 2);
    p.w_gut0 = (bf16_t*)take((size_t)NEXP * 2048 * DM); p.w_dt0 = (bf16_t*)take((size_t)NEXP * DM * EFF);
    p.w_in1t = (bf16_t*)take((size_t)N_IN1 * DM * 2); p.w_out1t = (bf16_t*)take((size_t)DM * LRU_W * 2);
    p.w_gut1 = (bf16_t*)take((size_t)NEXP * 2048 * DM); p.w_dt1 = (bf16_t*)take((size_t)NEXP * DM * EFF);
    p.w_lru = (bf16_t*)take((size_t)2 * 2 * 16 * 2 * 96 * 192 * 2);
    p.H = (bf16_t*)take((size_t)T_TOK * DM * 2); p.G = (bf16_t*)take((size_t)T_TOK * N_IN1 * 2); p.AO = (bf16_t*)take((size_t)T_TOK * LRU_W * 2); p.HF = (bf16_t*)take((size_t)256 * 32 * 8 * 3 * 64 * 8);
    p.XA = (bf16_t*)take((size_t)T_TOK * DM * 2); p.ACT = (bf16_t*)take((size_t)ROWS_PAD * EFF * 2); p.YB = (bf16_t*)take((size_t)ROWS_PAD * DM * 2);
    p.XC = (bf16_t*)take((size_t)T_TOK * LRU_W * 2); p.KVH = (bf16_t*)take((size_t)NBATCH * 8 * 2 * SEQ * 128 * 2);
    p.tokl = (int*)take((size_t)NEXP * ECAP * 4); p.gatel = (float*)take((size_t)NEXP * ECAP * 4); p.asg = (int*)take((size_t)T_TOK * 2 * 4);
    if (off > ws_size) return;
    (void)hipMemsetAsync(d_ws, 0, zero_bytes, stream);
    static int grid = 0;
    if (!grid) { int dev = 0, cus = 0, per_cu = 0; (void)hipGetDevice(&dev); (void)hipDeviceGetAttribute(&cus, hipDeviceAttributeMultiprocessorCount, dev);
        (void)hipFuncSetAttribute((const void*)mega, hipFuncAttributeMaxDynamicSharedMemorySize, LDS_TOTAL);
        (void)hipOccupancyMaxActiveBlocksPerMultiprocessor(&per_cu, mega, 512, LDS_TOTAL);
        grid = cus * (per_cu < 1 ? per_cu : 1); }
    if (grid > 0) mega<<<grid, 512, LDS_TOTAL, stream>>>(p);
}
```

```cpp
#include <hip/hip_runtime.h>
#include <stdint.h>

typedef unsigned short bf16_t;
typedef float f32x4 __attribute__((ext_vector_type(4)));

#define DI __device__ __forceinline__

constexpr int T_TOK = 16384, DM = 2048, SEQ = 4096, NBATCH = 4;
constexpr int N_IN0 = 5120, N_IN1 = 5376, LRU_W = 2688, LRU_BW = 168;
constexpr int NEXP = 32, EFF = 1024, ECAP = 16384, ROWS_PAD = 40960;

DI float bf2f(bf16_t b) { return __uint_as_float(((unsigned)b) << 16); }
DI bf16_t f2bf(float f) { unsigned u = __float_as_uint(f); u += 0x7FFFu + ((u >> 16) & 1u); return (bf16_t)(u >> 16); }
DI float sigmoidf_(float x) { return __builtin_amdgcn_rcpf(1.0f + __expf(-x)); }
DI float siluf_(float x) { return x * __builtin_amdgcn_rcpf(1.0f + __expf(-x)); }
DI float gelu_tanh(float x) { const float u = 0.7978845608028654f * (x + 0.044715f * x * x * x); return x * __builtin_amdgcn_rcpf(1.0f + __expf(-2.0f * u)); }
DI float wave_sum(float v) { for (int o = 32; o > 0; o >>= 1) v += __shfl_xor(v, o); return v; }
DI float wave_max(float v) { for (int o = 32; o > 0; o >>= 1) v = fmaxf(v, __shfl_xor(v, o)); return v; }

struct Params {
    const float *x, *c;
    const float *norm0_mix, *ada0_mix_w, *ada0_mix_b, *w_in0, *conv_w, *conv_b, *conv_norm_g, *conv_norm_b, *w_out0;
    const float *norm0_ffn, *ada0_ffn_w, *ada0_ffn_b, *moe0_w_group, *moe0_w_expert, *moe0_w_gate_up, *moe0_w_down;
    const float *norm1_mix, *ada1_mix_w, *ada1_mix_b, *w_in1, *lru_conv_w, *lru_conv_b, *lru_w_a, *lru_b_a, *lru_w_x, *lru_b_x, *lru_lambda, *w_out1;
    const float *norm1_ffn, *ada1_ffn_w, *ada1_ffn_b, *moe1_w_group, *moe1_w_expert, *moe1_w_gate_up, *moe1_w_down;
    const float *norm_final;
    float* out;
    unsigned* bar; int* cnt;
    float* mod;
    bf16_t* wrt;
    float* rbias;
    bf16_t *w_in0t, *w_out0t, *w_gut0, *w_dt0, *w_in1t, *w_out1t, *w_gut1, *w_dt1, *w_lru;
    bf16_t *H, *G, *AO, *HF, *ACT, *YB, *XC, *KVH;
    bf16_t* XA;
    int* tokl; float* gatel; int* asg;
};

constexpr bool YB8_E = true;
struct GUnit { int rowbase; int nvalid; int e; const int* gather; };
struct GArgs { const bf16_t* A; const bf16_t* Bt; size_t bt_estride; long long lda, K, moe_layer; const float* xin; long long lgate; };
typedef unsigned u32x4_ __attribute__((ext_vector_type(4)));
typedef __bf16 bf2v_ __attribute__((ext_vector_type(2)));
typedef float f32x2_ __attribute__((ext_vector_type(2)));
DI unsigned pk2e(float a, float b) { f32x2_ v = {a, b}; bf2v_ r = __builtin_convertvector(v, bf2v_); return __builtin_bit_cast(unsigned, r); }
DI u32x4_ pack8(f32x4 a, f32x4 b) { return (u32x4_){pk2e(a[0], a[1]), pk2e(a[2], a[3]), pk2e(b[0], b[1]), pk2e(b[2], b[3])}; }
struct EpiIn0 { static constexpr bool GATHER = false, PRE = false; const float* xin; int lgate; DI void operator()(const Params& p, const GUnit& u, int r, int col0, f32x4 lo0, f32x4 lo1, f32x4 hi0, f32x4 hi1) const {
    const int row = u.rowbase + r;
    if (col0 < 3072) { bf16_t* o = p.G + (size_t)row * N_IN0 + col0; *(u32x4_*)o = pack8(lo0, lo1); *(u32x4_*)(o + 128) = pack8(hi0, hi1); }
    else { const int b = row / SEQ, t = row % SEQ, i0 = (col0 - 3072) >> 7, i1 = i0 + 1;
        bf16_t* o0 = p.KVH + ((size_t)((b * 8 + (i0 & 7)) * 2 + (i0 >> 3)) * SEQ + t) * 128 + (col0 & 127);
        bf16_t* o1 = p.KVH + ((size_t)((b * 8 + (i1 & 7)) * 2 + (i1 >> 3)) * SEQ + t) * 128 + (col0 & 127);
        *(u32x4_*)o0 = pack8(lo0, lo1); *(u32x4_*)o1 = pack8(hi0, hi1); } } };
template <bool F32RES> struct EpiOutT { static constexpr bool GATHER = false, PRE = true; const float* xin; int lgate;
    struct UPre { f32x4 g0, g1, g2, g3; };
    struct Pre { f32x4 x0, x1, x2, x3; u32x4_ a, c; };
    DI UPre unit_pre(const Params& p, const GUnit& u, int col0) const { const int b = u.rowbase / SEQ; const float* gt = p.mod + (lgate * 4 + b) * 6144 + 4096 + col0;
        UPre q; q.g0 = *(const f32x4*)gt; q.g1 = *(const f32x4*)(gt + 4); q.g2 = *(const f32x4*)(gt + 128); q.g3 = *(const f32x4*)(gt + 132); return q; }
    DI Pre pre(const Params& p, const GUnit& u, int r, int col0) const { const size_t off = (size_t)(u.rowbase + r) * DM + col0; Pre q;
        if constexpr (F32RES) { const float* xi = xin + off; q.x0 = *(const f32x4*)xi; q.x1 = *(const f32x4*)(xi + 4); q.x2 = *(const f32x4*)(xi + 128); q.x3 = *(const f32x4*)(xi + 132); }
        else { const bf16_t* o = p.XA + off; q.a = *(const u32x4_*)o; q.c = *(const u32x4_*)(o + 128); }
        return q; }
    DI void fin(const Params& p, const GUnit& u, int r, int col0, const UPre& g, const Pre& q, f32x4 lo0, f32x4 lo1, f32x4 hi0, f32x4 hi1) const {
        bf16_t* o = p.XA + (size_t)(u.rowbase + r) * DM + col0;
        f32x4 r0, r1, r2, r3;
        if constexpr (F32RES) { r0 = q.x0; r1 = q.x1; r2 = q.x2; r3 = q.x3; }
        else { const u32x4_ a = q.a, c = q.c;
            r0 = (f32x4){__uint_as_float(a[0] << 16), __uint_as_float(a[0] & 0xffff0000u), __uint_as_float(a[1] << 16), __uint_as_float(a[1] & 0xffff0000u)};
            r1 = (f32x4){__uint_as_float(a[2] << 16), __uint_as_float(a[2] & 0xffff0000u), __uint_as_float(a[3] << 16), __uint_as_float(a[3] & 0xffff0000u)};
            r2 = (f32x4){__uint_as_float(c[0] << 16), __uint_as_float(c[0] & 0xffff0000u), __uint_as_float(c[1] << 16), __uint_as_float(c[1] & 0xffff0000u)};
            r3 = (f32x4){__uint_as_float(c[2] << 16), __uint_as_float(c[2] & 0xffff0000u), __uint_as_float(c[3] << 16), __uint_as_float(c[3] & 0xffff0000u)}; }
        *(u32x4_*)o = pack8(r0 + g.g0 * lo0, r1 + g.g1 * lo1); *(u32x4_*)(o + 128) = pack8(r2 + g.g2 * hi0, r3 + g.g3 * hi1); } };
DI unsigned pk4_fp8e(float a, float b, float c, float d, float sc) { a = fminf(fmaxf(a * sc, -448.f), 448.f); b = fminf(fmaxf(b * sc, -448.f), 448.f); c = fminf(fmaxf(c * sc, -448.f), 448.f); d = fminf(fmaxf(d * sc, -448.f), 448.f);
    unsigned w = 0u; w = __builtin_amdgcn_cvt_pk_fp8_f32(a, b, w, false); w = __builtin_amdgcn_cvt_pk_fp8_f32(c, d, w, true); return w; }
struct EpiGU { static constexpr bool GATHER = true, PRE = false; const float* xin; int lgate; DI void operator()(const Params& p, const GUnit& u, int r, int col0, f32x4 lo0, f32x4 lo1, f32x4 hi0, f32x4 hi1) const {
    f32x4 a0, a1;
#pragma unroll
    for (int j = 0; j < 4; ++j) { a0[j] = siluf_(lo0[j]) * hi0[j]; a1[j] = siluf_(lo1[j]) * hi1[j]; }
    *(uint2*)((unsigned char*)p.ACT + (size_t)(u.rowbase + r) * EFF + (col0 >> 8) * 128 + (col0 & 127)) = make_uint2(pk4_fp8e(a0[0], a0[1], a0[2], a0[3], 8.f), pk4_fp8e(a1[0], a1[1], a1[2], a1[3], 8.f)); } };
struct EpiDown { static constexpr bool GATHER = false, PRE = true; const float* xin; int lgate;
    struct UPre { int none; };
    struct Pre { float g; };
    DI UPre unit_pre(const Params&, const GUnit&, int) const { return UPre{0}; }
    DI Pre pre(const Params& p, const GUnit& u, int r, int) const { return Pre{p.gatel[(u.gather - p.tokl) + r]}; }
    DI void fin(const Params& p, const GUnit& u, int r, int col0, const UPre&, const Pre& q, f32x4 lo0, f32x4 lo1, f32x4 hi0, f32x4 hi1) const {
    const float g = q.g;
    if constexpr (YB8_E) { const float gs = g * 64.f; unsigned char* o = (unsigned char*)p.YB + (size_t)(u.rowbase + r) * DM + col0;
        *(uint2*)o = make_uint2(pk4_fp8e(lo0[0], lo0[1], lo0[2], lo0[3], gs), pk4_fp8e(lo1[0], lo1[1], lo1[2], lo1[3], gs)); *(uint2*)(o + 128) = make_uint2(pk4_fp8e(hi0[0], hi0[1], hi0[2], hi0[3], gs), pk4_fp8e(hi1[0], hi1[1], hi1[2], hi1[3], gs)); }
    else { bf16_t* o = p.YB + (size_t)(u.rowbase + r) * DM + col0; *(u32x4_*)o = pack8(lo0 * g, lo1 * g); *(u32x4_*)(o + 128) = pack8(hi0 * g, hi1 * g); } } };
struct EpiIn1 { static constexpr bool GATHER = false, PRE = false; const float* xin; int lgate; DI void operator()(const Params& p, const GUnit& u, int r, int col0, f32x4 lo0, f32x4 lo1, f32x4 hi0, f32x4 hi1) const {
    bf16_t* o = p.G + (size_t)(u.rowbase + r) * N_IN1 + col0;
    if (col0 < LRU_W) {
#pragma unroll
        for (int j = 0; j < 4; ++j) { lo0[j] = gelu_tanh(lo0[j]); lo1[j] = gelu_tanh(lo1[j]); } }
    if (col0 + 128 < LRU_W) {
#pragma unroll
        for (int j = 0; j < 4; ++j) { hi0[j] = gelu_tanh(hi0[j]); hi1[j] = gelu_tanh(hi1[j]); } }
    *(u32x4_*)o = pack8(lo0, lo1); *(u32x4_*)(o + 128) = pack8(hi0, hi1); } };

#define LAS __attribute__((address_space(3)))
typedef short bf16x8 __attribute__((ext_vector_type(8)));
DI int opaque_tid() { int t = threadIdx.x; asm volatile("" : "+v"(t)); return t; }
namespace gm {
constexpr int BM = 256, BK = 64, HALF = 128, HTB = HALF * BK * 2, STAGE_BYTES = 8 * HTB, NXCD = 8, WGM = 4;
constexpr int TAB_OFF = STAGE_BYTES;
DI int lds_byte(int r, int c) { const int st = (r >> 4) * 2 + (c >> 5), rr = r & 15, cc = c & 31, ob = rr * 64 + cc * 2; return st * 1024 + (ob ^ (((ob >> 9) & 1) << 5)); }
DI int perm32(int rho) { const int n = rho >> 4, i = rho & 15; return 8 * (i >> 2) + 4 * n + (i & 3); }
DI void stage_rc(int b, int& R, int& C) { const int st = b / 1024, sb = b % 1024, swz = sb ^ (((sb >> 9) & 1) << 5); R = (st >> 1) * 16 + swz / 64; C = (st & 1) * 32 + (swz % 64) / 2; }
struct Unit { int arow, nvalid, orow, pn, e, goff; };
struct DenseSched {
    static constexpr bool GATHER = false, HALF_SKIP = false;
    int nM, nN, nwg, G, c;
    DI void init(int M, int N) { nM = M / BM; nN = N / BM; nwg = nM * nN; G = gridDim.x; c = blockIdx.x; }
    DI bool next(int i, Unit& u) const {
        const long L = (long)i * G + c; if (L >= nwg) return false;
        int wgid = (int)L; { const int q = nwg / NXCD, r = nwg % NXCD, xcd = wgid % NXCD, off = wgid / NXCD; wgid = (xcd < r ? xcd * (q + 1) : r * (q + 1) + (xcd - r) * q) + off; }
        const int nig = WGM * nN, gid = wgid / nig, fm = gid * WGM, gsz = (nM - fm) < WGM ? (nM - fm) : WGM;
        const int pm = fm + ((wgid % nig) % gsz); u.pn = (wgid % nig) / gsz; u.arow = pm * BM; u.orow = pm * BM; u.nvalid = BM; u.e = 0; u.goff = 0; return true;
    }
};
template <bool GATH> struct MoeSched {
    static constexpr bool GATHER = GATH, HALF_SKIP = true;
    const LAS int* tab; int G, c;
    DI void init(const LAS int* t) { tab = t; G = gridDim.x; c = blockIdx.x; }
    DI bool next(int i, Unit& u) const {
        const int L = i * G + c, mtile = L >> 3; const int total = __builtin_amdgcn_readfirstlane(tab[32]);
        if (mtile >= total) return false;
        int e = 0; for (int j = 1; j < 32; ++j) { if (__builtin_amdgcn_readfirstlane(tab[j]) <= mtile) e = j; }
        const int mt = mtile - __builtin_amdgcn_readfirstlane(tab[e]); const int cn = __builtin_amdgcn_readfirstlane(tab[64 + e]);
        u.e = e; u.pn = L & 7; u.orow = mtile * BM; u.arow = mtile * BM; u.nvalid = (cn - mt * BM) < BM ? (cn - mt * BM) : BM; u.goff = e * ECAP + mt * BM; return true;
    }
};
DI void moe_tables(LAS int* tab, const int* cnt) {
    if (threadIdx.x == 0) { int run = 0; for (int e = 0; e < 32; ++e) { const int cn = cnt[e]; tab[e] = run; tab[64 + e] = cn; run += (cn + 255) >> 8; } tab[32] = run; }
    __syncthreads();
}

typedef int i32x8 __attribute__((ext_vector_type(8)));
typedef int i32x4 __attribute__((ext_vector_type(4)));
DI void mfma8(f32x4& acc, const i32x8& w8, const i32x8& x8, int ws, int as) {
    asm volatile("v_mfma_scale_f32_16x16x128_f8f6f4 %0, %1, %2, %0, %3, %4 op_sel_hi:[0,0,0]" : "+v"(acc) : "v"(w8), "v"(x8), "v"(ws), "v"(as)); }
template <class Epi, class Sched, bool FP8 = false>
DI void gemm_phase(LAS unsigned char* lds, const Params& p, const bf16_t* A, const bf16_t* Bt, size_t bt_estride, int K, const Sched& S, const Epi& E, int wscale = 0x7f7f7f7f, int ascale = 0x7f7f7f7f) {
    const int tid = opaque_tid(), wid = __builtin_amdgcn_readfirstlane(tid >> 6), lane = tid & 63, wr = wid >> 2, wc = wid & 3, fr = lane & 15, fq = lane >> 4;
    const int nt = K / BK;
    unsigned voffA[2], voffB[2];
#pragma unroll
    for (int i = 0; i < 2; ++i) { int R, C; stage_rc(tid * 16 + i * 8192, R, C); voffA[i] = (unsigned)(R * K + C) * 2u; voffB[i] = (unsigned)(((R & ~31) + perm32(R & 31)) * K + C) * 2u; }
    const size_t kstep = (size_t)(BK * 2), hstep = (size_t)HALF * K * 2, tstep = 2 * hstep;
    const unsigned ldsw = (unsigned)wid * 1024u;
    const int aoff = lds_byte(wr * 64 + fr, fq * 8), boff = lds_byte(wc * 32 + fr, fq * 8);
#define G_SA(b, h) (((b) * 2 + (h)) * HTB)
#define G_SB(b, h) ((4 + (b) * 2 + (h)) * HTB)
#define G_STAGE(bufoff, gbase, voff) do { _Pragma("unroll") for (int _i = 0; _i < 2; ++_i) \
        __builtin_amdgcn_global_load_lds((const unsigned*)((const char*)(gbase) + (voff)[_i]), (LAS unsigned*)(lds + (bufoff) + ldsw + _i * 8192), 16, 0, 0); } while (0)
#define G_STAGE_A(bufoff, ubase, gv, h, koff) do { if constexpr (Sched::GATHER) { G_STAGE(bufoff, (const char*)A + (koff), gv[h]); } else { G_STAGE(bufoff, (ubase) + (h) * hstep + (koff), voffA); } } while (0)
#define G_LD16(off_) (*(const LAS i32x4*)(lds + (off_)))
#define G_LD16B(off_) (*(const LAS bf16x8*)(lds + (off_)))
#define G_LDA(dst, b, h) do { _Pragma("unroll") for (int m = 0; m < 4; ++m) { if constexpr (FP8) dst##8[m] = __builtin_shufflevector(G_LD16(G_SA(b, h) + aoff + m * 2048), G_LD16(G_SA(b, h) + aoff + m * 2048 + 1024), 0, 1, 2, 3, 4, 5, 6, 7); \
        else { dst[m][0] = G_LD16B(G_SA(b, h) + aoff + m * 2048); dst[m][1] = G_LD16B(G_SA(b, h) + aoff + m * 2048 + 1024); } } } while (0)
#define G_LDB(dst, b, h) do { _Pragma("unroll") for (int n = 0; n < 2; ++n) { if constexpr (FP8) dst##8[n] = __builtin_shufflevector(G_LD16(G_SB(b, h) + boff + n * 2048), G_LD16(G_SB(b, h) + boff + n * 2048 + 1024), 0, 1, 2, 3, 4, 5, 6, 7); \
        else { dst[n][0] = G_LD16B(G_SB(b, h) + boff + n * 2048); dst[n][1] = G_LD16B(G_SB(b, h) + boff + n * 2048 + 1024); } } } while (0)
#define G_MMA(ai, bj, At, Bt_) do { __builtin_amdgcn_s_setprio(1); _Pragma("unroll") for (int m = 0; m < 4; ++m) _Pragma("unroll") for (int n = 0; n < 2; ++n) { \
        if constexpr (FP8) mfma8(acc[ai][bj][m][n], Bt_##8[n], At##8[m], wscale, ascale); \
        else { _Pragma("unroll") for (int k = 0; k < 2; ++k) acc[ai][bj][m][n] = __builtin_amdgcn_mfma_f32_16x16x32_bf16(Bt_[n][k], At[m][k], acc[ai][bj][m][n], 0, 0, 0); } } \
        __builtin_amdgcn_s_setprio(0); } while (0)
#define G_WAIT_V(n) asm volatile("s_waitcnt vmcnt(" #n ")" ::: "memory")
#define G_WAIT_L(n) asm volatile("s_waitcnt lgkmcnt(" #n ")" ::: "memory")
#define G_BAR __builtin_amdgcn_s_barrier()
#define G_SCHED __builtin_amdgcn_sched_barrier(0)
    Unit cur, nxt; int ui = 0;
    if (!S.next(0, cur)) return;
    f32x4 acc[2][2][4][2];
#pragma unroll
    for (int a = 0; a < 2; ++a)
#pragma unroll
        for (int b = 0; b < 2; ++b)
#pragma unroll
            for (int m = 0; m < 4; ++m)
#pragma unroll
                for (int n = 0; n < 2; ++n) acc[a][b][m][n] = (f32x4){0.f, 0.f, 0.f, 0.f};
    bf16x8 At[4][2], B0[2][2], B1[2][2]; i32x8 At8[4], B08[2], B18[2];
    unsigned gcur[2][2] = {{0u, 0u}, {0u, 0u}}, gnxt[2][2] = {{0u, 0u}, {0u, 0u}};
    auto gather_offs = [&](const Unit& u, unsigned (&g)[2][2]) {
        if constexpr (Sched::GATHER) {
#pragma unroll
            for (int h = 0; h < 2; ++h)
#pragma unroll
                for (int i = 0; i < 2; ++i) { int tz = tid; asm volatile("" : "+v"(tz)); int R, C; stage_rc(tz * 16 + i * 8192, R, C); const int r = h * HALF + R; const int tk = p.tokl[u.goff + (r < u.nvalid ? r : 0)]; const int tok = r < u.nvalid ? tk : 0; g[h][i] = (unsigned)(tok * K + C) * 2u; }
        }
    };
    const char* cA = (const char*)A + (size_t)(cur.arow / BM) * tstep; const char* cB = (const char*)Bt + ((size_t)cur.e * bt_estride) * 2 + (size_t)cur.pn * tstep;
    gather_offs(cur, gcur);
    G_STAGE(G_SB(0, 0), cB, voffB); G_STAGE_A(G_SA(0, 0), cA, gcur, 0, 0); G_STAGE(G_SB(0, 1), cB + hstep, voffB); G_STAGE_A(G_SA(0, 1), cA, gcur, 1, 0);
    if (wr == 1) G_BAR;
    G_WAIT_V(4); G_BAR;
    G_STAGE(G_SB(1, 0), cB + kstep, voffB); G_STAGE_A(G_SA(1, 0), cA, gcur, 0, kstep); G_STAGE(G_SB(1, 1), cB + hstep + kstep, voffB);
    G_WAIT_V(6); G_BAR;
    for (;;) {
        const bool has_next = S.next(ui + 1, nxt);
        const char* nA = has_next ? (const char*)A + (size_t)(nxt.arow / BM) * tstep : cA;
        const char* nB = has_next ? (const char*)Bt + ((size_t)nxt.e * bt_estride) * 2 + (size_t)nxt.pn * tstep : cB;
        if constexpr (Sched::GATHER) { if (has_next) gather_offs(nxt, gnxt); else {
#pragma unroll
            for (int h = 0; h < 2; ++h) { gnxt[h][0] = gcur[h][0]; gnxt[h][1] = gcur[h][1]; } } }
        for (int t = 0; t < nt; t += 2) {
            const bool last = (t == nt - 2);
            const size_t k1 = (size_t)(t + 1) * kstep;
            const char* a2 = last ? nA : cA; const char* b2 = last ? nB : cB + (size_t)(t + 2) * kstep;
            const size_t k2 = last ? 0 : (size_t)(t + 2) * kstep; const size_t k3 = k2 + kstep;
            const char* b3 = b2 + kstep;
            unsigned g2[2][2];
#pragma unroll
            for (int h = 0; h < 2; ++h) { g2[h][0] = last ? gnxt[h][0] : gcur[h][0]; g2[h][1] = last ? gnxt[h][1] : gcur[h][1]; }
            G_LDB(B0, 0, 0); G_SCHED; G_LDA(At, 0, 0); G_STAGE_A(G_SA(1, 1), cA, gcur, 1, k1);
            G_WAIT_L(8); G_BAR; G_WAIT_L(0); G_MMA(0, 0, At, B0); G_BAR; G_SCHED;
            G_LDB(B1, 0, 1); G_STAGE(G_SB(0, 0), b2, voffB);
            G_BAR; G_WAIT_L(0); G_MMA(0, 1, At, B1); G_BAR;
            G_LDA(At, 0, 1); G_STAGE_A(G_SA(0, 0), a2, g2, 0, k2);
            G_BAR; G_WAIT_L(0); if (!Sched::HALF_SKIP || cur.nvalid > HALF) G_MMA(1, 0, At, B0); G_BAR; G_SCHED;
            G_STAGE(G_SB(0, 1), b2 + hstep, voffB);
            G_WAIT_V(6); G_BAR; if (!Sched::HALF_SKIP || cur.nvalid > HALF) G_MMA(1, 1, At, B1); G_BAR;
            G_LDB(B0, 1, 0); G_SCHED; G_LDA(At, 1, 0); G_STAGE_A(G_SA(0, 1), a2, g2, 1, k2);
            G_WAIT_L(8); G_BAR; G_WAIT_L(0); G_MMA(0, 0, At, B0); G_BAR; G_SCHED;
            G_LDB(B1, 1, 1); G_STAGE(G_SB(1, 0), b3, voffB);
            G_BAR; G_WAIT_L(0); G_MMA(0, 1, At, B1); G_BAR;
            G_LDA(At, 1, 1); G_STAGE_A(G_SA(1, 0), a2, g2, 0, k3);
            G_BAR; G_WAIT_L(0); if (!Sched::HALF_SKIP || cur.nvalid > HALF) G_MMA(1, 0, At, B0); G_BAR; G_SCHED;
            G_STAGE(G_SB(1, 1), b3 + hstep, voffB);
            G_WAIT_V(6); G_BAR; if (!Sched::HALF_SKIP || cur.nvalid > HALF) G_MMA(1, 1, At, B1); G_BAR;
        }
        if constexpr (FP8) asm volatile("s_nop 15\n\ts_nop 15" ::: "memory");
        { GUnit gu; gu.rowbase = cur.orow; gu.nvalid = cur.nvalid; gu.e = cur.e; gu.gather = p.tokl + cur.goff;
          if constexpr (Epi::PRE) {
            const int col0 = cur.pn * BM + wc * 32 + fq * 8; const auto up = E.unit_pre(p, gu, col0);
#pragma unroll
            for (int ai = 0; ai < 2; ++ai) { typename Epi::Pre pr[4];
#pragma unroll
              for (int m = 0; m < 4; ++m) pr[m] = E.pre(p, gu, ai * HALF + wr * 64 + m * 16 + fr, col0);
              asm volatile("" ::: "memory");
#pragma unroll
              for (int m = 0; m < 4; ++m) { const int r = ai * HALF + wr * 64 + m * 16 + fr;
                if (!Sched::HALF_SKIP || r < cur.nvalid) E.fin(p, gu, r, col0, up, pr[m], acc[ai][0][m][0], acc[ai][0][m][1], acc[ai][1][m][0], acc[ai][1][m][1]); } }
          } else {
#pragma unroll
          for (int ai = 0; ai < 2; ++ai)
#pragma unroll
            for (int m = 0; m < 4; ++m) { const int r = ai * HALF + wr * 64 + m * 16 + fr;
              if (!Sched::HALF_SKIP || r < cur.nvalid) E(p, gu, r, cur.pn * BM + wc * 32 + fq * 8, acc[ai][0][m][0], acc[ai][0][m][1], acc[ai][1][m][0], acc[ai][1][m][1]); } } }
        if (!has_next) break;
#pragma unroll
        for (int a = 0; a < 2; ++a)
#pragma unroll
            for (int b = 0; b < 2; ++b)
#pragma unroll
                for (int m = 0; m < 4; ++m)
#pragma unroll
                    for (int n = 0; n < 2; ++n) acc[a][b][m][n] = (f32x4){0.f, 0.f, 0.f, 0.f};
        cur = nxt; cA = nA; cB = nB; ++ui;
#pragma unroll
        for (int h = 0; h < 2; ++h) { gcur[h][0] = gnxt[h][0]; gcur[h][1] = gnxt[h][1]; }
    }
    G_WAIT_V(0);
    if (wr == 0) G_BAR;
    G_BAR;
}
}

extern __shared__ __attribute__((aligned(16))) unsigned char dyn_smem[];
constexpr int LDS_BYTES = gm::STAGE_BYTES + 1024;

typedef __bf16 bf2v __attribute__((ext_vector_type(2)));
typedef float f32x2 __attribute__((ext_vector_type(2)));
typedef float f32x16 __attribute__((ext_vector_type(16)));
typedef short s16x4 __attribute__((ext_vector_type(4)));
typedef unsigned u32x4 __attribute__((ext_vector_type(4)));
DI unsigned pk2(float a, float b) { f32x2 v = {a, b}; bf2v r = __builtin_convertvector(v, bf2v); return __builtin_bit_cast(unsigned, r); }
DI float bflo(unsigned u) { return __uint_as_float(u << 16); }
DI float bfhi(unsigned u) { return __uint_as_float(u & 0xffff0000u); }

DI unsigned pk4_fp8(float a, float b, float c, float d, float sc) {
    a = __builtin_amdgcn_fmed3f(a * sc, -448.f, 448.f); b = __builtin_amdgcn_fmed3f(b * sc, -448.f, 448.f); c = __builtin_amdgcn_fmed3f(c * sc, -448.f, 448.f); d = __builtin_amdgcn_fmed3f(d * sc, -448.f, 448.f);
    unsigned w = 0u; w = __builtin_amdgcn_cvt_pk_fp8_f32(a, b, w, false); w = __builtin_amdgcn_cvt_pk_fp8_f32(c, d, w, true); return w; }
constexpr bool D8_IN0 = true, D8_OUT0 = false, D8_IN1 = false;
constexpr bool YB8 = true;
constexpr float Y8_SCALE = 64.f;
constexpr float W8_SCALE = 256.f, A8_SCALE = 8.f;
constexpr int W8_E8M0 = 0x77777777, A8_E8M0 = 0x7c7c7c7c;
namespace ph {
DI void mods(const Params& p, LAS unsigned char* lds) {
    const int tid = opaque_tid(), wave = tid >> 6, lane = tid & 63, l8 = tid & 7, rg = tid >> 3;
    LAS float* fl = (LAS float*)lds; LAS float* red = fl + 4 * DM;
    for (int i = tid; i < 4 * DM; i += 512) fl[i] = siluf_(p.c[i]);
    __syncthreads();
    for (int u = blockIdx.x; u < 768; u += gridDim.x) {
        const int l = u / 192, c32 = u % 192;
        const float* w = l == 0 ? p.ada0_mix_w : l == 1 ? p.ada0_ffn_w : l == 2 ? p.ada1_mix_w : p.ada1_ffn_w;
        const float* bs = l == 0 ? p.ada0_mix_b : l == 1 ? p.ada0_ffn_b : l == 2 ? p.ada1_mix_b : p.ada1_ffn_b;
        f32x4 acc[4] = {{0.f, 0.f, 0.f, 0.f}, {0.f, 0.f, 0.f, 0.f}, {0.f, 0.f, 0.f, 0.f}, {0.f, 0.f, 0.f, 0.f}};
        const float* wp = w + (size_t)rg * 6144 + c32 * 32 + l8 * 4;
#pragma unroll 8
        for (int i = 0; i < 32; ++i) { const f32x4 wv = *(const f32x4*)(wp + (size_t)(64 * i) * 6144); const int k = rg + 64 * i;
#pragma unroll
            for (int b = 0; b < 4; ++b) acc[b] += fl[b * DM + k] * wv; }
#pragma unroll
        for (int b = 0; b < 4; ++b)
#pragma unroll
            for (int j = 0; j < 4; ++j) { float v = acc[b][j]; v += __shfl_xor(v, 8); v += __shfl_xor(v, 16); v += __shfl_xor(v, 32); acc[b][j] = v; }
        if (lane < 8) {
#pragma unroll
            for (int b = 0; b < 4; ++b) *(LAS f32x4*)(red + (wave * 4 + b) * 32 + lane * 4) = acc[b]; }
        __syncthreads();
        if (tid < 128) { const int b = tid >> 5, col = tid & 31; float sum = 0.f;
#pragma unroll
            for (int w8 = 0; w8 < 8; ++w8) sum += red[(w8 * 4 + b) * 32 + col];
            p.mod[(l * 4 + b) * 6144 + c32 * 32 + col] = sum + bs[c32 * 32 + col]; }
        __syncthreads();
    }
}
constexpr int NT_UNITS = (640 + 256 + 672 + 336 + 2 * (8192 + 4096)) / 2;
struct UD { const float* sp; bf16_t* dst; int K, N, mode, e, kt, ntile; };
DI UD tdecode(const Params& p, int u, int lane) {
    const float* srcs[8] = {p.w_in0, p.w_out0, p.w_in1, p.w_out1, p.moe0_w_gate_up, p.moe0_w_down, p.moe1_w_gate_up, p.moe1_w_down};
    bf16_t* dsts[8] = {p.w_in0t, p.w_out0t, p.w_in1t, p.w_out1t, p.w_gut0, p.w_dt0, p.w_gut1, p.w_dt1};
    constexpr int Ks[8] = {DM, DM, DM, LRU_W, DM, EFF, DM, EFF}, Ns[8] = {N_IN0, DM, N_IN1, DM, 2048, DM, 2048, DM}, nus[8] = {320, 128, 336, 168, 4096, 2048, 4096, 2048};
    constexpr int modes[8] = {D8_IN0 ? 2 : 0, D8_OUT0 ? 2 : 0, D8_IN1 ? 2 : 0, 0, 3, 2, 3, 2};
    int v = u, mi = 0;
#pragma unroll
    for (int m = 0; m < 8; ++m) { if (mi == m && v >= nus[m]) { v -= nus[m]; mi = m + 1; } }
    UD d; const float* src = srcs[0]; d.dst = dsts[0]; d.K = Ks[0]; d.N = Ns[0]; d.mode = modes[0];
#pragma unroll
    for (int m = 1; m < 8; ++m) if (mi == m) { src = srcs[m]; d.dst = dsts[m]; d.K = Ks[m]; d.N = Ns[m]; d.mode = modes[m]; }
    const int ntl = d.N / 256, ktl = d.K / 128; d.e = v / (ktl * ntl); const int rem = v % (ktl * ntl); d.kt = rem / ntl; d.ntile = rem % ntl;
    d.sp = src + (size_t)d.e * d.K * d.N + (size_t)(d.kt * 128) * d.N + d.ntile * 256 + lane * 4;
    return d;
}
DI void transposer(const Params& p, LAS unsigned char* lds, int first, int count, int stride) {
    const int tid = opaque_tid(), wave = tid >> 6, lane = tid & 63;
    LAS float* fl = (LAS float*)lds;
    if (count <= 0) return;
    if (tdecode(p, first, lane).mode & 2) {
        LAS unsigned* td = (LAS unsigned*)lds;
        const int nl = lane & 15, ks = lane >> 4;
        auto src_of = [&](const UD& d, int g, int j) -> const float* { const int kq = 4 * (g >> 2) + ks, nq = 16 * (g & 3) + nl; return d.sp - lane * 4 + (size_t)(4 * kq + j) * d.N + 4 * nq; };
        f32x4 va[4][4], vb[4][4];
        auto load_unit = [&](int u, f32x4 (&v)[4][4]) { const UD dd = tdecode(p, u, lane);
#pragma unroll
            for (int i = 0; i < 4; ++i)
#pragma unroll
                for (int j = 0; j < 4; ++j) v[i][j] = *(const f32x4*)src_of(dd, wave * 4 + i, j); };
        auto process = [&](int jn, f32x4 (&v)[4][4]) { const int u = first + jn * stride;
            const UD d = tdecode(p, u, lane); const int K = d.K, N = d.N, mode = d.mode, e = d.e, kt = d.kt, ntile = d.ntile;
            LAS unsigned* tile = td + (jn & 1) * (256 * 33);
#pragma unroll
            for (int i = 0; i < 4; ++i) { const int g = wave * 4 + i, kq = 4 * (g >> 2) + ks, nq = 16 * (g & 3) + nl;
#pragma unroll
                for (int en = 0; en < 4; ++en) tile[(4 * nq + en) * 33 + kq] = pk4_fp8(v[i][0][en], v[i][1][en], v[i][2][en], v[i][3][en], W8_SCALE); }
            __syncthreads();
            if (jn + 2 < count) load_unit(u + 2 * stride, v);
            { const int n = tid >> 1, kh = tid & 1; const int ng = ntile * 256 + n; const int jg = ng & 1023; const int np = (mode & 1) ? (256 * (jg >> 7) + (ng < 1024 ? 0 : 128) + (jg & 127)) : ng;
              unsigned char* dp = (unsigned char*)d.dst + (size_t)e * N * K + (size_t)np * K + kt * 128 + kh * 64;
#pragma unroll
              for (int jj = 0; jj < 4; ++jj) { const LAS unsigned* tp = tile + n * 33 + kh * 16 + jj * 4; *(uint4*)(dp + jj * 16) = make_uint4(tp[0], tp[1], tp[2], tp[3]); } } };
        load_unit(first, va); if (count > 1) load_unit(first + stride, vb);
        for (int jn = 0; jn < count; jn += 2) { process(jn, va); if (jn + 1 < count) process(jn + 1, vb); }
        __syncthreads();
        return;
    }
    f32x4 vv[16];
    { const UD d0 = tdecode(p, first, lane);
#pragma unroll
        for (int i = 0; i < 16; ++i) vv[i] = *(const f32x4*)(d0.sp + (size_t)(i * 8 + wave) * d0.N); }
    for (int j = 0; j < count; ++j) { const int u = first + j * stride;
        const UD d = tdecode(p, u, lane); const int K = d.K, N = d.N, mode = d.mode, e = d.e, kt = d.kt, ntile = d.ntile; bf16_t* dst = d.dst;
#pragma unroll
        for (int i = 0; i < 16; ++i) { LAS float* tp = fl + (i * 8 + wave) * 257 + lane * 4; tp[0] = vv[i][0]; tp[1] = vv[i][1]; tp[2] = vv[i][2]; tp[3] = vv[i][3]; }
        __syncthreads();
        if (j + 1 < count) { const UD dn = tdecode(p, u + stride, lane);
#pragma unroll
            for (int i = 0; i < 16; ++i) vv[i] = *(const f32x4*)(dn.sp + (size_t)(i * 8 + wave) * dn.N); }
        { const int n = tid >> 1, kh = tid & 1; const int ng = ntile * 256 + n; const int jg = ng & 1023; const int np = (mode & 1) ? (256 * (jg >> 7) + (ng < 1024 ? 0 : 128) + (jg & 127)) : ng;
          bf16_t* dp = dst + (size_t)e * N * K + (size_t)np * K + kt * 128 + kh * 64;
#pragma unroll
          for (int jj = 0; jj < 8; ++jj) { unsigned w4[4];
#pragma unroll
              for (int q = 0; q < 4; ++q) { const int k = kh * 64 + jj * 8 + q * 2; w4[q] = pk2(fl[k * 257 + n], fl[(k + 1) * 257 + n]); }
              *(uint4*)(dp + jj * 8) = make_uint4(w4[0], w4[1], w4[2], w4[3]); } }
        __syncthreads();
    }
}
DI void lru_weights(const Params& p) {
    const int tid = opaque_tid();
    for (size_t i = (size_t)blockIdx.x * 512 + tid; i < (size_t)2 * 2 * 16 * 4 * 48 * 192; i += (size_t)gridDim.x * 512) {
        const int k = i % 192, j = (i / 192) % 48, qt = (i / (192 * 48)) % 4, n = (i / (192 * 48 * 4)) % 16, which = (i / (192 * 48 * 4 * 16)) % 2, dir = i / (192 * 48 * 4 * 16 * 2);
        const float* w = which == 0 ? p.lru_w_a : p.lru_w_x; float v = 0.f;
        if (j < 42 && k < 168) v = w[(((size_t)dir * 16 + n) * 168 + k) * 168 + qt * 42 + j];
        p.w_lru[i] = f2bf(v);
    }
}
DI void fold_router(const Params& p) {
    const int tid = opaque_tid(), wave = tid >> 6, lane = tid & 63;
    for (size_t i = (size_t)blockIdx.x * 512 + tid; i < (size_t)2 * 4 * 48 * DM; i += (size_t)gridDim.x * 512) {
        const int k = i % DM, n = (i / DM) % 48, b = (i / (DM * 48)) % 4, l = i / (DM * 48 * 4);
        const float* g = l == 0 ? p.norm0_ffn : p.norm1_ffn; const float* md = p.mod + ((l == 0 ? 1 : 3) * 4 + b) * 6144;
        const float* we = l == 0 ? p.moe0_w_expert : p.moe1_w_expert; const float* wg = l == 0 ? p.moe0_w_group : p.moe1_w_group;
        const float w = n < 32 ? we[k * 32 + n] : n < 36 ? wg[k * 4 + (n - 32)] : 0.f;
        const float wf = g[k] * (1.f + md[2048 + k]) * w;
        const bf16_t hi = f2bf(wf); const float r1 = wf - bf2f(hi); const bf16_t mid = f2bf(r1); const bf16_t lo = f2bf(r1 - bf2f(mid));
        bf16_t* dst = p.wrt + ((size_t)((l * 4 + b) * 3) * 48 + n) * DM + k;
        dst[0] = hi; dst[(size_t)48 * DM] = mid; dst[(size_t)96 * DM] = lo;
    }
    for (int task = blockIdx.x * 8 + wave; task < 2 * 4 * 48; task += gridDim.x * 8) {
        const int n = task % 48, b = (task / 48) % 4, l = task / (48 * 4);
        const float* md = p.mod + ((l == 0 ? 1 : 3) * 4 + b) * 6144;
        const float* we = l == 0 ? p.moe0_w_expert : p.moe1_w_expert; const float* wg = l == 0 ? p.moe0_w_group : p.moe1_w_group;
        float part = 0.f;
        for (int k = lane; k < DM; k += 64) { const float w = n < 32 ? we[k * 32 + n] : n < 36 ? wg[k * 4 + (n - 32)] : 0.f; part += md[k] * w; }
        part = wave_sum(part); if (lane == 0) p.rbias[task] = part;
    }
}
template <int MODE, bool OUT8 = false> DI void norm_rows(const Params& p, const float* xin  , const float* gain, int lmod, int lgate, const LAS int* tab) {
    const int tid = opaque_tid(), wave = tid >> 6, lane = tid & 63;
    f32x4 gn[8];
#pragma unroll
    for (int i = 0; i < 8; ++i) gn[i] = *(const f32x4*)(gain + i * 256 + lane * 4);
    for (int row = blockIdx.x * 8 + wave; row < T_TOK; row += gridDim.x * 8) {
        const int b = row / SEQ;
        int a0 = 0, a1 = 0;
        if constexpr (MODE >= 1) { a0 = p.asg[row * 2]; a1 = p.asg[row * 2 + 1]; }
        f32x4 v[8]; uint2 vr[8];
        if (xin) {
#pragma unroll
            for (int i = 0; i < 8; ++i) v[i] = *(const f32x4*)(xin + (size_t)row * DM + i * 256 + lane * 4);
        } else {
#pragma unroll
            for (int i = 0; i < 8; ++i) vr[i] = *(const uint2*)(p.XA + (size_t)row * DM + i * 256 + lane * 4);
        }
        f32x4 gq[8], sc[8], sh[8];
        if constexpr (MODE >= 1) { const float* gt = p.mod + (lgate * 4 + b) * 6144 + 4096;
#pragma unroll
            for (int i = 0; i < 8; ++i) gq[i] = *(const f32x4*)(gt + i * 256 + lane * 4); }
        if constexpr (MODE != 2) { const float* md = p.mod + (lmod * 4 + b) * 6144;
#pragma unroll
            for (int i = 0; i < 8; ++i) { sc[i] = *(const f32x4*)(md + 2048 + i * 256 + lane * 4); sh[i] = *(const f32x4*)(md + i * 256 + lane * 4); } }
        if (!xin) {
#pragma unroll
            for (int i = 0; i < 8; ++i) v[i] = (f32x4){bflo(vr[i].x), bfhi(vr[i].x), bflo(vr[i].y), bfhi(vr[i].y)};
        }
        if constexpr (MODE >= 1) {
            const size_t r0 = (size_t)tab[a0 >> 14] * 256 + (a0 & 16383), r1 = (size_t)tab[a1 >> 14] * 256 + (a1 & 16383);
            if constexpr (YB8) { unsigned y0[8], y1[8];
#pragma unroll
                for (int i = 0; i < 8; ++i) { const int col = i * 256 + lane * 4; y0[i] = *(const unsigned*)((const unsigned char*)p.YB + r0 * DM + col); y1[i] = *(const unsigned*)((const unsigned char*)p.YB + r1 * DM + col); }
#pragma unroll
                for (int i = 0; i < 8; ++i) {
                    const f32x2 c0 = __builtin_amdgcn_cvt_pk_f32_fp8(y0[i], false), c1 = __builtin_amdgcn_cvt_pk_f32_fp8(y0[i], true), d0 = __builtin_amdgcn_cvt_pk_f32_fp8(y1[i], false), d1 = __builtin_amdgcn_cvt_pk_f32_fp8(y1[i], true);
                    const f32x4 g4 = gq[i] * (1.f / Y8_SCALE);
                    v[i][0] += g4[0] * (c0[0] + d0[0]); v[i][1] += g4[1] * (c0[1] + d0[1]); v[i][2] += g4[2] * (c1[0] + d1[0]); v[i][3] += g4[3] * (c1[1] + d1[1]); } }
            else {
#pragma unroll
                for (int i = 0; i < 8; ++i) { const int col = i * 256 + lane * 4; const f32x4 g4 = gq[i]; const uint2 y0 = *(const uint2*)(p.YB + r0 * DM + col), y1 = *(const uint2*)(p.YB + r1 * DM + col);
                v[i][0] += g4[0] * (bflo(y0.x) + bflo(y1.x)); v[i][1] += g4[1] * (bfhi(y0.x) + bfhi(y1.x));
                v[i][2] += g4[2] * (bflo(y0.y) + bflo(y1.y)); v[i][3] += g4[3] * (bfhi(y0.y) + bfhi(y1.y)); } }
            if constexpr (MODE == 1) {
#pragma unroll
                for (int i = 0; i < 8; ++i) { const uint2 w = make_uint2(pk2(v[i][0], v[i][1]), pk2(v[i][2], v[i][3])); *(uint2*)(p.XA + (size_t)row * DM + i * 256 + lane * 4) = w;
                    v[i] = (f32x4){bflo(w.x), bfhi(w.x), bflo(w.y), bfhi(w.y)}; }
            }
        }
        float ss = 0.f;
#pragma unroll
        for (int i = 0; i < 8; ++i) ss += v[i][0] * v[i][0] + v[i][1] * v[i][1] + v[i][2] * v[i][2] + v[i][3] * v[i][3];
        ss = wave_sum(ss); const float rstd = rsqrtf(ss * (1.0f / DM) + 1e-6f);
        if constexpr (MODE == 2) {
#pragma unroll
            for (int i = 0; i < 8; ++i) { const int col = i * 256 + lane * 4; *(f32x4*)(p.out + (size_t)row * DM + col) = v[i] * rstd * gn[i]; }
        } else {
#pragma unroll
            for (int i = 0; i < 8; ++i) { const int col = i * 256 + lane * 4;
                const f32x4 h = v[i] * rstd * gn[i] * (1.f + sc[i]) + sh[i];
                if constexpr (OUT8) *(unsigned*)((unsigned char*)p.H + (size_t)row * DM + col) = pk4_fp8(h[0], h[1], h[2], h[3], A8_SCALE);
                else *(uint2*)(p.H + (size_t)row * DM + col) = make_uint2(pk2(h[0], h[1]), pk2(h[2], h[3])); } }
    }
}
template <bool DRY = false, bool NORM = false> DI void router(const Params& p, int l, LAS unsigned char* lds, const float* gain = nullptr, int lmod = 0) {
    const int tid = opaque_tid(), wave = __builtin_amdgcn_readfirstlane(tid >> 6), lane = tid & 63;
    LAS float* lg = (LAS float*)lds + (wave & 3) * (16 * 48);
    LAS float* rsl = (LAS float*)lds + 4 * 16 * 48 + (wave & 3) * 16;
    LAS f32x4* part = (LAS f32x4*)(lds + 16384);
    LAS float* ssp = (LAS float*)(lds + 16384 + 98304);
    for (int tg = blockIdx.x; tg < T_TOK / 64; tg += gridDim.x) {
        const int b = (tg * 64) / SEQ, r = lane & 15, q = lane >> 4;
        const bf16_t* xa = p.XA + (size_t)(tg * 64 + r) * DM + wave * 256 + 8 * q;
        const bf16_t* wt = p.wrt + ((size_t)((l * 4 + b) * 3) * 48 + r) * DM + wave * 256 + 8 * q;
        f32x4 acc[4][3]; float ss[4] = {0.f, 0.f, 0.f, 0.f};
#pragma unroll
        for (int t = 0; t < 4; ++t)
#pragma unroll
            for (int n = 0; n < 3; ++n) acc[t][n] = (f32x4){0.f, 0.f, 0.f, 0.f};
        u32x4 aA[4], aB[4], bA[9], bB[9];
        auto ld = [&](int st, u32x4 (&aa)[4], u32x4 (&bb)[9]) {
#pragma unroll
            for (int t = 0; t < 4; ++t) aa[t] = *(const u32x4*)(xa + (size_t)t * 16 * DM + st * 32);
#pragma unroll
            for (int i = 0; i < 9; ++i) bb[i] = *(const u32x4*)(wt + (size_t)i * 16 * DM + st * 32); };
        auto mm = [&](const u32x4 (&aa)[4], const u32x4 (&bb)[9]) {
#pragma unroll
            for (int t = 0; t < 4; ++t) {
#pragma unroll
                for (int e = 0; e < 4; ++e) { const float x0 = bflo(aa[t][e]), x1 = bfhi(aa[t][e]); ss[t] += x0 * x0 + x1 * x1; }
#pragma unroll
                for (int i = 0; i < 9; ++i) acc[t][i % 3] = __builtin_amdgcn_mfma_f32_16x16x32_bf16(__builtin_bit_cast(bf16x8, aa[t]), __builtin_bit_cast(bf16x8, bb[i]), acc[t][i % 3], 0, 0, 0); } };
        ld(0, aA, bA);
        for (int st = 0; st < 8; st += 2) {
            ld(st + 1, aB, bB);
            mm(aA, bA);
            if (st + 2 < 8) ld(st + 2, aA, bA);
            mm(aB, bB);
        }
#pragma unroll
        for (int t = 0; t < 4; ++t) {
#pragma unroll
            for (int n = 0; n < 3; ++n) part[((wave * 4 + t) * 3 + n) * 64 + lane] = acc[t][n];
            float sq = ss[t]; sq += __shfl_xor(sq, 16); sq += __shfl_xor(sq, 32);
            if (q == 0) ssp[(wave * 4 + t) * 16 + r] = sq; }
        __syncthreads();
        if (wave < 4) {
        const int tile = tg * 4 + wave, row0 = tile * 16;
        f32x4 a3[3] = {{0.f, 0.f, 0.f, 0.f}, {0.f, 0.f, 0.f, 0.f}, {0.f, 0.f, 0.f, 0.f}}; float ssr = 0.f;
#pragma unroll
        for (int w2 = 0; w2 < 8; ++w2) {
#pragma unroll
            for (int n = 0; n < 3; ++n) a3[n] += part[((w2 * 4 + wave) * 3 + n) * 64 + lane];
            ssr += ssp[(w2 * 4 + wave) * 16 + r]; }
        const float rstd = rsqrtf(ssr * (1.0f / DM) + 1e-6f);
        if (NORM && q == 0) rsl[r] = rstd;
#pragma unroll
        for (int j = 0; j < 4; ++j) { const float rs = __shfl(rstd, 4 * q + j);
#pragma unroll
            for (int n = 0; n < 3; ++n) lg[(4 * q + j) * 48 + n * 16 + r] = a3[n][j] * rs + p.rbias[(l * 4 + b) * 48 + n * 16 + r]; }
        __builtin_amdgcn_wave_barrier();
        if (!DRY && lane < 16) {
            const LAS float* L = lg + lane * 48; const int tok = row0 + lane;
            int gs = 0; float gm = L[32];
#pragma unroll
            for (int g = 1; g < 4; ++g) if (L[32 + g] > gm) { gm = L[32 + g]; gs = g; }
            float gden = 0.f;
#pragma unroll
            for (int g = 0; g < 4; ++g) gden += __expf(L[32 + g] - gm);
            const float gprob = 1.0f / gden;
            int i0 = 0; float v0 = L[gs * 8];
            for (int j = 1; j < 8; ++j) { const float x = L[gs * 8 + j]; if (x > v0) { v0 = x; i0 = j; } }
            int i1 = -1; float v1 = -3.4e38f;
            for (int j = 0; j < 8; ++j) { const float x = L[gs * 8 + j]; if (j != i0 && x > v1) { v1 = x; i1 = j; } }
            const float e1 = __expf(v1 - v0), g0 = gprob / (1.f + e1), g1 = gprob * e1 / (1.f + e1);
            const int ea = gs * 8 + i0, eb = gs * 8 + i1;
            const int sa = atomicAdd(&p.cnt[l * 32 + ea], 1), sb = atomicAdd(&p.cnt[l * 32 + eb], 1);
            p.tokl[ea * ECAP + sa] = tok; p.gatel[ea * ECAP + sa] = g0; p.tokl[eb * ECAP + sb] = tok; p.gatel[eb * ECAP + sb] = g1;
            p.asg[tok * 2] = (ea << 14) | sa; p.asg[tok * 2 + 1] = (eb << 14) | sb;
        }
        }
        __syncthreads();
        if constexpr (NORM) {
            const int kh = wave >> 2, row0 = (tg * 4 + (wave & 3)) * 16;
            const float* md = p.mod + (lmod * 4 + b) * 6144;
            f32x4 g4[8], sc[8], sh[8];
#pragma unroll
            for (int i = 0; i < 8; ++i) { const int col = i * 256 + lane * 4; g4[i] = *(const f32x4*)(gain + col); sc[i] = 1.f + *(const f32x4*)(md + 2048 + col); sh[i] = *(const f32x4*)(md + col); g4[i] *= sc[i]; }
            for (int j0 = 0; j0 < 8; j0 += 4) {
                uint2 ar[4][8];
#pragma unroll
                for (int jj = 0; jj < 4; ++jj)
#pragma unroll
                    for (int i = 0; i < 8; ++i) ar[jj][i] = *(const uint2*)(p.XA + (size_t)(row0 + kh * 8 + j0 + jj) * DM + i * 256 + lane * 4);
                asm volatile("" ::: "memory");
#pragma unroll
                for (int jj = 0; jj < 4; ++jj) { const int row = row0 + kh * 8 + j0 + jj; const float rs = rsl[kh * 8 + j0 + jj];
#pragma unroll
                    for (int i = 0; i < 8; ++i) { const int col = i * 256 + lane * 4; const f32x4 v = {bflo(ar[jj][i].x), bfhi(ar[jj][i].x), bflo(ar[jj][i].y), bfhi(ar[jj][i].y)};
                        const f32x4 h = v * rs * g4[i] + sh[i];
                        *(unsigned*)((unsigned char*)p.H + (size_t)row * DM + col) = pk4_fp8(h[0], h[1], h[2], h[3], A8_SCALE); } } }
            __syncthreads();
        }
    }
}
DI void conv_gln(const Params& p, LAS unsigned char* lds) {
    const int tid = opaque_tid(), wave = tid >> 6, lane = tid & 63;
    LAS float* at = (LAS float*)lds;
    u32x4 rv[3], rg[3];
    auto load_raw = [&](int u) { const int g = u & 7, t0 = ((u >> 3) & 63) * 64, b = u >> 9;
#pragma unroll
        for (int i = 0; i < 3; ++i) { const int idx = tid + 512 * i, rr = idx >> 4, c8 = idx & 15, t = t0 - 15 + rr; rv[i] = (u32x4){0u, 0u, 0u, 0u}; rg[i] = (u32x4){0u, 0u, 0u, 0u};
            if (idx < 94 * 16 && t >= 0 && t < SEQ) { const bf16_t* row = p.G + (size_t)(b * SEQ + t) * N_IN0 + g * 128 + c8 * 8; rv[i] = *(const u32x4*)row; rg[i] = *(const u32x4*)(row + 1024); } } };
    int gcur = -1; f32x2 wk[31], bias = {0.f, 0.f}, gam = {0.f, 0.f}, bet = {0.f, 0.f};
    if ((int)blockIdx.x < 2048) load_raw(blockIdx.x);
    for (int u = blockIdx.x; u < 2048; u += gridDim.x) {
        const int g = u & 7, t0 = ((u >> 3) & 63) * 64, b = u >> 9;
        const int ch = g * 128 + 2 * lane;
        if (g != gcur) { gcur = g;
#pragma unroll
            for (int k = 0; k < 31; ++k) wk[k] = *(const f32x2*)(p.conv_w + k * 1024 + ch);
            bias = *(const f32x2*)(p.conv_b + ch); gam = *(const f32x2*)(p.conv_norm_g + ch); bet = *(const f32x2*)(p.conv_norm_b + ch); }
#pragma unroll
        for (int i = 0; i < 3; ++i) { const int idx = tid + 512 * i, rr = idx >> 4, c8 = idx & 15;
            if (idx < 94 * 16) { const u32x4 v = rv[i], gg = rg[i];
                const f32x4 lo = {bflo(v[0]) * sigmoidf_(bflo(gg[0])), bfhi(v[0]) * sigmoidf_(bfhi(gg[0])), bflo(v[1]) * sigmoidf_(bflo(gg[1])), bfhi(v[1]) * sigmoidf_(bfhi(gg[1]))};
                const f32x4 hi = {bflo(v[2]) * sigmoidf_(bflo(gg[2])), bfhi(v[2]) * sigmoidf_(bfhi(gg[2])), bflo(v[3]) * sigmoidf_(bflo(gg[3])), bfhi(v[3]) * sigmoidf_(bfhi(gg[3]))};
                *(LAS f32x4*)(at + rr * 132 + c8 * 8) = lo; *(LAS f32x4*)(at + rr * 132 + c8 * 8 + 4) = hi; } }
        __syncthreads();
        if (u + (int)gridDim.x < 2048) load_raw(u + gridDim.x);
        f32x2 acc[8];
#pragma unroll
        for (int j = 0; j < 8; ++j) acc[j] = bias;
#pragma unroll
        for (int rr = 0; rr < 38; ++rr) { const f32x2 a2 = *(const LAS f32x2*)(at + (wave * 8 + rr) * 132 + 2 * lane);
#pragma unroll
            for (int j = 0; j < 8; ++j) { const int k = rr - j; if (k >= 0 && k < 31) acc[j] += wk[k] * a2; } }
#pragma unroll
        for (int j = 0; j < 8; ++j) { const float mu = wave_sum(acc[j][0] + acc[j][1]) * (1.f / 128.f); const float d0 = acc[j][0] - mu, d1 = acc[j][1] - mu;
            const float var = wave_sum(d0 * d0 + d1 * d1) * (1.f / 128.f); const float rs = rsqrtf(var + 1e-6f);
            const float y0 = d0 * rs * gam[0] + bet[0], y1 = d1 * rs * gam[1] + bet[1];
            if constexpr (D8_OUT0) *(unsigned short*)((unsigned char*)p.AO + (size_t)(b * SEQ + t0 + wave * 8 + j) * DM + ch) = (unsigned short)(pk4_fp8(siluf_(y0), siluf_(y1), 0.f, 0.f, A8_SCALE) & 0xffffu);
            else *(unsigned*)(p.AO + (size_t)(b * SEQ + t0 + wave * 8 + j) * DM + ch) = pk2(siluf_(y0), siluf_(y1)); }
        __syncthreads();
    }
}
DI unsigned off_b(unsigned row, unsigned ch) { return 256u * row + 16u * (ch ^ (((row & 3u) << 2) | ((row >> 2) & 3u))); }
DI void tr_read4(unsigned a0, unsigned a1, s16x4& r00, s16x4& r01, s16x4& r10, s16x4& r11) {
    asm volatile("ds_read_b64_tr_b16 %0, %4\n\tds_read_b64_tr_b16 %1, %5\n\tds_read_b64_tr_b16 %2, %4 offset:4096\n\tds_read_b64_tr_b16 %3, %5 offset:4096\n\ts_waitcnt lgkmcnt(0)"
                 : "=&v"(r00), "=&v"(r01), "=&v"(r10), "=&v"(r11) : "v"(a0), "v"(a1) : "memory");
}
template <int PASS> DI void attn_wave(const Params& p, LAS unsigned char* vimg, unsigned vb0, unsigned vb1, int lane_, int b, int h, int qbase  ) {
    int lane = lane_; asm volatile("" : "+v"(lane));
    const int c = lane & 31, hh = lane >> 5, srow = lane >> 4, sch = lane & 15;
    constexpr int QS = PASS == 0 ? 16 : 1, NT = PASS == 0 ? 13 : 5;
    const int tq = qbase + QS * c;
    const bf16_t* gb = p.G + (size_t)(b * SEQ) * N_IN0; const bf16_t* kb = p.KVH + (size_t)((b * 8 + h) * 2) * SEQ * 128;
    bf16_t* st_o = p.YB + ((size_t)(b * 8 + h) * SEQ + tq) * 128;
    float* st_ml = (float*)(p.YB + (size_t)NBATCH * 8 * SEQ * 128) + ((size_t)(b * 8 + h) * SEQ + tq) * 2;
    bf16x8 qf[8];
#pragma unroll
    for (int ks = 0; ks < 8; ++ks) qf[ks] = *(const bf16x8*)(gb + (size_t)tq * N_IN0 + 2048 + h * 128 + 16 * ks + 8 * hh);
    const float sc2 = 0.08838834764831845f * 1.4426950408889634f, sl2 = exp2f(-(float)(h + 1)) * 1.4426950408889634f;
    f32x16 o[4]; float m_run, l_run;
    if constexpr (PASS == 0) {
#pragma unroll
        for (int i = 0; i < 4; ++i)
#pragma unroll
            for (int j = 0; j < 16; ++j) o[i][j] = 0.f;
        m_run = -30000.f; l_run = 0.f;
    } else {
#pragma unroll
        for (int c4 = 0; c4 < 4; ++c4)
#pragma unroll
            for (int g4 = 0; g4 < 4; ++g4) { const uint2 v = *(const uint2*)(st_o + 32 * c4 + 8 * g4 + 4 * hh); o[c4][4 * g4] = bflo(v.x); o[c4][4 * g4 + 1] = bfhi(v.x); o[c4][4 * g4 + 2] = bflo(v.y); o[c4][4 * g4 + 3] = bfhi(v.y); }
        const f32x2 ml = *(const f32x2*)st_ml; m_run = ml[0]; l_run = hh == 0 ? ml[1] : 0.f;
    }
    auto tile_geom = [&](int tile, int& d, int& sb) { if constexpr (PASS == 0) { if (tile < 5) { d = 16; sb = qbase - 1024 + 512 * tile; } else { d = 4; sb = qbase - 256 + 128 * (tile - 5); } } else { d = 1; sb = qbase - 64 + 32 * tile; } };
    auto load_k = [&](int tile, bf16x8 (&kf)[8]) { int d, sb; tile_geom(tile, d, sb); int sp = sb + d * c; sp = sp < 0 ? 0 : (sp >= SEQ ? SEQ - 1 : sp);
        const bf16_t* src = kb + (unsigned)(sp * 128 + 8 * hh);
#pragma unroll
        for (int ks = 0; ks < 8; ++ks) kf[ks] = *(const bf16x8*)(src + 16 * ks); };
    auto load_v = [&](int tile, u32x4 (&vv)[8]) { int d, sb; tile_geom(tile, d, sb);
#pragma unroll
        for (int i = 0; i < 8; ++i) { int sp = sb + d * (srow + 4 * i); sp = sp < 0 ? 0 : (sp >= SEQ ? SEQ - 1 : sp); vv[i] = *(const u32x4*)(kb + (unsigned)(SEQ * 128 + sp * 128 + sch * 8)); } };
    bf16x8 kf[8]; u32x4 vv[8];
    load_k(0, kf); load_v(0, vv);
    for (int tile = 0; tile < NT; ++tile) {
        int d, sb; tile_geom(tile, d, sb);
        const int tn = tile < NT - 1 ? tile + 1 : NT - 1;
#pragma unroll
        for (int i = 0; i < 8; ++i) *(LAS u32x4*)(vimg + off_b(srow + 4 * i, sch)) = vv[i];
        load_v(tn, vv);
        f32x16 sacc;
#pragma unroll
        for (int j = 0; j < 16; ++j) sacc[j] = 0.f;
#pragma unroll
        for (int ks = 0; ks < 8; ++ks) sacc = __builtin_amdgcn_mfma_f32_32x32x16_bf16(kf[ks], qf[ks], sacc, 0, 0, 0);
        load_k(tn, kf);
        const float df = (float)d, basef = (float)(sb - tq) + df * (float)(4 * hh);
        const float lo = fmaxf(-64.f * df, -(float)tq), hi = fminf(64.f * df, (float)(SEQ - 1 - tq));
        const float mid = 0.5f * (lo + hi), half = 0.5f * (hi - lo);
        float tmax = -1e30f;
#pragma unroll
        for (int i = 0; i < 16; ++i) { const float deltaf = basef + df * (float)((i & 3) + 8 * (i >> 2));
            const bool valid = __builtin_fabsf(deltaf - mid) <= half;
            const float sv = valid ? sacc[i] * sc2 - sl2 * __builtin_fabsf(deltaf) : -1e30f; sacc[i] = sv; tmax = fmaxf(tmax, sv); }
        tmax = fmaxf(tmax, __shfl_xor(tmax, 32));
        const float m_new = tmax > m_run + 8.0f ? tmax : m_run;
        if (__any(m_new != m_run)) { const float alpha = __builtin_amdgcn_exp2f(m_run - m_new);
            l_run *= alpha;
#pragma unroll
            for (int i = 0; i < 4; ++i) o[i] *= alpha; }
        m_run = m_new;
        float psum = 0.f;
#pragma unroll
        for (int i = 0; i < 16; ++i) { const float pi = __builtin_amdgcn_exp2f(sacc[i] - m_new); psum += pi; sacc[i] = pi; }
        l_run += psum;
        bf16x8 pf[2];
#pragma unroll
        for (int s = 0; s < 2; ++s) { const unsigned w0 = pk2(sacc[8 * s], sacc[8 * s + 1]), w1 = pk2(sacc[8 * s + 2], sacc[8 * s + 3]), w2 = pk2(sacc[8 * s + 4], sacc[8 * s + 5]), w3 = pk2(sacc[8 * s + 6], sacc[8 * s + 7]);
            pf[s] = __builtin_bit_cast(bf16x8, (u32x4){w0, w1, w2, w3}); }
#pragma unroll
        for (int c4 = 0; c4 < 4; ++c4) {
            s16x4 r00, r01, r10, r11; tr_read4(vb0 ^ (unsigned)(c4 << 6), vb1 ^ (unsigned)(c4 << 6), r00, r01, r10, r11);
            const bf16x8 v0 = __builtin_shufflevector(r00, r01, 0, 1, 2, 3, 4, 5, 6, 7), v1 = __builtin_shufflevector(r10, r11, 0, 1, 2, 3, 4, 5, 6, 7);
            o[c4] = __builtin_amdgcn_mfma_f32_32x32x16_bf16(v0, pf[0], o[c4], 0, 0, 0);
            o[c4] = __builtin_amdgcn_mfma_f32_32x32x16_bf16(v1, pf[1], o[c4], 0, 0, 0); }
    }
    const float ltot = l_run + __shfl_xor(l_run, 32);
    if constexpr (PASS == 0) {
#pragma unroll
        for (int c4 = 0; c4 < 4; ++c4)
#pragma unroll
            for (int g4 = 0; g4 < 4; ++g4) *(uint2*)(st_o + 32 * c4 + 8 * g4 + 4 * hh) = make_uint2(pk2(o[c4][4 * g4], o[c4][4 * g4 + 1]), pk2(o[c4][4 * g4 + 2], o[c4][4 * g4 + 3]));
        if (hh == 0) *(f32x2*)st_ml = (f32x2){m_run, ltot};
    } else {
        const float inv = 1.0f / ltot;
        bf16_t* orow = p.AO + (size_t)(b * SEQ + tq) * DM + 1024 + h * 128;
#pragma unroll
        for (int c4 = 0; c4 < 4; ++c4)
#pragma unroll
            for (int g4 = 0; g4 < 4; ++g4) { const int dh = 32 * c4 + 8 * g4 + 4 * hh;
                if constexpr (D8_OUT0) *(unsigned*)((unsigned char*)p.AO + (size_t)(b * SEQ + tq) * DM + 1024 + h * 128 + dh) = pk4_fp8(o[c4][4 * g4] * inv, o[c4][4 * g4 + 1] * inv, o[c4][4 * g4 + 2] * inv, o[c4][4 * g4 + 3] * inv, A8_SCALE);
                else *(uint2*)(orow + dh) = make_uint2(pk2(o[c4][4 * g4] * inv, o[c4][4 * g4 + 1] * inv), pk2(o[c4][4 * g4 + 2] * inv, o[c4][4 * g4 + 3] * inv)); }
    }
}
DI void attention(const Params& p, LAS unsigned char* lds) {
    const int tid = opaque_tid(), wave = __builtin_amdgcn_readfirstlane(tid >> 6), lane = tid & 63, hh = lane >> 5;
    LAS unsigned char* vimg = lds + wave * 8192;
    const unsigned vbase = (unsigned)(uintptr_t)vimg;
    const int q4 = (lane & 15) >> 2, pp = lane & 3, blk = (lane >> 4) & 1;
    const unsigned vb0 = vbase + 256u * (4 * hh + q4) + 16u * ((2 * blk + (pp >> 1)) ^ (hh & 3)) + 8u * (pp & 1) + ((unsigned)q4 << 6);
    const unsigned vb1 = vbase + 256u * (8 + 4 * hh + q4) + 16u * ((2 * blk + (pp >> 1)) ^ ((2 + hh) & 3)) + 8u * (pp & 1) + ((unsigned)q4 << 6);
    for (int u = blockIdx.x; u < 256; u += gridDim.x) {
        const int bh = (u & 7) * 4 + ((u >> 3) >> 3), span = (u >> 3) & 7, h = bh & 7, b = bh >> 3;
#pragma unroll 1
        for (int j = 0; j < 2; ++j) attn_wave<0>(p, vimg, vb0, vb1, lane, b, h, span * 512 + wave * 2 + j);
        asm volatile("s_waitcnt vmcnt(0)" ::: "memory");
        __syncthreads();
#pragma unroll 1
        for (int j = 0; j < 2; ++j) attn_wave<1>(p, vimg, vb0, vb1, lane, b, h, span * 512 + (wave * 2 + j) * 32);
        __syncthreads();
    }
}
DI float om_exp2x(float la, float a) {
    const float x = 2.f * la;
    const float pl = x * (1.f + x * (0.5f + x * (0.16666667f + x * (0.041666668f + x * 0.008333334f))));
    return x > -0.25f ? -pl : 1.f - a * a;
}
DI void lru_conv(const Params& p) {
    const int tid = opaque_tid();
    if (tid < 336) {
        const int ch = tid * 8;
        float cw[4][8], cb[8];
#pragma unroll
        for (int j = 0; j < 4; ++j) { const f32x4 w0 = *(const f32x4*)(p.lru_conv_w + j * LRU_W + ch), w1 = *(const f32x4*)(p.lru_conv_w + j * LRU_W + ch + 4);
            cw[j][0] = w0[0]; cw[j][1] = w0[1]; cw[j][2] = w0[2]; cw[j][3] = w0[3]; cw[j][4] = w1[0]; cw[j][5] = w1[1]; cw[j][6] = w1[2]; cw[j][7] = w1[3]; }
        { const f32x4 b0 = *(const f32x4*)(p.lru_conv_b + ch), b1 = *(const f32x4*)(p.lru_conv_b + ch + 4); cb[0] = b0[0]; cb[1] = b0[1]; cb[2] = b0[2]; cb[3] = b0[3]; cb[4] = b1[0]; cb[5] = b1[1]; cb[6] = b1[2]; cb[7] = b1[3]; }
        for (int run = blockIdx.x; run < T_TOK / 32; run += gridDim.x) {
            const int tok0 = run * 32, t0 = tok0 % SEQ;
            const bf16_t* src = p.G + (size_t)tok0 * N_IN1 + LRU_W + ch;
            u32x4 rows[35];
#pragma unroll
            for (int i = 0; i < 35; ++i) { const int t = t0 - 2 + i; rows[i] = (t >= 0 && t < SEQ) ? *(const u32x4*)(src + (ptrdiff_t)(i - 2) * N_IN1) : (u32x4){0u, 0u, 0u, 0u}; }
#pragma unroll
            for (int i = 0; i < 32; ++i) { float xc[8];
#pragma unroll
                for (int e = 0; e < 8; ++e) xc[e] = cb[e];
#pragma unroll
                for (int j = 0; j < 4; ++j) { const u32x4 xv = rows[i + j];
                    xc[0] += cw[j][0] * bflo(xv[0]); xc[1] += cw[j][1] * bfhi(xv[0]); xc[2] += cw[j][2] * bflo(xv[1]); xc[3] += cw[j][3] * bfhi(xv[1]);
                    xc[4] += cw[j][4] * bflo(xv[2]); xc[5] += cw[j][5] * bfhi(xv[2]); xc[6] += cw[j][6] * bflo(xv[3]); xc[7] += cw[j][7] * bfhi(xv[3]); }
                *(u32x4*)(p.XC + (size_t)(tok0 + i) * LRU_W + ch) = (u32x4){pk2(xc[0], xc[1]), pk2(xc[2], xc[3]), pk2(xc[4], xc[5]), pk2(xc[6], xc[7])}; }
        }
    }
}
DI void lru(const Params& p, LAS unsigned char* lds) {
    const int tid = opaque_tid(), wave = __builtin_amdgcn_readfirstlane(tid >> 6), lane = tid & 63, col = lane & 15, g = lane >> 4;
    LAS unsigned char* wl = lds;
    LAS unsigned char* xs = lds + 36864;
    LAS float* sums = (LAS float*)(lds + 36864 + 86016);
    LAS float* cst = sums + 1920;
    for (int u = blockIdx.x; u < 256; u += gridDim.x) {
        const int b = u >> 6, n = (u >> 2) & 15, qt = u & 3, chq = n * LRU_BW + qt * 42;
        const char* xcb = (const char*)(p.XC + (size_t)(b * SEQ) * LRU_W + n * LRU_BW);
        const bf16_t* gb = p.G + (size_t)(b * SEQ) * N_IN1;
        unsigned poff[6];
#pragma unroll
        for (int i = 0; i < 6; ++i) { const int idx = tid + 512 * i; poff[i] = (unsigned)((idx / 21) * LRU_W + (idx % 21) * 8) * 2u; }
        auto dma_chunk = [&](int chunk, int bsel) { const char* src = xcb + (size_t)chunk * 128 * LRU_W * 2; LAS unsigned char* dst = xs + bsel * 43008 + wave * 1024;
#pragma unroll
            for (int i = 0; i < 5; ++i) __builtin_amdgcn_global_load_lds((const unsigned*)(src + poff[i]), (LAS unsigned*)(dst + i * 8192), 16, 0, 0);
            if (wave < 2) __builtin_amdgcn_global_load_lds((const unsigned*)(src + poff[5]), (LAS unsigned*)(dst + 5 * 8192), 16, 0, 0); };
        for (int dir = 0; dir < 2; ++dir) {
            __syncthreads();
            for (int i = tid; i < 2 * 48 * 24; i += 512) { const int which = i / (48 * 24), r = (i / 24) % 48, ck = i % 24; const int nt = r >> 4, cl = r & 15, ks = ck >> 2, gg = ck & 3;
                *(LAS u32x4*)(wl + ((which * 3 + nt) * 6 + ks) * 1024 + (gg * 16 + cl) * 16) = *(const u32x4*)(p.w_lru + ((((size_t)(dir * 2 + which) * 16 + n) * 4 + qt) * 48 + r) * 192 + ck * 8); }
            if (tid < 48) { const bool valid = tid < 42; const int ch = dir * LRU_W + chq + tid;
                cst[tid] = valid ? -1.44269504f * p.lru_b_a[ch] : 0.f; cst[48 + tid] = valid ? -1.44269504f * p.lru_b_x[ch] : 0.f;
                const float lam = valid ? p.lru_lambda[ch] : 0.f; const float sp = (-lam > 20.f) ? -lam : log1pf(__expf(-lam)); cst[96 + tid] = -8.0f * 1.44269504f * sp; }
            dma_chunk(dir == 0 ? 0 : 31, 0);
            asm volatile("s_waitcnt vmcnt(0)" ::: "memory");
            __syncthreads();
            float cba[3], cbx[3], cex[3];
#pragma unroll
            for (int nt = 0; nt < 3; ++nt) { cba[nt] = cst[nt * 16 + col]; cbx[nt] = cst[48 + nt * 16 + col]; cex[nt] = cst[96 + nt * 16 + col]; }
            bf16x8 breg[3][6];
#pragma unroll
            for (int nt = 0; nt < 3; ++nt)
#pragma unroll
                for (int ks = 0; ks < 6; ++ks) { breg[nt][ks] = *(const LAS bf16x8*)(wl + (nt * 6 + ks) * 1024 + lane * 16); asm volatile("" : "+v"(breg[nt][ks])); }
            const int wpos = dir == 0 ? wave : 7 - wave;
            float carry[3] = {0.f, 0.f, 0.f};
            for (int step = 0; step < 32; ++step) {
                const int c = dir == 0 ? step : 31 - step, c0 = c * 128, par = step & 1;
                const bool has_next = step < 31;
                if (has_next) dma_chunk(dir == 0 ? c + 1 : c - 1, par ^ 1);
                LAS unsigned char* xb = xs + par * 43008;
                uint2 hfv[3] = {make_uint2(0u, 0u), make_uint2(0u, 0u), make_uint2(0u, 0u)}; unsigned short gtv[3][4];
                const uint2* hfp = (const uint2*)p.HF + ((size_t)((u * 32 + c) * 8 + wave) * 3) * 64 + lane;
                const bf16_t* gbw = gb + (size_t)(c0 + wave * 16) * N_IN1 + chq;
                bf16_t* aow = p.AO + (size_t)(b * SEQ + c0 + wave * 16) * LRU_W + chq;
                if (dir == 1) {
#pragma unroll
                    for (int nt = 0; nt < 3; ++nt) { hfv[nt] = hfp[nt * 64];
#pragma unroll
                        for (int r = 0; r < 4; ++r) gtv[nt][r] = (nt * 16 + col < 42) ? gbw[(unsigned)((4 * g + r) * N_IN1 + nt * 16 + col)] : (unsigned short)0; } }
                bf16x8 af[6];
#pragma unroll
                for (int ks = 0; ks < 6; ++ks) { const int ch0 = 32 * ks + 8 * g; const bool kval = ch0 < LRU_BW; const int chl0 = kval ? ch0 : 160;
                    const u32x4 xv = *(const LAS u32x4*)(xb + (wave * 16 + col) * 336 + chl0 * 2);
                    af[ks] = __builtin_bit_cast(bf16x8, kval ? xv : (u32x4){0u, 0u, 0u, 0u}); }
                f32x4 acc[2][3];
                {
                    bf16x8 bl[6];
                    const LAS unsigned char* wl1 = wl + 18 * 1024 + lane * 16;
#pragma unroll
                    for (int ks = 0; ks < 6; ++ks) bl[ks] = *(const LAS bf16x8*)(wl1 + ks * 1024);
#pragma unroll
                    for (int nt = 0; nt < 3; ++nt) {
                        acc[0][nt] = (f32x4){0.f, 0.f, 0.f, 0.f}; acc[1][nt] = (f32x4){0.f, 0.f, 0.f, 0.f};
#pragma unroll
                        for (int ks = 0; ks < 6; ++ks) acc[0][nt] = __builtin_amdgcn_mfma_f32_16x16x32_bf16(af[ks], breg[nt][ks], acc[0][nt], 0, 0, 0);
#pragma unroll
                        for (int ks = 0; ks < 6; ++ks) { acc[1][nt] = __builtin_amdgcn_mfma_f32_16x16x32_bf16(af[ks], bl[ks], acc[1][nt], 0, 0, 0);
                            if (nt < 2) bl[ks] = *(const LAS bf16x8*)(wl1 + ((nt + 1) * 6 + ks) * 1024); }
                    }
                }
                float hl[3][4], Pl[3][4];
#pragma unroll
                for (int nt = 0; nt < 3; ++nt) { const int chl = nt * 16 + col;
                    float av[4], uv[4];
#pragma unroll
                    for (int r = 0; r < 4; ++r) {
                        const float rg = __builtin_amdgcn_rcpf(1.0f + __builtin_amdgcn_exp2f(__builtin_fmaf(acc[0][nt][r], -1.44269504f, cba[nt])));
                        const float ig = __builtin_amdgcn_rcpf(1.0f + __builtin_amdgcn_exp2f(__builtin_fmaf(acc[1][nt][r], -1.44269504f, cbx[nt])));
                        const float a = __builtin_amdgcn_exp2f(cex[nt] * rg);
                        const float xcv = bf2f(*(const LAS bf16_t*)(xb + (wave * 16 + 4 * g + r) * 336 + (qt * 42 + chl) * 2));
                        av[r] = a; uv[r] = __builtin_amdgcn_sqrtf(__builtin_fmaf(-a, a, 1.0f)) * (ig * xcv); }
                    float h[4], P[4], A, H;
                    if (dir == 0) { h[0] = uv[0]; P[0] = av[0];
#pragma unroll
                        for (int r = 1; r < 4; ++r) { h[r] = av[r] * h[r - 1] + uv[r]; P[r] = av[r] * P[r - 1]; }
                        A = P[3]; H = h[3];
                        { const float A1 = __shfl_up(A, 16), H1 = __shfl_up(H, 16); if (g >= 1) { H = A * H1 + H; A = A * A1; } }
                        { const float A2 = __shfl_up(A, 32), H2 = __shfl_up(H, 32); if (g >= 2) { H = A * H2 + H; A = A * A2; } }
                        float Ae = __shfl_up(A, 16), He = __shfl_up(H, 16); if (g == 0) { Ae = 1.f; He = 0.f; }
#pragma unroll
                        for (int r = 0; r < 4; ++r) { hl[nt][r] = h[r] + P[r] * He; Pl[nt][r] = P[r] * Ae; }
                        if (g == 3) *(LAS f32x2*)(sums + (par * 48 + chl) * 20 + wpos * 2) = (f32x2){A, H};
                    } else { h[3] = uv[3]; P[3] = av[3];
#pragma unroll
                        for (int r = 2; r >= 0; --r) { h[r] = av[r] * h[r + 1] + uv[r]; P[r] = av[r] * P[r + 1]; }
                        A = P[0]; H = h[0];
                        { const float A1 = __shfl_down(A, 16), H1 = __shfl_down(H, 16); if (g <= 2) { H = A * H1 + H; A = A * A1; } }
                        { const float A2 = __shfl_down(A, 32), H2 = __shfl_down(H, 32); if (g <= 1) { H = A * H2 + H; A = A * A2; } }
                        float Ae = __shfl_down(A, 16), He = __shfl_down(H, 16); if (g == 3) { Ae = 1.f; He = 0.f; }
#pragma unroll
                        for (int r = 0; r < 4; ++r) { hl[nt][r] = h[r] + P[r] * He; Pl[nt][r] = P[r] * Ae; }
                        if (g == 0) *(LAS f32x2*)(sums + (par * 48 + chl) * 20 + wpos * 2) = (f32x2){A, H};
                    }
                }
                asm volatile("s_waitcnt vmcnt(0)" ::: "memory");
                __syncthreads();
                f32x4 sv[3][4];
#pragma unroll
                for (int nt = 0; nt < 3; ++nt)
#pragma unroll
                    for (int j = 0; j < 4; ++j) sv[nt][j] = *(const LAS f32x4*)(sums + (par * 48 + nt * 16 + col) * 20 + j * 4);
#pragma unroll
                for (int nt = 0; nt < 3; ++nt) { const int chl = nt * 16 + col; float C = carry[nt], Cw = 0.f;
#pragma unroll
                    for (int k = 0; k < 8; ++k) { if (k == wpos) Cw = C; C = sv[nt][k >> 1][(k & 1) * 2] * C + sv[nt][k >> 1][(k & 1) * 2 + 1]; }
                    carry[nt] = C;
                    float hv[4];
#pragma unroll
                    for (int r = 0; r < 4; ++r) hv[r] = hl[nt][r] + Pl[nt][r] * Cw;
                    if (dir == 0) ((uint2*)p.HF)[((size_t)((u * 32 + c) * 8 + wave) * 3 + nt) * 64 + lane] = make_uint2(pk2(hv[0], hv[1]), pk2(hv[2], hv[3]));
                    else if (chl < 42) { const float ff[4] = {bflo(hfv[nt].x), bfhi(hfv[nt].x), bflo(hfv[nt].y), bfhi(hfv[nt].y)};
#pragma unroll
                        for (int r = 0; r < 4; ++r) aow[(unsigned)((4 * g + r) * LRU_W + chl)] = f2bf(bf2f(gtv[nt][r]) * (ff[r] + hv[r])); }
                }
            }
        }
    }
}
}

#define XB_TMO      128
#define XB_XCNT(j)  (256  + 64 * (j))
#define XB_XSUB(j)  (1280 + 64 * (j))
#define XB_XGEN(j)  (2304 + 64 * (j))
#define XB_TOP      3328
#define XB_TOPGEN   3392
#define XCD_BAR_WORDS 3456
#define XB_SPIN_CAP (1u << 18)

__device__ __forceinline__ unsigned xb_ld(unsigned* p)              { return __hip_atomic_load(p, __ATOMIC_RELAXED, __HIP_MEMORY_SCOPE_AGENT); }
__device__ __forceinline__ unsigned xb_add(unsigned* p, unsigned v) { return __hip_atomic_fetch_add(p, v, __ATOMIC_RELAXED, __HIP_MEMORY_SCOPE_AGENT); }
__device__ __forceinline__ unsigned xb_xcc_id() { return (unsigned)__builtin_amdgcn_s_getreg((3 << 11) | 20) & 0xFu; }
#define XB_SPIN(cond, bar) do { unsigned _sp = 0; while (cond) { __builtin_amdgcn_s_sleep(1); \
    if ((++_sp & 255u) == 0u) { if (xb_ld(&(bar)[XB_TMO])) break; if (_sp > XB_SPIN_CAP) { atomicAdd(&(bar)[XB_TMO], 1u); break; } } } } while (0)

struct XcdBarrier {
    unsigned* bar; unsigned x;
    volatile LAS unsigned* st;
};

__device__ __forceinline__ XcdBarrier xcd_barrier_post(unsigned* bar, volatile LAS unsigned* st) {
    XcdBarrier b; b.bar = bar; b.x = xb_xcc_id(); b.st = st;
    if (threadIdx.x == 0) (void)xb_add(&bar[XB_XCNT(b.x)], 1u);
    return b;
}
__device__ __forceinline__ void xcd_barrier_complete(unsigned* bar, unsigned x, unsigned& nloc, unsigned& nx) {
    const unsigned G = gridDim.x * gridDim.y * gridDim.z;
    unsigned sum, cnt, mine, sp = 0u;
    for (;;) {
        sum = 0u; cnt = 0u; mine = 0u;
#pragma unroll
        for (unsigned j = 0; j < 16; ++j) { const unsigned c = xb_ld(&bar[XB_XCNT(j)]); sum += c; cnt += (c > 0u) ? 1u : 0u; mine = (j == x) ? c : mine; }
        if (sum == G) break;
        __builtin_amdgcn_s_sleep(1);
        if ((++sp & 255u) == 0u) { if (xb_ld(&bar[XB_TMO])) break; if (sp > XB_SPIN_CAP) { atomicAdd(&bar[XB_TMO], 1u); break; } }
    }
    nloc = mine > 0u ? mine : 1u; nx = cnt > 0u ? cnt : 1u;
}

__device__ __forceinline__ void xcd_barrier(const XcdBarrier& b) {
    asm volatile("s_waitcnt vmcnt(0)" ::: "memory");
    __syncthreads();
    if (threadIdx.x == 0) {
        unsigned* bar = b.bar;
        __builtin_amdgcn_s_waitcnt(0);
        unsigned nloc = b.st[0], nx = b.st[1];
        if (nloc == 0u) { xcd_barrier_complete(bar, b.x, nloc, nx); b.st[0] = nloc; b.st[1] = nx; }
        const unsigned old = xb_add(&bar[XB_XSUB(b.x)], 1u);
        const unsigned gen = old / nloc;
        if (old + 1u == (gen + 1u) * nloc) {
            __builtin_amdgcn_fence(__ATOMIC_RELEASE, "agent");
            asm volatile("s_waitcnt vmcnt(0)" ::: "memory");
            const unsigned og = xb_add(&bar[XB_TOP], 1u);
            const unsigned tg = og / nx;
            if (og + 1u == (tg + 1u) * nx) xb_add(&bar[XB_TOPGEN], 1u);
            else XB_SPIN(xb_ld(&bar[XB_TOPGEN]) == tg, bar);
            __builtin_amdgcn_fence(__ATOMIC_ACQUIRE, "agent");
            xb_add(&bar[XB_XGEN(b.x)], 1u);
            asm volatile("s_waitcnt vmcnt(0)" ::: "memory");
        } else {
            XB_SPIN(xb_ld(&bar[XB_XGEN(b.x)]) == gen, bar);
            __builtin_amdgcn_fence(__ATOMIC_ACQUIRE, "agent");
            asm volatile("s_waitcnt vmcnt(0)" ::: "memory");
        }
    }
    __syncthreads();
}


constexpr int PROBE = 0;
constexpr int LDS_XB_OFF = gm::STAGE_BYTES + 1024;
constexpr int LDS_TOTAL = LDS_XB_OFF + 16;
__global__ void __launch_bounds__(512, 2) mega(Params p) {
    LAS unsigned char* lds = (LAS unsigned char*)dyn_smem;
    LAS int* tab = (LAS int*)(lds + gm::TAB_OFF);
    volatile LAS unsigned* xbw = (volatile LAS unsigned*)(lds + LDS_XB_OFF);
    if (threadIdx.x == 0) { xbw[0] = 0u; xbw[1] = 0u; xbw[2] = 0u; xbw[3] = 0u; }
    __syncthreads();
    XcdBarrier bar = xcd_barrier_post(p.bar, xbw);
    ph::mods(p, lds);
    if constexpr (PROBE == 14) { ph::mods(p, lds); ph::mods(p, lds); }
    xcd_barrier(bar);
    { const int c = blockIdx.x, G = gridDim.x;
      ph::transposer(p, lds, c, c < 320 ? (320 - c + G - 1) / G : 0, G); __syncthreads();
      ph::transposer(p, lds, 320 + c, c < 632 ? (632 - c + G - 1) / G : 0, G); __syncthreads(); }
    ph::lru_weights(p);
    ph::fold_router(p);
    ph::norm_rows<0, D8_IN0>(p, p.x, p.norm0_mix, 0, 0, nullptr);
    xcd_barrier(bar);
    { const int c = blockIdx.x, G = gridDim.x; const int tcount = c < 6144 ? (6144 - c + G - 1) / G : 0; const bool t_first = ((c >> 3) & 1) != 0;
      if (t_first) { ph::transposer(p, lds, 952 + c, tcount, G); __syncthreads(); }
      { gm::DenseSched S; S.init(T_TOK, N_IN0); EpiIn0 e; e.xin = nullptr; e.lgate = 0; if constexpr (D8_IN0) gm::gemm_phase<EpiIn0, gm::DenseSched, true>(lds, p, p.H, p.w_in0t, 0, DM / 2, S, e, W8_E8M0, A8_E8M0); else gm::gemm_phase(lds, p, p.H, p.w_in0t, 0, DM, S, e); }
      if (!t_first) { __syncthreads(); ph::transposer(p, lds, 952 + c, tcount, G); }
      if constexpr (PROBE == 21) { __syncthreads(); ph::transposer(p, lds, 952 + c, tcount, G); }
      if constexpr (PROBE == 24) { __syncthreads(); if (t_first) ph::transposer(p, lds, 952 + c, tcount, G); }
      if constexpr (PROBE == 23) { __syncthreads(); if (t_first) { ph::transposer(p, lds, 952 + c, tcount, G); __syncthreads(); }
        { gm::DenseSched S; S.init(T_TOK, N_IN0); EpiIn0 e; e.xin = nullptr; e.lgate = 0; gm::gemm_phase<EpiIn0, gm::DenseSched, true>(lds, p, p.H, p.w_in0t, 0, DM / 2, S, e, W8_E8M0, A8_E8M0); }
        if (!t_first) { __syncthreads(); ph::transposer(p, lds, 952 + c, tcount, G); } }
      if constexpr (PROBE == 20) { __syncthreads(); gm::DenseSched S; S.init(T_TOK, N_IN0); EpiIn0 e; e.xin = nullptr; e.lgate = 0; gm::gemm_phase<EpiIn0, gm::DenseSched, true>(lds, p, p.H, p.w_in0t, 0, DM / 2, S, e, W8_E8M0, A8_E8M0); } }
    xcd_barrier(bar);
    ph::attention(p, lds);
    if constexpr (PROBE == 4) ph::attention(p, lds);
    __syncthreads();
    ph::conv_gln(p, lds);
    if constexpr (PROBE == 5) ph::conv_gln(p, lds);
    xcd_barrier(bar);
    { gm::DenseSched S; S.init(T_TOK, DM); EpiOutT<true> e; e.xin = p.x; e.lgate = 0; if constexpr (D8_OUT0) gm::gemm_phase<EpiOutT<true>, gm::DenseSched, true>(lds, p, p.AO, p.w_out0t, 0, DM / 2, S, e, W8_E8M0, A8_E8M0); else gm::gemm_phase(lds, p, p.AO, p.w_out0t, 0, DM, S, e); }
    xcd_barrier(bar);
    ph::router<false, true>(p, 0, lds, p.norm0_ffn, 1);
    if constexpr (PROBE == 12) { ph::router<true>(p, 0, lds); ph::router<true>(p, 0, lds); }
    xcd_barrier(bar);
    if constexpr (PROBE == 11) { xcd_barrier(bar); xcd_barrier(bar); xcd_barrier(bar); xcd_barrier(bar); xcd_barrier(bar); xcd_barrier(bar); xcd_barrier(bar); xcd_barrier(bar); xcd_barrier(bar); xcd_barrier(bar); }
    gm::moe_tables(tab, p.cnt);
    { gm::MoeSched<true> S; S.init(tab); EpiGU e; e.xin = nullptr; e.lgate = 0; gm::gemm_phase<EpiGU, gm::MoeSched<true>, true>(lds, p, p.H, p.w_gut0, (size_t)2048 * (DM / 2), DM / 2, S, e, W8_E8M0, A8_E8M0); if constexpr (PROBE == 3) gm::gemm_phase<EpiGU, gm::MoeSched<true>, true>(lds, p, p.H, p.w_gut0, (size_t)2048 * (DM / 2), DM / 2, S, e, W8_E8M0, A8_E8M0); }
    xcd_barrier(bar);
    { gm::MoeSched<false> S; S.init(tab); EpiDown e; e.xin = nullptr; e.lgate = 0; gm::gemm_phase<EpiDown, gm::MoeSched<false>, true>(lds, p, p.ACT, p.w_dt0, (size_t)DM * (EFF / 2), EFF / 2, S, e, W8_E8M0, A8_E8M0); if constexpr (PROBE == 8) gm::gemm_phase<EpiDown, gm::MoeSched<false>, true>(lds, p, p.ACT, p.w_dt0, (size_t)DM * (EFF / 2), EFF / 2, S, e, W8_E8M0, A8_E8M0); }
    xcd_barrier(bar);
    ph::norm_rows<1, D8_IN1>(p, nullptr, p.norm1_mix, 2, 1, tab);
    xcd_barrier(bar);
    { const int c = blockIdx.x, G = gridDim.x; int tfirst, tcount, tstride;
      if (G == 256) { tstride = 1; if (c < 64) { tcount = 18; tfirst = 18 * c; } else { tcount = 26; tfirst = 1152 + 26 * (c - 64); } }
      else { tstride = G; tfirst = c; tcount = c < 6144 ? (6144 - c + G - 1) / G : 0; }
      const bool t_first = ((c >> 3) & 1) != 0;
      if (t_first) { ph::transposer(p, lds, 7096 + tfirst, tcount, tstride); __syncthreads(); }
      { gm::DenseSched S; S.init(T_TOK, N_IN1); EpiIn1 e; e.xin = nullptr; e.lgate = 0; gm::gemm_phase(lds, p, p.H, p.w_in1t, 0, DM, S, e); }
      if (!t_first) { __syncthreads(); ph::transposer(p, lds, 7096 + tfirst, tcount, tstride); } }
    xcd_barrier(bar);
    ph::lru_conv(p);
    if constexpr (PROBE == 9) { ph::lru_conv(p); ph::lru_conv(p); }
    xcd_barrier(bar);
    ph::lru(p, lds);
    if constexpr (PROBE == 6) ph::lru(p, lds);
    xcd_barrier(bar);
    { gm::DenseSched S; S.init(T_TOK, DM); EpiOutT<false> e; e.xin = nullptr; e.lgate = 2; gm::gemm_phase(lds, p, p.AO, p.w_out1t, 0, LRU_W, S, e); }
    xcd_barrier(bar);
    ph::router<false, true>(p, 1, lds, p.norm1_ffn, 3);
    xcd_barrier(bar);
    gm::moe_tables(tab, p.cnt + 32);
    { gm::MoeSched<true> S; S.init(tab); EpiGU e; e.xin = nullptr; e.lgate = 0; gm::gemm_phase<EpiGU, gm::MoeSched<true>, true>(lds, p, p.H, p.w_gut1, (size_t)2048 * (DM / 2), DM / 2, S, e, W8_E8M0, A8_E8M0); }
    xcd_barrier(bar);
    { gm::MoeSched<false> S; S.init(tab); EpiDown e; e.xin = nullptr; e.lgate = 0; gm::gemm_phase<EpiDown, gm::MoeSched<false>, true>(lds, p, p.ACT, p.w_dt1, (size_t)DM * (EFF / 2), EFF / 2, S, e, W8_E8M0, A8_E8M0); }
    xcd_barrier(bar);
    ph::norm_rows<2>(p, nullptr, p.norm_final, 0, 3, tab);
}

static inline size_t al256(size_t x) { return (x + 255) & ~(size_t)255; }

extern "C" void kernel_launch(void* const* d_in, const int* in_sizes, int n_in, void* d_out, int out_size, void* d_ws, size_t ws_size, hipStream_t stream) {
    Params p{};
    const float** ip = (const float**)&p.x;
    for (int i = 0; i < 38; ++i) ip[i] = (const float*)d_in[i];
    p.out = (float*)d_out;
    char* w = (char*)d_ws; size_t off = 0;
    auto take = [&](size_t bytes) { char* r = w + off; off += al256(bytes); return r; };
    p.bar = (unsigned*)take(16384); p.cnt = (int*)take(256);
    const size_t zero_bytes = off;
    p.mod = (float*)take(4 * 4 * 6144 * 4); p.wrt = (bf16_t*)take((size_t)2 * 4 * 3 * 48 * 2048 * 2); p.rbias = (float*)take(2 * 4 * 48 * 4);
    p.w_in0t = (bf16_t*)take((size_t)N_IN0 * DM * 2); p.w_out0t = (bf16_t*)take((size_t)DM * DM * 2);
    p.w_gut0 = (bf16_t*)take((size_t)NEXP * 2048 * DM); p.w_dt0 = (bf16_t*)take((size_t)NEXP * DM * EFF);
    p.w_in1t = (bf16_t*)take((size_t)N_IN1 * DM * 2); p.w_out1t = (bf16_t*)take((size_t)DM * LRU_W * 2);
    p.w_gut1 = (bf16_t*)take((size_t)NEXP * 2048 * DM); p.w_dt1 = (bf16_t*)take((size_t)NEXP * DM * EFF);
    p.w_lru = (bf16_t*)take((size_t)2 * 2 * 16 * 2 * 96 * 192 * 2);
    p.H = (bf16_t*)take((size_t)T_TOK * DM * 2); p.G = (bf16_t*)take((size_t)T_TOK * N_IN1 * 2); p.AO = (bf16_t*)take((size_t)T_TOK * LRU_W * 2); p.HF = (bf16_t*)take((size_t)256 * 32 * 8 * 3 * 64 * 8);
    p.XA = (bf16_t*)take((size_t)T_TOK * DM * 2); p.ACT = (bf16_t*)take((size_t)ROWS_PAD * EFF * 2); p.YB = (bf16_t*)take((size_t)ROWS_PAD * DM * 2);
    p.XC = (bf16_t*)take((size_t)T_TOK * LRU_W * 2); p.KVH = (bf16_t*)take((size_t)NBATCH * 8 * 2 * SEQ * 128 * 2);
    p.tokl = (int*)take((size_t)NEXP * ECAP * 4); p.gatel = (float*)take((size_t)NEXP * ECAP * 4); p.asg = (int*)take((size_t)T_TOK * 2 * 4);
    if (off > ws_size) return;
    (void)hipMemsetAsync(d_ws, 0, zero_bytes, stream);
    static int grid = 0;
    if (!grid) { int dev = 0, cus = 0, per_cu = 0; (void)hipGetDevice(&dev); (void)hipDeviceGetAttribute(&cus, hipDeviceAttributeMultiprocessorCount, dev);
        (void)hipFuncSetAttribute((const void*)mega, hipFuncAttributeMaxDynamicSharedMemorySize, LDS_TOTAL);
        (void)hipOccupancyMaxActiveBlocksPerMultiprocessor(&per_cu, mega, 512, LDS_TOTAL);
        grid = cus * (per_cu < 1 ? per_cu : 1); }
    if (grid > 0) mega<<<grid, 512, LDS_TOTAL, stream>>>(p);
}
```

```cpp
#include <hip/hip_runtime.h>
#include <stdint.h>

typedef unsigned short bf16_t;
typedef float f32x4 __attribute__((ext_vector_type(4)));

#define DI __device__ __forceinline__

constexpr int T_TOK = 16384, DM = 2048, SEQ = 4096, NBATCH = 4;
constexpr int N_IN0 = 5120, N_IN1 = 5376, LRU_W = 2688, LRU_BW = 168;
constexpr int NEXP = 32, EFF = 1024, ECAP = 16384, ROWS_PAD = 40960;

DI float bf2f(bf16_t b) { return __uint_as_float(((unsigned)b) << 16); }
DI bf16_t f2bf(float f) { unsigned u = __float_as_uint(f); u += 0x7FFFu + ((u >> 16) & 1u); return (bf16_t)(u >> 16); }
DI float sigmoidf_(float x) { return __builtin_amdgcn_rcpf(1.0f + __expf(-x)); }
DI float siluf_(float x) { return x * __builtin_amdgcn_rcpf(1.0f + __expf(-x)); }
DI float gelu_tanh(float x) { const float u = 0.7978845608028654f * (x + 0.044715f * x * x * x); return x * __builtin_amdgcn_rcpf(1.0f + __expf(-2.0f * u)); }
template <int CTRL, int ROWMASK> DI float dpp_mov(float oldv, float v) { return __builtin_bit_cast(float, __builtin_amdgcn_update_dpp(__builtin_bit_cast(int, oldv), __builtin_bit_cast(int, v), CTRL, ROWMASK, 0xf, false)); }
DI float wave_sum(float v) {
    v += dpp_mov<0xB1, 0xf>(0.f, v);
    v += dpp_mov<0x4E, 0xf>(0.f, v);
    v += dpp_mov<0x141, 0xf>(0.f, v);
    v += dpp_mov<0x140, 0xf>(0.f, v);
    v += dpp_mov<0x142, 0xa>(0.f, v);
    v += dpp_mov<0x143, 0xc>(0.f, v);
    return __builtin_bit_cast(float, __builtin_amdgcn_readlane(__builtin_bit_cast(int, v), 63)); }
DI float wave_max(float v) { for (int o = 32; o > 0; o >>= 1) v = fmaxf(v, __shfl_xor(v, o)); return v; }

struct Params {
    const float *x, *c;
    const float *norm0_mix, *ada0_mix_w, *ada0_mix_b, *w_in0, *conv_w, *conv_b, *conv_norm_g, *conv_norm_b, *w_out0;
    const float *norm0_ffn, *ada0_ffn_w, *ada0_ffn_b, *moe0_w_group, *moe0_w_expert, *moe0_w_gate_up, *moe0_w_down;
    const float *norm1_mix, *ada1_mix_w, *ada1_mix_b, *w_in1, *lru_conv_w, *lru_conv_b, *lru_w_a, *lru_b_a, *lru_w_x, *lru_b_x, *lru_lambda, *w_out1;
    const float *norm1_ffn, *ada1_ffn_w, *ada1_ffn_b, *moe1_w_group, *moe1_w_expert, *moe1_w_gate_up, *moe1_w_down;
    const float *norm_final;
    float* out;
    unsigned* bar; int* cnt;
    float* mod;
    bf16_t* wrt;
    float* rbias;
    bf16_t *w_in0t, *w_out0t, *w_gut0, *w_dt0, *w_in1t, *w_out1t, *w_gut1, *w_dt1, *w_lru;
    bf16_t *H, *G, *AO, *HF, *ACT, *YB, *XC, *KVH;
    bf16_t* XA;
    int* tokl; float* gatel; int* asg;
};

constexpr bool YB8_E = true;
struct GUnit { int rowbase; int nvalid; int e; const int* gather; };
struct GArgs { const bf16_t* A; const bf16_t* Bt; size_t bt_estride; long long lda, K, moe_layer; const float* xin; long long lgate; };
typedef unsigned u32x4_ __attribute__((ext_vector_type(4)));
typedef __bf16 bf2v_ __attribute__((ext_vector_type(2)));
typedef float f32x2_ __attribute__((ext_vector_type(2)));
DI unsigned pk2e(float a, float b) { f32x2_ v = {a, b}; bf2v_ r = __builtin_convertvector(v, bf2v_); return __builtin_bit_cast(unsigned, r); }
DI u32x4_ pack8(f32x4 a, f32x4 b) { return (u32x4_){pk2e(a[0], a[1]), pk2e(a[2], a[3]), pk2e(b[0], b[1]), pk2e(b[2], b[3])}; }
struct EpiIn0 { static constexpr bool GATHER = false, PRE = false; const float* xin; int lgate; DI void operator()(const Params& p, const GUnit& u, int r, int col0, f32x4 lo0, f32x4 lo1, f32x4 hi0, f32x4 hi1) const {
    const int row = u.rowbase + r;
    if (col0 < 3072) { bf16_t* o = p.G + (size_t)row * N_IN0 + col0; *(u32x4_*)o = pack8(lo0, lo1); *(u32x4_*)(o + 128) = pack8(hi0, hi1); }
    else { const int b = row / SEQ, t = row % SEQ, i0 = (col0 - 3072) >> 7, i1 = i0 + 1;
        bf16_t* o0 = p.KVH + ((size_t)((b * 8 + (i0 & 7)) * 2 + (i0 >> 3)) * SEQ + t) * 128 + (col0 & 127);
        bf16_t* o1 = p.KVH + ((size_t)((b * 8 + (i1 & 7)) * 2 + (i1 >> 3)) * SEQ + t) * 128 + (col0 & 127);
        *(u32x4_*)o0 = pack8(lo0, lo1); *(u32x4_*)o1 = pack8(hi0, hi1); } } };
template <bool F32RES> struct EpiOutT { static constexpr bool GATHER = false, PRE = true; const float* xin; int lgate;
    struct UPre { f32x4 g0, g1, g2, g3; };
    struct Pre { f32x4 x0, x1, x2, x3; u32x4_ a, c; };
    DI UPre unit_pre(const Params& p, const GUnit& u, int col0) const { const int b = u.rowbase / SEQ; const float* gt = p.mod + (lgate * 4 + b) * 6144 + 4096 + col0;
        UPre q; q.g0 = *(const f32x4*)gt; q.g1 = *(const f32x4*)(gt + 4); q.g2 = *(const f32x4*)(gt + 128); q.g3 = *(const f32x4*)(gt + 132); return q; }
    DI Pre pre(const Params& p, const GUnit& u, int r, int col0) const { const size_t off = (size_t)(u.rowbase + r) * DM + col0; Pre q;
        if constexpr (F32RES) { const float* xi = xin + off; q.x0 = *(const f32x4*)xi; q.x1 = *(const f32x4*)(xi + 4); q.x2 = *(const f32x4*)(xi + 128); q.x3 = *(const f32x4*)(xi + 132); }
        else { const bf16_t* o = p.XA + off; q.a = *(const u32x4_*)o; q.c = *(const u32x4_*)(o + 128); }
        return q; }
    DI void fin(const Params& p, const GUnit& u, int r, int col0, const UPre& g, const Pre& q, f32x4 lo0, f32x4 lo1, f32x4 hi0, f32x4 hi1) const {
        bf16_t* o = p.XA + (size_t)(u.rowbase + r) * DM + col0;
        f32x4 r0, r1, r2, r3;
        if constexpr (F32RES) { r0 = q.x0; r1 = q.x1; r2 = q.x2; r3 = q.x3; }
        else { const u32x4_ a = q.a, c = q.c;
            r0 = (f32x4){__uint_as_float(a[0] << 16), __uint_as_float(a[0] & 0xffff0000u), __uint_as_float(a[1] << 16), __uint_as_float(a[1] & 0xffff0000u)};
            r1 = (f32x4){__uint_as_float(a[2] << 16), __uint_as_float(a[2] & 0xffff0000u), __uint_as_float(a[3] << 16), __uint_as_float(a[3] & 0xffff0000u)};
            r2 = (f32x4){__uint_as_float(c[0] << 16), __uint_as_float(c[0] & 0xffff0000u), __uint_as_float(c[1] << 16), __uint_as_float(c[1] & 0xffff0000u)};
            r3 = (f32x4){__uint_as_float(c[2] << 16), __uint_as_float(c[2] & 0xffff0000u), __uint_as_float(c[3] << 16), __uint_as_float(c[3] & 0xffff0000u)}; }
        *(u32x4_*)o = pack8(r0 + g.g0 * lo0, r1 + g.g1 * lo1); *(u32x4_*)(o + 128) = pack8(r2 + g.g2 * hi0, r3 + g.g3 * hi1); } };
DI unsigned pk4_fp8e(float a, float b, float c, float d, float sc) { a = fminf(fmaxf(a * sc, -448.f), 448.f); b = fminf(fmaxf(b * sc, -448.f), 448.f); c = fminf(fmaxf(c * sc, -448.f), 448.f); d = fminf(fmaxf(d * sc, -448.f), 448.f);
    unsigned w = 0u; w = __builtin_amdgcn_cvt_pk_fp8_f32(a, b, w, false); w = __builtin_amdgcn_cvt_pk_fp8_f32(c, d, w, true); return w; }
struct EpiGU { static constexpr bool GATHER = true, PRE = false; const float* xin; int lgate; DI void operator()(const Params& p, const GUnit& u, int r, int col0, f32x4 lo0, f32x4 lo1, f32x4 hi0, f32x4 hi1) const {
    f32x4 a0, a1;
#pragma unroll
    for (int j = 0; j < 4; ++j) { a0[j] = siluf_(lo0[j]) * hi0[j]; a1[j] = siluf_(lo1[j]) * hi1[j]; }
    *(uint2*)((unsigned char*)p.ACT + (size_t)(u.rowbase + r) * EFF + (col0 >> 8) * 128 + (col0 & 127)) = make_uint2(pk4_fp8e(a0[0], a0[1], a0[2], a0[3], 8.f), pk4_fp8e(a1[0], a1[1], a1[2], a1[3], 8.f)); } };
struct EpiDown { static constexpr bool GATHER = false, PRE = true; const float* xin; int lgate;
    struct UPre { int none; };
    struct Pre { float g; };
    DI UPre unit_pre(const Params&, const GUnit&, int) const { return UPre{0}; }
    DI Pre pre(const Params& p, const GUnit& u, int r, int) const { return Pre{p.gatel[(u.gather - p.tokl) + r]}; }
    DI void fin(const Params& p, const GUnit& u, int r, int col0, const UPre&, const Pre& q, f32x4 lo0, f32x4 lo1, f32x4 hi0, f32x4 hi1) const {
    const float g = q.g;
    if constexpr (YB8_E) { const float gs = g * 64.f; unsigned char* o = (unsigned char*)p.YB + (size_t)(u.rowbase + r) * DM + col0;
        *(uint2*)o = make_uint2(pk4_fp8e(lo0[0], lo0[1], lo0[2], lo0[3], gs), pk4_fp8e(lo1[0], lo1[1], lo1[2], lo1[3], gs)); *(uint2*)(o + 128) = make_uint2(pk4_fp8e(hi0[0], hi0[1], hi0[2], hi0[3], gs), pk4_fp8e(hi1[0], hi1[1], hi1[2], hi1[3], gs)); }
    else { bf16_t* o = p.YB + (size_t)(u.rowbase + r) * DM + col0; *(u32x4_*)o = pack8(lo0 * g, lo1 * g); *(u32x4_*)(o + 128) = pack8(hi0 * g, hi1 * g); } } };
struct EpiIn1 { static constexpr bool GATHER = false, PRE = false; const float* xin; int lgate; DI void operator()(const Params& p, const GUnit& u, int r, int col0, f32x4 lo0, f32x4 lo1, f32x4 hi0, f32x4 hi1) const {
    bf16_t* o = p.G + (size_t)(u.rowbase + r) * N_IN1 + col0;
    if (col0 < LRU_W) {
#pragma unroll
        for (int j = 0; j < 4; ++j) { lo0[j] = gelu_tanh(lo0[j]); lo1[j] = gelu_tanh(lo1[j]); } }
    if (col0 + 128 < LRU_W) {
#pragma unroll
        for (int j = 0; j < 4; ++j) { hi0[j] = gelu_tanh(hi0[j]); hi1[j] = gelu_tanh(hi1[j]); } }
    *(u32x4_*)o = pack8(lo0, lo1); *(u32x4_*)(o + 128) = pack8(hi0, hi1); } };

#define LAS __attribute__((address_space(3)))
typedef short bf16x8 __attribute__((ext_vector_type(8)));
DI int opaque_tid() { int t = threadIdx.x; asm volatile("" : "+v"(t)); return t; }
namespace gm {
constexpr int BM = 256, BK = 64, HALF = 128, HTB = HALF * BK * 2, STAGE_BYTES = 8 * HTB, NXCD = 8, WGM = 4;
constexpr int TAB_OFF = STAGE_BYTES;
DI int lds_byte(int r, int c) { const int st = (r >> 4) * 2 + (c >> 5), rr = r & 15, cc = c & 31, ob = rr * 64 + cc * 2; return st * 1024 + (ob ^ (((ob >> 9) & 1) << 5)); }
DI int perm32(int rho) { const int n = rho >> 4, i = rho & 15; return 8 * (i >> 2) + 4 * n + (i & 3); }
DI void stage_rc(int b, int& R, int& C) { const int st = b / 1024, sb = b % 1024, swz = sb ^ (((sb >> 9) & 1) << 5); R = (st >> 1) * 16 + swz / 64; C = (st & 1) * 32 + (swz % 64) / 2; }
struct Unit { int arow, nvalid, orow, pn, e, goff; };
struct DenseSched {
    static constexpr bool GATHER = false, HALF_SKIP = false;
    int nM, nN, nwg, G, c;
    DI void init(int M, int N) { nM = M / BM; nN = N / BM; nwg = nM * nN; G = gridDim.x; c = blockIdx.x; }
    DI bool next(int i, Unit& u) const {
        const long L = (long)i * G + c; if (L >= nwg) return false;
        int wgid = (int)L; { const int q = nwg / NXCD, r = nwg % NXCD, xcd = wgid % NXCD, off = wgid / NXCD; wgid = (xcd < r ? xcd * (q + 1) : r * (q + 1) + (xcd - r) * q) + off; }
        const int nig = WGM * nN, gid = wgid / nig, fm = gid * WGM, gsz = (nM - fm) < WGM ? (nM - fm) : WGM;
        const int pm = fm + ((wgid % nig) % gsz); u.pn = (wgid % nig) / gsz; u.arow = pm * BM; u.orow = pm * BM; u.nvalid = BM; u.e = 0; u.goff = 0; return true;
    }
};
template <bool GATH> struct MoeSched {
    static constexpr bool GATHER = GATH, HALF_SKIP = true;
    const LAS int* tab; int G, c;
    DI void init(const LAS int* t) { tab = t; G = gridDim.x; c = blockIdx.x; }
    DI bool next(int i, Unit& u) const {
        const int L = i * G + c, mtile = L >> 3; const int total = __builtin_amdgcn_readfirstlane(tab[32]);
        if (mtile >= total) return false;
        int e = 0; for (int j = 1; j < 32; ++j) { if (__builtin_amdgcn_readfirstlane(tab[j]) <= mtile) e = j; }
        const int mt = mtile - __builtin_amdgcn_readfirstlane(tab[e]); const int cn = __builtin_amdgcn_readfirstlane(tab[64 + e]);
        u.e = e; u.pn = L & 7; u.orow = mtile * BM; u.arow = mtile * BM; u.nvalid = (cn - mt * BM) < BM ? (cn - mt * BM) : BM; u.goff = e * ECAP + mt * BM; return true;
    }
};
DI void moe_tables(LAS int* tab, const int* cnt) {
    if (threadIdx.x == 0) { int run = 0; for (int e = 0; e < 32; ++e) { const int cn = cnt[e]; tab[e] = run; tab[64 + e] = cn; run += (cn + 255) >> 8; } tab[32] = run; }
    __syncthreads();
}

typedef int i32x8 __attribute__((ext_vector_type(8)));
typedef int i32x4 __attribute__((ext_vector_type(4)));
DI void mfma8(f32x4& acc, const i32x8& w8, const i32x8& x8, int ws, int as) {
    asm volatile("v_mfma_scale_f32_16x16x128_f8f6f4 %0, %1, %2, %0, %3, %4 op_sel_hi:[0,0,0]" : "+v"(acc) : "v"(w8), "v"(x8), "v"(ws), "v"(as)); }
template <class Epi, class Sched, bool FP8 = false>
DI void gemm_phase(LAS unsigned char* lds, const Params& p, const bf16_t* A, const bf16_t* Bt, size_t bt_estride, int K, const Sched& S, const Epi& E, int wscale = 0x7f7f7f7f, int ascale = 0x7f7f7f7f) {
    const int tid = opaque_tid(), wid = __builtin_amdgcn_readfirstlane(tid >> 6), lane = tid & 63, wr = wid >> 2, wc = wid & 3, fr = lane & 15, fq = lane >> 4;
    const int nt = K / BK;
    unsigned voffA[2], voffB[2];
#pragma unroll
    for (int i = 0; i < 2; ++i) { int R, C; stage_rc(tid * 16 + i * 8192, R, C); voffA[i] = (unsigned)(R * K + C) * 2u; voffB[i] = (unsigned)(((R & ~31) + perm32(R & 31)) * K + C) * 2u; }
    const size_t kstep = (size_t)(BK * 2), hstep = (size_t)HALF * K * 2, tstep = 2 * hstep;
    const unsigned ldsw = (unsigned)wid * 1024u;
    const int aoff = lds_byte(wr * 64 + fr, fq * 8), boff = lds_byte(wc * 32 + fr, fq * 8);
#define G_SA(b, h) (((b) * 2 + (h)) * HTB)
#define G_SB(b, h) ((4 + (b) * 2 + (h)) * HTB)
#define G_STAGE(bufoff, gbase, voff) do { _Pragma("unroll") for (int _i = 0; _i < 2; ++_i) \
        __builtin_amdgcn_global_load_lds((const unsigned*)((const char*)(gbase) + (voff)[_i]), (LAS unsigned*)(lds + (bufoff) + ldsw + _i * 8192), 16, 0, 0); } while (0)
#define G_STAGE_A(bufoff, ubase, gv, h, koff) do { if constexpr (Sched::GATHER) { G_STAGE(bufoff, (const char*)A + (koff), gv[h]); } else { G_STAGE(bufoff, (ubase) + (h) * hstep + (koff), voffA); } } while (0)
#define G_LD16(off_) (*(const LAS i32x4*)(lds + (off_)))
#define G_LD16B(off_) (*(const LAS bf16x8*)(lds + (off_)))
#define G_LDA(dst, b, h) do { _Pragma("unroll") for (int m = 0; m < 4; ++m) { if constexpr (FP8) dst##8[m] = __builtin_shufflevector(G_LD16(G_SA(b, h) + aoff + m * 2048), G_LD16(G_SA(b, h) + aoff + m * 2048 + 1024), 0, 1, 2, 3, 4, 5, 6, 7); \
        else { dst[m][0] = G_LD16B(G_SA(b, h) + aoff + m * 2048); dst[m][1] = G_LD16B(G_SA(b, h) + aoff + m * 2048 + 1024); } } } while (0)
#define G_LDB(dst, b, h) do { _Pragma("unroll") for (int n = 0; n < 2; ++n) { if constexpr (FP8) dst##8[n] = __builtin_shufflevector(G_LD16(G_SB(b, h) + boff + n * 2048), G_LD16(G_SB(b, h) + boff + n * 2048 + 1024), 0, 1, 2, 3, 4, 5, 6, 7); \
        else { dst[n][0] = G_LD16B(G_SB(b, h) + boff + n * 2048); dst[n][1] = G_LD16B(G_SB(b, h) + boff + n * 2048 + 1024); } } } while (0)
#define G_MMA(ai, bj, At, Bt_) do { __builtin_amdgcn_s_setprio(1); _Pragma("unroll") for (int m = 0; m < 4; ++m) _Pragma("unroll") for (int n = 0; n < 2; ++n) { \
        if constexpr (FP8) mfma8(acc[ai][bj][m][n], Bt_##8[n], At##8[m], wscale, ascale); \
        else { _Pragma("unroll") for (int k = 0; k < 2; ++k) acc[ai][bj][m][n] = __builtin_amdgcn_mfma_f32_16x16x32_bf16(Bt_[n][k], At[m][k], acc[ai][bj][m][n], 0, 0, 0); } } \
        __builtin_amdgcn_s_setprio(0); } while (0)
#define G_WAIT_V(n) asm volatile("s_waitcnt vmcnt(" #n ")" ::: "memory")
#define G_WAIT_L(n) asm volatile("s_waitcnt lgkmcnt(" #n ")" ::: "memory")
#define G_BAR __builtin_amdgcn_s_barrier()
#define G_SCHED __builtin_amdgcn_sched_barrier(0)
    Unit cur, nxt; int ui = 0;
    if (!S.next(0, cur)) return;
    f32x4 acc[2][2][4][2];
#pragma unroll
    for (int a = 0; a < 2; ++a)
#pragma unroll
        for (int b = 0; b < 2; ++b)
#pragma unroll
            for (int m = 0; m < 4; ++m)
#pragma unroll
                for (int n = 0; n < 2; ++n) acc[a][b][m][n] = (f32x4){0.f, 0.f, 0.f, 0.f};
    bf16x8 At[4][2], B0[2][2], B1[2][2]; i32x8 At8[4], B08[2], B18[2];
    unsigned gcur[2][2] = {{0u, 0u}, {0u, 0u}}, gnxt[2][2] = {{0u, 0u}, {0u, 0u}};
    auto gather_offs = [&](const Unit& u, unsigned (&g)[2][2]) {
        if constexpr (Sched::GATHER) {
#pragma unroll
            for (int h = 0; h < 2; ++h)
#pragma unroll
                for (int i = 0; i < 2; ++i) { int tz = tid; asm volatile("" : "+v"(tz)); int R, C; stage_rc(tz * 16 + i * 8192, R, C); const int r = h * HALF + R; const int tk = p.tokl[u.goff + (r < u.nvalid ? r : 0)]; const int tok = r < u.nvalid ? tk : 0; g[h][i] = (unsigned)(tok * K + C) * 2u; }
        }
    };
    const char* cA = (const char*)A + (size_t)(cur.arow / BM) * tstep; const char* cB = (const char*)Bt + ((size_t)cur.e * bt_estride) * 2 + (size_t)cur.pn * tstep;
    gather_offs(cur, gcur);
    G_STAGE(G_SB(0, 0), cB, voffB); G_STAGE_A(G_SA(0, 0), cA, gcur, 0, 0); G_STAGE(G_SB(0, 1), cB + hstep, voffB); G_STAGE_A(G_SA(0, 1), cA, gcur, 1, 0);
    if (wr == 1) G_BAR;
    G_WAIT_V(4); G_BAR;
    G_STAGE(G_SB(1, 0), cB + kstep, voffB); G_STAGE_A(G_SA(1, 0), cA, gcur, 0, kstep); G_STAGE(G_SB(1, 1), cB + hstep + kstep, voffB);
    G_WAIT_V(6); G_BAR;
    for (;;) {
        const bool has_next = S.next(ui + 1, nxt);
        const char* nA = has_next ? (const char*)A + (size_t)(nxt.arow / BM) * tstep : cA;
        const char* nB = has_next ? (const char*)Bt + ((size_t)nxt.e * bt_estride) * 2 + (size_t)nxt.pn * tstep : cB;
        if constexpr (Sched::GATHER) { if (has_next) gather_offs(nxt, gnxt); else {
#pragma unroll
            for (int h = 0; h < 2; ++h) { gnxt[h][0] = gcur[h][0]; gnxt[h][1] = gcur[h][1]; } } }
        for (int t = 0; t < nt; t += 2) {
            const bool last = (t == nt - 2);
            const size_t k1 = (size_t)(t + 1) * kstep;
            const char* a2 = last ? nA : cA; const char* b2 = last ? nB : cB + (size_t)(t + 2) * kstep;
            const size_t k2 = last ? 0 : (size_t)(t + 2) * kstep; const size_t k3 = k2 + kstep;
            const char* b3 = b2 + kstep;
            unsigned g2[2][2];
#pragma unroll
            for (int h = 0; h < 2; ++h) { g2[h][0] = last ? gnxt[h][0] : gcur[h][0]; g2[h][1] = last ? gnxt[h][1] : gcur[h][1]; }
            G_LDB(B0, 0, 0); G_SCHED; G_LDA(At, 0, 0); G_STAGE_A(G_SA(1, 1), cA, gcur, 1, k1);
            G_WAIT_L(8); G_BAR; G_WAIT_L(0); G_MMA(0, 0, At, B0); G_BAR; G_SCHED;
            G_LDB(B1, 0, 1); G_STAGE(G_SB(0, 0), b2, voffB);
            G_BAR; G_WAIT_L(0); G_MMA(0, 1, At, B1); G_BAR;
            G_LDA(At, 0, 1); G_STAGE_A(G_SA(0, 0), a2, g2, 0, k2);
            G_BAR; G_WAIT_L(0); if (!Sched::HALF_SKIP || cur.nvalid > HALF) G_MMA(1, 0, At, B0); G_BAR; G_SCHED;
            G_STAGE(G_SB(0, 1), b2 + hstep, voffB);
            G_WAIT_V(6); G_BAR; if (!Sched::HALF_SKIP || cur.nvalid > HALF) G_MMA(1, 1, At, B1); G_BAR;
            G_LDB(B0, 1, 0); G_SCHED; G_LDA(At, 1, 0); G_STAGE_A(G_SA(0, 1), a2, g2, 1, k2);
            G_WAIT_L(8); G_BAR; G_WAIT_L(0); G_MMA(0, 0, At, B0); G_BAR; G_SCHED;
            G_LDB(B1, 1, 1); G_STAGE(G_SB(1, 0), b3, voffB);
            G_BAR; G_WAIT_L(0); G_MMA(0, 1, At, B1); G_BAR;
            G_LDA(At, 1, 1); G_STAGE_A(G_SA(1, 0), a2, g2, 0, k3);
            G_BAR; G_WAIT_L(0); if (!Sched::HALF_SKIP || cur.nvalid > HALF) G_MMA(1, 0, At, B0); G_BAR; G_SCHED;
            G_STAGE(G_SB(1, 1), b3 + hstep, voffB);
            G_WAIT_V(6); G_BAR; if (!Sched::HALF_SKIP || cur.nvalid > HALF) G_MMA(1, 1, At, B1); G_BAR;
        }
        if constexpr (FP8) asm volatile("s_nop 15\n\ts_nop 15" ::: "memory");
        { GUnit gu; gu.rowbase = cur.orow; gu.nvalid = cur.nvalid; gu.e = cur.e; gu.gather = p.tokl + cur.goff;
          if constexpr (Epi::PRE) {
            const int col0 = cur.pn * BM + wc * 32 + fq * 8; const auto up = E.unit_pre(p, gu, col0);
#pragma unroll
            for (int ai = 0; ai < 2; ++ai) { typename Epi::Pre pr[4];
#pragma unroll
              for (int m = 0; m < 4; ++m) pr[m] = E.pre(p, gu, ai * HALF + wr * 64 + m * 16 + fr, col0);
              asm volatile("" ::: "memory");
#pragma unroll
              for (int m = 0; m < 4; ++m) { const int r = ai * HALF + wr * 64 + m * 16 + fr;
                if (!Sched::HALF_SKIP || r < cur.nvalid) E.fin(p, gu, r, col0, up, pr[m], acc[ai][0][m][0], acc[ai][0][m][1], acc[ai][1][m][0], acc[ai][1][m][1]); } }
          } else {
#pragma unroll
          for (int ai = 0; ai < 2; ++ai)
#pragma unroll
            for (int m = 0; m < 4; ++m) { const int r = ai * HALF + wr * 64 + m * 16 + fr;
              if (!Sched::HALF_SKIP || r < cur.nvalid) E(p, gu, r, cur.pn * BM + wc * 32 + fq * 8, acc[ai][0][m][0], acc[ai][0][m][1], acc[ai][1][m][0], acc[ai][1][m][1]); } } }
        if (!has_next) break;
#pragma unroll
        for (int a = 0; a < 2; ++a)
#pragma unroll
            for (int b = 0; b < 2; ++b)
#pragma unroll
                for (int m = 0; m < 4; ++m)
#pragma unroll
                    for (int n = 0; n < 2; ++n) acc[a][b][m][n] = (f32x4){0.f, 0.f, 0.f, 0.f};
        cur = nxt; cA = nA; cB = nB; ++ui;
#pragma unroll
        for (int h = 0; h < 2; ++h) { gcur[h][0] = gnxt[h][0]; gcur[h][1] = gnxt[h][1]; }
    }
    G_WAIT_V(0);
    if (wr == 0) G_BAR;
    G_BAR;
}
}

extern __shared__ __attribute__((aligned(16))) unsigned char dyn_smem[];
constexpr int LDS_BYTES = gm::STAGE_BYTES + 1024;

typedef __bf16 bf2v __attribute__((ext_vector_type(2)));
typedef float f32x2 __attribute__((ext_vector_type(2)));
typedef float f32x16 __attribute__((ext_vector_type(16)));
typedef short s16x4 __attribute__((ext_vector_type(4)));
typedef unsigned u32x4 __attribute__((ext_vector_type(4)));
DI unsigned pk2(float a, float b) { f32x2 v = {a, b}; bf2v r = __builtin_convertvector(v, bf2v); return __builtin_bit_cast(unsigned, r); }
DI float bflo(unsigned u) { return __uint_as_float(u << 16); }
DI float bfhi(unsigned u) { return __uint_as_float(u & 0xffff0000u); }

DI unsigned pk4_fp8(float a, float b, float c, float d, float sc) {
    a = __builtin_amdgcn_fmed3f(a * sc, -448.f, 448.f); b = __builtin_amdgcn_fmed3f(b * sc, -448.f, 448.f); c = __builtin_amdgcn_fmed3f(c * sc, -448.f, 448.f); d = __builtin_amdgcn_fmed3f(d * sc, -448.f, 448.f);
    unsigned w = 0u; w = __builtin_amdgcn_cvt_pk_fp8_f32(a, b, w, false); w = __builtin_amdgcn_cvt_pk_fp8_f32(c, d, w, true); return w; }
constexpr bool D8_IN0 = true, D8_OUT0 = false, D8_IN1 = false;
constexpr bool YB8 = true;
constexpr float Y8_SCALE = 64.f;
constexpr float W8_SCALE = 256.f, A8_SCALE = 8.f;
constexpr int W8_E8M0 = 0x77777777, A8_E8M0 = 0x7c7c7c7c;
namespace ph {
DI void mods(const Params& p, LAS unsigned char* lds) {
    const int tid = opaque_tid(), wave = tid >> 6, lane = tid & 63, l8 = tid & 7, rg = tid >> 3;
    LAS float* fl = (LAS float*)lds; LAS float* red = fl + 4 * DM;
    for (int i = tid; i < 4 * DM; i += 512) fl[i] = siluf_(p.c[i]);
    __syncthreads();
    for (int u = blockIdx.x; u < 768; u += gridDim.x) {
        const int l = u / 192, c32 = u % 192;
        const float* w = l == 0 ? p.ada0_mix_w : l == 1 ? p.ada0_ffn_w : l == 2 ? p.ada1_mix_w : p.ada1_ffn_w;
        const float* bs = l == 0 ? p.ada0_mix_b : l == 1 ? p.ada0_ffn_b : l == 2 ? p.ada1_mix_b : p.ada1_ffn_b;
        f32x4 acc[4] = {{0.f, 0.f, 0.f, 0.f}, {0.f, 0.f, 0.f, 0.f}, {0.f, 0.f, 0.f, 0.f}, {0.f, 0.f, 0.f, 0.f}};
        const float* wp = w + (size_t)rg * 6144 + c32 * 32 + l8 * 4;
#pragma unroll 8
        for (int i = 0; i < 32; ++i) { const f32x4 wv = *(const f32x4*)(wp + (size_t)(64 * i) * 6144); const int k = rg + 64 * i;
#pragma unroll
            for (int b = 0; b < 4; ++b) acc[b] += fl[b * DM + k] * wv; }
#pragma unroll
        for (int b = 0; b < 4; ++b)
#pragma unroll
            for (int j = 0; j < 4; ++j) { float v = acc[b][j]; v += __shfl_xor(v, 8); v += __shfl_xor(v, 16); v += __shfl_xor(v, 32); acc[b][j] = v; }
        if (lane < 8) {
#pragma unroll
            for (int b = 0; b < 4; ++b) *(LAS f32x4*)(red + (wave * 4 + b) * 32 + lane * 4) = acc[b]; }
        __syncthreads();
        if (tid < 128) { const int b = tid >> 5, col = tid & 31; float sum = 0.f;
#pragma unroll
            for (int w8 = 0; w8 < 8; ++w8) sum += red[(w8 * 4 + b) * 32 + col];
            p.mod[(l * 4 + b) * 6144 + c32 * 32 + col] = sum + bs[c32 * 32 + col]; }
        __syncthreads();
    }
}
constexpr int NT_UNITS = (640 + 256 + 672 + 336 + 2 * (8192 + 4096)) / 2;
struct UD { const float* sp; bf16_t* dst; int K, N, mode, e, kt, ntile; };
DI UD tdecode(const Params& p, int u, int lane) {
    const float* srcs[8] = {p.w_in0, p.w_out0, p.w_in1, p.w_out1, p.moe0_w_gate_up, p.moe0_w_down, p.moe1_w_gate_up, p.moe1_w_down};
    bf16_t* dsts[8] = {p.w_in0t, p.w_out0t, p.w_in1t, p.w_out1t, p.w_gut0, p.w_dt0, p.w_gut1, p.w_dt1};
    constexpr int Ks[8] = {DM, DM, DM, LRU_W, DM, EFF, DM, EFF}, Ns[8] = {N_IN0, DM, N_IN1, DM, 2048, DM, 2048, DM}, nus[8] = {320, 128, 336, 168, 4096, 2048, 4096, 2048};
    constexpr int modes[8] = {D8_IN0 ? 2 : 0, D8_OUT0 ? 2 : 0, D8_IN1 ? 2 : 0, 0, 3, 2, 3, 2};
    int v = u, mi = 0;
#pragma unroll
    for (int m = 0; m < 8; ++m) { if (mi == m && v >= nus[m]) { v -= nus[m]; mi = m + 1; } }
    UD d; const float* src = srcs[0]; d.dst = dsts[0]; d.K = Ks[0]; d.N = Ns[0]; d.mode = modes[0];
#pragma unroll
    for (int m = 1; m < 8; ++m) if (mi == m) { src = srcs[m]; d.dst = dsts[m]; d.K = Ks[m]; d.N = Ns[m]; d.mode = modes[m]; }
    const int ntl = d.N / 256, ktl = d.K / 128; d.e = v / (ktl * ntl); const int rem = v % (ktl * ntl); d.kt = rem / ntl; d.ntile = rem % ntl;
    d.sp = src + (size_t)d.e * d.K * d.N + (size_t)(d.kt * 128) * d.N + d.ntile * 256 + lane * 4;
    return d;
}
DI void transposer(const Params& p, LAS unsigned char* lds, int first, int count, int stride) {
    const int tid = opaque_tid(), wave = tid >> 6, lane = tid & 63;
    LAS float* fl = (LAS float*)lds;
    if (count <= 0) return;
    if (tdecode(p, first, lane).mode & 2) {
        LAS unsigned* td = (LAS unsigned*)lds;
        const int nl = lane & 15, ks = lane >> 4;
        auto src_of = [&](const UD& d, int g, int j) -> const float* { const int kq = 4 * (g >> 2) + ks, nq = 16 * (g & 3) + nl; return d.sp - lane * 4 + (size_t)(4 * kq + j) * d.N + 4 * nq; };
        f32x4 va[4][4], vb[4][4];
        auto load_unit = [&](int u, f32x4 (&v)[4][4]) { const UD dd = tdecode(p, u, lane);
#pragma unroll
            for (int i = 0; i < 4; ++i)
#pragma unroll
                for (int j = 0; j < 4; ++j) v[i][j] = *(const f32x4*)src_of(dd, wave * 4 + i, j); };
        auto process = [&](int jn, f32x4 (&v)[4][4]) { const int u = first + jn * stride;
            const UD d = tdecode(p, u, lane); const int K = d.K, N = d.N, mode = d.mode, e = d.e, kt = d.kt, ntile = d.ntile;
            LAS unsigned* tile = td + (jn & 1) * (256 * 33);
#pragma unroll
            for (int i = 0; i < 4; ++i) { const int g = wave * 4 + i, kq = 4 * (g >> 2) + ks, nq = 16 * (g & 3) + nl;
#pragma unroll
                for (int en = 0; en < 4; ++en) tile[(4 * nq + en) * 33 + kq] = pk4_fp8(v[i][0][en], v[i][1][en], v[i][2][en], v[i][3][en], W8_SCALE); }
            __syncthreads();
            if (jn + 2 < count) load_unit(u + 2 * stride, v);
            { const int n = tid >> 1, kh = tid & 1; const int ng = ntile * 256 + n; const int jg = ng & 1023; const int np = (mode & 1) ? (256 * (jg >> 7) + (ng < 1024 ? 0 : 128) + (jg & 127)) : ng;
              unsigned char* dp = (unsigned char*)d.dst + (size_t)e * N * K + (size_t)np * K + kt * 128 + kh * 64;
#pragma unroll
              for (int jj = 0; jj < 4; ++jj) { const LAS unsigned* tp = tile + n * 33 + kh * 16 + jj * 4; *(uint4*)(dp + jj * 16) = make_uint4(tp[0], tp[1], tp[2], tp[3]); } } };
        load_unit(first, va); if (count > 1) load_unit(first + stride, vb);
        for (int jn = 0; jn < count; jn += 2) { process(jn, va); if (jn + 1 < count) process(jn + 1, vb); }
        __syncthreads();
        return;
    }
    f32x4 vv[16];
    { const UD d0 = tdecode(p, first, lane);
#pragma unroll
        for (int i = 0; i < 16; ++i) vv[i] = *(const f32x4*)(d0.sp + (size_t)(i * 8 + wave) * d0.N); }
    for (int j = 0; j < count; ++j) { const int u = first + j * stride;
        const UD d = tdecode(p, u, lane); const int K = d.K, N = d.N, mode = d.mode, e = d.e, kt = d.kt, ntile = d.ntile; bf16_t* dst = d.dst;
#pragma unroll
        for (int i = 0; i < 16; ++i) { LAS float* tp = fl + (i * 8 + wave) * 257 + lane * 4; tp[0] = vv[i][0]; tp[1] = vv[i][1]; tp[2] = vv[i][2]; tp[3] = vv[i][3]; }
        __syncthreads();
        if (j + 1 < count) { const UD dn = tdecode(p, u + stride, lane);
#pragma unroll
            for (int i = 0; i < 16; ++i) vv[i] = *(const f32x4*)(dn.sp + (size_t)(i * 8 + wave) * dn.N); }
        { const int n = tid >> 1, kh = tid & 1; const int ng = ntile * 256 + n; const int jg = ng & 1023; const int np = (mode & 1) ? (256 * (jg >> 7) + (ng < 1024 ? 0 : 128) + (jg & 127)) : ng;
          bf16_t* dp = dst + (size_t)e * N * K + (size_t)np * K + kt * 128 + kh * 64;
#pragma unroll
          for (int jj = 0; jj < 8; ++jj) { unsigned w4[4];
#pragma unroll
              for (int q = 0; q < 4; ++q) { const int k = kh * 64 + jj * 8 + q * 2; w4[q] = pk2(fl[k * 257 + n], fl[(k + 1) * 257 + n]); }
              *(uint4*)(dp + jj * 8) = make_uint4(w4[0], w4[1], w4[2], w4[3]); } }
        __syncthreads();
    }
}
DI void lru_weights(const Params& p) {
    const int tid = opaque_tid();
    for (size_t i = (size_t)blockIdx.x * 512 + tid; i < (size_t)2 * 2 * 16 * 4 * 48 * 192; i += (size_t)gridDim.x * 512) {
        const int k = i % 192, j = (i / 192) % 48, qt = (i / (192 * 48)) % 4, n = (i / (192 * 48 * 4)) % 16, which = (i / (192 * 48 * 4 * 16)) % 2, dir = i / (192 * 48 * 4 * 16 * 2);
        const float* w = which == 0 ? p.lru_w_a : p.lru_w_x; float v = 0.f;
        if (j < 42 && k < 168) v = w[(((size_t)dir * 16 + n) * 168 + k) * 168 + qt * 42 + j];
        p.w_lru[i] = f2bf(v);
    }
}
DI void fold_router(const Params& p) {
    const int tid = opaque_tid(), wave = tid >> 6, lane = tid & 63;
    for (size_t i = (size_t)blockIdx.x * 512 + tid; i < (size_t)2 * 4 * 48 * DM; i += (size_t)gridDim.x * 512) {
        const int k = i % DM, n = (i / DM) % 48, b = (i / (DM * 48)) % 4, l = i / (DM * 48 * 4);
        const float* g = l == 0 ? p.norm0_ffn : p.norm1_ffn; const float* md = p.mod + ((l == 0 ? 1 : 3) * 4 + b) * 6144;
        const float* we = l == 0 ? p.moe0_w_expert : p.moe1_w_expert; const float* wg = l == 0 ? p.moe0_w_group : p.moe1_w_group;
        const float w = n < 32 ? we[k * 32 + n] : n < 36 ? wg[k * 4 + (n - 32)] : 0.f;
        const float wf = g[k] * (1.f + md[2048 + k]) * w;
        const bf16_t hi = f2bf(wf); const float r1 = wf - bf2f(hi); const bf16_t mid = f2bf(r1); const bf16_t lo = f2bf(r1 - bf2f(mid));
        bf16_t* dst = p.wrt + ((size_t)((l * 4 + b) * 3) * 48 + n) * DM + k;
        dst[0] = hi; dst[(size_t)48 * DM] = mid; dst[(size_t)96 * DM] = lo;
    }
    for (int task = blockIdx.x * 8 + wave; task < 2 * 4 * 48; task += gridDim.x * 8) {
        const int n = task % 48, b = (task / 48) % 4, l = task / (48 * 4);
        const float* md = p.mod + ((l == 0 ? 1 : 3) * 4 + b) * 6144;
        const float* we = l == 0 ? p.moe0_w_expert : p.moe1_w_expert; const float* wg = l == 0 ? p.moe0_w_group : p.moe1_w_group;
        float part = 0.f;
        for (int k = lane; k < DM; k += 64) { const float w = n < 32 ? we[k * 32 + n] : n < 36 ? wg[k * 4 + (n - 32)] : 0.f; part += md[k] * w; }
        part = wave_sum(part); if (lane == 0) p.rbias[task] = part;
    }
}
template <int MODE, bool OUT8 = false> DI void norm_rows(const Params& p, const float* xin  , const float* gain, int lmod, int lgate, const LAS int* tab) {
    const int tid = opaque_tid(), wave = tid >> 6, lane = tid & 63;
    f32x4 gn[8];
#pragma unroll
    for (int i = 0; i < 8; ++i) gn[i] = *(const f32x4*)(gain + i * 256 + lane * 4);
    for (int row = blockIdx.x * 8 + wave; row < T_TOK; row += gridDim.x * 8) {
        const int b = row / SEQ;
        int a0 = 0, a1 = 0;
        if constexpr (MODE >= 1) { a0 = p.asg[row * 2]; a1 = p.asg[row * 2 + 1]; }
        f32x4 v[8]; uint2 vr[8];
        if (xin) {
#pragma unroll
            for (int i = 0; i < 8; ++i) v[i] = *(const f32x4*)(xin + (size_t)row * DM + i * 256 + lane * 4);
        } else {
#pragma unroll
            for (int i = 0; i < 8; ++i) vr[i] = *(const uint2*)(p.XA + (size_t)row * DM + i * 256 + lane * 4);
        }
        f32x4 gq[8], sc[8], sh[8];
        if constexpr (MODE >= 1) { const float* gt = p.mod + (lgate * 4 + b) * 6144 + 4096;
#pragma unroll
            for (int i = 0; i < 8; ++i) gq[i] = *(const f32x4*)(gt + i * 256 + lane * 4); }
        if constexpr (MODE != 2) { const float* md = p.mod + (lmod * 4 + b) * 6144;
#pragma unroll
            for (int i = 0; i < 8; ++i) { sc[i] = *(const f32x4*)(md + 2048 + i * 256 + lane * 4); sh[i] = *(const f32x4*)(md + i * 256 + lane * 4); } }
        if (!xin) {
#pragma unroll
            for (int i = 0; i < 8; ++i) v[i] = (f32x4){bflo(vr[i].x), bfhi(vr[i].x), bflo(vr[i].y), bfhi(vr[i].y)};
        }
        if constexpr (MODE >= 1) {
            const size_t r0 = (size_t)tab[a0 >> 14] * 256 + (a0 & 16383), r1 = (size_t)tab[a1 >> 14] * 256 + (a1 & 16383);
            if constexpr (YB8) { unsigned y0[8], y1[8];
#pragma unroll
                for (int i = 0; i < 8; ++i) { const int col = i * 256 + lane * 4; y0[i] = *(const unsigned*)((const unsigned char*)p.YB + r0 * DM + col); y1[i] = *(const unsigned*)((const unsigned char*)p.YB + r1 * DM + col); }
#pragma unroll
                for (int i = 0; i < 8; ++i) {
                    const f32x2 c0 = __builtin_amdgcn_cvt_pk_f32_fp8(y0[i], false), c1 = __builtin_amdgcn_cvt_pk_f32_fp8(y0[i], true), d0 = __builtin_amdgcn_cvt_pk_f32_fp8(y1[i], false), d1 = __builtin_amdgcn_cvt_pk_f32_fp8(y1[i], true);
                    const f32x4 g4 = gq[i] * (1.f / Y8_SCALE);
                    v[i][0] += g4[0] * (c0[0] + d0[0]); v[i][1] += g4[1] * (c0[1] + d0[1]); v[i][2] += g4[2] * (c1[0] + d1[0]); v[i][3] += g4[3] * (c1[1] + d1[1]); } }
            else {
#pragma unroll
                for (int i = 0; i < 8; ++i) { const int col = i * 256 + lane * 4; const f32x4 g4 = gq[i]; const uint2 y0 = *(const uint2*)(p.YB + r0 * DM + col), y1 = *(const uint2*)(p.YB + r1 * DM + col);
                v[i][0] += g4[0] * (bflo(y0.x) + bflo(y1.x)); v[i][1] += g4[1] * (bfhi(y0.x) + bfhi(y1.x));
                v[i][2] += g4[2] * (bflo(y0.y) + bflo(y1.y)); v[i][3] += g4[3] * (bfhi(y0.y) + bfhi(y1.y)); } }
            if constexpr (MODE == 1) {
#pragma unroll
                for (int i = 0; i < 8; ++i) { const uint2 w = make_uint2(pk2(v[i][0], v[i][1]), pk2(v[i][2], v[i][3])); *(uint2*)(p.XA + (size_t)row * DM + i * 256 + lane * 4) = w;
                    v[i] = (f32x4){bflo(w.x), bfhi(w.x), bflo(w.y), bfhi(w.y)}; }
            }
        }
        float ss = 0.f;
#pragma unroll
        for (int i = 0; i < 8; ++i) ss += v[i][0] * v[i][0] + v[i][1] * v[i][1] + v[i][2] * v[i][2] + v[i][3] * v[i][3];
        ss = wave_sum(ss); const float rstd = rsqrtf(ss * (1.0f / DM) + 1e-6f);
        if constexpr (MODE == 2) {
#pragma unroll
            for (int i = 0; i < 8; ++i) { const int col = i * 256 + lane * 4; *(f32x4*)(p.out + (size_t)row * DM + col) = v[i] * rstd * gn[i]; }
        } else {
#pragma unroll
            for (int i = 0; i < 8; ++i) { const int col = i * 256 + lane * 4;
                const f32x4 h = v[i] * rstd * gn[i] * (1.f + sc[i]) + sh[i];
                if constexpr (OUT8) *(unsigned*)((unsigned char*)p.H + (size_t)row * DM + col) = pk4_fp8(h[0], h[1], h[2], h[3], A8_SCALE);
                else *(uint2*)(p.H + (size_t)row * DM + col) = make_uint2(pk2(h[0], h[1]), pk2(h[2], h[3])); } }
    }
}
template <bool DRY = false, bool NORM = false> DI void router(const Params& p, int l, LAS unsigned char* lds, const float* gain = nullptr, int lmod = 0) {
    const int tid = opaque_tid(), wave = __builtin_amdgcn_readfirstlane(tid >> 6), lane = tid & 63;
    LAS float* lg = (LAS float*)lds + (wave & 3) * (16 * 48);
    LAS float* rsl = (LAS float*)lds + 4 * 16 * 48 + (wave & 3) * 16;
    LAS f32x4* part = (LAS f32x4*)(lds + 16384);
    LAS float* ssp = (LAS float*)(lds + 16384 + 98304);
    for (int tg = blockIdx.x; tg < T_TOK / 64; tg += gridDim.x) {
        const int b = (tg * 64) / SEQ, r = lane & 15, q = lane >> 4;
        const bf16_t* xa = p.XA + (size_t)(tg * 64 + r) * DM + wave * 256 + 8 * q;
        const bf16_t* wt = p.wrt + ((size_t)((l * 4 + b) * 3) * 48 + r) * DM + wave * 256 + 8 * q;
        f32x4 acc[4][3]; float ss[4] = {0.f, 0.f, 0.f, 0.f};
#pragma unroll
        for (int t = 0; t < 4; ++t)
#pragma unroll
            for (int n = 0; n < 3; ++n) acc[t][n] = (f32x4){0.f, 0.f, 0.f, 0.f};
        u32x4 aA[4], aB[4], bA[9], bB[9];
        auto ld = [&](int st, u32x4 (&aa)[4], u32x4 (&bb)[9]) {
#pragma unroll
            for (int t = 0; t < 4; ++t) aa[t] = *(const u32x4*)(xa + (size_t)t * 16 * DM + st * 32);
#pragma unroll
            for (int i = 0; i < 9; ++i) bb[i] = *(const u32x4*)(wt + (size_t)i * 16 * DM + st * 32); };
        auto mm = [&](const u32x4 (&aa)[4], const u32x4 (&bb)[9]) {
#pragma unroll
            for (int t = 0; t < 4; ++t) {
#pragma unroll
                for (int e = 0; e < 4; ++e) { const float x0 = bflo(aa[t][e]), x1 = bfhi(aa[t][e]); ss[t] += x0 * x0 + x1 * x1; }
#pragma unroll
                for (int i = 0; i < 9; ++i) acc[t][i % 3] = __builtin_amdgcn_mfma_f32_16x16x32_bf16(__builtin_bit_cast(bf16x8, aa[t]), __builtin_bit_cast(bf16x8, bb[i]), acc[t][i % 3], 0, 0, 0); } };
        ld(0, aA, bA);
        for (int st = 0; st < 8; st += 2) {
            ld(st + 1, aB, bB);
            mm(aA, bA);
            if (st + 2 < 8) ld(st + 2, aA, bA);
            mm(aB, bB);
        }
#pragma unroll
        for (int t = 0; t < 4; ++t) {
#pragma unroll
            for (int n = 0; n < 3; ++n) part[((wave * 4 + t) * 3 + n) * 64 + lane] = acc[t][n];
            float sq = ss[t]; sq += __shfl_xor(sq, 16); sq += __shfl_xor(sq, 32);
            if (q == 0) ssp[(wave * 4 + t) * 16 + r] = sq; }
        __syncthreads();
        if (wave < 4) {
        const int tile = tg * 4 + wave, row0 = tile * 16;
        f32x4 a3[3] = {{0.f, 0.f, 0.f, 0.f}, {0.f, 0.f, 0.f, 0.f}, {0.f, 0.f, 0.f, 0.f}}; float ssr = 0.f;
#pragma unroll
        for (int w2 = 0; w2 < 8; ++w2) {
#pragma unroll
            for (int n = 0; n < 3; ++n) a3[n] += part[((w2 * 4 + wave) * 3 + n) * 64 + lane];
            ssr += ssp[(w2 * 4 + wave) * 16 + r]; }
        const float rstd = rsqrtf(ssr * (1.0f / DM) + 1e-6f);
        if (NORM && q == 0) rsl[r] = rstd;
#pragma unroll
        for (int j = 0; j < 4; ++j) { const float rs = __shfl(rstd, 4 * q + j);
#pragma unroll
            for (int n = 0; n < 3; ++n) lg[(4 * q + j) * 48 + n * 16 + r] = a3[n][j] * rs + p.rbias[(l * 4 + b) * 48 + n * 16 + r]; }
        __builtin_amdgcn_wave_barrier();
        if (!DRY && lane < 16) {
            const LAS float* L = lg + lane * 48; const int tok = row0 + lane;
            int gs = 0; float gm = L[32];
#pragma unroll
            for (int g = 1; g < 4; ++g) if (L[32 + g] > gm) { gm = L[32 + g]; gs = g; }
            float gden = 0.f;
#pragma unroll
            for (int g = 0; g < 4; ++g) gden += __expf(L[32 + g] - gm);
            const float gprob = 1.0f / gden;
            int i0 = 0; float v0 = L[gs * 8];
            for (int j = 1; j < 8; ++j) { const float x = L[gs * 8 + j]; if (x > v0) { v0 = x; i0 = j; } }
            int i1 = -1; float v1 = -3.4e38f;
            for (int j = 0; j < 8; ++j) { const float x = L[gs * 8 + j]; if (j != i0 && x > v1) { v1 = x; i1 = j; } }
            const float e1 = __expf(v1 - v0), g0 = gprob / (1.f + e1), g1 = gprob * e1 / (1.f + e1);
            const int ea = gs * 8 + i0, eb = gs * 8 + i1;
            const int sa = atomicAdd(&p.cnt[l * 32 + ea], 1), sb = atomicAdd(&p.cnt[l * 32 + eb], 1);
            p.tokl[ea * ECAP + sa] = tok; p.gatel[ea * ECAP + sa] = g0; p.tokl[eb * ECAP + sb] = tok; p.gatel[eb * ECAP + sb] = g1;
            p.asg[tok * 2] = (ea << 14) | sa; p.asg[tok * 2 + 1] = (eb << 14) | sb;
        }
        }
        __syncthreads();
        if constexpr (NORM) {
            const int kh = wave >> 2, row0 = (tg * 4 + (wave & 3)) * 16;
            const float* md = p.mod + (lmod * 4 + b) * 6144;
            f32x4 g4[8], sc[8], sh[8];
#pragma unroll
            for (int i = 0; i < 8; ++i) { const int col = i * 256 + lane * 4; g4[i] = *(const f32x4*)(gain + col); sc[i] = 1.f + *(const f32x4*)(md + 2048 + col); sh[i] = *(const f32x4*)(md + col); g4[i] *= sc[i]; }
            for (int j0 = 0; j0 < 8; j0 += 4) {
                uint2 ar[4][8];
#pragma unroll
                for (int jj = 0; jj < 4; ++jj)
#pragma unroll
                    for (int i = 0; i < 8; ++i) ar[jj][i] = *(const uint2*)(p.XA + (size_t)(row0 + kh * 8 + j0 + jj) * DM + i * 256 + lane * 4);
                asm volatile("" ::: "memory");
#pragma unroll
                for (int jj = 0; jj < 4; ++jj) { const int row = row0 + kh * 8 + j0 + jj; const float rs = rsl[kh * 8 + j0 + jj];
#pragma unroll
                    for (int i = 0; i < 8; ++i) { const int col = i * 256 + lane * 4; const f32x4 v = {bflo(ar[jj][i].x), bfhi(ar[jj][i].x), bflo(ar[jj][i].y), bfhi(ar[jj][i].y)};
                        const f32x4 h = v * rs * g4[i] + sh[i];
                        *(unsigned*)((unsigned char*)p.H + (size_t)row * DM + col) = pk4_fp8(h[0], h[1], h[2], h[3], A8_SCALE); } } }
            __syncthreads();
        }
    }
}
DI void conv_gln(const Params& p, LAS unsigned char* lds) {
    const int tid = opaque_tid(), wave = tid >> 6, lane = tid & 63;
    LAS float* at = (LAS float*)lds;
    u32x4 rv[3], rg[3];
    auto load_raw = [&](int u) { const int g = u & 7, t0 = ((u >> 3) & 63) * 64, b = u >> 9;
#pragma unroll
        for (int i = 0; i < 3; ++i) { const int idx = tid + 512 * i, rr = idx >> 4, c8 = idx & 15, t = t0 - 15 + rr; rv[i] = (u32x4){0u, 0u, 0u, 0u}; rg[i] = (u32x4){0u, 0u, 0u, 0u};
            if (idx < 94 * 16 && t >= 0 && t < SEQ) { const bf16_t* row = p.G + (size_t)(b * SEQ + t) * N_IN0 + g * 128 + c8 * 8; rv[i] = *(const u32x4*)row; rg[i] = *(const u32x4*)(row + 1024); } } };
    int gcur = -1; f32x2 wk[31], bias = {0.f, 0.f}, gam = {0.f, 0.f}, bet = {0.f, 0.f};
    if ((int)blockIdx.x < 2048) load_raw(blockIdx.x);
    for (int u = blockIdx.x; u < 2048; u += gridDim.x) {
        const int g = u & 7, t0 = ((u >> 3) & 63) * 64, b = u >> 9;
        const int ch = g * 128 + 2 * lane;
        if (g != gcur) { gcur = g;
#pragma unroll
            for (int k = 0; k < 31; ++k) wk[k] = *(const f32x2*)(p.conv_w + k * 1024 + ch);
            bias = *(const f32x2*)(p.conv_b + ch); gam = *(const f32x2*)(p.conv_norm_g + ch); bet = *(const f32x2*)(p.conv_norm_b + ch); }
#pragma unroll
        for (int i = 0; i < 3; ++i) { const int idx = tid + 512 * i, rr = idx >> 4, c8 = idx & 15;
            if (idx < 94 * 16) { const u32x4 v = rv[i], gg = rg[i];
                const f32x4 lo = {bflo(v[0]) * sigmoidf_(bflo(gg[0])), bfhi(v[0]) * sigmoidf_(bfhi(gg[0])), bflo(v[1]) * sigmoidf_(bflo(gg[1])), bfhi(v[1]) * sigmoidf_(bfhi(gg[1]))};
                const f32x4 hi = {bflo(v[2]) * sigmoidf_(bflo(gg[2])), bfhi(v[2]) * sigmoidf_(bfhi(gg[2])), bflo(v[3]) * sigmoidf_(bflo(gg[3])), bfhi(v[3]) * sigmoidf_(bfhi(gg[3]))};
                *(LAS f32x4*)(at + rr * 132 + c8 * 8) = lo; *(LAS f32x4*)(at + rr * 132 + c8 * 8 + 4) = hi; } }
        __syncthreads();
        if (u + (int)gridDim.x < 2048) load_raw(u + gridDim.x);
        f32x2 acc[8];
#pragma unroll
        for (int j = 0; j < 8; ++j) acc[j] = bias;
#pragma unroll
        for (int rr = 0; rr < 38; ++rr) { const f32x2 a2 = *(const LAS f32x2*)(at + (wave * 8 + rr) * 132 + 2 * lane);
#pragma unroll
            for (int j = 0; j < 8; ++j) { const int k = rr - j; if (k >= 0 && k < 31) acc[j] += wk[k] * a2; } }
#pragma unroll
        for (int j = 0; j < 8; ++j) { const float mu = wave_sum(acc[j][0] + acc[j][1]) * (1.f / 128.f); const float d0 = acc[j][0] - mu, d1 = acc[j][1] - mu;
            const float var = wave_sum(d0 * d0 + d1 * d1) * (1.f / 128.f); const float rs = rsqrtf(var + 1e-6f);
            const float y0 = d0 * rs * gam[0] + bet[0], y1 = d1 * rs * gam[1] + bet[1];
            if constexpr (D8_OUT0) *(unsigned short*)((unsigned char*)p.AO + (size_t)(b * SEQ + t0 + wave * 8 + j) * DM + ch) = (unsigned short)(pk4_fp8(siluf_(y0), siluf_(y1), 0.f, 0.f, A8_SCALE) & 0xffffu);
            else *(unsigned*)(p.AO + (size_t)(b * SEQ + t0 + wave * 8 + j) * DM + ch) = pk2(siluf_(y0), siluf_(y1)); }
        __syncthreads();
    }
}
DI unsigned off_b(unsigned row, unsigned ch) { return 256u * row + 16u * (ch ^ (((row & 3u) << 2) | ((row >> 2) & 3u))); }
DI void tr_read4(unsigned a0, unsigned a1, s16x4& r00, s16x4& r01, s16x4& r10, s16x4& r11) {
    asm volatile("ds_read_b64_tr_b16 %0, %4\n\tds_read_b64_tr_b16 %1, %5\n\tds_read_b64_tr_b16 %2, %4 offset:4096\n\tds_read_b64_tr_b16 %3, %5 offset:4096\n\ts_waitcnt lgkmcnt(0)"
                 : "=&v"(r00), "=&v"(r01), "=&v"(r10), "=&v"(r11) : "v"(a0), "v"(a1) : "memory");
}
template <int PASS> DI void attn_wave(const Params& p, LAS unsigned char* vimg, unsigned vb0, unsigned vb1, int lane_, int b, int h, int qbase  ) {
    int lane = lane_; asm volatile("" : "+v"(lane));
    const int c = lane & 31, hh = lane >> 5, srow = lane >> 4, sch = lane & 15;
    constexpr int QS = PASS == 0 ? 16 : 1, NT = PASS == 0 ? 13 : 5;
    const int tq = qbase + QS * c;
    const bf16_t* gb = p.G + (size_t)(b * SEQ) * N_IN0; const bf16_t* kb = p.KVH + (size_t)((b * 8 + h) * 2) * SEQ * 128;
    bf16_t* st_o = p.YB + ((size_t)(b * 8 + h) * SEQ + tq) * 128;
    float* st_ml = (float*)(p.YB + (size_t)NBATCH * 8 * SEQ * 128) + ((size_t)(b * 8 + h) * SEQ + tq) * 2;
    bf16x8 qf[8];
#pragma unroll
    for (int ks = 0; ks < 8; ++ks) qf[ks] = *(const bf16x8*)(gb + (size_t)tq * N_IN0 + 2048 + h * 128 + 16 * ks + 8 * hh);
    const float sc2 = 0.08838834764831845f * 1.4426950408889634f, sl2 = exp2f(-(float)(h + 1)) * 1.4426950408889634f;
    f32x16 o[4]; float m_run, l_run;
    if constexpr (PASS == 0) {
#pragma unroll
        for (int i = 0; i < 4; ++i)
#pragma unroll
            for (int j = 0; j < 16; ++j) o[i][j] = 0.f;
        m_run = -30000.f; l_run = 0.f;
    } else {
#pragma unroll
        for (int c4 = 0; c4 < 4; ++c4)
#pragma unroll
            for (int g4 = 0; g4 < 4; ++g4) { const uint2 v = *(const uint2*)(st_o + 32 * c4 + 8 * g4 + 4 * hh); o[c4][4 * g4] = bflo(v.x); o[c4][4 * g4 + 1] = bfhi(v.x); o[c4][4 * g4 + 2] = bflo(v.y); o[c4][4 * g4 + 3] = bfhi(v.y); }
        const f32x2 ml = *(const f32x2*)st_ml; m_run = ml[0]; l_run = hh == 0 ? ml[1] : 0.f;
    }
    auto tile_geom = [&](int tile, int& d, int& sb) { if constexpr (PASS == 0) { if (tile < 5) { d = 16; sb = qbase - 1024 + 512 * tile; } else { d = 4; sb = qbase - 256 + 128 * (tile - 5); } } else { d = 1; sb = qbase - 64 + 32 * tile; } };
    auto load_k = [&](int tile, bf16x8 (&kf)[8]) { int d, sb; tile_geom(tile, d, sb); int sp = sb + d * c; sp = sp < 0 ? 0 : (sp >= SEQ ? SEQ - 1 : sp);
        const bf16_t* src = kb + (unsigned)(sp * 128 + 8 * hh);
#pragma unroll
        for (int ks = 0; ks < 8; ++ks) kf[ks] = *(const bf16x8*)(src + 16 * ks); };
    auto load_v = [&](int tile, u32x4 (&vv)[8]) { int d, sb; tile_geom(tile, d, sb);
#pragma unroll
        for (int i = 0; i < 8; ++i) { int sp = sb + d * (srow + 4 * i); sp = sp < 0 ? 0 : (sp >= SEQ ? SEQ - 1 : sp); vv[i] = *(const u32x4*)(kb + (unsigned)(SEQ * 128 + sp * 128 + sch * 8)); } };
    bf16x8 kf[8]; u32x4 vv[8];
    load_k(0, kf); load_v(0, vv);
    for (int tile = 0; tile < NT; ++tile) {
        int d, sb; tile_geom(tile, d, sb);
        const int tn = tile < NT - 1 ? tile + 1 : NT - 1;
#pragma unroll
        for (int i = 0; i < 8; ++i) *(LAS u32x4*)(vimg + off_b(srow + 4 * i, sch)) = vv[i];
        load_v(tn, vv);
        f32x16 sacc;
#pragma unroll
        for (int j = 0; j < 16; ++j) sacc[j] = 0.f;
#pragma unroll
        for (int ks = 0; ks < 8; ++ks) sacc = __builtin_amdgcn_mfma_f32_32x32x16_bf16(kf[ks], qf[ks], sacc, 0, 0, 0);
        load_k(tn, kf);
        const float df = (float)d, basef = (float)(sb - tq) + df * (float)(4 * hh);
        const float lo = fmaxf(-64.f * df, -(float)tq), hi = fminf(64.f * df, (float)(SEQ - 1 - tq));
        const float mid = 0.5f * (lo + hi), half = 0.5f * (hi - lo);
        float tmax = -1e30f;
#pragma unroll
        for (int i = 0; i < 16; ++i) { const float deltaf = basef + df * (float)((i & 3) + 8 * (i >> 2));
            const bool valid = __builtin_fabsf(deltaf - mid) <= half;
            const float sv = valid ? sacc[i] * sc2 - sl2 * __builtin_fabsf(deltaf) : -1e30f; sacc[i] = sv; tmax = fmaxf(tmax, sv); }
        tmax = fmaxf(tmax, __shfl_xor(tmax, 32));
        const float m_new = tmax > m_run + 8.0f ? tmax : m_run;
        if (__any(m_new != m_run)) { const float alpha = __builtin_amdgcn_exp2f(m_run - m_new);
            l_run *= alpha;
#pragma unroll
            for (int i = 0; i < 4; ++i) o[i] *= alpha; }
        m_run = m_new;
        float psum = 0.f;
#pragma unroll
        for (int i = 0; i < 16; ++i) { const float pi = __builtin_amdgcn_exp2f(sacc[i] - m_new); psum += pi; sacc[i] = pi; }
        l_run += psum;
        bf16x8 pf[2];
#pragma unroll
        for (int s = 0; s < 2; ++s) { const unsigned w0 = pk2(sacc[8 * s], sacc[8 * s + 1]), w1 = pk2(sacc[8 * s + 2], sacc[8 * s + 3]), w2 = pk2(sacc[8 * s + 4], sacc[8 * s + 5]), w3 = pk2(sacc[8 * s + 6], sacc[8 * s + 7]);
            pf[s] = __builtin_bit_cast(bf16x8, (u32x4){w0, w1, w2, w3}); }
#pragma unroll
        for (int c4 = 0; c4 < 4; ++c4) {
            s16x4 r00, r01, r10, r11; tr_read4(vb0 ^ (unsigned)(c4 << 6), vb1 ^ (unsigned)(c4 << 6), r00, r01, r10, r11);
            const bf16x8 v0 = __builtin_shufflevector(r00, r01, 0, 1, 2, 3, 4, 5, 6, 7), v1 = __builtin_shufflevector(r10, r11, 0, 1, 2, 3, 4, 5, 6, 7);
            o[c4] = __builtin_amdgcn_mfma_f32_32x32x16_bf16(v0, pf[0], o[c4], 0, 0, 0);
            o[c4] = __builtin_amdgcn_mfma_f32_32x32x16_bf16(v1, pf[1], o[c4], 0, 0, 0); }
    }
    const float ltot = l_run + __shfl_xor(l_run, 32);
    if constexpr (PASS == 0) {
#pragma unroll
        for (int c4 = 0; c4 < 4; ++c4)
#pragma unroll
            for (int g4 = 0; g4 < 4; ++g4) *(uint2*)(st_o + 32 * c4 + 8 * g4 + 4 * hh) = make_uint2(pk2(o[c4][4 * g4], o[c4][4 * g4 + 1]), pk2(o[c4][4 * g4 + 2], o[c4][4 * g4 + 3]));
        if (hh == 0) *(f32x2*)st_ml = (f32x2){m_run, ltot};
    } else {
        const float inv = 1.0f / ltot;
        bf16_t* orow = p.AO + (size_t)(b * SEQ + tq) * DM + 1024 + h * 128;
#pragma unroll
        for (int c4 = 0; c4 < 4; ++c4)
#pragma unroll
            for (int g4 = 0; g4 < 4; ++g4) { const int dh = 32 * c4 + 8 * g4 + 4 * hh;
                if constexpr (D8_OUT0) *(unsigned*)((unsigned char*)p.AO + (size_t)(b * SEQ + tq) * DM + 1024 + h * 128 + dh) = pk4_fp8(o[c4][4 * g4] * inv, o[c4][4 * g4 + 1] * inv, o[c4][4 * g4 + 2] * inv, o[c4][4 * g4 + 3] * inv, A8_SCALE);
                else *(uint2*)(orow + dh) = make_uint2(pk2(o[c4][4 * g4] * inv, o[c4][4 * g4 + 1] * inv), pk2(o[c4][4 * g4 + 2] * inv, o[c4][4 * g4 + 3] * inv)); }
    }
}
DI void attention(const Params& p, LAS unsigned char* lds) {
    const int tid = opaque_tid(), wave = __builtin_amdgcn_readfirstlane(tid >> 6), lane = tid & 63, hh = lane >> 5;
    LAS unsigned char* vimg = lds + wave * 8192;
    const unsigned vbase = (unsigned)(uintptr_t)vimg;
    const int q4 = (lane & 15) >> 2, pp = lane & 3, blk = (lane >> 4) & 1;
    const unsigned vb0 = vbase + 256u * (4 * hh + q4) + 16u * ((2 * blk + (pp >> 1)) ^ (hh & 3)) + 8u * (pp & 1) + ((unsigned)q4 << 6);
    const unsigned vb1 = vbase + 256u * (8 + 4 * hh + q4) + 16u * ((2 * blk + (pp >> 1)) ^ ((2 + hh) & 3)) + 8u * (pp & 1) + ((unsigned)q4 << 6);
    for (int u = blockIdx.x; u < 256; u += gridDim.x) {
        const int bh = (u & 7) * 4 + ((u >> 3) >> 3), span = (u >> 3) & 7, h = bh & 7, b = bh >> 3;
#pragma unroll 1
        for (int j = 0; j < 2; ++j) attn_wave<0>(p, vimg, vb0, vb1, lane, b, h, span * 512 + wave * 2 + j);
        asm volatile("s_waitcnt vmcnt(0)" ::: "memory");
        __syncthreads();
#pragma unroll 1
        for (int j = 0; j < 2; ++j) attn_wave<1>(p, vimg, vb0, vb1, lane, b, h, span * 512 + (wave * 2 + j) * 32);
        __syncthreads();
    }
}
DI float om_exp2x(float la, float a) {
    const float x = 2.f * la;
    const float pl = x * (1.f + x * (0.5f + x * (0.16666667f + x * (0.041666668f + x * 0.008333334f))));
    return x > -0.25f ? -pl : 1.f - a * a;
}
DI void lru_conv(const Params& p) {
    const int tid = opaque_tid();
    if (tid < 336) {
        const int ch = tid * 8;
        float cw[4][8], cb[8];
#pragma unroll
        for (int j = 0; j < 4; ++j) { const f32x4 w0 = *(const f32x4*)(p.lru_conv_w + j * LRU_W + ch), w1 = *(const f32x4*)(p.lru_conv_w + j * LRU_W + ch + 4);
            cw[j][0] = w0[0]; cw[j][1] = w0[1]; cw[j][2] = w0[2]; cw[j][3] = w0[3]; cw[j][4] = w1[0]; cw[j][5] = w1[1]; cw[j][6] = w1[2]; cw[j][7] = w1[3]; }
        { const f32x4 b0 = *(const f32x4*)(p.lru_conv_b + ch), b1 = *(const f32x4*)(p.lru_conv_b + ch + 4); cb[0] = b0[0]; cb[1] = b0[1]; cb[2] = b0[2]; cb[3] = b0[3]; cb[4] = b1[0]; cb[5] = b1[1]; cb[6] = b1[2]; cb[7] = b1[3]; }
        for (int run = blockIdx.x; run < T_TOK / 32; run += gridDim.x) {
            const int tok0 = run * 32, t0 = tok0 % SEQ;
            const bf16_t* src = p.G + (size_t)tok0 * N_IN1 + LRU_W + ch;
            u32x4 rows[35];
#pragma unroll
            for (int i = 0; i < 35; ++i) { const int t = t0 - 2 + i; rows[i] = (t >= 0 && t < SEQ) ? *(const u32x4*)(src + (ptrdiff_t)(i - 2) * N_IN1) : (u32x4){0u, 0u, 0u, 0u}; }
#pragma unroll
            for (int i = 0; i < 32; ++i) { float xc[8];
#pragma unroll
                for (int e = 0; e < 8; ++e) xc[e] = cb[e];
#pragma unroll
                for (int j = 0; j < 4; ++j) { const u32x4 xv = rows[i + j];
                    xc[0] += cw[j][0] * bflo(xv[0]); xc[1] += cw[j][1] * bfhi(xv[0]); xc[2] += cw[j][2] * bflo(xv[1]); xc[3] += cw[j][3] * bfhi(xv[1]);
                    xc[4] += cw[j][4] * bflo(xv[2]); xc[5] += cw[j][5] * bfhi(xv[2]); xc[6] += cw[j][6] * bflo(xv[3]); xc[7] += cw[j][7] * bfhi(xv[3]); }
                *(u32x4*)(p.XC + (size_t)(tok0 + i) * LRU_W + ch) = (u32x4){pk2(xc[0], xc[1]), pk2(xc[2], xc[3]), pk2(xc[4], xc[5]), pk2(xc[6], xc[7])}; }
        }
    }
}
DI void lru(const Params& p, LAS unsigned char* lds) {
    const int tid = opaque_tid(), wave = __builtin_amdgcn_readfirstlane(tid >> 6), lane = tid & 63, col = lane & 15, g = lane >> 4;
    LAS unsigned char* wl = lds;
    LAS unsigned char* xs = lds + 36864;
    LAS float* sums = (LAS float*)(lds + 36864 + 86016);
    LAS float* cst = sums + 1920;
    for (int u = blockIdx.x; u < 256; u += gridDim.x) {
        const int b = u >> 6, n = (u >> 2) & 15, qt = u & 3, chq = n * LRU_BW + qt * 42;
        const char* xcb = (const char*)(p.XC + (size_t)(b * SEQ) * LRU_W + n * LRU_BW);
        const bf16_t* gb = p.G + (size_t)(b * SEQ) * N_IN1;
        unsigned poff[6];
#pragma unroll
        for (int i = 0; i < 6; ++i) { const int idx = tid + 512 * i; poff[i] = (unsigned)((idx / 21) * LRU_W + (idx % 21) * 8) * 2u; }
        auto dma_chunk = [&](int chunk, int bsel) { const char* src = xcb + (size_t)chunk * 128 * LRU_W * 2; LAS unsigned char* dst = xs + bsel * 43008 + wave * 1024;
#pragma unroll
            for (int i = 0; i < 5; ++i) __builtin_amdgcn_global_load_lds((const unsigned*)(src + poff[i]), (LAS unsigned*)(dst + i * 8192), 16, 0, 0);
            if (wave < 2) __builtin_amdgcn_global_load_lds((const unsigned*)(src + poff[5]), (LAS unsigned*)(dst + 5 * 8192), 16, 0, 0); };
        for (int dir = 0; dir < 2; ++dir) {
            __syncthreads();
            for (int i = tid; i < 2 * 48 * 24; i += 512) { const int which = i / (48 * 24), r = (i / 24) % 48, ck = i % 24; const int nt = r >> 4, cl = r & 15, ks = ck >> 2, gg = ck & 3;
                *(LAS u32x4*)(wl + ((which * 3 + nt) * 6 + ks) * 1024 + (gg * 16 + cl) * 16) = *(const u32x4*)(p.w_lru + ((((size_t)(dir * 2 + which) * 16 + n) * 4 + qt) * 48 + r) * 192 + ck * 8); }
            if (tid < 48) { const bool valid = tid < 42; const int ch = dir * LRU_W + chq + tid;
                cst[tid] = valid ? -1.44269504f * p.lru_b_a[ch] : 0.f; cst[48 + tid] = valid ? -1.44269504f * p.lru_b_x[ch] : 0.f;
                const float lam = valid ? p.lru_lambda[ch] : 0.f; const float sp = (-lam > 20.f) ? -lam : log1pf(__expf(-lam)); cst[96 + tid] = -8.0f * 1.44269504f * sp; }
            dma_chunk(dir == 0 ? 0 : 31, 0);
            asm volatile("s_waitcnt vmcnt(0)" ::: "memory");
            __syncthreads();
            float cba[3], cbx[3], cex[3];
#pragma unroll
            for (int nt = 0; nt < 3; ++nt) { cba[nt] = cst[nt * 16 + col]; cbx[nt] = cst[48 + nt * 16 + col]; cex[nt] = cst[96 + nt * 16 + col]; }
            bf16x8 breg[3][6];
#pragma unroll
            for (int nt = 0; nt < 3; ++nt)
#pragma unroll
                for (int ks = 0; ks < 6; ++ks) { breg[nt][ks] = *(const LAS bf16x8*)(wl + (nt * 6 + ks) * 1024 + lane * 16); asm volatile("" : "+v"(breg[nt][ks])); }
            const int wpos = dir == 0 ? wave : 7 - wave;
            float carry[3] = {0.f, 0.f, 0.f};
            for (int step = 0; step < 32; ++step) {
                const int c = dir == 0 ? step : 31 - step, c0 = c * 128, par = step & 1;
                const bool has_next = step < 31;
                if (has_next) dma_chunk(dir == 0 ? c + 1 : c - 1, par ^ 1);
                LAS unsigned char* xb = xs + par * 43008;
                uint2 hfv[3] = {make_uint2(0u, 0u), make_uint2(0u, 0u), make_uint2(0u, 0u)}; unsigned short gtv[3][4];
                const uint2* hfp = (const uint2*)p.HF + ((size_t)((u * 32 + c) * 8 + wave) * 3) * 64 + lane;
                const bf16_t* gbw = gb + (size_t)(c0 + wave * 16) * N_IN1 + chq;
                bf16_t* aow = p.AO + (size_t)(b * SEQ + c0 + wave * 16) * LRU_W + chq;
                if (dir == 1) {
#pragma unroll
                    for (int nt = 0; nt < 3; ++nt) { hfv[nt] = hfp[nt * 64];
#pragma unroll
                        for (int r = 0; r < 4; ++r) gtv[nt][r] = (nt * 16 + col < 42) ? gbw[(unsigned)((4 * g + r) * N_IN1 + nt * 16 + col)] : (unsigned short)0; } }
                bf16x8 af[6];
#pragma unroll
                for (int ks = 0; ks < 6; ++ks) { const int ch0 = 32 * ks + 8 * g; const bool kval = ch0 < LRU_BW; const int chl0 = kval ? ch0 : 160;
                    const u32x4 xv = *(const LAS u32x4*)(xb + (wave * 16 + col) * 336 + chl0 * 2);
                    af[ks] = __builtin_bit_cast(bf16x8, kval ? xv : (u32x4){0u, 0u, 0u, 0u}); }
                f32x4 acc[2][3];
                {
                    bf16x8 bl[6];
                    const LAS unsigned char* wl1 = wl + 18 * 1024 + lane * 16;
#pragma unroll
                    for (int ks = 0; ks < 6; ++ks) bl[ks] = *(const LAS bf16x8*)(wl1 + ks * 1024);
#pragma unroll
                    for (int nt = 0; nt < 3; ++nt) {
                        acc[0][nt] = (f32x4){0.f, 0.f, 0.f, 0.f}; acc[1][nt] = (f32x4){0.f, 0.f, 0.f, 0.f};
#pragma unroll
                        for (int ks = 0; ks < 6; ++ks) acc[0][nt] = __builtin_amdgcn_mfma_f32_16x16x32_bf16(af[ks], breg[nt][ks], acc[0][nt], 0, 0, 0);
#pragma unroll
                        for (int ks = 0; ks < 6; ++ks) { acc[1][nt] = __builtin_amdgcn_mfma_f32_16x16x32_bf16(af[ks], bl[ks], acc[1][nt], 0, 0, 0);
                            if (nt < 2) bl[ks] = *(const LAS bf16x8*)(wl1 + ((nt + 1) * 6 + ks) * 1024); }
                    }
                }
                float hl[3][4], Pl[3][4];
#pragma unroll
                for (int nt = 0; nt < 3; ++nt) { const int chl = nt * 16 + col;
                    float av[4], uv[4];
#pragma unroll
                    for (int r = 0; r < 4; ++r) {
                        const float rg = __builtin_amdgcn_rcpf(1.0f + __builtin_amdgcn_exp2f(__builtin_fmaf(acc[0][nt][r], -1.44269504f, cba[nt])));
                        const float ig = __builtin_amdgcn_rcpf(1.0f + __builtin_amdgcn_exp2f(__builtin_fmaf(acc[1][nt][r], -1.44269504f, cbx[nt])));
                        const float a = __builtin_amdgcn_exp2f(cex[nt] * rg);
                        const float xcv = bf2f(*(const LAS bf16_t*)(xb + (wave * 16 + 4 * g + r) * 336 + (qt * 42 + chl) * 2));
                        av[r] = a; uv[r] = __builtin_amdgcn_sqrtf(__builtin_fmaf(-a, a, 1.0f)) * (ig * xcv); }
                    float h[4], P[4], A, H;
                    if (dir == 0) { h[0] = uv[0]; P[0] = av[0];
#pragma unroll
                        for (int r = 1; r < 4; ++r) { h[r] = av[r] * h[r - 1] + uv[r]; P[r] = av[r] * P[r - 1]; }
                        A = P[3]; H = h[3];
                        { const float A1 = __shfl_up(A, 16), H1 = __shfl_up(H, 16); if (g >= 1) { H = A * H1 + H; A = A * A1; } }
                        { const float A2 = __shfl_up(A, 32), H2 = __shfl_up(H, 32); if (g >= 2) { H = A * H2 + H; A = A * A2; } }
                        float Ae = __shfl_up(A, 16), He = __shfl_up(H, 16); if (g == 0) { Ae = 1.f; He = 0.f; }
#pragma unroll
                        for (int r = 0; r < 4; ++r) { hl[nt][r] = h[r] + P[r] * He; Pl[nt][r] = P[r] * Ae; }
                        if (g == 3) *(LAS f32x2*)(sums + (par * 48 + chl) * 20 + wpos * 2) = (f32x2){A, H};
                    } else { h[3] = uv[3]; P[3] = av[3];
#pragma unroll
                        for (int r = 2; r >= 0; --r) { h[r] = av[r] * h[r + 1] + uv[r]; P[r] = av[r] * P[r + 1]; }
                        A = P[0]; H = h[0];
                        { const float A1 = __shfl_down(A, 16), H1 = __shfl_down(H, 16); if (g <= 2) { H = A * H1 + H; A = A * A1; } }
                        { const float A2 = __shfl_down(A, 32), H2 = __shfl_down(H, 32); if (g <= 1) { H = A * H2 + H; A = A * A2; } }
                        float Ae = __shfl_down(A, 16), He = __shfl_down(H, 16); if (g == 3) { Ae = 1.f; He = 0.f; }
#pragma unroll
                        for (int r = 0; r < 4; ++r) { hl[nt][r] = h[r] + P[r] * He; Pl[nt][r] = P[r] * Ae; }
                        if (g == 0) *(LAS f32x2*)(sums + (par * 48 + chl) * 20 + wpos * 2) = (f32x2){A, H};
                    }
                }
                asm volatile("s_waitcnt vmcnt(0)" ::: "memory");
                __syncthreads();
                f32x4 sv[3][4];
#pragma unroll
                for (int nt = 0; nt < 3; ++nt)
#pragma unroll
                    for (int j = 0; j < 4; ++j) sv[nt][j] = *(const LAS f32x4*)(sums + (par * 48 + nt * 16 + col) * 20 + j * 4);
#pragma unroll
                for (int nt = 0; nt < 3; ++nt) { const int chl = nt * 16 + col; float C = carry[nt], Cw = 0.f;
#pragma unroll
                    for (int k = 0; k < 8; ++k) { if (k == wpos) Cw = C; C = sv[nt][k >> 1][(k & 1) * 2] * C + sv[nt][k >> 1][(k & 1) * 2 + 1]; }
                    carry[nt] = C;
                    float hv[4];
#pragma unroll
                    for (int r = 0; r < 4; ++r) hv[r] = hl[nt][r] + Pl[nt][r] * Cw;
                    if (dir == 0) ((uint2*)p.HF)[((size_t)((u * 32 + c) * 8 + wave) * 3 + nt) * 64 + lane] = make_uint2(pk2(hv[0], hv[1]), pk2(hv[2], hv[3]));
                    else if (chl < 42) { const float ff[4] = {bflo(hfv[nt].x), bfhi(hfv[nt].x), bflo(hfv[nt].y), bfhi(hfv[nt].y)};
#pragma unroll
                        for (int r = 0; r < 4; ++r) aow[(unsigned)((4 * g + r) * LRU_W + chl)] = f2bf(bf2f(gtv[nt][r]) * (ff[r] + hv[r])); }
                }
            }
        }
    }
}
}

#define XB_TMO      128
#define XB_XCNT(j)  (256  + 64 * (j))
#define XB_XSUB(j)  (1280 + 64 * (j))
#define XB_XGEN(j)  (2304 + 64 * (j))
#define XB_TOP      3328
#define XB_TOPGEN   3392
#define XCD_BAR_WORDS 3456
#define XB_SPIN_CAP (1u << 18)

__device__ __forceinline__ unsigned xb_ld(unsigned* p)              { return __hip_atomic_load(p, __ATOMIC_RELAXED, __HIP_MEMORY_SCOPE_AGENT); }
__device__ __forceinline__ unsigned xb_add(unsigned* p, unsigned v) { return __hip_atomic_fetch_add(p, v, __ATOMIC_RELAXED, __HIP_MEMORY_SCOPE_AGENT); }
__device__ __forceinline__ unsigned xb_xcc_id() { return (unsigned)__builtin_amdgcn_s_getreg((3 << 11) | 20) & 0xFu; }
#define XB_SPIN(cond, bar) do { unsigned _sp = 0; while (cond) { __builtin_amdgcn_s_sleep(1); \
    if ((++_sp & 255u) == 0u) { if (xb_ld(&(bar)[XB_TMO])) break; if (_sp > XB_SPIN_CAP) { atomicAdd(&(bar)[XB_TMO], 1u); break; } } } } while (0)

struct XcdBarrier {
    unsigned* bar; unsigned x;
    volatile LAS unsigned* st;
};

__device__ __forceinline__ XcdBarrier xcd_barrier_post(unsigned* bar, volatile LAS unsigned* st) {
    XcdBarrier b; b.bar = bar; b.x = xb_xcc_id(); b.st = st;
    if (threadIdx.x == 0) (void)xb_add(&bar[XB_XCNT(b.x)], 1u);
    return b;
}
__device__ __forceinline__ void xcd_barrier_complete(unsigned* bar, unsigned x, unsigned& nloc, unsigned& nx) {
    const unsigned G = gridDim.x * gridDim.y * gridDim.z;
    unsigned sum, cnt, mine, sp = 0u;
    for (;;) {
        sum = 0u; cnt = 0u; mine = 0u;
#pragma unroll
        for (unsigned j = 0; j < 16; ++j) { const unsigned c = xb_ld(&bar[XB_XCNT(j)]); sum += c; cnt += (c > 0u) ? 1u : 0u; mine = (j == x) ? c : mine; }
        if (sum == G) break;
        __builtin_amdgcn_s_sleep(1);
        if ((++sp & 255u) == 0u) { if (xb_ld(&bar[XB_TMO])) break; if (sp > XB_SPIN_CAP) { atomicAdd(&bar[XB_TMO], 1u); break; } }
    }
    nloc = mine > 0u ? mine : 1u; nx = cnt > 0u ? cnt : 1u;
}

__device__ __forceinline__ void xcd_barrier(const XcdBarrier& b) {
    asm volatile("s_waitcnt vmcnt(0)" ::: "memory");
    __syncthreads();
    if (threadIdx.x == 0) {
        unsigned* bar = b.bar;
        __builtin_amdgcn_s_waitcnt(0);
        unsigned nloc = b.st[0], nx = b.st[1];
        if (nloc == 0u) { xcd_barrier_complete(bar, b.x, nloc, nx); b.st[0] = nloc; b.st[1] = nx; }
        const unsigned old = xb_add(&bar[XB_XSUB(b.x)], 1u);
        const unsigned gen = old / nloc;
        if (old + 1u == (gen + 1u) * nloc) {
            __builtin_amdgcn_fence(__ATOMIC_RELEASE, "agent");
            asm volatile("s_waitcnt vmcnt(0)" ::: "memory");
            const unsigned og = xb_add(&bar[XB_TOP], 1u);
            const unsigned tg = og / nx;
            if (og + 1u == (tg + 1u) * nx) xb_add(&bar[XB_TOPGEN], 1u);
            else XB_SPIN(xb_ld(&bar[XB_TOPGEN]) == tg, bar);
            __builtin_amdgcn_fence(__ATOMIC_ACQUIRE, "agent");
            xb_add(&bar[XB_XGEN(b.x)], 1u);
            asm volatile("s_waitcnt vmcnt(0)" ::: "memory");
        } else {
            XB_SPIN(xb_ld(&bar[XB_XGEN(b.x)]) == gen, bar);
            __builtin_amdgcn_fence(__ATOMIC_ACQUIRE, "agent");
            asm volatile("s_waitcnt vmcnt(0)" ::: "memory");
        }
    }
    __syncthreads();
}


constexpr int PROBE = 0;
constexpr int LDS_XB_OFF = gm::STAGE_BYTES + 1024;
constexpr int LDS_TOTAL = LDS_XB_OFF + 16;
__global__ void __launch_bounds__(512, 2) mega(Params p) {
    LAS unsigned char* lds = (LAS unsigned char*)dyn_smem;
    LAS int* tab = (LAS int*)(lds + gm::TAB_OFF);
    volatile LAS unsigned* xbw = (volatile LAS unsigned*)(lds + LDS_XB_OFF);
    if (threadIdx.x == 0) { xbw[0] = 0u; xbw[1] = 0u; xbw[2] = 0u; xbw[3] = 0u; }
    __syncthreads();
    XcdBarrier bar = xcd_barrier_post(p.bar, xbw);
    ph::mods(p, lds);
    if constexpr (PROBE == 14) { ph::mods(p, lds); ph::mods(p, lds); }
    xcd_barrier(bar);
    { const int c = blockIdx.x, G = gridDim.x;
      ph::transposer(p, lds, c, c < 320 ? (320 - c + G - 1) / G : 0, G); __syncthreads();
      ph::transposer(p, lds, 320 + c, c < 632 ? (632 - c + G - 1) / G : 0, G); __syncthreads(); }
    ph::lru_weights(p);
    ph::fold_router(p);
    ph::norm_rows<0, D8_IN0>(p, p.x, p.norm0_mix, 0, 0, nullptr);
    xcd_barrier(bar);
    { const int c = blockIdx.x, G = gridDim.x; const int tcount = c < 6144 ? (6144 - c + G - 1) / G : 0; const bool t_first = ((c >> 3) & 1) != 0;
      if (t_first) { ph::transposer(p, lds, 952 + c, tcount, G); __syncthreads(); }
      { gm::DenseSched S; S.init(T_TOK, N_IN0); EpiIn0 e; e.xin = nullptr; e.lgate = 0; if constexpr (D8_IN0) gm::gemm_phase<EpiIn0, gm::DenseSched, true>(lds, p, p.H, p.w_in0t, 0, DM / 2, S, e, W8_E8M0, A8_E8M0); else gm::gemm_phase(lds, p, p.H, p.w_in0t, 0, DM, S, e); }
      if (!t_first) { __syncthreads(); ph::transposer(p, lds, 952 + c, tcount, G); }
      if constexpr (PROBE == 21) { __syncthreads(); ph::transposer(p, lds, 952 + c, tcount, G); }
      if constexpr (PROBE == 24) { __syncthreads(); if (t_first) ph::transposer(p, lds, 952 + c, tcount, G); }
      if constexpr (PROBE == 23) { __syncthreads(); if (t_first) { ph::transposer(p, lds, 952 + c, tcount, G); __syncthreads(); }
        { gm::DenseSched S; S.init(T_TOK, N_IN0); EpiIn0 e; e.xin = nullptr; e.lgate = 0; gm::gemm_phase<EpiIn0, gm::DenseSched, true>(lds, p, p.H, p.w_in0t, 0, DM / 2, S, e, W8_E8M0, A8_E8M0); }
        if (!t_first) { __syncthreads(); ph::transposer(p, lds, 952 + c, tcount, G); } }
      if constexpr (PROBE == 20) { __syncthreads(); gm::DenseSched S; S.init(T_TOK, N_IN0); EpiIn0 e; e.xin = nullptr; e.lgate = 0; gm::gemm_phase<EpiIn0, gm::DenseSched, true>(lds, p, p.H, p.w_in0t, 0, DM / 2, S, e, W8_E8M0, A8_E8M0); } }
    xcd_barrier(bar);
    ph::attention(p, lds);
    if constexpr (PROBE == 4) ph::attention(p, lds);
    __syncthreads();
    ph::conv_gln(p, lds);
    if constexpr (PROBE == 5) ph::conv_gln(p, lds);
    xcd_barrier(bar);
    { gm::DenseSched S; S.init(T_TOK, DM); EpiOutT<true> e; e.xin = p.x; e.lgate = 0; if constexpr (D8_OUT0) gm::gemm_phase<EpiOutT<true>, gm::DenseSched, true>(lds, p, p.AO, p.w_out0t, 0, DM / 2, S, e, W8_E8M0, A8_E8M0); else gm::gemm_phase(lds, p, p.AO, p.w_out0t, 0, DM, S, e); }
    xcd_barrier(bar);
    ph::router<false, true>(p, 0, lds, p.norm0_ffn, 1);
    if constexpr (PROBE == 12) { ph::router<true>(p, 0, lds); ph::router<true>(p, 0, lds); }
    xcd_barrier(bar);
    if constexpr (PROBE == 11) { xcd_barrier(bar); xcd_barrier(bar); xcd_barrier(bar); xcd_barrier(bar); xcd_barrier(bar); xcd_barrier(bar); xcd_barrier(bar); xcd_barrier(bar); xcd_barrier(bar); xcd_barrier(bar); }
    gm::moe_tables(tab, p.cnt);
    { gm::MoeSched<true> S; S.init(tab); EpiGU e; e.xin = nullptr; e.lgate = 0; gm::gemm_phase<EpiGU, gm::MoeSched<true>, true>(lds, p, p.H, p.w_gut0, (size_t)2048 * (DM / 2), DM / 2, S, e, W8_E8M0, A8_E8M0); if constexpr (PROBE == 3) gm::gemm_phase<EpiGU, gm::MoeSched<true>, true>(lds, p, p.H, p.w_gut0, (size_t)2048 * (DM / 2), DM / 2, S, e, W8_E8M0, A8_E8M0); }
    xcd_barrier(bar);
    { gm::MoeSched<false> S; S.init(tab); EpiDown e; e.xin = nullptr; e.lgate = 0; gm::gemm_phase<EpiDown, gm::MoeSched<false>, true>(lds, p, p.ACT, p.w_dt0, (size_t)DM * (EFF / 2), EFF / 2, S, e, W8_E8M0, A8_E8M0); if constexpr (PROBE == 8) gm::gemm_phase<EpiDown, gm::MoeSched<false>, true>(lds, p, p.ACT, p.w_dt0, (size_t)DM * (EFF / 2), EFF / 2, S, e, W8_E8M0, A8_E8M0); }
    xcd_barrier(bar);
    ph::norm_rows<1, D8_IN1>(p, nullptr, p.norm1_mix, 2, 1, tab);
    xcd_barrier(bar);
    { const int c = blockIdx.x, G = gridDim.x; int tfirst, tcount, tstride;
      if (G == 256) { tstride = 1; if (c < 64) { tcount = 18; tfirst = 18 * c; } else { tcount = 26; tfirst = 1152 + 26 * (c - 64); } }
      else { tstride = G; tfirst = c; tcount = c < 6144 ? (6144 - c + G - 1) / G : 0; }
      const bool t_first = ((c >> 3) & 1) != 0;
      if (t_first) { ph::transposer(p, lds, 7096 + tfirst, tcount, tstride); __syncthreads(); }
      { gm::DenseSched S; S.init(T_TOK, N_IN1); EpiIn1 e; e.xin = nullptr; e.lgate = 0; gm::gemm_phase(lds, p, p.H, p.w_in1t, 0, DM, S, e); }
      if (!t_first) { __syncthreads(); ph::transposer(p, lds, 7096 + tfirst, tcount, tstride); } }
    xcd_barrier(bar);
    ph::lru_conv(p);
    if constexpr (PROBE == 9) { ph::lru_conv(p); ph::lru_conv(p); }
    xcd_barrier(bar);
    ph::lru(p, lds);
    if constexpr (PROBE == 6) ph::lru(p, lds);
    xcd_barrier(bar);
    { gm::DenseSched S; S.init(T_TOK, DM); EpiOutT<false> e; e.xin = nullptr; e.lgate = 2; gm::gemm_phase(lds, p, p.AO, p.w_out1t, 0, LRU_W, S, e); }
    xcd_barrier(bar);
    ph::router<false, true>(p, 1, lds, p.norm1_ffn, 3);
    xcd_barrier(bar);
    gm::moe_tables(tab, p.cnt + 32);
    { gm::MoeSched<true> S; S.init(tab); EpiGU e; e.xin = nullptr; e.lgate = 0; gm::gemm_phase<EpiGU, gm::MoeSched<true>, true>(lds, p, p.H, p.w_gut1, (size_t)2048 * (DM / 2), DM / 2, S, e, W8_E8M0, A8_E8M0); }
    xcd_barrier(bar);
    { gm::MoeSched<false> S; S.init(tab); EpiDown e; e.xin = nullptr; e.lgate = 0; gm::gemm_phase<EpiDown, gm::MoeSched<false>, true>(lds, p, p.ACT, p.w_dt1, (size_t)DM * (EFF / 2), EFF / 2, S, e, W8_E8M0, A8_E8M0); }
    xcd_barrier(bar);
    ph::norm_rows<2>(p, nullptr, p.norm_final, 0, 3, tab);
}

static inline size_t al256(size_t x) { return (x + 255) & ~(size_t)255; }

extern "C" void kernel_launch(void* const* d_in, const int* in_sizes, int n_in, void* d_out, int out_size, void* d_ws, size_t ws_size, hipStream_t stream) {
    Params p{};
    const float** ip = (const float**)&p.x;
    for (int i = 0; i < 38; ++i) ip[i] = (const float*)d_in[i];
    p.out = (float*)d_out;
    char* w = (char*)d_ws; size_t off = 0;
    auto take = [&](size_t bytes) { char* r = w + off; off += al256(bytes); return r; };
    p.bar = (unsigned*)take(16384); p.cnt = (int*)take(256);
    const size_t zero_bytes = off;
    p.mod = (float*)take(4 * 4 * 6144 * 4); p.wrt = (bf16_t*)take((size_t)2 * 4 * 3 * 48 * 2048 * 2); p.rbias = (float*)take(2 * 4 * 48 * 4);
    p.w_in0t = (bf16_t*)take((size_t)N_IN0 * DM * 2); p.w_out0t = (bf16_t*)take((size_t)DM * DM * 2);
    p.w_gut0 = (bf16_t*)take((size_t)NEXP * 2048 * DM); p.w_dt0 = (bf16_t*)take((size_t)NEXP * DM * EFF);
    p.w_in1t = (bf16_t*)take((size_t)N_IN1 * DM * 2); p.w_out1t = (bf16_t*)take((size_t)DM * LRU_W * 2);
    p.w_gut1 = (bf16_t*)take((size_t)NEXP * 2048 * DM); p.w_dt1 = (bf16_t*)take((size_t)NEXP * DM * EFF);
    p.w_lru = (bf16_t*)take((size_t)2 * 2 * 16 * 2 * 96 * 192 * 2);
    p.H = (bf16_t*)take((size_t)T_TOK * DM * 2); p.G = (bf16_t*)take((size_t)T_TOK * N_IN1 * 2); p.AO = (bf16_t*)take((size_t)T_TOK * LRU_W * 2); p.HF = (bf16_t*)take((size_t)256 * 32 * 8 * 3 * 64 * 8);
    p.XA = (bf16_t*)take((size_t)T_TOK * DM * 2); p.ACT = (bf16_t*)take((size_t)ROWS_PAD * EFF * 2); p.YB = (bf16_t*)take((size_t)ROWS_PAD * DM * 2);
    p.XC = (bf16_t*)take((size_t)T_TOK * LRU_W * 2); p.KVH = (bf16_t*)take((size_t)NBATCH * 8 * 2 * SEQ * 128 * 2);
    p.tokl = (int*)take((size_t)NEXP * ECAP * 4); p.gatel = (float*)take((size_t)NEXP * ECAP * 4); p.asg = (int*)take((size_t)T_TOK * 2 * 4);
    if (off > ws_size) return;
    (void)hipMemsetAsync(d_ws, 0, zero_bytes, stream);
    static int grid = 0;
    if (!grid) { int dev = 0, cus = 0, per_cu = 0; (void)hipGetDevice(&dev); (void)hipDeviceGetAttribute(&cus, hipDeviceAttributeMultiprocessorCount, dev);
        (void)hipFuncSetAttribute((const void*)mega, hipFuncAttributeMaxDynamicSharedMemorySize, LDS_TOTAL);
        (void)hipOccupancyMaxActiveBlocksPerMultiprocessor(&per_cu, mega, 512, LDS_TOTAL);
        grid = cus * (per_cu < 1 ? per_cu : 1); }
    if (grid > 0) mega<<<grid, 512, LDS_TOTAL, stream>>>(p);
}
```

```cpp
#include <hip/hip_runtime.h>
#include <stdint.h>

typedef unsigned short bf16_t;
typedef float f32x4 __attribute__((ext_vector_type(4)));

#define DI __device__ __forceinline__

constexpr int T_TOK = 16384, DM = 2048, SEQ = 4096, NBATCH = 4;
constexpr int N_IN0 = 5120, N_IN1 = 5376, LRU_W = 2688, LRU_BW = 168;
constexpr int NEXP = 32, EFF = 1024, ECAP = 16384, ROWS_PAD = 40960;

DI float bf2f(bf16_t b) { return __uint_as_float(((unsigned)b) << 16); }
DI bf16_t f2bf(float f) { unsigned u = __float_as_uint(f); u += 0x7FFFu + ((u >> 16) & 1u); return (bf16_t)(u >> 16); }
DI float sigmoidf_(float x) { return __builtin_amdgcn_rcpf(1.0f + __expf(-x)); }
DI float siluf_(float x) { return x * __builtin_amdgcn_rcpf(1.0f + __expf(-x)); }
DI float gelu_tanh(float x) { const float u = 0.7978845608028654f * (x + 0.044715f * x * x * x); return x * __builtin_amdgcn_rcpf(1.0f + __expf(-2.0f * u)); }
template <int CTRL, int ROWMASK> DI float dpp_mov(float oldv, float v) { return __builtin_bit_cast(float, __builtin_amdgcn_update_dpp(__builtin_bit_cast(int, oldv), __builtin_bit_cast(int, v), CTRL, ROWMASK, 0xf, false)); }
DI float wave_sum(float v) {
    v += dpp_mov<0xB1, 0xf>(0.f, v);
    v += dpp_mov<0x4E, 0xf>(0.f, v);
    v += dpp_mov<0x141, 0xf>(0.f, v);
    v += dpp_mov<0x140, 0xf>(0.f, v);
    v += dpp_mov<0x142, 0xa>(0.f, v);
    v += dpp_mov<0x143, 0xc>(0.f, v);
    return __builtin_bit_cast(float, __builtin_amdgcn_readlane(__builtin_bit_cast(int, v), 63)); }
DI float wave_max(float v) { for (int o = 32; o > 0; o >>= 1) v = fmaxf(v, __shfl_xor(v, o)); return v; }

struct Params {
    const float *x, *c;
    const float *norm0_mix, *ada0_mix_w, *ada0_mix_b, *w_in0, *conv_w, *conv_b, *conv_norm_g, *conv_norm_b, *w_out0;
    const float *norm0_ffn, *ada0_ffn_w, *ada0_ffn_b, *moe0_w_group, *moe0_w_expert, *moe0_w_gate_up, *moe0_w_down;
    const float *norm1_mix, *ada1_mix_w, *ada1_mix_b, *w_in1, *lru_conv_w, *lru_conv_b, *lru_w_a, *lru_b_a, *lru_w_x, *lru_b_x, *lru_lambda, *w_out1;
    const float *norm1_ffn, *ada1_ffn_w, *ada1_ffn_b, *moe1_w_group, *moe1_w_expert, *moe1_w_gate_up, *moe1_w_down;
    const float *norm_final;
    float* out;
    unsigned* bar; int* cnt;
    float* mod;
    bf16_t* wrt;
    float* rbias;
    bf16_t *w_in0t, *w_out0t, *w_gut0, *w_dt0, *w_in1t, *w_out1t, *w_gut1, *w_dt1, *w_lru;
    bf16_t *H, *G, *AO, *HF, *ACT, *YB, *XC, *KVH;
    bf16_t* XA;
    int* tokl; float* gatel; int* asg;
};

constexpr bool YB8_E = true;
struct GUnit { int rowbase; int nvalid; int e; const int* gather; };
struct GArgs { const bf16_t* A; const bf16_t* Bt; size_t bt_estride; long long lda, K, moe_layer; const float* xin; long long lgate; };
typedef unsigned u32x4_ __attribute__((ext_vector_type(4)));
typedef __bf16 bf2v_ __attribute__((ext_vector_type(2)));
typedef float f32x2_ __attribute__((ext_vector_type(2)));
DI unsigned pk2e(float a, float b) { f32x2_ v = {a, b}; bf2v_ r = __builtin_convertvector(v, bf2v_); return __builtin_bit_cast(unsigned, r); }
DI u32x4_ pack8(f32x4 a, f32x4 b) { return (u32x4_){pk2e(a[0], a[1]), pk2e(a[2], a[3]), pk2e(b[0], b[1]), pk2e(b[2], b[3])}; }
struct EpiIn0 { static constexpr bool GATHER = false, PRE = false; const float* xin; int lgate; DI void operator()(const Params& p, const GUnit& u, int r, int col0, f32x4 lo0, f32x4 lo1, f32x4 hi0, f32x4 hi1) const {
    const int row = u.rowbase + r;
    if (col0 < 3072) { bf16_t* o = p.G + (size_t)row * N_IN0 + col0; *(u32x4_*)o = pack8(lo0, lo1); *(u32x4_*)(o + 128) = pack8(hi0, hi1); }
    else { const int b = row / SEQ, t = row % SEQ, i0 = (col0 - 3072) >> 7, i1 = i0 + 1;
        bf16_t* o0 = p.KVH + ((size_t)((b * 8 + (i0 & 7)) * 2 + (i0 >> 3)) * SEQ + t) * 128 + (col0 & 127);
        bf16_t* o1 = p.KVH + ((size_t)((b * 8 + (i1 & 7)) * 2 + (i1 >> 3)) * SEQ + t) * 128 + (col0 & 127);
        *(u32x4_*)o0 = pack8(lo0, lo1); *(u32x4_*)o1 = pack8(hi0, hi1); } } };
template <bool F32RES> struct EpiOutT { static constexpr bool GATHER = false, PRE = true; const float* xin; int lgate;
    struct UPre { f32x4 g0, g1, g2, g3; };
    struct Pre { f32x4 x0, x1, x2, x3; u32x4_ a, c; };
    DI UPre unit_pre(const Params& p, const GUnit& u, int col0) const { const int b = u.rowbase / SEQ; const float* gt = p.mod + (lgate * 4 + b) * 6144 + 4096 + col0;
        UPre q; q.g0 = *(const f32x4*)gt; q.g1 = *(const f32x4*)(gt + 4); q.g2 = *(const f32x4*)(gt + 128); q.g3 = *(const f32x4*)(gt + 132); return q; }
    DI Pre pre(const Params& p, const GUnit& u, int r, int col0) const { const size_t off = (size_t)(u.rowbase + r) * DM + col0; Pre q;
        if constexpr (F32RES) { const float* xi = xin + off; q.x0 = *(const f32x4*)xi; q.x1 = *(const f32x4*)(xi + 4); q.x2 = *(const f32x4*)(xi + 128); q.x3 = *(const f32x4*)(xi + 132); }
        else { const bf16_t* o = p.XA + off; q.a = *(const u32x4_*)o; q.c = *(const u32x4_*)(o + 128); }
        return q; }
    DI void fin(const Params& p, const GUnit& u, int r, int col0, const UPre& g, const Pre& q, f32x4 lo0, f32x4 lo1, f32x4 hi0, f32x4 hi1) const {
        bf16_t* o = p.XA + (size_t)(u.rowbase + r) * DM + col0;
        f32x4 r0, r1, r2, r3;
        if constexpr (F32RES) { r0 = q.x0; r1 = q.x1; r2 = q.x2; r3 = q.x3; }
        else { const u32x4_ a = q.a, c = q.c;
            r0 = (f32x4){__uint_as_float(a[0] << 16), __uint_as_float(a[0] & 0xffff0000u), __uint_as_float(a[1] << 16), __uint_as_float(a[1] & 0xffff0000u)};
            r1 = (f32x4){__uint_as_float(a[2] << 16), __uint_as_float(a[2] & 0xffff0000u), __uint_as_float(a[3] << 16), __uint_as_float(a[3] & 0xffff0000u)};
            r2 = (f32x4){__uint_as_float(c[0] << 16), __uint_as_float(c[0] & 0xffff0000u), __uint_as_float(c[1] << 16), __uint_as_float(c[1] & 0xffff0000u)};
            r3 = (f32x4){__uint_as_float(c[2] << 16), __uint_as_float(c[2] & 0xffff0000u), __uint_as_float(c[3] << 16), __uint_as_float(c[3] & 0xffff0000u)}; }
        *(u32x4_*)o = pack8(r0 + g.g0 * lo0, r1 + g.g1 * lo1); *(u32x4_*)(o + 128) = pack8(r2 + g.g2 * hi0, r3 + g.g3 * hi1); } };
DI unsigned pk4_fp8e(float a, float b, float c, float d, float sc) { a = fminf(fmaxf(a * sc, -448.f), 448.f); b = fminf(fmaxf(b * sc, -448.f), 448.f); c = fminf(fmaxf(c * sc, -448.f), 448.f); d = fminf(fmaxf(d * sc, -448.f), 448.f);
    unsigned w = 0u; w = __builtin_amdgcn_cvt_pk_fp8_f32(a, b, w, false); w = __builtin_amdgcn_cvt_pk_fp8_f32(c, d, w, true); return w; }
struct EpiGU { static constexpr bool GATHER = true, PRE = false; const float* xin; int lgate; DI void operator()(const Params& p, const GUnit& u, int r, int col0, f32x4 lo0, f32x4 lo1, f32x4 hi0, f32x4 hi1) const {
    f32x4 a0, a1;
#pragma unroll
    for (int j = 0; j < 4; ++j) { a0[j] = siluf_(lo0[j]) * hi0[j]; a1[j] = siluf_(lo1[j]) * hi1[j]; }
    *(uint2*)((unsigned char*)p.ACT + (size_t)(u.rowbase + r) * EFF + (col0 >> 8) * 128 + (col0 & 127)) = make_uint2(pk4_fp8e(a0[0], a0[1], a0[2], a0[3], 8.f), pk4_fp8e(a1[0], a1[1], a1[2], a1[3], 8.f)); } };
struct EpiDown { static constexpr bool GATHER = false, PRE = true; const float* xin; int lgate;
    struct UPre { int none; };
    struct Pre { float g; };
    DI UPre unit_pre(const Params&, const GUnit&, int) const { return UPre{0}; }
    DI Pre pre(const Params& p, const GUnit& u, int r, int) const { return Pre{p.gatel[(u.gather - p.tokl) + r]}; }
    DI void fin(const Params& p, const GUnit& u, int r, int col0, const UPre&, const Pre& q, f32x4 lo0, f32x4 lo1, f32x4 hi0, f32x4 hi1) const {
    const float g = q.g;
    if constexpr (YB8_E) { const float gs = g * 64.f; unsigned char* o = (unsigned char*)p.YB + (size_t)(u.rowbase + r) * DM + col0;
        *(uint2*)o = make_uint2(pk4_fp8e(lo0[0], lo0[1], lo0[2], lo0[3], gs), pk4_fp8e(lo1[0], lo1[1], lo1[2], lo1[3], gs)); *(uint2*)(o + 128) = make_uint2(pk4_fp8e(hi0[0], hi0[1], hi0[2], hi0[3], gs), pk4_fp8e(hi1[0], hi1[1], hi1[2], hi1[3], gs)); }
    else { bf16_t* o = p.YB + (size_t)(u.rowbase + r) * DM + col0; *(u32x4_*)o = pack8(lo0 * g, lo1 * g); *(u32x4_*)(o + 128) = pack8(hi0 * g, hi1 * g); } } };
struct EpiIn1 { static constexpr bool GATHER = false, PRE = false; const float* xin; int lgate; DI void operator()(const Params& p, const GUnit& u, int r, int col0, f32x4 lo0, f32x4 lo1, f32x4 hi0, f32x4 hi1) const {
    bf16_t* o = p.G + (size_t)(u.rowbase + r) * N_IN1 + col0;
    if (col0 < LRU_W) {
#pragma unroll
        for (int j = 0; j < 4; ++j) { lo0[j] = gelu_tanh(lo0[j]); lo1[j] = gelu_tanh(lo1[j]); } }
    if (col0 + 128 < LRU_W) {
#pragma unroll
        for (int j = 0; j < 4; ++j) { hi0[j] = gelu_tanh(hi0[j]); hi1[j] = gelu_tanh(hi1[j]); } }
    *(u32x4_*)o = pack8(lo0, lo1); *(u32x4_*)(o + 128) = pack8(hi0, hi1); } };

#define LAS __attribute__((address_space(3)))
typedef short bf16x8 __attribute__((ext_vector_type(8)));
DI int opaque_tid() { int t = threadIdx.x; asm volatile("" : "+v"(t)); return t; }
namespace gm {
constexpr int BM = 256, BK = 64, HALF = 128, HTB = HALF * BK * 2, STAGE_BYTES = 8 * HTB, NXCD = 8, WGM = 4;
constexpr int TAB_OFF = STAGE_BYTES;
DI int lds_byte(int r, int c) { const int st = (r >> 4) * 2 + (c >> 5), rr = r & 15, cc = c & 31, ob = rr * 64 + cc * 2; return st * 1024 + (ob ^ (((ob >> 9) & 1) << 5)); }
DI int perm32(int rho) { const int n = rho >> 4, i = rho & 15; return 8 * (i >> 2) + 4 * n + (i & 3); }
DI void stage_rc(int b, int& R, int& C) { const int st = b / 1024, sb = b % 1024, swz = sb ^ (((sb >> 9) & 1) << 5); R = (st >> 1) * 16 + swz / 64; C = (st & 1) * 32 + (swz % 64) / 2; }
struct Unit { int arow, nvalid, orow, pn, e, goff; };
struct DenseSched {
    static constexpr bool GATHER = false, HALF_SKIP = false;
    int nM, nN, nwg, G, c;
    DI void init(int M, int N) { nM = M / BM; nN = N / BM; nwg = nM * nN; G = gridDim.x; c = blockIdx.x; }
    DI bool next(int i, Unit& u) const {
        const long L = (long)i * G + c; if (L >= nwg) return false;
        int wgid = (int)L; { const int q = nwg / NXCD, r = nwg % NXCD, xcd = wgid % NXCD, off = wgid / NXCD; wgid = (xcd < r ? xcd * (q + 1) : r * (q + 1) + (xcd - r) * q) + off; }
        const int nig = WGM * nN, gid = wgid / nig, fm = gid * WGM, gsz = (nM - fm) < WGM ? (nM - fm) : WGM;
        const int pm = fm + ((wgid % nig) % gsz); u.pn = (wgid % nig) / gsz; u.arow = pm * BM; u.orow = pm * BM; u.nvalid = BM; u.e = 0; u.goff = 0; return true;
    }
};
template <bool GATH> struct MoeSched {
    static constexpr bool GATHER = GATH, HALF_SKIP = true;
    const LAS int* tab; int G, c;
    DI void init(const LAS int* t) { tab = t; G = gridDim.x; c = blockIdx.x; }
    DI bool next(int i, Unit& u) const {
        const int L = i * G + c, mtile = L >> 3; const int total = __builtin_amdgcn_readfirstlane(tab[32]);
        if (mtile >= total) return false;
        int e = 0; for (int j = 1; j < 32; ++j) { if (__builtin_amdgcn_readfirstlane(tab[j]) <= mtile) e = j; }
        const int mt = mtile - __builtin_amdgcn_readfirstlane(tab[e]); const int cn = __builtin_amdgcn_readfirstlane(tab[64 + e]);
        u.e = e; u.pn = L & 7; u.orow = mtile * BM; u.arow = mtile * BM; u.nvalid = (cn - mt * BM) < BM ? (cn - mt * BM) : BM; u.goff = e * ECAP + mt * BM; return true;
    }
};
DI void moe_tables(LAS int* tab, const int* cnt) {
    if (threadIdx.x == 0) { int run = 0; for (int e = 0; e < 32; ++e) { const int cn = cnt[e]; tab[e] = run; tab[64 + e] = cn; run += (cn + 255) >> 8; } tab[32] = run; }
    __syncthreads();
}

typedef int i32x8 __attribute__((ext_vector_type(8)));
typedef int i32x4 __attribute__((ext_vector_type(4)));
DI void mfma8(f32x4& acc, const i32x8& w8, const i32x8& x8, int ws, int as) {
    asm volatile("v_mfma_scale_f32_16x16x128_f8f6f4 %0, %1, %2, %0, %3, %4 op_sel_hi:[0,0,0]" : "+v"(acc) : "v"(w8), "v"(x8), "v"(ws), "v"(as)); }
template <class Epi, class Sched, bool FP8 = false>
DI void gemm_phase(LAS unsigned char* lds, const Params& p, const bf16_t* A, const bf16_t* Bt, size_t bt_estride, int K, const Sched& S, const Epi& E, int wscale = 0x7f7f7f7f, int ascale = 0x7f7f7f7f) {
    const int tid = opaque_tid(), wid = __builtin_amdgcn_readfirstlane(tid >> 6), lane = tid & 63, wr = wid >> 2, wc = wid & 3, fr = lane & 15, fq = lane >> 4;
    const int nt = K / BK;
    unsigned voffA[2], voffB[2];
#pragma unroll
    for (int i = 0; i < 2; ++i) { int R, C; stage_rc(tid * 16 + i * 8192, R, C); voffA[i] = (unsigned)(R * K + C) * 2u; voffB[i] = (unsigned)(((R & ~31) + perm32(R & 31)) * K + C) * 2u; }
    const size_t kstep = (size_t)(BK * 2), hstep = (size_t)HALF * K * 2, tstep = 2 * hstep;
    const unsigned ldsw = (unsigned)wid * 1024u;
    const int aoff = lds_byte(wr * 64 + fr, fq * 8), boff = lds_byte(wc * 32 + fr, fq * 8);
#define G_SA(b, h) (((b) * 2 + (h)) * HTB)
#define G_SB(b, h) ((4 + (b) * 2 + (h)) * HTB)
#define G_STAGE(bufoff, gbase, voff) do { _Pragma("unroll") for (int _i = 0; _i < 2; ++_i) \
        __builtin_amdgcn_global_load_lds((const unsigned*)((const char*)(gbase) + (voff)[_i]), (LAS unsigned*)(lds + (bufoff) + ldsw + _i * 8192), 16, 0, 0); } while (0)
#define G_STAGE_A(bufoff, ubase, gv, h, koff) do { if constexpr (Sched::GATHER) { G_STAGE(bufoff, (const char*)A + (koff), gv[h]); } else { G_STAGE(bufoff, (ubase) + (h) * hstep + (koff), voffA); } } while (0)
#define G_LD16(off_) (*(const LAS i32x4*)(lds + (off_)))
#define G_LD16B(off_) (*(const LAS bf16x8*)(lds + (off_)))
#define G_LDA(dst, b, h) do { _Pragma("unroll") for (int m = 0; m < 4; ++m) { if constexpr (FP8) dst##8[m] = __builtin_shufflevector(G_LD16(G_SA(b, h) + aoff + m * 2048), G_LD16(G_SA(b, h) + aoff + m * 2048 + 1024), 0, 1, 2, 3, 4, 5, 6, 7); \
        else { dst[m][0] = G_LD16B(G_SA(b, h) + aoff + m * 2048); dst[m][1] = G_LD16B(G_SA(b, h) + aoff + m * 2048 + 1024); } } } while (0)
#define G_LDB(dst, b, h) do { _Pragma("unroll") for (int n = 0; n < 2; ++n) { if constexpr (FP8) dst##8[n] = __builtin_shufflevector(G_LD16(G_SB(b, h) + boff + n * 2048), G_LD16(G_SB(b, h) + boff + n * 2048 + 1024), 0, 1, 2, 3, 4, 5, 6, 7); \
        else { dst[n][0] = G_LD16B(G_SB(b, h) + boff + n * 2048); dst[n][1] = G_LD16B(G_SB(b, h) + boff + n * 2048 + 1024); } } } while (0)
#define G_MMA(ai, bj, At, Bt_) do { __builtin_amdgcn_s_setprio(1); _Pragma("unroll") for (int m = 0; m < 4; ++m) _Pragma("unroll") for (int n = 0; n < 2; ++n) { \
        if constexpr (FP8) mfma8(acc[ai][bj][m][n], Bt_##8[n], At##8[m], wscale, ascale); \
        else { _Pragma("unroll") for (int k = 0; k < 2; ++k) acc[ai][bj][m][n] = __builtin_amdgcn_mfma_f32_16x16x32_bf16(Bt_[n][k], At[m][k], acc[ai][bj][m][n], 0, 0, 0); } } \
        __builtin_amdgcn_s_setprio(0); } while (0)
#define G_WAIT_V(n) asm volatile("s_waitcnt vmcnt(" #n ")" ::: "memory")
#define G_WAIT_L(n) asm volatile("s_waitcnt lgkmcnt(" #n ")" ::: "memory")
#define G_BAR __builtin_amdgcn_s_barrier()
#define G_SCHED __builtin_amdgcn_sched_barrier(0)
    Unit cur, nxt; int ui = 0;
    if (!S.next(0, cur)) return;
    f32x4 acc[2][2][4][2];
#pragma unroll
    for (int a = 0; a < 2; ++a)
#pragma unroll
        for (int b = 0; b < 2; ++b)
#pragma unroll
            for (int m = 0; m < 4; ++m)
#pragma unroll
                for (int n = 0; n < 2; ++n) acc[a][b][m][n] = (f32x4){0.f, 0.f, 0.f, 0.f};
    bf16x8 At[4][2], B0[2][2], B1[2][2]; i32x8 At8[4], B08[2], B18[2];
    unsigned gcur[2][2] = {{0u, 0u}, {0u, 0u}}, gnxt[2][2] = {{0u, 0u}, {0u, 0u}};
    auto gather_offs = [&](const Unit& u, unsigned (&g)[2][2]) {
        if constexpr (Sched::GATHER) {
#pragma unroll
            for (int h = 0; h < 2; ++h)
#pragma unroll
                for (int i = 0; i < 2; ++i) { int tz = tid; asm volatile("" : "+v"(tz)); int R, C; stage_rc(tz * 16 + i * 8192, R, C); const int r = h * HALF + R; const int tk = p.tokl[u.goff + (r < u.nvalid ? r : 0)]; const int tok = r < u.nvalid ? tk : 0; g[h][i] = (unsigned)(tok * K + C) * 2u; }
        }
    };
    const char* cA = (const char*)A + (size_t)(cur.arow / BM) * tstep; const char* cB = (const char*)Bt + ((size_t)cur.e * bt_estride) * 2 + (size_t)cur.pn * tstep;
    gather_offs(cur, gcur);
    G_STAGE(G_SB(0, 0), cB, voffB); G_STAGE_A(G_SA(0, 0), cA, gcur, 0, 0); G_STAGE(G_SB(0, 1), cB + hstep, voffB); G_STAGE_A(G_SA(0, 1), cA, gcur, 1, 0);
    if (wr == 1) G_BAR;
    G_WAIT_V(4); G_BAR;
    G_STAGE(G_SB(1, 0), cB + kstep, voffB); G_STAGE_A(G_SA(1, 0), cA, gcur, 0, kstep); G_STAGE(G_SB(1, 1), cB + hstep + kstep, voffB);
    G_WAIT_V(6); G_BAR;
    for (;;) {
        const bool has_next = S.next(ui + 1, nxt);
        const char* nA = has_next ? (const char*)A + (size_t)(nxt.arow / BM) * tstep : cA;
        const char* nB = has_next ? (const char*)Bt + ((size_t)nxt.e * bt_estride) * 2 + (size_t)nxt.pn * tstep : cB;
        if constexpr (Sched::GATHER) { if (has_next) gather_offs(nxt, gnxt); else {
#pragma unroll
            for (int h = 0; h < 2; ++h) { gnxt[h][0] = gcur[h][0]; gnxt[h][1] = gcur[h][1]; } } }
        for (int t = 0; t < nt; t += 2) {
            const bool last = (t == nt - 2);
            const size_t k1 = (size_t)(t + 1) * kstep;
            const char* a2 = last ? nA : cA; const char* b2 = last ? nB : cB + (size_t)(t + 2) * kstep;
            const size_t k2 = last ? 0 : (size_t)(t + 2) * kstep; const size_t k3 = k2 + kstep;
            const char* b3 = b2 + kstep;
            unsigned g2[2][2];
#pragma unroll
            for (int h = 0; h < 2; ++h) { g2[h][0] = last ? gnxt[h][0] : gcur[h][0]; g2[h][1] = last ? gnxt[h][1] : gcur[h][1]; }
            G_LDB(B0, 0, 0); G_SCHED; G_LDA(At, 0, 0); G_STAGE_A(G_SA(1, 1), cA, gcur, 1, k1);
            G_WAIT_L(8); G_BAR; G_WAIT_L(0); G_MMA(0, 0, At, B0); G_BAR; G_SCHED;
            G_LDB(B1, 0, 1); G_STAGE(G_SB(0, 0), b2, voffB);
            G_BAR; G_WAIT_L(0); G_MMA(0, 1, At, B1); G_BAR;
            G_LDA(At, 0, 1); G_STAGE_A(G_SA(0, 0), a2, g2, 0, k2);
            G_BAR; G_WAIT_L(0); if (!Sched::HALF_SKIP || cur.nvalid > HALF) G_MMA(1, 0, At, B0); G_BAR; G_SCHED;
            G_STAGE(G_SB(0, 1), b2 + hstep, voffB);
            G_WAIT_V(6); G_BAR; if (!Sched::HALF_SKIP || cur.nvalid > HALF) G_MMA(1, 1, At, B1); G_BAR;
            G_LDB(B0, 1, 0); G_SCHED; G_LDA(At, 1, 0); G_STAGE_A(G_SA(0, 1), a2, g2, 1, k2);
            G_WAIT_L(8); G_BAR; G_WAIT_L(0); G_MMA(0, 0, At, B0); G_BAR; G_SCHED;
            G_LDB(B1, 1, 1); G_STAGE(G_SB(1, 0), b3, voffB);
            G_BAR; G_WAIT_L(0); G_MMA(0, 1, At, B1); G_BAR;
            G_LDA(At, 1, 1); G_STAGE_A(G_SA(1, 0), a2, g2, 0, k3);
            G_BAR; G_WAIT_L(0); if (!Sched::HALF_SKIP || cur.nvalid > HALF) G_MMA(1, 0, At, B0); G_BAR; G_SCHED;
            G_STAGE(G_SB(1, 1), b3 + hstep, voffB);
            G_WAIT_V(6); G_BAR; if (!Sched::HALF_SKIP || cur.nvalid > HALF) G_MMA(1, 1, At, B1); G_BAR;
        }
        if constexpr (FP8) asm volatile("s_nop 15\n\ts_nop 15" ::: "memory");
        { GUnit gu; gu.rowbase = cur.orow; gu.nvalid = cur.nvalid; gu.e = cur.e; gu.gather = p.tokl + cur.goff;
          if constexpr (Epi::PRE) {
            const int col0 = cur.pn * BM + wc * 32 + fq * 8; const auto up = E.unit_pre(p, gu, col0);
#pragma unroll
            for (int ai = 0; ai < 2; ++ai) { typename Epi::Pre pr[4];
#pragma unroll
              for (int m = 0; m < 4; ++m) pr[m] = E.pre(p, gu, ai * HALF + wr * 64 + m * 16 + fr, col0);
              asm volatile("" ::: "memory");
#pragma unroll
              for (int m = 0; m < 4; ++m) { const int r = ai * HALF + wr * 64 + m * 16 + fr;
                if (!Sched::HALF_SKIP || r < cur.nvalid) E.fin(p, gu, r, col0, up, pr[m], acc[ai][0][m][0], acc[ai][0][m][1], acc[ai][1][m][0], acc[ai][1][m][1]); } }
          } else {
#pragma unroll
          for (int ai = 0; ai < 2; ++ai)
#pragma unroll
            for (int m = 0; m < 4; ++m) { const int r = ai * HALF + wr * 64 + m * 16 + fr;
              if (!Sched::HALF_SKIP || r < cur.nvalid) E(p, gu, r, cur.pn * BM + wc * 32 + fq * 8, acc[ai][0][m][0], acc[ai][0][m][1], acc[ai][1][m][0], acc[ai][1][m][1]); } } }
        if (!has_next) break;
#pragma unroll
        for (int a = 0; a < 2; ++a)
#pragma unroll
            for (int b = 0; b < 2; ++b)
#pragma unroll
                for (int m = 0; m < 4; ++m)
#pragma unroll
                    for (int n = 0; n < 2; ++n) acc[a][b][m][n] = (f32x4){0.f, 0.f, 0.f, 0.f};
        cur = nxt; cA = nA; cB = nB; ++ui;
#pragma unroll
        for (int h = 0; h < 2; ++h) { gcur[h][0] = gnxt[h][0]; gcur[h][1] = gnxt[h][1]; }
    }
    G_WAIT_V(0);
    if (wr == 0) G_BAR;
    G_BAR;
}
}

extern __shared__ __attribute__((aligned(16))) unsigned char dyn_smem[];
constexpr int LDS_BYTES = gm::STAGE_BYTES + 1024;

typedef __bf16 bf2v __attribute__((ext_vector_type(2)));
typedef float f32x2 __attribute__((ext_vector_type(2)));
typedef float f32x16 __attribute__((ext_vector_type(16)));
typedef short s16x4 __attribute__((ext_vector_type(4)));
typedef unsigned u32x4 __attribute__((ext_vector_type(4)));
DI unsigned pk2(float a, float b) { f32x2 v = {a, b}; bf2v r = __builtin_convertvector(v, bf2v); return __builtin_bit_cast(unsigned, r); }
DI float bflo(unsigned u) { return __uint_as_float(u << 16); }
DI float bfhi(unsigned u) { return __uint_as_float(u & 0xffff0000u); }

DI unsigned pk4_fp8(float a, float b, float c, float d, float sc) {
    a = __builtin_amdgcn_fmed3f(a * sc, -448.f, 448.f); b = __builtin_amdgcn_fmed3f(b * sc, -448.f, 448.f); c = __builtin_amdgcn_fmed3f(c * sc, -448.f, 448.f); d = __builtin_amdgcn_fmed3f(d * sc, -448.f, 448.f);
    unsigned w = 0u; w = __builtin_amdgcn_cvt_pk_fp8_f32(a, b, w, false); w = __builtin_amdgcn_cvt_pk_fp8_f32(c, d, w, true); return w; }
constexpr bool D8_IN0 = true, D8_OUT0 = false, D8_IN1 = false;
constexpr bool YB8 = true;
constexpr float Y8_SCALE = 64.f;
constexpr float W8_SCALE = 256.f, A8_SCALE = 8.f;
constexpr int W8_E8M0 = 0x77777777, A8_E8M0 = 0x7c7c7c7c;
namespace ph {
DI void mods(const Params& p, LAS unsigned char* lds) {
    const int tid = opaque_tid(), wave = tid >> 6, lane = tid & 63, l8 = tid & 7, rg = tid >> 3;
    LAS float* fl = (LAS float*)lds; LAS float* red = fl + 4 * DM;
    for (int i = tid; i < 4 * DM; i += 512) fl[i] = siluf_(p.c[i]);
    __syncthreads();
    for (int u = blockIdx.x; u < 768; u += gridDim.x) {
        const int l = u / 192, c32 = u % 192;
        const float* w = l == 0 ? p.ada0_mix_w : l == 1 ? p.ada0_ffn_w : l == 2 ? p.ada1_mix_w : p.ada1_ffn_w;
        const float* bs = l == 0 ? p.ada0_mix_b : l == 1 ? p.ada0_ffn_b : l == 2 ? p.ada1_mix_b : p.ada1_ffn_b;
        f32x4 acc[4] = {{0.f, 0.f, 0.f, 0.f}, {0.f, 0.f, 0.f, 0.f}, {0.f, 0.f, 0.f, 0.f}, {0.f, 0.f, 0.f, 0.f}};
        const float* wp = w + (size_t)rg * 6144 + c32 * 32 + l8 * 4;
#pragma unroll 8
        for (int i = 0; i < 32; ++i) { const f32x4 wv = *(const f32x4*)(wp + (size_t)(64 * i) * 6144); const int k = rg + 64 * i;
#pragma unroll
            for (int b = 0; b < 4; ++b) acc[b] += fl[b * DM + k] * wv; }
#pragma unroll
        for (int b = 0; b < 4; ++b)
#pragma unroll
            for (int j = 0; j < 4; ++j) { float v = acc[b][j]; v += __shfl_xor(v, 8); v += __shfl_xor(v, 16); v += __shfl_xor(v, 32); acc[b][j] = v; }
        if (lane < 8) {
#pragma unroll
            for (int b = 0; b < 4; ++b) *(LAS f32x4*)(red + (wave * 4 + b) * 32 + lane * 4) = acc[b]; }
        __syncthreads();
        if (tid < 128) { const int b = tid >> 5, col = tid & 31; float sum = 0.f;
#pragma unroll
            for (int w8 = 0; w8 < 8; ++w8) sum += red[(w8 * 4 + b) * 32 + col];
            p.mod[(l * 4 + b) * 6144 + c32 * 32 + col] = sum + bs[c32 * 32 + col]; }
        __syncthreads();
    }
}
constexpr int NT_UNITS = (640 + 256 + 672 + 336 + 2 * (8192 + 4096)) / 2;
struct UD { const float* sp; bf16_t* dst; int K, N, mode, e, kt, ntile; };
DI UD tdecode(const Params& p, int u, int lane) {
    const float* srcs[8] = {p.w_in0, p.w_out0, p.w_in1, p.w_out1, p.moe0_w_gate_up, p.moe0_w_down, p.moe1_w_gate_up, p.moe1_w_down};
    bf16_t* dsts[8] = {p.w_in0t, p.w_out0t, p.w_in1t, p.w_out1t, p.w_gut0, p.w_dt0, p.w_gut1, p.w_dt1};
    constexpr int Ks[8] = {DM, DM, DM, LRU_W, DM, EFF, DM, EFF}, Ns[8] = {N_IN0, DM, N_IN1, DM, 2048, DM, 2048, DM}, nus[8] = {320, 128, 336, 168, 4096, 2048, 4096, 2048};
    constexpr int modes[8] = {D8_IN0 ? 2 : 0, D8_OUT0 ? 2 : 0, D8_IN1 ? 2 : 0, 0, 3, 2, 3, 2};
    int v = u, mi = 0;
#pragma unroll
    for (int m = 0; m < 8; ++m) { if (mi == m && v >= nus[m]) { v -= nus[m]; mi = m + 1; } }
    UD d; const float* src = srcs[0]; d.dst = dsts[0]; d.K = Ks[0]; d.N = Ns[0]; d.mode = modes[0];
#pragma unroll
    for (int m = 1; m < 8; ++m) if (mi == m) { src = srcs[m]; d.dst = dsts[m]; d.K = Ks[m]; d.N = Ns[m]; d.mode = modes[m]; }
    const int ntl = d.N / 256, ktl = d.K / 128; d.e = v / (ktl * ntl); const int rem = v % (ktl * ntl); d.kt = rem / ntl; d.ntile = rem % ntl;
    d.sp = src + (size_t)d.e * d.K * d.N + (size_t)(d.kt * 128) * d.N + d.ntile * 256 + lane * 4;
    return d;
}
DI void transposer(const Params& p, LAS unsigned char* lds, int first, int count, int stride) {
    const int tid = opaque_tid(), wave = tid >> 6, lane = tid & 63;
    LAS float* fl = (LAS float*)lds;
    if (count <= 0) return;
    if (tdecode(p, first, lane).mode & 2) {
        LAS unsigned* td = (LAS unsigned*)lds;
        const int nl = lane & 15, ks = lane >> 4;
        auto src_of = [&](const UD& d, int g, int j) -> const float* { const int kq = 4 * (g >> 2) + ks, nq = 16 * (g & 3) + nl; return d.sp - lane * 4 + (size_t)(4 * kq + j) * d.N + 4 * nq; };
        f32x4 va[4][4], vb[4][4];
        auto load_unit = [&](int u, f32x4 (&v)[4][4]) { const UD dd = tdecode(p, u, lane);
#pragma unroll
            for (int i = 0; i < 4; ++i)
#pragma unroll
                for (int j = 0; j < 4; ++j) v[i][j] = *(const f32x4*)src_of(dd, wave * 4 + i, j); };
        auto process = [&](int jn, f32x4 (&v)[4][4]) { const int u = first + jn * stride;
            const UD d = tdecode(p, u, lane); const int K = d.K, N = d.N, mode = d.mode, e = d.e, kt = d.kt, ntile = d.ntile;
            LAS unsigned* tile = td + (jn & 1) * (256 * 33);
#pragma unroll
            for (int i = 0; i < 4; ++i) { const int g = wave * 4 + i, kq = 4 * (g >> 2) + ks, nq = 16 * (g & 3) + nl;
#pragma unroll
                for (int en = 0; en < 4; ++en) tile[(4 * nq + en) * 33 + kq] = pk4_fp8(v[i][0][en], v[i][1][en], v[i][2][en], v[i][3][en], W8_SCALE); }
            __syncthreads();
            if (jn + 2 < count) load_unit(u + 2 * stride, v);
            { const int n = tid >> 1, kh = tid & 1; const int ng = ntile * 256 + n; const int jg = ng & 1023; const int np = (mode & 1) ? (256 * (jg >> 7) + (ng < 1024 ? 0 : 128) + (jg & 127)) : ng;
              unsigned char* dp = (unsigned char*)d.dst + (size_t)e * N * K + (size_t)np * K + kt * 128 + kh * 64;
#pragma unroll
              for (int jj = 0; jj < 4; ++jj) { const LAS unsigned* tp = tile + n * 33 + kh * 16 + jj * 4; *(uint4*)(dp + jj * 16) = make_uint4(tp[0], tp[1], tp[2], tp[3]); } } };
        load_unit(first, va); if (count > 1) load_unit(first + stride, vb);
        for (int jn = 0; jn < count; jn += 2) { process(jn, va); if (jn + 1 < count) process(jn + 1, vb); }
        __syncthreads();
        return;
    }
    f32x4 vv[16];
    { const UD d0 = tdecode(p, first, lane);
#pragma unroll
        for (int i = 0; i < 16; ++i) vv[i] = *(const f32x4*)(d0.sp + (size_t)(i * 8 + wave) * d0.N); }
    for (int j = 0; j < count; ++j) { const int u = first + j * stride;
        const UD d = tdecode(p, u, lane); const int K = d.K, N = d.N, mode = d.mode, e = d.e, kt = d.kt, ntile = d.ntile; bf16_t* dst = d.dst;
#pragma unroll
        for (int i = 0; i < 16; ++i) { LAS float* tp = fl + (i * 8 + wave) * 257 + lane * 4; tp[0] = vv[i][0]; tp[1] = vv[i][1]; tp[2] = vv[i][2]; tp[3] = vv[i][3]; }
        __syncthreads();
        if (j + 1 < count) { const UD dn = tdecode(p, u + stride, lane);
#pragma unroll
            for (int i = 0; i < 16; ++i) vv[i] = *(const f32x4*)(dn.sp + (size_t)(i * 8 + wave) * dn.N); }
        { const int n = tid >> 1, kh = tid & 1; const int ng = ntile * 256 + n; const int jg = ng & 1023; const int np = (mode & 1) ? (256 * (jg >> 7) + (ng < 1024 ? 0 : 128) + (jg & 127)) : ng;
          bf16_t* dp = dst + (size_t)e * N * K + (size_t)np * K + kt * 128 + kh * 64;
#pragma unroll
          for (int jj = 0; jj < 8; ++jj) { unsigned w4[4];
#pragma unroll
              for (int q = 0; q < 4; ++q) { const int k = kh * 64 + jj * 8 + q * 2; w4[q] = pk2(fl[k * 257 + n], fl[(k + 1) * 257 + n]); }
              *(uint4*)(dp + jj * 8) = make_uint4(w4[0], w4[1], w4[2], w4[3]); } }
        __syncthreads();
    }
}
DI void lru_weights(const Params& p) {
    const int tid = opaque_tid();
    for (size_t i = (size_t)blockIdx.x * 512 + tid; i < (size_t)2 * 2 * 16 * 4 * 48 * 192; i += (size_t)gridDim.x * 512) {
        const int k = i % 192, j = (i / 192) % 48, qt = (i / (192 * 48)) % 4, n = (i / (192 * 48 * 4)) % 16, which = (i / (192 * 48 * 4 * 16)) % 2, dir = i / (192 * 48 * 4 * 16 * 2);
        const float* w = which == 0 ? p.lru_w_a : p.lru_w_x; float v = 0.f;
        if (j < 42 && k < 168) v = w[(((size_t)dir * 16 + n) * 168 + k) * 168 + qt * 42 + j];
        p.w_lru[i] = f2bf(v);
    }
}
DI void fold_router(const Params& p) {
    const int tid = opaque_tid(), wave = tid >> 6, lane = tid & 63;
    for (size_t i = (size_t)blockIdx.x * 512 + tid; i < (size_t)2 * 4 * 48 * DM; i += (size_t)gridDim.x * 512) {
        const int k = i % DM, n = (i / DM) % 48, b = (i / (DM * 48)) % 4, l = i / (DM * 48 * 4);
        const float* g = l == 0 ? p.norm0_ffn : p.norm1_ffn; const float* md = p.mod + ((l == 0 ? 1 : 3) * 4 + b) * 6144;
        const float* we = l == 0 ? p.moe0_w_expert : p.moe1_w_expert; const float* wg = l == 0 ? p.moe0_w_group : p.moe1_w_group;
        const float w = n < 32 ? we[k * 32 + n] : n < 36 ? wg[k * 4 + (n - 32)] : 0.f;
        const float wf = g[k] * (1.f + md[2048 + k]) * w;
        const bf16_t hi = f2bf(wf); const float r1 = wf - bf2f(hi); const bf16_t mid = f2bf(r1); const bf16_t lo = f2bf(r1 - bf2f(mid));
        bf16_t* dst = p.wrt + ((size_t)((l * 4 + b) * 3) * 48 + n) * DM + k;
        dst[0] = hi; dst[(size_t)48 * DM] = mid; dst[(size_t)96 * DM] = lo;
    }
    for (int task = blockIdx.x * 8 + wave; task < 2 * 4 * 48; task += gridDim.x * 8) {
        const int n = task % 48, b = (task / 48) % 4, l = task / (48 * 4);
        const float* md = p.mod + ((l == 0 ? 1 : 3) * 4 + b) * 6144;
        const float* we = l == 0 ? p.moe0_w_expert : p.moe1_w_expert; const float* wg = l == 0 ? p.moe0_w_group : p.moe1_w_group;
        float part = 0.f;
        for (int k = lane; k < DM; k += 64) { const float w = n < 32 ? we[k * 32 + n] : n < 36 ? wg[k * 4 + (n - 32)] : 0.f; part += md[k] * w; }
        part = wave_sum(part); if (lane == 0) p.rbias[task] = part;
    }
}
template <int MODE, bool OUT8 = false> DI void norm_rows(const Params& p, const float* xin  , const float* gain, int lmod, int lgate, const LAS int* tab) {
    const int tid = opaque_tid(), wave = tid >> 6, lane = tid & 63;
    f32x4 gn[8];
#pragma unroll
    for (int i = 0; i < 8; ++i) gn[i] = *(const f32x4*)(gain + i * 256 + lane * 4);
    for (int row = blockIdx.x * 8 + wave; row < T_TOK; row += gridDim.x * 8) {
        const int b = row / SEQ;
        int a0 = 0, a1 = 0;
        if constexpr (MODE >= 1) { a0 = p.asg[row * 2]; a1 = p.asg[row * 2 + 1]; }
        f32x4 v[8]; uint2 vr[8];
        if (xin) {
#pragma unroll
            for (int i = 0; i < 8; ++i) v[i] = *(const f32x4*)(xin + (size_t)row * DM + i * 256 + lane * 4);
        } else {
#pragma unroll
            for (int i = 0; i < 8; ++i) vr[i] = *(const uint2*)(p.XA + (size_t)row * DM + i * 256 + lane * 4);
        }
        f32x4 gq[8], sc[8], sh[8];
        if constexpr (MODE >= 1) { const float* gt = p.mod + (lgate * 4 + b) * 6144 + 4096;
#pragma unroll
            for (int i = 0; i < 8; ++i) gq[i] = *(const f32x4*)(gt + i * 256 + lane * 4); }
        if constexpr (MODE != 2) { const float* md = p.mod + (lmod * 4 + b) * 6144;
#pragma unroll
            for (int i = 0; i < 8; ++i) { sc[i] = *(const f32x4*)(md + 2048 + i * 256 + lane * 4); sh[i] = *(const f32x4*)(md + i * 256 + lane * 4); } }
        if (!xin) {
#pragma unroll
            for (int i = 0; i < 8; ++i) v[i] = (f32x4){bflo(vr[i].x), bfhi(vr[i].x), bflo(vr[i].y), bfhi(vr[i].y)};
        }
        if constexpr (MODE >= 1) {
            const size_t r0 = (size_t)tab[a0 >> 14] * 256 + (a0 & 16383), r1 = (size_t)tab[a1 >> 14] * 256 + (a1 & 16383);
            if constexpr (YB8) { unsigned y0[8], y1[8];
#pragma unroll
                for (int i = 0; i < 8; ++i) { const int col = i * 256 + lane * 4; y0[i] = *(const unsigned*)((const unsigned char*)p.YB + r0 * DM + col); y1[i] = *(const unsigned*)((const unsigned char*)p.YB + r1 * DM + col); }
#pragma unroll
                for (int i = 0; i < 8; ++i) {
                    const f32x2 c0 = __builtin_amdgcn_cvt_pk_f32_fp8(y0[i], false), c1 = __builtin_amdgcn_cvt_pk_f32_fp8(y0[i], true), d0 = __builtin_amdgcn_cvt_pk_f32_fp8(y1[i], false), d1 = __builtin_amdgcn_cvt_pk_f32_fp8(y1[i], true);
                    const f32x4 g4 = gq[i] * (1.f / Y8_SCALE);
                    v[i][0] += g4[0] * (c0[0] + d0[0]); v[i][1] += g4[1] * (c0[1] + d0[1]); v[i][2] += g4[2] * (c1[0] + d1[0]); v[i][3] += g4[3] * (c1[1] + d1[1]); } }
            else {
#pragma unroll
                for (int i = 0; i < 8; ++i) { const int col = i * 256 + lane * 4; const f32x4 g4 = gq[i]; const uint2 y0 = *(const uint2*)(p.YB + r0 * DM + col), y1 = *(const uint2*)(p.YB + r1 * DM + col);
                v[i][0] += g4[0] * (bflo(y0.x) + bflo(y1.x)); v[i][1] += g4[1] * (bfhi(y0.x) + bfhi(y1.x));
                v[i][2] += g4[2] * (bflo(y0.y) + bflo(y1.y)); v[i][3] += g4[3] * (bfhi(y0.y) + bfhi(y1.y)); } }
            if constexpr (MODE == 1) {
#pragma unroll
                for (int i = 0; i < 8; ++i) { const uint2 w = make_uint2(pk2(v[i][0], v[i][1]), pk2(v[i][2], v[i][3])); *(uint2*)(p.XA + (size_t)row * DM + i * 256 + lane * 4) = w;
                    v[i] = (f32x4){bflo(w.x), bfhi(w.x), bflo(w.y), bfhi(w.y)}; }
            }
        }
        float ss = 0.f;
#pragma unroll
        for (int i = 0; i < 8; ++i) ss += v[i][0] * v[i][0] + v[i][1] * v[i][1] + v[i][2] * v[i][2] + v[i][3] * v[i][3];
        ss = wave_sum(ss); const float rstd = rsqrtf(ss * (1.0f / DM) + 1e-6f);
        if constexpr (MODE == 2) {
#pragma unroll
            for (int i = 0; i < 8; ++i) { const int col = i * 256 + lane * 4; *(f32x4*)(p.out + (size_t)row * DM + col) = v[i] * rstd * gn[i]; }
        } else {
#pragma unroll
            for (int i = 0; i < 8; ++i) { const int col = i * 256 + lane * 4;
                const f32x4 h = v[i] * rstd * gn[i] * (1.f + sc[i]) + sh[i];
                if constexpr (OUT8) *(unsigned*)((unsigned char*)p.H + (size_t)row * DM + col) = pk4_fp8(h[0], h[1], h[2], h[3], A8_SCALE);
                else *(uint2*)(p.H + (size_t)row * DM + col) = make_uint2(pk2(h[0], h[1]), pk2(h[2], h[3])); } }
    }
}
template <bool DRY = false, bool NORM = false> DI void router(const Params& p, int l, LAS unsigned char* lds, const float* gain = nullptr, int lmod = 0) {
    const int tid = opaque_tid(), wave = __builtin_amdgcn_readfirstlane(tid >> 6), lane = tid & 63;
    LAS float* lg = (LAS float*)lds + (wave & 3) * (16 * 48);
    LAS float* rsl = (LAS float*)lds + 4 * 16 * 48 + (wave & 3) * 16;
    LAS f32x4* part = (LAS f32x4*)(lds + 16384);
    LAS float* ssp = (LAS float*)(lds + 16384 + 98304);
    for (int tg = blockIdx.x; tg < T_TOK / 64; tg += gridDim.x) {
        const int b = (tg * 64) / SEQ, r = lane & 15, q = lane >> 4;
        const bf16_t* xa = p.XA + (size_t)(tg * 64 + r) * DM + wave * 256 + 8 * q;
        const bf16_t* wt = p.wrt + ((size_t)((l * 4 + b) * 3) * 48 + r) * DM + wave * 256 + 8 * q;
        f32x4 acc[4][3]; float ss[4] = {0.f, 0.f, 0.f, 0.f};
#pragma unroll
        for (int t = 0; t < 4; ++t)
#pragma unroll
            for (int n = 0; n < 3; ++n) acc[t][n] = (f32x4){0.f, 0.f, 0.f, 0.f};
        u32x4 aA[4], aB[4], bA[9], bB[9];
        auto ld = [&](int st, u32x4 (&aa)[4], u32x4 (&bb)[9]) {
#pragma unroll
            for (int t = 0; t < 4; ++t) aa[t] = *(const u32x4*)(xa + (size_t)t * 16 * DM + st * 32);
#pragma unroll
            for (int i = 0; i < 9; ++i) bb[i] = *(const u32x4*)(wt + (size_t)i * 16 * DM + st * 32); };
        auto mm = [&](const u32x4 (&aa)[4], const u32x4 (&bb)[9]) {
#pragma unroll
            for (int t = 0; t < 4; ++t) {
#pragma unroll
                for (int e = 0; e < 4; ++e) { const float x0 = bflo(aa[t][e]), x1 = bfhi(aa[t][e]); ss[t] += x0 * x0 + x1 * x1; }
#pragma unroll
                for (int i = 0; i < 9; ++i) acc[t][i % 3] = __builtin_amdgcn_mfma_f32_16x16x32_bf16(__builtin_bit_cast(bf16x8, aa[t]), __builtin_bit_cast(bf16x8, bb[i]), acc[t][i % 3], 0, 0, 0); } };
        ld(0, aA, bA);
        for (int st = 0; st < 8; st += 2) {
            ld(st + 1, aB, bB);
            mm(aA, bA);
            if (st + 2 < 8) ld(st + 2, aA, bA);
            mm(aB, bB);
        }
#pragma unroll
        for (int t = 0; t < 4; ++t) {
#pragma unroll
            for (int n = 0; n < 3; ++n) part[((wave * 4 + t) * 3 + n) * 64 + lane] = acc[t][n];
            float sq = ss[t]; sq += __shfl_xor(sq, 16); sq += __shfl_xor(sq, 32);
            if (q == 0) ssp[(wave * 4 + t) * 16 + r] = sq; }
        __syncthreads();
        if (wave < 4) {
        const int tile = tg * 4 + wave, row0 = tile * 16;
        f32x4 a3[3] = {{0.f, 0.f, 0.f, 0.f}, {0.f, 0.f, 0.f, 0.f}, {0.f, 0.f, 0.f, 0.f}}; float ssr = 0.f;
#pragma unroll
        for (int w2 = 0; w2 < 8; ++w2) {
#pragma unroll
            for (int n = 0; n < 3; ++n) a3[n] += part[((w2 * 4 + wave) * 3 + n) * 64 + lane];
            ssr += ssp[(w2 * 4 + wave) * 16 + r]; }
        const float rstd = rsqrtf(ssr * (1.0f / DM) + 1e-6f);
        if (NORM && q == 0) rsl[r] = rstd;
#pragma unroll
        for (int j = 0; j < 4; ++j) { const float rs = __shfl(rstd, 4 * q + j);
#pragma unroll
            for (int n = 0; n < 3; ++n) lg[(4 * q + j) * 48 + n * 16 + r] = a3[n][j] * rs + p.rbias[(l * 4 + b) * 48 + n * 16 + r]; }
        __builtin_amdgcn_wave_barrier();
        if (!DRY && lane < 16) {
            const LAS float* L = lg + lane * 48; const int tok = row0 + lane;
            int gs = 0; float gm = L[32];
#pragma unroll
            for (int g = 1; g < 4; ++g) if (L[32 + g] > gm) { gm = L[32 + g]; gs = g; }
            float gden = 0.f;
#pragma unroll
            for (int g = 0; g < 4; ++g) gden += __expf(L[32 + g] - gm);
            const float gprob = 1.0f / gden;
            int i0 = 0; float v0 = L[gs * 8];
            for (int j = 1; j < 8; ++j) { const float x = L[gs * 8 + j]; if (x > v0) { v0 = x; i0 = j; } }
            int i1 = -1; float v1 = -3.4e38f;
            for (int j = 0; j < 8; ++j) { const float x = L[gs * 8 + j]; if (j != i0 && x > v1) { v1 = x; i1 = j; } }
            const float e1 = __expf(v1 - v0), g0 = gprob / (1.f + e1), g1 = gprob * e1 / (1.f + e1);
            const int ea = gs * 8 + i0, eb = gs * 8 + i1;
            const int sa = atomicAdd(&p.cnt[l * 32 + ea], 1), sb = atomicAdd(&p.cnt[l * 32 + eb], 1);
            p.tokl[ea * ECAP + sa] = tok; p.gatel[ea * ECAP + sa] = g0; p.tokl[eb * ECAP + sb] = tok; p.gatel[eb * ECAP + sb] = g1;
            p.asg[tok * 2] = (ea << 14) | sa; p.asg[tok * 2 + 1] = (eb << 14) | sb;
        }
        }
        __syncthreads();
        if constexpr (NORM) {
            const int kh = wave >> 2, row0 = (tg * 4 + (wave & 3)) * 16;
            const float* md = p.mod + (lmod * 4 + b) * 6144;
            f32x4 g4[8], sc[8], sh[8];
#pragma unroll
            for (int i = 0; i < 8; ++i) { const int col = i * 256 + lane * 4; g4[i] = *(const f32x4*)(gain + col); sc[i] = 1.f + *(const f32x4*)(md + 2048 + col); sh[i] = *(const f32x4*)(md + col); g4[i] *= sc[i]; }
            for (int j0 = 0; j0 < 8; j0 += 4) {
                uint2 ar[4][8];
#pragma unroll
                for (int jj = 0; jj < 4; ++jj)
#pragma unroll
                    for (int i = 0; i < 8; ++i) ar[jj][i] = *(const uint2*)(p.XA + (size_t)(row0 + kh * 8 + j0 + jj) * DM + i * 256 + lane * 4);
                asm volatile("" ::: "memory");
#pragma unroll
                for (int jj = 0; jj < 4; ++jj) { const int row = row0 + kh * 8 + j0 + jj; const float rs = rsl[kh * 8 + j0 + jj];
#pragma unroll
                    for (int i = 0; i < 8; ++i) { const int col = i * 256 + lane * 4; const f32x4 v = {bflo(ar[jj][i].x), bfhi(ar[jj][i].x), bflo(ar[jj][i].y), bfhi(ar[jj][i].y)};
                        const f32x4 h = v * rs * g4[i] + sh[i];
                        *(unsigned*)((unsigned char*)p.H + (size_t)row * DM + col) = pk4_fp8(h[0], h[1], h[2], h[3], A8_SCALE); } } }
            __syncthreads();
        }
    }
}
DI void conv_gln(const Params& p, LAS unsigned char* lds) {
    const int tid = opaque_tid(), wave = tid >> 6, lane = tid & 63;
    LAS float* at = (LAS float*)lds;
    u32x4 rv[3], rg[3];
    auto load_raw = [&](int u) { const int g = u & 7, t0 = ((u >> 3) & 63) * 64, b = u >> 9;
#pragma unroll
        for (int i = 0; i < 3; ++i) { const int idx = tid + 512 * i, rr = idx >> 4, c8 = idx & 15, t = t0 - 15 + rr; rv[i] = (u32x4){0u, 0u, 0u, 0u}; rg[i] = (u32x4){0u, 0u, 0u, 0u};
            if (idx < 94 * 16 && t >= 0 && t < SEQ) { const bf16_t* row = p.G + (size_t)(b * SEQ + t) * N_IN0 + g * 128 + c8 * 8; rv[i] = *(const u32x4*)row; rg[i] = *(const u32x4*)(row + 1024); } } };
    int gcur = -1; f32x2 wk[31], bias = {0.f, 0.f}, gam = {0.f, 0.f}, bet = {0.f, 0.f};
    if ((int)blockIdx.x < 2048) load_raw(blockIdx.x);
    for (int u = blockIdx.x; u < 2048; u += gridDim.x) {
        const int g = u & 7, t0 = ((u >> 3) & 63) * 64, b = u >> 9;
        const int ch = g * 128 + 2 * lane;
        if (g != gcur) { gcur = g;
#pragma unroll
            for (int k = 0; k < 31; ++k) wk[k] = *(const f32x2*)(p.conv_w + k * 1024 + ch);
            bias = *(const f32x2*)(p.conv_b + ch); gam = *(const f32x2*)(p.conv_norm_g + ch); bet = *(const f32x2*)(p.conv_norm_b + ch); }
#pragma unroll
        for (int i = 0; i < 3; ++i) { const int idx = tid + 512 * i, rr = idx >> 4, c8 = idx & 15;
            if (idx < 94 * 16) { const u32x4 v = rv[i], gg = rg[i];
                const f32x4 lo = {bflo(v[0]) * sigmoidf_(bflo(gg[0])), bfhi(v[0]) * sigmoidf_(bfhi(gg[0])), bflo(v[1]) * sigmoidf_(bflo(gg[1])), bfhi(v[1]) * sigmoidf_(bfhi(gg[1]))};
                const f32x4 hi = {bflo(v[2]) * sigmoidf_(bflo(gg[2])), bfhi(v[2]) * sigmoidf_(bfhi(gg[2])), bflo(v[3]) * sigmoidf_(bflo(gg[3])), bfhi(v[3]) * sigmoidf_(bfhi(gg[3]))};
                *(LAS f32x4*)(at + rr * 132 + c8 * 8) = lo; *(LAS f32x4*)(at + rr * 132 + c8 * 8 + 4) = hi; } }
        __syncthreads();
        if (u + (int)gridDim.x < 2048) load_raw(u + gridDim.x);
        f32x2 acc[8];
#pragma unroll
        for (int j = 0; j < 8; ++j) acc[j] = bias;
#pragma unroll
        for (int rr = 0; rr < 38; ++rr) { const f32x2 a2 = *(const LAS f32x2*)(at + (wave * 8 + rr) * 132 + 2 * lane);
#pragma unroll
            for (int j = 0; j < 8; ++j) { const int k = rr - j; if (k >= 0 && k < 31) acc[j] += wk[k] * a2; } }
#pragma unroll
        for (int j = 0; j < 8; ++j) { const float mu = wave_sum(acc[j][0] + acc[j][1]) * (1.f / 128.f); const float d0 = acc[j][0] - mu, d1 = acc[j][1] - mu;
            const float var = wave_sum(d0 * d0 + d1 * d1) * (1.f / 128.f); const float rs = rsqrtf(var + 1e-6f);
            const float y0 = d0 * rs * gam[0] + bet[0], y1 = d1 * rs * gam[1] + bet[1];
            if constexpr (D8_OUT0) *(unsigned short*)((unsigned char*)p.AO + (size_t)(b * SEQ + t0 + wave * 8 + j) * DM + ch) = (unsigned short)(pk4_fp8(siluf_(y0), siluf_(y1), 0.f, 0.f, A8_SCALE) & 0xffffu);
            else *(unsigned*)(p.AO + (size_t)(b * SEQ + t0 + wave * 8 + j) * DM + ch) = pk2(siluf_(y0), siluf_(y1)); }
        __syncthreads();
    }
}
DI unsigned off_b(unsigned row, unsigned ch) { return 256u * row + 16u * (ch ^ (((row & 3u) << 2) | ((row >> 2) & 3u))); }
DI void tr_read4(unsigned a0, unsigned a1, s16x4& r00, s16x4& r01, s16x4& r10, s16x4& r11) {
    asm volatile("ds_read_b64_tr_b16 %0, %4\n\tds_read_b64_tr_b16 %1, %5\n\tds_read_b64_tr_b16 %2, %4 offset:4096\n\tds_read_b64_tr_b16 %3, %5 offset:4096\n\ts_waitcnt lgkmcnt(0)"
                 : "=&v"(r00), "=&v"(r01), "=&v"(r10), "=&v"(r11) : "v"(a0), "v"(a1) : "memory");
}
template <int PASS> DI void attn_wave(const Params& p, LAS unsigned char* vimg, unsigned vb0, unsigned vb1, int lane_, int b, int h, int qbase  ) {
    int lane = lane_; asm volatile("" : "+v"(lane));
    const int c = lane & 31, hh = lane >> 5, srow = lane >> 4, sch = lane & 15;
    constexpr int QS = PASS == 0 ? 16 : 1, NT = PASS == 0 ? 13 : 5;
    const int tq = qbase + QS * c;
    const bf16_t* gb = p.G + (size_t)(b * SEQ) * N_IN0; const bf16_t* kb = p.KVH + (size_t)((b * 8 + h) * 2) * SEQ * 128;
    bf16_t* st_o = p.YB + ((size_t)(b * 8 + h) * SEQ + tq) * 128;
    float* st_ml = (float*)(p.YB + (size_t)NBATCH * 8 * SEQ * 128) + ((size_t)(b * 8 + h) * SEQ + tq) * 2;
    bf16x8 qf[8];
#pragma unroll
    for (int ks = 0; ks < 8; ++ks) qf[ks] = *(const bf16x8*)(gb + (size_t)tq * N_IN0 + 2048 + h * 128 + 16 * ks + 8 * hh);
    const float sc2 = 0.08838834764831845f * 1.4426950408889634f, sl2 = exp2f(-(float)(h + 1)) * 1.4426950408889634f;
    f32x16 o[4]; float m_run, l_run;
    if constexpr (PASS == 0) {
#pragma unroll
        for (int i = 0; i < 4; ++i)
#pragma unroll
            for (int j = 0; j < 16; ++j) o[i][j] = 0.f;
        m_run = -30000.f; l_run = 0.f;
    } else {
#pragma unroll
        for (int c4 = 0; c4 < 4; ++c4)
#pragma unroll
            for (int g4 = 0; g4 < 4; ++g4) { const uint2 v = *(const uint2*)(st_o + 32 * c4 + 8 * g4 + 4 * hh); o[c4][4 * g4] = bflo(v.x); o[c4][4 * g4 + 1] = bfhi(v.x); o[c4][4 * g4 + 2] = bflo(v.y); o[c4][4 * g4 + 3] = bfhi(v.y); }
        const f32x2 ml = *(const f32x2*)st_ml; m_run = ml[0]; l_run = hh == 0 ? ml[1] : 0.f;
    }
    auto tile_geom = [&](int tile, int& d, int& sb) { if constexpr (PASS == 0) { if (tile < 5) { d = 16; sb = qbase - 1024 + 512 * tile; } else { d = 4; sb = qbase - 256 + 128 * (tile - 5); } } else { d = 1; sb = qbase - 64 + 32 * tile; } };
    auto load_k = [&](int tile, bf16x8 (&kf)[8]) { int d, sb; tile_geom(tile, d, sb); int sp = sb + d * c; sp = sp < 0 ? 0 : (sp >= SEQ ? SEQ - 1 : sp);
        const bf16_t* src = kb + (unsigned)(sp * 128 + 8 * hh);
#pragma unroll
        for (int ks = 0; ks < 8; ++ks) kf[ks] = *(const bf16x8*)(src + 16 * ks); };
    auto load_v = [&](int tile, u32x4 (&vv)[8]) { int d, sb; tile_geom(tile, d, sb);
#pragma unroll
        for (int i = 0; i < 8; ++i) { int sp = sb + d * (srow + 4 * i); sp = sp < 0 ? 0 : (sp >= SEQ ? SEQ - 1 : sp); vv[i] = *(const u32x4*)(kb + (unsigned)(SEQ * 128 + sp * 128 + sch * 8)); } };
    bf16x8 kf[8]; u32x4 vv[8];
    load_k(0, kf); load_v(0, vv);
    for (int tile = 0; tile < NT; ++tile) {
        int d, sb; tile_geom(tile, d, sb);
        const int tn = tile < NT - 1 ? tile + 1 : NT - 1;
#pragma unroll
        for (int i = 0; i < 8; ++i) *(LAS u32x4*)(vimg + off_b(srow + 4 * i, sch)) = vv[i];
        load_v(tn, vv);
        f32x16 sacc;
#pragma unroll
        for (int j = 0; j < 16; ++j) sacc[j] = 0.f;
#pragma unroll
        for (int ks = 0; ks < 8; ++ks) sacc = __builtin_amdgcn_mfma_f32_32x32x16_bf16(kf[ks], qf[ks], sacc, 0, 0, 0);
        load_k(tn, kf);
        const float df = (float)d, basef = (float)(sb - tq) + df * (float)(4 * hh);
        const float lo = fmaxf(-64.f * df, -(float)tq), hi = fminf(64.f * df, (float)(SEQ - 1 - tq));
        const float mid = 0.5f * (lo + hi), half = 0.5f * (hi - lo);
        float tmax = -1e30f;
#pragma unroll
        for (int i = 0; i < 16; ++i) { const float deltaf = basef + df * (float)((i & 3) + 8 * (i >> 2));
            const bool valid = __builtin_fabsf(deltaf - mid) <= half;
            const float sv = valid ? sacc[i] * sc2 - sl2 * __builtin_fabsf(deltaf) : -1e30f; sacc[i] = sv; tmax = fmaxf(tmax, sv); }
        tmax = fmaxf(tmax, __shfl_xor(tmax, 32));
        const float m_new = tmax > m_run + 8.0f ? tmax : m_run;
        if (__any(m_new != m_run)) { const float alpha = __builtin_amdgcn_exp2f(m_run - m_new);
            l_run *= alpha;
#pragma unroll
            for (int i = 0; i < 4; ++i) o[i] *= alpha; }
        m_run = m_new;
        float psum = 0.f;
#pragma unroll
        for (int i = 0; i < 16; ++i) { const float pi = __builtin_amdgcn_exp2f(sacc[i] - m_new); psum += pi; sacc[i] = pi; }
        l_run += psum;
        bf16x8 pf[2];
#pragma unroll
        for (int s = 0; s < 2; ++s) { const unsigned w0 = pk2(sacc[8 * s], sacc[8 * s + 1]), w1 = pk2(sacc[8 * s + 2], sacc[8 * s + 3]), w2 = pk2(sacc[8 * s + 4], sacc[8 * s + 5]), w3 = pk2(sacc[8 * s + 6], sacc[8 * s + 7]);
            pf[s] = __builtin_bit_cast(bf16x8, (u32x4){w0, w1, w2, w3}); }
#pragma unroll
        for (int c4 = 0; c4 < 4; ++c4) {
            s16x4 r00, r01, r10, r11; tr_read4(vb0 ^ (unsigned)(c4 << 6), vb1 ^ (unsigned)(c4 << 6), r00, r01, r10, r11);
            const bf16x8 v0 = __builtin_shufflevector(r00, r01, 0, 1, 2, 3, 4, 5, 6, 7), v1 = __builtin_shufflevector(r10, r11, 0, 1, 2, 3, 4, 5, 6, 7);
            o[c4] = __builtin_amdgcn_mfma_f32_32x32x16_bf16(v0, pf[0], o[c4], 0, 0, 0);
            o[c4] = __builtin_amdgcn_mfma_f32_32x32x16_bf16(v1, pf[1], o[c4], 0, 0, 0); }
    }
    const float ltot = l_run + __shfl_xor(l_run, 32);
    if constexpr (PASS == 0) {
#pragma unroll
        for (int c4 = 0; c4 < 4; ++c4)
#pragma unroll
            for (int g4 = 0; g4 < 4; ++g4) *(uint2*)(st_o + 32 * c4 + 8 * g4 + 4 * hh) = make_uint2(pk2(o[c4][4 * g4], o[c4][4 * g4 + 1]), pk2(o[c4][4 * g4 + 2], o[c4][4 * g4 + 3]));
        if (hh == 0) *(f32x2*)st_ml = (f32x2){m_run, ltot};
    } else {
        const float inv = 1.0f / ltot;
        bf16_t* orow = p.AO + (size_t)(b * SEQ + tq) * DM + 1024 + h * 128;
#pragma unroll
        for (int c4 = 0; c4 < 4; ++c4)
#pragma unroll
            for (int g4 = 0; g4 < 4; ++g4) { const int dh = 32 * c4 + 8 * g4 + 4 * hh;
                if constexpr (D8_OUT0) *(unsigned*)((unsigned char*)p.AO + (size_t)(b * SEQ + tq) * DM + 1024 + h * 128 + dh) = pk4_fp8(o[c4][4 * g4] * inv, o[c4][4 * g4 + 1] * inv, o[c4][4 * g4 + 2] * inv, o[c4][4 * g4 + 3] * inv, A8_SCALE);
                else *(uint2*)(orow + dh) = make_uint2(pk2(o[c4][4 * g4] * inv, o[c4][4 * g4 + 1] * inv), pk2(o[c4][4 * g4 + 2] * inv, o[c4][4 * g4 + 3] * inv)); }
    }
}
DI void attention(const Params& p, LAS unsigned char* lds) {
    const int tid = opaque_tid(), wave = __builtin_amdgcn_readfirstlane(tid >> 6), lane = tid & 63, hh = lane >> 5;
    LAS unsigned char* vimg = lds + wave * 8192;
    const unsigned vbase = (unsigned)(uintptr_t)vimg;
    const int q4 = (lane & 15) >> 2, pp = lane & 3, blk = (lane >> 4) & 1;
    const unsigned vb0 = vbase + 256u * (4 * hh + q4) + 16u * ((2 * blk + (pp >> 1)) ^ (hh & 3)) + 8u * (pp & 1) + ((unsigned)q4 << 6);
    const unsigned vb1 = vbase + 256u * (8 + 4 * hh + q4) + 16u * ((2 * blk + (pp >> 1)) ^ ((2 + hh) & 3)) + 8u * (pp & 1) + ((unsigned)q4 << 6);
    for (int u = blockIdx.x; u < 256; u += gridDim.x) {
        const int bh = (u & 7) * 4 + ((u >> 3) >> 3), span = (u >> 3) & 7, h = bh & 7, b = bh >> 3;
#pragma unroll 1
        for (int j = 0; j < 2; ++j) attn_wave<0>(p, vimg, vb0, vb1, lane, b, h, span * 512 + wave * 2 + j);
        asm volatile("s_waitcnt vmcnt(0)" ::: "memory");
        __syncthreads();
#pragma unroll 1
        for (int j = 0; j < 2; ++j) attn_wave<1>(p, vimg, vb0, vb1, lane, b, h, span * 512 + (wave * 2 + j) * 32);
        __syncthreads();
    }
}
DI float om_exp2x(float la, float a) {
    const float x = 2.f * la;
    const float pl = x * (1.f + x * (0.5f + x * (0.16666667f + x * (0.041666668f + x * 0.008333334f))));
    return x > -0.25f ? -pl : 1.f - a * a;
}
DI void lru_conv(const Params& p) {
    const int tid = opaque_tid();
    if (tid < 336) {
        const int ch = tid * 8;
        float cw[4][8], cb[8];
#pragma unroll
        for (int j = 0; j < 4; ++j) { const f32x4 w0 = *(const f32x4*)(p.lru_conv_w + j * LRU_W + ch), w1 = *(const f32x4*)(p.lru_conv_w + j * LRU_W + ch + 4);
            cw[j][0] = w0[0]; cw[j][1] = w0[1]; cw[j][2] = w0[2]; cw[j][3] = w0[3]; cw[j][4] = w1[0]; cw[j][5] = w1[1]; cw[j][6] = w1[2]; cw[j][7] = w1[3]; }
        { const f32x4 b0 = *(const f32x4*)(p.lru_conv_b + ch), b1 = *(const f32x4*)(p.lru_conv_b + ch + 4); cb[0] = b0[0]; cb[1] = b0[1]; cb[2] = b0[2]; cb[3] = b0[3]; cb[4] = b1[0]; cb[5] = b1[1]; cb[6] = b1[2]; cb[7] = b1[3]; }
        for (int run = blockIdx.x; run < T_TOK / 32; run += gridDim.x) {
            const int tok0 = run * 32, t0 = tok0 % SEQ;
            const bf16_t* src = p.G + (size_t)tok0 * N_IN1 + LRU_W + ch;
            u32x4 rows[35];
#pragma unroll
            for (int i = 0; i < 35; ++i) { const int t = t0 - 2 + i; rows[i] = (t >= 0 && t < SEQ) ? *(const u32x4*)(src + (ptrdiff_t)(i - 2) * N_IN1) : (u32x4){0u, 0u, 0u, 0u}; }
#pragma unroll
            for (int i = 0; i < 32; ++i) { float xc[8];
#pragma unroll
                for (int e = 0; e < 8; ++e) xc[e] = cb[e];
#pragma unroll
                for (int j = 0; j < 4; ++j) { const u32x4 xv = rows[i + j];
                    xc[0] += cw[j][0] * bflo(xv[0]); xc[1] += cw[j][1] * bfhi(xv[0]); xc[2] += cw[j][2] * bflo(xv[1]); xc[3] += cw[j][3] * bfhi(xv[1]);
                    xc[4] += cw[j][4] * bflo(xv[2]); xc[5] += cw[j][5] * bfhi(xv[2]); xc[6] += cw[j][6] * bflo(xv[3]); xc[7] += cw[j][7] * bfhi(xv[3]); }
                *(u32x4*)(p.XC + (size_t)(tok0 + i) * LRU_W + ch) = (u32x4){pk2(xc[0], xc[1]), pk2(xc[2], xc[3]), pk2(xc[4], xc[5]), pk2(xc[6], xc[7])}; }
        }
    }
}
DI void lru(const Params& p, LAS unsigned char* lds) {
    const int tid = opaque_tid(), wave = __builtin_amdgcn_readfirstlane(tid >> 6), lane = tid & 63, col = lane & 15, g = lane >> 4;
    LAS unsigned char* wl = lds;
    LAS unsigned char* xs = lds + 36864;
    LAS float* sums = (LAS float*)(lds + 36864 + 86016);
    LAS float* cst = sums + 1920;
    for (int u = blockIdx.x; u < 256; u += gridDim.x) {
        const int bq = (u >> 5) * 8 + (u & 7), qt = (u >> 3) & 3, b = bq >> 4, n = bq & 15, chq = n * LRU_BW + qt * 42;
        const char* xcb = (const char*)(p.XC + (size_t)(b * SEQ) * LRU_W + n * LRU_BW);
        const bf16_t* gb = p.G + (size_t)(b * SEQ) * N_IN1;
        unsigned poff[6];
#pragma unroll
        for (int i = 0; i < 6; ++i) { const int idx = tid + 512 * i; poff[i] = (unsigned)((idx / 21) * LRU_W + (idx % 21) * 8) * 2u; }
        auto dma_chunk = [&](int chunk, int bsel) { const char* src = xcb + (size_t)chunk * 128 * LRU_W * 2; LAS unsigned char* dst = xs + bsel * 43008 + wave * 1024;
#pragma unroll
            for (int i = 0; i < 5; ++i) __builtin_amdgcn_global_load_lds((const unsigned*)(src + poff[i]), (LAS unsigned*)(dst + i * 8192), 16, 0, 0);
            if (wave < 2) __builtin_amdgcn_global_load_lds((const unsigned*)(src + poff[5]), (LAS unsigned*)(dst + 5 * 8192), 16, 0, 0); };
        for (int dir = 0; dir < 2; ++dir) {
            __syncthreads();
            for (int i = tid; i < 2 * 48 * 24; i += 512) { const int which = i / (48 * 24), r = (i / 24) % 48, ck = i % 24; const int nt = r >> 4, cl = r & 15, ks = ck >> 2, gg = ck & 3;
                *(LAS u32x4*)(wl + ((which * 3 + nt) * 6 + ks) * 1024 + (gg * 16 + cl) * 16) = *(const u32x4*)(p.w_lru + ((((size_t)(dir * 2 + which) * 16 + n) * 4 + qt) * 48 + r) * 192 + ck * 8); }
            if (tid < 48) { const bool valid = tid < 42; const int ch = dir * LRU_W + chq + tid;
                cst[tid] = valid ? -1.44269504f * p.lru_b_a[ch] : 0.f; cst[48 + tid] = valid ? -1.44269504f * p.lru_b_x[ch] : 0.f;
                const float lam = valid ? p.lru_lambda[ch] : 0.f; const float sp = (-lam > 20.f) ? -lam : log1pf(__expf(-lam)); cst[96 + tid] = -8.0f * 1.44269504f * sp; }
            dma_chunk(dir == 0 ? 0 : 31, 0);
            asm volatile("s_waitcnt vmcnt(0)" ::: "memory");
            __syncthreads();
            float cba[3], cbx[3], cex[3];
#pragma unroll
            for (int nt = 0; nt < 3; ++nt) { cba[nt] = cst[nt * 16 + col]; cbx[nt] = cst[48 + nt * 16 + col]; cex[nt] = cst[96 + nt * 16 + col]; }
            bf16x8 breg[3][6];
#pragma unroll
            for (int nt = 0; nt < 3; ++nt)
#pragma unroll
                for (int ks = 0; ks < 6; ++ks) { breg[nt][ks] = *(const LAS bf16x8*)(wl + (nt * 6 + ks) * 1024 + lane * 16); asm volatile("" : "+v"(breg[nt][ks])); }
            const int wpos = dir == 0 ? wave : 7 - wave;
            float carry[3] = {0.f, 0.f, 0.f};
            for (int step = 0; step < 32; ++step) {
                const int c = dir == 0 ? step : 31 - step, c0 = c * 128, par = step & 1;
                const bool has_next = step < 31;
                if (has_next) dma_chunk(dir == 0 ? c + 1 : c - 1, par ^ 1);
                LAS unsigned char* xb = xs + par * 43008;
                uint2 hfv[3] = {make_uint2(0u, 0u), make_uint2(0u, 0u), make_uint2(0u, 0u)}; unsigned short gtv[3][4];
                const uint2* hfp = (const uint2*)p.HF + ((size_t)((u * 32 + c) * 8 + wave) * 3) * 64 + lane;
                const bf16_t* gbw = gb + (size_t)(c0 + wave * 16) * N_IN1 + chq;
                bf16_t* aow = p.AO + (size_t)(b * SEQ + c0 + wave * 16) * LRU_W + chq;
                if (dir == 1) {
#pragma unroll
                    for (int nt = 0; nt < 3; ++nt) { hfv[nt] = hfp[nt * 64];
#pragma unroll
                        for (int r = 0; r < 4; ++r) gtv[nt][r] = (nt * 16 + col < 42) ? gbw[(unsigned)((4 * g + r) * N_IN1 + nt * 16 + col)] : (unsigned short)0; } }
                bf16x8 af[6];
#pragma unroll
                for (int ks = 0; ks < 6; ++ks) { const int ch0 = 32 * ks + 8 * g; const bool kval = ch0 < LRU_BW; const int chl0 = kval ? ch0 : 160;
                    const u32x4 xv = *(const LAS u32x4*)(xb + (wave * 16 + col) * 336 + chl0 * 2);
                    af[ks] = __builtin_bit_cast(bf16x8, kval ? xv : (u32x4){0u, 0u, 0u, 0u}); }
                f32x4 acc[2][3];
                {
                    bf16x8 bl[6];
                    const LAS unsigned char* wl1 = wl + 18 * 1024 + lane * 16;
#pragma unroll
                    for (int ks = 0; ks < 6; ++ks) bl[ks] = *(const LAS bf16x8*)(wl1 + ks * 1024);
#pragma unroll
                    for (int nt = 0; nt < 3; ++nt) {
                        acc[0][nt] = (f32x4){0.f, 0.f, 0.f, 0.f}; acc[1][nt] = (f32x4){0.f, 0.f, 0.f, 0.f};
#pragma unroll
                        for (int ks = 0; ks < 6; ++ks) acc[0][nt] = __builtin_amdgcn_mfma_f32_16x16x32_bf16(af[ks], breg[nt][ks], acc[0][nt], 0, 0, 0);
#pragma unroll
                        for (int ks = 0; ks < 6; ++ks) { acc[1][nt] = __builtin_amdgcn_mfma_f32_16x16x32_bf16(af[ks], bl[ks], acc[1][nt], 0, 0, 0);
                            if (nt < 2) bl[ks] = *(const LAS bf16x8*)(wl1 + ((nt + 1) * 6 + ks) * 1024); }
                    }
                }
                float hl[3][4], Pl[3][4];
#pragma unroll
                for (int nt = 0; nt < 3; ++nt) { const int chl = nt * 16 + col;
                    float av[4], uv[4];
#pragma unroll
                    for (int r = 0; r < 4; ++r) {
                        const float rg = __builtin_amdgcn_rcpf(1.0f + __builtin_amdgcn_exp2f(__builtin_fmaf(acc[0][nt][r], -1.44269504f, cba[nt])));
                        const float ig = __builtin_amdgcn_rcpf(1.0f + __builtin_amdgcn_exp2f(__builtin_fmaf(acc[1][nt][r], -1.44269504f, cbx[nt])));
                        const float a = __builtin_amdgcn_exp2f(cex[nt] * rg);
                        const float xcv = bf2f(*(const LAS bf16_t*)(xb + (wave * 16 + 4 * g + r) * 336 + (qt * 42 + chl) * 2));
                        av[r] = a; uv[r] = __builtin_amdgcn_sqrtf(__builtin_fmaf(-a, a, 1.0f)) * (ig * xcv); }
                    float h[4], P[4], A, H;
                    if (dir == 0) { h[0] = uv[0]; P[0] = av[0];
#pragma unroll
                        for (int r = 1; r < 4; ++r) { h[r] = av[r] * h[r - 1] + uv[r]; P[r] = av[r] * P[r - 1]; }
                        A = P[3]; H = h[3];
                        { const float A1 = __shfl_up(A, 16), H1 = __shfl_up(H, 16); if (g >= 1) { H = A * H1 + H; A = A * A1; } }
                        { const float A2 = __shfl_up(A, 32), H2 = __shfl_up(H, 32); if (g >= 2) { H = A * H2 + H; A = A * A2; } }
                        float Ae = __shfl_up(A, 16), He = __shfl_up(H, 16); if (g == 0) { Ae = 1.f; He = 0.f; }
#pragma unroll
                        for (int r = 0; r < 4; ++r) { hl[nt][r] = h[r] + P[r] * He; Pl[nt][r] = P[r] * Ae; }
                        if (g == 3) *(LAS f32x2*)(sums + (par * 48 + chl) * 20 + wpos * 2) = (f32x2){A, H};
                    } else { h[3] = uv[3]; P[3] = av[3];
#pragma unroll
                        for (int r = 2; r >= 0; --r) { h[r] = av[r] * h[r + 1] + uv[r]; P[r] = av[r] * P[r + 1]; }
                        A = P[0]; H = h[0];
                        { const float A1 = __shfl_down(A, 16), H1 = __shfl_down(H, 16); if (g <= 2) { H = A * H1 + H; A = A * A1; } }
                        { const float A2 = __shfl_down(A, 32), H2 = __shfl_down(H, 32); if (g <= 1) { H = A * H2 + H; A = A * A2; } }
                        float Ae = __shfl_down(A, 16), He = __shfl_down(H, 16); if (g == 3) { Ae = 1.f; He = 0.f; }
#pragma unroll
                        for (int r = 0; r < 4; ++r) { hl[nt][r] = h[r] + P[r] * He; Pl[nt][r] = P[r] * Ae; }
                        if (g == 0) *(LAS f32x2*)(sums + (par * 48 + chl) * 20 + wpos * 2) = (f32x2){A, H};
                    }
                }
                asm volatile("s_waitcnt vmcnt(0)" ::: "memory");
                __syncthreads();
                f32x4 sv[3][4];
#pragma unroll
                for (int nt = 0; nt < 3; ++nt)
#pragma unroll
                    for (int j = 0; j < 4; ++j) sv[nt][j] = *(const LAS f32x4*)(sums + (par * 48 + nt * 16 + col) * 20 + j * 4);
#pragma unroll
                for (int nt = 0; nt < 3; ++nt) { const int chl = nt * 16 + col; float C = carry[nt], Cw = 0.f;
#pragma unroll
                    for (int k = 0; k < 8; ++k) { if (k == wpos) Cw = C; C = sv[nt][k >> 1][(k & 1) * 2] * C + sv[nt][k >> 1][(k & 1) * 2 + 1]; }
                    carry[nt] = C;
                    float hv[4];
#pragma unroll
                    for (int r = 0; r < 4; ++r) hv[r] = hl[nt][r] + Pl[nt][r] * Cw;
                    if (dir == 0) ((uint2*)p.HF)[((size_t)((u * 32 + c) * 8 + wave) * 3 + nt) * 64 + lane] = make_uint2(pk2(hv[0], hv[1]), pk2(hv[2], hv[3]));
                    else if (chl < 42) { const float ff[4] = {bflo(hfv[nt].x), bfhi(hfv[nt].x), bflo(hfv[nt].y), bfhi(hfv[nt].y)};
#pragma unroll
                        for (int r = 0; r < 4; ++r) aow[(unsigned)((4 * g + r) * LRU_W + chl)] = f2bf(bf2f(gtv[nt][r]) * (ff[r] + hv[r])); }
                }
            }
        }
    }
}
}

#define XB_TMO      128
#define XB_XCNT(j)  (256  + 64 * (j))
#define XB_XSUB(j)  (1280 + 64 * (j))
#define XB_XGEN(j)  (2304 + 64 * (j))
#define XB_TOP      3328
#define XB_TOPGEN   3392
#define XCD_BAR_WORDS 3456
#define XB_SPIN_CAP (1u << 18)

__device__ __forceinline__ unsigned xb_ld(unsigned* p)              { return __hip_atomic_load(p, __ATOMIC_RELAXED, __HIP_MEMORY_SCOPE_AGENT); }
__device__ __forceinline__ unsigned xb_add(unsigned* p, unsigned v) { return __hip_atomic_fetch_add(p, v, __ATOMIC_RELAXED, __HIP_MEMORY_SCOPE_AGENT); }
__device__ __forceinline__ unsigned xb_xcc_id() { return (unsigned)__builtin_amdgcn_s_getreg((3 << 11) | 20) & 0xFu; }
#define XB_SPIN(cond, bar) do { unsigned _sp = 0; while (cond) { __builtin_amdgcn_s_sleep(1); \
    if ((++_sp & 255u) == 0u) { if (xb_ld(&(bar)[XB_TMO])) break; if (_sp > XB_SPIN_CAP) { atomicAdd(&(bar)[XB_TMO], 1u); break; } } } } while (0)

struct XcdBarrier {
    unsigned* bar; unsigned x;
    volatile LAS unsigned* st;
};

__device__ __forceinline__ XcdBarrier xcd_barrier_post(unsigned* bar, volatile LAS unsigned* st) {
    XcdBarrier b; b.bar = bar; b.x = xb_xcc_id(); b.st = st;
    if (threadIdx.x == 0) (void)xb_add(&bar[XB_XCNT(b.x)], 1u);
    return b;
}
__device__ __forceinline__ void xcd_barrier_complete(unsigned* bar, unsigned x, unsigned& nloc, unsigned& nx) {
    const unsigned G = gridDim.x * gridDim.y * gridDim.z;
    unsigned sum, cnt, mine, sp = 0u;
    for (;;) {
        sum = 0u; cnt = 0u; mine = 0u;
#pragma unroll
        for (unsigned j = 0; j < 16; ++j) { const unsigned c = xb_ld(&bar[XB_XCNT(j)]); sum += c; cnt += (c > 0u) ? 1u : 0u; mine = (j == x) ? c : mine; }
        if (sum == G) break;
        __builtin_amdgcn_s_sleep(1);
        if ((++sp & 255u) == 0u) { if (xb_ld(&bar[XB_TMO])) break; if (sp > XB_SPIN_CAP) { atomicAdd(&bar[XB_TMO], 1u); break; } }
    }
    nloc = mine > 0u ? mine : 1u; nx = cnt > 0u ? cnt : 1u;
}

__device__ __forceinline__ void xcd_barrier(const XcdBarrier& b) {
    asm volatile("s_waitcnt vmcnt(0)" ::: "memory");
    __syncthreads();
    if (threadIdx.x == 0) {
        unsigned* bar = b.bar;
        __builtin_amdgcn_s_waitcnt(0);
        unsigned nloc = b.st[0], nx = b.st[1];
        if (nloc == 0u) { xcd_barrier_complete(bar, b.x, nloc, nx); b.st[0] = nloc; b.st[1] = nx; }
        const unsigned old = xb_add(&bar[XB_XSUB(b.x)], 1u);
        const unsigned gen = old / nloc;
        if (old + 1u == (gen + 1u) * nloc) {
            __builtin_amdgcn_fence(__ATOMIC_RELEASE, "agent");
            asm volatile("s_waitcnt vmcnt(0)" ::: "memory");
            const unsigned og = xb_add(&bar[XB_TOP], 1u);
            const unsigned tg = og / nx;
            if (og + 1u == (tg + 1u) * nx) xb_add(&bar[XB_TOPGEN], 1u);
            else XB_SPIN(xb_ld(&bar[XB_TOPGEN]) == tg, bar);
            __builtin_amdgcn_fence(__ATOMIC_ACQUIRE, "agent");
            xb_add(&bar[XB_XGEN(b.x)], 1u);
            asm volatile("s_waitcnt vmcnt(0)" ::: "memory");
        } else {
            XB_SPIN(xb_ld(&bar[XB_XGEN(b.x)]) == gen, bar);
            __builtin_amdgcn_fence(__ATOMIC_ACQUIRE, "agent");
            asm volatile("s_waitcnt vmcnt(0)" ::: "memory");
        }
    }
    __syncthreads();
}


constexpr int PROBE = 0;
constexpr int LDS_XB_OFF = gm::STAGE_BYTES + 1024;
constexpr int LDS_TOTAL = LDS_XB_OFF + 16;
__global__ void __launch_bounds__(512, 2) mega(Params p) {
    LAS unsigned char* lds = (LAS unsigned char*)dyn_smem;
    LAS int* tab = (LAS int*)(lds + gm::TAB_OFF);
    volatile LAS unsigned* xbw = (volatile LAS unsigned*)(lds + LDS_XB_OFF);
    if (threadIdx.x == 0) { xbw[0] = 0u; xbw[1] = 0u; xbw[2] = 0u; xbw[3] = 0u; }
    __syncthreads();
    XcdBarrier bar = xcd_barrier_post(p.bar, xbw);
    ph::mods(p, lds);
    if constexpr (PROBE == 14) { ph::mods(p, lds); ph::mods(p, lds); }
    xcd_barrier(bar);
    { const int c = blockIdx.x, G = gridDim.x;
      ph::transposer(p, lds, c, c < 320 ? (320 - c + G - 1) / G : 0, G); __syncthreads();
      ph::transposer(p, lds, 320 + c, c < 632 ? (632 - c + G - 1) / G : 0, G); __syncthreads(); }
    ph::lru_weights(p);
    ph::fold_router(p);
    ph::norm_rows<0, D8_IN0>(p, p.x, p.norm0_mix, 0, 0, nullptr);
    xcd_barrier(bar);
    { const int c = blockIdx.x, G = gridDim.x; const int tcount = c < 6144 ? (6144 - c + G - 1) / G : 0; const bool t_first = ((c >> 3) & 1) != 0;
      if (t_first) { ph::transposer(p, lds, 952 + c, tcount, G); __syncthreads(); }
      { gm::DenseSched S; S.init(T_TOK, N_IN0); EpiIn0 e; e.xin = nullptr; e.lgate = 0; if constexpr (D8_IN0) gm::gemm_phase<EpiIn0, gm::DenseSched, true>(lds, p, p.H, p.w_in0t, 0, DM / 2, S, e, W8_E8M0, A8_E8M0); else gm::gemm_phase(lds, p, p.H, p.w_in0t, 0, DM, S, e); }
      if (!t_first) { __syncthreads(); ph::transposer(p, lds, 952 + c, tcount, G); }
      if constexpr (PROBE == 21) { __syncthreads(); ph::transposer(p, lds, 952 + c, tcount, G); }
      if constexpr (PROBE == 24) { __syncthreads(); if (t_first) ph::transposer(p, lds, 952 + c, tcount, G); }
      if constexpr (PROBE == 23) { __syncthreads(); if (t_first) { ph::transposer(p, lds, 952 + c, tcount, G); __syncthreads(); }
        { gm::DenseSched S; S.init(T_TOK, N_IN0); EpiIn0 e; e.xin = nullptr; e.lgate = 0; gm::gemm_phase<EpiIn0, gm::DenseSched, true>(lds, p, p.H, p.w_in0t, 0, DM / 2, S, e, W8_E8M0, A8_E8M0); }
        if (!t_first) { __syncthreads(); ph::transposer(p, lds, 952 + c, tcount, G); } }
      if constexpr (PROBE == 20) { __syncthreads(); gm::DenseSched S; S.init(T_TOK, N_IN0); EpiIn0 e; e.xin = nullptr; e.lgate = 0; gm::gemm_phase<EpiIn0, gm::DenseSched, true>(lds, p, p.H, p.w_in0t, 0, DM / 2, S, e, W8_E8M0, A8_E8M0); } }
    xcd_barrier(bar);
    ph::attention(p, lds);
    if constexpr (PROBE == 4) ph::attention(p, lds);
    __syncthreads();
    ph::conv_gln(p, lds);
    if constexpr (PROBE == 5) ph::conv_gln(p, lds);
    xcd_barrier(bar);
    { gm::DenseSched S; S.init(T_TOK, DM); EpiOutT<true> e; e.xin = p.x; e.lgate = 0; if constexpr (D8_OUT0) gm::gemm_phase<EpiOutT<true>, gm::DenseSched, true>(lds, p, p.AO, p.w_out0t, 0, DM / 2, S, e, W8_E8M0, A8_E8M0); else gm::gemm_phase(lds, p, p.AO, p.w_out0t, 0, DM, S, e); }
    xcd_barrier(bar);
    ph::router<false, true>(p, 0, lds, p.norm0_ffn, 1);
    if constexpr (PROBE == 12) { ph::router<true>(p, 0, lds); ph::router<true>(p, 0, lds); }
    xcd_barrier(bar);
    if constexpr (PROBE == 11) { xcd_barrier(bar); xcd_barrier(bar); xcd_barrier(bar); xcd_barrier(bar); xcd_barrier(bar); xcd_barrier(bar); xcd_barrier(bar); xcd_barrier(bar); xcd_barrier(bar); xcd_barrier(bar); }
    gm::moe_tables(tab, p.cnt);
    { gm::MoeSched<true> S; S.init(tab); EpiGU e; e.xin = nullptr; e.lgate = 0; gm::gemm_phase<EpiGU, gm::MoeSched<true>, true>(lds, p, p.H, p.w_gut0, (size_t)2048 * (DM / 2), DM / 2, S, e, W8_E8M0, A8_E8M0); if constexpr (PROBE == 3) gm::gemm_phase<EpiGU, gm::MoeSched<true>, true>(lds, p, p.H, p.w_gut0, (size_t)2048 * (DM / 2), DM / 2, S, e, W8_E8M0, A8_E8M0); }
    xcd_barrier(bar);
    { gm::MoeSched<false> S; S.init(tab); EpiDown e; e.xin = nullptr; e.lgate = 0; gm::gemm_phase<EpiDown, gm::MoeSched<false>, true>(lds, p, p.ACT, p.w_dt0, (size_t)DM * (EFF / 2), EFF / 2, S, e, W8_E8M0, A8_E8M0); if constexpr (PROBE == 8) gm::gemm_phase<EpiDown, gm::MoeSched<false>, true>(lds, p, p.ACT, p.w_dt0, (size_t)DM * (EFF / 2), EFF / 2, S, e, W8_E8M0, A8_E8M0); }
    xcd_barrier(bar);
    ph::norm_rows<1, D8_IN1>(p, nullptr, p.norm1_mix, 2, 1, tab);
    xcd_barrier(bar);
    { const int c = blockIdx.x, G = gridDim.x; int tfirst, tcount, tstride;
      if (G == 256) { tstride = 1; if (c < 64) { tcount = 18; tfirst = 18 * c; } else { tcount = 26; tfirst = 1152 + 26 * (c - 64); } }
      else { tstride = G; tfirst = c; tcount = c < 6144 ? (6144 - c + G - 1) / G : 0; }
      const bool t_first = ((c >> 3) & 1) != 0;
      if (t_first) { ph::transposer(p, lds, 7096 + tfirst, tcount, tstride); __syncthreads(); }
      { gm::DenseSched S; S.init(T_TOK, N_IN1); EpiIn1 e; e.xin = nullptr; e.lgate = 0; gm::gemm_phase(lds, p, p.H, p.w_in1t, 0, DM, S, e); }
      if (!t_first) { __syncthreads(); ph::transposer(p, lds, 7096 + tfirst, tcount, tstride); } }
    xcd_barrier(bar);
    ph::lru_conv(p);
    if constexpr (PROBE == 9) { ph::lru_conv(p); ph::lru_conv(p); }
    xcd_barrier(bar);
    ph::lru(p, lds);
    if constexpr (PROBE == 6) ph::lru(p, lds);
    xcd_barrier(bar);
    { gm::DenseSched S; S.init(T_TOK, DM); EpiOutT<false> e; e.xin = nullptr; e.lgate = 2; gm::gemm_phase(lds, p, p.AO, p.w_out1t, 0, LRU_W, S, e); }
    xcd_barrier(bar);
    ph::router<false, true>(p, 1, lds, p.norm1_ffn, 3);
    xcd_barrier(bar);
    gm::moe_tables(tab, p.cnt + 32);
    { gm::MoeSched<true> S; S.init(tab); EpiGU e; e.xin = nullptr; e.lgate = 0; gm::gemm_phase<EpiGU, gm::MoeSched<true>, true>(lds, p, p.H, p.w_gut1, (size_t)2048 * (DM / 2), DM / 2, S, e, W8_E8M0, A8_E8M0); }
    xcd_barrier(bar);
    { gm::MoeSched<false> S; S.init(tab); EpiDown e; e.xin = nullptr; e.lgate = 0; gm::gemm_phase<EpiDown, gm::MoeSched<false>, true>(lds, p, p.ACT, p.w_dt1, (size_t)DM * (EFF / 2), EFF / 2, S, e, W8_E8M0, A8_E8M0); }
    xcd_barrier(bar);
    ph::norm_rows<2>(p, nullptr, p.norm_final, 0, 3, tab);
}

static inline size_t al256(size_t x) { return (x + 255) & ~(size_t)255; }

extern "C" void kernel_launch(void* const* d_in, const int* in_sizes, int n_in, void* d_out, int out_size, void* d_ws, size_t ws_size, hipStream_t stream) {
    Params p{};
    const float** ip = (const float**)&p.x;
    for (int i = 0; i < 38; ++i) ip[i] = (const float*)d_in[i];
    p.out = (float*)d_out;
    char* w = (char*)d_ws; size_t off = 0;
    auto take = [&](size_t bytes) { char* r = w + off; off += al256(bytes); return r; };
    p.bar = (unsigned*)take(16384); p.cnt = (int*)take(256);
    const size_t zero_bytes = off;
    p.mod = (float*)take(4 * 4 * 6144 * 4); p.wrt = (bf16_t*)take((size_t)2 * 4 * 3 * 48 * 2048 * 2); p.rbias = (float*)take(2 * 4 * 48 * 4);
    p.w_in0t = (bf16_t*)take((size_t)N_IN0 * DM * 2); p.w_out0t = (bf16_t*)take((size_t)DM * DM * 2);
    p.w_gut0 = (bf16_t*)take((size_t)NEXP * 2048 * DM); p.w_dt0 = (bf16_t*)take((size_t)NEXP * DM * EFF);
    p.w_in1t = (bf16_t*)take((size_t)N_IN1 * DM * 2); p.w_out1t = (bf16_t*)take((size_t)DM * LRU_W * 2);
    p.w_gut1 = (bf16_t*)take((size_t)NEXP * 2048 * DM); p.w_dt1 = (bf16_t*)take((size_t)NEXP * DM * EFF);
    p.w_lru = (bf16_t*)take((size_t)2 * 2 * 16 * 2 * 96 * 192 * 2);
    p.H = (bf16_t*)take((size_t)T_TOK * DM * 2); p.G = (bf16_t*)take((size_t)T_TOK * N_IN1 * 2); p.AO = (bf16_t*)take((size_t)T_TOK * LRU_W * 2); p.HF = (bf16_t*)take((size_t)256 * 32 * 8 * 3 * 64 * 8);
    p.XA = (bf16_t*)take((size_t)T_TOK * DM * 2); p.ACT = (bf16_t*)take((size_t)ROWS_PAD * EFF * 2); p.YB = (bf16_t*)take((size_t)ROWS_PAD * DM * 2);
    p.XC = (bf16_t*)take((size_t)T_TOK * LRU_W * 2); p.KVH = (bf16_t*)take((size_t)NBATCH * 8 * 2 * SEQ * 128 * 2);
    p.tokl = (int*)take((size_t)NEXP * ECAP * 4); p.gatel = (float*)take((size_t)NEXP * ECAP * 4); p.asg = (int*)take((size_t)T_TOK * 2 * 4);
    if (off > ws_size) return;
    (void)hipMemsetAsync(d_ws, 0, zero_bytes, stream);
    static int grid = 0;
    if (!grid) { int dev = 0, cus = 0, per_cu = 0; (void)hipGetDevice(&dev); (void)hipDeviceGetAttribute(&cus, hipDeviceAttributeMultiprocessorCount, dev);
        (void)hipFuncSetAttribute((const void*)mega, hipFuncAttributeMaxDynamicSharedMemorySize, LDS_TOTAL);
        (void)hipOccupancyMaxActiveBlocksPerMultiprocessor(&per_cu, mega, 512, LDS_TOTAL);
        grid = cus * (per_cu < 1 ? per_cu : 1); }
    if (grid > 0) mega<<<grid, 512, LDS_TOTAL, stream>>>(p);
}
```

```cpp
#include <hip/hip_runtime.h>
#include <stdint.h>

typedef unsigned short bf16_t;
typedef float f32x4 __attribute__((ext_vector_type(4)));

#define DI __device__ __forceinline__

constexpr int T_TOK = 16384, DM = 2048, SEQ = 4096, NBATCH = 4;
constexpr int N_IN0 = 5120, N_IN1 = 5376, LRU_W = 2688, LRU_BW = 168;
constexpr int NEXP = 32, EFF = 1024, ECAP = 16384, ROWS_PAD = 40960;

DI float bf2f(bf16_t b) { return __uint_as_float(((unsigned)b) << 16); }
DI bf16_t f2bf(float f) { unsigned u = __float_as_uint(f); u += 0x7FFFu + ((u >> 16) & 1u); return (bf16_t)(u >> 16); }
DI float sigmoidf_(float x) { return __builtin_amdgcn_rcpf(1.0f + __expf(-x)); }
DI float siluf_(float x) { return x * __builtin_amdgcn_rcpf(1.0f + __expf(-x)); }
DI float gelu_tanh(float x) { const float u = 0.7978845608028654f * (x + 0.044715f * x * x * x); return x * __builtin_amdgcn_rcpf(1.0f + __expf(-2.0f * u)); }
template <int CTRL, int ROWMASK> DI float dpp_mov(float oldv, float v) { return __builtin_bit_cast(float, __builtin_amdgcn_update_dpp(__builtin_bit_cast(int, oldv), __builtin_bit_cast(int, v), CTRL, ROWMASK, 0xf, false)); }
DI float wave_sum(float v) {
    v += dpp_mov<0xB1, 0xf>(0.f, v);
    v += dpp_mov<0x4E, 0xf>(0.f, v);
    v += dpp_mov<0x141, 0xf>(0.f, v);
    v += dpp_mov<0x140, 0xf>(0.f, v);
    v += dpp_mov<0x142, 0xa>(0.f, v);
    v += dpp_mov<0x143, 0xc>(0.f, v);
    return __builtin_bit_cast(float, __builtin_amdgcn_readlane(__builtin_bit_cast(int, v), 63)); }
DI float wave_max(float v) { for (int o = 32; o > 0; o >>= 1) v = fmaxf(v, __shfl_xor(v, o)); return v; }

struct Params {
    const float *x, *c;
    const float *norm0_mix, *ada0_mix_w, *ada0_mix_b, *w_in0, *conv_w, *conv_b, *conv_norm_g, *conv_norm_b, *w_out0;
    const float *norm0_ffn, *ada0_ffn_w, *ada0_ffn_b, *moe0_w_group, *moe0_w_expert, *moe0_w_gate_up, *moe0_w_down;
    const float *norm1_mix, *ada1_mix_w, *ada1_mix_b, *w_in1, *lru_conv_w, *lru_conv_b, *lru_w_a, *lru_b_a, *lru_w_x, *lru_b_x, *lru_lambda, *w_out1;
    const float *norm1_ffn, *ada1_ffn_w, *ada1_ffn_b, *moe1_w_group, *moe1_w_expert, *moe1_w_gate_up, *moe1_w_down;
    const float *norm_final;
    float* out;
    unsigned* bar; int* cnt;
    float* mod;
    bf16_t* wrt;
    float* rbias;
    bf16_t *w_in0t, *w_out0t, *w_gut0, *w_dt0, *w_in1t, *w_out1t, *w_gut1, *w_dt1, *w_lru;
    bf16_t *H, *G, *AO, *HF, *ACT, *YB, *XC, *KVH;
    bf16_t* XA;
    int* tokl; float* gatel; int* asg;
};

constexpr bool YB8_E = true;
struct GUnit { int rowbase; int nvalid; int e; const int* gather; };
struct GArgs { const bf16_t* A; const bf16_t* Bt; size_t bt_estride; long long lda, K, moe_layer; const float* xin; long long lgate; };
typedef unsigned u32x4_ __attribute__((ext_vector_type(4)));
typedef __bf16 bf2v_ __attribute__((ext_vector_type(2)));
typedef float f32x2_ __attribute__((ext_vector_type(2)));
DI unsigned pk2e(float a, float b) { f32x2_ v = {a, b}; bf2v_ r = __builtin_convertvector(v, bf2v_); return __builtin_bit_cast(unsigned, r); }
DI u32x4_ pack8(f32x4 a, f32x4 b) { return (u32x4_){pk2e(a[0], a[1]), pk2e(a[2], a[3]), pk2e(b[0], b[1]), pk2e(b[2], b[3])}; }
struct EpiIn0 { static constexpr bool GATHER = false, PRE = false; const float* xin; int lgate; DI void operator()(const Params& p, const GUnit& u, int r, int col0, f32x4 lo0, f32x4 lo1, f32x4 hi0, f32x4 hi1) const {
    const int row = u.rowbase + r;
    if (col0 < 3072) { bf16_t* o = p.G + (size_t)row * N_IN0 + col0; *(u32x4_*)o = pack8(lo0, lo1); *(u32x4_*)(o + 128) = pack8(hi0, hi1); }
    else { const int b = row / SEQ, t = row % SEQ, i0 = (col0 - 3072) >> 7, i1 = i0 + 1;
        bf16_t* o0 = p.KVH + ((size_t)((b * 8 + (i0 & 7)) * 2 + (i0 >> 3)) * SEQ + t) * 128 + (col0 & 127);
        bf16_t* o1 = p.KVH + ((size_t)((b * 8 + (i1 & 7)) * 2 + (i1 >> 3)) * SEQ + t) * 128 + (col0 & 127);
        *(u32x4_*)o0 = pack8(lo0, lo1); *(u32x4_*)o1 = pack8(hi0, hi1); } } };
template <bool F32RES> struct EpiOutT { static constexpr bool GATHER = false, PRE = true; const float* xin; int lgate;
    struct UPre { f32x4 g0, g1, g2, g3; };
    struct Pre { f32x4 x0, x1, x2, x3; u32x4_ a, c; };
    DI UPre unit_pre(const Params& p, const GUnit& u, int col0) const { const int b = u.rowbase / SEQ; const float* gt = p.mod + (lgate * 4 + b) * 6144 + 4096 + col0;
        UPre q; q.g0 = *(const f32x4*)gt; q.g1 = *(const f32x4*)(gt + 4); q.g2 = *(const f32x4*)(gt + 128); q.g3 = *(const f32x4*)(gt + 132); return q; }
    DI Pre pre(const Params& p, const GUnit& u, int r, int col0) const { const size_t off = (size_t)(u.rowbase + r) * DM + col0; Pre q;
        if constexpr (F32RES) { const float* xi = xin + off; q.x0 = *(const f32x4*)xi; q.x1 = *(const f32x4*)(xi + 4); q.x2 = *(const f32x4*)(xi + 128); q.x3 = *(const f32x4*)(xi + 132); }
        else { const bf16_t* o = p.XA + off; q.a = *(const u32x4_*)o; q.c = *(const u32x4_*)(o + 128); }
        return q; }
    DI void fin(const Params& p, const GUnit& u, int r, int col0, const UPre& g, const Pre& q, f32x4 lo0, f32x4 lo1, f32x4 hi0, f32x4 hi1) const {
        bf16_t* o = p.XA + (size_t)(u.rowbase + r) * DM + col0;
        f32x4 r0, r1, r2, r3;
        if constexpr (F32RES) { r0 = q.x0; r1 = q.x1; r2 = q.x2; r3 = q.x3; }
        else { const u32x4_ a = q.a, c = q.c;
            r0 = (f32x4){__uint_as_float(a[0] << 16), __uint_as_float(a[0] & 0xffff0000u), __uint_as_float(a[1] << 16), __uint_as_float(a[1] & 0xffff0000u)};
            r1 = (f32x4){__uint_as_float(a[2] << 16), __uint_as_float(a[2] & 0xffff0000u), __uint_as_float(a[3] << 16), __uint_as_float(a[3] & 0xffff0000u)};
            r2 = (f32x4){__uint_as_float(c[0] << 16), __uint_as_float(c[0] & 0xffff0000u), __uint_as_float(c[1] << 16), __uint_as_float(c[1] & 0xffff0000u)};
            r3 = (f32x4){__uint_as_float(c[2] << 16), __uint_as_float(c[2] & 0xffff0000u), __uint_as_float(c[3] << 16), __uint_as_float(c[3] & 0xffff0000u)}; }
        *(u32x4_*)o = pack8(r0 + g.g0 * lo0, r1 + g.g1 * lo1); *(u32x4_*)(o + 128) = pack8(r2 + g.g2 * hi0, r3 + g.g3 * hi1); } };
DI unsigned pk4_fp8e(float a, float b, float c, float d, float sc) { a = fminf(fmaxf(a * sc, -448.f), 448.f); b = fminf(fmaxf(b * sc, -448.f), 448.f); c = fminf(fmaxf(c * sc, -448.f), 448.f); d = fminf(fmaxf(d * sc, -448.f), 448.f);
    unsigned w = 0u; w = __builtin_amdgcn_cvt_pk_fp8_f32(a, b, w, false); w = __builtin_amdgcn_cvt_pk_fp8_f32(c, d, w, true); return w; }
struct EpiGU { static constexpr bool GATHER = true, PRE = false; const float* xin; int lgate; DI void operator()(const Params& p, const GUnit& u, int r, int col0, f32x4 lo0, f32x4 lo1, f32x4 hi0, f32x4 hi1) const {
    f32x4 a0, a1;
#pragma unroll
    for (int j = 0; j < 4; ++j) { a0[j] = siluf_(lo0[j]) * hi0[j]; a1[j] = siluf_(lo1[j]) * hi1[j]; }
    *(uint2*)((unsigned char*)p.ACT + (size_t)(u.rowbase + r) * EFF + (col0 >> 8) * 128 + (col0 & 127)) = make_uint2(pk4_fp8e(a0[0], a0[1], a0[2], a0[3], 8.f), pk4_fp8e(a1[0], a1[1], a1[2], a1[3], 8.f)); } };
struct EpiDown { static constexpr bool GATHER = false, PRE = true; const float* xin; int lgate;
    struct UPre { int none; };
    struct Pre { float g; };
    DI UPre unit_pre(const Params&, const GUnit&, int) const { return UPre{0}; }
    DI Pre pre(const Params& p, const GUnit& u, int r, int) const { return Pre{p.gatel[(u.gather - p.tokl) + r]}; }
    DI void fin(const Params& p, const GUnit& u, int r, int col0, const UPre&, const Pre& q, f32x4 lo0, f32x4 lo1, f32x4 hi0, f32x4 hi1) const {
    const float g = q.g;
    if constexpr (YB8_E) { const float gs = g * 64.f; unsigned char* o = (unsigned char*)p.YB + (size_t)(u.rowbase + r) * DM + col0;
        *(uint2*)o = make_uint2(pk4_fp8e(lo0[0], lo0[1], lo0[2], lo0[3], gs), pk4_fp8e(lo1[0], lo1[1], lo1[2], lo1[3], gs)); *(uint2*)(o + 128) = make_uint2(pk4_fp8e(hi0[0], hi0[1], hi0[2], hi0[3], gs), pk4_fp8e(hi1[0], hi1[1], hi1[2], hi1[3], gs)); }
    else { bf16_t* o = p.YB + (size_t)(u.rowbase + r) * DM + col0; *(u32x4_*)o = pack8(lo0 * g, lo1 * g); *(u32x4_*)(o + 128) = pack8(hi0 * g, hi1 * g); } } };
struct EpiIn1 { static constexpr bool GATHER = false, PRE = false; const float* xin; int lgate; DI void operator()(const Params& p, const GUnit& u, int r, int col0, f32x4 lo0, f32x4 lo1, f32x4 hi0, f32x4 hi1) const {
    bf16_t* o = p.G + (size_t)(u.rowbase + r) * N_IN1 + col0;
    if (col0 < LRU_W) {
#pragma unroll
        for (int j = 0; j < 4; ++j) { lo0[j] = gelu_tanh(lo0[j]); lo1[j] = gelu_tanh(lo1[j]); } }
    if (col0 + 128 < LRU_W) {
#pragma unroll
        for (int j = 0; j < 4; ++j) { hi0[j] = gelu_tanh(hi0[j]); hi1[j] = gelu_tanh(hi1[j]); } }
    *(u32x4_*)o = pack8(lo0, lo1); *(u32x4_*)(o + 128) = pack8(hi0, hi1); } };

#define LAS __attribute__((address_space(3)))
typedef short bf16x8 __attribute__((ext_vector_type(8)));
DI int opaque_tid() { int t = threadIdx.x; asm volatile("" : "+v"(t)); return t; }
namespace gm {
constexpr int BM = 256, BK = 64, HALF = 128, HTB = HALF * BK * 2, STAGE_BYTES = 8 * HTB, NXCD = 8, WGM = 4;
constexpr int TAB_OFF = STAGE_BYTES;
DI int lds_byte(int r, int c) { const int st = (r >> 4) * 2 + (c >> 5), rr = r & 15, cc = c & 31, ob = rr * 64 + cc * 2; return st * 1024 + (ob ^ (((ob >> 9) & 1) << 5)); }
DI int perm32(int rho) { const int n = rho >> 4, i = rho & 15; return 8 * (i >> 2) + 4 * n + (i & 3); }
DI void stage_rc(int b, int& R, int& C) { const int st = b / 1024, sb = b % 1024, swz = sb ^ (((sb >> 9) & 1) << 5); R = (st >> 1) * 16 + swz / 64; C = (st & 1) * 32 + (swz % 64) / 2; }
struct Unit { int arow, nvalid, orow, pn, e, goff; };
struct DenseSched {
    static constexpr bool GATHER = false, HALF_SKIP = false;
    int nM, nN, nwg, G, c;
    DI void init(int M, int N) { nM = M / BM; nN = N / BM; nwg = nM * nN; G = gridDim.x; c = blockIdx.x; }
    DI bool next(int i, Unit& u) const {
        const long L = (long)i * G + c; if (L >= nwg) return false;
        int wgid = (int)L; { const int q = nwg / NXCD, r = nwg % NXCD, xcd = wgid % NXCD, off = wgid / NXCD; wgid = (xcd < r ? xcd * (q + 1) : r * (q + 1) + (xcd - r) * q) + off; }
        const int nig = WGM * nN, gid = wgid / nig, fm = gid * WGM, gsz = (nM - fm) < WGM ? (nM - fm) : WGM;
        const int pm = fm + ((wgid % nig) % gsz); u.pn = (wgid % nig) / gsz; u.arow = pm * BM; u.orow = pm * BM; u.nvalid = BM; u.e = 0; u.goff = 0; return true;
    }
};
template <bool GATH> struct MoeSched {
    static constexpr bool GATHER = GATH, HALF_SKIP = true;
    const LAS int* tab; int G, c;
    DI void init(const LAS int* t) { tab = t; G = gridDim.x; c = blockIdx.x; }
    DI bool next(int i, Unit& u) const {
        const int L = i * G + c, mtile = L >> 3; const int total = __builtin_amdgcn_readfirstlane(tab[32]);
        if (mtile >= total) return false;
        int e = 0; for (int j = 1; j < 32; ++j) { if (__builtin_amdgcn_readfirstlane(tab[j]) <= mtile) e = j; }
        const int mt = mtile - __builtin_amdgcn_readfirstlane(tab[e]); const int cn = __builtin_amdgcn_readfirstlane(tab[64 + e]);
        u.e = e; u.pn = L & 7; u.orow = mtile * BM; u.arow = mtile * BM; u.nvalid = (cn - mt * BM) < BM ? (cn - mt * BM) : BM; u.goff = e * ECAP + mt * BM; return true;
    }
};
DI void moe_tables(LAS int* tab, const int* cnt) {
    if (threadIdx.x == 0) { int run = 0; for (int e = 0; e < 32; ++e) { const int cn = cnt[e]; tab[e] = run; tab[64 + e] = cn; run += (cn + 255) >> 8; } tab[32] = run; }
    __syncthreads();
}

typedef int i32x8 __attribute__((ext_vector_type(8)));
typedef int i32x4 __attribute__((ext_vector_type(4)));
DI void mfma8(f32x4& acc, const i32x8& w8, const i32x8& x8, int ws, int as) {
    asm volatile("v_mfma_scale_f32_16x16x128_f8f6f4 %0, %1, %2, %0, %3, %4 op_sel_hi:[0,0,0]" : "+v"(acc) : "v"(w8), "v"(x8), "v"(ws), "v"(as)); }
template <class Epi, class Sched, bool FP8 = false>
DI void gemm_phase(LAS unsigned char* lds, const Params& p, const bf16_t* A, const bf16_t* Bt, size_t bt_estride, int K, const Sched& S, const Epi& E, int wscale = 0x7f7f7f7f, int ascale = 0x7f7f7f7f) {
    const int tid = opaque_tid(), wid = __builtin_amdgcn_readfirstlane(tid >> 6), lane = tid & 63, wr = wid >> 2, wc = wid & 3, fr = lane & 15, fq = lane >> 4;
    const int nt = K / BK;
    unsigned voffA[2], voffB[2];
#pragma unroll
    for (int i = 0; i < 2; ++i) { int R, C; stage_rc(tid * 16 + i * 8192, R, C); voffA[i] = (unsigned)(R * K + C) * 2u; voffB[i] = (unsigned)(((R & ~31) + perm32(R & 31)) * K + C) * 2u; }
    const size_t kstep = (size_t)(BK * 2), hstep = (size_t)HALF * K * 2, tstep = 2 * hstep;
    const unsigned ldsw = (unsigned)wid * 1024u;
    const int aoff = lds_byte(wr * 64 + fr, fq * 8), boff = lds_byte(wc * 32 + fr, fq * 8);
#define G_SA(b, h) (((b) * 2 + (h)) * HTB)
#define G_SB(b, h) ((4 + (b) * 2 + (h)) * HTB)
#define G_STAGE(bufoff, gbase, voff) do { _Pragma("unroll") for (int _i = 0; _i < 2; ++_i) \
        __builtin_amdgcn_global_load_lds((const unsigned*)((const char*)(gbase) + (voff)[_i]), (LAS unsigned*)(lds + (bufoff) + ldsw + _i * 8192), 16, 0, 0); } while (0)
#define G_STAGE_A(bufoff, ubase, gv, h, koff) do { if constexpr (Sched::GATHER) { G_STAGE(bufoff, (const char*)A + (koff), gv[h]); } else { G_STAGE(bufoff, (ubase) + (h) * hstep + (koff), voffA); } } while (0)
#define G_LD16(off_) (*(const LAS i32x4*)(lds + (off_)))
#define G_LD16B(off_) (*(const LAS bf16x8*)(lds + (off_)))
#define G_LDA(dst, b, h) do { _Pragma("unroll") for (int m = 0; m < 4; ++m) { if constexpr (FP8) dst##8[m] = __builtin_shufflevector(G_LD16(G_SA(b, h) + aoff + m * 2048), G_LD16(G_SA(b, h) + aoff + m * 2048 + 1024), 0, 1, 2, 3, 4, 5, 6, 7); \
        else { dst[m][0] = G_LD16B(G_SA(b, h) + aoff + m * 2048); dst[m][1] = G_LD16B(G_SA(b, h) + aoff + m * 2048 + 1024); } } } while (0)
#define G_LDB(dst, b, h) do { _Pragma("unroll") for (int n = 0; n < 2; ++n) { if constexpr (FP8) dst##8[n] = __builtin_shufflevector(G_LD16(G_SB(b, h) + boff + n * 2048), G_LD16(G_SB(b, h) + boff + n * 2048 + 1024), 0, 1, 2, 3, 4, 5, 6, 7); \
        else { dst[n][0] = G_LD16B(G_SB(b, h) + boff + n * 2048); dst[n][1] = G_LD16B(G_SB(b, h) + boff + n * 2048 + 1024); } } } while (0)
#define G_MMA(ai, bj, At, Bt_) do { __builtin_amdgcn_s_setprio(1); _Pragma("unroll") for (int m = 0; m < 4; ++m) _Pragma("unroll") for (int n = 0; n < 2; ++n) { \
        if constexpr (FP8) mfma8(acc[ai][bj][m][n], Bt_##8[n], At##8[m], wscale, ascale); \
        else { _Pragma("unroll") for (int k = 0; k < 2; ++k) acc[ai][bj][m][n] = __builtin_amdgcn_mfma_f32_16x16x32_bf16(Bt_[n][k], At[m][k], acc[ai][bj][m][n], 0, 0, 0); } } \
        __builtin_amdgcn_s_setprio(0); } while (0)
#define G_WAIT_V(n) asm volatile("s_waitcnt vmcnt(" #n ")" ::: "memory")
#define G_WAIT_L(n) asm volatile("s_waitcnt lgkmcnt(" #n ")" ::: "memory")
#define G_BAR __builtin_amdgcn_s_barrier()
#define G_SCHED __builtin_amdgcn_sched_barrier(0)
    Unit cur, nxt; int ui = 0;
    if (!S.next(0, cur)) return;
    f32x4 acc[2][2][4][2];
#pragma unroll
    for (int a = 0; a < 2; ++a)
#pragma unroll
        for (int b = 0; b < 2; ++b)
#pragma unroll
            for (int m = 0; m < 4; ++m)
#pragma unroll
                for (int n = 0; n < 2; ++n) acc[a][b][m][n] = (f32x4){0.f, 0.f, 0.f, 0.f};
    bf16x8 At[4][2], B0[2][2], B1[2][2]; i32x8 At8[4], B08[2], B18[2];
    unsigned gcur[2][2] = {{0u, 0u}, {0u, 0u}}, gnxt[2][2] = {{0u, 0u}, {0u, 0u}};
    auto gather_offs = [&](const Unit& u, unsigned (&g)[2][2]) {
        if constexpr (Sched::GATHER) {
#pragma unroll
            for (int h = 0; h < 2; ++h)
#pragma unroll
                for (int i = 0; i < 2; ++i) { int tz = tid; asm volatile("" : "+v"(tz)); int R, C; stage_rc(tz * 16 + i * 8192, R, C); const int r = h * HALF + R; const int tk = p.tokl[u.goff + (r < u.nvalid ? r : 0)]; const int tok = r < u.nvalid ? tk : 0; g[h][i] = (unsigned)(tok * K + C) * 2u; }
        }
    };
    const char* cA = (const char*)A + (size_t)(cur.arow / BM) * tstep; const char* cB = (const char*)Bt + ((size_t)cur.e * bt_estride) * 2 + (size_t)cur.pn * tstep;
    gather_offs(cur, gcur);
    G_STAGE(G_SB(0, 0), cB, voffB); G_STAGE_A(G_SA(0, 0), cA, gcur, 0, 0); G_STAGE(G_SB(0, 1), cB + hstep, voffB); G_STAGE_A(G_SA(0, 1), cA, gcur, 1, 0);
    if (wr == 1) G_BAR;
    G_WAIT_V(4); G_BAR;
    G_STAGE(G_SB(1, 0), cB + kstep, voffB); G_STAGE_A(G_SA(1, 0), cA, gcur, 0, kstep); G_STAGE(G_SB(1, 1), cB + hstep + kstep, voffB);
    G_WAIT_V(6); G_BAR;
    for (;;) {
        const bool has_next = S.next(ui + 1, nxt);
        const char* nA = has_next ? (const char*)A + (size_t)(nxt.arow / BM) * tstep : cA;
        const char* nB = has_next ? (const char*)Bt + ((size_t)nxt.e * bt_estride) * 2 + (size_t)nxt.pn * tstep : cB;
        if constexpr (Sched::GATHER) { if (has_next) gather_offs(nxt, gnxt); else {
#pragma unroll
            for (int h = 0; h < 2; ++h) { gnxt[h][0] = gcur[h][0]; gnxt[h][1] = gcur[h][1]; } } }
        for (int t = 0; t < nt; t += 2) {
            const bool last = (t == nt - 2);
            const size_t k1 = (size_t)(t + 1) * kstep;
            const char* a2 = last ? nA : cA; const char* b2 = last ? nB : cB + (size_t)(t + 2) * kstep;
            const size_t k2 = last ? 0 : (size_t)(t + 2) * kstep; const size_t k3 = k2 + kstep;
            const char* b3 = b2 + kstep;
            unsigned g2[2][2];
#pragma unroll
            for (int h = 0; h < 2; ++h) { g2[h][0] = last ? gnxt[h][0] : gcur[h][0]; g2[h][1] = last ? gnxt[h][1] : gcur[h][1]; }
            G_LDB(B0, 0, 0); G_SCHED; G_LDA(At, 0, 0); G_STAGE_A(G_SA(1, 1), cA, gcur, 1, k1);
            G_WAIT_L(8); G_BAR; G_WAIT_L(0); G_MMA(0, 0, At, B0); G_BAR; G_SCHED;
            G_LDB(B1, 0, 1); G_STAGE(G_SB(0, 0), b2, voffB);
            G_BAR; G_WAIT_L(0); G_MMA(0, 1, At, B1); G_BAR;
            G_LDA(At, 0, 1); G_STAGE_A(G_SA(0, 0), a2, g2, 0, k2);
            G_BAR; G_WAIT_L(0); if (!Sched::HALF_SKIP || cur.nvalid > HALF) G_MMA(1, 0, At, B0); G_BAR; G_SCHED;
            G_STAGE(G_SB(0, 1), b2 + hstep, voffB);
            G_WAIT_V(6); G_BAR; if (!Sched::HALF_SKIP || cur.nvalid > HALF) G_MMA(1, 1, At, B1); G_BAR;
            G_LDB(B0, 1, 0); G_SCHED; G_LDA(At, 1, 0); G_STAGE_A(G_SA(0, 1), a2, g2, 1, k2);
            G_WAIT_L(8); G_BAR; G_WAIT_L(0); G_MMA(0, 0, At, B0); G_BAR; G_SCHED;
            G_LDB(B1, 1, 1); G_STAGE(G_SB(1, 0), b3, voffB);
            G_BAR; G_WAIT_L(0); G_MMA(0, 1, At, B1); G_BAR;
            G_LDA(At, 1, 1); G_STAGE_A(G_SA(1, 0), a2, g2, 0, k3);
            G_BAR; G_WAIT_L(0); if (!Sched::HALF_SKIP || cur.nvalid > HALF) G_MMA(1, 0, At, B0); G_BAR; G_SCHED;
            G_STAGE(G_SB(1, 1), b3 + hstep, voffB);
            G_WAIT_V(6); G_BAR; if (!Sched::HALF_SKIP || cur.nvalid > HALF) G_MMA(1, 1, At, B1); G_BAR;
        }
        if constexpr (FP8) asm volatile("s_nop 15\n\ts_nop 15" ::: "memory");
        { GUnit gu; gu.rowbase = cur.orow; gu.nvalid = cur.nvalid; gu.e = cur.e; gu.gather = p.tokl + cur.goff;
          if constexpr (Epi::PRE) {
            const int col0 = cur.pn * BM + wc * 32 + fq * 8; const auto up = E.unit_pre(p, gu, col0);
#pragma unroll
            for (int ai = 0; ai < 2; ++ai) { typename Epi::Pre pr[4];
#pragma unroll
              for (int m = 0; m < 4; ++m) pr[m] = E.pre(p, gu, ai * HALF + wr * 64 + m * 16 + fr, col0);
              asm volatile("" ::: "memory");
#pragma unroll
              for (int m = 0; m < 4; ++m) { const int r = ai * HALF + wr * 64 + m * 16 + fr;
                if (!Sched::HALF_SKIP || r < cur.nvalid) E.fin(p, gu, r, col0, up, pr[m], acc[ai][0][m][0], acc[ai][0][m][1], acc[ai][1][m][0], acc[ai][1][m][1]); } }
          } else {
#pragma unroll
          for (int ai = 0; ai < 2; ++ai)
#pragma unroll
            for (int m = 0; m < 4; ++m) { const int r = ai * HALF + wr * 64 + m * 16 + fr;
              if (!Sched::HALF_SKIP || r < cur.nvalid) E(p, gu, r, cur.pn * BM + wc * 32 + fq * 8, acc[ai][0][m][0], acc[ai][0][m][1], acc[ai][1][m][0], acc[ai][1][m][1]); } } }
        if (!has_next) break;
#pragma unroll
        for (int a = 0; a < 2; ++a)
#pragma unroll
            for (int b = 0; b < 2; ++b)
#pragma unroll
                for (int m = 0; m < 4; ++m)
#pragma unroll
                    for (int n = 0; n < 2; ++n) acc[a][b][m][n] = (f32x4){0.f, 0.f, 0.f, 0.f};
        cur = nxt; cA = nA; cB = nB; ++ui;
#pragma unroll
        for (int h = 0; h < 2; ++h) { gcur[h][0] = gnxt[h][0]; gcur[h][1] = gnxt[h][1]; }
    }
    G_WAIT_V(0);
    if (wr == 0) G_BAR;
    G_BAR;
}
}

extern __shared__ __attribute__((aligned(16))) unsigned char dyn_smem[];
constexpr int LDS_BYTES = gm::STAGE_BYTES + 1024;

typedef __bf16 bf2v __attribute__((ext_vector_type(2)));
typedef float f32x2 __attribute__((ext_vector_type(2)));
typedef float f32x16 __attribute__((ext_vector_type(16)));
typedef short s16x4 __attribute__((ext_vector_type(4)));
typedef unsigned u32x4 __attribute__((ext_vector_type(4)));
DI unsigned pk2(float a, float b) { f32x2 v = {a, b}; bf2v r = __builtin_convertvector(v, bf2v); return __builtin_bit_cast(unsigned, r); }
DI float bflo(unsigned u) { return __uint_as_float(u << 16); }
DI float bfhi(unsigned u) { return __uint_as_float(u & 0xffff0000u); }

DI unsigned pk4_fp8(float a, float b, float c, float d, float sc) {
    a = __builtin_amdgcn_fmed3f(a * sc, -448.f, 448.f); b = __builtin_amdgcn_fmed3f(b * sc, -448.f, 448.f); c = __builtin_amdgcn_fmed3f(c * sc, -448.f, 448.f); d = __builtin_amdgcn_fmed3f(d * sc, -448.f, 448.f);
    unsigned w = 0u; w = __builtin_amdgcn_cvt_pk_fp8_f32(a, b, w, false); w = __builtin_amdgcn_cvt_pk_fp8_f32(c, d, w, true); return w; }
constexpr bool D8_IN0 = true, D8_OUT0 = true, D8_IN1 = false;
constexpr bool YB8 = true;
constexpr float Y8_SCALE = 64.f;
constexpr float W8_SCALE = 256.f, A8_SCALE = 8.f;
constexpr int W8_E8M0 = 0x77777777, A8_E8M0 = 0x7c7c7c7c;
namespace ph {
DI void mods(const Params& p, LAS unsigned char* lds) {
    const int tid = opaque_tid(), wave = tid >> 6, lane = tid & 63, l8 = tid & 7, rg = tid >> 3;
    LAS float* fl = (LAS float*)lds; LAS float* red = fl + 4 * DM;
    for (int i = tid; i < 4 * DM; i += 512) fl[i] = siluf_(p.c[i]);
    __syncthreads();
    for (int u = blockIdx.x; u < 768; u += gridDim.x) {
        const int l = u / 192, c32 = u % 192;
        const float* w = l == 0 ? p.ada0_mix_w : l == 1 ? p.ada0_ffn_w : l == 2 ? p.ada1_mix_w : p.ada1_ffn_w;
        const float* bs = l == 0 ? p.ada0_mix_b : l == 1 ? p.ada0_ffn_b : l == 2 ? p.ada1_mix_b : p.ada1_ffn_b;
        f32x4 acc[4] = {{0.f, 0.f, 0.f, 0.f}, {0.f, 0.f, 0.f, 0.f}, {0.f, 0.f, 0.f, 0.f}, {0.f, 0.f, 0.f, 0.f}};
        const float* wp = w + (size_t)rg * 6144 + c32 * 32 + l8 * 4;
#pragma unroll 8
        for (int i = 0; i < 32; ++i) { const f32x4 wv = *(const f32x4*)(wp + (size_t)(64 * i) * 6144); const int k = rg + 64 * i;
#pragma unroll
            for (int b = 0; b < 4; ++b) acc[b] += fl[b * DM + k] * wv; }
#pragma unroll
        for (int b = 0; b < 4; ++b)
#pragma unroll
            for (int j = 0; j < 4; ++j) { float v = acc[b][j]; v += __shfl_xor(v, 8); v += __shfl_xor(v, 16); v += __shfl_xor(v, 32); acc[b][j] = v; }
        if (lane < 8) {
#pragma unroll
            for (int b = 0; b < 4; ++b) *(LAS f32x4*)(red + (wave * 4 + b) * 32 + lane * 4) = acc[b]; }
        __syncthreads();
        if (tid < 128) { const int b = tid >> 5, col = tid & 31; float sum = 0.f;
#pragma unroll
            for (int w8 = 0; w8 < 8; ++w8) sum += red[(w8 * 4 + b) * 32 + col];
            p.mod[(l * 4 + b) * 6144 + c32 * 32 + col] = sum + bs[c32 * 32 + col]; }
        __syncthreads();
    }
}
constexpr int NT_UNITS = (640 + 256 + 672 + 336 + 2 * (8192 + 4096)) / 2;
struct UD { const float* sp; bf16_t* dst; int K, N, mode, e, kt, ntile; };
DI UD tdecode(const Params& p, int u, int lane) {
    const float* srcs[8] = {p.w_in0, p.w_out0, p.w_in1, p.w_out1, p.moe0_w_gate_up, p.moe0_w_down, p.moe1_w_gate_up, p.moe1_w_down};
    bf16_t* dsts[8] = {p.w_in0t, p.w_out0t, p.w_in1t, p.w_out1t, p.w_gut0, p.w_dt0, p.w_gut1, p.w_dt1};
    constexpr int Ks[8] = {DM, DM, DM, LRU_W, DM, EFF, DM, EFF}, Ns[8] = {N_IN0, DM, N_IN1, DM, 2048, DM, 2048, DM}, nus[8] = {320, 128, 336, 168, 4096, 2048, 4096, 2048};
    constexpr int modes[8] = {D8_IN0 ? 2 : 0, D8_OUT0 ? 2 : 0, D8_IN1 ? 2 : 0, 0, 3, 2, 3, 2};
    int v = u, mi = 0;
#pragma unroll
    for (int m = 0; m < 8; ++m) { if (mi == m && v >= nus[m]) { v -= nus[m]; mi = m + 1; } }
    UD d; const float* src = srcs[0]; d.dst = dsts[0]; d.K = Ks[0]; d.N = Ns[0]; d.mode = modes[0];
#pragma unroll
    for (int m = 1; m < 8; ++m) if (mi == m) { src = srcs[m]; d.dst = dsts[m]; d.K = Ks[m]; d.N = Ns[m]; d.mode = modes[m]; }
    const int ntl = d.N / 256, ktl = d.K / 128; d.e = v / (ktl * ntl); const int rem = v % (ktl * ntl); d.kt = rem / ntl; d.ntile = rem % ntl;
    d.sp = src + (size_t)d.e * d.K * d.N + (size_t)(d.kt * 128) * d.N + d.ntile * 256 + lane * 4;
    return d;
}
DI void transposer(const Params& p, LAS unsigned char* lds, int first, int count, int stride) {
    const int tid = opaque_tid(), wave = tid >> 6, lane = tid & 63;
    LAS float* fl = (LAS float*)lds;
    if (count <= 0) return;
    if (tdecode(p, first, lane).mode & 2) {
        LAS unsigned* td = (LAS unsigned*)lds;
        const int nl = lane & 15, ks = lane >> 4;
        auto src_of = [&](const UD& d, int g, int j) -> const float* { const int kq = 4 * (g >> 2) + ks, nq = 16 * (g & 3) + nl; return d.sp - lane * 4 + (size_t)(4 * kq + j) * d.N + 4 * nq; };
        f32x4 va[4][4], vb[4][4];
        auto load_unit = [&](int u, f32x4 (&v)[4][4]) { const UD dd = tdecode(p, u, lane);
#pragma unroll
            for (int i = 0; i < 4; ++i)
#pragma unroll
                for (int j = 0; j < 4; ++j) v[i][j] = *(const f32x4*)src_of(dd, wave * 4 + i, j); };
        auto process = [&](int jn, f32x4 (&v)[4][4]) { const int u = first + jn * stride;
            const UD d = tdecode(p, u, lane); const int K = d.K, N = d.N, mode = d.mode, e = d.e, kt = d.kt, ntile = d.ntile;
            LAS unsigned* tile = td + (jn & 1) * (256 * 33);
#pragma unroll
            for (int i = 0; i < 4; ++i) { const int g = wave * 4 + i, kq = 4 * (g >> 2) + ks, nq = 16 * (g & 3) + nl;
#pragma unroll
                for (int en = 0; en < 4; ++en) tile[(4 * nq + en) * 33 + kq] = pk4_fp8(v[i][0][en], v[i][1][en], v[i][2][en], v[i][3][en], W8_SCALE); }
            __syncthreads();
            if (jn + 2 < count) load_unit(u + 2 * stride, v);
            { const int n = tid >> 1, kh = tid & 1; const int ng = ntile * 256 + n; const int jg = ng & 1023; const int np = (mode & 1) ? (256 * (jg >> 7) + (ng < 1024 ? 0 : 128) + (jg & 127)) : ng;
              unsigned char* dp = (unsigned char*)d.dst + (size_t)e * N * K + (size_t)np * K + kt * 128 + kh * 64;
#pragma unroll
              for (int jj = 0; jj < 4; ++jj) { const LAS unsigned* tp = tile + n * 33 + kh * 16 + jj * 4; *(uint4*)(dp + jj * 16) = make_uint4(tp[0], tp[1], tp[2], tp[3]); } } };
        load_unit(first, va); if (count > 1) load_unit(first + stride, vb);
        for (int jn = 0; jn < count; jn += 2) { process(jn, va); if (jn + 1 < count) process(jn + 1, vb); }
        __syncthreads();
        return;
    }
    f32x4 vv[16];
    { const UD d0 = tdecode(p, first, lane);
#pragma unroll
        for (int i = 0; i < 16; ++i) vv[i] = *(const f32x4*)(d0.sp + (size_t)(i * 8 + wave) * d0.N); }
    for (int j = 0; j < count; ++j) { const int u = first + j * stride;
        const UD d = tdecode(p, u, lane); const int K = d.K, N = d.N, mode = d.mode, e = d.e, kt = d.kt, ntile = d.ntile; bf16_t* dst = d.dst;
#pragma unroll
        for (int i = 0; i < 16; ++i) { LAS float* tp = fl + (i * 8 + wave) * 257 + lane * 4; tp[0] = vv[i][0]; tp[1] = vv[i][1]; tp[2] = vv[i][2]; tp[3] = vv[i][3]; }
        __syncthreads();
        if (j + 1 < count) { const UD dn = tdecode(p, u + stride, lane);
#pragma unroll
            for (int i = 0; i < 16; ++i) vv[i] = *(const f32x4*)(dn.sp + (size_t)(i * 8 + wave) * dn.N); }
        { const int n = tid >> 1, kh = tid & 1; const int ng = ntile * 256 + n; const int jg = ng & 1023; const int np = (mode & 1) ? (256 * (jg >> 7) + (ng < 1024 ? 0 : 128) + (jg & 127)) : ng;
          bf16_t* dp = dst + (size_t)e * N * K + (size_t)np * K + kt * 128 + kh * 64;
#pragma unroll
          for (int jj = 0; jj < 8; ++jj) { unsigned w4[4];
#pragma unroll
              for (int q = 0; q < 4; ++q) { const int k = kh * 64 + jj * 8 + q * 2; w4[q] = pk2(fl[k * 257 + n], fl[(k + 1) * 257 + n]); }
              *(uint4*)(dp + jj * 8) = make_uint4(w4[0], w4[1], w4[2], w4[3]); } }
        __syncthreads();
    }
}
DI void lru_weights(const Params& p) {
    const int tid = opaque_tid();
    for (size_t i = (size_t)blockIdx.x * 512 + tid; i < (size_t)2 * 2 * 16 * 4 * 48 * 192; i += (size_t)gridDim.x * 512) {
        const int k = i % 192, j = (i / 192) % 48, qt = (i / (192 * 48)) % 4, n = (i / (192 * 48 * 4)) % 16, which = (i / (192 * 48 * 4 * 16)) % 2, dir = i / (192 * 48 * 4 * 16 * 2);
        const float* w = which == 0 ? p.lru_w_a : p.lru_w_x; float v = 0.f;
        if (j < 42 && k < 168) v = w[(((size_t)dir * 16 + n) * 168 + k) * 168 + qt * 42 + j];
        p.w_lru[i] = f2bf(v);
    }
}
DI void fold_router(const Params& p) {
    const int tid = opaque_tid(), wave = tid >> 6, lane = tid & 63;
    for (size_t i = (size_t)blockIdx.x * 512 + tid; i < (size_t)2 * 4 * 48 * DM; i += (size_t)gridDim.x * 512) {
        const int k = i % DM, n = (i / DM) % 48, b = (i / (DM * 48)) % 4, l = i / (DM * 48 * 4);
        const float* g = l == 0 ? p.norm0_ffn : p.norm1_ffn; const float* md = p.mod + ((l == 0 ? 1 : 3) * 4 + b) * 6144;
        const float* we = l == 0 ? p.moe0_w_expert : p.moe1_w_expert; const float* wg = l == 0 ? p.moe0_w_group : p.moe1_w_group;
        const float w = n < 32 ? we[k * 32 + n] : n < 36 ? wg[k * 4 + (n - 32)] : 0.f;
        const float wf = g[k] * (1.f + md[2048 + k]) * w;
        const bf16_t hi = f2bf(wf); const float r1 = wf - bf2f(hi); const bf16_t mid = f2bf(r1); const bf16_t lo = f2bf(r1 - bf2f(mid));
        bf16_t* dst = p.wrt + ((size_t)((l * 4 + b) * 3) * 48 + n) * DM + k;
        dst[0] = hi; dst[(size_t)48 * DM] = mid; dst[(size_t)96 * DM] = lo;
    }
    for (int task = blockIdx.x * 8 + wave; task < 2 * 4 * 48; task += gridDim.x * 8) {
        const int n = task % 48, b = (task / 48) % 4, l = task / (48 * 4);
        const float* md = p.mod + ((l == 0 ? 1 : 3) * 4 + b) * 6144;
        const float* we = l == 0 ? p.moe0_w_expert : p.moe1_w_expert; const float* wg = l == 0 ? p.moe0_w_group : p.moe1_w_group;
        float part = 0.f;
        for (int k = lane; k < DM; k += 64) { const float w = n < 32 ? we[k * 32 + n] : n < 36 ? wg[k * 4 + (n - 32)] : 0.f; part += md[k] * w; }
        part = wave_sum(part); if (lane == 0) p.rbias[task] = part;
    }
}
template <int MODE, bool OUT8 = false> DI void norm_rows(const Params& p, const float* xin  , const float* gain, int lmod, int lgate, const LAS int* tab) {
    const int tid = opaque_tid(), wave = tid >> 6, lane = tid & 63;
    f32x4 gn[8];
#pragma unroll
    for (int i = 0; i < 8; ++i) gn[i] = *(const f32x4*)(gain + i * 256 + lane * 4);
    for (int row = blockIdx.x * 8 + wave; row < T_TOK; row += gridDim.x * 8) {
        const int b = row / SEQ;
        int a0 = 0, a1 = 0;
        if constexpr (MODE >= 1) { a0 = p.asg[row * 2]; a1 = p.asg[row * 2 + 1]; }
        f32x4 v[8]; uint2 vr[8];
        if (xin) {
#pragma unroll
            for (int i = 0; i < 8; ++i) v[i] = *(const f32x4*)(xin + (size_t)row * DM + i * 256 + lane * 4);
        } else {
#pragma unroll
            for (int i = 0; i < 8; ++i) vr[i] = *(const uint2*)(p.XA + (size_t)row * DM + i * 256 + lane * 4);
        }
        f32x4 gq[8], sc[8], sh[8];
        if constexpr (MODE >= 1) { const float* gt = p.mod + (lgate * 4 + b) * 6144 + 4096;
#pragma unroll
            for (int i = 0; i < 8; ++i) gq[i] = *(const f32x4*)(gt + i * 256 + lane * 4); }
        if constexpr (MODE != 2) { const float* md = p.mod + (lmod * 4 + b) * 6144;
#pragma unroll
            for (int i = 0; i < 8; ++i) { sc[i] = *(const f32x4*)(md + 2048 + i * 256 + lane * 4); sh[i] = *(const f32x4*)(md + i * 256 + lane * 4); } }
        if (!xin) {
#pragma unroll
            for (int i = 0; i < 8; ++i) v[i] = (f32x4){bflo(vr[i].x), bfhi(vr[i].x), bflo(vr[i].y), bfhi(vr[i].y)};
        }
        if constexpr (MODE >= 1) {
            const size_t r0 = (size_t)tab[a0 >> 14] * 256 + (a0 & 16383), r1 = (size_t)tab[a1 >> 14] * 256 + (a1 & 16383);
            if constexpr (YB8) { unsigned y0[8], y1[8];
#pragma unroll
                for (int i = 0; i < 8; ++i) { const int col = i * 256 + lane * 4; y0[i] = *(const unsigned*)((const unsigned char*)p.YB + r0 * DM + col); y1[i] = *(const unsigned*)((const unsigned char*)p.YB + r1 * DM + col); }
#pragma unroll
                for (int i = 0; i < 8; ++i) {
                    const f32x2 c0 = __builtin_amdgcn_cvt_pk_f32_fp8(y0[i], false), c1 = __builtin_amdgcn_cvt_pk_f32_fp8(y0[i], true), d0 = __builtin_amdgcn_cvt_pk_f32_fp8(y1[i], false), d1 = __builtin_amdgcn_cvt_pk_f32_fp8(y1[i], true);
                    const f32x4 g4 = gq[i] * (1.f / Y8_SCALE);
                    v[i][0] += g4[0] * (c0[0] + d0[0]); v[i][1] += g4[1] * (c0[1] + d0[1]); v[i][2] += g4[2] * (c1[0] + d1[0]); v[i][3] += g4[3] * (c1[1] + d1[1]); } }
            else {
#pragma unroll
                for (int i = 0; i < 8; ++i) { const int col = i * 256 + lane * 4; const f32x4 g4 = gq[i]; const uint2 y0 = *(const uint2*)(p.YB + r0 * DM + col), y1 = *(const uint2*)(p.YB + r1 * DM + col);
                v[i][0] += g4[0] * (bflo(y0.x) + bflo(y1.x)); v[i][1] += g4[1] * (bfhi(y0.x) + bfhi(y1.x));
                v[i][2] += g4[2] * (bflo(y0.y) + bflo(y1.y)); v[i][3] += g4[3] * (bfhi(y0.y) + bfhi(y1.y)); } }
            if constexpr (MODE == 1) {
#pragma unroll
                for (int i = 0; i < 8; ++i) { const uint2 w = make_uint2(pk2(v[i][0], v[i][1]), pk2(v[i][2], v[i][3])); *(uint2*)(p.XA + (size_t)row * DM + i * 256 + lane * 4) = w;
                    v[i] = (f32x4){bflo(w.x), bfhi(w.x), bflo(w.y), bfhi(w.y)}; }
            }
        }
        float ss = 0.f;
#pragma unroll
        for (int i = 0; i < 8; ++i) ss += v[i][0] * v[i][0] + v[i][1] * v[i][1] + v[i][2] * v[i][2] + v[i][3] * v[i][3];
        ss = wave_sum(ss); const float rstd = rsqrtf(ss * (1.0f / DM) + 1e-6f);
        if constexpr (MODE == 2) {
#pragma unroll
            for (int i = 0; i < 8; ++i) { const int col = i * 256 + lane * 4; *(f32x4*)(p.out + (size_t)row * DM + col) = v[i] * rstd * gn[i]; }
        } else {
#pragma unroll
            for (int i = 0; i < 8; ++i) { const int col = i * 256 + lane * 4;
                const f32x4 h = v[i] * rstd * gn[i] * (1.f + sc[i]) + sh[i];
                if constexpr (OUT8) *(unsigned*)((unsigned char*)p.H + (size_t)row * DM + col) = pk4_fp8(h[0], h[1], h[2], h[3], A8_SCALE);
                else *(uint2*)(p.H + (size_t)row * DM + col) = make_uint2(pk2(h[0], h[1]), pk2(h[2], h[3])); } }
    }
}
template <bool DRY = false, bool NORM = false> DI void router(const Params& p, int l, LAS unsigned char* lds, const float* gain = nullptr, int lmod = 0) {
    const int tid = opaque_tid(), wave = __builtin_amdgcn_readfirstlane(tid >> 6), lane = tid & 63;
    LAS float* lg = (LAS float*)lds + (wave & 3) * (16 * 48);
    LAS float* rsl = (LAS float*)lds + 4 * 16 * 48 + (wave & 3) * 16;
    LAS f32x4* part = (LAS f32x4*)(lds + 16384);
    LAS float* ssp = (LAS float*)(lds + 16384 + 98304);
    for (int tg = blockIdx.x; tg < T_TOK / 64; tg += gridDim.x) {
        const int b = (tg * 64) / SEQ, r = lane & 15, q = lane >> 4;
        const bf16_t* xa = p.XA + (size_t)(tg * 64 + r) * DM + wave * 256 + 8 * q;
        const bf16_t* wt = p.wrt + ((size_t)((l * 4 + b) * 3) * 48 + r) * DM + wave * 256 + 8 * q;
        f32x4 acc[4][3]; float ss[4] = {0.f, 0.f, 0.f, 0.f};
#pragma unroll
        for (int t = 0; t < 4; ++t)
#pragma unroll
            for (int n = 0; n < 3; ++n) acc[t][n] = (f32x4){0.f, 0.f, 0.f, 0.f};
        u32x4 aA[4], aB[4], bA[9], bB[9];
        auto ld = [&](int st, u32x4 (&aa)[4], u32x4 (&bb)[9]) {
#pragma unroll
            for (int t = 0; t < 4; ++t) aa[t] = *(const u32x4*)(xa + (size_t)t * 16 * DM + st * 32);
#pragma unroll
            for (int i = 0; i < 9; ++i) bb[i] = *(const u32x4*)(wt + (size_t)i * 16 * DM + st * 32); };
        auto mm = [&](const u32x4 (&aa)[4], const u32x4 (&bb)[9]) {
#pragma unroll
            for (int t = 0; t < 4; ++t) {
#pragma unroll
                for (int e = 0; e < 4; ++e) { const float x0 = bflo(aa[t][e]), x1 = bfhi(aa[t][e]); ss[t] += x0 * x0 + x1 * x1; }
#pragma unroll
                for (int i = 0; i < 9; ++i) acc[t][i % 3] = __builtin_amdgcn_mfma_f32_16x16x32_bf16(__builtin_bit_cast(bf16x8, aa[t]), __builtin_bit_cast(bf16x8, bb[i]), acc[t][i % 3], 0, 0, 0); } };
        ld(0, aA, bA);
        for (int st = 0; st < 8; st += 2) {
            ld(st + 1, aB, bB);
            mm(aA, bA);
            if (st + 2 < 8) ld(st + 2, aA, bA);
            mm(aB, bB);
        }
#pragma unroll
        for (int t = 0; t < 4; ++t) {
#pragma unroll
            for (int n = 0; n < 3; ++n) part[((wave * 4 + t) * 3 + n) * 64 + lane] = acc[t][n];
            float sq = ss[t]; sq += __shfl_xor(sq, 16); sq += __shfl_xor(sq, 32);
            if (q == 0) ssp[(wave * 4 + t) * 16 + r] = sq; }
        __syncthreads();
        if (wave < 4) {
        const int tile = tg * 4 + wave, row0 = tile * 16;
        f32x4 a3[3] = {{0.f, 0.f, 0.f, 0.f}, {0.f, 0.f, 0.f, 0.f}, {0.f, 0.f, 0.f, 0.f}}; float ssr = 0.f;
#pragma unroll
        for (int w2 = 0; w2 < 8; ++w2) {
#pragma unroll
            for (int n = 0; n < 3; ++n) a3[n] += part[((w2 * 4 + wave) * 3 + n) * 64 + lane];
            ssr += ssp[(w2 * 4 + wave) * 16 + r]; }
        const float rstd = rsqrtf(ssr * (1.0f / DM) + 1e-6f);
        if (NORM && q == 0) rsl[r] = rstd;
#pragma unroll
        for (int j = 0; j < 4; ++j) { const float rs = __shfl(rstd, 4 * q + j);
#pragma unroll
            for (int n = 0; n < 3; ++n) lg[(4 * q + j) * 48 + n * 16 + r] = a3[n][j] * rs + p.rbias[(l * 4 + b) * 48 + n * 16 + r]; }
        __builtin_amdgcn_wave_barrier();
        if (!DRY && lane < 16) {
            const LAS float* L = lg + lane * 48; const int tok = row0 + lane;
            int gs = 0; float gm = L[32];
#pragma unroll
            for (int g = 1; g < 4; ++g) if (L[32 + g] > gm) { gm = L[32 + g]; gs = g; }
            float gden = 0.f;
#pragma unroll
            for (int g = 0; g < 4; ++g) gden += __expf(L[32 + g] - gm);
            const float gprob = 1.0f / gden;
            int i0 = 0; float v0 = L[gs * 8];
            for (int j = 1; j < 8; ++j) { const float x = L[gs * 8 + j]; if (x > v0) { v0 = x; i0 = j; } }
            int i1 = -1; float v1 = -3.4e38f;
            for (int j = 0; j < 8; ++j) { const float x = L[gs * 8 + j]; if (j != i0 && x > v1) { v1 = x; i1 = j; } }
            const float e1 = __expf(v1 - v0), g0 = gprob / (1.f + e1), g1 = gprob * e1 / (1.f + e1);
            const int ea = gs * 8 + i0, eb = gs * 8 + i1;
            const int sa = atomicAdd(&p.cnt[l * 32 + ea], 1), sb = atomicAdd(&p.cnt[l * 32 + eb], 1);
            p.tokl[ea * ECAP + sa] = tok; p.gatel[ea * ECAP + sa] = g0; p.tokl[eb * ECAP + sb] = tok; p.gatel[eb * ECAP + sb] = g1;
            p.asg[tok * 2] = (ea << 14) | sa; p.asg[tok * 2 + 1] = (eb << 14) | sb;
        }
        }
        __syncthreads();
        if constexpr (NORM) {
            const int kh = wave >> 2, row0 = (tg * 4 + (wave & 3)) * 16;
            const float* md = p.mod + (lmod * 4 + b) * 6144;
            f32x4 g4[8], sc[8], sh[8];
#pragma unroll
            for (int i = 0; i < 8; ++i) { const int col = i * 256 + lane * 4; g4[i] = *(const f32x4*)(gain + col); sc[i] = 1.f + *(const f32x4*)(md + 2048 + col); sh[i] = *(const f32x4*)(md + col); g4[i] *= sc[i]; }
            for (int j0 = 0; j0 < 8; j0 += 4) {
                uint2 ar[4][8];
#pragma unroll
                for (int jj = 0; jj < 4; ++jj)
#pragma unroll
                    for (int i = 0; i < 8; ++i) ar[jj][i] = *(const uint2*)(p.XA + (size_t)(row0 + kh * 8 + j0 + jj) * DM + i * 256 + lane * 4);
                asm volatile("" ::: "memory");
#pragma unroll
                for (int jj = 0; jj < 4; ++jj) { const int row = row0 + kh * 8 + j0 + jj; const float rs = rsl[kh * 8 + j0 + jj];
#pragma unroll
                    for (int i = 0; i < 8; ++i) { const int col = i * 256 + lane * 4; const f32x4 v = {bflo(ar[jj][i].x), bfhi(ar[jj][i].x), bflo(ar[jj][i].y), bfhi(ar[jj][i].y)};
                        const f32x4 h = v * rs * g4[i] + sh[i];
                        *(unsigned*)((unsigned char*)p.H + (size_t)row * DM + col) = pk4_fp8(h[0], h[1], h[2], h[3], A8_SCALE); } } }
            __syncthreads();
        }
    }
}
DI void conv_gln(const Params& p, LAS unsigned char* lds) {
    const int tid = opaque_tid(), wave = tid >> 6, lane = tid & 63;
    LAS float* at = (LAS float*)lds;
    u32x4 rv[3], rg[3];
    auto load_raw = [&](int u) { const int g = u & 7, t0 = ((u >> 3) & 63) * 64, b = u >> 9;
#pragma unroll
        for (int i = 0; i < 3; ++i) { const int idx = tid + 512 * i, rr = idx >> 4, c8 = idx & 15, t = t0 - 15 + rr; rv[i] = (u32x4){0u, 0u, 0u, 0u}; rg[i] = (u32x4){0u, 0u, 0u, 0u};
            if (idx < 94 * 16 && t >= 0 && t < SEQ) { const bf16_t* row = p.G + (size_t)(b * SEQ + t) * N_IN0 + g * 128 + c8 * 8; rv[i] = *(const u32x4*)row; rg[i] = *(const u32x4*)(row + 1024); } } };
    int gcur = -1; f32x2 wk[31], bias = {0.f, 0.f}, gam = {0.f, 0.f}, bet = {0.f, 0.f};
    if ((int)blockIdx.x < 2048) load_raw(blockIdx.x);
    for (int u = blockIdx.x; u < 2048; u += gridDim.x) {
        const int g = u & 7, t0 = ((u >> 3) & 63) * 64, b = u >> 9;
        const int ch = g * 128 + 2 * lane;
        if (g != gcur) { gcur = g;
#pragma unroll
            for (int k = 0; k < 31; ++k) wk[k] = *(const f32x2*)(p.conv_w + k * 1024 + ch);
            bias = *(const f32x2*)(p.conv_b + ch); gam = *(const f32x2*)(p.conv_norm_g + ch); bet = *(const f32x2*)(p.conv_norm_b + ch); }
#pragma unroll
        for (int i = 0; i < 3; ++i) { const int idx = tid + 512 * i, rr = idx >> 4, c8 = idx & 15;
            if (idx < 94 * 16) { const u32x4 v = rv[i], gg = rg[i];
                const f32x4 lo = {bflo(v[0]) * sigmoidf_(bflo(gg[0])), bfhi(v[0]) * sigmoidf_(bfhi(gg[0])), bflo(v[1]) * sigmoidf_(bflo(gg[1])), bfhi(v[1]) * sigmoidf_(bfhi(gg[1]))};
                const f32x4 hi = {bflo(v[2]) * sigmoidf_(bflo(gg[2])), bfhi(v[2]) * sigmoidf_(bfhi(gg[2])), bflo(v[3]) * sigmoidf_(bflo(gg[3])), bfhi(v[3]) * sigmoidf_(bfhi(gg[3]))};
                *(LAS f32x4*)(at + rr * 132 + c8 * 8) = lo; *(LAS f32x4*)(at + rr * 132 + c8 * 8 + 4) = hi; } }
        __syncthreads();
        if (u + (int)gridDim.x < 2048) load_raw(u + gridDim.x);
        f32x2 acc[8];
#pragma unroll
        for (int j = 0; j < 8; ++j) acc[j] = bias;
#pragma unroll
        for (int rr = 0; rr < 38; ++rr) { const f32x2 a2 = *(const LAS f32x2*)(at + (wave * 8 + rr) * 132 + 2 * lane);
#pragma unroll
            for (int j = 0; j < 8; ++j) { const int k = rr - j; if (k >= 0 && k < 31) acc[j] += wk[k] * a2; } }
#pragma unroll
        for (int j = 0; j < 8; ++j) { const float mu = wave_sum(acc[j][0] + acc[j][1]) * (1.f / 128.f); const float d0 = acc[j][0] - mu, d1 = acc[j][1] - mu;
            const float var = wave_sum(d0 * d0 + d1 * d1) * (1.f / 128.f); const float rs = rsqrtf(var + 1e-6f);
            const float y0 = d0 * rs * gam[0] + bet[0], y1 = d1 * rs * gam[1] + bet[1];
            if constexpr (D8_OUT0) *(unsigned short*)((unsigned char*)p.AO + (size_t)(b * SEQ + t0 + wave * 8 + j) * DM + ch) = (unsigned short)(pk4_fp8(siluf_(y0), siluf_(y1), 0.f, 0.f, A8_SCALE) & 0xffffu);
            else *(unsigned*)(p.AO + (size_t)(b * SEQ + t0 + wave * 8 + j) * DM + ch) = pk2(siluf_(y0), siluf_(y1)); }
        __syncthreads();
    }
}
DI unsigned off_b(unsigned row, unsigned ch) { return 256u * row + 16u * (ch ^ (((row & 3u) << 2) | ((row >> 2) & 3u))); }
DI void tr_read4(unsigned a0, unsigned a1, s16x4& r00, s16x4& r01, s16x4& r10, s16x4& r11) {
    asm volatile("ds_read_b64_tr_b16 %0, %4\n\tds_read_b64_tr_b16 %1, %5\n\tds_read_b64_tr_b16 %2, %4 offset:4096\n\tds_read_b64_tr_b16 %3, %5 offset:4096\n\ts_waitcnt lgkmcnt(0)"
                 : "=&v"(r00), "=&v"(r01), "=&v"(r10), "=&v"(r11) : "v"(a0), "v"(a1) : "memory");
}
template <int PASS> DI void attn_wave(const Params& p, LAS unsigned char* vimg, unsigned vb0, unsigned vb1, int lane_, int b, int h, int qbase  ) {
    int lane = lane_; asm volatile("" : "+v"(lane));
    const int c = lane & 31, hh = lane >> 5, srow = lane >> 4, sch = lane & 15;
    constexpr int QS = PASS == 0 ? 16 : 1, NT = PASS == 0 ? 13 : 5;
    const int tq = qbase + QS * c;
    const bf16_t* gb = p.G + (size_t)(b * SEQ) * N_IN0; const bf16_t* kb = p.KVH + (size_t)((b * 8 + h) * 2) * SEQ * 128;
    bf16_t* st_o = p.YB + ((size_t)(b * 8 + h) * SEQ + tq) * 128;
    float* st_ml = (float*)(p.YB + (size_t)NBATCH * 8 * SEQ * 128) + ((size_t)(b * 8 + h) * SEQ + tq) * 2;
    bf16x8 qf[8];
#pragma unroll
    for (int ks = 0; ks < 8; ++ks) qf[ks] = *(const bf16x8*)(gb + (size_t)tq * N_IN0 + 2048 + h * 128 + 16 * ks + 8 * hh);
    const float sc2 = 0.08838834764831845f * 1.4426950408889634f, sl2 = exp2f(-(float)(h + 1)) * 1.4426950408889634f;
    f32x16 o[4]; float m_run, l_run;
    if constexpr (PASS == 0) {
#pragma unroll
        for (int i = 0; i < 4; ++i)
#pragma unroll
            for (int j = 0; j < 16; ++j) o[i][j] = 0.f;
        m_run = -30000.f; l_run = 0.f;
    } else {
#pragma unroll
        for (int c4 = 0; c4 < 4; ++c4)
#pragma unroll
            for (int g4 = 0; g4 < 4; ++g4) { const uint2 v = *(const uint2*)(st_o + 32 * c4 + 8 * g4 + 4 * hh); o[c4][4 * g4] = bflo(v.x); o[c4][4 * g4 + 1] = bfhi(v.x); o[c4][4 * g4 + 2] = bflo(v.y); o[c4][4 * g4 + 3] = bfhi(v.y); }
        const f32x2 ml = *(const f32x2*)st_ml; m_run = ml[0]; l_run = hh == 0 ? ml[1] : 0.f;
    }
    auto tile_geom = [&](int tile, int& d, int& sb) { if constexpr (PASS == 0) { if (tile < 5) { d = 16; sb = qbase - 1024 + 512 * tile; } else { d = 4; sb = qbase - 256 + 128 * (tile - 5); } } else { d = 1; sb = qbase - 64 + 32 * tile; } };
    auto load_k = [&](int tile, bf16x8 (&kf)[8]) { int d, sb; tile_geom(tile, d, sb); int sp = sb + d * c; sp = sp < 0 ? 0 : (sp >= SEQ ? SEQ - 1 : sp);
        const bf16_t* src = kb + (unsigned)(sp * 128 + 8 * hh);
#pragma unroll
        for (int ks = 0; ks < 8; ++ks) kf[ks] = *(const bf16x8*)(src + 16 * ks); };
    auto load_v = [&](int tile, u32x4 (&vv)[8]) { int d, sb; tile_geom(tile, d, sb);
#pragma unroll
        for (int i = 0; i < 8; ++i) { int sp = sb + d * (srow + 4 * i); sp = sp < 0 ? 0 : (sp >= SEQ ? SEQ - 1 : sp); vv[i] = *(const u32x4*)(kb + (unsigned)(SEQ * 128 + sp * 128 + sch * 8)); } };
    bf16x8 kf[8]; u32x4 vv[8];
    load_k(0, kf); load_v(0, vv);
    for (int tile = 0; tile < NT; ++tile) {
        int d, sb; tile_geom(tile, d, sb);
        const int tn = tile < NT - 1 ? tile + 1 : NT - 1;
#pragma unroll
        for (int i = 0; i < 8; ++i) *(LAS u32x4*)(vimg + off_b(srow + 4 * i, sch)) = vv[i];
        load_v(tn, vv);
        f32x16 sacc;
#pragma unroll
        for (int j = 0; j < 16; ++j) sacc[j] = 0.f;
#pragma unroll
        for (int ks = 0; ks < 8; ++ks) sacc = __builtin_amdgcn_mfma_f32_32x32x16_bf16(kf[ks], qf[ks], sacc, 0, 0, 0);
        load_k(tn, kf);
        const float df = (float)d, basef = (float)(sb - tq) + df * (float)(4 * hh);
        const float lo = fmaxf(-64.f * df, -(float)tq), hi = fminf(64.f * df, (float)(SEQ - 1 - tq));
        const float mid = 0.5f * (lo + hi), half = 0.5f * (hi - lo);
        float tmax = -1e30f;
#pragma unroll
        for (int i = 0; i < 16; ++i) { const float deltaf = basef + df * (float)((i & 3) + 8 * (i >> 2));
            const bool valid = __builtin_fabsf(deltaf - mid) <= half;
            const float sv = valid ? sacc[i] * sc2 - sl2 * __builtin_fabsf(deltaf) : -1e30f; sacc[i] = sv; tmax = fmaxf(tmax, sv); }
        tmax = fmaxf(tmax, __shfl_xor(tmax, 32));
        const float m_new = tmax > m_run + 8.0f ? tmax : m_run;
        if (__any(m_new != m_run)) { const float alpha = __builtin_amdgcn_exp2f(m_run - m_new);
            l_run *= alpha;
#pragma unroll
            for (int i = 0; i < 4; ++i) o[i] *= alpha; }
        m_run = m_new;
        float psum = 0.f;
#pragma unroll
        for (int i = 0; i < 16; ++i) { const float pi = __builtin_amdgcn_exp2f(sacc[i] - m_new); psum += pi; sacc[i] = pi; }
        l_run += psum;
        bf16x8 pf[2];
#pragma unroll
        for (int s = 0; s < 2; ++s) { const unsigned w0 = pk2(sacc[8 * s], sacc[8 * s + 1]), w1 = pk2(sacc[8 * s + 2], sacc[8 * s + 3]), w2 = pk2(sacc[8 * s + 4], sacc[8 * s + 5]), w3 = pk2(sacc[8 * s + 6], sacc[8 * s + 7]);
            pf[s] = __builtin_bit_cast(bf16x8, (u32x4){w0, w1, w2, w3}); }
#pragma unroll
        for (int c4 = 0; c4 < 4; ++c4) {
            s16x4 r00, r01, r10, r11; tr_read4(vb0 ^ (unsigned)(c4 << 6), vb1 ^ (unsigned)(c4 << 6), r00, r01, r10, r11);
            const bf16x8 v0 = __builtin_shufflevector(r00, r01, 0, 1, 2, 3, 4, 5, 6, 7), v1 = __builtin_shufflevector(r10, r11, 0, 1, 2, 3, 4, 5, 6, 7);
            o[c4] = __builtin_amdgcn_mfma_f32_32x32x16_bf16(v0, pf[0], o[c4], 0, 0, 0);
            o[c4] = __builtin_amdgcn_mfma_f32_32x32x16_bf16(v1, pf[1], o[c4], 0, 0, 0); }
    }
    const float ltot = l_run + __shfl_xor(l_run, 32);
    if constexpr (PASS == 0) {
#pragma unroll
        for (int c4 = 0; c4 < 4; ++c4)
#pragma unroll
            for (int g4 = 0; g4 < 4; ++g4) *(uint2*)(st_o + 32 * c4 + 8 * g4 + 4 * hh) = make_uint2(pk2(o[c4][4 * g4], o[c4][4 * g4 + 1]), pk2(o[c4][4 * g4 + 2], o[c4][4 * g4 + 3]));
        if (hh == 0) *(f32x2*)st_ml = (f32x2){m_run, ltot};
    } else {
        const float inv = 1.0f / ltot;
        bf16_t* orow = p.AO + (size_t)(b * SEQ + tq) * DM + 1024 + h * 128;
#pragma unroll
        for (int c4 = 0; c4 < 4; ++c4)
#pragma unroll
            for (int g4 = 0; g4 < 4; ++g4) { const int dh = 32 * c4 + 8 * g4 + 4 * hh;
                if constexpr (D8_OUT0) *(unsigned*)((unsigned char*)p.AO + (size_t)(b * SEQ + tq) * DM + 1024 + h * 128 + dh) = pk4_fp8(o[c4][4 * g4] * inv, o[c4][4 * g4 + 1] * inv, o[c4][4 * g4 + 2] * inv, o[c4][4 * g4 + 3] * inv, A8_SCALE);
                else *(uint2*)(orow + dh) = make_uint2(pk2(o[c4][4 * g4] * inv, o[c4][4 * g4 + 1] * inv), pk2(o[c4][4 * g4 + 2] * inv, o[c4][4 * g4 + 3] * inv)); }
    }
}
DI void attention(const Params& p, LAS unsigned char* lds) {
    const int tid = opaque_tid(), wave = __builtin_amdgcn_readfirstlane(tid >> 6), lane = tid & 63, hh = lane >> 5;
    LAS unsigned char* vimg = lds + wave * 8192;
    const unsigned vbase = (unsigned)(uintptr_t)vimg;
    const int q4 = (lane & 15) >> 2, pp = lane & 3, blk = (lane >> 4) & 1;
    const unsigned vb0 = vbase + 256u * (4 * hh + q4) + 16u * ((2 * blk + (pp >> 1)) ^ (hh & 3)) + 8u * (pp & 1) + ((unsigned)q4 << 6);
    const unsigned vb1 = vbase + 256u * (8 + 4 * hh + q4) + 16u * ((2 * blk + (pp >> 1)) ^ ((2 + hh) & 3)) + 8u * (pp & 1) + ((unsigned)q4 << 6);
    for (int u = blockIdx.x; u < 256; u += gridDim.x) {
        const int bh = (u & 7) * 4 + ((u >> 3) >> 3), span = (u >> 3) & 7, h = bh & 7, b = bh >> 3;
#pragma unroll 1
        for (int j = 0; j < 2; ++j) attn_wave<0>(p, vimg, vb0, vb1, lane, b, h, span * 512 + wave * 2 + j);
        asm volatile("s_waitcnt vmcnt(0)" ::: "memory");
        __syncthreads();
#pragma unroll 1
        for (int j = 0; j < 2; ++j) attn_wave<1>(p, vimg, vb0, vb1, lane, b, h, span * 512 + (wave * 2 + j) * 32);
        __syncthreads();
    }
}
DI float om_exp2x(float la, float a) {
    const float x = 2.f * la;
    const float pl = x * (1.f + x * (0.5f + x * (0.16666667f + x * (0.041666668f + x * 0.008333334f))));
    return x > -0.25f ? -pl : 1.f - a * a;
}
DI void lru_conv(const Params& p) {
    const int tid = opaque_tid();
    if (tid < 336) {
        const int ch = tid * 8;
        float cw[4][8], cb[8];
#pragma unroll
        for (int j = 0; j < 4; ++j) { const f32x4 w0 = *(const f32x4*)(p.lru_conv_w + j * LRU_W + ch), w1 = *(const f32x4*)(p.lru_conv_w + j * LRU_W + ch + 4);
            cw[j][0] = w0[0]; cw[j][1] = w0[1]; cw[j][2] = w0[2]; cw[j][3] = w0[3]; cw[j][4] = w1[0]; cw[j][5] = w1[1]; cw[j][6] = w1[2]; cw[j][7] = w1[3]; }
        { const f32x4 b0 = *(const f32x4*)(p.lru_conv_b + ch), b1 = *(const f32x4*)(p.lru_conv_b + ch + 4); cb[0] = b0[0]; cb[1] = b0[1]; cb[2] = b0[2]; cb[3] = b0[3]; cb[4] = b1[0]; cb[5] = b1[1]; cb[6] = b1[2]; cb[7] = b1[3]; }
        for (int run = blockIdx.x; run < T_TOK / 32; run += gridDim.x) {
            const int tok0 = run * 32, t0 = tok0 % SEQ;
            const bf16_t* src = p.G + (size_t)tok0 * N_IN1 + LRU_W + ch;
            u32x4 rows[35];
#pragma unroll
            for (int i = 0; i < 35; ++i) { const int t = t0 - 2 + i; rows[i] = (t >= 0 && t < SEQ) ? *(const u32x4*)(src + (ptrdiff_t)(i - 2) * N_IN1) : (u32x4){0u, 0u, 0u, 0u}; }
#pragma unroll
            for (int i = 0; i < 32; ++i) { float xc[8];
#pragma unroll
                for (int e = 0; e < 8; ++e) xc[e] = cb[e];
#pragma unroll
                for (int j = 0; j < 4; ++j) { const u32x4 xv = rows[i + j];
                    xc[0] += cw[j][0] * bflo(xv[0]); xc[1] += cw[j][1] * bfhi(xv[0]); xc[2] += cw[j][2] * bflo(xv[1]); xc[3] += cw[j][3] * bfhi(xv[1]);
                    xc[4] += cw[j][4] * bflo(xv[2]); xc[5] += cw[j][5] * bfhi(xv[2]); xc[6] += cw[j][6] * bflo(xv[3]); xc[7] += cw[j][7] * bfhi(xv[3]); }
                *(u32x4*)(p.XC + (size_t)(tok0 + i) * LRU_W + ch) = (u32x4){pk2(xc[0], xc[1]), pk2(xc[2], xc[3]), pk2(xc[4], xc[5]), pk2(xc[6], xc[7])}; }
        }
    }
}
DI void lru(const Params& p, LAS unsigned char* lds) {
    const int tid = opaque_tid(), wave = __builtin_amdgcn_readfirstlane(tid >> 6), lane = tid & 63, col = lane & 15, g = lane >> 4;
    LAS unsigned char* wl = lds;
    LAS unsigned char* xs = lds + 36864;
    LAS float* sums = (LAS float*)(lds + 36864 + 86016);
    LAS float* cst = sums + 1920;
    for (int u = blockIdx.x; u < 256; u += gridDim.x) {
        const int bq = (u >> 5) * 8 + (u & 7), qt = (u >> 3) & 3, b = bq >> 4, n = bq & 15, chq = n * LRU_BW + qt * 42;
        const char* xcb = (const char*)(p.XC + (size_t)(b * SEQ) * LRU_W + n * LRU_BW);
        const bf16_t* gb = p.G + (size_t)(b * SEQ) * N_IN1;
        unsigned poff[6];
#pragma unroll
        for (int i = 0; i < 6; ++i) { const int idx = tid + 512 * i; poff[i] = (unsigned)((idx / 21) * LRU_W + (idx % 21) * 8) * 2u; }
        auto dma_chunk = [&](int chunk, int bsel) { const char* src = xcb + (size_t)chunk * 128 * LRU_W * 2; LAS unsigned char* dst = xs + bsel * 43008 + wave * 1024;
#pragma unroll
            for (int i = 0; i < 5; ++i) __builtin_amdgcn_global_load_lds((const unsigned*)(src + poff[i]), (LAS unsigned*)(dst + i * 8192), 16, 0, 0);
            if (wave < 2) __builtin_amdgcn_global_load_lds((const unsigned*)(src + poff[5]), (LAS unsigned*)(dst + 5 * 8192), 16, 0, 0); };
        for (int dir = 0; dir < 2; ++dir) {
            __syncthreads();
            for (int i = tid; i < 2 * 48 * 24; i += 512) { const int which = i / (48 * 24), r = (i / 24) % 48, ck = i % 24; const int nt = r >> 4, cl = r & 15, ks = ck >> 2, gg = ck & 3;
                *(LAS u32x4*)(wl + ((which * 3 + nt) * 6 + ks) * 1024 + (gg * 16 + cl) * 16) = *(const u32x4*)(p.w_lru + ((((size_t)(dir * 2 + which) * 16 + n) * 4 + qt) * 48 + r) * 192 + ck * 8); }
            if (tid < 48) { const bool valid = tid < 42; const int ch = dir * LRU_W + chq + tid;
                cst[tid] = valid ? -1.44269504f * p.lru_b_a[ch] : 0.f; cst[48 + tid] = valid ? -1.44269504f * p.lru_b_x[ch] : 0.f;
                const float lam = valid ? p.lru_lambda[ch] : 0.f; const float sp = (-lam > 20.f) ? -lam : log1pf(__expf(-lam)); cst[96 + tid] = -8.0f * 1.44269504f * sp; }
            dma_chunk(dir == 0 ? 0 : 31, 0);
            asm volatile("s_waitcnt vmcnt(0)" ::: "memory");
            __syncthreads();
            float cba[3], cbx[3], cex[3];
#pragma unroll
            for (int nt = 0; nt < 3; ++nt) { cba[nt] = cst[nt * 16 + col]; cbx[nt] = cst[48 + nt * 16 + col]; cex[nt] = cst[96 + nt * 16 + col]; }
            bf16x8 breg[3][6];
#pragma unroll
            for (int nt = 0; nt < 3; ++nt)
#pragma unroll
                for (int ks = 0; ks < 6; ++ks) { breg[nt][ks] = *(const LAS bf16x8*)(wl + (nt * 6 + ks) * 1024 + lane * 16); asm volatile("" : "+v"(breg[nt][ks])); }
            const int wpos = dir == 0 ? wave : 7 - wave;
            float carry[3] = {0.f, 0.f, 0.f};
            for (int step = 0; step < 32; ++step) {
                const int c = dir == 0 ? step : 31 - step, c0 = c * 128, par = step & 1;
                const bool has_next = step < 31;
                if (has_next) dma_chunk(dir == 0 ? c + 1 : c - 1, par ^ 1);
                LAS unsigned char* xb = xs + par * 43008;
                uint2 hfv[3] = {make_uint2(0u, 0u), make_uint2(0u, 0u), make_uint2(0u, 0u)}; unsigned short gtv[3][4];
                const uint2* hfp = (const uint2*)p.HF + ((size_t)((u * 32 + c) * 8 + wave) * 3) * 64 + lane;
                const bf16_t* gbw = gb + (size_t)(c0 + wave * 16) * N_IN1 + chq;
                bf16_t* aow = p.AO + (size_t)(b * SEQ + c0 + wave * 16) * LRU_W + chq;
                if (dir == 1) {
#pragma unroll
                    for (int nt = 0; nt < 3; ++nt) { hfv[nt] = hfp[nt * 64];
#pragma unroll
                        for (int r = 0; r < 4; ++r) gtv[nt][r] = (nt * 16 + col < 42) ? gbw[(unsigned)((4 * g + r) * N_IN1 + nt * 16 + col)] : (unsigned short)0; } }
                bf16x8 af[6];
#pragma unroll
                for (int ks = 0; ks < 6; ++ks) { const int ch0 = 32 * ks + 8 * g; const bool kval = ch0 < LRU_BW; const int chl0 = kval ? ch0 : 160;
                    const u32x4 xv = *(const LAS u32x4*)(xb + (wave * 16 + col) * 336 + chl0 * 2);
                    af[ks] = __builtin_bit_cast(bf16x8, kval ? xv : (u32x4){0u, 0u, 0u, 0u}); }
                f32x4 acc[2][3];
                {
                    bf16x8 bl[6];
                    const LAS unsigned char* wl1 = wl + 18 * 1024 + lane * 16;
#pragma unroll
                    for (int ks = 0; ks < 6; ++ks) bl[ks] = *(const LAS bf16x8*)(wl1 + ks * 1024);
#pragma unroll
                    for (int nt = 0; nt < 3; ++nt) {
                        acc[0][nt] = (f32x4){0.f, 0.f, 0.f, 0.f}; acc[1][nt] = (f32x4){0.f, 0.f, 0.f, 0.f};
#pragma unroll
                        for (int ks = 0; ks < 6; ++ks) acc[0][nt] = __builtin_amdgcn_mfma_f32_16x16x32_bf16(af[ks], breg[nt][ks], acc[0][nt], 0, 0, 0);
#pragma unroll
                        for (int ks = 0; ks < 6; ++ks) { acc[1][nt] = __builtin_amdgcn_mfma_f32_16x16x32_bf16(af[ks], bl[ks], acc[1][nt], 0, 0, 0);
                            if (nt < 2) bl[ks] = *(const LAS bf16x8*)(wl1 + ((nt + 1) * 6 + ks) * 1024); }
                    }
                }
                float hl[3][4], Pl[3][4];
#pragma unroll
                for (int nt = 0; nt < 3; ++nt) { const int chl = nt * 16 + col;
                    float av[4], uv[4];
#pragma unroll
                    for (int r = 0; r < 4; ++r) {
                        const float rg = __builtin_amdgcn_rcpf(1.0f + __builtin_amdgcn_exp2f(__builtin_fmaf(acc[0][nt][r], -1.44269504f, cba[nt])));
                        const float ig = __builtin_amdgcn_rcpf(1.0f + __builtin_amdgcn_exp2f(__builtin_fmaf(acc[1][nt][r], -1.44269504f, cbx[nt])));
                        const float a = __builtin_amdgcn_exp2f(cex[nt] * rg);
                        const float xcv = bf2f(*(const LAS bf16_t*)(xb + (wave * 16 + 4 * g + r) * 336 + (qt * 42 + chl) * 2));
                        av[r] = a; uv[r] = __builtin_amdgcn_sqrtf(__builtin_fmaf(-a, a, 1.0f)) * (ig * xcv); }
                    float h[4], P[4], A, H;
                    if (dir == 0) { h[0] = uv[0]; P[0] = av[0];
#pragma unroll
                        for (int r = 1; r < 4; ++r) { h[r] = av[r] * h[r - 1] + uv[r]; P[r] = av[r] * P[r - 1]; }
                        A = P[3]; H = h[3];
                        { const float A1 = __shfl_up(A, 16), H1 = __shfl_up(H, 16); if (g >= 1) { H = A * H1 + H; A = A * A1; } }
                        { const float A2 = __shfl_up(A, 32), H2 = __shfl_up(H, 32); if (g >= 2) { H = A * H2 + H; A = A * A2; } }
                        float Ae = __shfl_up(A, 16), He = __shfl_up(H, 16); if (g == 0) { Ae = 1.f; He = 0.f; }
#pragma unroll
                        for (int r = 0; r < 4; ++r) { hl[nt][r] = h[r] + P[r] * He; Pl[nt][r] = P[r] * Ae; }
                        if (g == 3) *(LAS f32x2*)(sums + (par * 48 + chl) * 20 + wpos * 2) = (f32x2){A, H};
                    } else { h[3] = uv[3]; P[3] = av[3];
#pragma unroll
                        for (int r = 2; r >= 0; --r) { h[r] = av[r] * h[r + 1] + uv[r]; P[r] = av[r] * P[r + 1]; }
                        A = P[0]; H = h[0];
                        { const float A1 = __shfl_down(A, 16), H1 = __shfl_down(H, 16); if (g <= 2) { H = A * H1 + H; A = A * A1; } }
                        { const float A2 = __shfl_down(A, 32), H2 = __shfl_down(H, 32); if (g <= 1) { H = A * H2 + H; A = A * A2; } }
                        float Ae = __shfl_down(A, 16), He = __shfl_down(H, 16); if (g == 3) { Ae = 1.f; He = 0.f; }
#pragma unroll
                        for (int r = 0; r < 4; ++r) { hl[nt][r] = h[r] + P[r] * He; Pl[nt][r] = P[r] * Ae; }
                        if (g == 0) *(LAS f32x2*)(sums + (par * 48 + chl) * 20 + wpos * 2) = (f32x2){A, H};
                    }
                }
                asm volatile("s_waitcnt vmcnt(0)" ::: "memory");
                __syncthreads();
                f32x4 sv[3][4];
#pragma unroll
                for (int nt = 0; nt < 3; ++nt)
#pragma unroll
                    for (int j = 0; j < 4; ++j) sv[nt][j] = *(const LAS f32x4*)(sums + (par * 48 + nt * 16 + col) * 20 + j * 4);
#pragma unroll
                for (int nt = 0; nt < 3; ++nt) { const int chl = nt * 16 + col; float C = carry[nt], Cw = 0.f;
#pragma unroll
                    for (int k = 0; k < 8; ++k) { if (k == wpos) Cw = C; C = sv[nt][k >> 1][(k & 1) * 2] * C + sv[nt][k >> 1][(k & 1) * 2 + 1]; }
                    carry[nt] = C;
                    float hv[4];
#pragma unroll
                    for (int r = 0; r < 4; ++r) hv[r] = hl[nt][r] + Pl[nt][r] * Cw;
                    if (dir == 0) ((uint2*)p.HF)[((size_t)((u * 32 + c) * 8 + wave) * 3 + nt) * 64 + lane] = make_uint2(pk2(hv[0], hv[1]), pk2(hv[2], hv[3]));
                    else if (chl < 42) { const float ff[4] = {bflo(hfv[nt].x), bfhi(hfv[nt].x), bflo(hfv[nt].y), bfhi(hfv[nt].y)};
#pragma unroll
                        for (int r = 0; r < 4; ++r) aow[(unsigned)((4 * g + r) * LRU_W + chl)] = f2bf(bf2f(gtv[nt][r]) * (ff[r] + hv[r])); }
                }
            }
        }
    }
}
}

#define XB_TMO      128
#define XB_XCNT(j)  (256  + 64 * (j))
#define XB_XSUB(j)  (1280 + 64 * (j))
#define XB_XGEN(j)  (2304 + 64 * (j))
#define XB_TOP      3328
#define XB_TOPGEN   3392
#define XCD_BAR_WORDS 3456
#define XB_SPIN_CAP (1u << 18)

__device__ __forceinline__ unsigned xb_ld(unsigned* p)              { return __hip_atomic_load(p, __ATOMIC_RELAXED, __HIP_MEMORY_SCOPE_AGENT); }
__device__ __forceinline__ unsigned xb_add(unsigned* p, unsigned v) { return __hip_atomic_fetch_add(p, v, __ATOMIC_RELAXED, __HIP_MEMORY_SCOPE_AGENT); }
__device__ __forceinline__ unsigned xb_xcc_id() { return (unsigned)__builtin_amdgcn_s_getreg((3 << 11) | 20) & 0xFu; }
#define XB_SPIN(cond, bar) do { unsigned _sp = 0; while (cond) { __builtin_amdgcn_s_sleep(1); \
    if ((++_sp & 255u) == 0u) { if (xb_ld(&(bar)[XB_TMO])) break; if (_sp > XB_SPIN_CAP) { atomicAdd(&(bar)[XB_TMO], 1u); break; } } } } while (0)

struct XcdBarrier {
    unsigned* bar; unsigned x;
    volatile LAS unsigned* st;
};

__device__ __forceinline__ XcdBarrier xcd_barrier_post(unsigned* bar, volatile LAS unsigned* st) {
    XcdBarrier b; b.bar = bar; b.x = xb_xcc_id(); b.st = st;
    if (threadIdx.x == 0) (void)xb_add(&bar[XB_XCNT(b.x)], 1u);
    return b;
}
__device__ __forceinline__ void xcd_barrier_complete(unsigned* bar, unsigned x, unsigned& nloc, unsigned& nx) {
    const unsigned G = gridDim.x * gridDim.y * gridDim.z;
    unsigned sum, cnt, mine, sp = 0u;
    for (;;) {
        sum = 0u; cnt = 0u; mine = 0u;
#pragma unroll
        for (unsigned j = 0; j < 16; ++j) { const unsigned c = xb_ld(&bar[XB_XCNT(j)]); sum += c; cnt += (c > 0u) ? 1u : 0u; mine = (j == x) ? c : mine; }
        if (sum == G) break;
        __builtin_amdgcn_s_sleep(1);
        if ((++sp & 255u) == 0u) { if (xb_ld(&bar[XB_TMO])) break; if (sp > XB_SPIN_CAP) { atomicAdd(&bar[XB_TMO], 1u); break; } }
    }
    nloc = mine > 0u ? mine : 1u; nx = cnt > 0u ? cnt : 1u;
}

__device__ __forceinline__ void xcd_barrier(const XcdBarrier& b) {
    asm volatile("s_waitcnt vmcnt(0)" ::: "memory");
    __syncthreads();
    if (threadIdx.x == 0) {
        unsigned* bar = b.bar;
        __builtin_amdgcn_s_waitcnt(0);
        unsigned nloc = b.st[0], nx = b.st[1];
        if (nloc == 0u) { xcd_barrier_complete(bar, b.x, nloc, nx); b.st[0] = nloc; b.st[1] = nx; }
        const unsigned old = xb_add(&bar[XB_XSUB(b.x)], 1u);
        const unsigned gen = old / nloc;
        if (old + 1u == (gen + 1u) * nloc) {
            __builtin_amdgcn_fence(__ATOMIC_RELEASE, "agent");
            asm volatile("s_waitcnt vmcnt(0)" ::: "memory");
            const unsigned og = xb_add(&bar[XB_TOP], 1u);
            const unsigned tg = og / nx;
            if (og + 1u == (tg + 1u) * nx) xb_add(&bar[XB_TOPGEN], 1u);
            else XB_SPIN(xb_ld(&bar[XB_TOPGEN]) == tg, bar);
            __builtin_amdgcn_fence(__ATOMIC_ACQUIRE, "agent");
            xb_add(&bar[XB_XGEN(b.x)], 1u);
            asm volatile("s_waitcnt vmcnt(0)" ::: "memory");
        } else {
            XB_SPIN(xb_ld(&bar[XB_XGEN(b.x)]) == gen, bar);
            __builtin_amdgcn_fence(__ATOMIC_ACQUIRE, "agent");
            asm volatile("s_waitcnt vmcnt(0)" ::: "memory");
        }
    }
    __syncthreads();
}


constexpr int PROBE = 0;
constexpr int LDS_XB_OFF = gm::STAGE_BYTES + 1024;
constexpr int LDS_TOTAL = LDS_XB_OFF + 16;
__global__ void __launch_bounds__(512, 2) mega(Params p) {
    LAS unsigned char* lds = (LAS unsigned char*)dyn_smem;
    LAS int* tab = (LAS int*)(lds + gm::TAB_OFF);
    volatile LAS unsigned* xbw = (volatile LAS unsigned*)(lds + LDS_XB_OFF);
    if (threadIdx.x == 0) { xbw[0] = 0u; xbw[1] = 0u; xbw[2] = 0u; xbw[3] = 0u; }
    __syncthreads();
    XcdBarrier bar = xcd_barrier_post(p.bar, xbw);
    ph::mods(p, lds);
    if constexpr (PROBE == 14) { ph::mods(p, lds); ph::mods(p, lds); }
    xcd_barrier(bar);
    { const int c = blockIdx.x, G = gridDim.x;
      constexpr int N8 = 320 + (D8_OUT0 ? 128 : 0);
      ph::transposer(p, lds, c, c < N8 ? (N8 - c + G - 1) / G : 0, G); __syncthreads();
      ph::transposer(p, lds, N8 + c, c < 952 - N8 ? (952 - N8 - c + G - 1) / G : 0, G); __syncthreads(); }
    ph::lru_weights(p);
    ph::fold_router(p);
    ph::norm_rows<0, D8_IN0>(p, p.x, p.norm0_mix, 0, 0, nullptr);
    xcd_barrier(bar);
    { const int c = blockIdx.x, G = gridDim.x; const int tcount = c < 6144 ? (6144 - c + G - 1) / G : 0; const bool t_first = ((c >> 3) & 1) != 0;
      if (t_first) { ph::transposer(p, lds, 952 + c, tcount, G); __syncthreads(); }
      { gm::DenseSched S; S.init(T_TOK, N_IN0); EpiIn0 e; e.xin = nullptr; e.lgate = 0; if constexpr (D8_IN0) gm::gemm_phase<EpiIn0, gm::DenseSched, true>(lds, p, p.H, p.w_in0t, 0, DM / 2, S, e, W8_E8M0, A8_E8M0); else gm::gemm_phase(lds, p, p.H, p.w_in0t, 0, DM, S, e); }
      if (!t_first) { __syncthreads(); ph::transposer(p, lds, 952 + c, tcount, G); }
      if constexpr (PROBE == 21) { __syncthreads(); ph::transposer(p, lds, 952 + c, tcount, G); }
      if constexpr (PROBE == 24) { __syncthreads(); if (t_first) ph::transposer(p, lds, 952 + c, tcount, G); }
      if constexpr (PROBE == 23) { __syncthreads(); if (t_first) { ph::transposer(p, lds, 952 + c, tcount, G); __syncthreads(); }
        { gm::DenseSched S; S.init(T_TOK, N_IN0); EpiIn0 e; e.xin = nullptr; e.lgate = 0; gm::gemm_phase<EpiIn0, gm::DenseSched, true>(lds, p, p.H, p.w_in0t, 0, DM / 2, S, e, W8_E8M0, A8_E8M0); }
        if (!t_first) { __syncthreads(); ph::transposer(p, lds, 952 + c, tcount, G); } }
      if constexpr (PROBE == 20) { __syncthreads(); gm::DenseSched S; S.init(T_TOK, N_IN0); EpiIn0 e; e.xin = nullptr; e.lgate = 0; gm::gemm_phase<EpiIn0, gm::DenseSched, true>(lds, p, p.H, p.w_in0t, 0, DM / 2, S, e, W8_E8M0, A8_E8M0); } }
    xcd_barrier(bar);
    ph::attention(p, lds);
    if constexpr (PROBE == 4) ph::attention(p, lds);
    __syncthreads();
    ph::conv_gln(p, lds);
    if constexpr (PROBE == 5) ph::conv_gln(p, lds);
    xcd_barrier(bar);
    { gm::DenseSched S; S.init(T_TOK, DM); EpiOutT<true> e; e.xin = p.x; e.lgate = 0; if constexpr (D8_OUT0) gm::gemm_phase<EpiOutT<true>, gm::DenseSched, true>(lds, p, p.AO, p.w_out0t, 0, DM / 2, S, e, W8_E8M0, A8_E8M0); else gm::gemm_phase(lds, p, p.AO, p.w_out0t, 0, DM, S, e); }
    xcd_barrier(bar);
    ph::router<false, true>(p, 0, lds, p.norm0_ffn, 1);
    if constexpr (PROBE == 12) { ph::router<true>(p, 0, lds); ph::router<true>(p, 0, lds); }
    xcd_barrier(bar);
    if constexpr (PROBE == 11) { xcd_barrier(bar); xcd_barrier(bar); xcd_barrier(bar); xcd_barrier(bar); xcd_barrier(bar); xcd_barrier(bar); xcd_barrier(bar); xcd_barrier(bar); xcd_barrier(bar); xcd_barrier(bar); }
    gm::moe_tables(tab, p.cnt);
    { gm::MoeSched<true> S; S.init(tab); EpiGU e; e.xin = nullptr; e.lgate = 0; gm::gemm_phase<EpiGU, gm::MoeSched<true>, true>(lds, p, p.H, p.w_gut0, (size_t)2048 * (DM / 2), DM / 2, S, e, W8_E8M0, A8_E8M0); if constexpr (PROBE == 3) gm::gemm_phase<EpiGU, gm::MoeSched<true>, true>(lds, p, p.H, p.w_gut0, (size_t)2048 * (DM / 2), DM / 2, S, e, W8_E8M0, A8_E8M0); }
    xcd_barrier(bar);
    { gm::MoeSched<false> S; S.init(tab); EpiDown e; e.xin = nullptr; e.lgate = 0; gm::gemm_phase<EpiDown, gm::MoeSched<false>, true>(lds, p, p.ACT, p.w_dt0, (size_t)DM * (EFF / 2), EFF / 2, S, e, W8_E8M0, A8_E8M0); if constexpr (PROBE == 8) gm::gemm_phase<EpiDown, gm::MoeSched<false>, true>(lds, p, p.ACT, p.w_dt0, (size_t)DM * (EFF / 2), EFF / 2, S, e, W8_E8M0, A8_E8M0); }
    xcd_barrier(bar);
    ph::norm_rows<1, D8_IN1>(p, nullptr, p.norm1_mix, 2, 1, tab);
    xcd_barrier(bar);
    { const int c = blockIdx.x, G = gridDim.x; int tfirst, tcount, tstride;
      if (G == 256) { tstride = 1; if (c < 64) { tcount = 18; tfirst = 18 * c; } else { tcount = 26; tfirst = 1152 + 26 * (c - 64); } }
      else { tstride = G; tfirst = c; tcount = c < 6144 ? (6144 - c + G - 1) / G : 0; }
      const bool t_first = ((c >> 3) & 1) != 0;
      if (t_first) { ph::transposer(p, lds, 7096 + tfirst, tcount, tstride); __syncthreads(); }
      { gm::DenseSched S; S.init(T_TOK, N_IN1); EpiIn1 e; e.xin = nullptr; e.lgate = 0; gm::gemm_phase(lds, p, p.H, p.w_in1t, 0, DM, S, e); }
      if (!t_first) { __syncthreads(); ph::transposer(p, lds, 7096 + tfirst, tcount, tstride); } }
    xcd_barrier(bar);
    ph::lru_conv(p);
    if constexpr (PROBE == 9) { ph::lru_conv(p); ph::lru_conv(p); }
    xcd_barrier(bar);
    ph::lru(p, lds);
    if constexpr (PROBE == 6) ph::lru(p, lds);
    xcd_barrier(bar);
    { gm::DenseSched S; S.init(T_TOK, DM); EpiOutT<false> e; e.xin = nullptr; e.lgate = 2; gm::gemm_phase(lds, p, p.AO, p.w_out1t, 0, LRU_W, S, e); }
    xcd_barrier(bar);
    ph::router<false, true>(p, 1, lds, p.norm1_ffn, 3);
    xcd_barrier(bar);
    gm::moe_tables(tab, p.cnt + 32);
    { gm::MoeSched<true> S; S.init(tab); EpiGU e; e.xin = nullptr; e.lgate = 0; gm::gemm_phase<EpiGU, gm::MoeSched<true>, true>(lds, p, p.H, p.w_gut1, (size_t)2048 * (DM / 2), DM / 2, S, e, W8_E8M0, A8_E8M0); }
    xcd_barrier(bar);
    { gm::MoeSched<false> S; S.init(tab); EpiDown e; e.xin = nullptr; e.lgate = 0; gm::gemm_phase<EpiDown, gm::MoeSched<false>, true>(lds, p, p.ACT, p.w_dt1, (size_t)DM * (EFF / 2), EFF / 2, S, e, W8_E8M0, A8_E8M0); }
    xcd_barrier(bar);
    ph::norm_rows<2>(p, nullptr, p.norm_final, 0, 3, tab);
}

static inline size_t al256(size_t x) { return (x + 255) & ~(size_t)255; }

extern "C" void kernel_launch(void* const* d_in, const int* in_sizes, int n_in, void* d_out, int out_size, void* d_ws, size_t ws_size, hipStream_t stream) {
    Params p{};
    const float** ip = (const float**)&p.x;
    for (int i = 0; i < 38; ++i) ip[i] = (const float*)d_in[i];
    p.out = (float*)d_out;
    char* w = (char*)d_ws; size_t off = 0;
    auto take = [&](size_t bytes) { char* r = w + off; off += al256(bytes); return r; };
    p.bar = (unsigned*)take(16384); p.cnt = (int*)take(256);
    const size_t zero_bytes = off;
    p.mod = (float*)take(4 * 4 * 6144 * 4); p.wrt = (bf16_t*)take((size_t)2 * 4 * 3 * 48 * 2048 * 2); p.rbias = (float*)take(2 * 4 * 48 * 4);
    p.w_in0t = (bf16_t*)take((size_t)N_IN0 * DM * 2); p.w_out0t = (bf16_t*)take((size_t)DM * DM * 2);
    p.w_gut0 = (bf16_t*)take((size_t)NEXP * 2048 * DM); p.w_dt0 = (bf16_t*)take((size_t)NEXP * DM * EFF);
    p.w_in1t = (bf16_t*)take((size_t)N_IN1 * DM * 2); p.w_out1t = (bf16_t*)take((size_t)DM * LRU_W * 2);
    p.w_gut1 = (bf16_t*)take((size_t)NEXP * 2048 * DM); p.w_dt1 = (bf16_t*)take((size_t)NEXP * DM * EFF);
    p.w_lru = (bf16_t*)take((size_t)2 * 2 * 16 * 2 * 96 * 192 * 2);
    p.H = (bf16_t*)take((size_t)T_TOK * DM * 2); p.G = (bf16_t*)take((size_t)T_TOK * N_IN1 * 2); p.AO = (bf16_t*)take((size_t)T_TOK * LRU_W * 2); p.HF = (bf16_t*)take((size_t)256 * 32 * 8 * 3 * 64 * 8);
    p.XA = (bf16_t*)take((size_t)T_TOK * DM * 2); p.ACT = (bf16_t*)take((size_t)ROWS_PAD * EFF * 2); p.YB = (bf16_t*)take((size_t)ROWS_PAD * DM * 2);
    p.XC = (bf16_t*)take((size_t)T_TOK * LRU_W * 2); p.KVH = (bf16_t*)take((size_t)NBATCH * 8 * 2 * SEQ * 128 * 2);
    p.tokl = (int*)take((size_t)NEXP * ECAP * 4); p.gatel = (float*)take((size_t)NEXP * ECAP * 4); p.asg = (int*)take((size_t)T_TOK * 2 * 4);
    if (off > ws_size) return;
    (void)hipMemsetAsync(d_ws, 0, zero_bytes, stream);
    static int grid = 0;
    if (!grid) { int dev = 0, cus = 0, per_cu = 0; (void)hipGetDevice(&dev); (void)hipDeviceGetAttribute(&cus, hipDeviceAttributeMultiprocessorCount, dev);
        (void)hipFuncSetAttribute((const void*)mega, hipFuncAttributeMaxDynamicSharedMemorySize, LDS_TOTAL);
        (void)hipOccupancyMaxActiveBlocksPerMultiprocessor(&per_cu, mega, 512, LDS_TOTAL);
        grid = cus * (per_cu < 1 ? per_cu : 1); }
    if (grid > 0) mega<<<grid, 512, LDS_TOTAL, stream>>>(p);
}
```
